# Optimizing an MI355X kernel written in HIP

```python
import math
import jax
import jax.numpy as jnp
from jax import lax
import numpy as np


D_MODEL = 1024
BATCH = 8
SEQ = 2048
DEPTH = 2

GRID_W = 64
CTX_LEN = 256
D_MIX = D_MODEL
D_CONV = D_MIX // 4
CONV_WIDTH = 3
D_SSM = D_MIX // 4
SSM_GROUP = 16
SSM_GROUPS = D_SSM // SSM_GROUP
SSM_STATE = 64
HEAD_DIM = 64
D_ATTN = D_MIX - D_CONV - D_SSM
N_Q_HEADS = D_ATTN // HEAD_DIM
N_KV_HEADS = 2
Q_PER_KV = N_Q_HEADS // N_KV_HEADS
D_KV = N_KV_HEADS * HEAD_DIM
AXIS_PAIRS = HEAD_DIM // 4
ROPE_BASE = 10000.0
WINDOW = 128
BLOCK = 128
N_EXPERTS = 32
TOP_K = 4
D_EXPERT = 128
D_SHARED = 128
ROUTED_SCALE = 2.5
NORM_EPS = 1e-6
NEG_INF = -1e30
PROJ_SPLITS = (D_CONV, 2 * D_CONV, 3 * D_CONV, 3 * D_CONV + D_SSM,
               3 * D_CONV + D_SSM + D_ATTN, 3 * D_CONV + D_SSM + D_ATTN + D_KV)
D_IN_PROJ = 3 * D_CONV + D_SSM + D_ATTN + 2 * D_KV

kernel_name = 'hybrid_conv_s5_swa_moe_dit_block'


def rms_norm(x, g):
    xf = x.astype(jnp.float32)
    y = xf * lax.rsqrt(jnp.mean(xf * xf, axis=-1, keepdims=True) + NORM_EPS)
    return (y * g.astype(jnp.float32)).astype(x.dtype)


def modulate(x, shift, scale):
    return x * (1.0 + scale) + shift


def axial_rope_angles(n_tokens):
    rows = n_tokens // GRID_W
    row = jnp.repeat(jnp.arange(rows, dtype=jnp.float32), GRID_W)
    col = jnp.tile(jnp.arange(GRID_W, dtype=jnp.float32), rows)
    inv_freq = ROPE_BASE ** (-jnp.arange(AXIS_PAIRS, dtype=jnp.float32) / AXIS_PAIRS)
    return jnp.stack([row[:, None] * inv_freq, col[:, None] * inv_freq], axis=1)


def apply_axial_rope(t, ang):
    b, l, h, _ = t.shape
    t4 = t.reshape(b, l, h, 2, 2, AXIS_PAIRS)
    t1, t2 = t4[..., 0, :], t4[..., 1, :]
    cos = jnp.cos(ang)[None, :, None]
    sin = jnp.sin(ang)[None, :, None]
    out = jnp.stack([t1 * cos - t2 * sin, t1 * sin + t2 * cos], axis=-2)
    return out.reshape(b, l, h, HEAD_DIM)


def head_rms(t, n_heads, g):
    b, l, _ = t.shape
    return rms_norm(t.reshape(b, l, n_heads, HEAD_DIM), g).astype(jnp.float32)


def short_conv_mixer(conv_x, conv_b, conv_c, conv_w):
    v = conv_c * conv_x
    y = lax.conv_general_dilated(v, conv_w.astype(v.dtype)[:, None, :], window_strides=(1,),
                                 padding=((1, 1),), dimension_numbers=('NWC', 'WIO', 'NWC'),
                                 feature_group_count=D_CONV)
    return conv_b * y


def ssm_drive(u, b_bar):
    b, l, _ = u.shape
    ug = u.reshape(b, l, SSM_GROUPS, SSM_GROUP).astype(jnp.complex64)
    return jnp.einsum('blgh,gph->blgp', ug, b_bar)


def ssm_readout(h, c_mat):
    b, l = h.shape[:2]
    return jnp.einsum('blgp,ghp->blgh', h, c_mat).real.reshape(b, l, D_SSM)


def diag_scan(lam_bar, bu, reverse):
    a = jnp.broadcast_to(lam_bar, bu.shape)

    def combine(e1, e2):
        a1, b1 = e1
        a2, b2 = e2
        return a1 * a2, a2 * b1 + b2

    _, h = lax.associative_scan(combine, (a, bu), reverse=reverse, axis=1)
    return h


def ssm_glu(y, w_glu, b_glu):
    g = jax.nn.gelu(y)
    return g * jax.nn.sigmoid(g @ w_glu + b_glu)


def ssm_mixer(u_lat, u_ctx, lam_re, lam_im, log_dt, b_re, b_im, c_re, c_im, d_skip, w_glu, b_glu,
              with_ctx_out):
    f32 = jnp.float32
    d = d_skip.astype(f32)
    ul = u_lat.astype(f32)
    uc = u_ctx.astype(f32)
    y_lat = d * ul
    y_ctx = d * uc if with_ctx_out else None
    for direction, reverse in ((0, False), (1, True)):
        lam = lax.complex(lam_re[direction].astype(f32), lam_im[direction].astype(f32))
        dt = jnp.exp(log_dt[direction].astype(f32))[:, None]
        lam_bar = jnp.exp(lam * dt)
        b_mat = lax.complex(b_re[direction].astype(f32), b_im[direction].astype(f32))
        b_bar = ((lam_bar - 1.0) / lam)[..., None] * b_mat
        c_mat = lax.complex(c_re[direction].astype(f32), c_im[direction].astype(f32))
        h_ctx = diag_scan(lam_bar, ssm_drive(uc, b_bar), reverse)
        h0 = h_ctx[:, 0] if reverse else h_ctx[:, -1]
        bu = ssm_drive(ul, b_bar)
        bu = bu.at[:, -1 if reverse else 0].add(lam_bar * h0)
        y_lat = y_lat + ssm_readout(diag_scan(lam_bar, bu, reverse), c_mat)
        if with_ctx_out:
            y_ctx = y_ctx + ssm_readout(h_ctx, c_mat)
    out_lat = ssm_glu(y_lat, w_glu, b_glu)
    out_ctx = ssm_glu(y_ctx, w_glu, b_glu) if with_ctx_out else None
    return out_lat, out_ctx


def window_attention(q, k, v, k_ctx, v_ctx, sink):
    b, l = q.shape[:2]
    n_blk = l // BLOCK
    n_ctx = k_ctx.shape[1]
    scale = HEAD_DIM ** -0.5
    qb = q.reshape(b, n_blk, BLOCK, N_KV_HEADS, Q_PER_KV, HEAD_DIM)

    def band(t):
        tp = jnp.pad(t, ((0, 0), (BLOCK, BLOCK), (0, 0), (0, 0)))
        tp = tp.reshape(b, n_blk + 2, BLOCK, N_KV_HEADS, HEAD_DIM)
        return jnp.concatenate([tp[:, :-2], tp[:, 1:-1], tp[:, 2:]], axis=2)

    kb, vb = band(k), band(v)
    s_win = jnp.einsum('bnqgrd,bnkgd->bgrnqk', qb, kb) * scale
    blk = jnp.arange(n_blk)[:, None, None]
    qpos = blk * BLOCK + jnp.arange(BLOCK)[None, :, None]
    kpos = (blk - 1) * BLOCK + jnp.arange(3 * BLOCK)[None, None, :]
    valid = (jnp.abs(qpos - kpos) <= WINDOW) & (kpos >= 0) & (kpos < l)
    s_win = jnp.where(valid, s_win, NEG_INF)
    s_ctx = jnp.einsum('bnqgrd,bcgd->bgrnqc', qb, k_ctx) * scale
    s_sink = jnp.broadcast_to(
        sink.astype(jnp.float32).reshape(N_KV_HEADS, Q_PER_KV)[None, :, :, None, None, None],
        s_win.shape[:-1] + (1,))
    p = jax.nn.softmax(jnp.concatenate([s_win, s_ctx, s_sink], axis=-1), axis=-1)
    p_win = p[..., :3 * BLOCK]
    p_ctx = p[..., 3 * BLOCK:3 * BLOCK + n_ctx]
    o = (jnp.einsum('bgrnqk,bnkgd->bnqgrd', p_win, vb)
         + jnp.einsum('bgrnqc,bcgd->bnqgrd', p_ctx, v_ctx))
    return o.reshape(b, l, D_ATTN)


def context_attention(q_ctx, k_ctx, v_ctx, sink):
    b, n_ctx = q_ctx.shape[:2]
    qg = q_ctx.reshape(b, n_ctx, N_KV_HEADS, Q_PER_KV, HEAD_DIM)
    s = jnp.einsum('bqgrd,bkgd->bgrqk', qg, k_ctx) * HEAD_DIM ** -0.5
    s_sink = jnp.broadcast_to(
        sink.astype(jnp.float32).reshape(N_KV_HEADS, Q_PER_KV)[None, :, :, None, None],
        s.shape[:-1] + (1,))
    p = jax.nn.softmax(jnp.concatenate([s, s_sink], axis=-1), axis=-1)
    o = jnp.einsum('bgrqk,bkgd->bqgrd', p[..., :n_ctx], v_ctx)
    return o.reshape(b, n_ctx, D_ATTN)


def moe_ffn(x, router_w, router_bias, w_exp_gate, w_exp_up, w_exp_down, w_sh_gate, w_sh_up, w_sh_down):
    shp = x.shape
    t = x.reshape(-1, D_MODEL)
    scores = jax.nn.sigmoid(t.astype(jnp.float32) @ router_w.astype(jnp.float32))
    _, idx = lax.top_k(scores + router_bias.astype(jnp.float32), TOP_K)
    sel = jnp.take_along_axis(scores, idx, axis=-1)
    wts = sel / jnp.sum(sel, axis=-1, keepdims=True) * ROUTED_SCALE
    gates = jnp.sum(jax.nn.one_hot(idx, N_EXPERTS, dtype=jnp.float32) * wts[..., None], axis=1)
    hg = jnp.einsum('td,def->tef', t, w_exp_gate)
    hu = jnp.einsum('td,def->tef', t, w_exp_up)
    hidden = jax.nn.silu(hg) * hu * gates[..., None]
    y = jnp.einsum('tef,efd->td', hidden, w_exp_down)
    y = y + (jax.nn.silu(t @ w_sh_gate) * (t @ w_sh_up)) @ w_sh_down
    return y.reshape(shp)


def setup_inputs(seed: int = 0) -> dict:
    key = jax.random.key(seed)
    ks = jax.random.split(key, 32)
    f32 = jnp.float32

    def nrm(i, shape, scale):
        return scale * jax.random.normal(ks[i], shape, f32)

    n_idx = jnp.arange(SSM_STATE, dtype=f32)
    ssm_shape = (DEPTH, 2, SSM_GROUPS, SSM_STATE)
    return {
        'x': nrm(0, (BATCH, SEQ, D_MODEL), 1.0),
        'c': nrm(1, (BATCH, D_MODEL), 1.0),
        'ctx': nrm(2, (BATCH, CTX_LEN, D_MODEL), 1.0),
        'c_ctx': nrm(3, (D_MODEL,), 1.0),
        'w_mod': nrm(4, (DEPTH, D_MODEL, 6 * D_MODEL), 0.5 * D_MODEL ** -0.5),
        'b_mod': nrm(5, (DEPTH, 6 * D_MODEL), 0.01),
        'norm1_g': 1.0 + nrm(6, (DEPTH, D_MODEL), 0.02),
        'norm2_g': 1.0 + nrm(7, (DEPTH, D_MODEL), 0.02),
        'w_in': nrm(8, (DEPTH, D_MODEL, D_IN_PROJ), D_MODEL ** -0.5),
        'conv_w': nrm(9, (DEPTH, CONV_WIDTH, D_CONV), CONV_WIDTH ** -0.5),
        'ssm_lam_re': -0.5 + nrm(10, ssm_shape, 0.01),
        'ssm_lam_im': jnp.pi * n_idx + nrm(11, ssm_shape, 0.01),
        'ssm_log_dt': jax.random.uniform(ks[12], (DEPTH, 2, SSM_GROUPS), dtype=f32,
                                         minval=math.log(1e-3), maxval=math.log(1e-1)),
        'ssm_b_re': nrm(13, (DEPTH, 2, SSM_GROUPS, SSM_STATE, SSM_GROUP), (2 * SSM_GROUP) ** -0.5),
        'ssm_b_im': nrm(14, (DEPTH, 2, SSM_GROUPS, SSM_STATE, SSM_GROUP), (2 * SSM_GROUP) ** -0.5),
        'ssm_c_re': nrm(15, (DEPTH, 2, SSM_GROUPS, SSM_GROUP, SSM_STATE), SSM_STATE ** -0.5),
        'ssm_c_im': nrm(16, (DEPTH, 2, SSM_GROUPS, SSM_GROUP, SSM_STATE), SSM_STATE ** -0.5),
        'ssm_d': nrm(17, (DEPTH, D_SSM), 1.0),
        'w_glu': nrm(18, (DEPTH, D_SSM, D_SSM), D_SSM ** -0.5),
        'b_glu': nrm(19, (DEPTH, D_SSM), 0.01),
        'q_norm_g': 1.0 + nrm(20, (DEPTH, HEAD_DIM), 0.02),
        'k_norm_g': 1.0 + nrm(21, (DEPTH, HEAD_DIM), 0.02),
        'attn_sink': nrm(22, (DEPTH, N_Q_HEADS), 1.0),
        'w_out': nrm(23, (DEPTH, D_MIX, D_MODEL), D_MIX ** -0.5),
        'router_w': nrm(24, (DEPTH, D_MODEL, N_EXPERTS), D_MODEL ** -0.5),
        'router_bias': nrm(25, (DEPTH, N_EXPERTS), 0.01),
        'w_exp_gate': nrm(26, (DEPTH, D_MODEL, N_EXPERTS, D_EXPERT), D_MODEL ** -0.5),
        'w_exp_up': nrm(27, (DEPTH, D_MODEL, N_EXPERTS, D_EXPERT), D_MODEL ** -0.5),
        'w_exp_down': nrm(28, (DEPTH, N_EXPERTS, D_EXPERT, D_MODEL), D_EXPERT ** -0.5),
        'w_sh_gate': nrm(29, (DEPTH, D_MODEL, D_SHARED), D_MODEL ** -0.5),
        'w_sh_up': nrm(30, (DEPTH, D_MODEL, D_SHARED), D_MODEL ** -0.5),
        'w_sh_down': nrm(31, (DEPTH, D_SHARED, D_MODEL), D_SHARED ** -0.5),
    }


def reference(x, c, ctx, c_ctx, w_mod, b_mod, norm1_g, norm2_g, w_in, conv_w,
              ssm_lam_re, ssm_lam_im, ssm_log_dt, ssm_b_re, ssm_b_im, ssm_c_re, ssm_c_im,
              ssm_d, w_glu, b_glu, q_norm_g, k_norm_g, attn_sink, w_out,
              router_w, router_bias, w_exp_gate, w_exp_up, w_exp_down,
              w_sh_gate, w_sh_up, w_sh_down):
    n_lat = x.shape[1]
    rope_ang = axial_rope_angles(n_lat)
    silu_c = jax.nn.silu(c)[:, None, :]
    silu_cc = jax.nn.silu(c_ctx)[None, None, :]
    h, hc = x, ctx
    for l in range(DEPTH):
        ctx_out = l < DEPTH - 1
        sh1, sc1, g1, sh2, sc2, g2 = jnp.split(silu_c @ w_mod[l] + b_mod[l], 6, axis=-1)
        csh1, csc1, cg1, csh2, csc2, cg2 = jnp.split(silu_cc @ w_mod[l] + b_mod[l], 6, axis=-1)

        p = modulate(rms_norm(h, norm1_g[l]), sh1, sc1) @ w_in[l]
        pc = modulate(rms_norm(hc, norm1_g[l]), csh1, csc1) @ w_in[l]
        conv_x, conv_b, conv_c, u, q, k, v = jnp.split(p, PROJ_SPLITS, axis=-1)
        conv_xc, conv_bc, conv_cc, uc, qc, kc, vc = jnp.split(pc, PROJ_SPLITS, axis=-1)

        y_conv = short_conv_mixer(conv_x, conv_b, conv_c, conv_w[l])
        y_ssm, y_ssm_c = ssm_mixer(u, uc, ssm_lam_re[l], ssm_lam_im[l], ssm_log_dt[l], ssm_b_re[l],
                                   ssm_b_im[l], ssm_c_re[l], ssm_c_im[l], ssm_d[l], w_glu[l], b_glu[l],
                                   ctx_out)
        q_lat = apply_axial_rope(head_rms(q, N_Q_HEADS, q_norm_g[l]), rope_ang)
        k_lat = apply_axial_rope(head_rms(k, N_KV_HEADS, k_norm_g[l]), rope_ang)
        v_lat = v.reshape(v.shape[0], n_lat, N_KV_HEADS, HEAD_DIM)
        k_ctx = head_rms(kc, N_KV_HEADS, k_norm_g[l])
        v_ctx = vc.reshape(vc.shape[0], vc.shape[1], N_KV_HEADS, HEAD_DIM)
        y_att = window_attention(q_lat, k_lat, v_lat, k_ctx, v_ctx, attn_sink[l])

        mix = jnp.concatenate([y_conv, y_ssm, y_att], axis=-1) @ w_out[l]
        h_mid = h + g1 * mix
        h_new = h_mid + g2 * moe_ffn(modulate(rms_norm(h_mid, norm2_g[l]), sh2, sc2),
                                     router_w[l], router_bias[l], w_exp_gate[l], w_exp_up[l],
                                     w_exp_down[l], w_sh_gate[l], w_sh_up[l], w_sh_down[l])

        if ctx_out:
            y_conv_c = short_conv_mixer(conv_xc, conv_bc, conv_cc, conv_w[l])
            q_ctx = head_rms(qc, N_Q_HEADS, q_norm_g[l])
            y_att_c = context_attention(q_ctx, k_ctx, v_ctx, attn_sink[l])
            mix_c = jnp.concatenate([y_conv_c, y_ssm_c, y_att_c], axis=-1) @ w_out[l]
            hc_mid = hc + cg1 * mix_c
            hc = hc_mid + cg2 * moe_ffn(modulate(rms_norm(hc_mid, norm2_g[l]), csh2, csc2),
                                        router_w[l], router_bias[l], w_exp_gate[l], w_exp_up[l],
                                        w_exp_down[l], w_sh_gate[l], w_sh_up[l], w_sh_down[l])
        h = h_new
    return h
```

```cpp
#include <hip/hip_runtime.h>
#include <hip/hip_cooperative_groups.h>
#include <cstdio>
#include <cstdint>
namespace cg = cooperative_groups;

constexpr int D = 1024, NB = 8, L = 2048, LC = 256;
constexpr int TL = NB * L, TC = NB * LC, TA = TL + TC;
constexpr int DIN = 1792, DCONV = 256, DSSM = 256, DATT = 512;
constexpr int NQH = 8, NKVH = 2, HD = 64;
constexpr int COL_U = 768, COL_Q = 1024, COL_K = 1536, COL_V = 1664;
constexpr int NE = 32, TOPK = 4, DE = 128;
constexpr int SG = 16, SH = 16, SP = 64;
constexpr int NT = 256;

enum { I_X = 0, I_C, I_CTX, I_CCTX, I_WMOD, I_BMOD, I_N1G, I_N2G, I_WIN, I_CONVW, I_LRE, I_LIM, I_LDT, I_BRE, I_BIM, I_CRE, I_CIM,
       I_SD, I_WGLU, I_BGLU, I_QG, I_KG, I_SINK, I_WOUT, I_RW, I_RB, I_WEG, I_WEU, I_WED, I_WSG, I_WSU, I_WSD, N_IN };

constexpr size_t WS_MOD = 65536;
constexpr size_t WS_BUFA = WS_MOD + 524288;
constexpr size_t WS_BUFP = WS_BUFA + (size_t)TA * D * 4;
constexpr size_t WS_Y = WS_BUFP + (size_t)TA * DIN * 4;
constexpr size_t WS_HC1 = WS_Y + (size_t)TA * DSSM * 4;
constexpr size_t WS_HCMID = WS_HC1 + (size_t)TC * D * 4;
constexpr size_t WS_RIDX = WS_HCMID + (size_t)TC * D * 4;
constexpr size_t WS_RWT = WS_RIDX + (size_t)TA * 4 * 4;
constexpr size_t WS_END = WS_RWT + (size_t)TA * 4 * 4;

struct P {
    const float* in[N_IN];
    float* out;
    unsigned char* ws;
};

__device__ __forceinline__ float silu_f(float x) { return x / (1.f + expf(-x)); }
__device__ __forceinline__ float sigmoid_f(float x) { return 1.f / (1.f + expf(-x)); }
__device__ __forceinline__ float gelu_f(float x) { return 0.5f * x * (1.f + tanhf(0.7978845608028654f * (x + 0.044715f * x * x * x))); }
__device__ __forceinline__ float wave_sum(float v) {
#pragma unroll
    for (int o = 32; o > 0; o >>= 1) v += __shfl_xor(v, o);
    return v;
}
__device__ __forceinline__ int row_bb(int r) { return r < TL ? r / L : 8; }
__device__ __forceinline__ const float* h_row(const P& p, int l, int r) {
    if (r < TL) return (l == 0 ? p.in[I_X] : p.out) + (size_t)r * D;
    return (l == 0 ? p.in[I_CTX] : (const float*)(p.ws + WS_HC1)) + (size_t)(r - TL) * D;
}
__device__ __forceinline__ float* hmid_row(const P& p, int r) {
    if (r < TL) return p.out + (size_t)r * D;
    return (float*)(p.ws + WS_HCMID) + (size_t)(r - TL) * D;
}
__device__ __forceinline__ const float* mod_vec(const P& p, int l, int bb, int chunk) {
    return (const float*)(p.ws + WS_MOD) + ((size_t)(l * 9 + bb) * 6 + chunk) * D;
}

template <class Epi>
__device__ void sgemm_stage(const float* A, int lda, const float* B, int ldb, int M, int N, int K, Epi epi, float* lds) {
    float* As = lds;
    float* Bs = lds + 16 * 68;
    const int t = threadIdx.x, tx = t & 15, ty = t >> 4;
    const int tn = N / 64, tm = M / 64;
    for (int tile = blockIdx.x; tile < tm * tn; tile += gridDim.x) {
        const int m0 = (tile / tn) * 64, n0 = (tile % tn) * 64;
        float acc[4][4];
#pragma unroll
        for (int i = 0; i < 4; ++i)
#pragma unroll
            for (int j = 0; j < 4; ++j) acc[i][j] = 0.f;
        for (int k0 = 0; k0 < K; k0 += 16) {
            {
                const int row = t >> 2, kq = (t & 3) * 4;
                const float4 v = *(const float4*)(A + (size_t)(m0 + row) * lda + k0 + kq);
                As[(kq + 0) * 68 + row] = v.x; As[(kq + 1) * 68 + row] = v.y; As[(kq + 2) * 68 + row] = v.z; As[(kq + 3) * 68 + row] = v.w;
                const int kr = t >> 4, nq = (t & 15) * 4;
                const float4 w = *(const float4*)(B + (size_t)(k0 + kr) * ldb + n0 + nq);
                *(float4*)(Bs + kr * 68 + nq) = w;
            }
            __syncthreads();
#pragma unroll
            for (int kk = 0; kk < 16; ++kk) {
                const float4 a = *(const float4*)(As + kk * 68 + ty * 4);
                const float4 b = *(const float4*)(Bs + kk * 68 + tx * 4);
                const float av[4] = {a.x, a.y, a.z, a.w}, bv[4] = {b.x, b.y, b.z, b.w};
#pragma unroll
                for (int i = 0; i < 4; ++i)
#pragma unroll
                    for (int j = 0; j < 4; ++j) acc[i][j] += av[i] * bv[j];
            }
            __syncthreads();
        }
#pragma unroll
        for (int i = 0; i < 4; ++i)
#pragma unroll
            for (int j = 0; j < 4; ++j) epi(m0 + ty * 4 + i, n0 + tx * 4 + j, acc[i][j]);
    }
}

__device__ void st_mod(const P& p, float* lds) {
    for (int i = threadIdx.x; i < 9 * D; i += NT) {
        const int bb = i / D, k = i % D;
        const float c = bb < 8 ? p.in[I_C][bb * D + k] : p.in[I_CCTX][k];
        lds[i] = silu_f(c);
    }
    __syncthreads();
    float* mod = (float*)(p.ws + WS_MOD);
    for (int idx = blockIdx.x * NT + threadIdx.x; idx < 2 * 6 * D; idx += gridDim.x * NT) {
        const int l = idx / (6 * D), j = idx % (6 * D);
        const float* w = p.in[I_WMOD] + (size_t)l * D * 6 * D + j;
        float acc[9];
#pragma unroll
        for (int bb = 0; bb < 9; ++bb) acc[bb] = 0.f;
        for (int k = 0; k < D; ++k) {
            const float wv = w[(size_t)k * 6 * D];
#pragma unroll
            for (int bb = 0; bb < 9; ++bb) acc[bb] += lds[bb * D + k] * wv;
        }
        const float bias = p.in[I_BMOD][l * 6 * D + j];
#pragma unroll
        for (int bb = 0; bb < 9; ++bb) mod[(size_t)(l * 9 + bb) * 6 * D + j] = acc[bb] + bias;
    }
}

__device__ void st_norm(const P& p, int l, int which) {
    const int lane = threadIdx.x & 63, wv = threadIdx.x >> 6;
    const int nrows = (which == 1 && l == 1) ? TL : TA;
    float* xn = (float*)(p.ws + WS_BUFA);
    const float* g = p.in[which == 0 ? I_N1G : I_N2G] + l * D;
    for (int r = blockIdx.x * 4 + wv; r < nrows; r += gridDim.x * 4) {
        const float* src = which == 0 ? h_row(p, l, r) : hmid_row(p, r);
        const int bb = row_bb(r);
        const float* sh = mod_vec(p, l, bb, which == 0 ? 0 : 3);
        const float* sc = mod_vec(p, l, bb, which == 0 ? 1 : 4);
        float4 v[4];
        float s = 0.f;
#pragma unroll
        for (int j = 0; j < 4; ++j) { v[j] = *(const float4*)(src + j * 256 + lane * 4); s += v[j].x * v[j].x + v[j].y * v[j].y + v[j].z * v[j].z + v[j].w * v[j].w; }
        s = wave_sum(s);
        const float rinv = rsqrtf(s * (1.f / D) + 1e-6f);
#pragma unroll
        for (int j = 0; j < 4; ++j) {
            const int k = j * 256 + lane * 4;
            const float4 gg = *(const float4*)(g + k), s1 = *(const float4*)(sc + k), s0 = *(const float4*)(sh + k);
            float4 o;
            o.x = v[j].x * rinv * gg.x * (1.f + s1.x) + s0.x;
            o.y = v[j].y * rinv * gg.y * (1.f + s1.y) + s0.y;
            o.z = v[j].z * rinv * gg.z * (1.f + s1.z) + s0.z;
            o.w = v[j].w * rinv * gg.w * (1.f + s1.w) + s0.w;
            *(float4*)(xn + (size_t)r * D + k) = o;
        }
    }
}

struct EpiStore { float* C; int ldc; __device__ void operator()(int r, int c, float v) const { C[(size_t)r * ldc + c] = v; } };

__device__ void st_qknorm(const P& p, int l) {
    float* pb = (float*)(p.ws + WS_BUFP);
    for (int idx = blockIdx.x * NT + threadIdx.x; idx < TA * 10; idx += gridDim.x * NT) {
        const int r = idx / 10, hh = idx % 10;
        float* v = pb + (size_t)r * DIN + COL_Q + hh * 64;
        const float* g = (hh < 8 ? p.in[I_QG] : p.in[I_KG]) + l * 64;
        float s = 0.f;
        for (int d = 0; d < 64; ++d) s += v[d] * v[d];
        const float rinv = rsqrtf(s * (1.f / 64.f) + 1e-6f);
        if (r < TL) {
            const int t = r % L;
            const float pos[2] = {(float)(t / 64), (float)(t % 64)};
#pragma unroll
            for (int a = 0; a < 2; ++a)
                for (int i = 0; i < 16; ++i) {
                    const float invf = powf(10000.f, -(float)i / 16.f);
                    const float ang = pos[a] * invf;
                    const float cs = cosf(ang), sn = sinf(ang);
                    const int d1 = a * 32 + i, d2 = d1 + 16;
                    const float t1 = v[d1] * rinv * g[d1], t2 = v[d2] * rinv * g[d2];
                    v[d1] = t1 * cs - t2 * sn;
                    v[d2] = t1 * sn + t2 * cs;
                }
        } else {
            for (int d = 0; d < 64; ++d) v[d] = v[d] * rinv * g[d];
        }
    }
}

__device__ void st_conv(const P& p, int l) {
    const float* pb = (const float*)(p.ws + WS_BUFP);
    float* mix = (float*)(p.ws + WS_BUFA);
    const float* cw = p.in[I_CONVW] + l * 3 * DCONV;
    const int nrows = l == 0 ? TA : TL;
    for (int idx = blockIdx.x * NT + threadIdx.x; idx < nrows * DCONV; idx += gridDim.x * NT) {
        const int r = idx / DCONV, ch = idx % DCONV;
        int t, len;
        if (r < TL) { t = r % L; len = L; } else { t = (r - TL) % LC; len = LC; }
        const float* pr = pb + (size_t)r * DIN;
        float y = cw[DCONV + ch] * (pr[512 + ch] * pr[ch]);
        if (t > 0) y += cw[ch] * (pr[-DIN + 512 + ch] * pr[-DIN + ch]);
        if (t < len - 1) y += cw[2 * DCONV + ch] * (pr[DIN + 512 + ch] * pr[DIN + ch]);
        mix[(size_t)r * D + ch] = pr[256 + ch] * y;
    }
}

__device__ void st_ssm(const P& p, int l, float* lds) {
    const int lane = threadIdx.x & 63, wv = threadIdx.x >> 6;
    float* red = lds + wv * (16 * 65);
    const float* pb = (const float*)(p.ws + WS_BUFP);
    float* yb = (float*)(p.ws + WS_Y);
    for (int item = blockIdx.x * 4 + wv; item < NB * SG; item += gridDim.x * 4) {
        const int b = item / SG, g = item % SG;
        for (int dir = 0; dir < 2; ++dir) {
            const int pi = ((l * 2 + dir) * SG + g) * SP + lane;
            const float lre = p.in[I_LRE][pi], lim = p.in[I_LIM][pi];
            const float dt = expf(p.in[I_LDT][(l * 2 + dir) * SG + g]);
            const float mag = expf(lre * dt);
            const float lbr = mag * cosf(lim * dt), lbi = mag * sinf(lim * dt);
            const float nr = lbr - 1.f, ni = lbi, den = lre * lre + lim * lim;
            const float fr = (nr * lre + ni * lim) / den, fi = (ni * lre - nr * lim) / den;
            float bbr[16], bbi[16], cr[16], ci[16];
#pragma unroll
            for (int h = 0; h < 16; ++h) {
                const float br = p.in[I_BRE][(size_t)pi * 16 + h], bi = p.in[I_BIM][(size_t)pi * 16 + h];
                bbr[h] = fr * br - fi * bi; bbi[h] = fr * bi + fi * br;
                const size_t cidx = ((size_t)((l * 2 + dir) * SG + g) * 16 + h) * SP + lane;
                cr[h] = p.in[I_CRE][cidx]; ci[h] = p.in[I_CIM][cidx];
            }
            float sr = 0.f, si = 0.f;
            const int nsteps = LC + L;
            for (int step = 0; step < nsteps; ++step) {
                int r; bool isctx = step < LC;
                if (dir == 0) r = isctx ? TL + b * LC + step : b * L + (step - LC);
                else r = isctx ? TL + b * LC + (LC - 1 - step) : b * L + (L - 1 - (step - LC));
                const float* u = pb + (size_t)r * DIN + COL_U + g * 16;
                float bur = 0.f, bui = 0.f;
#pragma unroll
                for (int h = 0; h < 16; ++h) { const float uv = u[h]; bur += bbr[h] * uv; bui += bbi[h] * uv; }
                const float nsr = lbr * sr - lbi * si + bur, nsi = lbr * si + lbi * sr + bui;
                sr = nsr; si = nsi;
                if (isctx && l == 1) continue;
#pragma unroll
                for (int h = 0; h < 16; ++h) red[h * 65 + lane] = cr[h] * sr - ci[h] * si;
                __syncthreads();
                const int hh = lane & 15, q = lane >> 4;
                float s = 0.f;
#pragma unroll
                for (int j = 0; j < 16; ++j) s += red[hh * 65 + q * 16 + j];
                s += __shfl_xor(s, 16); s += __shfl_xor(s, 32);
                __syncthreads();
                if (lane < 16) {
                    float* y = yb + (size_t)r * DSSM + g * 16 + lane;
                    if (dir == 0) *y = p.in[I_SD][l * DSSM + g * 16 + lane] * u[lane] + s;
                    else *y = gelu_f(*y + s);
                }
            }
        }
    }
}

struct EpiGlu { const float* gb; float* mix; const float* bias; __device__ void operator()(int r, int c, float v) const { mix[(size_t)r * D + 256 + c] = gb[(size_t)r * DSSM + c] * sigmoid_f(v + bias[c]); } };

__device__ void st_attn(const P& p, int l) {
    const float* pb = (const float*)(p.ws + WS_BUFP);
    float* mix = (float*)(p.ws + WS_BUFA);
    const int nrows = l == 0 ? TA : TL;
    for (int idx = blockIdx.x * NT + threadIdx.x; idx < nrows * NQH; idx += gridDim.x * NT) {
        const int r = idx / NQH, hq = idx % NQH, g = hq / 4;
        int b, j0, j1;
        if (r < TL) { b = r / L; const int t = r % L; j0 = t - 128 < 0 ? 0 : t - 128; j1 = t + 128 > L - 1 ? L - 1 : t + 128; }
        else { b = (r - TL) / LC; j0 = 0; j1 = -1; }
        float q[64];
        const float* qp = pb + (size_t)r * DIN + COL_Q + hq * 64;
#pragma unroll
        for (int d = 0; d < 64; ++d) q[d] = qp[d] * 0.125f;
        const float sink = p.in[I_SINK][l * NQH + hq];
        const int nlat = j1 - j0 + 1, nkeys = nlat + LC;
        float m = sink;
        for (int j = 0; j < nkeys; ++j) {
            const int kr = j < nlat ? b * L + j0 + j : TL + b * LC + (j - nlat);
            const float* kp = pb + (size_t)kr * DIN + COL_K + g * 64;
            float s = 0.f;
#pragma unroll
            for (int d = 0; d < 64; ++d) s += q[d] * kp[d];
            m = fmaxf(m, s);
        }
        float den = expf(sink - m);
        float o[64];
#pragma unroll
        for (int d = 0; d < 64; ++d) o[d] = 0.f;
        for (int j = 0; j < nkeys; ++j) {
            const int kr = j < nlat ? b * L + j0 + j : TL + b * LC + (j - nlat);
            const float* kp = pb + (size_t)kr * DIN + COL_K + g * 64;
            const float* vp = pb + (size_t)kr * DIN + COL_V + g * 64;
            float s = 0.f;
#pragma unroll
            for (int d = 0; d < 64; ++d) s += q[d] * kp[d];
            const float pe = expf(s - m);
            den += pe;
#pragma unroll
            for (int d = 0; d < 64; ++d) o[d] += pe * vp[d];
        }
        const float inv = 1.f / den;
        float* op = mix + (size_t)r * D + 512 + hq * 64;
#pragma unroll
        for (int d = 0; d < 64; ++d) op[d] = o[d] * inv;
    }
}

struct EpiOut { P p; int l; __device__ void operator()(int r, int c, float v) const {
    const float g1 = mod_vec(p, l, row_bb(r), 2)[c];
    const float hv = h_row(p, l, r)[c];
    hmid_row(p, r)[c] = hv + g1 * v; } };

__device__ void st_router(const P& p, int l, float* lds) {
    const float* xn = (const float*)(p.ws + WS_BUFA);
    int* ridx = (int*)(p.ws + WS_RIDX);
    float* rwt = (float*)(p.ws + WS_RWT);
    const int nrows = l == 0 ? TA : TL;
    const float* rw = p.in[I_RW] + (size_t)l * D * NE;
    const int e = threadIdx.x & 31, rl = threadIdx.x >> 5;
    for (int r0 = blockIdx.x * 8; r0 < nrows; r0 += gridDim.x * 8) {
        const int r = r0 + rl;
        const float* x = xn + (size_t)r * D;
        float acc = 0.f;
        for (int k = 0; k < D; ++k) acc += x[k] * rw[k * NE + e];
        lds[rl * 32 + e] = sigmoid_f(acc);
        __syncthreads();
        if (threadIdx.x < 8) {
            const int rr = r0 + threadIdx.x;
            const float* sc = lds + threadIdx.x * 32;
            unsigned used = 0u;
            int sel[4]; float sv[4]; float sum = 0.f;
#pragma unroll
            for (int k = 0; k < 4; ++k) {
                float best = -1e30f; int bi = 0;
                for (int j = 0; j < 32; ++j) {
                    const float v = sc[j] + p.in[I_RB][l * NE + j];
                    if (!((used >> j) & 1u) && v > best) { best = v; bi = j; }
                }
                used |= 1u << bi; sel[k] = bi; sv[k] = sc[bi]; sum += sc[bi];
            }
#pragma unroll
            for (int k = 0; k < 4; ++k) { ridx[rr * 4 + k] = sel[k]; rwt[rr * 4 + k] = sv[k] / sum * 2.5f; }
        }
        __syncthreads();
    }
}

__device__ void st_moeh(const P& p, int l) {
    const float* xn = (const float*)(p.ws + WS_BUFA);
    float* hid = (float*)(p.ws + WS_BUFP);
    const int* ridx = (const int*)(p.ws + WS_RIDX);
    const float* rwt = (const float*)(p.ws + WS_RWT);
    const int nrows = l == 0 ? TA : TL;
    const int f = threadIdx.x & 127, half = threadIdx.x >> 7;
    for (int it = blockIdx.x * 2 + half; it < nrows * 5; it += gridDim.x * 2) {
        const int r = it / 5, s = it % 5;
        const float* x = xn + (size_t)r * D;
        const float *wg, *wu; size_t stride; float w;
        if (s < 4) {
            const int e = ridx[r * 4 + s]; w = rwt[r * 4 + s];
            wg = p.in[I_WEG] + (size_t)l * D * NE * DE + (size_t)e * DE + f;
            wu = p.in[I_WEU] + (size_t)l * D * NE * DE + (size_t)e * DE + f;
            stride = (size_t)NE * DE;
        } else {
            w = 1.f;
            wg = p.in[I_WSG] + (size_t)l * D * DE + f;
            wu = p.in[I_WSU] + (size_t)l * D * DE + f;
            stride = DE;
        }
        float ag = 0.f, au = 0.f;
        for (int k = 0; k < D; ++k) { const float xv = x[k]; ag += xv * wg[k * stride]; au += xv * wu[k * stride]; }
        hid[(size_t)it * DE + f] = silu_f(ag) * au * w;
    }
}

__device__ void st_moey(const P& p, int l) {
    const float* hid = (const float*)(p.ws + WS_BUFP);
    const int* ridx = (const int*)(p.ws + WS_RIDX);
    const int nrows = l == 0 ? TA : TL;
    for (int idx = blockIdx.x * NT + threadIdx.x; idx < nrows * D; idx += gridDim.x * NT) {
        const int r = idx / D, d = idx % D;
        float acc = 0.f;
        for (int s = 0; s < 5; ++s) {
            const float* wd = s < 4 ? p.in[I_WED] + ((size_t)(l * NE + ridx[r * 4 + s]) * DE) * D + d : p.in[I_WSD] + (size_t)l * DE * D + d;
            const float* hv = hid + (size_t)(r * 5 + s) * DE;
            for (int f = 0; f < DE; ++f) acc += hv[f] * wd[(size_t)f * D];
        }
        const float g2 = mod_vec(p, l, row_bb(r), 5)[d];
        const float v = hmid_row(p, r)[d] + g2 * acc;
        if (r < TL) p.out[(size_t)r * D + d] = v;
        else ((float*)(p.ws + WS_HC1))[(size_t)(r - TL) * D + d] = v;
    }
}

constexpr int STAGES_PER_LAYER = 10;
constexpr int N_STAGES = 1 + 2 * STAGES_PER_LAYER;

__device__ void run_stage(const P& p, int s, float* lds) {
    if (s == 0) { st_mod(p, lds); return; }
    const int l = (s - 1) / STAGES_PER_LAYER, k = (s - 1) % STAGES_PER_LAYER;
    switch (k) {
    case 0: st_norm(p, l, 0); break;
    case 1: sgemm_stage((const float*)(p.ws + WS_BUFA), D, p.in[I_WIN] + (size_t)l * D * DIN, DIN, TA, DIN, D, EpiStore{(float*)(p.ws + WS_BUFP), DIN}, lds); break;
    case 2: st_qknorm(p, l); break;
    case 3: st_conv(p, l); st_attn(p, l); st_ssm(p, l, lds); break;
    case 4: sgemm_stage((const float*)(p.ws + WS_Y), DSSM, p.in[I_WGLU] + (size_t)l * DSSM * DSSM, DSSM, l == 0 ? TA : TL, DSSM, DSSM,
                        EpiGlu{(const float*)(p.ws + WS_Y), (float*)(p.ws + WS_BUFA), p.in[I_BGLU] + l * DSSM}, lds); break;
    case 5: sgemm_stage((const float*)(p.ws + WS_BUFA), D, p.in[I_WOUT] + (size_t)l * D * D, D, l == 0 ? TA : TL, D, D, EpiOut{p, l}, lds); break;
    case 6: st_norm(p, l, 1); break;
    case 7: st_router(p, l, lds); break;
    case 8: st_moeh(p, l); break;
    case 9: st_moey(p, l); break;
    }
}

template <bool COOP>
__global__ void __launch_bounds__(NT) mega(P p, int lo, int hi) {
    __shared__ __attribute__((aligned(16))) float lds[9 * D + 64];
    for (int s = lo; s < hi; ++s) {
        run_stage(p, s, lds);
        if (COOP) { if (s + 1 < hi) cg::this_grid().sync(); }
    }
}

extern "C" void kernel_launch(void* const* d_in, const int* in_sizes, int n_in, void* d_out, int out_size, void* d_ws, size_t ws_size, hipStream_t stream) {
    if (n_in != N_IN || ws_size < WS_END) { fprintf(stderr, "kernel_launch: unexpected n_in %d or ws_size %zu (< %zu)\n", n_in, ws_size, (size_t)WS_END); return; }
    P p{};
    for (int i = 0; i < N_IN; ++i) p.in[i] = (const float*)d_in[i];
    p.out = (float*)d_out; p.ws = (unsigned char*)d_ws;
    static int grid_blocks = 0;
    if (!grid_blocks) {
        int dev = 0, cus = 0, per_cu = 0;
        hipGetDevice(&dev);
        hipDeviceGetAttribute(&cus, hipDeviceAttributeMultiprocessorCount, dev);
        hipOccupancyMaxActiveBlocksPerMultiprocessor(&per_cu, (const void*)mega<true>, NT, 0);
        if (per_cu < 1) per_cu = 1;
        if (per_cu > 2) per_cu = 2;
        grid_blocks = cus * per_cu;
    }
    int lo = 0, hi = N_STAGES;
    void* args[] = {&p, &lo, &hi};
    hipError_t e = hipLaunchCooperativeKernel((const void*)mega<true>, dim3(grid_blocks), dim3(NT), args, 0, stream);
    if (e != hipSuccess) fprintf(stderr, "cooperative launch failed: %s (grid %d)\n", hipGetErrorString(e), grid_blocks);
}
```

```cpp
#include <hip/hip_runtime.h>
#include <hip/hip_cooperative_groups.h>
#include <cstdio>
#include <cstdint>
namespace cg = cooperative_groups;

constexpr int D = 1024, NB = 8, L = 2048, LC = 256;
constexpr int TL = NB * L, TC = NB * LC, TA = TL + TC;
constexpr int DIN = 1792, DCONV = 256, DSSM = 256, DATT = 512;
constexpr int NQH = 8, NKVH = 2, HD = 64;
constexpr int COL_U = 768, COL_Q = 1024, COL_K = 1536, COL_V = 1664;
constexpr int NE = 32, TOPK = 4, DE = 128;
constexpr int SG = 16, SH = 16, SP = 64;
constexpr int NT = 256;

enum { I_X = 0, I_C, I_CTX, I_CCTX, I_WMOD, I_BMOD, I_N1G, I_N2G, I_WIN, I_CONVW, I_LRE, I_LIM, I_LDT, I_BRE, I_BIM, I_CRE, I_CIM,
       I_SD, I_WGLU, I_BGLU, I_QG, I_KG, I_SINK, I_WOUT, I_RW, I_RB, I_WEG, I_WEU, I_WED, I_WSG, I_WSU, I_WSD, N_IN };

typedef unsigned short bf16_t;
constexpr size_t WS_CTL = 0;
constexpr size_t WS_MOD = 65536;
constexpr size_t WS_ZERO_END = WS_MOD + (size_t)2 * 9 * 6 * D * 4;
constexpr size_t WS_RBIAS = 524288;
constexpr size_t WS_ROPE = WS_RBIAS + 4096;
constexpr size_t WS_KJ = WS_ROPE + 524288;
constexpr size_t WS_R1 = WS_KJ + 2097152;
constexpr size_t WS_BUFA = WS_R1;
constexpr size_t WS_PC = WS_BUFA + (size_t)TA * D * 2;
constexpr size_t WS_UA = WS_PC + (size_t)TA * 768 * 2;
constexpr size_t WS_E = WS_UA + (size_t)16 * 640 * 768 * 2;
constexpr size_t WS_G = WS_E + (size_t)16 * 640 * 256 * 4;
constexpr size_t WS_QB = WS_G + (size_t)TA * DSSM * 2;
constexpr size_t WS_KB = WS_QB + (size_t)TA * DATT * 2;
constexpr size_t WS_VT = WS_KB + (size_t)TA * 128 * 2;
constexpr size_t WS_SLAB = WS_R1;
constexpr size_t WS_HID = WS_SLAB + (size_t)TA * 4 * D * 2;
constexpr size_t WS_HC1 = WS_HID + (size_t)TA * 5 * DE * 2;
constexpr size_t WS_HCMID = WS_HC1 + (size_t)TC * D * 4;
constexpr size_t WS_LCODE = WS_HCMID + (size_t)TC * D * 4;
constexpr size_t WS_LW = WS_LCODE + (size_t)NE * TA * 4;
constexpr size_t WS_WTIN = WS_LW + (size_t)NE * TA * 4;
constexpr size_t WS_WTOUT = WS_WTIN + (size_t)DIN * D * 2;
constexpr size_t WS_WTGLU = WS_WTOUT + (size_t)D * D * 2;
constexpr size_t WS_WGU = WS_WTGLU + (size_t)DSSM * DSSM * 2;
constexpr size_t WS_WD = WS_WGU + (size_t)33 * 256 * D * 2;
constexpr size_t WS_WST = WS_WD + (size_t)33 * D * DE * 2;
constexpr size_t WS_KW = WS_WST + (size_t)16 * 256 * 512 * 2;
constexpr size_t WS_END = WS_KW + (size_t)16 * 512 * 768 * 2;
static_assert(WS_VT + (size_t)TA * 128 * 2 <= WS_HID, "overlay");
static_assert(WS_ZERO_END <= WS_RBIAS, "zero region");
static_assert(WS_END <= 268435456, "workspace too large");

struct P {
    const float* in[N_IN];
    float* out;
    unsigned char* ws;
};

__device__ __forceinline__ bf16_t f2bf(float f) { unsigned u = __float_as_uint(f); u += 0x7FFFu + ((u >> 16) & 1u); return (bf16_t)(u >> 16); }
__device__ __forceinline__ float bf2f(bf16_t b) { return __uint_as_float((unsigned)b << 16); }
__device__ __forceinline__ unsigned cvt_pk_bf16(float lo, float hi) { unsigned r; asm("v_cvt_pk_bf16_f32 %0, %1, %2" : "=v"(r) : "v"(lo), "v"(hi)); return r; }
struct BfPtr { const bf16_t* p; __device__ __forceinline__ float operator[](long i) const { return bf2f(p[i]); }
               __device__ __forceinline__ BfPtr operator+(long o) const { return BfPtr{p + o}; } };
__device__ __forceinline__ float silu_f(float x) { return x / (1.f + expf(-x)); }
__device__ __forceinline__ float sigmoid_f(float x) { return 1.f / (1.f + expf(-x)); }
__device__ __forceinline__ float gelu_f(float x) { return 0.5f * x * (1.f + tanhf(0.7978845608028654f * (x + 0.044715f * x * x * x))); }
__device__ __forceinline__ float wave_sum(float v) {
#pragma unroll
    for (int o = 32; o > 0; o >>= 1) v += __shfl_xor(v, o);
    return v;
}
__device__ __forceinline__ int row_bb(int r) { return r < TL ? r / L : 8; }
__device__ __forceinline__ const float* h_row(const P& p, int l, int r) {
    if (r < TL) return (l == 0 ? p.in[I_X] : p.out) + (size_t)r * D;
    return (l == 0 ? p.in[I_CTX] : (const float*)(p.ws + WS_HC1)) + (size_t)(r - TL) * D;
}
__device__ __forceinline__ float* hmid_row(const P& p, int r) {
    if (r < TL) return p.out + (size_t)r * D;
    return (float*)(p.ws + WS_HCMID) + (size_t)(r - TL) * D;
}
__device__ __forceinline__ const float* mod_vec(const P& p, int l, int bb, int chunk) {
    return (const float*)(p.ws + WS_MOD) + ((size_t)(l * 9 + bb) * 6 + chunk) * D;
}

__device__ void st_mod(const P& p, float* lds) {
    float* red = lds + 9 * D;
    for (int i = threadIdx.x; i < 9 * D; i += NT) {
        const int bb = i / D, k = i % D;
        const float c = bb < 8 ? p.in[I_C][bb * D + k] : p.in[I_CCTX][k];
        lds[i] = silu_f(c);
    }
    __syncthreads();
    float* mod = (float*)(p.ws + WS_MOD);
    const int col = threadIdx.x & 31, ks = threadIdx.x >> 5;
    for (int item = blockIdx.x; item < 2 * 6 * D / 32; item += gridDim.x) {
        const int l = item / (6 * D / 32), j = (item % (6 * D / 32)) * 32 + col;
        const float* w = p.in[I_WMOD] + (size_t)l * D * 6 * D + j;
        float acc[9];
#pragma unroll
        for (int bb = 0; bb < 9; ++bb) acc[bb] = 0.f;
        for (int k = ks * 128; k < ks * 128 + 128; ++k) {
            const float wv = w[(size_t)k * 6 * D];
#pragma unroll
            for (int bb = 0; bb < 9; ++bb) acc[bb] += lds[bb * D + k] * wv;
        }
#pragma unroll
        for (int bb = 0; bb < 9; ++bb) red[(bb * 8 + ks) * 32 + col] = acc[bb];
        __syncthreads();
        for (int o = threadIdx.x; o < 9 * 32; o += NT) {
            const int bb = o >> 5, c2 = o & 31;
            float sum = p.in[I_BMOD][l * 6 * D + (item % (6 * D / 32)) * 32 + c2];
#pragma unroll
            for (int q = 0; q < 8; ++q) sum += red[(bb * 8 + q) * 32 + c2];
            mod[(size_t)(l * 9 + bb) * 6 * D + (item % (6 * D / 32)) * 32 + c2] = sum;
        }
        __syncthreads();
    }
}

__device__ void st_norm(const P& p, int l, int which) {
    const int lane = threadIdx.x & 63, wv = threadIdx.x >> 6;
    const int nrows = (which == 1 && l == 1) ? TL : TA;
    float* xn = (float*)(p.ws + WS_BUFA);
    const float* g = p.in[which == 0 ? I_N1G : I_N2G] + l * D;
    for (int r = blockIdx.x * 4 + wv; r < nrows; r += gridDim.x * 4) {
        const float* src = which == 0 ? h_row(p, l, r) : hmid_row(p, r);
        const int bb = row_bb(r);
        const float* sh = mod_vec(p, l, bb, which == 0 ? 0 : 3);
        const float* sc = mod_vec(p, l, bb, which == 0 ? 1 : 4);
        float4 v[4];
        float s = 0.f;
#pragma unroll
        for (int j = 0; j < 4; ++j) { v[j] = *(const float4*)(src + j * 256 + lane * 4); s += v[j].x * v[j].x + v[j].y * v[j].y + v[j].z * v[j].z + v[j].w * v[j].w; }
        s = wave_sum(s);
        const float rinv = rsqrtf(s * (1.f / D) + 1e-6f);
#pragma unroll
        for (int j = 0; j < 4; ++j) {
            const int k = j * 256 + lane * 4;
            const float4 gg = *(const float4*)(g + k), s1 = *(const float4*)(sc + k), s0 = *(const float4*)(sh + k);
            float4 o;
            o.x = v[j].x * rinv * gg.x * (1.f + s1.x) + s0.x;
            o.y = v[j].y * rinv * gg.y * (1.f + s1.y) + s0.y;
            o.z = v[j].z * rinv * gg.z * (1.f + s1.z) + s0.z;
            o.w = v[j].w * rinv * gg.w * (1.f + s1.w) + s0.w;
            if (which == 1) *(float4*)(xn + (size_t)r * D + k) = o;
            else { uint2 pk; pk.x = (unsigned)f2bf(o.x) | ((unsigned)f2bf(o.y) << 16); pk.y = (unsigned)f2bf(o.z) | ((unsigned)f2bf(o.w) << 16);
                   *(uint2*)((bf16_t*)(p.ws + WS_BUFA) + (size_t)r * D + k) = pk; }
        }
    }
}


__device__ void st_conv(const P& p, int l) {
    const BfPtr pb{(const bf16_t*)(p.ws + WS_PC)};
    bf16_t* mix = (bf16_t*)(p.ws + WS_BUFA);
    const float* cw = p.in[I_CONVW] + l * 3 * DCONV;
    const int nrows = l == 0 ? TA : TL;
    for (int idx = blockIdx.x * NT + threadIdx.x; idx < nrows * DCONV; idx += gridDim.x * NT) {
        const int r = idx / DCONV, ch = idx % DCONV;
        int t, len;
        if (r < TL) { t = r % L; len = L; } else { t = (r - TL) % LC; len = LC; }
        const BfPtr pr = pb + (long)r * 768;
        float y = cw[DCONV + ch] * (pr[512 + ch] * pr[ch]);
        if (t > 0) y += cw[ch] * (pr[-768 + 512 + ch] * pr[-768 + ch]);
        if (t < len - 1) y += cw[2 * DCONV + ch] * (pr[768 + 512 + ch] * pr[768 + ch]);
        mix[(size_t)r * D + ch] = f2bf(pr[256 + ch] * y);
    }
}

struct EpiOut { P p; int l; __device__ void operator()(int r, int c, float v) const {
    const float g1 = mod_vec(p, l, row_bb(r), 2)[c];
    const float hv = h_row(p, l, r)[c];
    hmid_row(p, r)[c] = hv + g1 * v; } };

typedef __attribute__((ext_vector_type(8))) short bf16x8;
typedef __attribute__((ext_vector_type(16))) float f32x16;
typedef __attribute__((ext_vector_type(4))) unsigned u32x4;
constexpr int G_ROWB = 144;
constexpr int G_TILEB = 128 * G_ROWB;
constexpr int LDS_BYTES = 4 * G_TILEB;

template <class ARow>
__device__ __forceinline__ void gemm_tile(f32x16 (&acc)[2][2], ARow arow, const bf16_t* Bt, int ldb, int K, unsigned char* lds) {
    const int t = threadIdx.x, lane = t & 63, w = t >> 6, wr = w >> 1, wc = w & 1, lr = lane & 31, lh = lane >> 5;
    const int srow = t >> 3, kc = t & 7;
    const bf16_t* ap[4]; const bf16_t* bp[4];
#pragma unroll
    for (int i = 0; i < 4; ++i) { ap[i] = arow(srow + 32 * i) + kc * 8; bp[i] = Bt + (size_t)(srow + 32 * i) * ldb + kc * 8; }
#pragma unroll
    for (int mi = 0; mi < 2; ++mi)
#pragma unroll
        for (int ni = 0; ni < 2; ++ni)
#pragma unroll
            for (int r = 0; r < 16; ++r) acc[mi][ni][r] = 0.f;
    u32x4 ra[4], rb[4];
#pragma unroll
    for (int i = 0; i < 4; ++i) { ra[i] = *(const u32x4*)(ap[i]); rb[i] = *(const u32x4*)(bp[i]); }
    __syncthreads();
    const int soff = srow * G_ROWB + kc * 16;
#pragma unroll
    for (int i = 0; i < 4; ++i) { *(u32x4*)(lds + soff + i * 32 * G_ROWB) = ra[i]; *(u32x4*)(lds + G_TILEB + soff + i * 32 * G_ROWB) = rb[i]; }
    __syncthreads();
    const int nk = K >> 6;
    const int aoff = (wr * 64 + lr) * G_ROWB + lh * 16, boff = G_TILEB + (wc * 64 + lr) * G_ROWB + lh * 16;
    for (int kt = 0; kt < nk; ++kt) {
        const unsigned char* cur = lds + (kt & 1) * 2 * G_TILEB;
        if (kt + 1 < nk) {
#pragma unroll
            for (int i = 0; i < 4; ++i) { ra[i] = *(const u32x4*)(ap[i] + (kt + 1) * 64); rb[i] = *(const u32x4*)(bp[i] + (kt + 1) * 64); }
        }
#pragma unroll
        for (int s4 = 0; s4 < 4; ++s4) {
            const bf16x8 a0 = *(const bf16x8*)(cur + aoff + s4 * 32), a1 = *(const bf16x8*)(cur + aoff + 32 * G_ROWB + s4 * 32);
            const bf16x8 b0 = *(const bf16x8*)(cur + boff + s4 * 32), b1 = *(const bf16x8*)(cur + boff + 32 * G_ROWB + s4 * 32);
            acc[0][0] = __builtin_amdgcn_mfma_f32_32x32x16_bf16(a0, b0, acc[0][0], 0, 0, 0);
            acc[0][1] = __builtin_amdgcn_mfma_f32_32x32x16_bf16(a0, b1, acc[0][1], 0, 0, 0);
            acc[1][0] = __builtin_amdgcn_mfma_f32_32x32x16_bf16(a1, b0, acc[1][0], 0, 0, 0);
            acc[1][1] = __builtin_amdgcn_mfma_f32_32x32x16_bf16(a1, b1, acc[1][1], 0, 0, 0);
        }
        if (kt + 1 < nk) {
            unsigned char* nxt = lds + ((kt + 1) & 1) * 2 * G_TILEB;
#pragma unroll
            for (int i = 0; i < 4; ++i) { *(u32x4*)(nxt + soff + i * 32 * G_ROWB) = ra[i]; *(u32x4*)(nxt + G_TILEB + soff + i * 32 * G_ROWB) = rb[i]; }
        }
        __syncthreads();
    }
}
template <class F>
__device__ __forceinline__ void acc_foreach(const f32x16 (&acc)[2][2], F f) {
    const int lane = threadIdx.x & 63, w = threadIdx.x >> 6, wr = w >> 1, wc = w & 1, lr = lane & 31, lh = lane >> 5;
#pragma unroll
    for (int mi = 0; mi < 2; ++mi)
#pragma unroll
        for (int ni = 0; ni < 2; ++ni)
#pragma unroll
            for (int r = 0; r < 16; ++r) f(wr * 64 + mi * 32 + (r & 3) + 8 * (r >> 2) + 4 * lh, wc * 64 + ni * 32 + lr, acc[mi][ni][r]);
}
struct ARowPlain { const bf16_t* A; int lda; __device__ __forceinline__ const bf16_t* operator()(int m) const { return A + (size_t)m * lda; } };

template <class Epi>
__device__ void gemm_stage(const bf16_t* A, int lda, const bf16_t* Bt, int ldb, int M, int N, int K, Epi epi, unsigned char* lds) {
    const int tn = N / 128, tm = M / 128;
    for (int tile = blockIdx.x; tile < tm * tn; tile += gridDim.x) {
        const int m0 = (tile / tn) * 128, n0 = (tile % tn) * 128;
        f32x16 acc[2][2];
        gemm_tile(acc, ARowPlain{A + (size_t)m0 * lda, lda}, Bt + (size_t)n0 * ldb, ldb, K, lds);
        acc_foreach(acc, [&](int r, int c, float v) { epi(m0 + r, n0 + c, v); });
    }
}
__device__ void prep_tr(const float* src, size_t sk, bf16_t* dst, int N, int K) {
    const int per = N * (K / 8);
    for (int idx = blockIdx.x * NT + threadIdx.x; idx < per; idx += gridDim.x * NT) {
        const int n = idx % N, kc = idx / N;
        const float* sp = src + (size_t)kc * 8 * sk + n;
        uint4 o;
        o.x = (unsigned)f2bf(sp[0]) | ((unsigned)f2bf(sp[sk]) << 16);
        o.y = (unsigned)f2bf(sp[2 * sk]) | ((unsigned)f2bf(sp[3 * sk]) << 16);
        o.z = (unsigned)f2bf(sp[4 * sk]) | ((unsigned)f2bf(sp[5 * sk]) << 16);
        o.w = (unsigned)f2bf(sp[6 * sk]) | ((unsigned)f2bf(sp[7 * sk]) << 16);
        *(uint4*)(dst + (size_t)n * K + kc * 8) = o;
    }
}
__device__ void st_prep_dense(const P& p, int l) {
    prep_tr(p.in[I_WIN] + (size_t)l * D * DIN, DIN, (bf16_t*)(p.ws + WS_WTIN), DIN, D);
    prep_tr(p.in[I_WOUT] + (size_t)l * D * D, D, (bf16_t*)(p.ws + WS_WTOUT), D, D);
    prep_tr(p.in[I_WGLU] + (size_t)l * DSSM * DSSM, DSSM, (bf16_t*)(p.ws + WS_WTGLU), DSSM, DSSM);
}
struct EpiStoreBf { bf16_t* C; int ldc; __device__ __forceinline__ void operator()(int r, int c, float v) const { C[(size_t)r * ldc + c] = f2bf(v); } };


typedef __attribute__((ext_vector_type(4))) float f32x4;
__device__ void st_rbias(const P& p, int l, float* lds) {
    if (blockIdx.x < 9) {
        const int bb = blockIdx.x, e = threadIdx.x & 31, ks = threadIdx.x >> 5;
        const float* sh2 = mod_vec(p, l, bb, 3);
        const float* rw = p.in[I_RW] + (size_t)l * D * NE;
        float a = 0.f;
        for (int k = ks * 128; k < ks * 128 + 128; ++k) a += sh2[k] * rw[k * NE + e];
        lds[threadIdx.x] = a;
        __syncthreads();
        if (threadIdx.x < 32) { float s = 0.f; for (int j = 0; j < 8; ++j) s += lds[j * 32 + threadIdx.x]; ((float*)(p.ws + WS_RBIAS))[(l * 9 + bb) * 32 + threadIdx.x] = s; }
        __syncthreads();
    }
}
__device__ void st_router2(const P& p, int l, unsigned char* ldsb) {
    const int lane = threadIdx.x & 63, w = threadIdx.x >> 6, i = lane & 31, hf = lane >> 5;
    float* sc = (float*)ldsb + w * (32 * 33);
    const int nrows = l == 0 ? TA : TL;
    const float* g2 = p.in[I_N2G] + l * D;
    const float* rw = p.in[I_RW] + (size_t)l * D * NE;
    int* cnt = (int*)(p.ws + WS_CTL) + l * NE;
    int* lcode = (int*)(p.ws + WS_LCODE);
    float* lw = (float*)(p.ws + WS_LW);
    bf16_t* xn2 = (bf16_t*)(p.ws + WS_BUFA);
    for (int item = blockIdx.x * 4 + w; item < nrows / 32; item += gridDim.x * 4) {
        const int r0 = item * 32, bb = row_bb(r0);
        const float* sc2 = mod_vec(p, l, bb, 4);
        const float* sh2 = mod_vec(p, l, bb, 3);
        const float* src = hmid_row(p, r0 + i) + hf * 512;
        f32x16 acc;
#pragma unroll
        for (int r = 0; r < 16; ++r) acc[r] = 0.f;
        float ss = 0.f;
        for (int c = 0; c < 128; ++c) {
            const int k = hf * 512 + 4 * c;
            const f32x4 x = *(const f32x4*)(src + 4 * c);
            const f32x4 gg = *(const f32x4*)(g2 + k), s1 = *(const f32x4*)(sc2 + k);
            ss += x[0] * x[0] + x[1] * x[1] + x[2] * x[2] + x[3] * x[3];
#pragma unroll
            for (int q = 0; q < 4; ++q) {
                const float a = x[q] * (gg[q] * (1.f + s1[q]));
                const float b = rw[(size_t)(k + q) * NE + i];
                acc = __builtin_amdgcn_mfma_f32_32x32x2f32(a, b, acc, 0, 0, 0);
            }
        }
        ss += __shfl_xor(ss, 32);
        const float rinv = rsqrtf(ss * (1.f / D) + 1e-6f);
        const float rb = ((const float*)(p.ws + WS_RBIAS))[(l * 9 + bb) * 32 + i];
#pragma unroll
        for (int r = 0; r < 16; ++r) {
            const int rho = (r & 3) + 8 * (r >> 2) + 4 * hf;
            const float rr = __shfl(rinv, rho);
            sc[rho * 33 + i] = sigmoid_f(rr * acc[r] + rb);
        }
        __builtin_amdgcn_s_waitcnt(0xc07f);
        __builtin_amdgcn_wave_barrier();
        {
            float gs[16], sh[16];
#pragma unroll
            for (int q = 0; q < 16; ++q) { const int k = (q >> 3) * 512 + 8 * lane + (q & 7); gs[q] = g2[k] * (1.f + sc2[k]); sh[q] = sh2[k]; }
            for (int rho = 0; rho < 32; ++rho) {
                const float rr = __shfl(rinv, rho);
                const float* s2 = hmid_row(p, r0 + rho);
                bf16_t* dst = xn2 + (size_t)(r0 + rho) * D;
#pragma unroll
                for (int h2 = 0; h2 < 2; ++h2) {
                    const f32x4 x0 = *(const f32x4*)(s2 + h2 * 512 + 8 * lane), x1 = *(const f32x4*)(s2 + h2 * 512 + 8 * lane + 4);
                    u32x4 o;
                    o[0] = (unsigned)f2bf(x0[0] * rr * gs[h2 * 8 + 0] + sh[h2 * 8 + 0]) | ((unsigned)f2bf(x0[1] * rr * gs[h2 * 8 + 1] + sh[h2 * 8 + 1]) << 16);
                    o[1] = (unsigned)f2bf(x0[2] * rr * gs[h2 * 8 + 2] + sh[h2 * 8 + 2]) | ((unsigned)f2bf(x0[3] * rr * gs[h2 * 8 + 3] + sh[h2 * 8 + 3]) << 16);
                    o[2] = (unsigned)f2bf(x1[0] * rr * gs[h2 * 8 + 4] + sh[h2 * 8 + 4]) | ((unsigned)f2bf(x1[1] * rr * gs[h2 * 8 + 5] + sh[h2 * 8 + 5]) << 16);
                    o[3] = (unsigned)f2bf(x1[2] * rr * gs[h2 * 8 + 6] + sh[h2 * 8 + 6]) | ((unsigned)f2bf(x1[3] * rr * gs[h2 * 8 + 7] + sh[h2 * 8 + 7]) << 16);
                    *(u32x4*)(dst + h2 * 512 + 8 * lane) = o;
                }
            }
        }
        if (lane < 32) {
            const int r = r0 + lane;
            float sel[32];
#pragma unroll
            for (int e = 0; e < 32; ++e) sel[e] = sc[lane * 33 + e] + p.in[I_RB][l * NE + e];
            int bi[4]; float sv[4]; float sum = 0.f;
#pragma unroll
            for (int k = 0; k < 4; ++k) {
                float best = -1e30f; int b = 0;
#pragma unroll
                for (int e = 0; e < 32; ++e) if (sel[e] > best) { best = sel[e]; b = e; }
#pragma unroll
                for (int e = 0; e < 32; ++e) if (e == b) sel[e] = -1e30f;
                bi[k] = b; sv[k] = sc[lane * 33 + b]; sum += sv[k];
            }
#pragma unroll
            for (int k = 0; k < 4; ++k) {
                const int pos = atomicAdd(&cnt[bi[k]], 1);
                lcode[(size_t)bi[k] * TA + pos] = r * 4 + k;
                lw[(size_t)bi[k] * TA + pos] = sv[k] / sum * 2.5f;
            }
        }
        __builtin_amdgcn_wave_barrier();
    }
}

constexpr int MOE_LDS_LIST = LDS_BYTES;
constexpr int LDS_TOTAL = LDS_BYTES + 128 * 4 + 128 * 4 + 64 * 4;
struct ARowCode { const bf16_t* base; const int* codes; int mode; __device__ __forceinline__ const bf16_t* operator()(int m) const {
    const int c = codes[m];
    if (mode == 0) return base + (size_t)(c < 0 ? 0 : (c >> 2)) * D;
    return base + (size_t)(c < 0 ? 0 : (c >> 2) * 5 + (c & 3)) * DE; } };
__device__ __forceinline__ void moe_tstart(const P& p, int l, int* ts) {
    if (threadIdx.x == 0) { const int* cnt = (const int*)(p.ws + WS_CTL) + l * NE; int a = 0; for (int e = 0; e < NE; ++e) { ts[e] = a; a += (cnt[e] + 127) >> 7; } ts[NE] = a; }
    __syncthreads();
}
__device__ void st_moe1(const P& p, int l, unsigned char* lds) {
    int* codes = (int*)(lds + MOE_LDS_LIST); float* wts = (float*)(codes + 128); int* ts = (int*)(wts + 128);
    const int nrows = l == 0 ? TA : TL;
    const int* cnt = (const int*)(p.ws + WS_CTL) + l * NE;
    const int* lcode = (const int*)(p.ws + WS_LCODE);
    const float* lw = (const float*)(p.ws + WS_LW);
    const bf16_t* xn2 = (const bf16_t*)(p.ws + WS_BUFA);
    bf16_t* hid = (bf16_t*)(p.ws + WS_HID);
    const bf16_t* wgu = (const bf16_t*)(p.ws + WS_WGU);
    moe_tstart(p, l, ts);
    const int nrt = ts[NE], nsh = nrows / 128, total = (nrt + nsh) * 2;
    const int lane = threadIdx.x & 63, w = threadIdx.x >> 6, wr = w >> 1, wc = w & 1, lr = lane & 31, lh = lane >> 5;
    for (int tile = blockIdx.x; tile < total; tile += gridDim.x) {
        const int rt = tile >> 1, j = tile & 1;
        int e, m0, valid;
        if (rt < nrt) { e = 0; while (ts[e + 1] <= rt) ++e; m0 = (rt - ts[e]) * 128; valid = cnt[e] - m0; if (valid > 128) valid = 128; }
        else { e = NE; m0 = (rt - nrt) * 128; valid = 128; }
        __syncthreads();
        if (threadIdx.x < 128) {
            const int m = threadIdx.x;
            if (e < NE) { const bool ok = m < valid; codes[m] = ok ? lcode[(size_t)e * TA + m0 + m] : -1; wts[m] = ok ? lw[(size_t)e * TA + m0 + m] : 0.f; }
            else { codes[m] = (m0 + m) * 4; wts[m] = 1.f; }
        }
        __syncthreads();
        f32x16 acc[2][2];
        gemm_tile(acc, ARowCode{xn2, codes, 0}, wgu + (size_t)((e * 2 + j) * 128) * D, D, D, lds);
        const int unit = j * 64 + wc * 32 + lr;
#pragma unroll
        for (int mi = 0; mi < 2; ++mi)
#pragma unroll
            for (int r = 0; r < 16; ++r) {
                const int m = wr * 64 + mi * 32 + (r & 3) + 8 * (r >> 2) + 4 * lh;
                const int c = codes[m];
                if (c >= 0) {
                    const float g = acc[mi][0][r], u = acc[mi][1][r];
                    const size_t hrow = e < NE ? (size_t)(c >> 2) * 5 + (c & 3) : (size_t)(c >> 2) * 5 + 4;
                    hid[hrow * DE + unit] = f2bf(silu_f(g) * u * wts[m]);
                }
            }
    }
}
__device__ void st_moe2(const P& p, int l, unsigned char* lds) {
    int* codes = (int*)(lds + MOE_LDS_LIST); float* wts = (float*)(codes + 128); int* ts = (int*)(wts + 128);
    const int* cnt = (const int*)(p.ws + WS_CTL) + l * NE;
    const int* lcode = (const int*)(p.ws + WS_LCODE);
    const bf16_t* hid = (const bf16_t*)(p.ws + WS_HID);
    bf16_t* slab = (bf16_t*)(p.ws + WS_SLAB);
    const bf16_t* wd = (const bf16_t*)(p.ws + WS_WD);
    moe_tstart(p, l, ts);
    const int nrt = ts[NE], total = nrt * 8;
    for (int tile = blockIdx.x; tile < total; tile += gridDim.x) {
        const int rt = tile >> 3, n0 = (tile & 7) * 128;
        int e = 0; while (ts[e + 1] <= rt) ++e;
        const int m0 = (rt - ts[e]) * 128; int valid = cnt[e] - m0; if (valid > 128) valid = 128;
        __syncthreads();
        if (threadIdx.x < 128) { const int m = threadIdx.x; codes[m] = m < valid ? lcode[(size_t)e * TA + m0 + m] : -1; }
        __syncthreads();
        f32x16 acc[2][2];
        gemm_tile(acc, ARowCode{hid, codes, 1}, wd + ((size_t)e * D + n0) * DE, DE, DE, lds);
        acc_foreach(acc, [&](int r, int c, float v) { const int code = codes[r]; if (code >= 0) slab[(size_t)code * D + n0 + c] = f2bf(v); });
    }
}
struct EpiMoeF { P p; int l; __device__ __forceinline__ void operator()(int r, int c, float v) const {
    const bf16_t* sl = (const bf16_t*)(p.ws + WS_SLAB) + (size_t)r * 4 * D + c;
    v += bf2f(sl[0]) + bf2f(sl[D]) + bf2f(sl[2 * D]) + bf2f(sl[3 * D]);
    const float g2 = mod_vec(p, l, row_bb(r), 5)[c];
    const float o = hmid_row(p, r)[c] + g2 * v;
    if (r < TL) p.out[(size_t)r * D + c] = o; else ((float*)(p.ws + WS_HC1))[(size_t)(r - TL) * D + c] = o; } };
__device__ void st_prep_moe(const P& p, int l) {
    bf16_t* wgu = (bf16_t*)(p.ws + WS_WGU);
    const int tot1 = 33 * 2 * 4 * 128 * 32;
    for (int idx = blockIdx.x * NT + threadIdx.x; idx < tot1; idx += gridDim.x * NT) {
        const int i = idx & 31; int q_ = idx >> 5; const int kc = q_ & 127; q_ >>= 7; const int q = q_ & 3; q_ >>= 2; const int j = q_ & 1; const int e = q_ >> 1;
        const int wc = q >> 1, ni = q & 1, unit = j * 64 + wc * 32 + i;
        const float* sp; size_t sk;
        if (e < NE) { sp = p.in[ni ? I_WEU : I_WEG] + ((size_t)(l * D + kc * 8) * NE + e) * DE + unit; sk = (size_t)NE * DE; }
        else { sp = p.in[ni ? I_WSU : I_WSG] + (size_t)(l * D + kc * 8) * DE + unit; sk = DE; }
        u32x4 o;
        o[0] = (unsigned)f2bf(sp[0]) | ((unsigned)f2bf(sp[sk]) << 16);
        o[1] = (unsigned)f2bf(sp[2 * sk]) | ((unsigned)f2bf(sp[3 * sk]) << 16);
        o[2] = (unsigned)f2bf(sp[4 * sk]) | ((unsigned)f2bf(sp[5 * sk]) << 16);
        o[3] = (unsigned)f2bf(sp[6 * sk]) | ((unsigned)f2bf(sp[7 * sk]) << 16);
        *(u32x4*)(wgu + ((size_t)(e * 2 + j) * 128 + q * 32 + i) * D + kc * 8) = o;
    }
    bf16_t* wd = (bf16_t*)(p.ws + WS_WD);
    const int tot2 = 33 * 16 * 1024;
    for (int idx = blockIdx.x * NT + threadIdx.x; idx < tot2; idx += gridDim.x * NT) {
        const int n = idx & 1023; int q_ = idx >> 10; const int kc = q_ & 15; const int e = q_ >> 4;
        const float* sp = (e < NE ? p.in[I_WED] + ((size_t)(l * NE + e) * DE + kc * 8) * D : p.in[I_WSD] + ((size_t)l * DE + kc * 8) * D) + n;
        u32x4 o;
        o[0] = (unsigned)f2bf(sp[0]) | ((unsigned)f2bf(sp[D]) << 16);
        o[1] = (unsigned)f2bf(sp[2 * D]) | ((unsigned)f2bf(sp[3 * D]) << 16);
        o[2] = (unsigned)f2bf(sp[4 * D]) | ((unsigned)f2bf(sp[5 * D]) << 16);
        o[3] = (unsigned)f2bf(sp[6 * D]) | ((unsigned)f2bf(sp[7 * D]) << 16);
        *(u32x4*)(wd + ((size_t)e * D + n) * DE + kc * 8) = o;
    }
}

struct SsmPar { float lre, lim, dt; };
__device__ __forceinline__ SsmPar ssm_par(const P& p, int l, int dir, int g, int pp) {
    const int pi = ((l * 2 + dir) * SG + g) * SP + pp;
    SsmPar r; r.lre = p.in[I_LRE][pi]; r.lim = p.in[I_LIM][pi]; r.dt = expf(p.in[I_LDT][(l * 2 + dir) * SG + g]); return r;
}
__device__ __forceinline__ float2 ssm_pow(const SsmPar& q, float e) {
    const float mag = expf(e * q.lre * q.dt), ang = e * (q.lim * q.dt);
    return make_float2(mag * cosf(ang), mag * sinf(ang));
}
__device__ __forceinline__ float2 ssm_f(const SsmPar& q) {
    const float2 lb = ssm_pow(q, 1.f);
    const float nr = lb.x - 1.f, ni = lb.y, den = q.lre * q.lre + q.lim * q.lim;
    return make_float2((nr * q.lre + ni * q.lim) / den, (ni * q.lre - nr * q.lim) / den);
}
__device__ __forceinline__ float2 cmul(float2 a, float2 b) { return make_float2(a.x * b.x - a.y * b.y, a.x * b.y + a.y * b.x); }
__device__ void st_ssm_kj(const P& p, float* lds) {
    float* lam = lds; float* Cc = lds + 128; float* Bb = Cc + 2048;
    float* kj = (float*)(p.ws + WS_KJ);
    const int t = threadIdx.x;
    for (int item = blockIdx.x; item < 64; item += gridDim.x) {
        const int l = item >> 5, g = (item >> 1) & 15, dir = item & 1;
        const int base = (l * 2 + dir) * SG + g;
        __syncthreads();
        if (t < 64) {
            const SsmPar q = ssm_par(p, l, dir, g, t);
            const float2 lb = ssm_pow(q, 1.f), f = ssm_f(q);
            lam[2 * t] = lb.x; lam[2 * t + 1] = lb.y;
            for (int h = 0; h < 16; ++h) {
                const size_t bi = ((size_t)base * SP + t) * 16 + h;
                const float2 bb = cmul(f, make_float2(p.in[I_BRE][bi], p.in[I_BIM][bi]));
                Bb[(t * 16 + h) * 2] = bb.x; Bb[(t * 16 + h) * 2 + 1] = bb.y;
            }
        }
        for (int i = t; i < 1024; i += NT) { const size_t ci = (size_t)base * 1024 + i; Cc[2 * i] = p.in[I_CRE][ci]; Cc[2 * i + 1] = p.in[I_CIM][ci]; }
        __syncthreads();
        const int ho = t >> 4, hi = t & 15;
        float acc[32];
#pragma unroll
        for (int j = 0; j < 32; ++j) acc[j] = 0.f;
        for (int pp = 0; pp < 64; ++pp) {
            float2 z = cmul(make_float2(Cc[(ho * 64 + pp) * 2], Cc[(ho * 64 + pp) * 2 + 1]), make_float2(Bb[(pp * 16 + hi) * 2], Bb[(pp * 16 + hi) * 2 + 1]));
            const float2 lb = make_float2(lam[2 * pp], lam[2 * pp + 1]);
#pragma unroll
            for (int j = 0; j < 32; ++j) { acc[j] += z.x; z = cmul(z, lb); }
        }
#pragma unroll
        for (int j = 0; j < 32; ++j) kj[((size_t)((l * 16 + g) * 2 + dir) * 32 + j) * 256 + ho * 16 + hi] = acc[j];
    }
    __syncthreads();
}
__device__ void st_prep_ssm(const P& p, int l) {
    bf16_t* wst = (bf16_t*)(p.ws + WS_WST);
    for (int idx = blockIdx.x * NT + threadIdx.x; idx < 16 * 256 * 64; idx += gridDim.x * NT) {
        const int kc = idx & 63, n = (idx >> 6) & 255, g = idx >> 14;
        const int dir = n >> 7, c = (n >> 6) & 1, pp = n & 63, s = kc >> 1, h0 = (kc & 1) * 8;
        const SsmPar q = ssm_par(p, l, dir, g, pp);
        const float2 coef = cmul(ssm_pow(q, dir == 0 ? (float)(31 - s) : (float)s), ssm_f(q));
        const size_t bi = ((size_t)((l * 2 + dir) * SG + g) * SP + pp) * 16 + h0;
        float v[8];
#pragma unroll
        for (int j = 0; j < 8; ++j) { const float2 z = cmul(coef, make_float2(p.in[I_BRE][bi + j], p.in[I_BIM][bi + j])); v[j] = c == 0 ? z.x : z.y; }
        u32x4 o; o[0] = cvt_pk_bf16(v[0], v[1]); o[1] = cvt_pk_bf16(v[2], v[3]); o[2] = cvt_pk_bf16(v[4], v[5]); o[3] = cvt_pk_bf16(v[6], v[7]);
        *(u32x4*)(wst + ((size_t)(g * 256 + n)) * 512 + kc * 8) = o;
    }
    bf16_t* kw = (bf16_t*)(p.ws + WS_KW);
    const float* kj = (const float*)(p.ws + WS_KJ);
    for (int idx = blockIdx.x * NT + threadIdx.x; idx < 16 * 512 * 96; idx += gridDim.x * NT) {
        const int kc = idx % 96, n = (idx / 96) & 511, g = idx / (96 * 512);
        const int tau = n >> 4, ho = n & 15;
        float v[8];
        if (kc < 64) {
            const int s = kc >> 1, hi0 = (kc & 1) * 8;
#pragma unroll
            for (int j = 0; j < 8; ++j) {
                float a = 0.f;
                if (s <= tau) a += kj[((size_t)((l * 16 + g) * 2 + 0) * 32 + (tau - s)) * 256 + ho * 16 + hi0 + j];
                if (s >= tau) a += kj[((size_t)((l * 16 + g) * 2 + 1) * 32 + (s - tau)) * 256 + ho * 16 + hi0 + j];
                if (s == tau && ho == hi0 + j) a += p.in[I_SD][l * DSSM + g * 16 + ho];
                v[j] = a;
            }
        } else {
            const int kk = (kc - 64) * 8, dir = kk >> 7, c = (kk >> 6) & 1, p0 = kk & 63;
            const float e = dir == 0 ? (float)(tau + 1) : (float)(32 - tau);
#pragma unroll
            for (int j = 0; j < 8; ++j) {
                const SsmPar q = ssm_par(p, l, dir, g, p0 + j);
                const size_t ci = ((size_t)((l * 2 + dir) * SG + g) * 16 + ho) * SP + p0 + j;
                const float2 z = cmul(make_float2(p.in[I_CRE][ci], p.in[I_CIM][ci]), ssm_pow(q, e));
                v[j] = c == 0 ? z.x : -z.y;
            }
        }
        u32x4 o; o[0] = cvt_pk_bf16(v[0], v[1]); o[1] = cvt_pk_bf16(v[2], v[3]); o[2] = cvt_pk_bf16(v[4], v[5]); o[3] = cvt_pk_bf16(v[6], v[7]);
        *(u32x4*)(kw + ((size_t)(g * 512 + n)) * 768 + kc * 8) = o;
    }
}
__device__ void st_ssm_egemm(const P& p, unsigned char* lds) {
    const bf16_t* ua = (const bf16_t*)(p.ws + WS_UA);
    const bf16_t* wst = (const bf16_t*)(p.ws + WS_WST);
    float* E = (float*)(p.ws + WS_E);
    for (int tile = blockIdx.x; tile < 160; tile += gridDim.x) {
        const int nt = tile & 1, mt = (tile >> 1) % 5, g = tile / 10;
        f32x16 acc[2][2];
        gemm_tile(acc, ARowPlain{ua + (size_t)(g * 640 + mt * 128) * 768, 768}, wst + (size_t)(g * 256 + nt * 128) * 512, 512, 512, lds);
        acc_foreach(acc, [&](int r, int c, float v) { E[(size_t)(g * 640 + mt * 128 + r) * 256 + nt * 128 + c] = v; });
    }
}
__device__ void st_ssm_carry(const P& p, int l) {
    bf16_t* ua = (bf16_t*)(p.ws + WS_UA);
    const float* E = (const float*)(p.ws + WS_E);
    for (int idx = blockIdx.x * NT + threadIdx.x; idx < NB * 16 * 2 * 64; idx += gridDim.x * NT) {
        const int pp = idx & 63, dir = (idx >> 6) & 1, g = (idx >> 7) & 15, b = idx >> 11;
        const float2 l32 = ssm_pow(ssm_par(p, l, dir, g, pp), 32.f);
        float2 S = make_float2(0.f, 0.f);
        for (int s0 = 0; s0 < 72; s0 += 8) {
            int ch[8]; float er[8], ei[8];
#pragma unroll
            for (int j = 0; j < 8; ++j) {
                const int step = s0 + j;
                if (dir == 0) ch[j] = step < 8 ? 512 + b * 8 + step : b * 64 + (step - 8);
                else ch[j] = step < 8 ? 512 + b * 8 + (7 - step) : b * 64 + (63 - (step - 8));
                const float* e = E + (size_t)(g * 640 + ch[j]) * 256 + dir * 128 + pp;
                er[j] = e[0]; ei[j] = e[64];
            }
#pragma unroll
            for (int j = 0; j < 8; ++j) {
                bf16_t* o = ua + (size_t)(g * 640 + ch[j]) * 768 + 512 + dir * 128 + pp;
                o[0] = f2bf(S.x); o[64] = f2bf(S.y);
                S = cmul(l32, S); S.x += er[j]; S.y += ei[j];
            }
        }
    }
}
__device__ void st_ssm_ygemm(const P& p, int l, unsigned char* lds) {
    const bf16_t* ua = (const bf16_t*)(p.ws + WS_UA);
    const bf16_t* kw = (const bf16_t*)(p.ws + WS_KW);
    bf16_t* G = (bf16_t*)(p.ws + WS_G);
    const int nmt = l == 0 ? 5 : 4;
    for (int tile = blockIdx.x; tile < 16 * nmt * 4; tile += gridDim.x) {
        const int nt = tile & 3, mt = (tile >> 2) % nmt, g = tile / (4 * nmt);
        f32x16 acc[2][2];
        gemm_tile(acc, ARowPlain{ua + (size_t)(g * 640 + mt * 128) * 768, 768}, kw + (size_t)(g * 512 + nt * 128) * 768, 768, 768, lds);
        acc_foreach(acc, [&](int r, int c, float v) {
            const int chunk = mt * 128 + r, n = nt * 128 + c;
            if (chunk < TA / 32) G[(size_t)(chunk * 32 + (n >> 4)) * DSSM + g * 16 + (n & 15)] = f2bf(gelu_f(v)); });
    }
}
struct EpiGlu2 { const bf16_t* G; bf16_t* mix; const float* bias; __device__ __forceinline__ void operator()(int r, int c, float v) const {
    mix[(size_t)r * D + 256 + c] = f2bf(bf2f(G[(size_t)r * DSSM + c]) * sigmoid_f(v + bias[c])); } };

constexpr float QSCALE = 0.125f * 1.4426950408889634f;
__device__ void st_rope_table(const P& p) {
    float2* tab = (float2*)(p.ws + WS_ROPE);
    for (int idx = blockIdx.x * NT + threadIdx.x; idx < L * 32; idx += gridDim.x * NT) {
        const int t = idx >> 5, a = (idx >> 4) & 1, i = idx & 15;
        const float pos = a == 0 ? (float)(t / 64) : (float)(t % 64);
        const float ang = pos * powf(10000.f, -(float)i / 16.f);
        tab[idx] = make_float2(cosf(ang), sinf(ang));
    }
}
__device__ void st_inproj(const P& p, int l, unsigned char* lds) {
    const bf16_t* A = (const bf16_t*)(p.ws + WS_BUFA);
    const bf16_t* Bt = (const bf16_t*)(p.ws + WS_WTIN);
    bf16_t* pc = (bf16_t*)(p.ws + WS_PC);
    bf16_t* ua = (bf16_t*)(p.ws + WS_UA);
    bf16_t* qb = (bf16_t*)(p.ws + WS_QB);
    bf16_t* kb = (bf16_t*)(p.ws + WS_KB);
    bf16_t* vt = (bf16_t*)(p.ws + WS_VT);
    const float2* rope = (const float2*)(p.ws + WS_ROPE);
    const int lane = threadIdx.x & 63, w = threadIdx.x >> 6, wr = w >> 1, wc = w & 1, lr = lane & 31, lh = lane >> 5;
    constexpr int TN = DIN / 128;
    for (int tile = blockIdx.x; tile < (TA / 128) * TN; tile += gridDim.x) {
        const int tn = tile % TN, m0 = (tile / TN) * 128, n0 = tn * 128;
        f32x16 acc[2][2];
        gemm_tile(acc, ARowPlain{A + (size_t)m0 * D, D}, Bt + (size_t)n0 * D, D, D, lds);
        if (tn < 6) {
            acc_foreach(acc, [&](int r, int c, float v) { pc[(size_t)(m0 + r) * 768 + n0 + c] = f2bf(v); });
        } else if (tn < 8) {
            acc_foreach(acc, [&](int r, int c, float v) { const int row = m0 + r, g = (tn - 6) * 8 + (c >> 4);
                ua[(size_t)(g * 640 + (row >> 5)) * 768 + (row & 31) * 16 + (c & 15)] = f2bf(v); });
        } else if (tn < 13) {
            const bool isq = tn < 12;
            const float* gain = (isq ? p.in[I_QG] : p.in[I_KG]) + l * 64;
            const float g0 = gain[lr], g1 = gain[32 + lr];
            const bool lat = m0 < TL;
            const int i16 = lr & 15; const bool hi = (lr >> 4) & 1;
            const float osc = isq ? QSCALE : 1.f;
#pragma unroll
            for (int mi = 0; mi < 2; ++mi)
#pragma unroll
                for (int r = 0; r < 16; ++r) {
                    const int row = m0 + wr * 64 + mi * 32 + (r & 3) + 8 * (r >> 2) + 4 * lh;
                    float x0 = acc[mi][0][r], x1 = acc[mi][1][r];
                    float ss = x0 * x0 + x1 * x1;
                    ss += __shfl_xor(ss, 1); ss += __shfl_xor(ss, 2); ss += __shfl_xor(ss, 4); ss += __shfl_xor(ss, 8); ss += __shfl_xor(ss, 16);
                    const float rinv = rsqrtf(ss * (1.f / 64.f) + 1e-6f);
                    x0 *= rinv * g0; x1 *= rinv * g1;
                    if (lat) {
                        const int t = row & (L - 1);
                        const float p0 = __shfl_xor(x0, 16), p1 = __shfl_xor(x1, 16);
                        const float2 cs0 = rope[(t * 2 + 0) * 16 + i16], cs1 = rope[(t * 2 + 1) * 16 + i16];
                        x0 = x0 * cs0.x + (hi ? p0 * cs0.y : -p0 * cs0.y);
                        x1 = x1 * cs1.x + (hi ? p1 * cs1.y : -p1 * cs1.y);
                    }
                    if (isq) { bf16_t* o = qb + (size_t)row * DATT + ((tn - 8) * 2 + wc) * 64 + lr; o[0] = f2bf(x0 * osc); o[32] = f2bf(x1 * osc); }
                    else { bf16_t* o = kb + (size_t)row * 128 + wc * 64 + lr; o[0] = f2bf(x0); o[32] = f2bf(x1); }
                }
        } else {
            const bool lat = m0 < TL;
#pragma unroll
            for (int mi = 0; mi < 2; ++mi)
#pragma unroll
                for (int ni = 0; ni < 2; ++ni)
#pragma unroll
                    for (int rg = 0; rg < 4; ++rg) {
                        const int row = m0 + wr * 64 + mi * 32 + 8 * rg + 4 * lh;
                        const int d = ni * 32 + lr, g = wc;
                        uint2 o; o.x = cvt_pk_bf16(acc[mi][ni][4 * rg], acc[mi][ni][4 * rg + 1]); o.y = cvt_pk_bf16(acc[mi][ni][4 * rg + 2], acc[mi][ni][4 * rg + 3]);
                        size_t off;
                        if (lat) { const int b = row >> 11, t = row & (L - 1); off = ((size_t)((b * 2 + g) * 64 + d)) * L + t; }
                        else { const int rc = row - TL, b = rc >> 8, t = rc & (LC - 1); off = (size_t)NB * 2 * 64 * L + ((size_t)((b * 2 + g) * 64 + d)) * LC + t; }
                        *(uint2*)(vt + off) = o;
                    }
        }
    }
}

constexpr int AT_KROWB = 144, AT_VROWB = 264, AT_VOFF = 128 * AT_KROWB;
__device__ void st_attn2(const P& p, int l, unsigned char* lds, int part, int nparts) {
    const bf16_t* qb = (const bf16_t*)(p.ws + WS_QB);
    const bf16_t* kb = (const bf16_t*)(p.ws + WS_KB);
    const bf16_t* vt = (const bf16_t*)(p.ws + WS_VT);
    bf16_t* mix = (bf16_t*)(p.ws + WS_BUFA);
    const int t = threadIdx.x, lane = t & 63, w = t >> 6, lr = lane & 31, lh = lane >> 5;
    const int nitems = NB * 16 * NQH + (l == 0 ? NB * 2 * NQH : 0);
    for (int item = blockIdx.x * nparts + part; item < nitems; item += gridDim.x * nparts) {
        const bool isctx = item >= NB * 16 * NQH;
        int b, qblk, hq;
        if (!isctx) { hq = item & 7; qblk = (item >> 3) & 15; b = item >> 7; }
        else { const int it = item - NB * 16 * NQH; hq = it & 7; qblk = (it >> 3) & 1; b = it >> 4; }
        const int g = hq >> 2;
        const int rq0 = isctx ? TL + b * LC + qblk * 128 : b * L + qblk * 128;
        const int qrow = rq0 + w * 32 + lr;
        bf16x8 qf[4];
#pragma unroll
        for (int s4 = 0; s4 < 4; ++s4) qf[s4] = *(const bf16x8*)(qb + (size_t)qrow * DATT + hq * 64 + s4 * 16 + lh * 8);
        float m = p.in[I_SINK][l * NQH + hq] * 1.4426950408889634f;
        float lsum = lh == 0 ? 1.f : 0.f;
        f32x16 o0, o1;
#pragma unroll
        for (int r = 0; r < 16; ++r) { o0[r] = 0.f; o1[r] = 0.f; }
        const int nkb = isctx ? 2 : 5;
        for (int kbi = 0; kbi < nkb; ++kbi) {
            bool win; int kblk;
            if (isctx) { win = false; kblk = kbi; } else if (kbi < 3) { win = true; kblk = qblk - 1 + kbi; } else { win = false; kblk = kbi - 3; }
            if (win && (kblk < 0 || kblk > 15)) continue;
            const bf16_t* ksrc = kb + (size_t)(win ? b * L + kblk * 128 : TL + b * LC + kblk * 128) * 128 + g * 64;
            const bf16_t* vsrc = win ? vt + (size_t)((b * 2 + g) * 64) * L + kblk * 128 : vt + (size_t)NB * 2 * 64 * L + (size_t)((b * 2 + g) * 64) * LC + kblk * 128;
            const int vld = win ? L : LC;
            __syncthreads();
#pragma unroll
            for (int i = 0; i < 4; ++i) {
                const int c = t + 256 * i;
                const int row = c >> 3, kc = c & 7;
                *(u32x4*)(lds + row * AT_KROWB + kc * 16) = *(const u32x4*)(ksrc + (size_t)row * 128 + kc * 8);
                const int d = c >> 4, ch = c & 15;
                const u32x4 vv = *(const u32x4*)(vsrc + (size_t)d * vld + ch * 8);
                uint2 lo, hi2; lo.x = vv[0]; lo.y = vv[1]; hi2.x = vv[2]; hi2.y = vv[3];
                *(uint2*)(lds + AT_VOFF + d * AT_VROWB + ch * 16) = lo;
                *(uint2*)(lds + AT_VOFF + d * AT_VROWB + ch * 16 + 8) = hi2;
            }
            __syncthreads();
            const int i0 = qblk * 128 + w * 32;
            for (int sub = 0; sub < 4; ++sub) {
                bool partial = false;
                if (win) {
                    const int j0 = kblk * 128 + sub * 32;
                    if (j0 > i0 + 31 + 128 || j0 + 31 < i0 - 128) continue;
                    partial = !(j0 >= i0 + 31 - 128 && j0 + 31 <= i0 + 128);
                }
                f32x16 sT;
#pragma unroll
                for (int r = 0; r < 16; ++r) sT[r] = 0.f;
#pragma unroll
                for (int s4 = 0; s4 < 4; ++s4) {
                    const bf16x8 kf = *(const bf16x8*)(lds + (sub * 32 + lr) * AT_KROWB + s4 * 32 + lh * 16);
                    sT = __builtin_amdgcn_mfma_f32_32x32x16_bf16(kf, qf[s4], sT, 0, 0, 0);
                }
                if (partial) {
                    const int j0 = kblk * 128 + sub * 32, qi = i0 + lr;
#pragma unroll
                    for (int r = 0; r < 16; ++r) { const int dj = j0 + (r & 3) + 8 * (r >> 2) + 4 * lh - qi; if (dj > 128 || dj < -128) sT[r] = -1e30f; }
                }
                float mt = sT[0];
#pragma unroll
                for (int r = 1; r < 16; ++r) mt = fmaxf(mt, sT[r]);
                mt = fmaxf(mt, __shfl_xor(mt, 32));
                const float mn = fmaxf(m, mt);
                const float alpha = __builtin_amdgcn_exp2f(m - mn);
                m = mn;
                float ps = 0.f;
#pragma unroll
                for (int r = 0; r < 16; ++r) { sT[r] = __builtin_amdgcn_exp2f(sT[r] - mn); ps += sT[r]; }
                lsum = lsum * alpha + ps;
#pragma unroll
                for (int r = 0; r < 16; ++r) { o0[r] *= alpha; o1[r] *= alpha; }
#pragma unroll
                for (int s2 = 0; s2 < 2; ++s2) {
                    u32x4 pk;
                    pk[0] = cvt_pk_bf16(sT[8 * s2 + 0], sT[8 * s2 + 1]); pk[1] = cvt_pk_bf16(sT[8 * s2 + 2], sT[8 * s2 + 3]);
                    pk[2] = cvt_pk_bf16(sT[8 * s2 + 4], sT[8 * s2 + 5]); pk[3] = cvt_pk_bf16(sT[8 * s2 + 6], sT[8 * s2 + 7]);
                    const bf16x8 pf = __builtin_bit_cast(bf16x8, pk);
                    const int kofs = (sub * 32 + s2 * 16 + lh * 4) * 2;
                    {
                        const uint2 a = *(const uint2*)(lds + AT_VOFF + lr * AT_VROWB + kofs), c2 = *(const uint2*)(lds + AT_VOFF + lr * AT_VROWB + kofs + 16);
                        u32x4 vv; vv[0] = a.x; vv[1] = a.y; vv[2] = c2.x; vv[3] = c2.y;
                        o0 = __builtin_amdgcn_mfma_f32_32x32x16_bf16(__builtin_bit_cast(bf16x8, vv), pf, o0, 0, 0, 0);
                    }
                    {
                        const uint2 a = *(const uint2*)(lds + AT_VOFF + (32 + lr) * AT_VROWB + kofs), c2 = *(const uint2*)(lds + AT_VOFF + (32 + lr) * AT_VROWB + kofs + 16);
                        u32x4 vv; vv[0] = a.x; vv[1] = a.y; vv[2] = c2.x; vv[3] = c2.y;
                        o1 = __builtin_amdgcn_mfma_f32_32x32x16_bf16(__builtin_bit_cast(bf16x8, vv), pf, o1, 0, 0, 0);
                    }
                }
            }
        }
        lsum += __shfl_xor(lsum, 32);
        const float inv = 1.f / lsum;
        bf16_t* orow = mix + (size_t)qrow * D + 512 + hq * 64;
#pragma unroll
        for (int rg = 0; rg < 4; ++rg) {
            uint2 a; a.x = cvt_pk_bf16(o0[4 * rg] * inv, o0[4 * rg + 1] * inv); a.y = cvt_pk_bf16(o0[4 * rg + 2] * inv, o0[4 * rg + 3] * inv);
            *(uint2*)(orow + 8 * rg + 4 * lh) = a;
            uint2 c2; c2.x = cvt_pk_bf16(o1[4 * rg] * inv, o1[4 * rg + 1] * inv); c2.y = cvt_pk_bf16(o1[4 * rg + 2] * inv, o1[4 * rg + 3] * inv);
            *(uint2*)(orow + 32 + 8 * rg + 4 * lh) = c2;
        }
    }
}

constexpr int STAGES_PER_LAYER = 11;
constexpr int N_STAGES = 1 + 2 * STAGES_PER_LAYER;

__device__ __forceinline__ void run_stage(const P& p, int s, unsigned char* ldsb) {
    float* lds = (float*)ldsb;
    if (s == 0) { st_mod(p, lds); st_rope_table(p); st_ssm_kj(p, lds); return; }
    const int l = (s - 1) / STAGES_PER_LAYER, k = (s - 1) % STAGES_PER_LAYER;
    switch (k) {
    case 0: st_rbias(p, l, lds); st_norm(p, l, 0); st_prep_dense(p, l); st_prep_moe(p, l); st_prep_ssm(p, l); break;
    case 1: st_inproj(p, l, ldsb); break;
    case 2: st_ssm_egemm(p, ldsb); st_conv(p, l); st_attn2(p, l, ldsb, 0, 4); break;
    case 3: st_ssm_carry(p, l); st_attn2(p, l, ldsb, 1, 4); break;
    case 4: st_ssm_ygemm(p, l, ldsb); st_attn2(p, l, ldsb, 2, 4); break;
    case 5: gemm_stage((const bf16_t*)(p.ws + WS_G), DSSM, (const bf16_t*)(p.ws + WS_WTGLU), DSSM, l == 0 ? TA : TL, DSSM, DSSM,
                       EpiGlu2{(const bf16_t*)(p.ws + WS_G), (bf16_t*)(p.ws + WS_BUFA), p.in[I_BGLU] + l * DSSM}, ldsb);
            st_attn2(p, l, ldsb, 3, 4); break;
    case 6: gemm_stage((const bf16_t*)(p.ws + WS_BUFA), D, (const bf16_t*)(p.ws + WS_WTOUT), D, l == 0 ? TA : TL, D, D, EpiOut{p, l}, ldsb); break;
    case 7: st_router2(p, l, ldsb); break;
    case 8: st_moe1(p, l, ldsb); break;
    case 9: st_moe2(p, l, ldsb); break;
    case 10: gemm_stage((const bf16_t*)(p.ws + WS_HID) + 4 * DE, 5 * DE, (const bf16_t*)(p.ws + WS_WD) + (size_t)32 * D * DE, DE, l == 0 ? TA : TL, D, DE, EpiMoeF{p, l}, ldsb); break;
    }
}

template <int S> __device__ __forceinline__ void run_all(const P& p, unsigned char* lds) {
    run_stage(p, S, lds);
    if constexpr (S + 1 < N_STAGES) { cg::this_grid().sync(); run_all<S + 1>(p, lds); }
}
__global__ void __launch_bounds__(NT) mega(P p) {
    __shared__ __attribute__((aligned(16))) unsigned char lds[LDS_TOTAL];
    run_all<0>(p, lds);
}

extern "C" void kernel_launch(void* const* d_in, const int* in_sizes, int n_in, void* d_out, int out_size, void* d_ws, size_t ws_size, hipStream_t stream) {
    if (n_in != N_IN || ws_size < WS_END) { fprintf(stderr, "kernel_launch: unexpected n_in %d or ws_size %zu (< %zu)\n", n_in, ws_size, (size_t)WS_END); return; }
    P p{};
    for (int i = 0; i < N_IN; ++i) p.in[i] = (const float*)d_in[i];
    p.out = (float*)d_out; p.ws = (unsigned char*)d_ws;
    static int grid_blocks = 0;
    if (!grid_blocks) {
        int dev = 0, cus = 0, per_cu = 0;
        hipGetDevice(&dev);
        hipDeviceGetAttribute(&cus, hipDeviceAttributeMultiprocessorCount, dev);
        hipOccupancyMaxActiveBlocksPerMultiprocessor(&per_cu, (const void*)mega, NT, 0);
        if (per_cu < 1) per_cu = 1;
        if (per_cu > 2) per_cu = 2;
        grid_blocks = cus * per_cu;
    }
    hipMemsetAsync((char*)d_ws + WS_CTL, 0, WS_ZERO_END, stream);
    void* args[] = {&p};
    hipError_t e = hipLaunchCooperativeKernel((const void*)mega, dim3(grid_blocks), dim3(NT), args, 0, stream);
    if (e != hipSuccess) fprintf(stderr, "cooperative launch failed: %s (grid %d)\n", hipGetErrorString(e), grid_blocks);
}
```

```cpp
#include <hip/hip_runtime.h>
#include <hip/hip_cooperative_groups.h>
#include <cstdio>
#include <cstdint>
namespace cg = cooperative_groups;
__device__ __forceinline__ int tid_opaque() { int t = threadIdx.x; asm volatile("" : "+v"(t)); return t; }
__device__ __forceinline__ int bid_opaque() { int b = blockIdx.x; asm volatile("" : "+s"(b)); return b; }
#define TIDX tid_opaque()
#define BIDX bid_opaque()

constexpr int D = 1024, NB = 8, L = 2048, LC = 256;
constexpr int TL = NB * L, TC = NB * LC, TA = TL + TC;
constexpr int DIN = 1792, DCONV = 256, DSSM = 256, DATT = 512;
constexpr int NQH = 8, NKVH = 2, HD = 64;
constexpr int COL_U = 768, COL_Q = 1024, COL_K = 1536, COL_V = 1664;
constexpr int NE = 32, TOPK = 4, DE = 128;
constexpr int SG = 16, SH = 16, SP = 64;
constexpr int NT = 256;

enum { I_X = 0, I_C, I_CTX, I_CCTX, I_WMOD, I_BMOD, I_N1G, I_N2G, I_WIN, I_CONVW, I_LRE, I_LIM, I_LDT, I_BRE, I_BIM, I_CRE, I_CIM,
       I_SD, I_WGLU, I_BGLU, I_QG, I_KG, I_SINK, I_WOUT, I_RW, I_RB, I_WEG, I_WEU, I_WED, I_WSG, I_WSU, I_WSD, N_IN };

typedef unsigned short bf16_t;
constexpr size_t WS_CTL = 0;
constexpr size_t WS_MOD = 65536;
constexpr size_t WS_ZERO_END = WS_MOD + (size_t)2 * 9 * 6 * D * 4;
constexpr size_t WS_RBIAS = 524288;
constexpr size_t WS_ROPE = WS_RBIAS + 4096;
constexpr size_t WS_KJ = WS_ROPE + 524288;
constexpr size_t WS_R1 = WS_KJ + 2097152;
constexpr size_t WS_BUFA = WS_R1;
constexpr size_t WS_PC = WS_BUFA + (size_t)TA * D * 2;
constexpr size_t WS_UA = WS_PC + (size_t)TA * 768 * 2;
constexpr size_t WS_E = WS_UA + (size_t)16 * 640 * 768 * 2;
constexpr size_t WS_G = WS_E + (size_t)16 * 640 * 256 * 4;
constexpr size_t WS_QB = WS_G + (size_t)TA * DSSM * 2;
constexpr size_t WS_KB = WS_QB + (size_t)TA * DATT * 2;
constexpr size_t WS_VT = WS_KB + (size_t)TA * 128 * 2;
constexpr size_t WS_SLAB = WS_R1;
constexpr size_t WS_HID = WS_SLAB + (size_t)TA * 4 * D * 2;
constexpr size_t WS_HC1 = WS_HID + (size_t)TA * 5 * DE * 2;
constexpr size_t WS_HCMID = WS_HC1 + (size_t)TC * D * 4;
constexpr size_t WS_LCODE = WS_HCMID + (size_t)TC * D * 4;
constexpr size_t WS_LW = WS_LCODE + (size_t)NE * TA * 4;
constexpr size_t WS_WTIN = WS_LW + (size_t)NE * TA * 4;
constexpr size_t WS_WTOUT = WS_WTIN + (size_t)DIN * D * 2;
constexpr size_t WS_WTGLU = WS_WTOUT + (size_t)D * D * 2;
constexpr size_t WS_WGU = WS_WTGLU + (size_t)DSSM * DSSM * 2;
constexpr size_t WS_WD = WS_WGU + (size_t)33 * 256 * D * 2;
constexpr size_t WS_WST = WS_WD + (size_t)33 * D * DE * 2;
constexpr size_t WS_KW = WS_WST + (size_t)16 * 256 * 512 * 2;
constexpr size_t WS_END = WS_KW + (size_t)16 * 512 * 768 * 2;
static_assert(WS_VT + (size_t)TA * 128 * 2 <= WS_HID, "overlay");
static_assert(WS_ZERO_END <= WS_RBIAS, "zero region");
static_assert(WS_END <= 268435456, "workspace too large");

struct P {
    const float* in[N_IN];
    float* out;
    unsigned char* ws;
};

__device__ __forceinline__ bf16_t f2bf(float f) { unsigned u = __float_as_uint(f); u += 0x7FFFu + ((u >> 16) & 1u); return (bf16_t)(u >> 16); }
__device__ __forceinline__ float bf2f(bf16_t b) { return __uint_as_float((unsigned)b << 16); }
__device__ __forceinline__ unsigned cvt_pk_bf16(float lo, float hi) { unsigned r; asm("v_cvt_pk_bf16_f32 %0, %1, %2" : "=v"(r) : "v"(lo), "v"(hi)); return r; }
struct BfPtr { const bf16_t* p; __device__ __forceinline__ float operator[](long i) const { return bf2f(p[i]); }
               __device__ __forceinline__ BfPtr operator+(long o) const { return BfPtr{p + o}; } };
__device__ __forceinline__ float silu_f(float x) { return x / (1.f + expf(-x)); }
__device__ __forceinline__ float sigmoid_f(float x) { return 1.f / (1.f + expf(-x)); }
__device__ __forceinline__ float gelu_f(float x) { return 0.5f * x * (1.f + tanhf(0.7978845608028654f * (x + 0.044715f * x * x * x))); }
__device__ __forceinline__ float wave_sum(float v) {
#pragma unroll
    for (int o = 32; o > 0; o >>= 1) v += __shfl_xor(v, o);
    return v;
}
__device__ __forceinline__ int row_bb(int r) { return r < TL ? r / L : 8; }
__device__ __forceinline__ const float* h_row(const P& p, int l, int r) {
    if (r < TL) return (l == 0 ? p.in[I_X] : p.out) + (size_t)r * D;
    return (l == 0 ? p.in[I_CTX] : (const float*)(p.ws + WS_HC1)) + (size_t)(r - TL) * D;
}
__device__ __forceinline__ float* hmid_row(const P& p, int r) {
    if (r < TL) return p.out + (size_t)r * D;
    return (float*)(p.ws + WS_HCMID) + (size_t)(r - TL) * D;
}
__device__ __forceinline__ const float* mod_vec(const P& p, int l, int bb, int chunk) {
    return (const float*)(p.ws + WS_MOD) + ((size_t)(l * 9 + bb) * 6 + chunk) * D;
}

__device__ void st_mod(const P& p, float* lds) {
    float* red = lds + 9 * D;
    for (int i = TIDX; i < 9 * D; i += NT) {
        const int bb = i / D, k = i % D;
        const float c = bb < 8 ? p.in[I_C][bb * D + k] : p.in[I_CCTX][k];
        lds[i] = silu_f(c);
    }
    __syncthreads();
    float* mod = (float*)(p.ws + WS_MOD);
    const int col = TIDX & 31, ks = TIDX >> 5;
    for (int item = BIDX; item < 2 * 6 * D / 32; item += gridDim.x) {
        const int l = item / (6 * D / 32), j = (item % (6 * D / 32)) * 32 + col;
        const float* w = p.in[I_WMOD] + (size_t)l * D * 6 * D + j;
        float acc[9];
#pragma unroll
        for (int bb = 0; bb < 9; ++bb) acc[bb] = 0.f;
        for (int k = ks * 128; k < ks * 128 + 128; ++k) {
            const float wv = w[(size_t)k * 6 * D];
#pragma unroll
            for (int bb = 0; bb < 9; ++bb) acc[bb] += lds[bb * D + k] * wv;
        }
#pragma unroll
        for (int bb = 0; bb < 9; ++bb) red[(bb * 8 + ks) * 32 + col] = acc[bb];
        __syncthreads();
        for (int o = TIDX; o < 9 * 32; o += NT) {
            const int bb = o >> 5, c2 = o & 31;
            float sum = p.in[I_BMOD][l * 6 * D + (item % (6 * D / 32)) * 32 + c2];
#pragma unroll
            for (int q = 0; q < 8; ++q) sum += red[(bb * 8 + q) * 32 + c2];
            mod[(size_t)(l * 9 + bb) * 6 * D + (item % (6 * D / 32)) * 32 + c2] = sum;
        }
        __syncthreads();
    }
}

__device__ void st_norm(const P& p, int l, int which) {
    const int lane = TIDX & 63, wv = TIDX >> 6;
    const int nrows = (which == 1 && l == 1) ? TL : TA;
    float* xn = (float*)(p.ws + WS_BUFA);
    const float* g = p.in[which == 0 ? I_N1G : I_N2G] + l * D;
    for (int r = BIDX * 4 + wv; r < nrows; r += gridDim.x * 4) {
        const float* src = which == 0 ? h_row(p, l, r) : hmid_row(p, r);
        const int bb = row_bb(r);
        const float* sh = mod_vec(p, l, bb, which == 0 ? 0 : 3);
        const float* sc = mod_vec(p, l, bb, which == 0 ? 1 : 4);
        float4 v[4];
        float s = 0.f;
#pragma unroll
        for (int j = 0; j < 4; ++j) { v[j] = *(const float4*)(src + j * 256 + lane * 4); s += v[j].x * v[j].x + v[j].y * v[j].y + v[j].z * v[j].z + v[j].w * v[j].w; }
        s = wave_sum(s);
        const float rinv = rsqrtf(s * (1.f / D) + 1e-6f);
#pragma unroll
        for (int j = 0; j < 4; ++j) {
            const int k = j * 256 + lane * 4;
            const float4 gg = *(const float4*)(g + k), s1 = *(const float4*)(sc + k), s0 = *(const float4*)(sh + k);
            float4 o;
            o.x = v[j].x * rinv * gg.x * (1.f + s1.x) + s0.x;
            o.y = v[j].y * rinv * gg.y * (1.f + s1.y) + s0.y;
            o.z = v[j].z * rinv * gg.z * (1.f + s1.z) + s0.z;
            o.w = v[j].w * rinv * gg.w * (1.f + s1.w) + s0.w;
            if (which == 1) *(float4*)(xn + (size_t)r * D + k) = o;
            else { uint2 pk; pk.x = (unsigned)f2bf(o.x) | ((unsigned)f2bf(o.y) << 16); pk.y = (unsigned)f2bf(o.z) | ((unsigned)f2bf(o.w) << 16);
                   *(uint2*)((bf16_t*)(p.ws + WS_BUFA) + (size_t)r * D + k) = pk; }
        }
    }
}


__device__ void st_conv(const P& p, int l) {
    const BfPtr pb{(const bf16_t*)(p.ws + WS_PC)};
    bf16_t* mix = (bf16_t*)(p.ws + WS_BUFA);
    const float* cw = p.in[I_CONVW] + l * 3 * DCONV;
    const int nrows = l == 0 ? TA : TL;
    for (int idx = BIDX * NT + TIDX; idx < nrows * DCONV; idx += gridDim.x * NT) {
        const int r = idx / DCONV, ch = idx % DCONV;
        int t, len;
        if (r < TL) { t = r % L; len = L; } else { t = (r - TL) % LC; len = LC; }
        const BfPtr pr = pb + (long)r * 768;
        float y = cw[DCONV + ch] * (pr[512 + ch] * pr[ch]);
        if (t > 0) y += cw[ch] * (pr[-768 + 512 + ch] * pr[-768 + ch]);
        if (t < len - 1) y += cw[2 * DCONV + ch] * (pr[768 + 512 + ch] * pr[768 + ch]);
        mix[(size_t)r * D + ch] = f2bf(pr[256 + ch] * y);
    }
}

struct EpiOut { P p; int l; __device__ void operator()(int r, int c, float v) const {
    const float g1 = mod_vec(p, l, row_bb(r), 2)[c];
    const float hv = h_row(p, l, r)[c];
    hmid_row(p, r)[c] = hv + g1 * v; } };

typedef __attribute__((ext_vector_type(8))) short bf16x8;
typedef __attribute__((ext_vector_type(16))) float f32x16;
typedef __attribute__((ext_vector_type(4))) unsigned u32x4;
constexpr int G_ROWB = 144;
constexpr int G_TILEB = 128 * G_ROWB;
constexpr int LDS_BYTES = 4 * G_TILEB;

template <class ARow>
__device__ __forceinline__ void gemm_tile(f32x16 (&acc)[2][2], ARow arow, const bf16_t* Bt, int ldb, int K, unsigned char* lds) {
    const int t = TIDX, lane = t & 63, w = t >> 6, wr = w >> 1, wc = w & 1, lr = lane & 31, lh = lane >> 5;
    const int srow = t >> 3, kc = t & 7;
    const bf16_t* ap[4]; const bf16_t* bp[4];
#pragma unroll
    for (int i = 0; i < 4; ++i) { ap[i] = arow(srow + 32 * i) + kc * 8; bp[i] = Bt + (size_t)(srow + 32 * i) * ldb + kc * 8; }
    float zf = 0.f; asm volatile("" : "+v"(zf));
#pragma unroll
    for (int mi = 0; mi < 2; ++mi)
#pragma unroll
        for (int ni = 0; ni < 2; ++ni)
#pragma unroll
            for (int r = 0; r < 16; ++r) acc[mi][ni][r] = zf;
    u32x4 ra[4], rb[4];
#pragma unroll
    for (int i = 0; i < 4; ++i) { ra[i] = *(const u32x4*)(ap[i]); rb[i] = *(const u32x4*)(bp[i]); }
    __syncthreads();
    const int soff = srow * G_ROWB + kc * 16;
#pragma unroll
    for (int i = 0; i < 4; ++i) { *(u32x4*)(lds + soff + i * 32 * G_ROWB) = ra[i]; *(u32x4*)(lds + G_TILEB + soff + i * 32 * G_ROWB) = rb[i]; }
    __syncthreads();
    const int nk = K >> 6;
    const int aoff = (wr * 64 + lr) * G_ROWB + lh * 16, boff = G_TILEB + (wc * 64 + lr) * G_ROWB + lh * 16;
    for (int kt = 0; kt < nk; ++kt) {
        const unsigned char* cur = lds + (kt & 1) * 2 * G_TILEB;
        if (kt + 1 < nk) {
#pragma unroll
            for (int i = 0; i < 4; ++i) { ra[i] = *(const u32x4*)(ap[i] + (kt + 1) * 64); rb[i] = *(const u32x4*)(bp[i] + (kt + 1) * 64); }
        }
#pragma unroll
        for (int s4 = 0; s4 < 4; ++s4) {
            const bf16x8 a0 = *(const bf16x8*)(cur + aoff + s4 * 32), a1 = *(const bf16x8*)(cur + aoff + 32 * G_ROWB + s4 * 32);
            const bf16x8 b0 = *(const bf16x8*)(cur + boff + s4 * 32), b1 = *(const bf16x8*)(cur + boff + 32 * G_ROWB + s4 * 32);
            acc[0][0] = __builtin_amdgcn_mfma_f32_32x32x16_bf16(a0, b0, acc[0][0], 0, 0, 0);
            acc[0][1] = __builtin_amdgcn_mfma_f32_32x32x16_bf16(a0, b1, acc[0][1], 0, 0, 0);
            acc[1][0] = __builtin_amdgcn_mfma_f32_32x32x16_bf16(a1, b0, acc[1][0], 0, 0, 0);
            acc[1][1] = __builtin_amdgcn_mfma_f32_32x32x16_bf16(a1, b1, acc[1][1], 0, 0, 0);
        }
        if (kt + 1 < nk) {
            unsigned char* nxt = lds + ((kt + 1) & 1) * 2 * G_TILEB;
#pragma unroll
            for (int i = 0; i < 4; ++i) { *(u32x4*)(nxt + soff + i * 32 * G_ROWB) = ra[i]; *(u32x4*)(nxt + G_TILEB + soff + i * 32 * G_ROWB) = rb[i]; }
        }
        __syncthreads();
    }
}
template <class F>
__device__ __forceinline__ void acc_foreach(const f32x16 (&acc)[2][2], F f) {
    const int lane = TIDX & 63, w = TIDX >> 6, wr = w >> 1, wc = w & 1, lr = lane & 31, lh = lane >> 5;
#pragma unroll
    for (int mi = 0; mi < 2; ++mi)
#pragma unroll
        for (int ni = 0; ni < 2; ++ni)
#pragma unroll
            for (int r = 0; r < 16; ++r) f(wr * 64 + mi * 32 + (r & 3) + 8 * (r >> 2) + 4 * lh, wc * 64 + ni * 32 + lr, acc[mi][ni][r]);
}
struct ARowPlain { const bf16_t* A; int lda; __device__ __forceinline__ const bf16_t* operator()(int m) const { return A + (size_t)m * lda; } };

template <class Epi>
__device__ void gemm_stage(const bf16_t* A, int lda, const bf16_t* Bt, int ldb, int M, int N, int K, Epi epi, unsigned char* lds) {
    const int tn = N / 128, tm = M / 128;
    for (int tile = BIDX; tile < tm * tn; tile += gridDim.x) {
        const int m0 = (tile / tn) * 128, n0 = (tile % tn) * 128;
        f32x16 acc[2][2];
        gemm_tile(acc, ARowPlain{A + (size_t)m0 * lda, lda}, Bt + (size_t)n0 * ldb, ldb, K, lds);
        acc_foreach(acc, [&](int r, int c, float v) { epi(m0 + r, n0 + c, v); });
    }
}
__device__ void prep_tr(const float* src, size_t sk, bf16_t* dst, int N, int K) {
    const int per = N * (K / 8);
    for (int idx = BIDX * NT + TIDX; idx < per; idx += gridDim.x * NT) {
        const int n = idx % N, kc = idx / N;
        const float* sp = src + (size_t)kc * 8 * sk + n;
        uint4 o;
        o.x = (unsigned)f2bf(sp[0]) | ((unsigned)f2bf(sp[sk]) << 16);
        o.y = (unsigned)f2bf(sp[2 * sk]) | ((unsigned)f2bf(sp[3 * sk]) << 16);
        o.z = (unsigned)f2bf(sp[4 * sk]) | ((unsigned)f2bf(sp[5 * sk]) << 16);
        o.w = (unsigned)f2bf(sp[6 * sk]) | ((unsigned)f2bf(sp[7 * sk]) << 16);
        *(uint4*)(dst + (size_t)n * K + kc * 8) = o;
    }
}
__device__ void st_prep_dense(const P& p, int l) {
    prep_tr(p.in[I_WIN] + (size_t)l * D * DIN, DIN, (bf16_t*)(p.ws + WS_WTIN), DIN, D);
    prep_tr(p.in[I_WOUT] + (size_t)l * D * D, D, (bf16_t*)(p.ws + WS_WTOUT), D, D);
    prep_tr(p.in[I_WGLU] + (size_t)l * DSSM * DSSM, DSSM, (bf16_t*)(p.ws + WS_WTGLU), DSSM, DSSM);
}
struct EpiStoreBf { bf16_t* C; int ldc; __device__ __forceinline__ void operator()(int r, int c, float v) const { C[(size_t)r * ldc + c] = f2bf(v); } };


typedef __attribute__((ext_vector_type(4))) float f32x4;
__device__ void st_rbias(const P& p, int l, float* lds) {
    if (BIDX < 9) {
        const int bb = BIDX, e = TIDX & 31, ks = TIDX >> 5;
        const float* sh2 = mod_vec(p, l, bb, 3);
        const float* rw = p.in[I_RW] + (size_t)l * D * NE;
        float a = 0.f;
        for (int k = ks * 128; k < ks * 128 + 128; ++k) a += sh2[k] * rw[k * NE + e];
        lds[TIDX] = a;
        __syncthreads();
        if (TIDX < 32) { float s = 0.f; for (int j = 0; j < 8; ++j) s += lds[j * 32 + TIDX]; ((float*)(p.ws + WS_RBIAS))[(l * 9 + bb) * 32 + TIDX] = s; }
        __syncthreads();
    }
}
__device__ void st_router2(const P& p, int l, unsigned char* ldsb) {
    const int lane = TIDX & 63, w = TIDX >> 6, i = lane & 31, hf = lane >> 5;
    float* sc = (float*)ldsb + w * (32 * 33);
    const int nrows = l == 0 ? TA : TL;
    const float* g2 = p.in[I_N2G] + l * D;
    const float* rw = p.in[I_RW] + (size_t)l * D * NE;
    int* cnt = (int*)(p.ws + WS_CTL) + l * NE;
    int* lcode = (int*)(p.ws + WS_LCODE);
    float* lw = (float*)(p.ws + WS_LW);
    bf16_t* xn2 = (bf16_t*)(p.ws + WS_BUFA);
    for (int item = BIDX * 4 + w; item < nrows / 32; item += gridDim.x * 4) {
        const int r0 = item * 32, bb = row_bb(r0);
        const float* sc2 = mod_vec(p, l, bb, 4);
        const float* sh2 = mod_vec(p, l, bb, 3);
        const float* src = hmid_row(p, r0 + i) + hf * 512;
        f32x16 acc;
        float zf = 0.f; asm volatile("" : "+v"(zf));
#pragma unroll
        for (int r = 0; r < 16; ++r) acc[r] = zf;
        float ss = 0.f;
        for (int c = 0; c < 128; ++c) {
            const int k = hf * 512 + 4 * c;
            const f32x4 x = *(const f32x4*)(src + 4 * c);
            const f32x4 gg = *(const f32x4*)(g2 + k), s1 = *(const f32x4*)(sc2 + k);
            ss += x[0] * x[0] + x[1] * x[1] + x[2] * x[2] + x[3] * x[3];
#pragma unroll
            for (int q = 0; q < 4; ++q) {
                const float a = x[q] * (gg[q] * (1.f + s1[q]));
                const float b = rw[(size_t)(k + q) * NE + i];
                acc = __builtin_amdgcn_mfma_f32_32x32x2f32(a, b, acc, 0, 0, 0);
            }
        }
        ss += __shfl_xor(ss, 32);
        const float rinv = rsqrtf(ss * (1.f / D) + 1e-6f);
        const float rb = ((const float*)(p.ws + WS_RBIAS))[(l * 9 + bb) * 32 + i];
#pragma unroll
        for (int r = 0; r < 16; ++r) {
            const int rho = (r & 3) + 8 * (r >> 2) + 4 * hf;
            const float rr = __shfl(rinv, rho);
            sc[rho * 33 + i] = sigmoid_f(rr * acc[r] + rb);
        }
        __builtin_amdgcn_s_waitcnt(0xc07f);
        __builtin_amdgcn_wave_barrier();
        {
            float gs[16], sh[16];
#pragma unroll
            for (int q = 0; q < 16; ++q) { const int k = (q >> 3) * 512 + 8 * lane + (q & 7); gs[q] = g2[k] * (1.f + sc2[k]); sh[q] = sh2[k]; }
            for (int rho = 0; rho < 32; ++rho) {
                const float rr = __shfl(rinv, rho);
                const float* s2 = hmid_row(p, r0 + rho);
                bf16_t* dst = xn2 + (size_t)(r0 + rho) * D;
#pragma unroll
                for (int h2 = 0; h2 < 2; ++h2) {
                    const f32x4 x0 = *(const f32x4*)(s2 + h2 * 512 + 8 * lane), x1 = *(const f32x4*)(s2 + h2 * 512 + 8 * lane + 4);
                    u32x4 o;
                    o[0] = (unsigned)f2bf(x0[0] * rr * gs[h2 * 8 + 0] + sh[h2 * 8 + 0]) | ((unsigned)f2bf(x0[1] * rr * gs[h2 * 8 + 1] + sh[h2 * 8 + 1]) << 16);
                    o[1] = (unsigned)f2bf(x0[2] * rr * gs[h2 * 8 + 2] + sh[h2 * 8 + 2]) | ((unsigned)f2bf(x0[3] * rr * gs[h2 * 8 + 3] + sh[h2 * 8 + 3]) << 16);
                    o[2] = (unsigned)f2bf(x1[0] * rr * gs[h2 * 8 + 4] + sh[h2 * 8 + 4]) | ((unsigned)f2bf(x1[1] * rr * gs[h2 * 8 + 5] + sh[h2 * 8 + 5]) << 16);
                    o[3] = (unsigned)f2bf(x1[2] * rr * gs[h2 * 8 + 6] + sh[h2 * 8 + 6]) | ((unsigned)f2bf(x1[3] * rr * gs[h2 * 8 + 7] + sh[h2 * 8 + 7]) << 16);
                    *(u32x4*)(dst + h2 * 512 + 8 * lane) = o;
                }
            }
        }
        if (lane < 32) {
            const int r = r0 + lane;
            float sel[32];
#pragma unroll
            for (int e = 0; e < 32; ++e) sel[e] = sc[lane * 33 + e] + p.in[I_RB][l * NE + e];
            int bi[4]; float sv[4]; float sum = 0.f;
#pragma unroll
            for (int k = 0; k < 4; ++k) {
                float best = -1e30f; int b = 0;
#pragma unroll
                for (int e = 0; e < 32; ++e) if (sel[e] > best) { best = sel[e]; b = e; }
#pragma unroll
                for (int e = 0; e < 32; ++e) if (e == b) sel[e] = -1e30f;
                bi[k] = b; sv[k] = sc[lane * 33 + b]; sum += sv[k];
            }
#pragma unroll
            for (int k = 0; k < 4; ++k) {
                const int pos = atomicAdd(&cnt[bi[k]], 1);
                lcode[(size_t)bi[k] * TA + pos] = r * 4 + k;
                lw[(size_t)bi[k] * TA + pos] = sv[k] / sum * 2.5f;
            }
        }
        __builtin_amdgcn_wave_barrier();
    }
}

constexpr int MOE_LDS_LIST = LDS_BYTES;
constexpr int LDS_TOTAL = LDS_BYTES + 128 * 4 + 128 * 4 + 64 * 4;
struct ARowCode { const bf16_t* base; const int* codes; int mode; __device__ __forceinline__ const bf16_t* operator()(int m) const {
    const int c = codes[m];
    if (mode == 0) return base + (size_t)(c < 0 ? 0 : (c >> 2)) * D;
    return base + (size_t)(c < 0 ? 0 : (c >> 2) * 5 + (c & 3)) * DE; } };
__device__ __forceinline__ void moe_tstart(const P& p, int l, int* ts) {
    if (TIDX == 0) { const int* cnt = (const int*)(p.ws + WS_CTL) + l * NE; int a = 0; for (int e = 0; e < NE; ++e) { ts[e] = a; a += (cnt[e] + 127) >> 7; } ts[NE] = a; }
    __syncthreads();
}
__device__ void st_moe1(const P& p, int l, unsigned char* lds) {
    int* codes = (int*)(lds + MOE_LDS_LIST); float* wts = (float*)(codes + 128); int* ts = (int*)(wts + 128);
    const int nrows = l == 0 ? TA : TL;
    const int* cnt = (const int*)(p.ws + WS_CTL) + l * NE;
    const int* lcode = (const int*)(p.ws + WS_LCODE);
    const float* lw = (const float*)(p.ws + WS_LW);
    const bf16_t* xn2 = (const bf16_t*)(p.ws + WS_BUFA);
    bf16_t* hid = (bf16_t*)(p.ws + WS_HID);
    const bf16_t* wgu = (const bf16_t*)(p.ws + WS_WGU);
    moe_tstart(p, l, ts);
    const int nrt = ts[NE], nsh = nrows / 128, total = (nrt + nsh) * 2;
    const int lane = TIDX & 63, w = TIDX >> 6, wr = w >> 1, wc = w & 1, lr = lane & 31, lh = lane >> 5;
    for (int tile = BIDX; tile < total; tile += gridDim.x) {
        const int rt = tile >> 1, j = tile & 1;
        int e, m0, valid;
        if (rt < nrt) { e = 0; while (ts[e + 1] <= rt) ++e; m0 = (rt - ts[e]) * 128; valid = cnt[e] - m0; if (valid > 128) valid = 128; }
        else { e = NE; m0 = (rt - nrt) * 128; valid = 128; }
        __syncthreads();
        if (TIDX < 128) {
            const int m = TIDX;
            if (e < NE) { const bool ok = m < valid; codes[m] = ok ? lcode[(size_t)e * TA + m0 + m] : -1; wts[m] = ok ? lw[(size_t)e * TA + m0 + m] : 0.f; }
            else { codes[m] = (m0 + m) * 4; wts[m] = 1.f; }
        }
        __syncthreads();
        f32x16 acc[2][2];
        gemm_tile(acc, ARowCode{xn2, codes, 0}, wgu + (size_t)((e * 2 + j) * 128) * D, D, D, lds);
        const int unit = j * 64 + wc * 32 + lr;
#pragma unroll
        for (int mi = 0; mi < 2; ++mi)
#pragma unroll
            for (int r = 0; r < 16; ++r) {
                const int m = wr * 64 + mi * 32 + (r & 3) + 8 * (r >> 2) + 4 * lh;
                const int c = codes[m];
                if (c >= 0) {
                    const float g = acc[mi][0][r], u = acc[mi][1][r];
                    const size_t hrow = e < NE ? (size_t)(c >> 2) * 5 + (c & 3) : (size_t)(c >> 2) * 5 + 4;
                    hid[hrow * DE + unit] = f2bf(silu_f(g) * u * wts[m]);
                }
            }
    }
}
__device__ void st_moe2(const P& p, int l, unsigned char* lds) {
    int* codes = (int*)(lds + MOE_LDS_LIST); float* wts = (float*)(codes + 128); int* ts = (int*)(wts + 128);
    const int* cnt = (const int*)(p.ws + WS_CTL) + l * NE;
    const int* lcode = (const int*)(p.ws + WS_LCODE);
    const bf16_t* hid = (const bf16_t*)(p.ws + WS_HID);
    bf16_t* slab = (bf16_t*)(p.ws + WS_SLAB);
    const bf16_t* wd = (const bf16_t*)(p.ws + WS_WD);
    moe_tstart(p, l, ts);
    const int nrt = ts[NE], total = nrt * 8;
    for (int tile = BIDX; tile < total; tile += gridDim.x) {
        const int rt = tile >> 3, n0 = (tile & 7) * 128;
        int e = 0; while (ts[e + 1] <= rt) ++e;
        const int m0 = (rt - ts[e]) * 128; int valid = cnt[e] - m0; if (valid > 128) valid = 128;
        __syncthreads();
        if (TIDX < 128) { const int m = TIDX; codes[m] = m < valid ? lcode[(size_t)e * TA + m0 + m] : -1; }
        __syncthreads();
        f32x16 acc[2][2];
        gemm_tile(acc, ARowCode{hid, codes, 1}, wd + ((size_t)e * D + n0) * DE, DE, DE, lds);
        acc_foreach(acc, [&](int r, int c, float v) { const int code = codes[r]; if (code >= 0) slab[(size_t)code * D + n0 + c] = f2bf(v); });
    }
}
struct EpiMoeF { P p; int l; __device__ __forceinline__ void operator()(int r, int c, float v) const {
    const bf16_t* sl = (const bf16_t*)(p.ws + WS_SLAB) + (size_t)r * 4 * D + c;
    v += bf2f(sl[0]) + bf2f(sl[D]) + bf2f(sl[2 * D]) + bf2f(sl[3 * D]);
    const float g2 = mod_vec(p, l, row_bb(r), 5)[c];
    const float o = hmid_row(p, r)[c] + g2 * v;
    if (r < TL) p.out[(size_t)r * D + c] = o; else ((float*)(p.ws + WS_HC1))[(size_t)(r - TL) * D + c] = o; } };
__device__ void st_prep_moe(const P& p, int l) {
    bf16_t* wgu = (bf16_t*)(p.ws + WS_WGU);
    const int tot1 = 33 * 2 * 4 * 128 * 32;
    for (int idx = BIDX * NT + TIDX; idx < tot1; idx += gridDim.x * NT) {
        const int i = idx & 31; int q_ = idx >> 5; const int kc = q_ & 127; q_ >>= 7; const int q = q_ & 3; q_ >>= 2; const int j = q_ & 1; const int e = q_ >> 1;
        const int wc = q >> 1, ni = q & 1, unit = j * 64 + wc * 32 + i;
        const float* sp; size_t sk;
        if (e < NE) { sp = p.in[ni ? I_WEU : I_WEG] + ((size_t)(l * D + kc * 8) * NE + e) * DE + unit; sk = (size_t)NE * DE; }
        else { sp = p.in[ni ? I_WSU : I_WSG] + (size_t)(l * D + kc * 8) * DE + unit; sk = DE; }
        u32x4 o;
        o[0] = (unsigned)f2bf(sp[0]) | ((unsigned)f2bf(sp[sk]) << 16);
        o[1] = (unsigned)f2bf(sp[2 * sk]) | ((unsigned)f2bf(sp[3 * sk]) << 16);
        o[2] = (unsigned)f2bf(sp[4 * sk]) | ((unsigned)f2bf(sp[5 * sk]) << 16);
        o[3] = (unsigned)f2bf(sp[6 * sk]) | ((unsigned)f2bf(sp[7 * sk]) << 16);
        *(u32x4*)(wgu + ((size_t)(e * 2 + j) * 128 + q * 32 + i) * D + kc * 8) = o;
    }
    bf16_t* wd = (bf16_t*)(p.ws + WS_WD);
    const int tot2 = 33 * 16 * 1024;
    for (int idx = BIDX * NT + TIDX; idx < tot2; idx += gridDim.x * NT) {
        const int n = idx & 1023; int q_ = idx >> 10; const int kc = q_ & 15; const int e = q_ >> 4;
        const float* sp = (e < NE ? p.in[I_WED] + ((size_t)(l * NE + e) * DE + kc * 8) * D : p.in[I_WSD] + ((size_t)l * DE + kc * 8) * D) + n;
        u32x4 o;
        o[0] = (unsigned)f2bf(sp[0]) | ((unsigned)f2bf(sp[D]) << 16);
        o[1] = (unsigned)f2bf(sp[2 * D]) | ((unsigned)f2bf(sp[3 * D]) << 16);
        o[2] = (unsigned)f2bf(sp[4 * D]) | ((unsigned)f2bf(sp[5 * D]) << 16);
        o[3] = (unsigned)f2bf(sp[6 * D]) | ((unsigned)f2bf(sp[7 * D]) << 16);
        *(u32x4*)(wd + ((size_t)e * D + n) * DE + kc * 8) = o;
    }
}

struct SsmPar { float lre, lim, dt; };
__device__ __forceinline__ SsmPar ssm_par(const P& p, int l, int dir, int g, int pp) {
    const int pi = ((l * 2 + dir) * SG + g) * SP + pp;
    SsmPar r; r.lre = p.in[I_LRE][pi]; r.lim = p.in[I_LIM][pi]; r.dt = expf(p.in[I_LDT][(l * 2 + dir) * SG + g]); return r;
}
__device__ __forceinline__ float2 ssm_pow(const SsmPar& q, float e) {
    const float mag = expf(e * q.lre * q.dt), ang = e * (q.lim * q.dt);
    return make_float2(mag * cosf(ang), mag * sinf(ang));
}
__device__ __forceinline__ float2 ssm_f(const SsmPar& q) {
    const float2 lb = ssm_pow(q, 1.f);
    const float nr = lb.x - 1.f, ni = lb.y, den = q.lre * q.lre + q.lim * q.lim;
    return make_float2((nr * q.lre + ni * q.lim) / den, (ni * q.lre - nr * q.lim) / den);
}
__device__ __forceinline__ float2 cmul(float2 a, float2 b) { return make_float2(a.x * b.x - a.y * b.y, a.x * b.y + a.y * b.x); }
__device__ void st_ssm_kj(const P& p, float* lds) {
    float* lam = lds; float* Cc = lds + 128; float* Bb = Cc + 2048;
    float* kj = (float*)(p.ws + WS_KJ);
    const int t = TIDX;
    for (int item = BIDX; item < 64; item += gridDim.x) {
        const int l = item >> 5, g = (item >> 1) & 15, dir = item & 1;
        const int base = (l * 2 + dir) * SG + g;
        __syncthreads();
        if (t < 64) {
            const SsmPar q = ssm_par(p, l, dir, g, t);
            const float2 lb = ssm_pow(q, 1.f), f = ssm_f(q);
            lam[2 * t] = lb.x; lam[2 * t + 1] = lb.y;
            for (int h = 0; h < 16; ++h) {
                const size_t bi = ((size_t)base * SP + t) * 16 + h;
                const float2 bb = cmul(f, make_float2(p.in[I_BRE][bi], p.in[I_BIM][bi]));
                Bb[(t * 16 + h) * 2] = bb.x; Bb[(t * 16 + h) * 2 + 1] = bb.y;
            }
        }
        for (int i = t; i < 1024; i += NT) { const size_t ci = (size_t)base * 1024 + i; Cc[2 * i] = p.in[I_CRE][ci]; Cc[2 * i + 1] = p.in[I_CIM][ci]; }
        __syncthreads();
        const int ho = t >> 4, hi = t & 15;
        float acc[32];
#pragma unroll
        for (int j = 0; j < 32; ++j) acc[j] = 0.f;
        for (int pp = 0; pp < 64; ++pp) {
            float2 z = cmul(make_float2(Cc[(ho * 64 + pp) * 2], Cc[(ho * 64 + pp) * 2 + 1]), make_float2(Bb[(pp * 16 + hi) * 2], Bb[(pp * 16 + hi) * 2 + 1]));
            const float2 lb = make_float2(lam[2 * pp], lam[2 * pp + 1]);
#pragma unroll
            for (int j = 0; j < 32; ++j) { acc[j] += z.x; z = cmul(z, lb); }
        }
#pragma unroll
        for (int j = 0; j < 32; ++j) kj[((size_t)((l * 16 + g) * 2 + dir) * 32 + j) * 256 + ho * 16 + hi] = acc[j];
    }
    __syncthreads();
}
__device__ void st_prep_ssm(const P& p, int l) {
    bf16_t* wst = (bf16_t*)(p.ws + WS_WST);
    for (int idx = BIDX * NT + TIDX; idx < 16 * 256 * 64; idx += gridDim.x * NT) {
        const int kc = idx & 63, n = (idx >> 6) & 255, g = idx >> 14;
        const int dir = n >> 7, c = (n >> 6) & 1, pp = n & 63, s = kc >> 1, h0 = (kc & 1) * 8;
        const SsmPar q = ssm_par(p, l, dir, g, pp);
        const float2 coef = cmul(ssm_pow(q, dir == 0 ? (float)(31 - s) : (float)s), ssm_f(q));
        const size_t bi = ((size_t)((l * 2 + dir) * SG + g) * SP + pp) * 16 + h0;
        float v[8];
#pragma unroll
        for (int j = 0; j < 8; ++j) { const float2 z = cmul(coef, make_float2(p.in[I_BRE][bi + j], p.in[I_BIM][bi + j])); v[j] = c == 0 ? z.x : z.y; }
        u32x4 o; o[0] = cvt_pk_bf16(v[0], v[1]); o[1] = cvt_pk_bf16(v[2], v[3]); o[2] = cvt_pk_bf16(v[4], v[5]); o[3] = cvt_pk_bf16(v[6], v[7]);
        *(u32x4*)(wst + ((size_t)(g * 256 + n)) * 512 + kc * 8) = o;
    }
    bf16_t* kw = (bf16_t*)(p.ws + WS_KW);
    const float* kj = (const float*)(p.ws + WS_KJ);
    for (int idx = BIDX * NT + TIDX; idx < 16 * 512 * 96; idx += gridDim.x * NT) {
        const int kc = idx % 96, n = (idx / 96) & 511, g = idx / (96 * 512);
        const int tau = n >> 4, ho = n & 15;
        float v[8];
        if (kc < 64) {
            const int s = kc >> 1, hi0 = (kc & 1) * 8;
#pragma unroll
            for (int j = 0; j < 8; ++j) {
                float a = 0.f;
                if (s <= tau) a += kj[((size_t)((l * 16 + g) * 2 + 0) * 32 + (tau - s)) * 256 + ho * 16 + hi0 + j];
                if (s >= tau) a += kj[((size_t)((l * 16 + g) * 2 + 1) * 32 + (s - tau)) * 256 + ho * 16 + hi0 + j];
                if (s == tau && ho == hi0 + j) a += p.in[I_SD][l * DSSM + g * 16 + ho];
                v[j] = a;
            }
        } else {
            const int kk = (kc - 64) * 8, dir = kk >> 7, c = (kk >> 6) & 1, p0 = kk & 63;
            const float e = dir == 0 ? (float)(tau + 1) : (float)(32 - tau);
#pragma unroll
            for (int j = 0; j < 8; ++j) {
                const SsmPar q = ssm_par(p, l, dir, g, p0 + j);
                const size_t ci = ((size_t)((l * 2 + dir) * SG + g) * 16 + ho) * SP + p0 + j;
                const float2 z = cmul(make_float2(p.in[I_CRE][ci], p.in[I_CIM][ci]), ssm_pow(q, e));
                v[j] = c == 0 ? z.x : -z.y;
            }
        }
        u32x4 o; o[0] = cvt_pk_bf16(v[0], v[1]); o[1] = cvt_pk_bf16(v[2], v[3]); o[2] = cvt_pk_bf16(v[4], v[5]); o[3] = cvt_pk_bf16(v[6], v[7]);
        *(u32x4*)(kw + ((size_t)(g * 512 + n)) * 768 + kc * 8) = o;
    }
}
__device__ void st_ssm_egemm(const P& p, unsigned char* lds) {
    const bf16_t* ua = (const bf16_t*)(p.ws + WS_UA);
    const bf16_t* wst = (const bf16_t*)(p.ws + WS_WST);
    float* E = (float*)(p.ws + WS_E);
    for (int tile = BIDX; tile < 160; tile += gridDim.x) {
        const int nt = tile & 1, mt = (tile >> 1) % 5, g = tile / 10;
        f32x16 acc[2][2];
        gemm_tile(acc, ARowPlain{ua + (size_t)(g * 640 + mt * 128) * 768, 768}, wst + (size_t)(g * 256 + nt * 128) * 512, 512, 512, lds);
        acc_foreach(acc, [&](int r, int c, float v) { E[(size_t)(g * 640 + mt * 128 + r) * 256 + nt * 128 + c] = v; });
    }
}
__device__ void st_ssm_carry(const P& p, int l) {
    bf16_t* ua = (bf16_t*)(p.ws + WS_UA);
    const float* E = (const float*)(p.ws + WS_E);
    for (int idx = BIDX * NT + TIDX; idx < NB * 16 * 2 * 64; idx += gridDim.x * NT) {
        const int pp = idx & 63, dir = (idx >> 6) & 1, g = (idx >> 7) & 15, b = idx >> 11;
        const float2 l32 = ssm_pow(ssm_par(p, l, dir, g, pp), 32.f);
        float2 S = make_float2(0.f, 0.f);
        for (int s0 = 0; s0 < 72; s0 += 8) {
            int ch[8]; float er[8], ei[8];
#pragma unroll
            for (int j = 0; j < 8; ++j) {
                const int step = s0 + j;
                if (dir == 0) ch[j] = step < 8 ? 512 + b * 8 + step : b * 64 + (step - 8);
                else ch[j] = step < 8 ? 512 + b * 8 + (7 - step) : b * 64 + (63 - (step - 8));
                const float* e = E + (size_t)(g * 640 + ch[j]) * 256 + dir * 128 + pp;
                er[j] = e[0]; ei[j] = e[64];
            }
#pragma unroll
            for (int j = 0; j < 8; ++j) {
                bf16_t* o = ua + (size_t)(g * 640 + ch[j]) * 768 + 512 + dir * 128 + pp;
                o[0] = f2bf(S.x); o[64] = f2bf(S.y);
                S = cmul(l32, S); S.x += er[j]; S.y += ei[j];
            }
        }
    }
}
__device__ void st_ssm_ygemm(const P& p, int l, unsigned char* lds) {
    const bf16_t* ua = (const bf16_t*)(p.ws + WS_UA);
    const bf16_t* kw = (const bf16_t*)(p.ws + WS_KW);
    bf16_t* G = (bf16_t*)(p.ws + WS_G);
    const int nmt = l == 0 ? 5 : 4;
    for (int tile = BIDX; tile < 16 * nmt * 4; tile += gridDim.x) {
        const int nt = tile & 3, mt = (tile >> 2) % nmt, g = tile / (4 * nmt);
        f32x16 acc[2][2];
        gemm_tile(acc, ARowPlain{ua + (size_t)(g * 640 + mt * 128) * 768, 768}, kw + (size_t)(g * 512 + nt * 128) * 768, 768, 768, lds);
        acc_foreach(acc, [&](int r, int c, float v) {
            const int chunk = mt * 128 + r, n = nt * 128 + c;
            if (chunk < TA / 32) G[(size_t)(chunk * 32 + (n >> 4)) * DSSM + g * 16 + (n & 15)] = f2bf(gelu_f(v)); });
    }
}
struct EpiGlu2 { const bf16_t* G; bf16_t* mix; const float* bias; __device__ __forceinline__ void operator()(int r, int c, float v) const {
    mix[(size_t)r * D + 256 + c] = f2bf(bf2f(G[(size_t)r * DSSM + c]) * sigmoid_f(v + bias[c])); } };

constexpr float QSCALE = 0.125f * 1.4426950408889634f;
__device__ void st_rope_table(const P& p) {
    float2* tab = (float2*)(p.ws + WS_ROPE);
    for (int idx = BIDX * NT + TIDX; idx < L * 32; idx += gridDim.x * NT) {
        const int t = idx >> 5, a = (idx >> 4) & 1, i = idx & 15;
        const float pos = a == 0 ? (float)(t / 64) : (float)(t % 64);
        const float ang = pos * powf(10000.f, -(float)i / 16.f);
        tab[idx] = make_float2(cosf(ang), sinf(ang));
    }
}
__device__ void st_inproj(const P& p, int l, unsigned char* lds) {
    const bf16_t* A = (const bf16_t*)(p.ws + WS_BUFA);
    const bf16_t* Bt = (const bf16_t*)(p.ws + WS_WTIN);
    bf16_t* pc = (bf16_t*)(p.ws + WS_PC);
    bf16_t* ua = (bf16_t*)(p.ws + WS_UA);
    bf16_t* qb = (bf16_t*)(p.ws + WS_QB);
    bf16_t* kb = (bf16_t*)(p.ws + WS_KB);
    bf16_t* vt = (bf16_t*)(p.ws + WS_VT);
    const float2* rope = (const float2*)(p.ws + WS_ROPE);
    const int lane = TIDX & 63, w = TIDX >> 6, wr = w >> 1, wc = w & 1, lr = lane & 31, lh = lane >> 5;
    constexpr int TN = DIN / 128;
    for (int tile = BIDX; tile < (TA / 128) * TN; tile += gridDim.x) {
        const int tn = tile % TN, m0 = (tile / TN) * 128, n0 = tn * 128;
        f32x16 acc[2][2];
        gemm_tile(acc, ARowPlain{A + (size_t)m0 * D, D}, Bt + (size_t)n0 * D, D, D, lds);
        if (tn < 6) {
            acc_foreach(acc, [&](int r, int c, float v) { pc[(size_t)(m0 + r) * 768 + n0 + c] = f2bf(v); });
        } else if (tn < 8) {
            acc_foreach(acc, [&](int r, int c, float v) { const int row = m0 + r, g = (tn - 6) * 8 + (c >> 4);
                ua[(size_t)(g * 640 + (row >> 5)) * 768 + (row & 31) * 16 + (c & 15)] = f2bf(v); });
        } else if (tn < 13) {
            const bool isq = tn < 12;
            const float* gain = (isq ? p.in[I_QG] : p.in[I_KG]) + l * 64;
            const float g0 = gain[lr], g1 = gain[32 + lr];
            const bool lat = m0 < TL;
            const int i16 = lr & 15; const bool hi = (lr >> 4) & 1;
            const float osc = isq ? QSCALE : 1.f;
#pragma unroll
            for (int mi = 0; mi < 2; ++mi)
#pragma unroll
                for (int r = 0; r < 16; ++r) {
                    const int row = m0 + wr * 64 + mi * 32 + (r & 3) + 8 * (r >> 2) + 4 * lh;
                    float x0 = acc[mi][0][r], x1 = acc[mi][1][r];
                    float ss = x0 * x0 + x1 * x1;
                    ss += __shfl_xor(ss, 1); ss += __shfl_xor(ss, 2); ss += __shfl_xor(ss, 4); ss += __shfl_xor(ss, 8); ss += __shfl_xor(ss, 16);
                    const float rinv = rsqrtf(ss * (1.f / 64.f) + 1e-6f);
                    x0 *= rinv * g0; x1 *= rinv * g1;
                    if (lat) {
                        const int t = row & (L - 1);
                        const float p0 = __shfl_xor(x0, 16), p1 = __shfl_xor(x1, 16);
                        const float2 cs0 = rope[(t * 2 + 0) * 16 + i16], cs1 = rope[(t * 2 + 1) * 16 + i16];
                        x0 = x0 * cs0.x + (hi ? p0 * cs0.y : -p0 * cs0.y);
                        x1 = x1 * cs1.x + (hi ? p1 * cs1.y : -p1 * cs1.y);
                    }
                    if (isq) { bf16_t* o = qb + (size_t)row * DATT + ((tn - 8) * 2 + wc) * 64 + lr; o[0] = f2bf(x0 * osc); o[32] = f2bf(x1 * osc); }
                    else { bf16_t* o = kb + (size_t)row * 128 + wc * 64 + lr; o[0] = f2bf(x0); o[32] = f2bf(x1); }
                }
        } else {
            const bool lat = m0 < TL;
#pragma unroll
            for (int mi = 0; mi < 2; ++mi)
#pragma unroll
                for (int ni = 0; ni < 2; ++ni)
#pragma unroll
                    for (int rg = 0; rg < 4; ++rg) {
                        const int row = m0 + wr * 64 + mi * 32 + 8 * rg + 4 * lh;
                        const int d = ni * 32 + lr, g = wc;
                        uint2 o; o.x = cvt_pk_bf16(acc[mi][ni][4 * rg], acc[mi][ni][4 * rg + 1]); o.y = cvt_pk_bf16(acc[mi][ni][4 * rg + 2], acc[mi][ni][4 * rg + 3]);
                        size_t off;
                        if (lat) { const int b = row >> 11, t = row & (L - 1); off = ((size_t)((b * 2 + g) * 64 + d)) * L + t; }
                        else { const int rc = row - TL, b = rc >> 8, t = rc & (LC - 1); off = (size_t)NB * 2 * 64 * L + ((size_t)((b * 2 + g) * 64 + d)) * LC + t; }
                        *(uint2*)(vt + off) = o;
                    }
        }
    }
}

constexpr int AT_KROWB = 144, AT_VROWB = 264, AT_VOFF = 128 * AT_KROWB;
__device__ void st_attn2(const P& p, int l, unsigned char* lds, int part, int nparts) {
    const bf16_t* qb = (const bf16_t*)(p.ws + WS_QB);
    const bf16_t* kb = (const bf16_t*)(p.ws + WS_KB);
    const bf16_t* vt = (const bf16_t*)(p.ws + WS_VT);
    bf16_t* mix = (bf16_t*)(p.ws + WS_BUFA);
    const int t = TIDX, lane = t & 63, w = t >> 6, lr = lane & 31, lh = lane >> 5;
    const int nitems = NB * 16 * NQH + (l == 0 ? NB * 2 * NQH : 0);
    for (int item = BIDX * nparts + part; item < nitems; item += gridDim.x * nparts) {
        const bool isctx = item >= NB * 16 * NQH;
        int b, qblk, hq;
        if (!isctx) { hq = item & 7; qblk = (item >> 3) & 15; b = item >> 7; }
        else { const int it = item - NB * 16 * NQH; hq = it & 7; qblk = (it >> 3) & 1; b = it >> 4; }
        const int g = hq >> 2;
        const int rq0 = isctx ? TL + b * LC + qblk * 128 : b * L + qblk * 128;
        const int qrow = rq0 + w * 32 + lr;
        bf16x8 qf[4];
#pragma unroll
        for (int s4 = 0; s4 < 4; ++s4) qf[s4] = *(const bf16x8*)(qb + (size_t)qrow * DATT + hq * 64 + s4 * 16 + lh * 8);
        float m = p.in[I_SINK][l * NQH + hq] * 1.4426950408889634f;
        float lsum = lh == 0 ? 1.f : 0.f;
        f32x16 o0, o1;
        float zf = 0.f; asm volatile("" : "+v"(zf));
#pragma unroll
        for (int r = 0; r < 16; ++r) { o0[r] = zf; o1[r] = zf; }
        const int nkb = isctx ? 2 : 5;
        for (int kbi = 0; kbi < nkb; ++kbi) {
            bool win; int kblk;
            if (isctx) { win = false; kblk = kbi; } else if (kbi < 3) { win = true; kblk = qblk - 1 + kbi; } else { win = false; kblk = kbi - 3; }
            if (win && (kblk < 0 || kblk > 15)) continue;
            const bf16_t* ksrc = kb + (size_t)(win ? b * L + kblk * 128 : TL + b * LC + kblk * 128) * 128 + g * 64;
            const bf16_t* vsrc = win ? vt + (size_t)((b * 2 + g) * 64) * L + kblk * 128 : vt + (size_t)NB * 2 * 64 * L + (size_t)((b * 2 + g) * 64) * LC + kblk * 128;
            const int vld = win ? L : LC;
            __syncthreads();
#pragma unroll
            for (int i = 0; i < 4; ++i) {
                const int c = t + 256 * i;
                const int row = c >> 3, kc = c & 7;
                *(u32x4*)(lds + row * AT_KROWB + kc * 16) = *(const u32x4*)(ksrc + (size_t)row * 128 + kc * 8);
                const int d = c >> 4, ch = c & 15;
                const u32x4 vv = *(const u32x4*)(vsrc + (size_t)d * vld + ch * 8);
                uint2 lo, hi2; lo.x = vv[0]; lo.y = vv[1]; hi2.x = vv[2]; hi2.y = vv[3];
                *(uint2*)(lds + AT_VOFF + d * AT_VROWB + ch * 16) = lo;
                *(uint2*)(lds + AT_VOFF + d * AT_VROWB + ch * 16 + 8) = hi2;
            }
            __syncthreads();
            const int i0 = qblk * 128 + w * 32;
            for (int sub = 0; sub < 4; ++sub) {
                bool partial = false;
                if (win) {
                    const int j0 = kblk * 128 + sub * 32;
                    if (j0 > i0 + 31 + 128 || j0 + 31 < i0 - 128) continue;
                    partial = !(j0 >= i0 + 31 - 128 && j0 + 31 <= i0 + 128);
                }
                f32x16 sT;
#pragma unroll
                for (int r = 0; r < 16; ++r) sT[r] = zf;
#pragma unroll
                for (int s4 = 0; s4 < 4; ++s4) {
                    const bf16x8 kf = *(const bf16x8*)(lds + (sub * 32 + lr) * AT_KROWB + s4 * 32 + lh * 16);
                    sT = __builtin_amdgcn_mfma_f32_32x32x16_bf16(kf, qf[s4], sT, 0, 0, 0);
                }
                if (partial) {
                    const int j0 = kblk * 128 + sub * 32, qi = i0 + lr;
#pragma unroll
                    for (int r = 0; r < 16; ++r) { const int dj = j0 + (r & 3) + 8 * (r >> 2) + 4 * lh - qi; if (dj > 128 || dj < -128) sT[r] = -1e30f; }
                }
                float mt = sT[0];
#pragma unroll
                for (int r = 1; r < 16; ++r) mt = fmaxf(mt, sT[r]);
                mt = fmaxf(mt, __shfl_xor(mt, 32));
                const float mn = fmaxf(m, mt);
                const float alpha = __builtin_amdgcn_exp2f(m - mn);
                m = mn;
                float ps = 0.f;
#pragma unroll
                for (int r = 0; r < 16; ++r) { sT[r] = __builtin_amdgcn_exp2f(sT[r] - mn); ps += sT[r]; }
                lsum = lsum * alpha + ps;
#pragma unroll
                for (int r = 0; r < 16; ++r) { o0[r] *= alpha; o1[r] *= alpha; }
#pragma unroll
                for (int s2 = 0; s2 < 2; ++s2) {
                    u32x4 pk;
                    pk[0] = cvt_pk_bf16(sT[8 * s2 + 0], sT[8 * s2 + 1]); pk[1] = cvt_pk_bf16(sT[8 * s2 + 2], sT[8 * s2 + 3]);
                    pk[2] = cvt_pk_bf16(sT[8 * s2 + 4], sT[8 * s2 + 5]); pk[3] = cvt_pk_bf16(sT[8 * s2 + 6], sT[8 * s2 + 7]);
                    const bf16x8 pf = __builtin_bit_cast(bf16x8, pk);
                    const int kofs = (sub * 32 + s2 * 16 + lh * 4) * 2;
                    {
                        const uint2 a = *(const uint2*)(lds + AT_VOFF + lr * AT_VROWB + kofs), c2 = *(const uint2*)(lds + AT_VOFF + lr * AT_VROWB + kofs + 16);
                        u32x4 vv; vv[0] = a.x; vv[1] = a.y; vv[2] = c2.x; vv[3] = c2.y;
                        o0 = __builtin_amdgcn_mfma_f32_32x32x16_bf16(__builtin_bit_cast(bf16x8, vv), pf, o0, 0, 0, 0);
                    }
                    {
                        const uint2 a = *(const uint2*)(lds + AT_VOFF + (32 + lr) * AT_VROWB + kofs), c2 = *(const uint2*)(lds + AT_VOFF + (32 + lr) * AT_VROWB + kofs + 16);
                        u32x4 vv; vv[0] = a.x; vv[1] = a.y; vv[2] = c2.x; vv[3] = c2.y;
                        o1 = __builtin_amdgcn_mfma_f32_32x32x16_bf16(__builtin_bit_cast(bf16x8, vv), pf, o1, 0, 0, 0);
                    }
                }
            }
        }
        lsum += __shfl_xor(lsum, 32);
        const float inv = 1.f / lsum;
        bf16_t* orow = mix + (size_t)qrow * D + 512 + hq * 64;
#pragma unroll
        for (int rg = 0; rg < 4; ++rg) {
            uint2 a; a.x = cvt_pk_bf16(o0[4 * rg] * inv, o0[4 * rg + 1] * inv); a.y = cvt_pk_bf16(o0[4 * rg + 2] * inv, o0[4 * rg + 3] * inv);
            *(uint2*)(orow + 8 * rg + 4 * lh) = a;
            uint2 c2; c2.x = cvt_pk_bf16(o1[4 * rg] * inv, o1[4 * rg + 1] * inv); c2.y = cvt_pk_bf16(o1[4 * rg + 2] * inv, o1[4 * rg + 3] * inv);
            *(uint2*)(orow + 32 + 8 * rg + 4 * lh) = c2;
        }
    }
}

constexpr int STAGES_PER_LAYER = 11;
constexpr int N_STAGES = 1 + 2 * STAGES_PER_LAYER;

__device__ __forceinline__ void run_stage(const P& p, int s, unsigned char* ldsb) {
    float* lds = (float*)ldsb;
    if (s == 0) { st_mod(p, lds); st_rope_table(p); st_ssm_kj(p, lds); return; }
    const int l = (s - 1) / STAGES_PER_LAYER, k = (s - 1) % STAGES_PER_LAYER;
    switch (k) {
    case 0: st_rbias(p, l, lds); st_norm(p, l, 0); st_prep_dense(p, l); st_prep_moe(p, l); st_prep_ssm(p, l); break;
    case 1: st_inproj(p, l, ldsb); break;
    case 2: st_ssm_egemm(p, ldsb); st_conv(p, l); st_attn2(p, l, ldsb, 0, 4); break;
    case 3: st_ssm_carry(p, l); st_attn2(p, l, ldsb, 1, 4); break;
    case 4: st_ssm_ygemm(p, l, ldsb); st_attn2(p, l, ldsb, 2, 4); break;
    case 5: gemm_stage((const bf16_t*)(p.ws + WS_G), DSSM, (const bf16_t*)(p.ws + WS_WTGLU), DSSM, l == 0 ? TA : TL, DSSM, DSSM,
                       EpiGlu2{(const bf16_t*)(p.ws + WS_G), (bf16_t*)(p.ws + WS_BUFA), p.in[I_BGLU] + l * DSSM}, ldsb);
            st_attn2(p, l, ldsb, 3, 4); break;
    case 6: gemm_stage((const bf16_t*)(p.ws + WS_BUFA), D, (const bf16_t*)(p.ws + WS_WTOUT), D, l == 0 ? TA : TL, D, D, EpiOut{p, l}, ldsb); break;
    case 7: st_router2(p, l, ldsb); break;
    case 8: st_moe1(p, l, ldsb); break;
    case 9: st_moe2(p, l, ldsb); break;
    case 10: gemm_stage((const bf16_t*)(p.ws + WS_HID) + 4 * DE, 5 * DE, (const bf16_t*)(p.ws + WS_WD) + (size_t)32 * D * DE, DE, l == 0 ? TA : TL, D, DE, EpiMoeF{p, l}, ldsb); break;
    }
}


#define XB_TMO      128
#define XB_XCNT(j)  (256  + 64 * (j))
#define XB_XSUB(j)  (1280 + 64 * (j))
#define XB_XGEN(j)  (2304 + 64 * (j))
#define XB_TOP      3328
#define XB_TOPGEN   3392
#define XCD_BAR_WORDS 3456
#define XB_SPIN_CAP (1u << 22)
#define LAS __attribute__((address_space(3)))
__device__ __forceinline__ unsigned xb_ld(unsigned* p)              { return __hip_atomic_load(p, __ATOMIC_RELAXED, __HIP_MEMORY_SCOPE_AGENT); }
__device__ __forceinline__ unsigned xb_add(unsigned* p, unsigned v) { return __hip_atomic_fetch_add(p, v, __ATOMIC_RELAXED, __HIP_MEMORY_SCOPE_AGENT); }
__device__ __forceinline__ unsigned xb_xcc_id() { return (unsigned)__builtin_amdgcn_s_getreg((3 << 11) | 20) & 0xFu; }
#define XB_SPIN(cond, bar) do { unsigned _sp = 0; while (cond) { __builtin_amdgcn_s_sleep(1); \
    if ((++_sp & 255u) == 0u) { if (xb_ld(&(bar)[XB_TMO])) break; if (_sp > XB_SPIN_CAP) { atomicAdd(&(bar)[XB_TMO], 1u); break; } } } } while (0)
struct XcdBarrier { unsigned* bar; unsigned x; volatile LAS unsigned* st; };
__device__ __forceinline__ XcdBarrier xcd_barrier_post(unsigned* bar, volatile LAS unsigned* st) {
    XcdBarrier b; b.bar = bar; b.x = xb_xcc_id(); b.st = st;
    if (threadIdx.x == 0) (void)xb_add(&bar[XB_XCNT(b.x)], 1u);
    return b;
}
__device__ __forceinline__ void xcd_barrier_complete(unsigned* bar, unsigned x, unsigned& nloc, unsigned& nx) {
    const unsigned G = gridDim.x * gridDim.y * gridDim.z;
    unsigned sum, cnt, mine, sp = 0u;
    for (;;) {
        sum = 0u; cnt = 0u; mine = 0u;
#pragma unroll
        for (unsigned j = 0; j < 16; ++j) { const unsigned c = xb_ld(&bar[XB_XCNT(j)]); sum += c; cnt += (c > 0u) ? 1u : 0u; mine = (j == x) ? c : mine; }
        if (sum == G) break;
        __builtin_amdgcn_s_sleep(1);
        if ((++sp & 255u) == 0u) { if (xb_ld(&bar[XB_TMO])) break; if (sp > XB_SPIN_CAP) { atomicAdd(&bar[XB_TMO], 1u); break; } }
    }
    nloc = mine > 0u ? mine : 1u; nx = cnt > 0u ? cnt : 1u;
}
__device__ __forceinline__ void xcd_barrier(const XcdBarrier& b) {
    asm volatile("s_waitcnt vmcnt(0)" ::: "memory");
    __syncthreads();
    if (threadIdx.x == 0) {
        unsigned* bar = b.bar;
        __builtin_amdgcn_s_waitcnt(0);
        unsigned nloc = b.st[0], nx = b.st[1];
        if (nloc == 0u) { xcd_barrier_complete(bar, b.x, nloc, nx); b.st[0] = nloc; b.st[1] = nx; }
        const unsigned old = xb_add(&bar[XB_XSUB(b.x)], 1u);
        const unsigned gen = old / nloc;
        if (old + 1u == (gen + 1u) * nloc) {
            __builtin_amdgcn_fence(__ATOMIC_RELEASE, "agent");
            asm volatile("s_waitcnt vmcnt(0)" ::: "memory");
            const unsigned og = xb_add(&bar[XB_TOP], 1u);
            const unsigned tg = og / nx;
            if (og + 1u == (tg + 1u) * nx) xb_add(&bar[XB_TOPGEN], 1u);
            else XB_SPIN(xb_ld(&bar[XB_TOPGEN]) == tg, bar);
            __builtin_amdgcn_fence(__ATOMIC_ACQUIRE, "agent");
            xb_add(&bar[XB_XGEN(b.x)], 1u);
            asm volatile("s_waitcnt vmcnt(0)" ::: "memory");
        } else {
            XB_SPIN(xb_ld(&bar[XB_XGEN(b.x)]) == gen, bar);
            __builtin_amdgcn_fence(__ATOMIC_ACQUIRE, "agent");
            asm volatile("s_waitcnt vmcnt(0)" ::: "memory");
        }
    }
    __syncthreads();
}
constexpr size_t WS_XBAR = 4096;

template <int S> __device__ __forceinline__ void run_all(const P& p, unsigned char* lds, const XcdBarrier& xb) {
    run_stage(p, S, lds);
    if constexpr (S + 1 < N_STAGES) {
        if constexpr (S == 0) cg::this_grid().sync();
        else xcd_barrier(xb);
        run_all<S + 1>(p, lds, xb);
    }
}
__global__ void __launch_bounds__(NT) mega(P p) {
    __shared__ __attribute__((aligned(16))) unsigned char lds[LDS_TOTAL + 16];
    volatile LAS unsigned* st = (volatile LAS unsigned*)(lds + LDS_TOTAL);
    if (threadIdx.x == 0) { st[0] = 0u; st[1] = 0u; }
    __syncthreads();
    const XcdBarrier xb = xcd_barrier_post((unsigned*)(p.ws + WS_CTL + WS_XBAR), st);
    run_all<0>(p, lds, xb);
}

extern "C" void kernel_launch(void* const* d_in, const int* in_sizes, int n_in, void* d_out, int out_size, void* d_ws, size_t ws_size, hipStream_t stream) {
    if (n_in != N_IN || ws_size < WS_END) { fprintf(stderr, "kernel_launch: unexpected n_in %d or ws_size %zu (< %zu)\n", n_in, ws_size, (size_t)WS_END); return; }
    P p{};
    for (int i = 0; i < N_IN; ++i) p.in[i] = (const float*)d_in[i];
    p.out = (float*)d_out; p.ws = (unsigned char*)d_ws;
    static int grid_blocks = 0;
    if (!grid_blocks) {
        int dev = 0, cus = 0, per_cu = 0;
        hipGetDevice(&dev);
        hipDeviceGetAttribute(&cus, hipDeviceAttributeMultiprocessorCount, dev);
        hipOccupancyMaxActiveBlocksPerMultiprocessor(&per_cu, (const void*)mega, NT, 0);
        if (per_cu < 1) per_cu = 1;
        if (per_cu > 2) per_cu = 2;
        grid_blocks = cus * per_cu;
    }
    hipMemsetAsync((char*)d_ws + WS_CTL, 0, 65536, stream);
    void* args[] = {&p};
    hipError_t e = hipLaunchCooperativeKernel((const void*)mega, dim3(grid_blocks), dim3(NT), args, 0, stream);
    if (e != hipSuccess) fprintf(stderr, "cooperative launch failed: %s (grid %d)\n", hipGetErrorString(e), grid_blocks);
}
```

```cpp
#include <hip/hip_runtime.h>
#include <hip/hip_cooperative_groups.h>
#include <cstdio>
#include <cstdint>
namespace cg = cooperative_groups;
__device__ __forceinline__ int tid_opaque() { int t = threadIdx.x; asm volatile("" : "+v"(t)); return t; }
__device__ __forceinline__ int bid_opaque() { int b = blockIdx.x; asm volatile("" : "+s"(b)); return b; }
#define TIDX tid_opaque()
#define BIDX bid_opaque()

constexpr int D = 1024, NB = 8, L = 2048, LC = 256;
constexpr int TL = NB * L, TC = NB * LC, TA = TL + TC;
constexpr int DIN = 1792, DCONV = 256, DSSM = 256, DATT = 512;
constexpr int NQH = 8, NKVH = 2, HD = 64;
constexpr int COL_U = 768, COL_Q = 1024, COL_K = 1536, COL_V = 1664;
constexpr int NE = 32, TOPK = 4, DE = 128;
constexpr int SG = 16, SH = 16, SP = 64;
constexpr int NT = 256;

enum { I_X = 0, I_C, I_CTX, I_CCTX, I_WMOD, I_BMOD, I_N1G, I_N2G, I_WIN, I_CONVW, I_LRE, I_LIM, I_LDT, I_BRE, I_BIM, I_CRE, I_CIM,
       I_SD, I_WGLU, I_BGLU, I_QG, I_KG, I_SINK, I_WOUT, I_RW, I_RB, I_WEG, I_WEU, I_WED, I_WSG, I_WSU, I_WSD, N_IN };

typedef unsigned short bf16_t;
constexpr size_t WS_CTL = 0;
constexpr size_t WS_MOD = 65536;
constexpr size_t WS_ZERO_END = WS_MOD + (size_t)2 * 9 * 6 * D * 4;
constexpr size_t WS_RBIAS = 524288;
constexpr size_t WS_ROPE = WS_RBIAS + 4096;
constexpr size_t WS_KJ = WS_ROPE + 524288;
constexpr size_t WS_R1 = WS_KJ + 2097152;
constexpr size_t WS_BUFA = WS_R1;
constexpr size_t WS_PC = WS_BUFA + (size_t)TA * D * 2;
constexpr size_t WS_UA = WS_PC + (size_t)TA * 768 * 2;
constexpr size_t WS_E = WS_UA + (size_t)16 * 640 * 768 * 2;
constexpr size_t WS_G = WS_E + (size_t)16 * 640 * 256 * 4;
constexpr size_t WS_QB = WS_G + (size_t)TA * DSSM * 2;
constexpr size_t WS_KB = WS_QB + (size_t)TA * DATT * 2;
constexpr size_t WS_VT = WS_KB + (size_t)TA * 128 * 2;
constexpr size_t WS_SLAB = WS_R1;
constexpr size_t WS_HID = WS_SLAB + (size_t)TA * 4 * D * 2;
constexpr size_t WS_HC1 = WS_HID + (size_t)TA * 5 * DE * 2;
constexpr size_t WS_HCMID = WS_HC1 + (size_t)TC * D * 4;
constexpr size_t WS_LCODE = WS_HCMID + (size_t)TC * D * 4;
constexpr size_t WS_LW = WS_LCODE + (size_t)NE * TA * 4;
constexpr size_t WS_WTIN = WS_LW + (size_t)NE * TA * 4;
constexpr size_t WS_WTOUT = WS_WTIN + (size_t)DIN * D * 2;
constexpr size_t WS_WTGLU = WS_WTOUT + (size_t)D * D * 2;
constexpr size_t WS_WGU = WS_WTGLU + (size_t)DSSM * DSSM * 2;
constexpr size_t WS_WD = WS_WGU + (size_t)33 * 256 * D * 2;
constexpr size_t WS_WST = WS_WD + (size_t)33 * D * DE * 2;
constexpr size_t WS_KW = WS_WST + (size_t)16 * 256 * 512 * 2;
constexpr size_t WS_END = WS_KW + (size_t)16 * 512 * 768 * 2;
static_assert(WS_VT + (size_t)TA * 128 * 2 <= WS_HID, "overlay");
static_assert(WS_ZERO_END <= WS_RBIAS, "zero region");
static_assert(WS_END <= 268435456, "workspace too large");

struct P {
    const float* in[N_IN];
    float* out;
    unsigned char* ws;
};

__device__ __forceinline__ bf16_t f2bf(float f) { unsigned u = __float_as_uint(f); u += 0x7FFFu + ((u >> 16) & 1u); return (bf16_t)(u >> 16); }
__device__ __forceinline__ float bf2f(bf16_t b) { return __uint_as_float((unsigned)b << 16); }
__device__ __forceinline__ unsigned cvt_pk_bf16(float lo, float hi) { unsigned r; asm("v_cvt_pk_bf16_f32 %0, %1, %2" : "=v"(r) : "v"(lo), "v"(hi)); return r; }
typedef __attribute__((ext_vector_type(4))) float f32x4;
struct BfPtr { const bf16_t* p; __device__ __forceinline__ float operator[](long i) const { return bf2f(p[i]); }
               __device__ __forceinline__ BfPtr operator+(long o) const { return BfPtr{p + o}; } };
__device__ __forceinline__ float silu_f(float x) { return x / (1.f + expf(-x)); }
__device__ __forceinline__ float sigmoid_f(float x) { return 1.f / (1.f + expf(-x)); }
__device__ __forceinline__ float gelu_f(float x) { return 0.5f * x * (1.f + tanhf(0.7978845608028654f * (x + 0.044715f * x * x * x))); }
__device__ __forceinline__ float wave_sum(float v) {
#pragma unroll
    for (int o = 32; o > 0; o >>= 1) v += __shfl_xor(v, o);
    return v;
}
__device__ __forceinline__ int row_bb(int r) { return r < TL ? r / L : 8; }
__device__ __forceinline__ const float* h_row(const P& p, int l, int r) {
    if (r < TL) return (l == 0 ? p.in[I_X] : p.out) + (size_t)r * D;
    return (l == 0 ? p.in[I_CTX] : (const float*)(p.ws + WS_HC1)) + (size_t)(r - TL) * D;
}
__device__ __forceinline__ float* hmid_row(const P& p, int r) {
    if (r < TL) return p.out + (size_t)r * D;
    return (float*)(p.ws + WS_HCMID) + (size_t)(r - TL) * D;
}
__device__ __forceinline__ const float* mod_vec(const P& p, int l, int bb, int chunk) {
    return (const float*)(p.ws + WS_MOD) + ((size_t)(l * 9 + bb) * 6 + chunk) * D;
}

__device__ __forceinline__ void st_mod(const P& p, float* lds) {
    float* red = lds + 9 * D;
    for (int i = TIDX; i < 9 * D; i += NT) {
        const int bb = i / D, k = i % D;
        const float c = bb < 8 ? p.in[I_C][bb * D + k] : p.in[I_CCTX][k];
        lds[i] = silu_f(c);
    }
    __syncthreads();
    float* mod = (float*)(p.ws + WS_MOD);
    const int col = TIDX & 31, ks = TIDX >> 5;
    for (int item = BIDX; item < 2 * 6 * D / 32; item += gridDim.x) {
        const int l = item / (6 * D / 32), j = (item % (6 * D / 32)) * 32 + col;
        const float* w = p.in[I_WMOD] + (size_t)l * D * 6 * D + j;
        float acc[9];
#pragma unroll
        for (int bb = 0; bb < 9; ++bb) acc[bb] = 0.f;
        for (int k = ks * 128; k < ks * 128 + 128; ++k) {
            const float wv = w[(size_t)k * 6 * D];
#pragma unroll
            for (int bb = 0; bb < 9; ++bb) acc[bb] += lds[bb * D + k] * wv;
        }
#pragma unroll
        for (int bb = 0; bb < 9; ++bb) red[(bb * 8 + ks) * 32 + col] = acc[bb];
        __syncthreads();
        for (int o = TIDX; o < 9 * 32; o += NT) {
            const int bb = o >> 5, c2 = o & 31;
            float sum = p.in[I_BMOD][l * 6 * D + (item % (6 * D / 32)) * 32 + c2];
#pragma unroll
            for (int q = 0; q < 8; ++q) sum += red[(bb * 8 + q) * 32 + c2];
            mod[(size_t)(l * 9 + bb) * 6 * D + (item % (6 * D / 32)) * 32 + c2] = sum;
        }
        __syncthreads();
    }
}

__device__ __forceinline__ void st_norm(const P& p, int l, int which) {
    const int lane = TIDX & 63, wv = TIDX >> 6;
    const int nrows = (which == 1 && l == 1) ? TL : TA;
    float* xn = (float*)(p.ws + WS_BUFA);
    const float* g = p.in[which == 0 ? I_N1G : I_N2G] + l * D;
    for (int r = BIDX * 4 + wv; r < nrows; r += gridDim.x * 4) {
        const float* src = which == 0 ? h_row(p, l, r) : hmid_row(p, r);
        const int bb = row_bb(r);
        const float* sh = mod_vec(p, l, bb, which == 0 ? 0 : 3);
        const float* sc = mod_vec(p, l, bb, which == 0 ? 1 : 4);
        float4 v[4];
        float s = 0.f;
#pragma unroll
        for (int j = 0; j < 4; ++j) { v[j] = *(const float4*)(src + j * 256 + lane * 4); s += v[j].x * v[j].x + v[j].y * v[j].y + v[j].z * v[j].z + v[j].w * v[j].w; }
        s = wave_sum(s);
        const float rinv = rsqrtf(s * (1.f / D) + 1e-6f);
#pragma unroll
        for (int j = 0; j < 4; ++j) {
            const int k = j * 256 + lane * 4;
            const float4 gg = *(const float4*)(g + k), s1 = *(const float4*)(sc + k), s0 = *(const float4*)(sh + k);
            float4 o;
            o.x = v[j].x * rinv * gg.x * (1.f + s1.x) + s0.x;
            o.y = v[j].y * rinv * gg.y * (1.f + s1.y) + s0.y;
            o.z = v[j].z * rinv * gg.z * (1.f + s1.z) + s0.z;
            o.w = v[j].w * rinv * gg.w * (1.f + s1.w) + s0.w;
            if (which == 1) *(float4*)(xn + (size_t)r * D + k) = o;
            else { uint2 pk; pk.x = (unsigned)f2bf(o.x) | ((unsigned)f2bf(o.y) << 16); pk.y = (unsigned)f2bf(o.z) | ((unsigned)f2bf(o.w) << 16);
                   *(uint2*)((bf16_t*)(p.ws + WS_BUFA) + (size_t)r * D + k) = pk; }
        }
    }
}


__device__ __forceinline__ void st_conv(const P& p, int l) {
    const BfPtr pb{(const bf16_t*)(p.ws + WS_PC)};
    bf16_t* mix = (bf16_t*)(p.ws + WS_BUFA);
    const float* cw = p.in[I_CONVW] + l * 3 * DCONV;
    const int nrows = l == 0 ? TA : TL;
    for (int idx = BIDX * NT + TIDX; idx < nrows * DCONV; idx += gridDim.x * NT) {
        const int r = idx / DCONV, ch = idx % DCONV;
        int t, len;
        if (r < TL) { t = r % L; len = L; } else { t = (r - TL) % LC; len = LC; }
        const BfPtr pr = pb + (long)r * 768;
        float y = cw[DCONV + ch] * (pr[512 + ch] * pr[ch]);
        if (t > 0) y += cw[ch] * (pr[-768 + 512 + ch] * pr[-768 + ch]);
        if (t < len - 1) y += cw[2 * DCONV + ch] * (pr[768 + 512 + ch] * pr[768 + ch]);
        mix[(size_t)r * D + ch] = f2bf(pr[256 + ch] * y);
    }
}

struct EpiOut { const float* modl; const float* hlat; const float* hctx; float* out; float* hcmid;
    __device__ __forceinline__ void operator()(int r, int c, float v0, float v1, float v2, float v3) const {
    const int bb = row_bb(r);
    const f32x4 g1 = *(const f32x4*)(modl + ((size_t)bb * 6 + 2) * D + c);
    const f32x4 hv = *(const f32x4*)((r < TL ? hlat + (size_t)r * D : hctx + (size_t)(r - TL) * D) + c);
    f32x4 o; o[0] = hv[0] + g1[0] * v0; o[1] = hv[1] + g1[1] * v1; o[2] = hv[2] + g1[2] * v2; o[3] = hv[3] + g1[3] * v3;
    *(f32x4*)((r < TL ? out + (size_t)r * D : hcmid + (size_t)(r - TL) * D) + c) = o; } };
__device__ __forceinline__ EpiOut make_epi_out(const P& p, int l) {
    return EpiOut{(const float*)(p.ws + WS_MOD) + (size_t)l * 9 * 6 * D, l == 0 ? p.in[I_X] : p.out, l == 0 ? p.in[I_CTX] : (const float*)(p.ws + WS_HC1), p.out, (float*)(p.ws + WS_HCMID)};
}

typedef __attribute__((ext_vector_type(8))) short bf16x8;
typedef __attribute__((ext_vector_type(16))) float f32x16;
typedef __attribute__((ext_vector_type(4))) unsigned u32x4;
constexpr int G_ROWB = 80;
constexpr int G_TILEB = 128 * G_ROWB;
constexpr int LDS_BYTES = 4 * G_TILEB;

template <class ARow>
__device__ __forceinline__ void gemm_tile(f32x16 (&acc)[2][2], ARow arow, const bf16_t* Bt, int ldb, int K, unsigned char* lds) {
    const int t = TIDX, lane = t & 63, w = t >> 6, wr = w >> 1, wc = w & 1, lr = lane & 31, lh = lane >> 5;
    const int srow = t >> 2, kc = t & 3;
    const bf16_t* ap[2]; const bf16_t* bp[2];
#pragma unroll
    for (int i = 0; i < 2; ++i) { ap[i] = arow(srow + 64 * i) + kc * 8; bp[i] = Bt + (size_t)(srow + 64 * i) * ldb + kc * 8; }
    float zf = 0.f; asm volatile("" : "+v"(zf));
#pragma unroll
    for (int mi = 0; mi < 2; ++mi)
#pragma unroll
        for (int ni = 0; ni < 2; ++ni)
#pragma unroll
            for (int r = 0; r < 16; ++r) acc[mi][ni][r] = zf;
    const int nk = K >> 5;
    const int soff = srow * G_ROWB + kc * 16;
    const int aoff = (wr * 64 + lr) * G_ROWB + lh * 16, boff = 2 * G_TILEB + (wc * 64 + lr) * G_ROWB + lh * 16;
    u32x4 r0[4], r1[4], r2[4];
#define G_LOAD(R, ks) do { R[0] = *(const u32x4*)(ap[0] + (ks) * 32); R[1] = *(const u32x4*)(ap[1] + (ks) * 32); \
                           R[2] = *(const u32x4*)(bp[0] + (ks) * 32); R[3] = *(const u32x4*)(bp[1] + (ks) * 32); } while (0)
#define G_WRITE(R, buf) do { unsigned char* d_ = lds + (buf) * G_TILEB + soff; *(u32x4*)(d_) = R[0]; *(u32x4*)(d_ + 64 * G_ROWB) = R[1]; \
                             *(u32x4*)(d_ + 2 * G_TILEB) = R[2]; *(u32x4*)(d_ + 2 * G_TILEB + 64 * G_ROWB) = R[3]; } while (0)
#define G_COMPUTE(buf) do { const unsigned char* c_ = lds + (buf) * G_TILEB; _Pragma("unroll") for (int s2 = 0; s2 < 2; ++s2) { \
        const bf16x8 a0 = *(const bf16x8*)(c_ + aoff + s2 * 32), a1 = *(const bf16x8*)(c_ + aoff + 32 * G_ROWB + s2 * 32); \
        const bf16x8 b0 = *(const bf16x8*)(c_ + boff + s2 * 32), b1 = *(const bf16x8*)(c_ + boff + 32 * G_ROWB + s2 * 32); \
        acc[0][0] = __builtin_amdgcn_mfma_f32_32x32x16_bf16(b0, a0, acc[0][0], 0, 0, 0); \
        acc[0][1] = __builtin_amdgcn_mfma_f32_32x32x16_bf16(b1, a0, acc[0][1], 0, 0, 0); \
        acc[1][0] = __builtin_amdgcn_mfma_f32_32x32x16_bf16(b0, a1, acc[1][0], 0, 0, 0); \
        acc[1][1] = __builtin_amdgcn_mfma_f32_32x32x16_bf16(b1, a1, acc[1][1], 0, 0, 0); } } while (0)
#define G_STEP(RN, ks) do { G_COMPUTE((ks) & 1); if ((ks) + 1 < nk) G_WRITE(RN, ((ks) + 1) & 1); if ((ks) + 4 < nk) G_LOAD(RN, (ks) + 4); __syncthreads(); } while (0)
    G_LOAD(r0, 0);
    if (1 < nk) G_LOAD(r1, 1);
    if (2 < nk) G_LOAD(r2, 2);
    __syncthreads();
    G_WRITE(r0, 0);
    if (3 < nk) G_LOAD(r0, 3);
    __syncthreads();
    for (int ks = 0; ks < nk; ks += 3) {
        G_STEP(r1, ks);
        if (ks + 1 < nk) G_STEP(r2, ks + 1);
        if (ks + 2 < nk) G_STEP(r0, ks + 2);
    }
#undef G_LOAD
#undef G_WRITE
#undef G_COMPUTE
#undef G_STEP
}
template <class F>
__device__ __forceinline__ void acc_foreach4(const f32x16 (&acc)[2][2], F f) {
    const int lane = TIDX & 63, w = (TIDX >> 6) & 3, wr = w >> 1, wc = w & 1, lr = lane & 31, lh = lane >> 5;
#pragma unroll
    for (int mi = 0; mi < 2; ++mi)
#pragma unroll
        for (int ni = 0; ni < 2; ++ni)
#pragma unroll
            for (int g = 0; g < 4; ++g)
                f(wr * 64 + mi * 32 + lr, wc * 64 + ni * 32 + 8 * g + 4 * lh, acc[mi][ni][4 * g], acc[mi][ni][4 * g + 1], acc[mi][ni][4 * g + 2], acc[mi][ni][4 * g + 3]);
}
__device__ __forceinline__ uint2 pack4(float a, float b, float c, float d) { uint2 o; o.x = cvt_pk_bf16(a, b); o.y = cvt_pk_bf16(c, d); return o; }
struct ARowPlain { const bf16_t* A; int lda; __device__ __forceinline__ const bf16_t* operator()(int m) const { return A + (size_t)m * lda; } };

template <class Epi>
__device__ __forceinline__ void gemm_stage(const bf16_t* A, int lda, const bf16_t* Bt, int ldb, int M, int N, int K, Epi epi, unsigned char* lds) {
    const int tn = N / 128, tm = M / 128;
    for (int tile = BIDX; tile < tm * tn; tile += gridDim.x) {
        const int m0 = (tile / tn) * 128, n0 = (tile % tn) * 128;
        f32x16 acc[2][2];
        gemm_tile(acc, ARowPlain{A + (size_t)m0 * lda, lda}, Bt + (size_t)n0 * ldb, ldb, K, lds);
        acc_foreach4(acc, [&](int r, int c, float v0, float v1, float v2, float v3) { epi(m0 + r, n0 + c, v0, v1, v2, v3); });
    }
}
__device__ __forceinline__ void prep_tr(const float* src, size_t sk, bf16_t* dst, int N, int K) {
    const int per = N * (K / 8);
    for (int idx = BIDX * NT + TIDX; idx < per; idx += gridDim.x * NT) {
        const int n = idx % N, kc = idx / N;
        const float* sp = src + (size_t)kc * 8 * sk + n;
        uint4 o;
        o.x = (unsigned)f2bf(sp[0]) | ((unsigned)f2bf(sp[sk]) << 16);
        o.y = (unsigned)f2bf(sp[2 * sk]) | ((unsigned)f2bf(sp[3 * sk]) << 16);
        o.z = (unsigned)f2bf(sp[4 * sk]) | ((unsigned)f2bf(sp[5 * sk]) << 16);
        o.w = (unsigned)f2bf(sp[6 * sk]) | ((unsigned)f2bf(sp[7 * sk]) << 16);
        *(uint4*)(dst + (size_t)n * K + kc * 8) = o;
    }
}
__device__ __forceinline__ void st_prep_dense(const P& p, int l) {
    prep_tr(p.in[I_WIN] + (size_t)l * D * DIN, DIN, (bf16_t*)(p.ws + WS_WTIN), DIN, D);
    prep_tr(p.in[I_WOUT] + (size_t)l * D * D, D, (bf16_t*)(p.ws + WS_WTOUT), D, D);
    prep_tr(p.in[I_WGLU] + (size_t)l * DSSM * DSSM, DSSM, (bf16_t*)(p.ws + WS_WTGLU), DSSM, DSSM);
}
struct EpiStoreBf { bf16_t* C; int ldc; __device__ __forceinline__ void operator()(int r, int c, float v0, float v1, float v2, float v3) const { *(uint2*)(C + (size_t)r * ldc + c) = pack4(v0, v1, v2, v3); } };


__device__ __forceinline__ void st_rbias(const P& p, int l, float* lds) {
    if (BIDX < 9) {
        const int bb = BIDX, e = TIDX & 31, ks = TIDX >> 5;
        const float* sh2 = mod_vec(p, l, bb, 3);
        const float* rw = p.in[I_RW] + (size_t)l * D * NE;
        float a = 0.f;
        for (int k = ks * 128; k < ks * 128 + 128; ++k) a += sh2[k] * rw[k * NE + e];
        lds[TIDX] = a;
        __syncthreads();
        if (TIDX < 32) { float s = 0.f; for (int j = 0; j < 8; ++j) s += lds[j * 32 + TIDX]; ((float*)(p.ws + WS_RBIAS))[(l * 9 + bb) * 32 + TIDX] = s; }
        __syncthreads();
    }
}
__device__ __forceinline__ void st_router2(const P& p, int l, unsigned char* ldsb) {
    const int lane = TIDX & 63, w = TIDX >> 6, i = lane & 31, hf = lane >> 5;
    float* sc = (float*)ldsb + w * (32 * 33);
    const int nrows = l == 0 ? TA : TL;
    const float* g2 = p.in[I_N2G] + l * D;
    const float* rw = p.in[I_RW] + (size_t)l * D * NE;
    int* cnt = (int*)(p.ws + WS_CTL) + l * NE;
    int* lcode = (int*)(p.ws + WS_LCODE);
    float* lw = (float*)(p.ws + WS_LW);
    bf16_t* xn2 = (bf16_t*)(p.ws + WS_BUFA);
    for (int item = BIDX * 4 + w; item < nrows / 32; item += gridDim.x * 4) {
        const int r0 = item * 32, bb = row_bb(r0);
        const float* sc2 = mod_vec(p, l, bb, 4);
        const float* sh2 = mod_vec(p, l, bb, 3);
        const float* src = hmid_row(p, r0 + i) + hf * 512;
        f32x16 acc;
        float zf = 0.f; asm volatile("" : "+v"(zf));
#pragma unroll
        for (int r = 0; r < 16; ++r) acc[r] = zf;
        float ss = 0.f;
        for (int c = 0; c < 128; ++c) {
            const int k = hf * 512 + 4 * c;
            const f32x4 x = *(const f32x4*)(src + 4 * c);
            const f32x4 gg = *(const f32x4*)(g2 + k), s1 = *(const f32x4*)(sc2 + k);
            ss += x[0] * x[0] + x[1] * x[1] + x[2] * x[2] + x[3] * x[3];
#pragma unroll
            for (int q = 0; q < 4; ++q) {
                const float a = x[q] * (gg[q] * (1.f + s1[q]));
                const float b = rw[(size_t)(k + q) * NE + i];
                acc = __builtin_amdgcn_mfma_f32_32x32x2f32(a, b, acc, 0, 0, 0);
            }
        }
        ss += __shfl_xor(ss, 32);
        const float rinv = rsqrtf(ss * (1.f / D) + 1e-6f);
        const float rb = ((const float*)(p.ws + WS_RBIAS))[(l * 9 + bb) * 32 + i];
#pragma unroll
        for (int r = 0; r < 16; ++r) {
            const int rho = (r & 3) + 8 * (r >> 2) + 4 * hf;
            const float rr = __shfl(rinv, rho);
            sc[rho * 33 + i] = sigmoid_f(rr * acc[r] + rb);
        }
        __builtin_amdgcn_s_waitcnt(0xc07f);
        __builtin_amdgcn_wave_barrier();
        {
            float gs[16], sh[16];
#pragma unroll
            for (int q = 0; q < 16; ++q) { const int k = (q >> 3) * 512 + 8 * lane + (q & 7); gs[q] = g2[k] * (1.f + sc2[k]); sh[q] = sh2[k]; }
            for (int rho = 0; rho < 32; ++rho) {
                const float rr = __shfl(rinv, rho);
                const float* s2 = hmid_row(p, r0 + rho);
                bf16_t* dst = xn2 + (size_t)(r0 + rho) * D;
#pragma unroll
                for (int h2 = 0; h2 < 2; ++h2) {
                    const f32x4 x0 = *(const f32x4*)(s2 + h2 * 512 + 8 * lane), x1 = *(const f32x4*)(s2 + h2 * 512 + 8 * lane + 4);
                    u32x4 o;
                    o[0] = (unsigned)f2bf(x0[0] * rr * gs[h2 * 8 + 0] + sh[h2 * 8 + 0]) | ((unsigned)f2bf(x0[1] * rr * gs[h2 * 8 + 1] + sh[h2 * 8 + 1]) << 16);
                    o[1] = (unsigned)f2bf(x0[2] * rr * gs[h2 * 8 + 2] + sh[h2 * 8 + 2]) | ((unsigned)f2bf(x0[3] * rr * gs[h2 * 8 + 3] + sh[h2 * 8 + 3]) << 16);
                    o[2] = (unsigned)f2bf(x1[0] * rr * gs[h2 * 8 + 4] + sh[h2 * 8 + 4]) | ((unsigned)f2bf(x1[1] * rr * gs[h2 * 8 + 5] + sh[h2 * 8 + 5]) << 16);
                    o[3] = (unsigned)f2bf(x1[2] * rr * gs[h2 * 8 + 6] + sh[h2 * 8 + 6]) | ((unsigned)f2bf(x1[3] * rr * gs[h2 * 8 + 7] + sh[h2 * 8 + 7]) << 16);
                    *(u32x4*)(dst + h2 * 512 + 8 * lane) = o;
                }
            }
        }
        if (lane < 32) {
            const int r = r0 + lane;
            float sel[32];
#pragma unroll
            for (int e = 0; e < 32; ++e) sel[e] = sc[lane * 33 + e] + p.in[I_RB][l * NE + e];
            int bi[4]; float sv[4]; float sum = 0.f;
#pragma unroll
            for (int k = 0; k < 4; ++k) {
                float best = -1e30f; int b = 0;
#pragma unroll
                for (int e = 0; e < 32; ++e) if (sel[e] > best) { best = sel[e]; b = e; }
#pragma unroll
                for (int e = 0; e < 32; ++e) if (e == b) sel[e] = -1e30f;
                bi[k] = b; sv[k] = sc[lane * 33 + b]; sum += sv[k];
            }
#pragma unroll
            for (int k = 0; k < 4; ++k) {
                const int pos = atomicAdd(&cnt[bi[k]], 1);
                lcode[(size_t)bi[k] * TA + pos] = r * 4 + k;
                lw[(size_t)bi[k] * TA + pos] = sv[k] / sum * 2.5f;
            }
        }
        __builtin_amdgcn_wave_barrier();
    }
}

constexpr int MOE_LDS_LIST = LDS_BYTES;
constexpr int LDS_MOE = LDS_BYTES + 128 * 4 + 128 * 4 + 64 * 4;
constexpr int LDS_MODB = (9 * D + 9 * 8 * 32) * 4;
constexpr int LDS_TOTAL = LDS_MOE > LDS_MODB ? LDS_MOE : LDS_MODB;
struct ARowCode { const bf16_t* base; const int* codes; int mode; __device__ __forceinline__ const bf16_t* operator()(int m) const {
    const int c = codes[m];
    if (mode == 0) return base + (size_t)(c < 0 ? 0 : (c >> 2)) * D;
    return base + (size_t)(c < 0 ? 0 : (c >> 2) * 5 + (c & 3)) * DE; } };
__device__ __forceinline__ void moe_tstart(const P& p, int l, int* ts) {
    if (TIDX == 0) { const int* cnt = (const int*)(p.ws + WS_CTL) + l * NE; int a = 0; for (int e = 0; e < NE; ++e) { ts[e] = a; a += (cnt[e] + 127) >> 7; } ts[NE] = a; }
    __syncthreads();
}
__device__ __forceinline__ void st_moe1(const P& p, int l, unsigned char* lds) {
    int* codes = (int*)(lds + MOE_LDS_LIST); float* wts = (float*)(codes + 128); int* ts = (int*)(wts + 128);
    const int nrows = l == 0 ? TA : TL;
    const int* cnt = (const int*)(p.ws + WS_CTL) + l * NE;
    const int* lcode = (const int*)(p.ws + WS_LCODE);
    const float* lw = (const float*)(p.ws + WS_LW);
    const bf16_t* xn2 = (const bf16_t*)(p.ws + WS_BUFA);
    bf16_t* hid = (bf16_t*)(p.ws + WS_HID);
    const bf16_t* wgu = (const bf16_t*)(p.ws + WS_WGU);
    moe_tstart(p, l, ts);
    const int nrt = ts[NE], nsh = nrows / 128, total = (nrt + nsh) * 2;
    const int lane = TIDX & 63, w = TIDX >> 6, wr = w >> 1, wc = w & 1, lr = lane & 31, lh = lane >> 5;
    for (int tile = BIDX; tile < total; tile += gridDim.x) {
        const int rt = tile >> 1, j = tile & 1;
        int e, m0, valid;
        if (rt < nrt) { e = 0; while (ts[e + 1] <= rt) ++e; m0 = (rt - ts[e]) * 128; valid = cnt[e] - m0; if (valid > 128) valid = 128; }
        else { e = NE; m0 = (rt - nrt) * 128; valid = 128; }
        __syncthreads();
        if (TIDX < 128) {
            const int m = TIDX;
            if (e < NE) { const bool ok = m < valid; codes[m] = ok ? lcode[(size_t)e * TA + m0 + m] : -1; wts[m] = ok ? lw[(size_t)e * TA + m0 + m] : 0.f; }
            else { codes[m] = (m0 + m) * 4; wts[m] = 1.f; }
        }
        __syncthreads();
        f32x16 acc[2][2];
        gemm_tile(acc, ARowCode{xn2, codes, 0}, wgu + (size_t)((e * 2 + j) * 128) * D, D, D, lds);
#pragma unroll
        for (int mi = 0; mi < 2; ++mi) {
            const int m = wr * 64 + mi * 32 + lr;
            const int c = codes[m];
            if (c >= 0) {
                const float wt = wts[m];
                const size_t hrow = e < NE ? (size_t)(c >> 2) * 5 + (c & 3) : (size_t)(c >> 2) * 5 + 4;
#pragma unroll
                for (int g = 0; g < 4; ++g) {
                    float h[4];
#pragma unroll
                    for (int q = 0; q < 4; ++q) h[q] = silu_f(acc[mi][0][4 * g + q]) * acc[mi][1][4 * g + q] * wt;
                    *(uint2*)(hid + hrow * DE + j * 64 + wc * 32 + 8 * g + 4 * lh) = pack4(h[0], h[1], h[2], h[3]);
                }
            }
        }
    }
}
__device__ __forceinline__ void st_moe2(const P& p, int l, unsigned char* lds) {
    int* codes = (int*)(lds + MOE_LDS_LIST); float* wts = (float*)(codes + 128); int* ts = (int*)(wts + 128);
    const int* cnt = (const int*)(p.ws + WS_CTL) + l * NE;
    const int* lcode = (const int*)(p.ws + WS_LCODE);
    const bf16_t* hid = (const bf16_t*)(p.ws + WS_HID);
    bf16_t* slab = (bf16_t*)(p.ws + WS_SLAB);
    const bf16_t* wd = (const bf16_t*)(p.ws + WS_WD);
    moe_tstart(p, l, ts);
    const int nrt = ts[NE], total = nrt * 8;
    for (int tile = BIDX; tile < total; tile += gridDim.x) {
        const int rt = tile >> 3, n0 = (tile & 7) * 128;
        int e = 0; while (ts[e + 1] <= rt) ++e;
        const int m0 = (rt - ts[e]) * 128; int valid = cnt[e] - m0; if (valid > 128) valid = 128;
        __syncthreads();
        if (TIDX < 128) { const int m = TIDX; codes[m] = m < valid ? lcode[(size_t)e * TA + m0 + m] : -1; }
        __syncthreads();
        f32x16 acc[2][2];
        gemm_tile(acc, ARowCode{hid, codes, 1}, wd + ((size_t)e * D + n0) * DE, DE, DE, lds);
        acc_foreach4(acc, [&](int r, int c, float v0, float v1, float v2, float v3) { const int code = codes[r]; if (code >= 0) *(uint2*)(slab + (size_t)code * D + n0 + c) = pack4(v0, v1, v2, v3); });
    }
}
struct EpiMoeF { const bf16_t* slab; const float* modl; float* out; const float* hcmid; float* hc1;
    __device__ __forceinline__ void operator()(int r, int c, float v0, float v1, float v2, float v3) const {
    const bf16_t* sl = slab + (size_t)r * 4 * D + c;
    float v[4] = {v0, v1, v2, v3};
#pragma unroll
    for (int k = 0; k < 4; ++k) { const uint2 q = *(const uint2*)(sl + (size_t)k * D);
        v[0] += __uint_as_float(q.x << 16); v[1] += __uint_as_float(q.x & 0xffff0000u); v[2] += __uint_as_float(q.y << 16); v[3] += __uint_as_float(q.y & 0xffff0000u); }
    const f32x4 g2 = *(const f32x4*)(modl + ((size_t)row_bb(r) * 6 + 5) * D + c);
    const f32x4 hm = *(const f32x4*)((r < TL ? out + (size_t)r * D : hcmid + (size_t)(r - TL) * D) + c);
    f32x4 o; o[0] = hm[0] + g2[0] * v[0]; o[1] = hm[1] + g2[1] * v[1]; o[2] = hm[2] + g2[2] * v[2]; o[3] = hm[3] + g2[3] * v[3];
    *(f32x4*)((r < TL ? out + (size_t)r * D : hc1 + (size_t)(r - TL) * D) + c) = o; } };
__device__ __forceinline__ EpiMoeF make_epi_moef(const P& p, int l) {
    return EpiMoeF{(const bf16_t*)(p.ws + WS_SLAB), (const float*)(p.ws + WS_MOD) + (size_t)l * 9 * 6 * D, p.out, (const float*)(p.ws + WS_HCMID), (float*)(p.ws + WS_HC1)};
}
__device__ __forceinline__ void st_prep_moe(const P& p, int l) {
    bf16_t* wgu = (bf16_t*)(p.ws + WS_WGU);
    const int tot1 = 33 * 2 * 4 * 128 * 32;
    for (int idx = BIDX * NT + TIDX; idx < tot1; idx += gridDim.x * NT) {
        const int i = idx & 31; int q_ = idx >> 5; const int kc = q_ & 127; q_ >>= 7; const int q = q_ & 3; q_ >>= 2; const int j = q_ & 1; const int e = q_ >> 1;
        const int wc = q >> 1, ni = q & 1, unit = j * 64 + wc * 32 + i;
        const float* sp; size_t sk;
        if (e < NE) { sp = p.in[ni ? I_WEU : I_WEG] + ((size_t)(l * D + kc * 8) * NE + e) * DE + unit; sk = (size_t)NE * DE; }
        else { sp = p.in[ni ? I_WSU : I_WSG] + (size_t)(l * D + kc * 8) * DE + unit; sk = DE; }
        u32x4 o;
        o[0] = (unsigned)f2bf(sp[0]) | ((unsigned)f2bf(sp[sk]) << 16);
        o[1] = (unsigned)f2bf(sp[2 * sk]) | ((unsigned)f2bf(sp[3 * sk]) << 16);
        o[2] = (unsigned)f2bf(sp[4 * sk]) | ((unsigned)f2bf(sp[5 * sk]) << 16);
        o[3] = (unsigned)f2bf(sp[6 * sk]) | ((unsigned)f2bf(sp[7 * sk]) << 16);
        *(u32x4*)(wgu + ((size_t)(e * 2 + j) * 128 + q * 32 + i) * D + kc * 8) = o;
    }
    bf16_t* wd = (bf16_t*)(p.ws + WS_WD);
    const int tot2 = 33 * 16 * 1024;
    for (int idx = BIDX * NT + TIDX; idx < tot2; idx += gridDim.x * NT) {
        const int n = idx & 1023; int q_ = idx >> 10; const int kc = q_ & 15; const int e = q_ >> 4;
        const float* sp = (e < NE ? p.in[I_WED] + ((size_t)(l * NE + e) * DE + kc * 8) * D : p.in[I_WSD] + ((size_t)l * DE + kc * 8) * D) + n;
        u32x4 o;
        o[0] = (unsigned)f2bf(sp[0]) | ((unsigned)f2bf(sp[D]) << 16);
        o[1] = (unsigned)f2bf(sp[2 * D]) | ((unsigned)f2bf(sp[3 * D]) << 16);
        o[2] = (unsigned)f2bf(sp[4 * D]) | ((unsigned)f2bf(sp[5 * D]) << 16);
        o[3] = (unsigned)f2bf(sp[6 * D]) | ((unsigned)f2bf(sp[7 * D]) << 16);
        *(u32x4*)(wd + ((size_t)e * D + n) * DE + kc * 8) = o;
    }
}

struct SsmPar { float lre, lim, dt; };
__device__ __forceinline__ SsmPar ssm_par(const P& p, int l, int dir, int g, int pp) {
    const int pi = ((l * 2 + dir) * SG + g) * SP + pp;
    SsmPar r; r.lre = p.in[I_LRE][pi]; r.lim = p.in[I_LIM][pi]; r.dt = expf(p.in[I_LDT][(l * 2 + dir) * SG + g]); return r;
}
__device__ __forceinline__ float2 ssm_pow(const SsmPar& q, float e) {
    const float mag = expf(e * q.lre * q.dt), ang = e * (q.lim * q.dt);
    return make_float2(mag * cosf(ang), mag * sinf(ang));
}
__device__ __forceinline__ float2 ssm_f(const SsmPar& q) {
    const float2 lb = ssm_pow(q, 1.f);
    const float nr = lb.x - 1.f, ni = lb.y, den = q.lre * q.lre + q.lim * q.lim;
    return make_float2((nr * q.lre + ni * q.lim) / den, (ni * q.lre - nr * q.lim) / den);
}
__device__ __forceinline__ float2 cmul(float2 a, float2 b) { return make_float2(a.x * b.x - a.y * b.y, a.x * b.y + a.y * b.x); }
__device__ __forceinline__ void st_ssm_kj(const P& p, float* lds) {
    float* lam = lds; float* Cc = lds + 128; float* Bb = Cc + 2048;
    float* kj = (float*)(p.ws + WS_KJ);
    const int t = TIDX;
    for (int item = BIDX; item < 64; item += gridDim.x) {
        const int l = item >> 5, g = (item >> 1) & 15, dir = item & 1;
        const int base = (l * 2 + dir) * SG + g;
        __syncthreads();
        if (t < 64) {
            const SsmPar q = ssm_par(p, l, dir, g, t);
            const float2 lb = ssm_pow(q, 1.f), f = ssm_f(q);
            lam[2 * t] = lb.x; lam[2 * t + 1] = lb.y;
            for (int h = 0; h < 16; ++h) {
                const size_t bi = ((size_t)base * SP + t) * 16 + h;
                const float2 bb = cmul(f, make_float2(p.in[I_BRE][bi], p.in[I_BIM][bi]));
                Bb[(t * 16 + h) * 2] = bb.x; Bb[(t * 16 + h) * 2 + 1] = bb.y;
            }
        }
        for (int i = t; i < 1024; i += NT) { const size_t ci = (size_t)base * 1024 + i; Cc[2 * i] = p.in[I_CRE][ci]; Cc[2 * i + 1] = p.in[I_CIM][ci]; }
        __syncthreads();
        const int ho = t >> 4, hi = t & 15;
        float acc[32];
#pragma unroll
        for (int j = 0; j < 32; ++j) acc[j] = 0.f;
        for (int pp = 0; pp < 64; ++pp) {
            float2 z = cmul(make_float2(Cc[(ho * 64 + pp) * 2], Cc[(ho * 64 + pp) * 2 + 1]), make_float2(Bb[(pp * 16 + hi) * 2], Bb[(pp * 16 + hi) * 2 + 1]));
            const float2 lb = make_float2(lam[2 * pp], lam[2 * pp + 1]);
#pragma unroll
            for (int j = 0; j < 32; ++j) { acc[j] += z.x; z = cmul(z, lb); }
        }
#pragma unroll
        for (int j = 0; j < 32; ++j) kj[((size_t)((l * 16 + g) * 2 + dir) * 32 + j) * 256 + ho * 16 + hi] = acc[j];
    }
    __syncthreads();
}
__device__ __forceinline__ void st_prep_ssm(const P& p, int l) {
    bf16_t* wst = (bf16_t*)(p.ws + WS_WST);
    for (int idx = BIDX * NT + TIDX; idx < 16 * 256 * 64; idx += gridDim.x * NT) {
        const int kc = idx & 63, n = (idx >> 6) & 255, g = idx >> 14;
        const int dir = n >> 7, c = (n >> 6) & 1, pp = n & 63, s = kc >> 1, h0 = (kc & 1) * 8;
        const SsmPar q = ssm_par(p, l, dir, g, pp);
        const float2 coef = cmul(ssm_pow(q, dir == 0 ? (float)(31 - s) : (float)s), ssm_f(q));
        const size_t bi = ((size_t)((l * 2 + dir) * SG + g) * SP + pp) * 16 + h0;
        float v[8];
#pragma unroll
        for (int j = 0; j < 8; ++j) { const float2 z = cmul(coef, make_float2(p.in[I_BRE][bi + j], p.in[I_BIM][bi + j])); v[j] = c == 0 ? z.x : z.y; }
        u32x4 o; o[0] = cvt_pk_bf16(v[0], v[1]); o[1] = cvt_pk_bf16(v[2], v[3]); o[2] = cvt_pk_bf16(v[4], v[5]); o[3] = cvt_pk_bf16(v[6], v[7]);
        *(u32x4*)(wst + ((size_t)(g * 256 + n)) * 512 + kc * 8) = o;
    }
    bf16_t* kw = (bf16_t*)(p.ws + WS_KW);
    const float* kj = (const float*)(p.ws + WS_KJ);
    for (int idx = BIDX * NT + TIDX; idx < 16 * 512 * 96; idx += gridDim.x * NT) {
        const int kc = idx % 96, n = (idx / 96) & 511, g = idx / (96 * 512);
        const int tau = n >> 4, ho = n & 15;
        float v[8];
        if (kc < 64) {
            const int s = kc >> 1, hi0 = (kc & 1) * 8;
#pragma unroll
            for (int j = 0; j < 8; ++j) {
                float a = 0.f;
                if (s <= tau) a += kj[((size_t)((l * 16 + g) * 2 + 0) * 32 + (tau - s)) * 256 + ho * 16 + hi0 + j];
                if (s >= tau) a += kj[((size_t)((l * 16 + g) * 2 + 1) * 32 + (s - tau)) * 256 + ho * 16 + hi0 + j];
                if (s == tau && ho == hi0 + j) a += p.in[I_SD][l * DSSM + g * 16 + ho];
                v[j] = a;
            }
        } else {
            const int kk = (kc - 64) * 8, dir = kk >> 7, c = (kk >> 6) & 1, p0 = kk & 63;
            const float e = dir == 0 ? (float)(tau + 1) : (float)(32 - tau);
#pragma unroll
            for (int j = 0; j < 8; ++j) {
                const SsmPar q = ssm_par(p, l, dir, g, p0 + j);
                const size_t ci = ((size_t)((l * 2 + dir) * SG + g) * 16 + ho) * SP + p0 + j;
                const float2 z = cmul(make_float2(p.in[I_CRE][ci], p.in[I_CIM][ci]), ssm_pow(q, e));
                v[j] = c == 0 ? z.x : -z.y;
            }
        }
        u32x4 o; o[0] = cvt_pk_bf16(v[0], v[1]); o[1] = cvt_pk_bf16(v[2], v[3]); o[2] = cvt_pk_bf16(v[4], v[5]); o[3] = cvt_pk_bf16(v[6], v[7]);
        *(u32x4*)(kw + ((size_t)(g * 512 + n)) * 768 + kc * 8) = o;
    }
}
__device__ __forceinline__ void st_ssm_egemm(const P& p, unsigned char* lds) {
    const bf16_t* ua = (const bf16_t*)(p.ws + WS_UA);
    const bf16_t* wst = (const bf16_t*)(p.ws + WS_WST);
    float* E = (float*)(p.ws + WS_E);
    for (int tile = BIDX; tile < 160; tile += gridDim.x) {
        const int nt = tile & 1, mt = (tile >> 1) % 5, g = tile / 10;
        f32x16 acc[2][2];
        gemm_tile(acc, ARowPlain{ua + (size_t)(g * 640 + mt * 128) * 768, 768}, wst + (size_t)(g * 256 + nt * 128) * 512, 512, 512, lds);
        acc_foreach4(acc, [&](int r, int c, float v0, float v1, float v2, float v3) { f32x4 o; o[0] = v0; o[1] = v1; o[2] = v2; o[3] = v3; *(f32x4*)(E + (size_t)(g * 640 + mt * 128 + r) * 256 + nt * 128 + c) = o; });
    }
}
__device__ __forceinline__ void st_ssm_carry(const P& p, int l) {
    bf16_t* ua = (bf16_t*)(p.ws + WS_UA);
    const float* E = (const float*)(p.ws + WS_E);
    for (int idx = BIDX * NT + TIDX; idx < NB * 16 * 2 * 64; idx += gridDim.x * NT) {
        const int pp = idx & 63, dir = (idx >> 6) & 1, g = (idx >> 7) & 15, b = idx >> 11;
        const float2 l32 = ssm_pow(ssm_par(p, l, dir, g, pp), 32.f);
        float2 S = make_float2(0.f, 0.f);
        for (int s0 = 0; s0 < 72; s0 += 8) {
            int ch[8]; float er[8], ei[8];
#pragma unroll
            for (int j = 0; j < 8; ++j) {
                const int step = s0 + j;
                if (dir == 0) ch[j] = step < 8 ? 512 + b * 8 + step : b * 64 + (step - 8);
                else ch[j] = step < 8 ? 512 + b * 8 + (7 - step) : b * 64 + (63 - (step - 8));
                const float* e = E + (size_t)(g * 640 + ch[j]) * 256 + dir * 128 + pp;
                er[j] = e[0]; ei[j] = e[64];
            }
#pragma unroll
            for (int j = 0; j < 8; ++j) {
                bf16_t* o = ua + (size_t)(g * 640 + ch[j]) * 768 + 512 + dir * 128 + pp;
                o[0] = f2bf(S.x); o[64] = f2bf(S.y);
                S = cmul(l32, S); S.x += er[j]; S.y += ei[j];
            }
        }
    }
}
__device__ __forceinline__ void st_ssm_ygemm(const P& p, int l, unsigned char* lds) {
    const bf16_t* ua = (const bf16_t*)(p.ws + WS_UA);
    const bf16_t* kw = (const bf16_t*)(p.ws + WS_KW);
    bf16_t* G = (bf16_t*)(p.ws + WS_G);
    const int nmt = l == 0 ? 5 : 4;
    for (int tile = BIDX; tile < 16 * nmt * 4; tile += gridDim.x) {
        const int nt = tile & 3, mt = (tile >> 2) % nmt, g = tile / (4 * nmt);
        f32x16 acc[2][2];
        gemm_tile(acc, ARowPlain{ua + (size_t)(g * 640 + mt * 128) * 768, 768}, kw + (size_t)(g * 512 + nt * 128) * 768, 768, 768, lds);
        acc_foreach4(acc, [&](int r, int c, float v0, float v1, float v2, float v3) {
            const int chunk = mt * 128 + r, n = nt * 128 + c;
            if (chunk < TA / 32) *(uint2*)(G + (size_t)(chunk * 32 + (n >> 4)) * DSSM + g * 16 + (n & 15)) = pack4(gelu_f(v0), gelu_f(v1), gelu_f(v2), gelu_f(v3)); });
    }
}
struct EpiGlu2 { const bf16_t* G; bf16_t* mix; const float* bias; __device__ __forceinline__ void operator()(int r, int c, float v0, float v1, float v2, float v3) const {
    const uint2 q = *(const uint2*)(G + (size_t)r * DSSM + c);
    const f32x4 b = *(const f32x4*)(bias + c);
    *(uint2*)(mix + (size_t)r * D + 256 + c) = pack4(__uint_as_float(q.x << 16) * sigmoid_f(v0 + b[0]), __uint_as_float(q.x & 0xffff0000u) * sigmoid_f(v1 + b[1]),
                                                     __uint_as_float(q.y << 16) * sigmoid_f(v2 + b[2]), __uint_as_float(q.y & 0xffff0000u) * sigmoid_f(v3 + b[3])); } };

constexpr float QSCALE = 0.125f * 1.4426950408889634f;
__device__ __forceinline__ void st_rope_table(const P& p) {
    float2* tab = (float2*)(p.ws + WS_ROPE);
    for (int idx = BIDX * NT + TIDX; idx < L * 32; idx += gridDim.x * NT) {
        const int t = idx >> 5, a = (idx >> 4) & 1, i = idx & 15;
        const float pos = a == 0 ? (float)(t / 64) : (float)(t % 64);
        const float ang = pos * powf(10000.f, -(float)i / 16.f);
        tab[idx] = make_float2(cosf(ang), sinf(ang));
    }
}
__device__ __forceinline__ void st_inproj(const P& p, int l, unsigned char* lds) {
    const bf16_t* A = (const bf16_t*)(p.ws + WS_BUFA);
    const bf16_t* Bt = (const bf16_t*)(p.ws + WS_WTIN);
    bf16_t* pc = (bf16_t*)(p.ws + WS_PC);
    bf16_t* ua = (bf16_t*)(p.ws + WS_UA);
    bf16_t* qb = (bf16_t*)(p.ws + WS_QB);
    bf16_t* kb = (bf16_t*)(p.ws + WS_KB);
    bf16_t* vt = (bf16_t*)(p.ws + WS_VT);
    const float2* rope = (const float2*)(p.ws + WS_ROPE);
    const int lane = TIDX & 63, w = TIDX >> 6, wr = w >> 1, wc = w & 1, lr = lane & 31, lh = lane >> 5;
    constexpr int TN = DIN / 128;
    for (int tile = BIDX; tile < (TA / 128) * TN; tile += gridDim.x) {
        const int tn = tile % TN, m0 = (tile / TN) * 128, n0 = tn * 128;
        f32x16 acc[2][2];
        gemm_tile(acc, ARowPlain{A + (size_t)m0 * D, D}, Bt + (size_t)n0 * D, D, D, lds);
        if (tn < 6) {
            acc_foreach4(acc, [&](int r, int c, float v0, float v1, float v2, float v3) { *(uint2*)(pc + (size_t)(m0 + r) * 768 + n0 + c) = pack4(v0, v1, v2, v3); });
        } else if (tn < 8) {
            acc_foreach4(acc, [&](int r, int c, float v0, float v1, float v2, float v3) { const int row = m0 + r, g = (tn - 6) * 8 + (c >> 4);
                *(uint2*)(ua + (size_t)(g * 640 + (row >> 5)) * 768 + (row & 31) * 16 + (c & 15)) = pack4(v0, v1, v2, v3); });
        } else if (tn < 13) {
            const bool isq = tn < 12;
            const float* gain = (isq ? p.in[I_QG] : p.in[I_KG]) + l * 64;
            const bool lat = m0 < TL;
            const float osc = isq ? QSCALE : 1.f;
#pragma unroll
            for (int mi = 0; mi < 2; ++mi) {
                const int row = m0 + wr * 64 + mi * 32 + lr;
                float ss = 0.f;
#pragma unroll
                for (int ni = 0; ni < 2; ++ni)
#pragma unroll
                    for (int r = 0; r < 16; ++r) ss += acc[mi][ni][r] * acc[mi][ni][r];
                ss += __shfl_xor(ss, 32);
                const float rinv = rsqrtf(ss * (1.f / 64.f) + 1e-6f) * osc;
                const int t = row & (L - 1);
                bf16_t* o = isq ? qb + (size_t)row * DATT + ((tn - 8) * 2 + wc) * 64 : kb + (size_t)row * 128 + wc * 64;
#pragma unroll
                for (int ni = 0; ni < 2; ++ni)
#pragma unroll
                    for (int g = 0; g < 2; ++g) {
                        const int d0 = ni * 32 + 8 * g + 4 * lh;
                        const f32x4 glo = *(const f32x4*)(gain + d0), ghi = *(const f32x4*)(gain + d0 + 16);
                        float t1[4], t2[4];
#pragma unroll
                        for (int q = 0; q < 4; ++q) { t1[q] = acc[mi][ni][4 * g + q] * rinv * glo[q]; t2[q] = acc[mi][ni][8 + 4 * g + q] * rinv * ghi[q]; }
                        if (lat) {
                            const float2* cs = rope + (t * 2 + ni) * 16 + 8 * g + 4 * lh;
                            const f32x4 c01 = *(const f32x4*)(cs), c23 = *(const f32x4*)(cs + 2);
                            const float cc[4] = {c01[0], c01[2], c23[0], c23[2]}, sn[4] = {c01[1], c01[3], c23[1], c23[3]};
#pragma unroll
                            for (int q = 0; q < 4; ++q) { const float a = t1[q], b = t2[q]; t1[q] = a * cc[q] - b * sn[q]; t2[q] = a * sn[q] + b * cc[q]; }
                        }
                        *(uint2*)(o + d0) = pack4(t1[0], t1[1], t1[2], t1[3]);
                        *(uint2*)(o + d0 + 16) = pack4(t2[0], t2[1], t2[2], t2[3]);
                    }
            }
        } else {
            acc_foreach4(acc, [&](int r, int c, float v0, float v1, float v2, float v3) { *(uint2*)(vt + (size_t)(m0 + r) * 128 + c) = pack4(v0, v1, v2, v3); });
        }
    }
}

constexpr int AT_KROWB = 144, AT_VROWB = 264, AT_VOFF = 128 * AT_KROWB;
__device__ __forceinline__ void st_attn2(const P& p, int l, unsigned char* lds, int part, int nparts) {
    const bf16_t* qb = (const bf16_t*)(p.ws + WS_QB);
    const bf16_t* kb = (const bf16_t*)(p.ws + WS_KB);
    const bf16_t* vt = (const bf16_t*)(p.ws + WS_VT);
    bf16_t* mix = (bf16_t*)(p.ws + WS_BUFA);
    const int t = TIDX, lane = t & 63, w = t >> 6, lr = lane & 31, lh = lane >> 5;
    const int nitems = NB * 16 * NQH + (l == 0 ? NB * 2 * NQH : 0);
    for (int item = BIDX * nparts + part; item < nitems; item += gridDim.x * nparts) {
        const bool isctx = item >= NB * 16 * NQH;
        int b, qblk, hq;
        if (!isctx) { hq = item & 7; qblk = (item >> 3) & 15; b = item >> 7; }
        else { const int it = item - NB * 16 * NQH; hq = it & 7; qblk = (it >> 3) & 1; b = it >> 4; }
        const int g = hq >> 2;
        const int rq0 = isctx ? TL + b * LC + qblk * 128 : b * L + qblk * 128;
        const int qrow = rq0 + w * 32 + lr;
        bf16x8 qf[4];
#pragma unroll
        for (int s4 = 0; s4 < 4; ++s4) qf[s4] = *(const bf16x8*)(qb + (size_t)qrow * DATT + hq * 64 + s4 * 16 + lh * 8);
        float m = p.in[I_SINK][l * NQH + hq] * 1.4426950408889634f;
        float lsum = lh == 0 ? 1.f : 0.f;
        f32x16 o0, o1;
        float zf = 0.f; asm volatile("" : "+v"(zf));
#pragma unroll
        for (int r = 0; r < 16; ++r) { o0[r] = zf; o1[r] = zf; }
        const int nkb = isctx ? 2 : 5;
        for (int kbi = 0; kbi < nkb; ++kbi) {
            bool win; int kblk;
            if (isctx) { win = false; kblk = kbi; } else if (kbi < 3) { win = true; kblk = qblk - 1 + kbi; } else { win = false; kblk = kbi - 3; }
            if (win && (kblk < 0 || kblk > 15)) continue;
            const bf16_t* ksrc = kb + (size_t)(win ? b * L + kblk * 128 : TL + b * LC + kblk * 128) * 128 + g * 64;
            const bf16_t* vsrc = vt + (size_t)(win ? b * L + kblk * 128 : TL + b * LC + kblk * 128) * 128 + g * 64;
            __syncthreads();
#pragma unroll
            for (int i = 0; i < 4; ++i) {
                const int c = t + 256 * i;
                const int row = c >> 3, kc = c & 7;
                *(u32x4*)(lds + row * AT_KROWB + kc * 16) = *(const u32x4*)(ksrc + (size_t)row * 128 + kc * 8);
                const u32x4 vv = *(const u32x4*)(vsrc + (size_t)row * 128 + kc * 8);
                unsigned char* vd = lds + AT_VOFF + (kc * 8) * AT_VROWB + row * 2;
#pragma unroll
                for (int q = 0; q < 4; ++q) { *(bf16_t*)(vd + (2 * q) * AT_VROWB) = (bf16_t)(vv[q] & 0xffffu); *(bf16_t*)(vd + (2 * q + 1) * AT_VROWB) = (bf16_t)(vv[q] >> 16); }
            }
            __syncthreads();
            const int i0 = qblk * 128 + w * 32;
            for (int sub = 0; sub < 4; ++sub) {
                bool partial = false;
                if (win) {
                    const int j0 = kblk * 128 + sub * 32;
                    if (j0 > i0 + 31 + 128 || j0 + 31 < i0 - 128) continue;
                    partial = !(j0 >= i0 + 31 - 128 && j0 + 31 <= i0 + 128);
                }
                f32x16 sT;
#pragma unroll
                for (int r = 0; r < 16; ++r) sT[r] = zf;
#pragma unroll
                for (int s4 = 0; s4 < 4; ++s4) {
                    const bf16x8 kf = *(const bf16x8*)(lds + (sub * 32 + lr) * AT_KROWB + s4 * 32 + lh * 16);
                    sT = __builtin_amdgcn_mfma_f32_32x32x16_bf16(kf, qf[s4], sT, 0, 0, 0);
                }
                if (partial) {
                    const int j0 = kblk * 128 + sub * 32, qi = i0 + lr;
#pragma unroll
                    for (int r = 0; r < 16; ++r) { const int dj = j0 + (r & 3) + 8 * (r >> 2) + 4 * lh - qi; if (dj > 128 || dj < -128) sT[r] = -1e30f; }
                }
                float mt = sT[0];
#pragma unroll
                for (int r = 1; r < 16; ++r) mt = fmaxf(mt, sT[r]);
                mt = fmaxf(mt, __shfl_xor(mt, 32));
                const float mn = fmaxf(m, mt);
                const float alpha = __builtin_amdgcn_exp2f(m - mn);
                m = mn;
                float ps = 0.f;
#pragma unroll
                for (int r = 0; r < 16; ++r) { sT[r] = __builtin_amdgcn_exp2f(sT[r] - mn); ps += sT[r]; }
                lsum = lsum * alpha + ps;
#pragma unroll
                for (int r = 0; r < 16; ++r) { o0[r] *= alpha; o1[r] *= alpha; }
#pragma unroll
                for (int s2 = 0; s2 < 2; ++s2) {
                    u32x4 pk;
                    pk[0] = cvt_pk_bf16(sT[8 * s2 + 0], sT[8 * s2 + 1]); pk[1] = cvt_pk_bf16(sT[8 * s2 + 2], sT[8 * s2 + 3]);
                    pk[2] = cvt_pk_bf16(sT[8 * s2 + 4], sT[8 * s2 + 5]); pk[3] = cvt_pk_bf16(sT[8 * s2 + 6], sT[8 * s2 + 7]);
                    const bf16x8 pf = __builtin_bit_cast(bf16x8, pk);
                    const int kofs = (sub * 32 + s2 * 16 + lh * 4) * 2;
                    {
                        const uint2 a = *(const uint2*)(lds + AT_VOFF + lr * AT_VROWB + kofs), c2 = *(const uint2*)(lds + AT_VOFF + lr * AT_VROWB + kofs + 16);
                        u32x4 vv; vv[0] = a.x; vv[1] = a.y; vv[2] = c2.x; vv[3] = c2.y;
                        o0 = __builtin_amdgcn_mfma_f32_32x32x16_bf16(__builtin_bit_cast(bf16x8, vv), pf, o0, 0, 0, 0);
                    }
                    {
                        const uint2 a = *(const uint2*)(lds + AT_VOFF + (32 + lr) * AT_VROWB + kofs), c2 = *(const uint2*)(lds + AT_VOFF + (32 + lr) * AT_VROWB + kofs + 16);
                        u32x4 vv; vv[0] = a.x; vv[1] = a.y; vv[2] = c2.x; vv[3] = c2.y;
                        o1 = __builtin_amdgcn_mfma_f32_32x32x16_bf16(__builtin_bit_cast(bf16x8, vv), pf, o1, 0, 0, 0);
                    }
                }
            }
        }
        lsum += __shfl_xor(lsum, 32);
        const float inv = 1.f / lsum;
        bf16_t* orow = mix + (size_t)qrow * D + 512 + hq * 64;
#pragma unroll
        for (int rg = 0; rg < 4; ++rg) {
            uint2 a; a.x = cvt_pk_bf16(o0[4 * rg] * inv, o0[4 * rg + 1] * inv); a.y = cvt_pk_bf16(o0[4 * rg + 2] * inv, o0[4 * rg + 3] * inv);
            *(uint2*)(orow + 8 * rg + 4 * lh) = a;
            uint2 c2; c2.x = cvt_pk_bf16(o1[4 * rg] * inv, o1[4 * rg + 1] * inv); c2.y = cvt_pk_bf16(o1[4 * rg + 2] * inv, o1[4 * rg + 3] * inv);
            *(uint2*)(orow + 32 + 8 * rg + 4 * lh) = c2;
        }
    }
}

constexpr int STAGES_PER_LAYER = 11;
constexpr int N_STAGES = 1 + 2 * STAGES_PER_LAYER;
constexpr int REP_STAGE = -1;

__device__ __forceinline__ void run_stage(const P& p, int s, unsigned char* ldsb) {
    float* lds = (float*)ldsb;
    if (s == 0) { st_mod(p, lds); st_rope_table(p); st_ssm_kj(p, lds); return; }
    const int l = (s - 1) / STAGES_PER_LAYER, k = (s - 1) % STAGES_PER_LAYER;
    switch (k) {
    case 0: st_rbias(p, l, lds); st_norm(p, l, 0); st_prep_dense(p, l); st_prep_moe(p, l); st_prep_ssm(p, l); break;
    case 1: st_inproj(p, l, ldsb); break;
    case 2: st_ssm_egemm(p, ldsb); st_conv(p, l); st_attn2(p, l, ldsb, 0, 4); break;
    case 3: st_ssm_carry(p, l); st_attn2(p, l, ldsb, 1, 4); break;
    case 4: st_ssm_ygemm(p, l, ldsb); st_attn2(p, l, ldsb, 2, 4); break;
    case 5: gemm_stage((const bf16_t*)(p.ws + WS_G), DSSM, (const bf16_t*)(p.ws + WS_WTGLU), DSSM, l == 0 ? TA : TL, DSSM, DSSM,
                       EpiGlu2{(const bf16_t*)(p.ws + WS_G), (bf16_t*)(p.ws + WS_BUFA), p.in[I_BGLU] + l * DSSM}, ldsb);
            st_attn2(p, l, ldsb, 3, 4); break;
    case 6: gemm_stage((const bf16_t*)(p.ws + WS_BUFA), D, (const bf16_t*)(p.ws + WS_WTOUT), D, l == 0 ? TA : TL, D, D, make_epi_out(p, l), ldsb); break;
    case 7: st_router2(p, l, ldsb); break;
    case 8: st_moe1(p, l, ldsb); break;
    case 9: st_moe2(p, l, ldsb); break;
    case 10: gemm_stage((const bf16_t*)(p.ws + WS_HID) + 4 * DE, 5 * DE, (const bf16_t*)(p.ws + WS_WD) + (size_t)32 * D * DE, DE, l == 0 ? TA : TL, D, DE, make_epi_moef(p, l), ldsb); break;
    }
}


#define XB_TMO      128
#define XB_XCNT(j)  (256  + 64 * (j))
#define XB_XSUB(j)  (1280 + 64 * (j))
#define XB_XGEN(j)  (2304 + 64 * (j))
#define XB_TOP      3328
#define XB_TOPGEN   3392
#define XCD_BAR_WORDS 3456
#define XB_SPIN_CAP (1u << 22)
#define LAS __attribute__((address_space(3)))
__device__ __forceinline__ unsigned xb_ld(unsigned* p)              { return __hip_atomic_load(p, __ATOMIC_RELAXED, __HIP_MEMORY_SCOPE_AGENT); }
__device__ __forceinline__ unsigned xb_add(unsigned* p, unsigned v) { return __hip_atomic_fetch_add(p, v, __ATOMIC_RELAXED, __HIP_MEMORY_SCOPE_AGENT); }
__device__ __forceinline__ unsigned xb_xcc_id() { return (unsigned)__builtin_amdgcn_s_getreg((3 << 11) | 20) & 0xFu; }
#define XB_SPIN(cond, bar) do { unsigned _sp = 0; while (cond) { __builtin_amdgcn_s_sleep(1); \
    if ((++_sp & 255u) == 0u) { if (xb_ld(&(bar)[XB_TMO])) break; if (_sp > XB_SPIN_CAP) { atomicAdd(&(bar)[XB_TMO], 1u); break; } } } } while (0)
struct XcdBarrier { unsigned* bar; unsigned x; volatile LAS unsigned* st; };
__device__ __forceinline__ XcdBarrier xcd_barrier_post(unsigned* bar, volatile LAS unsigned* st) {
    XcdBarrier b; b.bar = bar; b.x = xb_xcc_id(); b.st = st;
    if (threadIdx.x == 0) (void)xb_add(&bar[XB_XCNT(b.x)], 1u);
    return b;
}
__device__ __forceinline__ void xcd_barrier_complete(unsigned* bar, unsigned x, unsigned& nloc, unsigned& nx) {
    const unsigned G = gridDim.x * gridDim.y * gridDim.z;
    unsigned sum, cnt, mine, sp = 0u;
    for (;;) {
        sum = 0u; cnt = 0u; mine = 0u;
#pragma unroll
        for (unsigned j = 0; j < 16; ++j) { const unsigned c = xb_ld(&bar[XB_XCNT(j)]); sum += c; cnt += (c > 0u) ? 1u : 0u; mine = (j == x) ? c : mine; }
        if (sum == G) break;
        __builtin_amdgcn_s_sleep(1);
        if ((++sp & 255u) == 0u) { if (xb_ld(&bar[XB_TMO])) break; if (sp > XB_SPIN_CAP) { atomicAdd(&bar[XB_TMO], 1u); break; } }
    }
    nloc = mine > 0u ? mine : 1u; nx = cnt > 0u ? cnt : 1u;
}
__device__ __forceinline__ void xcd_barrier(const XcdBarrier& b) {
    asm volatile("s_waitcnt vmcnt(0)" ::: "memory");
    __syncthreads();
    if (threadIdx.x == 0) {
        unsigned* bar = b.bar;
        __builtin_amdgcn_s_waitcnt(0);
        unsigned nloc = b.st[0], nx = b.st[1];
        if (nloc == 0u) { xcd_barrier_complete(bar, b.x, nloc, nx); b.st[0] = nloc; b.st[1] = nx; }
        const unsigned old = xb_add(&bar[XB_XSUB(b.x)], 1u);
        const unsigned gen = old / nloc;
        if (old + 1u == (gen + 1u) * nloc) {
            __builtin_amdgcn_fence(__ATOMIC_RELEASE, "agent");
            asm volatile("s_waitcnt vmcnt(0)" ::: "memory");
            const unsigned og = xb_add(&bar[XB_TOP], 1u);
            const unsigned tg = og / nx;
            if (og + 1u == (tg + 1u) * nx) xb_add(&bar[XB_TOPGEN], 1u);
            else XB_SPIN(xb_ld(&bar[XB_TOPGEN]) == tg, bar);
            __builtin_amdgcn_fence(__ATOMIC_ACQUIRE, "agent");
            xb_add(&bar[XB_XGEN(b.x)], 1u);
            asm volatile("s_waitcnt vmcnt(0)" ::: "memory");
        } else {
            XB_SPIN(xb_ld(&bar[XB_XGEN(b.x)]) == gen, bar);
            __builtin_amdgcn_fence(__ATOMIC_ACQUIRE, "agent");
            asm volatile("s_waitcnt vmcnt(0)" ::: "memory");
        }
    }
    __syncthreads();
}
constexpr size_t WS_XBAR = 4096;

template <int S> __device__ __forceinline__ void run_all(const P& p, unsigned char* lds, const XcdBarrier& xb) {
    run_stage(p, S, lds);
    if constexpr (S == REP_STAGE) { xcd_barrier(xb); run_stage(p, S, lds); }
    if constexpr (S + 1 < N_STAGES) {
        if constexpr (S == 0) cg::this_grid().sync();
        else xcd_barrier(xb);
        run_all<S + 1>(p, lds, xb);
    }
}
__global__ void __launch_bounds__(NT) mega(P p) {
    __shared__ __attribute__((aligned(16))) unsigned char lds[LDS_TOTAL + 16];
    volatile LAS unsigned* st = (volatile LAS unsigned*)(lds + LDS_TOTAL);
    if (threadIdx.x == 0) { st[0] = 0u; st[1] = 0u; }
    __syncthreads();
    const XcdBarrier xb = xcd_barrier_post((unsigned*)(p.ws + WS_CTL + WS_XBAR), st);
    run_all<0>(p, lds, xb);
}

extern "C" void kernel_launch(void* const* d_in, const int* in_sizes, int n_in, void* d_out, int out_size, void* d_ws, size_t ws_size, hipStream_t stream) {
    if (n_in != N_IN || ws_size < WS_END) { fprintf(stderr, "kernel_launch: unexpected n_in %d or ws_size %zu (< %zu)\n", n_in, ws_size, (size_t)WS_END); return; }
    P p{};
    for (int i = 0; i < N_IN; ++i) p.in[i] = (const float*)d_in[i];
    p.out = (float*)d_out; p.ws = (unsigned char*)d_ws;
    static int grid_blocks = 0;
    if (!grid_blocks) {
        int dev = 0, cus = 0, per_cu = 0;
        hipGetDevice(&dev);
        hipDeviceGetAttribute(&cus, hipDeviceAttributeMultiprocessorCount, dev);
        hipOccupancyMaxActiveBlocksPerMultiprocessor(&per_cu, (const void*)mega, NT, 0);
        if (per_cu < 1) per_cu = 1;
        if (per_cu > 2) per_cu = 2;
        grid_blocks = cus * per_cu;
    }
    hipMemsetAsync((char*)d_ws + WS_CTL, 0, 65536, stream);
    void* args[] = {&p};
    hipError_t e = hipLaunchCooperativeKernel((const void*)mega, dim3(grid_blocks), dim3(NT), args, 0, stream);
    if (e != hipSuccess) fprintf(stderr, "cooperative launch failed: %s (grid %d)\n", hipGetErrorString(e), grid_blocks);
}
```

```cpp
#include <hip/hip_runtime.h>
#include <hip/hip_cooperative_groups.h>
#include <cstdio>
#include <cstdint>
namespace cg = cooperative_groups;
constexpr int ABL = 0;

__device__ __forceinline__ int tid_opaque() { int t = threadIdx.x; asm volatile("" : "+v"(t)); return t; }
__device__ __forceinline__ int bid_opaque() { int b = blockIdx.x; asm volatile("" : "+s"(b)); return b; }
__device__ __forceinline__ int xcd_first(int total, int& end, int& step) {
    const int nb = gridDim.x; int b = blockIdx.x; asm volatile("" : "+s"(b));
    if (nb & 7) { end = total; step = nb; return b; }
    const int x = b & 7, j = b >> 3, per = (total + 7) >> 3, lo = x * per;
    end = lo + per < total ? lo + per : total; step = nb >> 3; return lo + j;
}
#define TIDX tid_opaque()
#define BIDX bid_opaque()

constexpr int D = 1024, NB = 8, L = 2048, LC = 256;
constexpr int TL = NB * L, TC = NB * LC, TA = TL + TC;
constexpr int DIN = 1792, DCONV = 256, DSSM = 256, DATT = 512;
constexpr int NQH = 8, NKVH = 2, HD = 64;
constexpr int COL_U = 768, COL_Q = 1024, COL_K = 1536, COL_V = 1664;
constexpr int NE = 32, TOPK = 4, DE = 128;
constexpr int SG = 16, SH = 16, SP = 64;
constexpr int NT = 256;

enum { I_X = 0, I_C, I_CTX, I_CCTX, I_WMOD, I_BMOD, I_N1G, I_N2G, I_WIN, I_CONVW, I_LRE, I_LIM, I_LDT, I_BRE, I_BIM, I_CRE, I_CIM,
       I_SD, I_WGLU, I_BGLU, I_QG, I_KG, I_SINK, I_WOUT, I_RW, I_RB, I_WEG, I_WEU, I_WED, I_WSG, I_WSU, I_WSD, N_IN };

typedef unsigned short bf16_t;
constexpr size_t WS_CTL = 0;
constexpr size_t WS_MOD = 65536;
constexpr size_t WS_ZERO_END = WS_MOD + (size_t)2 * 9 * 6 * D * 4;
constexpr size_t WS_RBIAS = 524288;
constexpr size_t WS_ROPE = WS_RBIAS + 4096;
constexpr size_t WS_KJ = WS_ROPE + 524288;
constexpr size_t WS_R1 = WS_KJ + 2097152;
constexpr size_t WS_BUFA = WS_R1;
constexpr size_t WS_PC = WS_BUFA + (size_t)TA * D * 2;
constexpr size_t WS_UA = WS_PC + (size_t)TA * 768 * 2;
constexpr size_t WS_E = WS_UA + (size_t)16 * 640 * 768 * 2;
constexpr size_t WS_G = WS_E + (size_t)16 * 640 * 256 * 4;
constexpr size_t WS_QB = WS_G + (size_t)TA * DSSM * 2;
constexpr size_t WS_KB = WS_QB + (size_t)TA * DATT * 2;
constexpr size_t WS_VT = WS_KB + (size_t)TA * 128 * 2;
constexpr size_t WS_SLAB = WS_R1;
constexpr size_t WS_HID = WS_SLAB + (size_t)TA * 4 * D * 2;
constexpr size_t WS_HC1 = WS_HID + (size_t)TA * 5 * DE * 2;
constexpr size_t WS_HCMID = WS_HC1 + (size_t)TC * D * 4;
constexpr size_t WS_LCODE = WS_HCMID + (size_t)TC * D * 4;
constexpr size_t WS_LW = WS_LCODE + (size_t)NE * TA * 4;
constexpr size_t WS_WTIN = WS_LW + (size_t)NE * TA * 4;
constexpr size_t WS_WTOUT = WS_WTIN + (size_t)DIN * D * 2;
constexpr size_t WS_WTGLU = WS_WTOUT + (size_t)D * D * 2;
constexpr size_t WS_WGU = WS_WTGLU + (size_t)DSSM * DSSM * 2;
constexpr size_t WS_WD = WS_WGU + (size_t)33 * 256 * D * 2;
constexpr size_t WS_WST = WS_WD + (size_t)33 * D * DE * 2;
constexpr size_t WS_KW = WS_WST + (size_t)16 * 256 * 512 * 2;
constexpr size_t WS_END = WS_KW + (size_t)16 * 512 * 768 * 2;
static_assert(WS_VT + (size_t)TA * 128 * 2 <= WS_HID, "overlay");
static_assert(WS_ZERO_END <= WS_RBIAS, "zero region");
static_assert(WS_END <= 268435456, "workspace too large");

struct P {
    const float* in[N_IN];
    float* out;
    unsigned char* ws;
};

__device__ __forceinline__ bf16_t f2bf(float f) { unsigned u = __float_as_uint(f); u += 0x7FFFu + ((u >> 16) & 1u); return (bf16_t)(u >> 16); }
__device__ __forceinline__ float bf2f(bf16_t b) { return __uint_as_float((unsigned)b << 16); }
__device__ __forceinline__ unsigned cvt_pk_bf16(float lo, float hi) { unsigned r; asm("v_cvt_pk_bf16_f32 %0, %1, %2" : "=v"(r) : "v"(lo), "v"(hi)); return r; }
typedef __attribute__((ext_vector_type(4))) float f32x4;
struct BfPtr { const bf16_t* p; __device__ __forceinline__ float operator[](long i) const { return bf2f(p[i]); }
               __device__ __forceinline__ BfPtr operator+(long o) const { return BfPtr{p + o}; } };
__device__ __forceinline__ float silu_f(float x) { return x / (1.f + expf(-x)); }
__device__ __forceinline__ float sigmoid_f(float x) { return 1.f / (1.f + expf(-x)); }
__device__ __forceinline__ float gelu_f(float x) { return 0.5f * x * (1.f + tanhf(0.7978845608028654f * (x + 0.044715f * x * x * x))); }
__device__ __forceinline__ float wave_sum(float v) {
#pragma unroll
    for (int o = 32; o > 0; o >>= 1) v += __shfl_xor(v, o);
    return v;
}
__device__ __forceinline__ int row_bb(int r) { return r < TL ? r / L : 8; }
__device__ __forceinline__ const float* h_row(const P& p, int l, int r) {
    if (r < TL) return (l == 0 ? p.in[I_X] : p.out) + (size_t)r * D;
    return (l == 0 ? p.in[I_CTX] : (const float*)(p.ws + WS_HC1)) + (size_t)(r - TL) * D;
}
__device__ __forceinline__ float* hmid_row(const P& p, int r) {
    if (r < TL) return p.out + (size_t)r * D;
    return (float*)(p.ws + WS_HCMID) + (size_t)(r - TL) * D;
}
__device__ __forceinline__ const float* mod_vec(const P& p, int l, int bb, int chunk) {
    return (const float*)(p.ws + WS_MOD) + ((size_t)(l * 9 + bb) * 6 + chunk) * D;
}

__device__ __forceinline__ void st_mod(const P& p, float* lds) {
    float* red = lds + 9 * D;
    for (int i = TIDX; i < 9 * D; i += NT) {
        const int bb = i / D, k = i % D;
        const float c = bb < 8 ? p.in[I_C][bb * D + k] : p.in[I_CCTX][k];
        lds[i] = silu_f(c);
    }
    __syncthreads();
    float* mod = (float*)(p.ws + WS_MOD);
    const int col = TIDX & 31, ks = TIDX >> 5;
    for (int item = BIDX; item < 2 * 6 * D / 32; item += gridDim.x) {
        const int l = item / (6 * D / 32), j = (item % (6 * D / 32)) * 32 + col;
        const float* w = p.in[I_WMOD] + (size_t)l * D * 6 * D + j;
        float acc[9];
#pragma unroll
        for (int bb = 0; bb < 9; ++bb) acc[bb] = 0.f;
        for (int k = ks * 128; k < ks * 128 + 128; ++k) {
            const float wv = w[(size_t)k * 6 * D];
#pragma unroll
            for (int bb = 0; bb < 9; ++bb) acc[bb] += lds[bb * D + k] * wv;
        }
#pragma unroll
        for (int bb = 0; bb < 9; ++bb) red[(bb * 8 + ks) * 32 + col] = acc[bb];
        __syncthreads();
        for (int o = TIDX; o < 9 * 32; o += NT) {
            const int bb = o >> 5, c2 = o & 31;
            float sum = p.in[I_BMOD][l * 6 * D + (item % (6 * D / 32)) * 32 + c2];
#pragma unroll
            for (int q = 0; q < 8; ++q) sum += red[(bb * 8 + q) * 32 + c2];
            mod[(size_t)(l * 9 + bb) * 6 * D + (item % (6 * D / 32)) * 32 + c2] = sum;
        }
        __syncthreads();
    }
}

__device__ __forceinline__ void st_norm(const P& p, int l, int which) {
    const int lane = TIDX & 63, wv = TIDX >> 6;
    const int nrows = (which == 1 && l == 1) ? TL : TA;
    float* xn = (float*)(p.ws + WS_BUFA);
    const float* g = p.in[which == 0 ? I_N1G : I_N2G] + l * D;
    for (int r = BIDX * 4 + wv; r < nrows; r += gridDim.x * 4) {
        const float* src = which == 0 ? h_row(p, l, r) : hmid_row(p, r);
        const int bb = row_bb(r);
        const float* sh = mod_vec(p, l, bb, which == 0 ? 0 : 3);
        const float* sc = mod_vec(p, l, bb, which == 0 ? 1 : 4);
        float4 v[4];
        float s = 0.f;
#pragma unroll
        for (int j = 0; j < 4; ++j) { v[j] = *(const float4*)(src + j * 256 + lane * 4); s += v[j].x * v[j].x + v[j].y * v[j].y + v[j].z * v[j].z + v[j].w * v[j].w; }
        s = wave_sum(s);
        const float rinv = rsqrtf(s * (1.f / D) + 1e-6f);
#pragma unroll
        for (int j = 0; j < 4; ++j) {
            const int k = j * 256 + lane * 4;
            const float4 gg = *(const float4*)(g + k), s1 = *(const float4*)(sc + k), s0 = *(const float4*)(sh + k);
            float4 o;
            o.x = v[j].x * rinv * gg.x * (1.f + s1.x) + s0.x;
            o.y = v[j].y * rinv * gg.y * (1.f + s1.y) + s0.y;
            o.z = v[j].z * rinv * gg.z * (1.f + s1.z) + s0.z;
            o.w = v[j].w * rinv * gg.w * (1.f + s1.w) + s0.w;
            if (which == 1) *(float4*)(xn + (size_t)r * D + k) = o;
            else { uint2 pk; pk.x = (unsigned)f2bf(o.x) | ((unsigned)f2bf(o.y) << 16); pk.y = (unsigned)f2bf(o.z) | ((unsigned)f2bf(o.w) << 16);
                   *(uint2*)((bf16_t*)(p.ws + WS_BUFA) + (size_t)r * D + k) = pk; }
        }
    }
}


__device__ __forceinline__ void st_conv(const P& p, int l) {
    const BfPtr pb{(const bf16_t*)(p.ws + WS_PC)};
    bf16_t* mix = (bf16_t*)(p.ws + WS_BUFA);
    const float* cw = p.in[I_CONVW] + l * 3 * DCONV;
    const int nrows = l == 0 ? TA : TL;
    for (int idx = BIDX * NT + TIDX; idx < nrows * DCONV; idx += gridDim.x * NT) {
        const int r = idx / DCONV, ch = idx % DCONV;
        int t, len;
        if (r < TL) { t = r % L; len = L; } else { t = (r - TL) % LC; len = LC; }
        const BfPtr pr = pb + (long)r * 768;
        float y = cw[DCONV + ch] * (pr[512 + ch] * pr[ch]);
        if (t > 0) y += cw[ch] * (pr[-768 + 512 + ch] * pr[-768 + ch]);
        if (t < len - 1) y += cw[2 * DCONV + ch] * (pr[768 + 512 + ch] * pr[768 + ch]);
        mix[(size_t)r * D + ch] = f2bf(pr[256 + ch] * y);
    }
}

struct EpiOut { const float* modl; const float* hlat; const float* hctx; float* out; float* hcmid;
    __device__ __forceinline__ void operator()(int r, int c, float v0, float v1, float v2, float v3) const {
    const int bb = row_bb(r);
    const f32x4 g1 = *(const f32x4*)(modl + ((size_t)bb * 6 + 2) * D + c);
    const f32x4 hv = *(const f32x4*)((r < TL ? hlat + (size_t)r * D : hctx + (size_t)(r - TL) * D) + c);
    f32x4 o; o[0] = hv[0] + g1[0] * v0; o[1] = hv[1] + g1[1] * v1; o[2] = hv[2] + g1[2] * v2; o[3] = hv[3] + g1[3] * v3;
    *(f32x4*)((r < TL ? out + (size_t)r * D : hcmid + (size_t)(r - TL) * D) + c) = o; } };
__device__ __forceinline__ EpiOut make_epi_out(const P& p, int l) {
    return EpiOut{(const float*)(p.ws + WS_MOD) + (size_t)l * 9 * 6 * D, l == 0 ? p.in[I_X] : p.out, l == 0 ? p.in[I_CTX] : (const float*)(p.ws + WS_HC1), p.out, (float*)(p.ws + WS_HCMID)};
}

typedef __attribute__((ext_vector_type(8))) short bf16x8;
typedef __attribute__((ext_vector_type(16))) float f32x16;
typedef __attribute__((ext_vector_type(4))) unsigned u32x4;
constexpr int G_ROWB = 80;
constexpr int G_TILEB = 128 * G_ROWB;
constexpr int LDS_BYTES = 4 * G_TILEB;

template <class ARow>
__device__ __forceinline__ void gemm_tile(f32x16 (&acc)[2][2], ARow arow, const bf16_t* Bt, int ldb, int K, unsigned char* lds) {
    const int t = TIDX, lane = t & 63, w = t >> 6, wr = w >> 1, wc = w & 1, lr = lane & 31, lh = lane >> 5;
    const int srow = t >> 2, kc = t & 3;
    const bf16_t* ap[2]; const bf16_t* bp[2];
#pragma unroll
    for (int i = 0; i < 2; ++i) { ap[i] = arow(srow + 64 * i) + kc * 8; bp[i] = Bt + (size_t)(srow + 64 * i) * ldb + kc * 8; }
    float zf = 0.f; asm volatile("" : "+v"(zf));
#pragma unroll
    for (int mi = 0; mi < 2; ++mi)
#pragma unroll
        for (int ni = 0; ni < 2; ++ni)
#pragma unroll
            for (int r = 0; r < 16; ++r) acc[mi][ni][r] = zf;
    bf16x8 zfrag; { unsigned zz = 0u; asm volatile("" : "+v"(zz)); u32x4 zv; zv[0] = zz; zv[1] = zz; zv[2] = zz; zv[3] = zz; zfrag = __builtin_bit_cast(bf16x8, zv); }
    const int nk = K >> 5;
    const int soff = srow * G_ROWB + kc * 16;
    const int aoff = (wr * 64 + lr) * G_ROWB + lh * 16, boff = 2 * G_TILEB + (wc * 64 + lr) * G_ROWB + lh * 16;
    u32x4 r0[4], r1[4], r2[4];
#define G_LOAD(R, ks) do { R[0] = *(const u32x4*)(ap[0] + (ks) * 32); R[1] = *(const u32x4*)(ap[1] + (ks) * 32); \
                           R[2] = *(const u32x4*)(bp[0] + (ks) * 32); R[3] = *(const u32x4*)(bp[1] + (ks) * 32); } while (0)
#define G_WRITE(R, buf) do { unsigned char* d_ = lds + (buf) * G_TILEB + soff; *(u32x4*)(d_) = R[0]; *(u32x4*)(d_ + 64 * G_ROWB) = R[1]; \
                             *(u32x4*)(d_ + 2 * G_TILEB) = R[2]; *(u32x4*)(d_ + 2 * G_TILEB + 64 * G_ROWB) = R[3]; } while (0)
#define G_COMPUTE(buf) do { const unsigned char* c_ = lds + (buf) * G_TILEB; _Pragma("unroll") for (int s2 = 0; s2 < 2; ++s2) { \
        const bf16x8 a0 = *(const bf16x8*)(c_ + aoff + s2 * 32), a1 = *(const bf16x8*)(c_ + aoff + 32 * G_ROWB + s2 * 32); \
        const bf16x8 b0 = *(const bf16x8*)(c_ + boff + s2 * 32), b1 = *(const bf16x8*)(c_ + boff + 32 * G_ROWB + s2 * 32); \
        acc[0][0] = __builtin_amdgcn_mfma_f32_32x32x16_bf16(b0, a0, acc[0][0], 0, 0, 0); \
        acc[0][1] = __builtin_amdgcn_mfma_f32_32x32x16_bf16(b1, a0, acc[0][1], 0, 0, 0); \
        acc[1][0] = __builtin_amdgcn_mfma_f32_32x32x16_bf16(b0, a1, acc[1][0], 0, 0, 0); \
        acc[1][1] = __builtin_amdgcn_mfma_f32_32x32x16_bf16(b1, a1, acc[1][1], 0, 0, 0); \
        if (ABL == 1) { acc[0][0] = __builtin_amdgcn_mfma_f32_32x32x16_bf16(zfrag, a0, acc[0][0], 0, 0, 0); acc[0][1] = __builtin_amdgcn_mfma_f32_32x32x16_bf16(zfrag, a0, acc[0][1], 0, 0, 0); \
                        acc[1][0] = __builtin_amdgcn_mfma_f32_32x32x16_bf16(zfrag, a1, acc[1][0], 0, 0, 0); acc[1][1] = __builtin_amdgcn_mfma_f32_32x32x16_bf16(zfrag, a1, acc[1][1], 0, 0, 0); } \
        if (ABL == 2) { const bf16x8 e0 = *(const volatile bf16x8*)(c_ + aoff + s2 * 32), e1 = *(const volatile bf16x8*)(c_ + aoff + 32 * G_ROWB + s2 * 32); \
                        const bf16x8 e2 = *(const volatile bf16x8*)(c_ + boff + s2 * 32), e3 = *(const volatile bf16x8*)(c_ + boff + 32 * G_ROWB + s2 * 32); \
                        asm volatile("" :: "v"(e0), "v"(e1), "v"(e2), "v"(e3)); } \
        } } while (0)
#define G_STEP(RN, ks) do { G_COMPUTE((ks) & 1); if ((ks) + 1 < nk) G_WRITE(RN, ((ks) + 1) & 1); if ((ks) + 4 < nk) G_LOAD(RN, (ks) + 4); \
        if (ABL == 3 && (ks) + 4 < nk) { u32x4 x0 = *(const volatile u32x4*)(ap[0] + ((ks) + 4) * 32), x1 = *(const volatile u32x4*)(ap[1] + ((ks) + 4) * 32), x2 = *(const volatile u32x4*)(bp[0] + ((ks) + 4) * 32), x3 = *(const volatile u32x4*)(bp[1] + ((ks) + 4) * 32); asm volatile("" :: "v"(x0), "v"(x1), "v"(x2), "v"(x3)); } \
        __syncthreads(); if (ABL == 4) __syncthreads(); } while (0)
    G_LOAD(r0, 0);
    if (1 < nk) G_LOAD(r1, 1);
    if (2 < nk) G_LOAD(r2, 2);
    __syncthreads();
    G_WRITE(r0, 0);
    if (3 < nk) G_LOAD(r0, 3);
    __syncthreads();
    for (int ks = 0; ks < nk; ks += 3) {
        G_STEP(r1, ks);
        if (ks + 1 < nk) G_STEP(r2, ks + 1);
        if (ks + 2 < nk) G_STEP(r0, ks + 2);
    }
#undef G_LOAD
#undef G_WRITE
#undef G_COMPUTE
#undef G_STEP
}
template <class F>
__device__ __forceinline__ void acc_foreach4(const f32x16 (&acc)[2][2], F f) {
    const int lane = TIDX & 63, w = (TIDX >> 6) & 3, wr = w >> 1, wc = w & 1, lr = lane & 31, lh = lane >> 5;
#pragma unroll
    for (int mi = 0; mi < 2; ++mi)
#pragma unroll
        for (int ni = 0; ni < 2; ++ni)
#pragma unroll
            for (int g = 0; g < 4; ++g)
                f(wr * 64 + mi * 32 + lr, wc * 64 + ni * 32 + 8 * g + 4 * lh, acc[mi][ni][4 * g], acc[mi][ni][4 * g + 1], acc[mi][ni][4 * g + 2], acc[mi][ni][4 * g + 3]);
}
__device__ __forceinline__ uint2 pack4(float a, float b, float c, float d) { uint2 o; o.x = cvt_pk_bf16(a, b); o.y = cvt_pk_bf16(c, d); return o; }
struct ARowPlain { const bf16_t* A; int lda; __device__ __forceinline__ const bf16_t* operator()(int m) const { return A + (size_t)m * lda; } };

template <class Epi>
__device__ __forceinline__ void gemm_stage(const bf16_t* A, int lda, const bf16_t* Bt, int ldb, int M, int N, int K, Epi epi, unsigned char* lds) {
    const int tn = N / 128, tm = M / 128;
    int t_end, t_step;
    for (int tile = xcd_first(tm * tn, t_end, t_step); tile < t_end; tile += t_step) {
        const int m0 = (tile / tn) * 128, n0 = (tile % tn) * 128;
        f32x16 acc[2][2];
        gemm_tile(acc, ARowPlain{A + (size_t)m0 * lda, lda}, Bt + (size_t)n0 * ldb, ldb, K, lds);
        acc_foreach4(acc, [&](int r, int c, float v0, float v1, float v2, float v3) { epi(m0 + r, n0 + c, v0, v1, v2, v3); });
    }
}
__device__ __forceinline__ void prep_tr(const float* src, size_t sk, bf16_t* dst, int N, int K) {
    const int per = N * (K / 8);
    for (int idx = BIDX * NT + TIDX; idx < per; idx += gridDim.x * NT) {
        const int n = idx % N, kc = idx / N;
        const float* sp = src + (size_t)kc * 8 * sk + n;
        uint4 o;
        o.x = (unsigned)f2bf(sp[0]) | ((unsigned)f2bf(sp[sk]) << 16);
        o.y = (unsigned)f2bf(sp[2 * sk]) | ((unsigned)f2bf(sp[3 * sk]) << 16);
        o.z = (unsigned)f2bf(sp[4 * sk]) | ((unsigned)f2bf(sp[5 * sk]) << 16);
        o.w = (unsigned)f2bf(sp[6 * sk]) | ((unsigned)f2bf(sp[7 * sk]) << 16);
        *(uint4*)(dst + (size_t)n * K + kc * 8) = o;
    }
}
__device__ __forceinline__ void st_prep_dense(const P& p, int l) {
    prep_tr(p.in[I_WIN] + (size_t)l * D * DIN, DIN, (bf16_t*)(p.ws + WS_WTIN), DIN, D);
    prep_tr(p.in[I_WOUT] + (size_t)l * D * D, D, (bf16_t*)(p.ws + WS_WTOUT), D, D);
    prep_tr(p.in[I_WGLU] + (size_t)l * DSSM * DSSM, DSSM, (bf16_t*)(p.ws + WS_WTGLU), DSSM, DSSM);
}
struct EpiStoreBf { bf16_t* C; int ldc; __device__ __forceinline__ void operator()(int r, int c, float v0, float v1, float v2, float v3) const { *(uint2*)(C + (size_t)r * ldc + c) = pack4(v0, v1, v2, v3); } };


__device__ __forceinline__ void st_rbias(const P& p, int l, float* lds) {
    if (BIDX < 9) {
        const int bb = BIDX, e = TIDX & 31, ks = TIDX >> 5;
        const float* sh2 = mod_vec(p, l, bb, 3);
        const float* rw = p.in[I_RW] + (size_t)l * D * NE;
        float a = 0.f;
        for (int k = ks * 128; k < ks * 128 + 128; ++k) a += sh2[k] * rw[k * NE + e];
        lds[TIDX] = a;
        __syncthreads();
        if (TIDX < 32) { float s = 0.f; for (int j = 0; j < 8; ++j) s += lds[j * 32 + TIDX]; ((float*)(p.ws + WS_RBIAS))[(l * 9 + bb) * 32 + TIDX] = s; }
        __syncthreads();
    }
}
__device__ __forceinline__ void st_router2(const P& p, int l, unsigned char* ldsb) {
    const int lane = TIDX & 63, w = TIDX >> 6, i = lane & 31, hf = lane >> 5;
    float* sc = (float*)ldsb + w * (32 * 33);
    const int nrows = l == 0 ? TA : TL;
    const float* g2 = p.in[I_N2G] + l * D;
    const float* rw = p.in[I_RW] + (size_t)l * D * NE;
    int* cnt = (int*)(p.ws + WS_CTL) + l * NE;
    int* lcode = (int*)(p.ws + WS_LCODE);
    float* lw = (float*)(p.ws + WS_LW);
    bf16_t* xn2 = (bf16_t*)(p.ws + WS_BUFA);
    for (int item = BIDX * 4 + w; item < nrows / 32; item += gridDim.x * 4) {
        const int r0 = item * 32, bb = row_bb(r0);
        const float* sc2 = mod_vec(p, l, bb, 4);
        const float* sh2 = mod_vec(p, l, bb, 3);
        const float* src = hmid_row(p, r0 + i) + hf * 512;
        f32x16 acc;
        float zf = 0.f; asm volatile("" : "+v"(zf));
#pragma unroll
        for (int r = 0; r < 16; ++r) acc[r] = zf;
        float ss = 0.f;
        for (int c = 0; c < 128; ++c) {
            const int k = hf * 512 + 4 * c;
            const f32x4 x = *(const f32x4*)(src + 4 * c);
            const f32x4 gg = *(const f32x4*)(g2 + k), s1 = *(const f32x4*)(sc2 + k);
            ss += x[0] * x[0] + x[1] * x[1] + x[2] * x[2] + x[3] * x[3];
#pragma unroll
            for (int q = 0; q < 4; ++q) {
                const float a = x[q] * (gg[q] * (1.f + s1[q]));
                const float b = rw[(size_t)(k + q) * NE + i];
                acc = __builtin_amdgcn_mfma_f32_32x32x2f32(a, b, acc, 0, 0, 0);
            }
        }
        ss += __shfl_xor(ss, 32);
        const float rinv = rsqrtf(ss * (1.f / D) + 1e-6f);
        const float rb = ((const float*)(p.ws + WS_RBIAS))[(l * 9 + bb) * 32 + i];
#pragma unroll
        for (int r = 0; r < 16; ++r) {
            const int rho = (r & 3) + 8 * (r >> 2) + 4 * hf;
            const float rr = __shfl(rinv, rho);
            sc[rho * 33 + i] = sigmoid_f(rr * acc[r] + rb);
        }
        __builtin_amdgcn_s_waitcnt(0xc07f);
        __builtin_amdgcn_wave_barrier();
        {
            float gs[16], sh[16];
#pragma unroll
            for (int q = 0; q < 16; ++q) { const int k = (q >> 3) * 512 + 8 * lane + (q & 7); gs[q] = g2[k] * (1.f + sc2[k]); sh[q] = sh2[k]; }
            for (int rho = 0; rho < 32; ++rho) {
                const float rr = __shfl(rinv, rho);
                const float* s2 = hmid_row(p, r0 + rho);
                bf16_t* dst = xn2 + (size_t)(r0 + rho) * D;
#pragma unroll
                for (int h2 = 0; h2 < 2; ++h2) {
                    const f32x4 x0 = *(const f32x4*)(s2 + h2 * 512 + 8 * lane), x1 = *(const f32x4*)(s2 + h2 * 512 + 8 * lane + 4);
                    u32x4 o;
                    o[0] = (unsigned)f2bf(x0[0] * rr * gs[h2 * 8 + 0] + sh[h2 * 8 + 0]) | ((unsigned)f2bf(x0[1] * rr * gs[h2 * 8 + 1] + sh[h2 * 8 + 1]) << 16);
                    o[1] = (unsigned)f2bf(x0[2] * rr * gs[h2 * 8 + 2] + sh[h2 * 8 + 2]) | ((unsigned)f2bf(x0[3] * rr * gs[h2 * 8 + 3] + sh[h2 * 8 + 3]) << 16);
                    o[2] = (unsigned)f2bf(x1[0] * rr * gs[h2 * 8 + 4] + sh[h2 * 8 + 4]) | ((unsigned)f2bf(x1[1] * rr * gs[h2 * 8 + 5] + sh[h2 * 8 + 5]) << 16);
                    o[3] = (unsigned)f2bf(x1[2] * rr * gs[h2 * 8 + 6] + sh[h2 * 8 + 6]) | ((unsigned)f2bf(x1[3] * rr * gs[h2 * 8 + 7] + sh[h2 * 8 + 7]) << 16);
                    *(u32x4*)(dst + h2 * 512 + 8 * lane) = o;
                }
            }
        }
        if (lane < 32) {
            const int r = r0 + lane;
            float sel[32];
#pragma unroll
            for (int e = 0; e < 32; ++e) sel[e] = sc[lane * 33 + e] + p.in[I_RB][l * NE + e];
            int bi[4]; float sv[4]; float sum = 0.f;
#pragma unroll
            for (int k = 0; k < 4; ++k) {
                float best = -1e30f; int b = 0;
#pragma unroll
                for (int e = 0; e < 32; ++e) if (sel[e] > best) { best = sel[e]; b = e; }
#pragma unroll
                for (int e = 0; e < 32; ++e) if (e == b) sel[e] = -1e30f;
                bi[k] = b; sv[k] = sc[lane * 33 + b]; sum += sv[k];
            }
#pragma unroll
            for (int k = 0; k < 4; ++k) {
                const int pos = atomicAdd(&cnt[bi[k]], 1);
                lcode[(size_t)bi[k] * TA + pos] = r * 4 + k;
                lw[(size_t)bi[k] * TA + pos] = sv[k] / sum * 2.5f;
            }
        }
        __builtin_amdgcn_wave_barrier();
    }
}

constexpr int MOE_LDS_LIST = LDS_BYTES;
constexpr int LDS_MOE = LDS_BYTES + 128 * 4 + 128 * 4 + 64 * 4;
constexpr int LDS_MODB = (9 * D + 9 * 8 * 32) * 4;
constexpr int LDS_TOTAL = LDS_MOE > LDS_MODB ? LDS_MOE : LDS_MODB;
struct ARowCode { const bf16_t* base; const int* codes; int mode; __device__ __forceinline__ const bf16_t* operator()(int m) const {
    const int c = codes[m];
    if (mode == 0) return base + (size_t)(c < 0 ? 0 : (c >> 2)) * D;
    return base + (size_t)(c < 0 ? 0 : (c >> 2) * 5 + (c & 3)) * DE; } };
__device__ __forceinline__ void moe_tstart(const P& p, int l, int* ts) {
    if (TIDX == 0) { const int* cnt = (const int*)(p.ws + WS_CTL) + l * NE; int a = 0; for (int e = 0; e < NE; ++e) { ts[e] = a; a += (cnt[e] + 127) >> 7; } ts[NE] = a; }
    __syncthreads();
}
__device__ __forceinline__ void st_moe1(const P& p, int l, unsigned char* lds) {
    int* codes = (int*)(lds + MOE_LDS_LIST); float* wts = (float*)(codes + 128); int* ts = (int*)(wts + 128);
    const int nrows = l == 0 ? TA : TL;
    const int* cnt = (const int*)(p.ws + WS_CTL) + l * NE;
    const int* lcode = (const int*)(p.ws + WS_LCODE);
    const float* lw = (const float*)(p.ws + WS_LW);
    const bf16_t* xn2 = (const bf16_t*)(p.ws + WS_BUFA);
    bf16_t* hid = (bf16_t*)(p.ws + WS_HID);
    const bf16_t* wgu = (const bf16_t*)(p.ws + WS_WGU);
    moe_tstart(p, l, ts);
    const int nrt = ts[NE], nsh = nrows / 128, total = (nrt + nsh) * 2;
    const int lane = TIDX & 63, w = TIDX >> 6, wr = w >> 1, wc = w & 1, lr = lane & 31, lh = lane >> 5;
    int t_end, t_step;
    for (int tile = xcd_first(total, t_end, t_step); tile < t_end; tile += t_step) {
        const int rt = tile >> 1, j = tile & 1;
        int e, m0, valid;
        if (rt < nrt) { e = 0; while (ts[e + 1] <= rt) ++e; m0 = (rt - ts[e]) * 128; valid = cnt[e] - m0; if (valid > 128) valid = 128; }
        else { e = NE; m0 = (rt - nrt) * 128; valid = 128; }
        __syncthreads();
        if (TIDX < 128) {
            const int m = TIDX;
            if (e < NE) { const bool ok = m < valid; codes[m] = ok ? lcode[(size_t)e * TA + m0 + m] : -1; wts[m] = ok ? lw[(size_t)e * TA + m0 + m] : 0.f; }
            else { codes[m] = (m0 + m) * 4; wts[m] = 1.f; }
        }
        __syncthreads();
        f32x16 acc[2][2];
        gemm_tile(acc, ARowCode{xn2, codes, 0}, wgu + (size_t)((e * 2 + j) * 128) * D, D, D, lds);
#pragma unroll
        for (int mi = 0; mi < 2; ++mi) {
            const int m = wr * 64 + mi * 32 + lr;
            const int c = codes[m];
            if (c >= 0) {
                const float wt = wts[m];
                const size_t hrow = e < NE ? (size_t)(c >> 2) * 5 + (c & 3) : (size_t)(c >> 2) * 5 + 4;
#pragma unroll
                for (int g = 0; g < 4; ++g) {
                    float h[4];
#pragma unroll
                    for (int q = 0; q < 4; ++q) h[q] = silu_f(acc[mi][0][4 * g + q]) * acc[mi][1][4 * g + q] * wt;
                    *(uint2*)(hid + hrow * DE + j * 64 + wc * 32 + 8 * g + 4 * lh) = pack4(h[0], h[1], h[2], h[3]);
                }
            }
        }
    }
}
__device__ __forceinline__ void st_moe2(const P& p, int l, unsigned char* lds) {
    int* codes = (int*)(lds + MOE_LDS_LIST); float* wts = (float*)(codes + 128); int* ts = (int*)(wts + 128);
    const int* cnt = (const int*)(p.ws + WS_CTL) + l * NE;
    const int* lcode = (const int*)(p.ws + WS_LCODE);
    const bf16_t* hid = (const bf16_t*)(p.ws + WS_HID);
    bf16_t* slab = (bf16_t*)(p.ws + WS_SLAB);
    const bf16_t* wd = (const bf16_t*)(p.ws + WS_WD);
    moe_tstart(p, l, ts);
    const int nrt = ts[NE], total = nrt * 8;
    int t_end, t_step;
    for (int tile = xcd_first(total, t_end, t_step); tile < t_end; tile += t_step) {
        const int rt = tile >> 3, n0 = (tile & 7) * 128;
        int e = 0; while (ts[e + 1] <= rt) ++e;
        const int m0 = (rt - ts[e]) * 128; int valid = cnt[e] - m0; if (valid > 128) valid = 128;
        __syncthreads();
        if (TIDX < 128) { const int m = TIDX; codes[m] = m < valid ? lcode[(size_t)e * TA + m0 + m] : -1; }
        __syncthreads();
        f32x16 acc[2][2];
        gemm_tile(acc, ARowCode{hid, codes, 1}, wd + ((size_t)e * D + n0) * DE, DE, DE, lds);
        acc_foreach4(acc, [&](int r, int c, float v0, float v1, float v2, float v3) { const int code = codes[r]; if (code >= 0) *(uint2*)(slab + (size_t)code * D + n0 + c) = pack4(v0, v1, v2, v3); });
    }
}
struct EpiMoeF { const bf16_t* slab; const float* modl; float* out; const float* hcmid; float* hc1;
    __device__ __forceinline__ void operator()(int r, int c, float v0, float v1, float v2, float v3) const {
    const bf16_t* sl = slab + (size_t)r * 4 * D + c;
    float v[4] = {v0, v1, v2, v3};
#pragma unroll
    for (int k = 0; k < 4; ++k) { const uint2 q = *(const uint2*)(sl + (size_t)k * D);
        v[0] += __uint_as_float(q.x << 16); v[1] += __uint_as_float(q.x & 0xffff0000u); v[2] += __uint_as_float(q.y << 16); v[3] += __uint_as_float(q.y & 0xffff0000u); }
    const f32x4 g2 = *(const f32x4*)(modl + ((size_t)row_bb(r) * 6 + 5) * D + c);
    const f32x4 hm = *(const f32x4*)((r < TL ? out + (size_t)r * D : hcmid + (size_t)(r - TL) * D) + c);
    f32x4 o; o[0] = hm[0] + g2[0] * v[0]; o[1] = hm[1] + g2[1] * v[1]; o[2] = hm[2] + g2[2] * v[2]; o[3] = hm[3] + g2[3] * v[3];
    *(f32x4*)((r < TL ? out + (size_t)r * D : hc1 + (size_t)(r - TL) * D) + c) = o; } };
__device__ __forceinline__ EpiMoeF make_epi_moef(const P& p, int l) {
    return EpiMoeF{(const bf16_t*)(p.ws + WS_SLAB), (const float*)(p.ws + WS_MOD) + (size_t)l * 9 * 6 * D, p.out, (const float*)(p.ws + WS_HCMID), (float*)(p.ws + WS_HC1)};
}
__device__ __forceinline__ void st_prep_moe(const P& p, int l) {
    bf16_t* wgu = (bf16_t*)(p.ws + WS_WGU);
    const int tot1 = 33 * 2 * 4 * 128 * 32;
    for (int idx = BIDX * NT + TIDX; idx < tot1; idx += gridDim.x * NT) {
        const int i = idx & 31; int q_ = idx >> 5; const int kc = q_ & 127; q_ >>= 7; const int q = q_ & 3; q_ >>= 2; const int j = q_ & 1; const int e = q_ >> 1;
        const int wc = q >> 1, ni = q & 1, unit = j * 64 + wc * 32 + i;
        const float* sp; size_t sk;
        if (e < NE) { sp = p.in[ni ? I_WEU : I_WEG] + ((size_t)(l * D + kc * 8) * NE + e) * DE + unit; sk = (size_t)NE * DE; }
        else { sp = p.in[ni ? I_WSU : I_WSG] + (size_t)(l * D + kc * 8) * DE + unit; sk = DE; }
        u32x4 o;
        o[0] = (unsigned)f2bf(sp[0]) | ((unsigned)f2bf(sp[sk]) << 16);
        o[1] = (unsigned)f2bf(sp[2 * sk]) | ((unsigned)f2bf(sp[3 * sk]) << 16);
        o[2] = (unsigned)f2bf(sp[4 * sk]) | ((unsigned)f2bf(sp[5 * sk]) << 16);
        o[3] = (unsigned)f2bf(sp[6 * sk]) | ((unsigned)f2bf(sp[7 * sk]) << 16);
        *(u32x4*)(wgu + ((size_t)(e * 2 + j) * 128 + q * 32 + i) * D + kc * 8) = o;
    }
    bf16_t* wd = (bf16_t*)(p.ws + WS_WD);
    const int tot2 = 33 * 16 * 1024;
    for (int idx = BIDX * NT + TIDX; idx < tot2; idx += gridDim.x * NT) {
        const int n = idx & 1023; int q_ = idx >> 10; const int kc = q_ & 15; const int e = q_ >> 4;
        const float* sp = (e < NE ? p.in[I_WED] + ((size_t)(l * NE + e) * DE + kc * 8) * D : p.in[I_WSD] + ((size_t)l * DE + kc * 8) * D) + n;
        u32x4 o;
        o[0] = (unsigned)f2bf(sp[0]) | ((unsigned)f2bf(sp[D]) << 16);
        o[1] = (unsigned)f2bf(sp[2 * D]) | ((unsigned)f2bf(sp[3 * D]) << 16);
        o[2] = (unsigned)f2bf(sp[4 * D]) | ((unsigned)f2bf(sp[5 * D]) << 16);
        o[3] = (unsigned)f2bf(sp[6 * D]) | ((unsigned)f2bf(sp[7 * D]) << 16);
        *(u32x4*)(wd + ((size_t)e * D + n) * DE + kc * 8) = o;
    }
}

struct SsmPar { float lre, lim, dt; };
__device__ __forceinline__ SsmPar ssm_par(const P& p, int l, int dir, int g, int pp) {
    const int pi = ((l * 2 + dir) * SG + g) * SP + pp;
    SsmPar r; r.lre = p.in[I_LRE][pi]; r.lim = p.in[I_LIM][pi]; r.dt = expf(p.in[I_LDT][(l * 2 + dir) * SG + g]); return r;
}
__device__ __forceinline__ float2 ssm_pow(const SsmPar& q, float e) {
    const float mag = expf(e * q.lre * q.dt), ang = e * (q.lim * q.dt);
    return make_float2(mag * cosf(ang), mag * sinf(ang));
}
__device__ __forceinline__ float2 ssm_f(const SsmPar& q) {
    const float2 lb = ssm_pow(q, 1.f);
    const float nr = lb.x - 1.f, ni = lb.y, den = q.lre * q.lre + q.lim * q.lim;
    return make_float2((nr * q.lre + ni * q.lim) / den, (ni * q.lre - nr * q.lim) / den);
}
__device__ __forceinline__ float2 cmul(float2 a, float2 b) { return make_float2(a.x * b.x - a.y * b.y, a.x * b.y + a.y * b.x); }
__device__ __forceinline__ void st_ssm_kj(const P& p, float* lds) {
    float* lam = lds; float* Cc = lds + 128; float* Bb = Cc + 2048;
    float* kj = (float*)(p.ws + WS_KJ);
    const int t = TIDX;
    for (int item = BIDX; item < 64; item += gridDim.x) {
        const int l = item >> 5, g = (item >> 1) & 15, dir = item & 1;
        const int base = (l * 2 + dir) * SG + g;
        __syncthreads();
        if (t < 64) {
            const SsmPar q = ssm_par(p, l, dir, g, t);
            const float2 lb = ssm_pow(q, 1.f), f = ssm_f(q);
            lam[2 * t] = lb.x; lam[2 * t + 1] = lb.y;
            for (int h = 0; h < 16; ++h) {
                const size_t bi = ((size_t)base * SP + t) * 16 + h;
                const float2 bb = cmul(f, make_float2(p.in[I_BRE][bi], p.in[I_BIM][bi]));
                Bb[(t * 16 + h) * 2] = bb.x; Bb[(t * 16 + h) * 2 + 1] = bb.y;
            }
        }
        for (int i = t; i < 1024; i += NT) { const size_t ci = (size_t)base * 1024 + i; Cc[2 * i] = p.in[I_CRE][ci]; Cc[2 * i + 1] = p.in[I_CIM][ci]; }
        __syncthreads();
        const int ho = t >> 4, hi = t & 15;
        float acc[32];
#pragma unroll
        for (int j = 0; j < 32; ++j) acc[j] = 0.f;
        for (int pp = 0; pp < 64; ++pp) {
            float2 z = cmul(make_float2(Cc[(ho * 64 + pp) * 2], Cc[(ho * 64 + pp) * 2 + 1]), make_float2(Bb[(pp * 16 + hi) * 2], Bb[(pp * 16 + hi) * 2 + 1]));
            const float2 lb = make_float2(lam[2 * pp], lam[2 * pp + 1]);
#pragma unroll
            for (int j = 0; j < 32; ++j) { acc[j] += z.x; z = cmul(z, lb); }
        }
#pragma unroll
        for (int j = 0; j < 32; ++j) kj[((size_t)((l * 16 + g) * 2 + dir) * 32 + j) * 256 + ho * 16 + hi] = acc[j];
    }
    __syncthreads();
}
__device__ __forceinline__ void st_prep_ssm(const P& p, int l) {
    bf16_t* wst = (bf16_t*)(p.ws + WS_WST);
    for (int idx = BIDX * NT + TIDX; idx < 16 * 256 * 64; idx += gridDim.x * NT) {
        const int kc = idx & 63, n = (idx >> 6) & 255, g = idx >> 14;
        const int dir = n >> 7, c = (n >> 6) & 1, pp = n & 63, s = kc >> 1, h0 = (kc & 1) * 8;
        const SsmPar q = ssm_par(p, l, dir, g, pp);
        const float2 coef = cmul(ssm_pow(q, dir == 0 ? (float)(31 - s) : (float)s), ssm_f(q));
        const size_t bi = ((size_t)((l * 2 + dir) * SG + g) * SP + pp) * 16 + h0;
        float v[8];
#pragma unroll
        for (int j = 0; j < 8; ++j) { const float2 z = cmul(coef, make_float2(p.in[I_BRE][bi + j], p.in[I_BIM][bi + j])); v[j] = c == 0 ? z.x : z.y; }
        u32x4 o; o[0] = cvt_pk_bf16(v[0], v[1]); o[1] = cvt_pk_bf16(v[2], v[3]); o[2] = cvt_pk_bf16(v[4], v[5]); o[3] = cvt_pk_bf16(v[6], v[7]);
        *(u32x4*)(wst + ((size_t)(g * 256 + n)) * 512 + kc * 8) = o;
    }
    bf16_t* kw = (bf16_t*)(p.ws + WS_KW);
    const float* kj = (const float*)(p.ws + WS_KJ);
    for (int idx = BIDX * NT + TIDX; idx < 16 * 512 * 96; idx += gridDim.x * NT) {
        const int kc = idx % 96, n = (idx / 96) & 511, g = idx / (96 * 512);
        const int tau = n >> 4, ho = n & 15;
        float v[8];
        if (kc < 64) {
            const int s = kc >> 1, hi0 = (kc & 1) * 8;
#pragma unroll
            for (int j = 0; j < 8; ++j) {
                float a = 0.f;
                if (s <= tau) a += kj[((size_t)((l * 16 + g) * 2 + 0) * 32 + (tau - s)) * 256 + ho * 16 + hi0 + j];
                if (s >= tau) a += kj[((size_t)((l * 16 + g) * 2 + 1) * 32 + (s - tau)) * 256 + ho * 16 + hi0 + j];
                if (s == tau && ho == hi0 + j) a += p.in[I_SD][l * DSSM + g * 16 + ho];
                v[j] = a;
            }
        } else {
            const int kk = (kc - 64) * 8, dir = kk >> 7, c = (kk >> 6) & 1, p0 = kk & 63;
            const float e = dir == 0 ? (float)(tau + 1) : (float)(32 - tau);
#pragma unroll
            for (int j = 0; j < 8; ++j) {
                const SsmPar q = ssm_par(p, l, dir, g, p0 + j);
                const size_t ci = ((size_t)((l * 2 + dir) * SG + g) * 16 + ho) * SP + p0 + j;
                const float2 z = cmul(make_float2(p.in[I_CRE][ci], p.in[I_CIM][ci]), ssm_pow(q, e));
                v[j] = c == 0 ? z.x : -z.y;
            }
        }
        u32x4 o; o[0] = cvt_pk_bf16(v[0], v[1]); o[1] = cvt_pk_bf16(v[2], v[3]); o[2] = cvt_pk_bf16(v[4], v[5]); o[3] = cvt_pk_bf16(v[6], v[7]);
        *(u32x4*)(kw + ((size_t)(g * 512 + n)) * 768 + kc * 8) = o;
    }
}
__device__ __forceinline__ void st_ssm_egemm(const P& p, unsigned char* lds) {
    const bf16_t* ua = (const bf16_t*)(p.ws + WS_UA);
    const bf16_t* wst = (const bf16_t*)(p.ws + WS_WST);
    float* E = (float*)(p.ws + WS_E);
    int t_end, t_step;
    for (int tile = xcd_first(160, t_end, t_step); tile < t_end; tile += t_step) {
        const int nt = tile & 1, mt = (tile >> 1) % 5, g = tile / 10;
        f32x16 acc[2][2];
        gemm_tile(acc, ARowPlain{ua + (size_t)(g * 640 + mt * 128) * 768, 768}, wst + (size_t)(g * 256 + nt * 128) * 512, 512, 512, lds);
        acc_foreach4(acc, [&](int r, int c, float v0, float v1, float v2, float v3) { f32x4 o; o[0] = v0; o[1] = v1; o[2] = v2; o[3] = v3; *(f32x4*)(E + (size_t)(g * 640 + mt * 128 + r) * 256 + nt * 128 + c) = o; });
    }
}
__device__ __forceinline__ void st_ssm_carry(const P& p, int l) {
    bf16_t* ua = (bf16_t*)(p.ws + WS_UA);
    const float* E = (const float*)(p.ws + WS_E);
    for (int idx = BIDX * NT + TIDX; idx < NB * 16 * 2 * 64; idx += gridDim.x * NT) {
        const int pp = idx & 63, dir = (idx >> 6) & 1, g = (idx >> 7) & 15, b = idx >> 11;
        const float2 l32 = ssm_pow(ssm_par(p, l, dir, g, pp), 32.f);
        float2 S = make_float2(0.f, 0.f);
        for (int s0 = 0; s0 < 72; s0 += 8) {
            int ch[8]; float er[8], ei[8];
#pragma unroll
            for (int j = 0; j < 8; ++j) {
                const int step = s0 + j;
                if (dir == 0) ch[j] = step < 8 ? 512 + b * 8 + step : b * 64 + (step - 8);
                else ch[j] = step < 8 ? 512 + b * 8 + (7 - step) : b * 64 + (63 - (step - 8));
                const float* e = E + (size_t)(g * 640 + ch[j]) * 256 + dir * 128 + pp;
                er[j] = e[0]; ei[j] = e[64];
            }
#pragma unroll
            for (int j = 0; j < 8; ++j) {
                bf16_t* o = ua + (size_t)(g * 640 + ch[j]) * 768 + 512 + dir * 128 + pp;
                o[0] = f2bf(S.x); o[64] = f2bf(S.y);
                S = cmul(l32, S); S.x += er[j]; S.y += ei[j];
            }
        }
    }
}
__device__ __forceinline__ void st_ssm_ygemm(const P& p, int l, unsigned char* lds) {
    const bf16_t* ua = (const bf16_t*)(p.ws + WS_UA);
    const bf16_t* kw = (const bf16_t*)(p.ws + WS_KW);
    bf16_t* G = (bf16_t*)(p.ws + WS_G);
    const int nmt = l == 0 ? 5 : 4;
    int t_end, t_step;
    for (int tile = xcd_first(16 * nmt * 4, t_end, t_step); tile < t_end; tile += t_step) {
        const int nt = tile & 3, mt = (tile >> 2) % nmt, g = tile / (4 * nmt);
        f32x16 acc[2][2];
        gemm_tile(acc, ARowPlain{ua + (size_t)(g * 640 + mt * 128) * 768, 768}, kw + (size_t)(g * 512 + nt * 128) * 768, 768, 768, lds);
        acc_foreach4(acc, [&](int r, int c, float v0, float v1, float v2, float v3) {
            const int chunk = mt * 128 + r, n = nt * 128 + c;
            if (chunk < TA / 32) *(uint2*)(G + (size_t)(chunk * 32 + (n >> 4)) * DSSM + g * 16 + (n & 15)) = pack4(gelu_f(v0), gelu_f(v1), gelu_f(v2), gelu_f(v3)); });
    }
}
struct EpiGlu2 { const bf16_t* G; bf16_t* mix; const float* bias; __device__ __forceinline__ void operator()(int r, int c, float v0, float v1, float v2, float v3) const {
    const uint2 q = *(const uint2*)(G + (size_t)r * DSSM + c);
    const f32x4 b = *(const f32x4*)(bias + c);
    *(uint2*)(mix + (size_t)r * D + 256 + c) = pack4(__uint_as_float(q.x << 16) * sigmoid_f(v0 + b[0]), __uint_as_float(q.x & 0xffff0000u) * sigmoid_f(v1 + b[1]),
                                                     __uint_as_float(q.y << 16) * sigmoid_f(v2 + b[2]), __uint_as_float(q.y & 0xffff0000u) * sigmoid_f(v3 + b[3])); } };

constexpr float QSCALE = 0.125f * 1.4426950408889634f;
__device__ __forceinline__ void st_rope_table(const P& p) {
    float2* tab = (float2*)(p.ws + WS_ROPE);
    for (int idx = BIDX * NT + TIDX; idx < L * 32; idx += gridDim.x * NT) {
        const int t = idx >> 5, a = (idx >> 4) & 1, i = idx & 15;
        const float pos = a == 0 ? (float)(t / 64) : (float)(t % 64);
        const float ang = pos * powf(10000.f, -(float)i / 16.f);
        tab[idx] = make_float2(cosf(ang), sinf(ang));
    }
}
__device__ __forceinline__ void st_inproj(const P& p, int l, unsigned char* lds) {
    const bf16_t* A = (const bf16_t*)(p.ws + WS_BUFA);
    const bf16_t* Bt = (const bf16_t*)(p.ws + WS_WTIN);
    bf16_t* pc = (bf16_t*)(p.ws + WS_PC);
    bf16_t* ua = (bf16_t*)(p.ws + WS_UA);
    bf16_t* qb = (bf16_t*)(p.ws + WS_QB);
    bf16_t* kb = (bf16_t*)(p.ws + WS_KB);
    bf16_t* vt = (bf16_t*)(p.ws + WS_VT);
    const float2* rope = (const float2*)(p.ws + WS_ROPE);
    const int lane = TIDX & 63, w = TIDX >> 6, wr = w >> 1, wc = w & 1, lr = lane & 31, lh = lane >> 5;
    constexpr int TN = DIN / 128;
    int t_end, t_step;
    for (int tile = xcd_first((TA / 128) * TN, t_end, t_step); tile < t_end; tile += t_step) {
        const int tn = tile % TN, m0 = (tile / TN) * 128, n0 = tn * 128;
        f32x16 acc[2][2];
        gemm_tile(acc, ARowPlain{A + (size_t)m0 * D, D}, Bt + (size_t)n0 * D, D, D, lds);
        if (tn < 6) {
            acc_foreach4(acc, [&](int r, int c, float v0, float v1, float v2, float v3) { *(uint2*)(pc + (size_t)(m0 + r) * 768 + n0 + c) = pack4(v0, v1, v2, v3); });
        } else if (tn < 8) {
            acc_foreach4(acc, [&](int r, int c, float v0, float v1, float v2, float v3) { const int row = m0 + r, g = (tn - 6) * 8 + (c >> 4);
                *(uint2*)(ua + (size_t)(g * 640 + (row >> 5)) * 768 + (row & 31) * 16 + (c & 15)) = pack4(v0, v1, v2, v3); });
        } else if (tn < 13) {
            const bool isq = tn < 12;
            const float* gain = (isq ? p.in[I_QG] : p.in[I_KG]) + l * 64;
            const bool lat = m0 < TL;
            const float osc = isq ? QSCALE : 1.f;
#pragma unroll
            for (int mi = 0; mi < 2; ++mi) {
                const int row = m0 + wr * 64 + mi * 32 + lr;
                float ss = 0.f;
#pragma unroll
                for (int ni = 0; ni < 2; ++ni)
#pragma unroll
                    for (int r = 0; r < 16; ++r) ss += acc[mi][ni][r] * acc[mi][ni][r];
                ss += __shfl_xor(ss, 32);
                const float rinv = rsqrtf(ss * (1.f / 64.f) + 1e-6f) * osc;
                const int t = row & (L - 1);
                bf16_t* o = isq ? qb + (size_t)row * DATT + ((tn - 8) * 2 + wc) * 64 : kb + (size_t)row * 128 + wc * 64;
#pragma unroll
                for (int ni = 0; ni < 2; ++ni)
#pragma unroll
                    for (int g = 0; g < 2; ++g) {
                        const int d0 = ni * 32 + 8 * g + 4 * lh;
                        const f32x4 glo = *(const f32x4*)(gain + d0), ghi = *(const f32x4*)(gain + d0 + 16);
                        float t1[4], t2[4];
#pragma unroll
                        for (int q = 0; q < 4; ++q) { t1[q] = acc[mi][ni][4 * g + q] * rinv * glo[q]; t2[q] = acc[mi][ni][8 + 4 * g + q] * rinv * ghi[q]; }
                        if (lat) {
                            const float2* cs = rope + (t * 2 + ni) * 16 + 8 * g + 4 * lh;
                            const f32x4 c01 = *(const f32x4*)(cs), c23 = *(const f32x4*)(cs + 2);
                            const float cc[4] = {c01[0], c01[2], c23[0], c23[2]}, sn[4] = {c01[1], c01[3], c23[1], c23[3]};
#pragma unroll
                            for (int q = 0; q < 4; ++q) { const float a = t1[q], b = t2[q]; t1[q] = a * cc[q] - b * sn[q]; t2[q] = a * sn[q] + b * cc[q]; }
                        }
                        *(uint2*)(o + d0) = pack4(t1[0], t1[1], t1[2], t1[3]);
                        *(uint2*)(o + d0 + 16) = pack4(t2[0], t2[1], t2[2], t2[3]);
                    }
            }
        } else {
            acc_foreach4(acc, [&](int r, int c, float v0, float v1, float v2, float v3) { *(uint2*)(vt + (size_t)(m0 + r) * 128 + c) = pack4(v0, v1, v2, v3); });
        }
    }
}

constexpr int AT_KROWB = 144, AT_VROWB = 264, AT_VOFF = 128 * AT_KROWB;
__device__ __forceinline__ void st_attn2(const P& p, int l, unsigned char* lds, int part, int nparts) {
    const bf16_t* qb = (const bf16_t*)(p.ws + WS_QB);
    const bf16_t* kb = (const bf16_t*)(p.ws + WS_KB);
    const bf16_t* vt = (const bf16_t*)(p.ws + WS_VT);
    bf16_t* mix = (bf16_t*)(p.ws + WS_BUFA);
    const int t = TIDX, lane = t & 63, w = t >> 6, lr = lane & 31, lh = lane >> 5;
    const int nitems = NB * 16 * NQH + (l == 0 ? NB * 2 * NQH : 0);
    int t_end, t_step;
    for (int kk = xcd_first((nitems - part + nparts - 1) / nparts, t_end, t_step); kk < t_end; kk += t_step) {
        const int item = kk * nparts + part;
        const bool isctx = item >= NB * 16 * NQH;
        int b, qblk, hq;
        if (!isctx) { hq = item & 7; qblk = (item >> 3) & 15; b = item >> 7; }
        else { const int it = item - NB * 16 * NQH; hq = it & 7; qblk = (it >> 3) & 1; b = it >> 4; }
        const int g = hq >> 2;
        const int rq0 = isctx ? TL + b * LC + qblk * 128 : b * L + qblk * 128;
        const int qrow = rq0 + w * 32 + lr;
        bf16x8 qf[4];
#pragma unroll
        for (int s4 = 0; s4 < 4; ++s4) qf[s4] = *(const bf16x8*)(qb + (size_t)qrow * DATT + hq * 64 + s4 * 16 + lh * 8);
        float m = p.in[I_SINK][l * NQH + hq] * 1.4426950408889634f;
        float lsum = lh == 0 ? 1.f : 0.f;
        f32x16 o0, o1;
        float zf = 0.f; asm volatile("" : "+v"(zf));
#pragma unroll
        for (int r = 0; r < 16; ++r) { o0[r] = zf; o1[r] = zf; }
        const int nkb = isctx ? 2 : 5;
        for (int kbi = 0; kbi < nkb; ++kbi) {
            bool win; int kblk;
            if (isctx) { win = false; kblk = kbi; } else if (kbi < 3) { win = true; kblk = qblk - 1 + kbi; } else { win = false; kblk = kbi - 3; }
            if (win && (kblk < 0 || kblk > 15)) continue;
            const bf16_t* ksrc = kb + (size_t)(win ? b * L + kblk * 128 : TL + b * LC + kblk * 128) * 128 + g * 64;
            const bf16_t* vsrc = vt + (size_t)(win ? b * L + kblk * 128 : TL + b * LC + kblk * 128) * 128 + g * 64;
            __syncthreads();
#pragma unroll
            for (int i = 0; i < 4; ++i) {
                const int c = t + 256 * i;
                const int row = c >> 3, kc = c & 7;
                *(u32x4*)(lds + row * AT_KROWB + kc * 16) = *(const u32x4*)(ksrc + (size_t)row * 128 + kc * 8);
                const u32x4 vv = *(const u32x4*)(vsrc + (size_t)row * 128 + kc * 8);
                unsigned char* vd = lds + AT_VOFF + (kc * 8) * AT_VROWB + row * 2;
#pragma unroll
                for (int q = 0; q < 4; ++q) { *(bf16_t*)(vd + (2 * q) * AT_VROWB) = (bf16_t)(vv[q] & 0xffffu); *(bf16_t*)(vd + (2 * q + 1) * AT_VROWB) = (bf16_t)(vv[q] >> 16); }
            }
            __syncthreads();
            const int i0 = qblk * 128 + w * 32;
            for (int sub = 0; sub < 4; ++sub) {
                bool partial = false;
                if (win) {
                    const int j0 = kblk * 128 + sub * 32;
                    if (j0 > i0 + 31 + 128 || j0 + 31 < i0 - 128) continue;
                    partial = !(j0 >= i0 + 31 - 128 && j0 + 31 <= i0 + 128);
                }
                f32x16 sT;
#pragma unroll
                for (int r = 0; r < 16; ++r) sT[r] = zf;
#pragma unroll
                for (int s4 = 0; s4 < 4; ++s4) {
                    const bf16x8 kf = *(const bf16x8*)(lds + (sub * 32 + lr) * AT_KROWB + s4 * 32 + lh * 16);
                    sT = __builtin_amdgcn_mfma_f32_32x32x16_bf16(kf, qf[s4], sT, 0, 0, 0);
                }
                if (partial) {
                    const int j0 = kblk * 128 + sub * 32, qi = i0 + lr;
#pragma unroll
                    for (int r = 0; r < 16; ++r) { const int dj = j0 + (r & 3) + 8 * (r >> 2) + 4 * lh - qi; if (dj > 128 || dj < -128) sT[r] = -1e30f; }
                }
                float mt = sT[0];
#pragma unroll
                for (int r = 1; r < 16; ++r) mt = fmaxf(mt, sT[r]);
                mt = fmaxf(mt, __shfl_xor(mt, 32));
                const float mn = fmaxf(m, mt);
                const float alpha = __builtin_amdgcn_exp2f(m - mn);
                m = mn;
                float ps = 0.f;
#pragma unroll
                for (int r = 0; r < 16; ++r) { sT[r] = __builtin_amdgcn_exp2f(sT[r] - mn); ps += sT[r]; }
                lsum = lsum * alpha + ps;
#pragma unroll
                for (int r = 0; r < 16; ++r) { o0[r] *= alpha; o1[r] *= alpha; }
#pragma unroll
                for (int s2 = 0; s2 < 2; ++s2) {
                    u32x4 pk;
                    pk[0] = cvt_pk_bf16(sT[8 * s2 + 0], sT[8 * s2 + 1]); pk[1] = cvt_pk_bf16(sT[8 * s2 + 2], sT[8 * s2 + 3]);
                    pk[2] = cvt_pk_bf16(sT[8 * s2 + 4], sT[8 * s2 + 5]); pk[3] = cvt_pk_bf16(sT[8 * s2 + 6], sT[8 * s2 + 7]);
                    const bf16x8 pf = __builtin_bit_cast(bf16x8, pk);
                    const int kofs = (sub * 32 + s2 * 16 + lh * 4) * 2;
                    {
                        const uint2 a = *(const uint2*)(lds + AT_VOFF + lr * AT_VROWB + kofs), c2 = *(const uint2*)(lds + AT_VOFF + lr * AT_VROWB + kofs + 16);
                        u32x4 vv; vv[0] = a.x; vv[1] = a.y; vv[2] = c2.x; vv[3] = c2.y;
                        o0 = __builtin_amdgcn_mfma_f32_32x32x16_bf16(__builtin_bit_cast(bf16x8, vv), pf, o0, 0, 0, 0);
                    }
                    {
                        const uint2 a = *(const uint2*)(lds + AT_VOFF + (32 + lr) * AT_VROWB + kofs), c2 = *(const uint2*)(lds + AT_VOFF + (32 + lr) * AT_VROWB + kofs + 16);
                        u32x4 vv; vv[0] = a.x; vv[1] = a.y; vv[2] = c2.x; vv[3] = c2.y;
                        o1 = __builtin_amdgcn_mfma_f32_32x32x16_bf16(__builtin_bit_cast(bf16x8, vv), pf, o1, 0, 0, 0);
                    }
                }
            }
        }
        lsum += __shfl_xor(lsum, 32);
        const float inv = 1.f / lsum;
        bf16_t* orow = mix + (size_t)qrow * D + 512 + hq * 64;
#pragma unroll
        for (int rg = 0; rg < 4; ++rg) {
            uint2 a; a.x = cvt_pk_bf16(o0[4 * rg] * inv, o0[4 * rg + 1] * inv); a.y = cvt_pk_bf16(o0[4 * rg + 2] * inv, o0[4 * rg + 3] * inv);
            *(uint2*)(orow + 8 * rg + 4 * lh) = a;
            uint2 c2; c2.x = cvt_pk_bf16(o1[4 * rg] * inv, o1[4 * rg + 1] * inv); c2.y = cvt_pk_bf16(o1[4 * rg + 2] * inv, o1[4 * rg + 3] * inv);
            *(uint2*)(orow + 32 + 8 * rg + 4 * lh) = c2;
        }
    }
}

constexpr int STAGES_PER_LAYER = 11;
constexpr int N_STAGES = 1 + 2 * STAGES_PER_LAYER;
constexpr int REP_STAGE = -1;

__device__ __forceinline__ void run_stage(const P& p, int s, unsigned char* ldsb) {
    float* lds = (float*)ldsb;
    if (s == 0) { st_mod(p, lds); st_rope_table(p); st_ssm_kj(p, lds); return; }
    const int l = (s - 1) / STAGES_PER_LAYER, k = (s - 1) % STAGES_PER_LAYER;
    switch (k) {
    case 0: st_rbias(p, l, lds); st_norm(p, l, 0); st_prep_dense(p, l); st_prep_moe(p, l); st_prep_ssm(p, l); break;
    case 1: st_inproj(p, l, ldsb); break;
    case 2: st_ssm_egemm(p, ldsb); st_conv(p, l); st_attn2(p, l, ldsb, 0, 4); break;
    case 3: st_ssm_carry(p, l); st_attn2(p, l, ldsb, 1, 4); break;
    case 4: st_ssm_ygemm(p, l, ldsb); st_attn2(p, l, ldsb, 2, 4); break;
    case 5: gemm_stage((const bf16_t*)(p.ws + WS_G), DSSM, (const bf16_t*)(p.ws + WS_WTGLU), DSSM, l == 0 ? TA : TL, DSSM, DSSM,
                       EpiGlu2{(const bf16_t*)(p.ws + WS_G), (bf16_t*)(p.ws + WS_BUFA), p.in[I_BGLU] + l * DSSM}, ldsb);
            st_attn2(p, l, ldsb, 3, 4); break;
    case 6: gemm_stage((const bf16_t*)(p.ws + WS_BUFA), D, (const bf16_t*)(p.ws + WS_WTOUT), D, l == 0 ? TA : TL, D, D, make_epi_out(p, l), ldsb); break;
    case 7: st_router2(p, l, ldsb); break;
    case 8: st_moe1(p, l, ldsb); break;
    case 9: st_moe2(p, l, ldsb); break;
    case 10: gemm_stage((const bf16_t*)(p.ws + WS_HID) + 4 * DE, 5 * DE, (const bf16_t*)(p.ws + WS_WD) + (size_t)32 * D * DE, DE, l == 0 ? TA : TL, D, DE, make_epi_moef(p, l), ldsb); break;
    }
}


#define XB_TMO      128
#define XB_XCNT(j)  (256  + 64 * (j))
#define XB_XSUB(j)  (1280 + 64 * (j))
#define XB_XGEN(j)  (2304 + 64 * (j))
#define XB_TOP      3328
#define XB_TOPGEN   3392
#define XCD_BAR_WORDS 3456
#define XB_SPIN_CAP (1u << 22)
#define LAS __attribute__((address_space(3)))
__device__ __forceinline__ unsigned xb_ld(unsigned* p)              { return __hip_atomic_load(p, __ATOMIC_RELAXED, __HIP_MEMORY_SCOPE_AGENT); }
__device__ __forceinline__ unsigned xb_add(unsigned* p, unsigned v) { return __hip_atomic_fetch_add(p, v, __ATOMIC_RELAXED, __HIP_MEMORY_SCOPE_AGENT); }
__device__ __forceinline__ unsigned xb_xcc_id() { return (unsigned)__builtin_amdgcn_s_getreg((3 << 11) | 20) & 0xFu; }
#define XB_SPIN(cond, bar) do { unsigned _sp = 0; while (cond) { __builtin_amdgcn_s_sleep(1); \
    if ((++_sp & 255u) == 0u) { if (xb_ld(&(bar)[XB_TMO])) break; if (_sp > XB_SPIN_CAP) { atomicAdd(&(bar)[XB_TMO], 1u); break; } } } } while (0)
struct XcdBarrier { unsigned* bar; unsigned x; volatile LAS unsigned* st; };
__device__ __forceinline__ XcdBarrier xcd_barrier_post(unsigned* bar, volatile LAS unsigned* st) {
    XcdBarrier b; b.bar = bar; b.x = xb_xcc_id(); b.st = st;
    if (threadIdx.x == 0) (void)xb_add(&bar[XB_XCNT(b.x)], 1u);
    return b;
}
__device__ __forceinline__ void xcd_barrier_complete(unsigned* bar, unsigned x, unsigned& nloc, unsigned& nx) {
    const unsigned G = gridDim.x * gridDim.y * gridDim.z;
    unsigned sum, cnt, mine, sp = 0u;
    for (;;) {
        sum = 0u; cnt = 0u; mine = 0u;
#pragma unroll
        for (unsigned j = 0; j < 16; ++j) { const unsigned c = xb_ld(&bar[XB_XCNT(j)]); sum += c; cnt += (c > 0u) ? 1u : 0u; mine = (j == x) ? c : mine; }
        if (sum == G) break;
        __builtin_amdgcn_s_sleep(1);
        if ((++sp & 255u) == 0u) { if (xb_ld(&bar[XB_TMO])) break; if (sp > XB_SPIN_CAP) { atomicAdd(&bar[XB_TMO], 1u); break; } }
    }
    nloc = mine > 0u ? mine : 1u; nx = cnt > 0u ? cnt : 1u;
}
__device__ __forceinline__ void xcd_barrier(const XcdBarrier& b) {
    asm volatile("s_waitcnt vmcnt(0)" ::: "memory");
    __syncthreads();
    if (threadIdx.x == 0) {
        unsigned* bar = b.bar;
        __builtin_amdgcn_s_waitcnt(0);
        unsigned nloc = b.st[0], nx = b.st[1];
        if (nloc == 0u) { xcd_barrier_complete(bar, b.x, nloc, nx); b.st[0] = nloc; b.st[1] = nx; }
        const unsigned old = xb_add(&bar[XB_XSUB(b.x)], 1u);
        const unsigned gen = old / nloc;
        if (old + 1u == (gen + 1u) * nloc) {
            __builtin_amdgcn_fence(__ATOMIC_RELEASE, "agent");
            asm volatile("s_waitcnt vmcnt(0)" ::: "memory");
            const unsigned og = xb_add(&bar[XB_TOP], 1u);
            const unsigned tg = og / nx;
            if (og + 1u == (tg + 1u) * nx) xb_add(&bar[XB_TOPGEN], 1u);
            else XB_SPIN(xb_ld(&bar[XB_TOPGEN]) == tg, bar);
            __builtin_amdgcn_fence(__ATOMIC_ACQUIRE, "agent");
            xb_add(&bar[XB_XGEN(b.x)], 1u);
            asm volatile("s_waitcnt vmcnt(0)" ::: "memory");
        } else {
            XB_SPIN(xb_ld(&bar[XB_XGEN(b.x)]) == gen, bar);
            __builtin_amdgcn_fence(__ATOMIC_ACQUIRE, "agent");
            asm volatile("s_waitcnt vmcnt(0)" ::: "memory");
        }
    }
    __syncthreads();
}
constexpr size_t WS_XBAR = 4096;

template <int S> __device__ __forceinline__ void run_all(const P& p, unsigned char* lds, const XcdBarrier& xb) {
    run_stage(p, S, lds);
    if constexpr (S == REP_STAGE) { xcd_barrier(xb); run_stage(p, S, lds); }
    if constexpr (S + 1 < N_STAGES) {
        if constexpr (S == 0) cg::this_grid().sync();
        else xcd_barrier(xb);
        run_all<S + 1>(p, lds, xb);
    }
}
__global__ void __launch_bounds__(NT) mega(P p) {
    __shared__ __attribute__((aligned(16))) unsigned char lds[LDS_TOTAL + 16];
    volatile LAS unsigned* st = (volatile LAS unsigned*)(lds + LDS_TOTAL);
    if (threadIdx.x == 0) { st[0] = 0u; st[1] = 0u; }
    __syncthreads();
    const XcdBarrier xb = xcd_barrier_post((unsigned*)(p.ws + WS_CTL + WS_XBAR), st);
    run_all<0>(p, lds, xb);
}

extern "C" void kernel_launch(void* const* d_in, const int* in_sizes, int n_in, void* d_out, int out_size, void* d_ws, size_t ws_size, hipStream_t stream) {
    if (n_in != N_IN || ws_size < WS_END) { fprintf(stderr, "kernel_launch: unexpected n_in %d or ws_size %zu (< %zu)\n", n_in, ws_size, (size_t)WS_END); return; }
    P p{};
    for (int i = 0; i < N_IN; ++i) p.in[i] = (const float*)d_in[i];
    p.out = (float*)d_out; p.ws = (unsigned char*)d_ws;
    static int grid_blocks = 0;
    if (!grid_blocks) {
        int dev = 0, cus = 0, per_cu = 0;
        hipGetDevice(&dev);
        hipDeviceGetAttribute(&cus, hipDeviceAttributeMultiprocessorCount, dev);
        hipOccupancyMaxActiveBlocksPerMultiprocessor(&per_cu, (const void*)mega, NT, 0);
        if (per_cu < 1) per_cu = 1;
        if (per_cu > 2) per_cu = 2;
        grid_blocks = cus * per_cu;
    }
    hipMemsetAsync((char*)d_ws + WS_CTL, 0, 65536, stream);
    void* args[] = {&p};
    hipError_t e = hipLaunchCooperativeKernel((const void*)mega, dim3(grid_blocks), dim3(NT), args, 0, stream);
    if (e != hipSuccess) fprintf(stderr, "cooperative launch failed: %s (grid %d)\n", hipGetErrorString(e), grid_blocks);
}
```

```cpp
#include <hip/hip_runtime.h>
#include <hip/hip_cooperative_groups.h>
#include <cstdio>
#include <cstdint>
namespace cg = cooperative_groups;
#define LAS __attribute__((address_space(3)))
constexpr int ABL = 0;

__device__ __forceinline__ int tid_opaque() { int t = threadIdx.x; asm volatile("" : "+v"(t)); return t; }
__device__ __forceinline__ int bid_opaque() { int b = blockIdx.x; asm volatile("" : "+s"(b)); return b; }
__device__ __forceinline__ int xcd_first(int total, int& end, int& step) {
    const int nb = gridDim.x; int b = blockIdx.x; asm volatile("" : "+s"(b));
    if (nb & 7) { end = total; step = nb; return b; }
    const int x = b & 7, j = b >> 3, per = (total + 7) >> 3, lo = x * per;
    end = lo + per < total ? lo + per : total; step = nb >> 3; return lo + j;
}
#define TIDX tid_opaque()
#define BIDX bid_opaque()

constexpr int D = 1024, NB = 8, L = 2048, LC = 256;
constexpr int TL = NB * L, TC = NB * LC, TA = TL + TC;
constexpr int DIN = 1792, DCONV = 256, DSSM = 256, DATT = 512;
constexpr int NQH = 8, NKVH = 2, HD = 64;
constexpr int COL_U = 768, COL_Q = 1024, COL_K = 1536, COL_V = 1664;
constexpr int NE = 32, TOPK = 4, DE = 128;
constexpr int SG = 16, SH = 16, SP = 64;
constexpr int NT = 256;

enum { I_X = 0, I_C, I_CTX, I_CCTX, I_WMOD, I_BMOD, I_N1G, I_N2G, I_WIN, I_CONVW, I_LRE, I_LIM, I_LDT, I_BRE, I_BIM, I_CRE, I_CIM,
       I_SD, I_WGLU, I_BGLU, I_QG, I_KG, I_SINK, I_WOUT, I_RW, I_RB, I_WEG, I_WEU, I_WED, I_WSG, I_WSU, I_WSD, N_IN };

typedef unsigned short bf16_t;
constexpr size_t WS_CTL = 0;
constexpr size_t WS_MOD = 65536;
constexpr size_t WS_ZERO_END = WS_MOD + (size_t)2 * 9 * 6 * D * 4;
constexpr size_t WS_RBIAS = 524288;
constexpr size_t WS_ROPE = WS_RBIAS + 4096;
constexpr size_t WS_KJ = WS_ROPE + 524288;
constexpr size_t WS_GS2 = WS_KJ + 2097152;
constexpr size_t WS_R1 = WS_GS2 + 131072;
constexpr size_t WS_BUFA = WS_R1;
constexpr size_t WS_PC = WS_BUFA + (size_t)TA * D * 2;
constexpr size_t WS_UA = WS_PC + (size_t)TA * 768 * 2;
constexpr size_t WS_E = WS_UA + (size_t)16 * 640 * 768 * 2;
constexpr size_t WS_G = WS_E + (size_t)16 * 640 * 256 * 4;
constexpr size_t WS_QB = WS_G + (size_t)TA * DSSM * 2;
constexpr size_t WS_KB = WS_QB + (size_t)TA * DATT * 2;
constexpr size_t WS_VT = WS_KB + (size_t)TA * 128 * 2;
constexpr size_t WS_SLAB = WS_R1;
constexpr size_t WS_HID = WS_SLAB + (size_t)TA * 4 * D * 2;
constexpr size_t WS_HC1 = WS_HID + (size_t)TA * 5 * DE * 2;
constexpr size_t WS_HCMID = WS_HC1 + (size_t)TC * D * 4;
constexpr size_t WS_LCODE = WS_HCMID + (size_t)TC * D * 4;
constexpr size_t WS_LW = WS_LCODE + (size_t)NE * TA * 4;
constexpr size_t WS_WTIN = WS_LW + (size_t)NE * TA * 4;
constexpr size_t WS_WTOUT = WS_WTIN + (size_t)DIN * D * 2;
constexpr size_t WS_WTGLU = WS_WTOUT + (size_t)D * D * 2;
constexpr size_t WS_WGU = WS_WTGLU + (size_t)DSSM * DSSM * 2;
constexpr size_t WS_WD = WS_WGU + (size_t)33 * 256 * D * 2;
constexpr size_t WS_WST = WS_WD + (size_t)33 * D * DE * 2;
constexpr size_t WS_KW = WS_WST + (size_t)16 * 256 * 512 * 2;
constexpr size_t WS_END = WS_KW + (size_t)16 * 512 * 768 * 2;
static_assert(WS_VT + (size_t)TA * 128 * 2 <= WS_HID, "overlay");
static_assert(WS_ZERO_END <= WS_RBIAS, "zero region");
static_assert(WS_END <= 268435456, "workspace too large");

struct P {
    const float* in[N_IN];
    float* out;
    unsigned char* ws;
};

__device__ __forceinline__ bf16_t f2bf(float f) { unsigned u = __float_as_uint(f); u += 0x7FFFu + ((u >> 16) & 1u); return (bf16_t)(u >> 16); }
__device__ __forceinline__ float bf2f(bf16_t b) { return __uint_as_float((unsigned)b << 16); }
__device__ __forceinline__ unsigned cvt_pk_bf16(float lo, float hi) { unsigned r; asm("v_cvt_pk_bf16_f32 %0, %1, %2" : "=v"(r) : "v"(lo), "v"(hi)); return r; }
typedef __attribute__((ext_vector_type(4))) float f32x4;
struct BfPtr { const bf16_t* p; __device__ __forceinline__ float operator[](long i) const { return bf2f(p[i]); }
               __device__ __forceinline__ BfPtr operator+(long o) const { return BfPtr{p + o}; } };
__device__ __forceinline__ float silu_f(float x) { return x / (1.f + expf(-x)); }
__device__ __forceinline__ float sigmoid_f(float x) { return 1.f / (1.f + expf(-x)); }
__device__ __forceinline__ float gelu_f(float x) { return 0.5f * x * (1.f + tanhf(0.7978845608028654f * (x + 0.044715f * x * x * x))); }
__device__ __forceinline__ float wave_sum(float v) {
#pragma unroll
    for (int o = 32; o > 0; o >>= 1) v += __shfl_xor(v, o);
    return v;
}
__device__ __forceinline__ int row_bb(int r) { return r < TL ? r / L : 8; }
__device__ __forceinline__ const float* h_row(const P& p, int l, int r) {
    if (r < TL) return (l == 0 ? p.in[I_X] : p.out) + (size_t)r * D;
    return (l == 0 ? p.in[I_CTX] : (const float*)(p.ws + WS_HC1)) + (size_t)(r - TL) * D;
}
__device__ __forceinline__ float* hmid_row(const P& p, int r) {
    if (r < TL) return p.out + (size_t)r * D;
    return (float*)(p.ws + WS_HCMID) + (size_t)(r - TL) * D;
}
__device__ __forceinline__ const float* mod_vec(const P& p, int l, int bb, int chunk) {
    return (const float*)(p.ws + WS_MOD) + ((size_t)(l * 9 + bb) * 6 + chunk) * D;
}

__device__ __forceinline__ void st_mod(const P& p, float* lds) {
    float* red = lds + 9 * D;
    for (int i = TIDX; i < 9 * D; i += NT) {
        const int bb = i / D, k = i % D;
        const float c = bb < 8 ? p.in[I_C][bb * D + k] : p.in[I_CCTX][k];
        lds[i] = silu_f(c);
    }
    __syncthreads();
    float* mod = (float*)(p.ws + WS_MOD);
    const int col = TIDX & 31, ks = TIDX >> 5;
    for (int item = BIDX; item < 2 * 6 * D / 32; item += gridDim.x) {
        const int l = item / (6 * D / 32), j = (item % (6 * D / 32)) * 32 + col;
        const float* w = p.in[I_WMOD] + (size_t)l * D * 6 * D + j;
        float acc[9];
#pragma unroll
        for (int bb = 0; bb < 9; ++bb) acc[bb] = 0.f;
        for (int k = ks * 128; k < ks * 128 + 128; ++k) {
            const float wv = w[(size_t)k * 6 * D];
#pragma unroll
            for (int bb = 0; bb < 9; ++bb) acc[bb] += lds[bb * D + k] * wv;
        }
#pragma unroll
        for (int bb = 0; bb < 9; ++bb) red[(bb * 8 + ks) * 32 + col] = acc[bb];
        __syncthreads();
        for (int o = TIDX; o < 9 * 32; o += NT) {
            const int bb = o >> 5, c2 = o & 31;
            float sum = p.in[I_BMOD][l * 6 * D + (item % (6 * D / 32)) * 32 + c2];
#pragma unroll
            for (int q = 0; q < 8; ++q) sum += red[(bb * 8 + q) * 32 + c2];
            mod[(size_t)(l * 9 + bb) * 6 * D + (item % (6 * D / 32)) * 32 + c2] = sum;
        }
        __syncthreads();
    }
}

__device__ __forceinline__ void st_norm(const P& p, int l, int which) {
    const int lane = TIDX & 63, wv = TIDX >> 6;
    const int nrows = (which == 1 && l == 1) ? TL : TA;
    float* xn = (float*)(p.ws + WS_BUFA);
    const float* g = p.in[which == 0 ? I_N1G : I_N2G] + l * D;
    for (int r = BIDX * 4 + wv; r < nrows; r += gridDim.x * 4) {
        const float* src = which == 0 ? h_row(p, l, r) : hmid_row(p, r);
        const int bb = row_bb(r);
        const float* sh = mod_vec(p, l, bb, which == 0 ? 0 : 3);
        const float* sc = mod_vec(p, l, bb, which == 0 ? 1 : 4);
        float4 v[4];
        float s = 0.f;
#pragma unroll
        for (int j = 0; j < 4; ++j) { v[j] = *(const float4*)(src + j * 256 + lane * 4); s += v[j].x * v[j].x + v[j].y * v[j].y + v[j].z * v[j].z + v[j].w * v[j].w; }
        s = wave_sum(s);
        const float rinv = rsqrtf(s * (1.f / D) + 1e-6f);
#pragma unroll
        for (int j = 0; j < 4; ++j) {
            const int k = j * 256 + lane * 4;
            const float4 gg = *(const float4*)(g + k), s1 = *(const float4*)(sc + k), s0 = *(const float4*)(sh + k);
            float4 o;
            o.x = v[j].x * rinv * gg.x * (1.f + s1.x) + s0.x;
            o.y = v[j].y * rinv * gg.y * (1.f + s1.y) + s0.y;
            o.z = v[j].z * rinv * gg.z * (1.f + s1.z) + s0.z;
            o.w = v[j].w * rinv * gg.w * (1.f + s1.w) + s0.w;
            if (which == 1) *(float4*)(xn + (size_t)r * D + k) = o;
            else { uint2 pk; pk.x = (unsigned)f2bf(o.x) | ((unsigned)f2bf(o.y) << 16); pk.y = (unsigned)f2bf(o.z) | ((unsigned)f2bf(o.w) << 16);
                   *(uint2*)((bf16_t*)(p.ws + WS_BUFA) + (size_t)r * D + k) = pk; }
        }
    }
}


__device__ __forceinline__ void st_conv(const P& p, int l) {
    const BfPtr pb{(const bf16_t*)(p.ws + WS_PC)};
    bf16_t* mix = (bf16_t*)(p.ws + WS_BUFA);
    const float* cw = p.in[I_CONVW] + l * 3 * DCONV;
    const int nrows = l == 0 ? TA : TL;
    for (int idx = BIDX * NT + TIDX; idx < nrows * DCONV; idx += gridDim.x * NT) {
        const int r = idx / DCONV, ch = idx % DCONV;
        int t, len;
        if (r < TL) { t = r % L; len = L; } else { t = (r - TL) % LC; len = LC; }
        const BfPtr pr = pb + (long)r * 768;
        float y = cw[DCONV + ch] * (pr[512 + ch] * pr[ch]);
        if (t > 0) y += cw[ch] * (pr[-768 + 512 + ch] * pr[-768 + ch]);
        if (t < len - 1) y += cw[2 * DCONV + ch] * (pr[768 + 512 + ch] * pr[768 + ch]);
        mix[(size_t)r * D + ch] = f2bf(pr[256 + ch] * y);
    }
}

struct EpiOut { const float* modl; const float* hlat; const float* hctx; float* out; float* hcmid;
    __device__ __forceinline__ void operator()(int r, int c, float v0, float v1, float v2, float v3) const {
    const int bb = row_bb(r);
    const f32x4 g1 = *(const f32x4*)(modl + ((size_t)bb * 6 + 2) * D + c);
    const f32x4 hv = *(const f32x4*)((r < TL ? hlat + (size_t)r * D : hctx + (size_t)(r - TL) * D) + c);
    f32x4 o; o[0] = hv[0] + g1[0] * v0; o[1] = hv[1] + g1[1] * v1; o[2] = hv[2] + g1[2] * v2; o[3] = hv[3] + g1[3] * v3;
    *(f32x4*)((r < TL ? out + (size_t)r * D : hcmid + (size_t)(r - TL) * D) + c) = o; } };
__device__ __forceinline__ EpiOut make_epi_out(const P& p, int l) {
    return EpiOut{(const float*)(p.ws + WS_MOD) + (size_t)l * 9 * 6 * D, l == 0 ? p.in[I_X] : p.out, l == 0 ? p.in[I_CTX] : (const float*)(p.ws + WS_HC1), p.out, (float*)(p.ws + WS_HCMID)};
}

typedef __attribute__((ext_vector_type(8))) short bf16x8;
typedef __attribute__((ext_vector_type(16))) float f32x16;
typedef __attribute__((ext_vector_type(4))) unsigned u32x4;
constexpr int G_STAGEB = 16384;
constexpr int G_NSTG = 4;
constexpr int LDS_BYTES = G_NSTG * G_STAGEB;

template <class ARow>
__device__ __forceinline__ void gemm_tile(f32x16 (&acc)[2][2], ARow arow, const bf16_t* Bt, int ldb, int K, unsigned char* lds) {
    const int t = TIDX, lane = t & 63, w = __builtin_amdgcn_readfirstlane(t >> 6), wr = w >> 1, wc = w & 1, lr = lane & 31, lh = lane >> 5;
    const int srow = t >> 2, lc = (t & 3) ^ ((srow >> 2) & 3);
    const bf16_t* ap[2]; const bf16_t* bp[2];
#pragma unroll
    for (int i = 0; i < 2; ++i) { ap[i] = arow(srow + 64 * i) + lc * 8; bp[i] = Bt + (size_t)(srow + 64 * i) * ldb + lc * 8; }
    float zf = 0.f; asm volatile("" : "+v"(zf));
#pragma unroll
    for (int mi = 0; mi < 2; ++mi)
#pragma unroll
        for (int ni = 0; ni < 2; ++ni)
#pragma unroll
            for (int r = 0; r < 16; ++r) acc[mi][ni][r] = zf;
    const int nk = K >> 5;
    LAS unsigned char* l3 = (LAS unsigned char*)lds;
    const int f = (lr >> 2) & 3;
    const int aoff = (wr * 64 + lr) * 64 + ((lh ^ f) << 4), boff = 8192 + (wc * 64 + lr) * 64 + ((lh ^ f) << 4);
#define G_ISSUE(ks) do { LAS unsigned char* d_ = l3 + ((ks) & 3) * G_STAGEB + w * 1024; \
        __builtin_amdgcn_global_load_lds((const unsigned*)(ap[0] + (ks) * 32), (LAS unsigned*)(d_), 16, 0, 0); \
        __builtin_amdgcn_global_load_lds((const unsigned*)(ap[1] + (ks) * 32), (LAS unsigned*)(d_ + 4096), 16, 0, 0); \
        __builtin_amdgcn_global_load_lds((const unsigned*)(bp[0] + (ks) * 32), (LAS unsigned*)(d_ + 8192), 16, 0, 0); \
        __builtin_amdgcn_global_load_lds((const unsigned*)(bp[1] + (ks) * 32), (LAS unsigned*)(d_ + 12288), 16, 0, 0); } while (0)
#define G_RD(A0, A1, B0, B1, slot, s2) do { const LAS unsigned char* c_ = l3 + (slot) * G_STAGEB; \
        A0 = *(const LAS bf16x8*)(c_ + (aoff ^ ((s2) << 5))); A1 = *(const LAS bf16x8*)(c_ + ((aoff + 2048) ^ ((s2) << 5))); \
        B0 = *(const LAS bf16x8*)(c_ + (boff ^ ((s2) << 5))); B1 = *(const LAS bf16x8*)(c_ + ((boff + 2048) ^ ((s2) << 5))); } while (0)
#define G_MM(A0, A1, B0, B1) do { \
        acc[0][0] = __builtin_amdgcn_mfma_f32_32x32x16_bf16(B0, A0, acc[0][0], 0, 0, 0); acc[0][1] = __builtin_amdgcn_mfma_f32_32x32x16_bf16(B1, A0, acc[0][1], 0, 0, 0); \
        acc[1][0] = __builtin_amdgcn_mfma_f32_32x32x16_bf16(B0, A1, acc[1][0], 0, 0, 0); acc[1][1] = __builtin_amdgcn_mfma_f32_32x32x16_bf16(B1, A1, acc[1][1], 0, 0, 0); } while (0)
    __syncthreads();
    G_ISSUE(0);
    if (1 < nk) G_ISSUE(1);
    if (2 < nk) G_ISSUE(2);
    if (2 < nk) asm volatile("s_waitcnt vmcnt(8)" ::: "memory"); else if (1 < nk) asm volatile("s_waitcnt vmcnt(4)" ::: "memory"); else asm volatile("s_waitcnt vmcnt(0)" ::: "memory");
    __builtin_amdgcn_s_barrier();
    if (3 < nk) G_ISSUE(3);
    bf16x8 fa0, fa1, fb0, fb1, ga0, ga1, gb0, gb1;
    G_RD(fa0, fa1, fb0, fb1, 0, 0);
    for (int ks = 0; ks < nk; ++ks) {
        G_RD(ga0, ga1, gb0, gb1, ks & 3, 1);
        __builtin_amdgcn_sched_barrier(0);
        asm volatile("s_waitcnt lgkmcnt(4)" ::: "memory");
        __builtin_amdgcn_sched_barrier(0);
        G_MM(fa0, fa1, fb0, fb1);
        __builtin_amdgcn_sched_barrier(0);
        if (ks + 1 < nk) {
            if (ks + 3 < nk) asm volatile("s_waitcnt vmcnt(8) lgkmcnt(0)" ::: "memory");
            else if (ks + 2 < nk) asm volatile("s_waitcnt vmcnt(4) lgkmcnt(0)" ::: "memory");
            else asm volatile("s_waitcnt vmcnt(0) lgkmcnt(0)" ::: "memory");
            __builtin_amdgcn_s_barrier();
            if (ks + 4 < nk) G_ISSUE(ks + 4);
            G_RD(fa0, fa1, fb0, fb1, (ks + 1) & 3, 0);
        } else {
            asm volatile("s_waitcnt lgkmcnt(0)" ::: "memory");
        }
        __builtin_amdgcn_sched_barrier(0);
        G_MM(ga0, ga1, gb0, gb1);
        __builtin_amdgcn_sched_barrier(0);
    }
#undef G_RD
#undef G_MM
#undef G_ISSUE
}
template <class F>
__device__ __forceinline__ void acc_foreach4(const f32x16 (&acc)[2][2], F f) {
    const int lane = TIDX & 63, w = (TIDX >> 6) & 3, wr = w >> 1, wc = w & 1, lr = lane & 31, lh = lane >> 5;
#pragma unroll
    for (int mi = 0; mi < 2; ++mi)
#pragma unroll
        for (int ni = 0; ni < 2; ++ni)
#pragma unroll
            for (int g = 0; g < 4; ++g)
                f(wr * 64 + mi * 32 + lr, wc * 64 + ni * 32 + 8 * g + 4 * lh, acc[mi][ni][4 * g], acc[mi][ni][4 * g + 1], acc[mi][ni][4 * g + 2], acc[mi][ni][4 * g + 3]);
}
constexpr int C_LD = 132;
template <class F>
__device__ __forceinline__ void acc_foreach4_lds(const f32x16 (&acc)[2][2], unsigned char* lds, F f) {
    float* C = (float*)lds;
    const int t = TIDX, lane = t & 63, w = (t >> 6) & 3, wr = w >> 1, wc = w & 1, lr = lane & 31, lh = lane >> 5;
    __syncthreads();
#pragma unroll
    for (int mi = 0; mi < 2; ++mi)
#pragma unroll
        for (int ni = 0; ni < 2; ++ni)
#pragma unroll
            for (int g = 0; g < 4; ++g) {
                f32x4 v; v[0] = acc[mi][ni][4 * g]; v[1] = acc[mi][ni][4 * g + 1]; v[2] = acc[mi][ni][4 * g + 2]; v[3] = acc[mi][ni][4 * g + 3];
                *(f32x4*)(C + (wr * 64 + mi * 32 + lr) * C_LD + wc * 64 + ni * 32 + 8 * g + 4 * lh) = v;
            }
    __syncthreads();
#pragma unroll 4
    for (int i = 0; i < 16; ++i) {
        const int idx = t + 256 * i, r = idx >> 5, c = (idx & 31) * 4;
        const f32x4 v = *(const f32x4*)(C + r * C_LD + c);
        f(r, c, v[0], v[1], v[2], v[3]);
    }
}
__device__ __forceinline__ uint2 pack4(float a, float b, float c, float d) { uint2 o; o.x = cvt_pk_bf16(a, b); o.y = cvt_pk_bf16(c, d); return o; }
struct ARowPlain { const bf16_t* A; int lda; __device__ __forceinline__ const bf16_t* operator()(int m) const { return A + (size_t)m * lda; } };

template <class Epi>
__device__ __forceinline__ void gemm_stage(const bf16_t* A, int lda, const bf16_t* Bt, int ldb, int M, int N, int K, Epi epi, unsigned char* lds) {
    const int tn = N / 128, tm = M / 128;
    int t_end, t_step;
    for (int tile = xcd_first(tm * tn, t_end, t_step); tile < t_end; tile += t_step) {
        const int m0 = (tile / tn) * 128, n0 = (tile % tn) * 128;
        f32x16 acc[2][2];
        gemm_tile(acc, ARowPlain{A + (size_t)m0 * lda, lda}, Bt + (size_t)n0 * ldb, ldb, K, lds);
        acc_foreach4_lds(acc, lds, [&](int r, int c, float v0, float v1, float v2, float v3) { epi(m0 + r, n0 + c, v0, v1, v2, v3); });
    }
}
__device__ __forceinline__ void prep_tr(const float* src, size_t sk, bf16_t* dst, int N, int K) {
    const int per = N * (K / 8);
    for (int idx = BIDX * NT + TIDX; idx < per; idx += gridDim.x * NT) {
        const int n = idx % N, kc = idx / N;
        const float* sp = src + (size_t)kc * 8 * sk + n;
        uint4 o;
        o.x = (unsigned)f2bf(sp[0]) | ((unsigned)f2bf(sp[sk]) << 16);
        o.y = (unsigned)f2bf(sp[2 * sk]) | ((unsigned)f2bf(sp[3 * sk]) << 16);
        o.z = (unsigned)f2bf(sp[4 * sk]) | ((unsigned)f2bf(sp[5 * sk]) << 16);
        o.w = (unsigned)f2bf(sp[6 * sk]) | ((unsigned)f2bf(sp[7 * sk]) << 16);
        *(uint4*)(dst + (size_t)n * K + kc * 8) = o;
    }
}
__device__ __forceinline__ void st_prep_dense(const P& p, int l) {
    prep_tr(p.in[I_WIN] + (size_t)l * D * DIN, DIN, (bf16_t*)(p.ws + WS_WTIN), DIN, D);
    prep_tr(p.in[I_WOUT] + (size_t)l * D * D, D, (bf16_t*)(p.ws + WS_WTOUT), D, D);
    prep_tr(p.in[I_WGLU] + (size_t)l * DSSM * DSSM, DSSM, (bf16_t*)(p.ws + WS_WTGLU), DSSM, DSSM);
}
struct EpiStoreBf { bf16_t* C; int ldc; __device__ __forceinline__ void operator()(int r, int c, float v0, float v1, float v2, float v3) const { *(uint2*)(C + (size_t)r * ldc + c) = pack4(v0, v1, v2, v3); } };


__device__ __forceinline__ void st_rbias(const P& p, int l, float* lds) {
    if (BIDX < 9) {
        { const int bb0 = BIDX; const float* sc2 = mod_vec(p, l, bb0, 4); const float* g2 = p.in[I_N2G] + l * D; float* gs = (float*)(p.ws + WS_GS2) + (size_t)(l * 9 + bb0) * D;
          for (int k = TIDX; k < D; k += NT) gs[k] = g2[k] * (1.f + sc2[k]); }
        const int bb = BIDX, e = TIDX & 31, ks = TIDX >> 5;
        const float* sh2 = mod_vec(p, l, bb, 3);
        const float* rw = p.in[I_RW] + (size_t)l * D * NE;
        float a = 0.f;
        for (int k = ks * 128; k < ks * 128 + 128; ++k) a += sh2[k] * rw[k * NE + e];
        lds[TIDX] = a;
        __syncthreads();
        if (TIDX < 32) { float s = 0.f; for (int j = 0; j < 8; ++j) s += lds[j * 32 + TIDX]; ((float*)(p.ws + WS_RBIAS))[(l * 9 + bb) * 32 + TIDX] = s; }
        __syncthreads();
    }
}
template <bool DRY = false>
__device__ __forceinline__ void st_router2(const P& p, int l, unsigned char* ldsb) {
    float* part = (float*)ldsb;
    float* ssq = part + 4 * 32 * 33;
    float* sc = ssq + 128;
    float* rinvs = sc + 32 * 33;
    const int t = TIDX, lane = t & 63, w = t >> 6, i = lane & 31, hf = lane >> 5;
    const int nrows = l == 0 ? TA : TL;
    const float* rw = p.in[I_RW] + (size_t)l * D * NE;
    int* cnt = (int*)(p.ws + WS_CTL) + l * NE;
    int* lcode = (int*)(p.ws + WS_LCODE);
    float* lw = (float*)(p.ws + WS_LW);
    bf16_t* xn2 = (bf16_t*)(p.ws + WS_BUFA);
    for (int item = BIDX; item < nrows / 32; item += gridDim.x) {
        const int r0 = item * 32, bb = row_bb(r0);
        const float* gs2 = (const float*)(p.ws + WS_GS2) + (size_t)(l * 9 + bb) * D;
        const float* sh2 = mod_vec(p, l, bb, 3);
        const int kb = w * 256 + hf * 128;
        const float* src = hmid_row(p, r0 + i) + kb;
        const float* gsp = gs2 + kb;
        const float* rwp = rw + (size_t)kb * NE + i;
        f32x16 acc;
        float zf = 0.f; asm volatile("" : "+v"(zf));
#pragma unroll
        for (int r = 0; r < 16; ++r) acc[r] = zf;
        float ss = 0.f;
        f32x4 xa[4], ga[4], xb[4], gb[4]; float wa[16], wb[16];
#define R_LOAD(X, G, W, cb) do { _Pragma("unroll") for (int q = 0; q < 4; ++q) { const int k = ((cb) * 4 + q) * 4; X[q] = *(const f32x4*)(src + k); G[q] = *(const f32x4*)(gsp + k); \
            _Pragma("unroll") for (int j = 0; j < 4; ++j) W[q * 4 + j] = rwp[(size_t)(k + j) * NE]; } } while (0)
#define R_COMP(X, G, W) do { _Pragma("unroll") for (int q = 0; q < 4; ++q) { ss += X[q][0] * X[q][0] + X[q][1] * X[q][1] + X[q][2] * X[q][2] + X[q][3] * X[q][3]; \
            _Pragma("unroll") for (int j = 0; j < 4; ++j) acc = __builtin_amdgcn_mfma_f32_32x32x2f32(X[q][j] * G[q][j], W[q * 4 + j], acc, 0, 0, 0); } } while (0)
        R_LOAD(xa, ga, wa, 0);
#pragma unroll 1
        for (int cb = 0; cb < 8; cb += 2) {
            R_LOAD(xb, gb, wb, cb + 1);
            R_COMP(xa, ga, wa);
            if (cb + 2 < 8) R_LOAD(xa, ga, wa, cb + 2);
            R_COMP(xb, gb, wb);
        }
#undef R_LOAD
#undef R_COMP
        ss += __shfl_xor(ss, 32);
        __syncthreads();
        if (hf == 0) ssq[w * 32 + i] = ss;
#pragma unroll
        for (int r = 0; r < 16; ++r) part[(w * 32 + (r & 3) + 8 * (r >> 2) + 4 * hf) * 33 + i] = acc[r];
        __syncthreads();
        for (int idx = t; idx < 1024; idx += NT) {
            const int row = idx >> 5, e = idx & 31;
            const float logit = part[(0 * 32 + row) * 33 + e] + part[(1 * 32 + row) * 33 + e] + part[(2 * 32 + row) * 33 + e] + part[(3 * 32 + row) * 33 + e];
            const float rinv = rsqrtf((ssq[row] + ssq[32 + row] + ssq[64 + row] + ssq[96 + row]) * (1.f / D) + 1e-6f);
            sc[row * 33 + e] = sigmoid_f(rinv * logit + ((const float*)(p.ws + WS_RBIAS))[(l * 9 + bb) * 32 + e]);
            if (e == 0) rinvs[row] = rinv;
        }
        __syncthreads();
        if (t < 32) {
            const int r = r0 + t;
            float sel[32];
#pragma unroll
            for (int e = 0; e < 32; ++e) sel[e] = sc[t * 33 + e] + p.in[I_RB][l * NE + e];
            int bi[4]; float sv[4]; float sum = 0.f;
#pragma unroll
            for (int k = 0; k < 4; ++k) {
                float best = -1e30f; int b = 0;
#pragma unroll
                for (int e = 0; e < 32; ++e) if (sel[e] > best) { best = sel[e]; b = e; }
#pragma unroll
                for (int e = 0; e < 32; ++e) if (e == b) sel[e] = -1e30f;
                bi[k] = b; sv[k] = sc[t * 33 + b]; sum += sv[k];
            }
#pragma unroll
            for (int k = 0; k < 4; ++k) {
                if (DRY) { if (sv[k] / sum == 12345.f) lw[0] = 0.f; } else {
                const int pos = atomicAdd(&cnt[bi[k]], 1);
                lcode[(size_t)bi[k] * TA + pos] = r * 4 + k;
                lw[(size_t)bi[k] * TA + pos] = sv[k] / sum * 2.5f; }
            }
        }
        {
            float gs[16], sh[16];
#pragma unroll
            for (int q = 0; q < 16; ++q) { const int k = (q >> 3) * 512 + 8 * lane + (q & 7); gs[q] = gs2[k]; sh[q] = sh2[k]; }
            for (int rr8 = 0; rr8 < 8; ++rr8) {
                const int rho = w * 8 + rr8;
                const float rr = rinvs[rho];
                const float* s2 = hmid_row(p, r0 + rho);
                bf16_t* dst = xn2 + (size_t)(r0 + rho) * D;
#pragma unroll
                for (int h2 = 0; h2 < 2; ++h2) {
                    const f32x4 x0 = *(const f32x4*)(s2 + h2 * 512 + 8 * lane), x1 = *(const f32x4*)(s2 + h2 * 512 + 8 * lane + 4);
                    u32x4 o;
                    o[0] = cvt_pk_bf16(x0[0] * rr * gs[h2 * 8 + 0] + sh[h2 * 8 + 0], x0[1] * rr * gs[h2 * 8 + 1] + sh[h2 * 8 + 1]);
                    o[1] = cvt_pk_bf16(x0[2] * rr * gs[h2 * 8 + 2] + sh[h2 * 8 + 2], x0[3] * rr * gs[h2 * 8 + 3] + sh[h2 * 8 + 3]);
                    o[2] = cvt_pk_bf16(x1[0] * rr * gs[h2 * 8 + 4] + sh[h2 * 8 + 4], x1[1] * rr * gs[h2 * 8 + 5] + sh[h2 * 8 + 5]);
                    o[3] = cvt_pk_bf16(x1[2] * rr * gs[h2 * 8 + 6] + sh[h2 * 8 + 6], x1[3] * rr * gs[h2 * 8 + 7] + sh[h2 * 8 + 7]);
                    *(u32x4*)(dst + h2 * 512 + 8 * lane) = o;
                }
            }
        }
    }
    __syncthreads();
}

constexpr int LDS_CSTAGE = 128 * C_LD * 4;
constexpr int MOE_LDS_LIST = LDS_CSTAGE;
constexpr int LDS_MOE = LDS_CSTAGE + 128 * 4 + 128 * 4 + 64 * 4;
constexpr int LDS_MODB = (9 * D + 9 * 8 * 32) * 4;
constexpr int LDS_TOTAL = LDS_MOE > LDS_MODB ? LDS_MOE : LDS_MODB;
struct ARowCode { const bf16_t* base; const int* codes; int mode; __device__ __forceinline__ const bf16_t* operator()(int m) const {
    const int c = codes[m];
    if (mode == 0) return base + (size_t)(c < 0 ? 0 : (c >> 2)) * D;
    return base + (size_t)(c < 0 ? 0 : (c >> 2) * 5 + (c & 3)) * DE; } };
__device__ __forceinline__ void moe_tstart(const P& p, int l, int* ts) {
    if (TIDX == 0) { const int* cnt = (const int*)(p.ws + WS_CTL) + l * NE; int a = 0; for (int e = 0; e < NE; ++e) { ts[e] = a; a += (cnt[e] + 127) >> 7; } ts[NE] = a; }
    __syncthreads();
}
__device__ __forceinline__ void st_moe1(const P& p, int l, unsigned char* lds) {
    int* codes = (int*)(lds + MOE_LDS_LIST); float* wts = (float*)(codes + 128); int* ts = (int*)(wts + 128);
    const int nrows = l == 0 ? TA : TL;
    const int* cnt = (const int*)(p.ws + WS_CTL) + l * NE;
    const int* lcode = (const int*)(p.ws + WS_LCODE);
    const float* lw = (const float*)(p.ws + WS_LW);
    const bf16_t* xn2 = (const bf16_t*)(p.ws + WS_BUFA);
    bf16_t* hid = (bf16_t*)(p.ws + WS_HID);
    const bf16_t* wgu = (const bf16_t*)(p.ws + WS_WGU);
    moe_tstart(p, l, ts);
    const int nrt = ts[NE], nsh = nrows / 128, total = (nrt + nsh) * 2;
    const int lane = TIDX & 63, w = TIDX >> 6, wr = w >> 1, wc = w & 1, lr = lane & 31, lh = lane >> 5;
    int t_end, t_step;
    for (int tile = xcd_first(total, t_end, t_step); tile < t_end; tile += t_step) {
        const int rt = tile >> 1, j = tile & 1;
        int e, m0, valid;
        if (rt < nrt) { e = 0; while (ts[e + 1] <= rt) ++e; m0 = (rt - ts[e]) * 128; valid = cnt[e] - m0; if (valid > 128) valid = 128; }
        else { e = NE; m0 = (rt - nrt) * 128; valid = 128; }
        __syncthreads();
        if (TIDX < 128) {
            const int m = TIDX;
            if (e < NE) { const bool ok = m < valid; codes[m] = ok ? lcode[(size_t)e * TA + m0 + m] : -1; wts[m] = ok ? lw[(size_t)e * TA + m0 + m] : 0.f; }
            else { codes[m] = (m0 + m) * 4; wts[m] = 1.f; }
        }
        __syncthreads();
        f32x16 acc[2][2];
        gemm_tile(acc, ARowCode{xn2, codes, 0}, wgu + (size_t)((e * 2 + j) * 128) * D, D, D, lds);
#pragma unroll
        for (int mi = 0; mi < 2; ++mi) {
            const int m = wr * 64 + mi * 32 + lr;
            const int c = codes[m];
            if (c >= 0) {
                const float wt = wts[m];
                const size_t hrow = e < NE ? (size_t)(c >> 2) * 5 + (c & 3) : (size_t)(c >> 2) * 5 + 4;
#pragma unroll
                for (int g = 0; g < 4; ++g) {
                    float h[4];
#pragma unroll
                    for (int q = 0; q < 4; ++q) h[q] = silu_f(acc[mi][0][4 * g + q]) * acc[mi][1][4 * g + q] * wt;
                    *(uint2*)(hid + hrow * DE + j * 64 + wc * 32 + 8 * g + 4 * lh) = pack4(h[0], h[1], h[2], h[3]);
                }
            }
        }
    }
}
__device__ __forceinline__ void st_moe2(const P& p, int l, unsigned char* lds) {
    int* codes = (int*)(lds + MOE_LDS_LIST); float* wts = (float*)(codes + 128); int* ts = (int*)(wts + 128);
    const int* cnt = (const int*)(p.ws + WS_CTL) + l * NE;
    const int* lcode = (const int*)(p.ws + WS_LCODE);
    const bf16_t* hid = (const bf16_t*)(p.ws + WS_HID);
    bf16_t* slab = (bf16_t*)(p.ws + WS_SLAB);
    const bf16_t* wd = (const bf16_t*)(p.ws + WS_WD);
    moe_tstart(p, l, ts);
    const int nrt = ts[NE], total = nrt * 8;
    int t_end, t_step;
    for (int tile = xcd_first(total, t_end, t_step); tile < t_end; tile += t_step) {
        const int rt = tile >> 3, n0 = (tile & 7) * 128;
        int e = 0; while (ts[e + 1] <= rt) ++e;
        const int m0 = (rt - ts[e]) * 128; int valid = cnt[e] - m0; if (valid > 128) valid = 128;
        __syncthreads();
        if (TIDX < 128) { const int m = TIDX; codes[m] = m < valid ? lcode[(size_t)e * TA + m0 + m] : -1; }
        __syncthreads();
        f32x16 acc[2][2];
        gemm_tile(acc, ARowCode{hid, codes, 1}, wd + ((size_t)e * D + n0) * DE, DE, DE, lds);
        acc_foreach4_lds(acc, lds, [&](int r, int c, float v0, float v1, float v2, float v3) { const int code = codes[r]; if (code >= 0) *(uint2*)(slab + (size_t)code * D + n0 + c) = pack4(v0, v1, v2, v3); });
    }
}
struct EpiMoeF { const bf16_t* slab; const float* modl; float* out; const float* hcmid; float* hc1; bool outw = true;
    __device__ __forceinline__ void operator()(int r, int c, float v0, float v1, float v2, float v3) const {
    const bf16_t* sl = slab + (size_t)r * 4 * D + c;
    float v[4] = {v0, v1, v2, v3};
#pragma unroll
    for (int k = 0; k < 4; ++k) { const uint2 q = *(const uint2*)(sl + (size_t)k * D);
        v[0] += __uint_as_float(q.x << 16); v[1] += __uint_as_float(q.x & 0xffff0000u); v[2] += __uint_as_float(q.y << 16); v[3] += __uint_as_float(q.y & 0xffff0000u); }
    const f32x4 g2 = *(const f32x4*)(modl + ((size_t)row_bb(r) * 6 + 5) * D + c);
    const f32x4 hm = *(const f32x4*)((r < TL ? out + (size_t)r * D : hcmid + (size_t)(r - TL) * D) + c);
    f32x4 o; o[0] = hm[0] + g2[0] * v[0]; o[1] = hm[1] + g2[1] * v[1]; o[2] = hm[2] + g2[2] * v[2]; o[3] = hm[3] + g2[3] * v[3];
    if (outw) *(f32x4*)((r < TL ? out + (size_t)r * D : hc1 + (size_t)(r - TL) * D) + c) = o;
    else if (o[0] == 12345.f) *(f32x4*)(hc1) = o; } };
__device__ __forceinline__ EpiMoeF make_epi_moef(const P& p, int l) {
    return EpiMoeF{(const bf16_t*)(p.ws + WS_SLAB), (const float*)(p.ws + WS_MOD) + (size_t)l * 9 * 6 * D, p.out, (const float*)(p.ws + WS_HCMID), (float*)(p.ws + WS_HC1)};
}
__device__ __forceinline__ void st_prep_moe(const P& p, int l) {
    bf16_t* wgu = (bf16_t*)(p.ws + WS_WGU);
    const int tot1 = 33 * 2 * 4 * 128 * 32;
    for (int idx = BIDX * NT + TIDX; idx < tot1; idx += gridDim.x * NT) {
        const int i = idx & 31; int q_ = idx >> 5; const int kc = q_ & 127; q_ >>= 7; const int q = q_ & 3; q_ >>= 2; const int j = q_ & 1; const int e = q_ >> 1;
        const int wc = q >> 1, ni = q & 1, unit = j * 64 + wc * 32 + i;
        const float* sp; size_t sk;
        if (e < NE) { sp = p.in[ni ? I_WEU : I_WEG] + ((size_t)(l * D + kc * 8) * NE + e) * DE + unit; sk = (size_t)NE * DE; }
        else { sp = p.in[ni ? I_WSU : I_WSG] + (size_t)(l * D + kc * 8) * DE + unit; sk = DE; }
        u32x4 o;
        o[0] = (unsigned)f2bf(sp[0]) | ((unsigned)f2bf(sp[sk]) << 16);
        o[1] = (unsigned)f2bf(sp[2 * sk]) | ((unsigned)f2bf(sp[3 * sk]) << 16);
        o[2] = (unsigned)f2bf(sp[4 * sk]) | ((unsigned)f2bf(sp[5 * sk]) << 16);
        o[3] = (unsigned)f2bf(sp[6 * sk]) | ((unsigned)f2bf(sp[7 * sk]) << 16);
        *(u32x4*)(wgu + ((size_t)(e * 2 + j) * 128 + q * 32 + i) * D + kc * 8) = o;
    }
    bf16_t* wd = (bf16_t*)(p.ws + WS_WD);
    const int tot2 = 33 * 16 * 1024;
    for (int idx = BIDX * NT + TIDX; idx < tot2; idx += gridDim.x * NT) {
        const int n = idx & 1023; int q_ = idx >> 10; const int kc = q_ & 15; const int e = q_ >> 4;
        const float* sp = (e < NE ? p.in[I_WED] + ((size_t)(l * NE + e) * DE + kc * 8) * D : p.in[I_WSD] + ((size_t)l * DE + kc * 8) * D) + n;
        u32x4 o;
        o[0] = (unsigned)f2bf(sp[0]) | ((unsigned)f2bf(sp[D]) << 16);
        o[1] = (unsigned)f2bf(sp[2 * D]) | ((unsigned)f2bf(sp[3 * D]) << 16);
        o[2] = (unsigned)f2bf(sp[4 * D]) | ((unsigned)f2bf(sp[5 * D]) << 16);
        o[3] = (unsigned)f2bf(sp[6 * D]) | ((unsigned)f2bf(sp[7 * D]) << 16);
        *(u32x4*)(wd + ((size_t)e * D + n) * DE + kc * 8) = o;
    }
}

struct SsmPar { float lre, lim, dt; };
__device__ __forceinline__ SsmPar ssm_par(const P& p, int l, int dir, int g, int pp) {
    const int pi = ((l * 2 + dir) * SG + g) * SP + pp;
    SsmPar r; r.lre = p.in[I_LRE][pi]; r.lim = p.in[I_LIM][pi]; r.dt = expf(p.in[I_LDT][(l * 2 + dir) * SG + g]); return r;
}
__device__ __forceinline__ float2 ssm_pow(const SsmPar& q, float e) {
    const float mag = expf(e * q.lre * q.dt), ang = e * (q.lim * q.dt);
    return make_float2(mag * cosf(ang), mag * sinf(ang));
}
__device__ __forceinline__ float2 ssm_f(const SsmPar& q) {
    const float2 lb = ssm_pow(q, 1.f);
    const float nr = lb.x - 1.f, ni = lb.y, den = q.lre * q.lre + q.lim * q.lim;
    return make_float2((nr * q.lre + ni * q.lim) / den, (ni * q.lre - nr * q.lim) / den);
}
__device__ __forceinline__ float2 cmul(float2 a, float2 b) { return make_float2(a.x * b.x - a.y * b.y, a.x * b.y + a.y * b.x); }
__device__ __forceinline__ void st_ssm_kj(const P& p, float* lds) {
    float* lam = lds; float* Cc = lds + 128; float* Bb = Cc + 2048;
    float* kj = (float*)(p.ws + WS_KJ);
    const int t = TIDX;
    for (int item = BIDX; item < 64; item += gridDim.x) {
        const int l = item >> 5, g = (item >> 1) & 15, dir = item & 1;
        const int base = (l * 2 + dir) * SG + g;
        __syncthreads();
        if (t < 64) {
            const SsmPar q = ssm_par(p, l, dir, g, t);
            const float2 lb = ssm_pow(q, 1.f), f = ssm_f(q);
            lam[2 * t] = lb.x; lam[2 * t + 1] = lb.y;
            for (int h = 0; h < 16; ++h) {
                const size_t bi = ((size_t)base * SP + t) * 16 + h;
                const float2 bb = cmul(f, make_float2(p.in[I_BRE][bi], p.in[I_BIM][bi]));
                Bb[(t * 16 + h) * 2] = bb.x; Bb[(t * 16 + h) * 2 + 1] = bb.y;
            }
        }
        for (int i = t; i < 1024; i += NT) { const size_t ci = (size_t)base * 1024 + i; Cc[2 * i] = p.in[I_CRE][ci]; Cc[2 * i + 1] = p.in[I_CIM][ci]; }
        __syncthreads();
        const int ho = t >> 4, hi = t & 15;
        float acc[32];
#pragma unroll
        for (int j = 0; j < 32; ++j) acc[j] = 0.f;
        for (int pp = 0; pp < 64; ++pp) {
            float2 z = cmul(make_float2(Cc[(ho * 64 + pp) * 2], Cc[(ho * 64 + pp) * 2 + 1]), make_float2(Bb[(pp * 16 + hi) * 2], Bb[(pp * 16 + hi) * 2 + 1]));
            const float2 lb = make_float2(lam[2 * pp], lam[2 * pp + 1]);
#pragma unroll
            for (int j = 0; j < 32; ++j) { acc[j] += z.x; z = cmul(z, lb); }
        }
#pragma unroll
        for (int j = 0; j < 32; ++j) kj[((size_t)((l * 16 + g) * 2 + dir) * 32 + j) * 256 + ho * 16 + hi] = acc[j];
    }
    __syncthreads();
}
__device__ __forceinline__ void st_prep_ssm(const P& p, int l) {
    bf16_t* wst = (bf16_t*)(p.ws + WS_WST);
    for (int idx = BIDX * NT + TIDX; idx < 16 * 256 * 64; idx += gridDim.x * NT) {
        const int kc = idx & 63, n = (idx >> 6) & 255, g = idx >> 14;
        const int dir = n >> 7, c = (n >> 6) & 1, pp = n & 63, s = kc >> 1, h0 = (kc & 1) * 8;
        const SsmPar q = ssm_par(p, l, dir, g, pp);
        const float2 coef = cmul(ssm_pow(q, dir == 0 ? (float)(31 - s) : (float)s), ssm_f(q));
        const size_t bi = ((size_t)((l * 2 + dir) * SG + g) * SP + pp) * 16 + h0;
        float v[8];
#pragma unroll
        for (int j = 0; j < 8; ++j) { const float2 z = cmul(coef, make_float2(p.in[I_BRE][bi + j], p.in[I_BIM][bi + j])); v[j] = c == 0 ? z.x : z.y; }
        u32x4 o; o[0] = cvt_pk_bf16(v[0], v[1]); o[1] = cvt_pk_bf16(v[2], v[3]); o[2] = cvt_pk_bf16(v[4], v[5]); o[3] = cvt_pk_bf16(v[6], v[7]);
        *(u32x4*)(wst + ((size_t)(g * 256 + n)) * 512 + kc * 8) = o;
    }
    bf16_t* kw = (bf16_t*)(p.ws + WS_KW);
    const float* kj = (const float*)(p.ws + WS_KJ);
    for (int idx = BIDX * NT + TIDX; idx < 16 * 512 * 96; idx += gridDim.x * NT) {
        const int kc = idx % 96, n = (idx / 96) & 511, g = idx / (96 * 512);
        const int tau = n >> 4, ho = n & 15;
        float v[8];
        if (kc < 64) {
            const int s = kc >> 1, hi0 = (kc & 1) * 8;
#pragma unroll
            for (int j = 0; j < 8; ++j) {
                float a = 0.f;
                if (s <= tau) a += kj[((size_t)((l * 16 + g) * 2 + 0) * 32 + (tau - s)) * 256 + ho * 16 + hi0 + j];
                if (s >= tau) a += kj[((size_t)((l * 16 + g) * 2 + 1) * 32 + (s - tau)) * 256 + ho * 16 + hi0 + j];
                if (s == tau && ho == hi0 + j) a += p.in[I_SD][l * DSSM + g * 16 + ho];
                v[j] = a;
            }
        } else {
            const int kk = (kc - 64) * 8, dir = kk >> 7, c = (kk >> 6) & 1, p0 = kk & 63;
            const float e = dir == 0 ? (float)(tau + 1) : (float)(32 - tau);
#pragma unroll
            for (int j = 0; j < 8; ++j) {
                const SsmPar q = ssm_par(p, l, dir, g, p0 + j);
                const size_t ci = ((size_t)((l * 2 + dir) * SG + g) * 16 + ho) * SP + p0 + j;
                const float2 z = cmul(make_float2(p.in[I_CRE][ci], p.in[I_CIM][ci]), ssm_pow(q, e));
                v[j] = c == 0 ? z.x : -z.y;
            }
        }
        u32x4 o; o[0] = cvt_pk_bf16(v[0], v[1]); o[1] = cvt_pk_bf16(v[2], v[3]); o[2] = cvt_pk_bf16(v[4], v[5]); o[3] = cvt_pk_bf16(v[6], v[7]);
        *(u32x4*)(kw + ((size_t)(g * 512 + n)) * 768 + kc * 8) = o;
    }
}
__device__ __forceinline__ void st_ssm_egemm(const P& p, unsigned char* lds) {
    const bf16_t* ua = (const bf16_t*)(p.ws + WS_UA);
    const bf16_t* wst = (const bf16_t*)(p.ws + WS_WST);
    float* E = (float*)(p.ws + WS_E);
    int t_end, t_step;
    for (int tile = xcd_first(160, t_end, t_step); tile < t_end; tile += t_step) {
        const int nt = tile & 1, mt = (tile >> 1) % 5, g = tile / 10;
        f32x16 acc[2][2];
        gemm_tile(acc, ARowPlain{ua + (size_t)(g * 640 + mt * 128) * 768, 768}, wst + (size_t)(g * 256 + nt * 128) * 512, 512, 512, lds);
        acc_foreach4_lds(acc, lds, [&](int r, int c, float v0, float v1, float v2, float v3) { f32x4 o; o[0] = v0; o[1] = v1; o[2] = v2; o[3] = v3; *(f32x4*)(E + (size_t)(g * 640 + mt * 128 + r) * 256 + nt * 128 + c) = o; });
    }
}
__device__ __forceinline__ void st_ssm_carry(const P& p, int l) {
    bf16_t* ua = (bf16_t*)(p.ws + WS_UA);
    const float* E = (const float*)(p.ws + WS_E);
    for (int idx = BIDX * NT + TIDX; idx < NB * 16 * 2 * 64; idx += gridDim.x * NT) {
        const int pp = idx & 63, dir = (idx >> 6) & 1, g = (idx >> 7) & 15, b = idx >> 11;
        const float2 l32 = ssm_pow(ssm_par(p, l, dir, g, pp), 32.f);
        float2 S = make_float2(0.f, 0.f);
        for (int s0 = 0; s0 < 72; s0 += 8) {
            int ch[8]; float er[8], ei[8];
#pragma unroll
            for (int j = 0; j < 8; ++j) {
                const int step = s0 + j;
                if (dir == 0) ch[j] = step < 8 ? 512 + b * 8 + step : b * 64 + (step - 8);
                else ch[j] = step < 8 ? 512 + b * 8 + (7 - step) : b * 64 + (63 - (step - 8));
                const float* e = E + (size_t)(g * 640 + ch[j]) * 256 + dir * 128 + pp;
                er[j] = e[0]; ei[j] = e[64];
            }
#pragma unroll
            for (int j = 0; j < 8; ++j) {
                bf16_t* o = ua + (size_t)(g * 640 + ch[j]) * 768 + 512 + dir * 128 + pp;
                o[0] = f2bf(S.x); o[64] = f2bf(S.y);
                S = cmul(l32, S); S.x += er[j]; S.y += ei[j];
            }
        }
    }
}
__device__ __forceinline__ void st_ssm_ygemm(const P& p, int l, unsigned char* lds) {
    const bf16_t* ua = (const bf16_t*)(p.ws + WS_UA);
    const bf16_t* kw = (const bf16_t*)(p.ws + WS_KW);
    bf16_t* G = (bf16_t*)(p.ws + WS_G);
    const int nmt = l == 0 ? 5 : 4;
    int t_end, t_step;
    for (int tile = xcd_first(16 * nmt * 4, t_end, t_step); tile < t_end; tile += t_step) {
        const int nt = tile & 3, mt = (tile >> 2) % nmt, g = tile / (4 * nmt);
        f32x16 acc[2][2];
        gemm_tile(acc, ARowPlain{ua + (size_t)(g * 640 + mt * 128) * 768, 768}, kw + (size_t)(g * 512 + nt * 128) * 768, 768, 768, lds);
        acc_foreach4_lds(acc, lds, [&](int r, int c, float v0, float v1, float v2, float v3) {
            const int chunk = mt * 128 + r, n = nt * 128 + c;
            if (chunk < TA / 32) *(uint2*)(G + (size_t)(chunk * 32 + (n >> 4)) * DSSM + g * 16 + (n & 15)) = pack4(gelu_f(v0), gelu_f(v1), gelu_f(v2), gelu_f(v3)); });
    }
}
struct EpiGlu2 { const bf16_t* G; bf16_t* mix; const float* bias; __device__ __forceinline__ void operator()(int r, int c, float v0, float v1, float v2, float v3) const {
    const uint2 q = *(const uint2*)(G + (size_t)r * DSSM + c);
    const f32x4 b = *(const f32x4*)(bias + c);
    *(uint2*)(mix + (size_t)r * D + 256 + c) = pack4(__uint_as_float(q.x << 16) * sigmoid_f(v0 + b[0]), __uint_as_float(q.x & 0xffff0000u) * sigmoid_f(v1 + b[1]),
                                                     __uint_as_float(q.y << 16) * sigmoid_f(v2 + b[2]), __uint_as_float(q.y & 0xffff0000u) * sigmoid_f(v3 + b[3])); } };

constexpr float QSCALE = 0.125f * 1.4426950408889634f;
__device__ __forceinline__ void st_rope_table(const P& p) {
    float2* tab = (float2*)(p.ws + WS_ROPE);
    for (int idx = BIDX * NT + TIDX; idx < L * 32; idx += gridDim.x * NT) {
        const int t = idx >> 5, a = (idx >> 4) & 1, i = idx & 15;
        const float pos = a == 0 ? (float)(t / 64) : (float)(t % 64);
        const float ang = pos * powf(10000.f, -(float)i / 16.f);
        tab[idx] = make_float2(cosf(ang), sinf(ang));
    }
}
__device__ __forceinline__ void st_inproj(const P& p, int l, unsigned char* lds) {
    const bf16_t* A = (const bf16_t*)(p.ws + WS_BUFA);
    const bf16_t* Bt = (const bf16_t*)(p.ws + WS_WTIN);
    bf16_t* pc = (bf16_t*)(p.ws + WS_PC);
    bf16_t* ua = (bf16_t*)(p.ws + WS_UA);
    bf16_t* qb = (bf16_t*)(p.ws + WS_QB);
    bf16_t* kb = (bf16_t*)(p.ws + WS_KB);
    bf16_t* vt = (bf16_t*)(p.ws + WS_VT);
    const float2* rope = (const float2*)(p.ws + WS_ROPE);
    const int lane = TIDX & 63, w = TIDX >> 6, wr = w >> 1, wc = w & 1, lr = lane & 31, lh = lane >> 5;
    constexpr int TN = DIN / 128;
    int t_end, t_step;
    for (int tile = xcd_first((TA / 128) * TN, t_end, t_step); tile < t_end; tile += t_step) {
        const int tn = tile % TN, m0 = (tile / TN) * 128, n0 = tn * 128;
        f32x16 acc[2][2];
        gemm_tile(acc, ARowPlain{A + (size_t)m0 * D, D}, Bt + (size_t)n0 * D, D, D, lds);
        if (tn < 6) {
            acc_foreach4_lds(acc, lds, [&](int r, int c, float v0, float v1, float v2, float v3) { *(uint2*)(pc + (size_t)(m0 + r) * 768 + n0 + c) = pack4(v0, v1, v2, v3); });
        } else if (tn < 8) {
            acc_foreach4_lds(acc, lds, [&](int r, int c, float v0, float v1, float v2, float v3) { const int row = m0 + r, g = (tn - 6) * 8 + (c >> 4);
                *(uint2*)(ua + (size_t)(g * 640 + (row >> 5)) * 768 + (row & 31) * 16 + (c & 15)) = pack4(v0, v1, v2, v3); });
        } else if (tn < 13) {
            const bool isq = tn < 12;
            const float* gain = (isq ? p.in[I_QG] : p.in[I_KG]) + l * 64;
            const bool lat = m0 < TL;
            const float osc = isq ? QSCALE : 1.f;
#pragma unroll
            for (int mi = 0; mi < 2; ++mi) {
                const int row = m0 + wr * 64 + mi * 32 + lr;
                float ss = 0.f;
#pragma unroll
                for (int ni = 0; ni < 2; ++ni)
#pragma unroll
                    for (int r = 0; r < 16; ++r) ss += acc[mi][ni][r] * acc[mi][ni][r];
                ss += __shfl_xor(ss, 32);
                const float rinv = rsqrtf(ss * (1.f / 64.f) + 1e-6f) * osc;
                const int t = row & (L - 1);
                bf16_t* o = isq ? qb + (size_t)row * DATT + ((tn - 8) * 2 + wc) * 64 : kb + (size_t)row * 128 + wc * 64;
#pragma unroll
                for (int ni = 0; ni < 2; ++ni)
#pragma unroll
                    for (int g = 0; g < 2; ++g) {
                        const int d0 = ni * 32 + 8 * g + 4 * lh;
                        const f32x4 glo = *(const f32x4*)(gain + d0), ghi = *(const f32x4*)(gain + d0 + 16);
                        float t1[4], t2[4];
#pragma unroll
                        for (int q = 0; q < 4; ++q) { t1[q] = acc[mi][ni][4 * g + q] * rinv * glo[q]; t2[q] = acc[mi][ni][8 + 4 * g + q] * rinv * ghi[q]; }
                        if (lat) {
                            const float2* cs = rope + (t * 2 + ni) * 16 + 8 * g + 4 * lh;
                            const f32x4 c01 = *(const f32x4*)(cs), c23 = *(const f32x4*)(cs + 2);
                            const float cc[4] = {c01[0], c01[2], c23[0], c23[2]}, sn[4] = {c01[1], c01[3], c23[1], c23[3]};
#pragma unroll
                            for (int q = 0; q < 4; ++q) { const float a = t1[q], b = t2[q]; t1[q] = a * cc[q] - b * sn[q]; t2[q] = a * sn[q] + b * cc[q]; }
                        }
                        *(uint2*)(o + d0) = pack4(t1[0], t1[1], t1[2], t1[3]);
                        *(uint2*)(o + d0 + 16) = pack4(t2[0], t2[1], t2[2], t2[3]);
                    }
            }
        } else {
            acc_foreach4_lds(acc, lds, [&](int r, int c, float v0, float v1, float v2, float v3) { *(uint2*)(vt + (size_t)(m0 + r) * 128 + c) = pack4(v0, v1, v2, v3); });
        }
    }
}

constexpr int AT_KROWB = 144, AT_VROWB = 136, AT_VOFF = 64 * AT_KROWB;
__device__ __forceinline__ void st_attn2(const P& p, int l, unsigned char* lds, int part, int nparts) {
    const bf16_t* qb = (const bf16_t*)(p.ws + WS_QB);
    const bf16_t* kb = (const bf16_t*)(p.ws + WS_KB);
    const bf16_t* vb = (const bf16_t*)(p.ws + WS_VT);
    bf16_t* mix = (bf16_t*)(p.ws + WS_BUFA);
    const int t = TIDX, lane = t & 63, w = t >> 6, lr = lane & 31, lh = lane >> 5;
    constexpr int NLAT = NB * 32 * 2;
    const int nitems = NLAT + (l == 0 ? NB * 4 * 2 : 0);
    int t_end, t_step;
    for (int kk = xcd_first((nitems - part + nparts - 1) / nparts, t_end, t_step); kk < t_end; kk += t_step) {
        const int item = kk * nparts + part;
        const bool isctx = item >= NLAT;
        int b, q64, g;
        if (!isctx) { g = item & 1; q64 = (item >> 1) & 31; b = item >> 6; }
        else { const int it = item - NLAT; g = it & 1; q64 = (it >> 1) & 3; b = it >> 3; }
        const int hq = g * 4 + w;
        const int rq0 = isctx ? TL + b * LC + q64 * 64 : b * L + q64 * 64;
        bf16x8 qf[2][4];
#pragma unroll
        for (int qs = 0; qs < 2; ++qs)
#pragma unroll
            for (int s4 = 0; s4 < 4; ++s4) qf[qs][s4] = *(const bf16x8*)(qb + (size_t)(rq0 + qs * 32 + lr) * DATT + hq * 64 + s4 * 16 + lh * 8);
        const float sinkl = p.in[I_SINK][l * NQH + hq] * 1.4426950408889634f;
        float m[2] = {sinkl, sinkl};
        float lsum[2]; lsum[0] = lsum[1] = lh == 0 ? 1.f : 0.f;
        f32x16 o[2][2];
        float zf = 0.f; asm volatile("" : "+v"(zf));
#pragma unroll
        for (int qs = 0; qs < 2; ++qs)
#pragma unroll
            for (int dt = 0; dt < 2; ++dt)
#pragma unroll
                for (int r = 0; r < 16; ++r) o[qs][dt][r] = zf;
        const int nwin = isctx ? 0 : 5, nkt = nwin + 4;
        const int srow = t >> 3, kc = t & 7;
        u32x4 pk[2], pv[2];
        auto tile_row0 = [&](int kt, bool& win, bool& valid) -> int {
            if (kt < nwin) { win = true; const int k64 = q64 - 2 + kt; valid = (k64 >= 0 && k64 < 32); return b * L + k64 * 64; }
            win = false; valid = true; return TL + b * LC + (kt - nwin) * 64;
        };
        int kt = 0; bool win, valid; int krow0 = 0;
        for (; kt < nkt; ++kt) { krow0 = tile_row0(kt, win, valid); if (valid) break; }
#pragma unroll
        for (int i = 0; i < 2; ++i) { const size_t off = (size_t)(krow0 + srow + 32 * i) * 128 + g * 64 + kc * 8; pk[i] = *(const u32x4*)(kb + off); pv[i] = *(const u32x4*)(vb + off); }
        while (kt < nkt) {
            const bool cwin = win; const int ckrow0 = krow0;
            __syncthreads();
#pragma unroll
            for (int i = 0; i < 2; ++i) {
                const int row = srow + 32 * i;
                *(u32x4*)(lds + row * AT_KROWB + kc * 16) = pk[i];
                unsigned char* vd = lds + AT_VOFF + (kc * 8) * AT_VROWB + row * 2;
#pragma unroll
                for (int q = 0; q < 4; ++q) { *(bf16_t*)(vd + (2 * q) * AT_VROWB) = (bf16_t)(pv[i][q] & 0xffffu); *(bf16_t*)(vd + (2 * q + 1) * AT_VROWB) = (bf16_t)(pv[i][q] >> 16); }
            }
            int nkt2 = kt + 1; bool nwin2 = false, nvalid = false; int nrow0 = 0;
            for (; nkt2 < nkt; ++nkt2) { nrow0 = tile_row0(nkt2, nwin2, nvalid); if (nvalid) break; }
            if (nkt2 < nkt) {
#pragma unroll
                for (int i = 0; i < 2; ++i) { const size_t off = (size_t)(nrow0 + srow + 32 * i) * 128 + g * 64 + kc * 8; pk[i] = *(const u32x4*)(kb + off); pv[i] = *(const u32x4*)(vb + off); }
            }
            __syncthreads();
            const int j0t = ckrow0 - b * L;
#pragma unroll
            for (int sub = 0; sub < 2; ++sub) {
                bf16x8 kf[4];
#pragma unroll
                for (int s4 = 0; s4 < 4; ++s4) kf[s4] = *(const bf16x8*)(lds + (sub * 32 + lr) * AT_KROWB + s4 * 32 + lh * 16);
#pragma unroll
                for (int qs = 0; qs < 2; ++qs) {
                    bool partial = false;
                    if (cwin) {
                        const int j0 = j0t + sub * 32, i0 = q64 * 64 + qs * 32;
                        if (j0 > i0 + 31 + 128 || j0 + 31 < i0 - 128) continue;
                        partial = !(j0 >= i0 + 31 - 128 && j0 + 31 <= i0 + 128);
                    }
                    f32x16 sT;
#pragma unroll
                    for (int r = 0; r < 16; ++r) sT[r] = zf;
#pragma unroll
                    for (int s4 = 0; s4 < 4; ++s4) sT = __builtin_amdgcn_mfma_f32_32x32x16_bf16(kf[s4], qf[qs][s4], sT, 0, 0, 0);
                    if (partial) {
                        const int dj0 = j0t + sub * 32 + 4 * lh - (q64 * 64 + qs * 32 + lr);
#pragma unroll
                        for (int r = 0; r < 16; ++r) { const int dj = dj0 + (r & 3) + 8 * (r >> 2); if (dj > 128 || dj < -128) sT[r] = -1e30f; }
                    }
                    float mt = sT[0];
#pragma unroll
                    for (int r = 1; r < 16; ++r) mt = fmaxf(mt, sT[r]);
                    mt = fmaxf(mt, __shfl_xor(mt, 32));
                    const float mn = fmaxf(m[qs], mt);
                    const float alpha = __builtin_amdgcn_exp2f(m[qs] - mn);
                    m[qs] = mn;
                    float ps = 0.f;
#pragma unroll
                    for (int r = 0; r < 16; ++r) { sT[r] = __builtin_amdgcn_exp2f(sT[r] - mn); ps += sT[r]; }
                    lsum[qs] = lsum[qs] * alpha + ps;
#pragma unroll
                    for (int r = 0; r < 16; ++r) { o[qs][0][r] *= alpha; o[qs][1][r] *= alpha; }
#pragma unroll
                    for (int s2 = 0; s2 < 2; ++s2) {
                        u32x4 pkk;
                        pkk[0] = cvt_pk_bf16(sT[8 * s2 + 0], sT[8 * s2 + 1]); pkk[1] = cvt_pk_bf16(sT[8 * s2 + 2], sT[8 * s2 + 3]);
                        pkk[2] = cvt_pk_bf16(sT[8 * s2 + 4], sT[8 * s2 + 5]); pkk[3] = cvt_pk_bf16(sT[8 * s2 + 6], sT[8 * s2 + 7]);
                        const bf16x8 pf = __builtin_bit_cast(bf16x8, pkk);
#pragma unroll
                        for (int dt = 0; dt < 2; ++dt) {
                            const unsigned char* vp = lds + AT_VOFF + (dt * 32 + lr) * AT_VROWB + (sub * 32 + s2 * 16 + lh * 4) * 2;
                            const uint2 a = *(const uint2*)(vp), c2 = *(const uint2*)(vp + 16);
                            u32x4 vv; vv[0] = a.x; vv[1] = a.y; vv[2] = c2.x; vv[3] = c2.y;
                            o[qs][dt] = __builtin_amdgcn_mfma_f32_32x32x16_bf16(__builtin_bit_cast(bf16x8, vv), pf, o[qs][dt], 0, 0, 0);
                        }
                    }
                }
            }
            kt = nkt2; win = nwin2; krow0 = nrow0;
        }
#pragma unroll
        for (int qs = 0; qs < 2; ++qs) {
            const float lt = lsum[qs] + __shfl_xor(lsum[qs], 32);
            const float inv = 1.f / lt;
            bf16_t* orow = mix + (size_t)(rq0 + qs * 32 + lr) * D + 512 + hq * 64;
#pragma unroll
            for (int dt = 0; dt < 2; ++dt)
#pragma unroll
                for (int rg = 0; rg < 4; ++rg)
                    *(uint2*)(orow + dt * 32 + 8 * rg + 4 * lh) = pack4(o[qs][dt][4 * rg] * inv, o[qs][dt][4 * rg + 1] * inv, o[qs][dt][4 * rg + 2] * inv, o[qs][dt][4 * rg + 3] * inv);
        }
    }
}


constexpr int FAKE = 0;
constexpr int PROBE2 = 0;
__device__ __forceinline__ void st_fake(const P& p, unsigned char* lds) {
    if (FAKE == 0) return;
    const bf16_t* A = (const bf16_t*)(p.ws + WS_BUFA);
    const bf16_t* Bt = (const bf16_t*)(p.ws + WS_WTIN);
    constexpr int TN = DIN / 128;
    int t_end, t_step;
    float sink = 0.f;
    for (int tile = xcd_first((TA / 128) * TN, t_end, t_step); tile < t_end; tile += t_step) {
        const int tn = tile % TN, m0 = (FAKE == 2 || FAKE == 3) ? 0 : (tile / TN) * 128, n0 = FAKE == 3 ? 0 : tn * 128;
        f32x16 acc[2][2];
        gemm_tile(acc, ARowPlain{A + (size_t)m0 * D, D}, Bt + (size_t)n0 * D, D, D, lds);
        if (FAKE == 4) {
            bf16_t* dst = (bf16_t*)(p.ws + WS_HID);
            acc_foreach4_lds(acc, lds, [&](int r, int c, float v0, float v1, float v2, float v3) { *(uint2*)(dst + ((size_t)((tile / TN) * 128 + r) * 128 + c)) = pack4(v0, v1, v2, v3); });
        } else if (FAKE == 5) {
            bf16_t* dst = (bf16_t*)(p.ws + WS_HID);
            __syncthreads();
            acc_foreach4_lds(acc, lds, [&](int r, int c, float v0, float v1, float v2, float v3) { *(uint2*)(lds + (r * 136 + c) * 2) = pack4(v0, v1, v2, v3); });
            __syncthreads();
            const int t = TIDX;
#pragma unroll
            for (int i = 0; i < 8; ++i) { const int ch = t + 256 * i, r = ch >> 4, cc = (ch & 15) * 8;
                *(u32x4*)(dst + ((size_t)((tile / TN) * 128 + r) * 128 + cc)) = *(const u32x4*)(lds + (r * 136 + cc) * 2); }
        } else {
#pragma unroll
        for (int mi = 0; mi < 2; ++mi)
#pragma unroll
            for (int ni = 0; ni < 2; ++ni) sink += acc[mi][ni][0] + acc[mi][ni][7];
        }
    }
    if (sink == 12345.678f) ((float*)(p.ws + WS_RBIAS))[1000] = sink;
}
constexpr int STAGES_PER_LAYER = 11;
constexpr int N_STAGES = 1 + 2 * STAGES_PER_LAYER;
constexpr int REP_STAGE = -1;

__device__ __forceinline__ void run_stage(const P& p, int s, unsigned char* ldsb) {
    float* lds = (float*)ldsb;
    if (s == 0) { st_mod(p, lds); st_rope_table(p); st_ssm_kj(p, lds); return; }
    const int l = (s - 1) / STAGES_PER_LAYER, k = (s - 1) % STAGES_PER_LAYER;
    switch (k) {
    case 0: st_rbias(p, l, lds); st_norm(p, l, 0); st_prep_dense(p, l); st_prep_moe(p, l); st_prep_ssm(p, l); break;
    case 1: if (l == 0) st_fake(p, ldsb); st_inproj(p, l, ldsb); break;
    case 2: st_ssm_egemm(p, ldsb); st_conv(p, l); break;
    case 3: st_ssm_carry(p, l); st_attn2(p, l, ldsb, 0, 1); break;
    case 4: st_ssm_ygemm(p, l, ldsb); break;
    case 5: gemm_stage((const bf16_t*)(p.ws + WS_G), DSSM, (const bf16_t*)(p.ws + WS_WTGLU), DSSM, l == 0 ? TA : TL, DSSM, DSSM,
                       EpiGlu2{(const bf16_t*)(p.ws + WS_G), (bf16_t*)(p.ws + WS_BUFA), p.in[I_BGLU] + l * DSSM}, ldsb);
            break;
    case 6: gemm_stage((const bf16_t*)(p.ws + WS_BUFA), D, (const bf16_t*)(p.ws + WS_WTOUT), D, l == 0 ? TA : TL, D, D, make_epi_out(p, l), ldsb); break;
    case 7: if (PROBE2 == 1 && l == 0) st_router2<true>(p, l, ldsb); st_router2(p, l, ldsb); break;
    case 8: st_moe1(p, l, ldsb); break;
    case 9: st_moe2(p, l, ldsb); break;
    case 10: if (PROBE2 == 2 && l == 0) { EpiMoeF e = make_epi_moef(p, l); e.outw = false; gemm_stage((const bf16_t*)(p.ws + WS_HID) + 4 * DE, 5 * DE, (const bf16_t*)(p.ws + WS_WD) + (size_t)32 * D * DE, DE, TA, D, DE, e, ldsb); }
             gemm_stage((const bf16_t*)(p.ws + WS_HID) + 4 * DE, 5 * DE, (const bf16_t*)(p.ws + WS_WD) + (size_t)32 * D * DE, DE, l == 0 ? TA : TL, D, DE, make_epi_moef(p, l), ldsb); break;
    }
}


#define XB_TMO      128
#define XB_XCNT(j)  (256  + 64 * (j))
#define XB_XSUB(j)  (1280 + 64 * (j))
#define XB_XGEN(j)  (2304 + 64 * (j))
#define XB_TOP      3328
#define XB_TOPGEN   3392
#define XCD_BAR_WORDS 3456
#define XB_SPIN_CAP (1u << 22)
__device__ __forceinline__ unsigned xb_ld(unsigned* p)              { return __hip_atomic_load(p, __ATOMIC_RELAXED, __HIP_MEMORY_SCOPE_AGENT); }
__device__ __forceinline__ unsigned xb_add(unsigned* p, unsigned v) { return __hip_atomic_fetch_add(p, v, __ATOMIC_RELAXED, __HIP_MEMORY_SCOPE_AGENT); }
__device__ __forceinline__ unsigned xb_xcc_id() { return (unsigned)__builtin_amdgcn_s_getreg((3 << 11) | 20) & 0xFu; }
#define XB_SPIN(cond, bar) do { unsigned _sp = 0; while (cond) { __builtin_amdgcn_s_sleep(1); \
    if ((++_sp & 255u) == 0u) { if (xb_ld(&(bar)[XB_TMO])) break; if (_sp > XB_SPIN_CAP) { atomicAdd(&(bar)[XB_TMO], 1u); break; } } } } while (0)
struct XcdBarrier { unsigned* bar; unsigned x; volatile LAS unsigned* st; };
__device__ __forceinline__ XcdBarrier xcd_barrier_post(unsigned* bar, volatile LAS unsigned* st) {
    XcdBarrier b; b.bar = bar; b.x = xb_xcc_id(); b.st = st;
    if (threadIdx.x == 0) (void)xb_add(&bar[XB_XCNT(b.x)], 1u);
    return b;
}
__device__ __forceinline__ void xcd_barrier_complete(unsigned* bar, unsigned x, unsigned& nloc, unsigned& nx) {
    const unsigned G = gridDim.x * gridDim.y * gridDim.z;
    unsigned sum, cnt, mine, sp = 0u;
    for (;;) {
        sum = 0u; cnt = 0u; mine = 0u;
#pragma unroll
        for (unsigned j = 0; j < 16; ++j) { const unsigned c = xb_ld(&bar[XB_XCNT(j)]); sum += c; cnt += (c > 0u) ? 1u : 0u; mine = (j == x) ? c : mine; }
        if (sum == G) break;
        __builtin_amdgcn_s_sleep(1);
        if ((++sp & 255u) == 0u) { if (xb_ld(&bar[XB_TMO])) break; if (sp > XB_SPIN_CAP) { atomicAdd(&bar[XB_TMO], 1u); break; } }
    }
    nloc = mine > 0u ? mine : 1u; nx = cnt > 0u ? cnt : 1u;
}
__device__ __forceinline__ void xcd_barrier(const XcdBarrier& b) {
    asm volatile("s_waitcnt vmcnt(0)" ::: "memory");
    __syncthreads();
    if (threadIdx.x == 0) {
        unsigned* bar = b.bar;
        __builtin_amdgcn_s_waitcnt(0);
        unsigned nloc = b.st[0], nx = b.st[1];
        if (nloc == 0u) { xcd_barrier_complete(bar, b.x, nloc, nx); b.st[0] = nloc; b.st[1] = nx; }
        const unsigned old = xb_add(&bar[XB_XSUB(b.x)], 1u);
        const unsigned gen = old / nloc;
        if (old + 1u == (gen + 1u) * nloc) {
            __builtin_amdgcn_fence(__ATOMIC_RELEASE, "agent");
            asm volatile("s_waitcnt vmcnt(0)" ::: "memory");
            const unsigned og = xb_add(&bar[XB_TOP], 1u);
            const unsigned tg = og / nx;
            if (og + 1u == (tg + 1u) * nx) xb_add(&bar[XB_TOPGEN], 1u);
            else XB_SPIN(xb_ld(&bar[XB_TOPGEN]) == tg, bar);
            __builtin_amdgcn_fence(__ATOMIC_ACQUIRE, "agent");
            xb_add(&bar[XB_XGEN(b.x)], 1u);
            asm volatile("s_waitcnt vmcnt(0)" ::: "memory");
        } else {
            XB_SPIN(xb_ld(&bar[XB_XGEN(b.x)]) == gen, bar);
            __builtin_amdgcn_fence(__ATOMIC_ACQUIRE, "agent");
            asm volatile("s_waitcnt vmcnt(0)" ::: "memory");
        }
    }
    __syncthreads();
}
constexpr size_t WS_XBAR = 4096;

template <int S> __device__ __forceinline__ void run_all(const P& p, unsigned char* lds, const XcdBarrier& xb) {
    run_stage(p, S, lds);
    if constexpr (S == REP_STAGE) { xcd_barrier(xb); run_stage(p, S, lds); }
    if constexpr (S + 1 < N_STAGES) {
        if constexpr (S == 0) cg::this_grid().sync();
        else xcd_barrier(xb);
        run_all<S + 1>(p, lds, xb);
    }
}
__global__ void __launch_bounds__(NT, 2) mega(P p) {
    __shared__ __attribute__((aligned(16))) unsigned char lds[LDS_TOTAL + 16];
    volatile LAS unsigned* st = (volatile LAS unsigned*)(lds + LDS_TOTAL);
    if (threadIdx.x == 0) { st[0] = 0u; st[1] = 0u; }
    __syncthreads();
    const XcdBarrier xb = xcd_barrier_post((unsigned*)(p.ws + WS_CTL + WS_XBAR), st);
    run_all<0>(p, lds, xb);
}

extern "C" void kernel_launch(void* const* d_in, const int* in_sizes, int n_in, void* d_out, int out_size, void* d_ws, size_t ws_size, hipStream_t stream) {
    if (n_in != N_IN || ws_size < WS_END) { fprintf(stderr, "kernel_launch: unexpected n_in %d or ws_size %zu (< %zu)\n", n_in, ws_size, (size_t)WS_END); return; }
    P p{};
    for (int i = 0; i < N_IN; ++i) p.in[i] = (const float*)d_in[i];
    p.out = (float*)d_out; p.ws = (unsigned char*)d_ws;
    static int grid_blocks = 0;
    if (!grid_blocks) {
        int dev = 0, cus = 0, per_cu = 0;
        hipGetDevice(&dev);
        hipDeviceGetAttribute(&cus, hipDeviceAttributeMultiprocessorCount, dev);
        hipOccupancyMaxActiveBlocksPerMultiprocessor(&per_cu, (const void*)mega, NT, 0);
        if (per_cu < 1) per_cu = 1;
        if (per_cu > 2) per_cu = 2;
        grid_blocks = cus * per_cu;
    }
    hipMemsetAsync((char*)d_ws + WS_CTL, 0, 65536, stream);
    void* args[] = {&p};
    hipError_t e = hipLaunchCooperativeKernel((const void*)mega, dim3(grid_blocks), dim3(NT), args, 0, stream);
    if (e != hipSuccess) fprintf(stderr, "cooperative launch failed: %s (grid %d)\n", hipGetErrorString(e), grid_blocks);
}
```

```cpp
#include <hip/hip_runtime.h>
#include <hip/hip_cooperative_groups.h>
#include <cstdio>
#include <cstdint>
namespace cg = cooperative_groups;
#define LAS __attribute__((address_space(3)))
constexpr int ABL = 0;

__device__ __forceinline__ int tid_opaque() { int t = threadIdx.x; asm volatile("" : "+v"(t)); return t; }
__device__ __forceinline__ int bid_opaque() { int b = blockIdx.x; asm volatile("" : "+s"(b)); return b; }
__device__ __forceinline__ int xcd_first(int total, int& end, int& step) {
    const int nb = gridDim.x; int b = blockIdx.x; asm volatile("" : "+s"(b));
    if (nb & 7) { end = total; step = nb; return b; }
    const int x = b & 7, j = b >> 3, per = (total + 7) >> 3, lo = x * per;
    end = lo + per < total ? lo + per : total; step = nb >> 3; return lo + j;
}
#define TIDX tid_opaque()
#define BIDX bid_opaque()

constexpr int D = 1024, NB = 8, L = 2048, LC = 256;
constexpr int TL = NB * L, TC = NB * LC, TA = TL + TC;
constexpr int DIN = 1792, DCONV = 256, DSSM = 256, DATT = 512;
constexpr int NQH = 8, NKVH = 2, HD = 64;
constexpr int COL_U = 768, COL_Q = 1024, COL_K = 1536, COL_V = 1664;
constexpr int NE = 32, TOPK = 4, DE = 128;
constexpr int SG = 16, SH = 16, SP = 64;
constexpr int NT = 256;

enum { I_X = 0, I_C, I_CTX, I_CCTX, I_WMOD, I_BMOD, I_N1G, I_N2G, I_WIN, I_CONVW, I_LRE, I_LIM, I_LDT, I_BRE, I_BIM, I_CRE, I_CIM,
       I_SD, I_WGLU, I_BGLU, I_QG, I_KG, I_SINK, I_WOUT, I_RW, I_RB, I_WEG, I_WEU, I_WED, I_WSG, I_WSU, I_WSD, N_IN };

typedef unsigned short bf16_t;
constexpr size_t WS_CTL = 0;
constexpr size_t WS_MOD = 65536;
constexpr size_t WS_ZERO_END = WS_MOD + (size_t)2 * 9 * 6 * D * 4;
constexpr size_t WS_RBIAS = 524288;
constexpr size_t WS_ROPE = WS_RBIAS + 4096;
constexpr size_t WS_KJ = WS_ROPE + 524288;
constexpr size_t WS_GS2 = WS_KJ + 2097152;
constexpr size_t WS_POW = WS_GS2 + 131072;
constexpr size_t WS_FB = WS_POW + (size_t)2 * 2 * 16 * 33 * 64 * 8;
constexpr size_t WS_R1 = WS_FB + (size_t)2 * 2 * 16 * 64 * 16 * 8;
constexpr size_t WS_BUFA = WS_R1;
constexpr size_t WS_PC = WS_BUFA + (size_t)TA * D * 2;
constexpr size_t WS_UA = WS_PC + (size_t)TA * 768 * 2;
constexpr size_t WS_E = WS_UA + (size_t)16 * 640 * 768 * 2;
constexpr size_t WS_G = WS_E + (size_t)16 * 640 * 256 * 4;
constexpr size_t WS_QB = WS_G + (size_t)TA * DSSM * 2;
constexpr size_t WS_KB = WS_QB + (size_t)TA * DATT * 2;
constexpr size_t WS_VT = WS_KB + (size_t)TA * 128 * 2;
constexpr size_t WS_SLAB = WS_R1;
constexpr size_t WS_HID = WS_SLAB + (size_t)TA * 4 * D * 2;
constexpr size_t WS_HC1 = WS_HID + (size_t)TA * 5 * DE * 2;
constexpr size_t WS_HCMID = WS_HC1 + (size_t)TC * D * 4;
constexpr size_t WS_LCODE = WS_HCMID + (size_t)TC * D * 4;
constexpr size_t WS_LW = WS_LCODE + (size_t)NE * TA * 4;
constexpr size_t WS_WTIN = WS_LW + (size_t)NE * TA * 4;
constexpr size_t WS_WTOUT = WS_WTIN + (size_t)DIN * D * 2;
constexpr size_t WS_WTGLU = WS_WTOUT + (size_t)D * D * 2;
constexpr size_t WS_WGU = WS_WTGLU + (size_t)DSSM * DSSM * 2;
constexpr size_t WS_WD = WS_WGU + (size_t)33 * 256 * D * 2;
constexpr size_t WS_WST = WS_WD + (size_t)33 * D * DE * 2;
constexpr size_t WS_KW = WS_WST + (size_t)16 * 256 * 512 * 2;
constexpr size_t WS_END = WS_KW + (size_t)16 * 512 * 768 * 2;
static_assert(WS_VT + (size_t)TA * 128 * 2 <= WS_HID, "overlay");
static_assert(WS_ZERO_END <= WS_RBIAS, "zero region");
static_assert(WS_END <= 268435456, "workspace too large");

struct P {
    const float* in[N_IN];
    float* out;
    unsigned char* ws;
};

__device__ __forceinline__ bf16_t f2bf(float f) { unsigned u = __float_as_uint(f); u += 0x7FFFu + ((u >> 16) & 1u); return (bf16_t)(u >> 16); }
__device__ __forceinline__ float bf2f(bf16_t b) { return __uint_as_float((unsigned)b << 16); }
__device__ __forceinline__ unsigned cvt_pk_bf16(float lo, float hi) { unsigned r; asm("v_cvt_pk_bf16_f32 %0, %1, %2" : "=v"(r) : "v"(lo), "v"(hi)); return r; }
typedef __attribute__((ext_vector_type(4))) float f32x4;
typedef __attribute__((ext_vector_type(4))) unsigned u32x4;
struct BfPtr { const bf16_t* p; __device__ __forceinline__ float operator[](long i) const { return bf2f(p[i]); }
               __device__ __forceinline__ BfPtr operator+(long o) const { return BfPtr{p + o}; } };
__device__ __forceinline__ float silu_f(float x) { return x / (1.f + expf(-x)); }
__device__ __forceinline__ float sigmoid_f(float x) { return 1.f / (1.f + expf(-x)); }
__device__ __forceinline__ float gelu_f(float x) { return 0.5f * x * (1.f + tanhf(0.7978845608028654f * (x + 0.044715f * x * x * x))); }
__device__ __forceinline__ float wave_sum(float v) {
#pragma unroll
    for (int o = 32; o > 0; o >>= 1) v += __shfl_xor(v, o);
    return v;
}
__device__ __forceinline__ int row_bb(int r) { return r < TL ? r / L : 8; }
__device__ __forceinline__ const float* h_row(const P& p, int l, int r) {
    if (r < TL) return (l == 0 ? p.in[I_X] : p.out) + (size_t)r * D;
    return (l == 0 ? p.in[I_CTX] : (const float*)(p.ws + WS_HC1)) + (size_t)(r - TL) * D;
}
__device__ __forceinline__ float* hmid_row(const P& p, int r) {
    if (r < TL) return p.out + (size_t)r * D;
    return (float*)(p.ws + WS_HCMID) + (size_t)(r - TL) * D;
}
__device__ __forceinline__ const float* mod_vec(const P& p, int l, int bb, int chunk) {
    return (const float*)(p.ws + WS_MOD) + ((size_t)(l * 9 + bb) * 6 + chunk) * D;
}

__device__ __forceinline__ void st_mod(const P& p, float* lds) {
    float* red = lds + 9 * D;
    for (int i = TIDX; i < 9 * D; i += NT) {
        const int bb = i / D, k = i % D;
        const float c = bb < 8 ? p.in[I_C][bb * D + k] : p.in[I_CCTX][k];
        lds[i] = silu_f(c);
    }
    __syncthreads();
    float* mod = (float*)(p.ws + WS_MOD);
    const int col = TIDX & 31, ks = TIDX >> 5;
    for (int item = BIDX; item < 2 * 6 * D / 32; item += gridDim.x) {
        const int l = item / (6 * D / 32), j = (item % (6 * D / 32)) * 32 + col;
        const float* w = p.in[I_WMOD] + (size_t)l * D * 6 * D + j;
        float acc[9];
#pragma unroll
        for (int bb = 0; bb < 9; ++bb) acc[bb] = 0.f;
        for (int k = ks * 128; k < ks * 128 + 128; ++k) {
            const float wv = w[(size_t)k * 6 * D];
#pragma unroll
            for (int bb = 0; bb < 9; ++bb) acc[bb] += lds[bb * D + k] * wv;
        }
#pragma unroll
        for (int bb = 0; bb < 9; ++bb) red[(bb * 8 + ks) * 32 + col] = acc[bb];
        __syncthreads();
        for (int o = TIDX; o < 9 * 32; o += NT) {
            const int bb = o >> 5, c2 = o & 31;
            float sum = p.in[I_BMOD][l * 6 * D + (item % (6 * D / 32)) * 32 + c2];
#pragma unroll
            for (int q = 0; q < 8; ++q) sum += red[(bb * 8 + q) * 32 + c2];
            mod[(size_t)(l * 9 + bb) * 6 * D + (item % (6 * D / 32)) * 32 + c2] = sum;
        }
        __syncthreads();
    }
}

__device__ __forceinline__ void st_norm(const P& p, int l, int which) {
    const int lane = TIDX & 63, wv = TIDX >> 6;
    const int nrows = (which == 1 && l == 1) ? TL : TA;
    float* xn = (float*)(p.ws + WS_BUFA);
    const float* g = p.in[which == 0 ? I_N1G : I_N2G] + l * D;
    for (int r = BIDX * 4 + wv; r < nrows; r += gridDim.x * 4) {
        const float* src = which == 0 ? h_row(p, l, r) : hmid_row(p, r);
        const int bb = row_bb(r);
        const float* sh = mod_vec(p, l, bb, which == 0 ? 0 : 3);
        const float* sc = mod_vec(p, l, bb, which == 0 ? 1 : 4);
        float4 v[4];
        float s = 0.f;
#pragma unroll
        for (int j = 0; j < 4; ++j) { v[j] = *(const float4*)(src + j * 256 + lane * 4); s += v[j].x * v[j].x + v[j].y * v[j].y + v[j].z * v[j].z + v[j].w * v[j].w; }
        s = wave_sum(s);
        const float rinv = rsqrtf(s * (1.f / D) + 1e-6f);
#pragma unroll
        for (int j = 0; j < 4; ++j) {
            const int k = j * 256 + lane * 4;
            const float4 gg = *(const float4*)(g + k), s1 = *(const float4*)(sc + k), s0 = *(const float4*)(sh + k);
            float4 o;
            o.x = v[j].x * rinv * gg.x * (1.f + s1.x) + s0.x;
            o.y = v[j].y * rinv * gg.y * (1.f + s1.y) + s0.y;
            o.z = v[j].z * rinv * gg.z * (1.f + s1.z) + s0.z;
            o.w = v[j].w * rinv * gg.w * (1.f + s1.w) + s0.w;
            if (which == 1) *(float4*)(xn + (size_t)r * D + k) = o;
            else { uint2 pk; pk.x = (unsigned)f2bf(o.x) | ((unsigned)f2bf(o.y) << 16); pk.y = (unsigned)f2bf(o.z) | ((unsigned)f2bf(o.w) << 16);
                   *(uint2*)((bf16_t*)(p.ws + WS_BUFA) + (size_t)r * D + k) = pk; }
        }
    }
}


__device__ __forceinline__ void bf8_to_f(const u32x4& v, float (&f)[8]) {
#pragma unroll
    for (int q = 0; q < 4; ++q) { f[2 * q] = __uint_as_float(v[q] << 16); f[2 * q + 1] = __uint_as_float(v[q] & 0xffff0000u); }
}
__device__ __forceinline__ void st_conv(const P& p, int l) {
    const bf16_t* pb = (const bf16_t*)(p.ws + WS_PC);
    bf16_t* mix = (bf16_t*)(p.ws + WS_BUFA);
    const float* cw = p.in[I_CONVW] + l * 3 * DCONV;
    const int nrows = l == 0 ? TA : TL;
    for (int idx = BIDX * NT + TIDX; idx < nrows * 32; idx += gridDim.x * NT) {
        const int r = idx >> 5, ch = (idx & 31) * 8;
        int t, len;
        if (r < TL) { t = r & (L - 1); len = L; } else { t = (r - TL) & (LC - 1); len = LC; }
        const bf16_t* pr = pb + (size_t)r * 768 + ch;
        float x[8], c[8], bgate[8], y[8];
        bf8_to_f(*(const u32x4*)(pr), x); bf8_to_f(*(const u32x4*)(pr + 512), c); bf8_to_f(*(const u32x4*)(pr + 256), bgate);
        const f32x4 w1a = *(const f32x4*)(cw + DCONV + ch), w1b = *(const f32x4*)(cw + DCONV + ch + 4);
#pragma unroll
        for (int q = 0; q < 8; ++q) y[q] = (q < 4 ? w1a[q] : w1b[q - 4]) * (c[q] * x[q]);
        if (t > 0) {
            bf8_to_f(*(const u32x4*)(pr - 768), x); bf8_to_f(*(const u32x4*)(pr - 768 + 512), c);
            const f32x4 wa = *(const f32x4*)(cw + ch), wb = *(const f32x4*)(cw + ch + 4);
#pragma unroll
            for (int q = 0; q < 8; ++q) y[q] += (q < 4 ? wa[q] : wb[q - 4]) * (c[q] * x[q]);
        }
        if (t < len - 1) {
            bf8_to_f(*(const u32x4*)(pr + 768), x); bf8_to_f(*(const u32x4*)(pr + 768 + 512), c);
            const f32x4 wa = *(const f32x4*)(cw + 2 * DCONV + ch), wb = *(const f32x4*)(cw + 2 * DCONV + ch + 4);
#pragma unroll
            for (int q = 0; q < 8; ++q) y[q] += (q < 4 ? wa[q] : wb[q - 4]) * (c[q] * x[q]);
        }
        u32x4 o;
#pragma unroll
        for (int q = 0; q < 4; ++q) o[q] = cvt_pk_bf16(bgate[2 * q] * y[2 * q], bgate[2 * q + 1] * y[2 * q + 1]);
        *(u32x4*)(mix + (size_t)r * D + ch) = o;
    }
}

struct EpiOut { const float* modl; const float* hlat; const float* hctx; float* out; float* hcmid;
    __device__ __forceinline__ void operator()(int r, int c, float v0, float v1, float v2, float v3) const {
    const int bb = row_bb(r);
    const f32x4 g1 = *(const f32x4*)(modl + ((size_t)bb * 6 + 2) * D + c);
    const f32x4 hv = *(const f32x4*)((r < TL ? hlat + (size_t)r * D : hctx + (size_t)(r - TL) * D) + c);
    f32x4 o; o[0] = hv[0] + g1[0] * v0; o[1] = hv[1] + g1[1] * v1; o[2] = hv[2] + g1[2] * v2; o[3] = hv[3] + g1[3] * v3;
    *(f32x4*)((r < TL ? out + (size_t)r * D : hcmid + (size_t)(r - TL) * D) + c) = o; } };
__device__ __forceinline__ EpiOut make_epi_out(const P& p, int l) {
    return EpiOut{(const float*)(p.ws + WS_MOD) + (size_t)l * 9 * 6 * D, l == 0 ? p.in[I_X] : p.out, l == 0 ? p.in[I_CTX] : (const float*)(p.ws + WS_HC1), p.out, (float*)(p.ws + WS_HCMID)};
}

typedef __attribute__((ext_vector_type(8))) short bf16x8;
typedef __attribute__((ext_vector_type(16))) float f32x16;
constexpr int G_STAGEB = 16384;
constexpr int G_NSTG = 4;
constexpr int LDS_BYTES = G_NSTG * G_STAGEB;

template <class ARow>
__device__ __forceinline__ void gemm_tile(f32x16 (&acc)[2][2], ARow arow, const bf16_t* Bt, int ldb, int K, unsigned char* lds) {
    const int t = TIDX, lane = t & 63, w = __builtin_amdgcn_readfirstlane(t >> 6), wr = w >> 1, wc = w & 1, lr = lane & 31, lh = lane >> 5;
    const int srow = t >> 2, lc = (t & 3) ^ ((srow >> 2) & 3);
    const bf16_t* ap[2]; const bf16_t* bp[2];
#pragma unroll
    for (int i = 0; i < 2; ++i) { ap[i] = arow(srow + 64 * i) + lc * 8; bp[i] = Bt + (size_t)(srow + 64 * i) * ldb + lc * 8; }
    float zf = 0.f; asm volatile("" : "+v"(zf));
#pragma unroll
    for (int mi = 0; mi < 2; ++mi)
#pragma unroll
        for (int ni = 0; ni < 2; ++ni)
#pragma unroll
            for (int r = 0; r < 16; ++r) acc[mi][ni][r] = zf;
    const int nk = K >> 5;
    LAS unsigned char* l3 = (LAS unsigned char*)lds;
    const int f = (lr >> 2) & 3;
    const int aoff = (wr * 64 + lr) * 64 + ((lh ^ f) << 4), boff = 8192 + (wc * 64 + lr) * 64 + ((lh ^ f) << 4);
#define G_ISSUE(ks) do { LAS unsigned char* d_ = l3 + ((ks) & 3) * G_STAGEB + w * 1024; \
        __builtin_amdgcn_global_load_lds((const unsigned*)(ap[0] + (ks) * 32), (LAS unsigned*)(d_), 16, 0, 0); \
        __builtin_amdgcn_global_load_lds((const unsigned*)(ap[1] + (ks) * 32), (LAS unsigned*)(d_ + 4096), 16, 0, 0); \
        __builtin_amdgcn_global_load_lds((const unsigned*)(bp[0] + (ks) * 32), (LAS unsigned*)(d_ + 8192), 16, 0, 0); \
        __builtin_amdgcn_global_load_lds((const unsigned*)(bp[1] + (ks) * 32), (LAS unsigned*)(d_ + 12288), 16, 0, 0); } while (0)
#define G_RD(A0, A1, B0, B1, slot, s2) do { const LAS unsigned char* c_ = l3 + (slot) * G_STAGEB; \
        A0 = *(const LAS bf16x8*)(c_ + (aoff ^ ((s2) << 5))); A1 = *(const LAS bf16x8*)(c_ + ((aoff + 2048) ^ ((s2) << 5))); \
        B0 = *(const LAS bf16x8*)(c_ + (boff ^ ((s2) << 5))); B1 = *(const LAS bf16x8*)(c_ + ((boff + 2048) ^ ((s2) << 5))); } while (0)
#define G_MM(A0, A1, B0, B1) do { \
        acc[0][0] = __builtin_amdgcn_mfma_f32_32x32x16_bf16(B0, A0, acc[0][0], 0, 0, 0); acc[0][1] = __builtin_amdgcn_mfma_f32_32x32x16_bf16(B1, A0, acc[0][1], 0, 0, 0); \
        acc[1][0] = __builtin_amdgcn_mfma_f32_32x32x16_bf16(B0, A1, acc[1][0], 0, 0, 0); acc[1][1] = __builtin_amdgcn_mfma_f32_32x32x16_bf16(B1, A1, acc[1][1], 0, 0, 0); } while (0)
    __syncthreads();
    G_ISSUE(0);
    if (1 < nk) G_ISSUE(1);
    if (2 < nk) G_ISSUE(2);
    if (2 < nk) asm volatile("s_waitcnt vmcnt(8)" ::: "memory"); else if (1 < nk) asm volatile("s_waitcnt vmcnt(4)" ::: "memory"); else asm volatile("s_waitcnt vmcnt(0)" ::: "memory");
    __builtin_amdgcn_s_barrier();
    if (3 < nk) G_ISSUE(3);
    bf16x8 fa0, fa1, fb0, fb1, ga0, ga1, gb0, gb1;
    G_RD(fa0, fa1, fb0, fb1, 0, 0);
    for (int ks = 0; ks < nk; ++ks) {
        G_RD(ga0, ga1, gb0, gb1, ks & 3, 1);
        __builtin_amdgcn_sched_barrier(0);
        asm volatile("s_waitcnt lgkmcnt(4)" ::: "memory");
        __builtin_amdgcn_sched_barrier(0);
        G_MM(fa0, fa1, fb0, fb1);
        __builtin_amdgcn_sched_barrier(0);
        if (ks + 1 < nk) {
            if (ks + 3 < nk) asm volatile("s_waitcnt vmcnt(8) lgkmcnt(0)" ::: "memory");
            else if (ks + 2 < nk) asm volatile("s_waitcnt vmcnt(4) lgkmcnt(0)" ::: "memory");
            else asm volatile("s_waitcnt vmcnt(0) lgkmcnt(0)" ::: "memory");
            __builtin_amdgcn_s_barrier();
            if (ks + 4 < nk) G_ISSUE(ks + 4);
            G_RD(fa0, fa1, fb0, fb1, (ks + 1) & 3, 0);
        } else {
            asm volatile("s_waitcnt lgkmcnt(0)" ::: "memory");
        }
        __builtin_amdgcn_sched_barrier(0);
        G_MM(ga0, ga1, gb0, gb1);
        __builtin_amdgcn_sched_barrier(0);
    }
#undef G_RD
#undef G_MM
#undef G_ISSUE
}
template <class F>
__device__ __forceinline__ void acc_foreach4(const f32x16 (&acc)[2][2], F f) {
    const int lane = TIDX & 63, w = (TIDX >> 6) & 3, wr = w >> 1, wc = w & 1, lr = lane & 31, lh = lane >> 5;
#pragma unroll
    for (int mi = 0; mi < 2; ++mi)
#pragma unroll
        for (int ni = 0; ni < 2; ++ni)
#pragma unroll
            for (int g = 0; g < 4; ++g)
                f(wr * 64 + mi * 32 + lr, wc * 64 + ni * 32 + 8 * g + 4 * lh, acc[mi][ni][4 * g], acc[mi][ni][4 * g + 1], acc[mi][ni][4 * g + 2], acc[mi][ni][4 * g + 3]);
}
constexpr int C_LD = 132;
template <class F>
__device__ __forceinline__ void acc_foreach4_lds(const f32x16 (&acc)[2][2], unsigned char* lds, F f) {
    float* C = (float*)lds;
    const int t = TIDX, lane = t & 63, w = (t >> 6) & 3, wr = w >> 1, wc = w & 1, lr = lane & 31, lh = lane >> 5;
    __syncthreads();
#pragma unroll
    for (int mi = 0; mi < 2; ++mi)
#pragma unroll
        for (int ni = 0; ni < 2; ++ni)
#pragma unroll
            for (int g = 0; g < 4; ++g) {
                f32x4 v; v[0] = acc[mi][ni][4 * g]; v[1] = acc[mi][ni][4 * g + 1]; v[2] = acc[mi][ni][4 * g + 2]; v[3] = acc[mi][ni][4 * g + 3];
                *(f32x4*)(C + (wr * 64 + mi * 32 + lr) * C_LD + wc * 64 + ni * 32 + 8 * g + 4 * lh) = v;
            }
    __syncthreads();
#pragma unroll 4
    for (int i = 0; i < 16; ++i) {
        const int idx = t + 256 * i, r = idx >> 5, c = (idx & 31) * 4;
        const f32x4 v = *(const f32x4*)(C + r * C_LD + c);
        f(r, c, v[0], v[1], v[2], v[3]);
    }
}
__device__ __forceinline__ uint2 pack4(float a, float b, float c, float d) { uint2 o; o.x = cvt_pk_bf16(a, b); o.y = cvt_pk_bf16(c, d); return o; }
struct ARowPlain { const bf16_t* A; int lda; __device__ __forceinline__ const bf16_t* operator()(int m) const { return A + (size_t)m * lda; } };

template <class Epi>
__device__ __forceinline__ void gemm_stage(const bf16_t* A, int lda, const bf16_t* Bt, int ldb, int M, int N, int K, Epi epi, unsigned char* lds) {
    const int tn = N / 128, tm = M / 128;
    int t_end, t_step;
    for (int tile = xcd_first(tm * tn, t_end, t_step); tile < t_end; tile += t_step) {
        const int m0 = (tile / tn) * 128, n0 = (tile % tn) * 128;
        f32x16 acc[2][2];
        gemm_tile(acc, ARowPlain{A + (size_t)m0 * lda, lda}, Bt + (size_t)n0 * ldb, ldb, K, lds);
        acc_foreach4_lds(acc, lds, [&](int r, int c, float v0, float v1, float v2, float v3) { epi(m0 + r, n0 + c, v0, v1, v2, v3); });
    }
}
__device__ __forceinline__ void tr_item(const float* src, size_t sk, bf16_t* dst, size_t dld, bf16_t* tl) {
    const int t = TIDX, kr = t >> 3, nq = (t & 7) * 4;
    __syncthreads();
#pragma unroll
    for (int ps = 0; ps < 4; ++ps) {
        const f32x4 v = *(const f32x4*)(src + (size_t)(kr + 32 * ps) * sk + nq);
#pragma unroll
        for (int j = 0; j < 4; ++j) tl[(nq + j) * 136 + kr + 32 * ps] = f2bf(v[j]);
    }
    __syncthreads();
    const int n = t >> 3, part = t & 7;
    const u32x4 a = *(const u32x4*)(tl + n * 136 + part * 16), b = *(const u32x4*)(tl + n * 136 + part * 16 + 8);
    bf16_t* o = dst + (size_t)n * dld + part * 16;
    *(u32x4*)o = a; *(u32x4*)(o + 8) = b;
}
__device__ __forceinline__ void st_prep_weights(const P& p, int l, unsigned char* lds) {
    bf16_t* tl = (bf16_t*)lds;
    constexpr int N_IN_ = (DIN / 32) * 8, N_OUT = (D / 32) * 8, N_GLU = (DSSM / 32) * 2, N_GU = 33 * 2 * 4 * 8, N_DN = 33 * (D / 32);
    constexpr int TOT = N_IN_ + N_OUT + N_GLU + N_GU + N_DN;
    for (int it = BIDX; it < TOT; it += gridDim.x) {
        int r = it;
        if (r < N_IN_) { const int nt = r >> 3, kt = r & 7; tr_item(p.in[I_WIN] + (size_t)l * D * DIN + (size_t)kt * 128 * DIN + nt * 32, DIN, (bf16_t*)(p.ws + WS_WTIN) + (size_t)nt * 32 * D + kt * 128, D, tl); continue; }
        r -= N_IN_;
        if (r < N_OUT) { const int nt = r >> 3, kt = r & 7; tr_item(p.in[I_WOUT] + (size_t)l * D * D + (size_t)kt * 128 * D + nt * 32, D, (bf16_t*)(p.ws + WS_WTOUT) + (size_t)nt * 32 * D + kt * 128, D, tl); continue; }
        r -= N_OUT;
        if (r < N_GLU) { const int nt = r >> 1, kt = r & 1; tr_item(p.in[I_WGLU] + (size_t)l * DSSM * DSSM + (size_t)kt * 128 * DSSM + nt * 32, DSSM, (bf16_t*)(p.ws + WS_WTGLU) + (size_t)nt * 32 * DSSM + kt * 128, DSSM, tl); continue; }
        r -= N_GLU;
        if (r < N_GU) {
            const int kt = r & 7, q = (r >> 3) & 3, j = (r >> 5) & 1, e = r >> 6;
            const int wc = q >> 1, ni = q & 1, unit0 = j * 64 + wc * 32;
            const float* sp; size_t sk;
            if (e < NE) { sp = p.in[ni ? I_WEU : I_WEG] + ((size_t)(l * D + kt * 128) * NE + e) * DE + unit0; sk = (size_t)NE * DE; }
            else { sp = p.in[ni ? I_WSU : I_WSG] + (size_t)(l * D + kt * 128) * DE + unit0; sk = DE; }
            tr_item(sp, sk, (bf16_t*)(p.ws + WS_WGU) + ((size_t)(e * 2 + j) * 128 + q * 32) * D + kt * 128, D, tl); continue;
        }
        r -= N_GU;
        {
            const int nt = r & 31, e = r >> 5;
            const float* sp = (e < NE ? p.in[I_WED] + (size_t)(l * NE + e) * DE * D : p.in[I_WSD] + (size_t)l * DE * D) + nt * 32;
            tr_item(sp, D, (bf16_t*)(p.ws + WS_WD) + ((size_t)e * D + nt * 32) * DE, DE, tl);
        }
    }
    __syncthreads();
}
struct EpiStoreBf { bf16_t* C; int ldc; __device__ __forceinline__ void operator()(int r, int c, float v0, float v1, float v2, float v3) const { *(uint2*)(C + (size_t)r * ldc + c) = pack4(v0, v1, v2, v3); } };


__device__ __forceinline__ void st_rbias(const P& p, int l, float* lds) {
    const int lane = TIDX & 63, w = TIDX >> 6;
    const float* rw = p.in[I_RW] + (size_t)l * D * NE;
    for (int o = BIDX * 4 + w; o < 9 * 32; o += gridDim.x * 4) {
        const int bb = o >> 5, e = o & 31;
        const float* sh2 = mod_vec(p, l, bb, 3);
        float a = 0.f;
#pragma unroll
        for (int j = 0; j < 16; ++j) { const int k = j * 64 + lane; a += sh2[k] * rw[(size_t)k * NE + e]; }
        a = wave_sum(a);
        if (lane == 0) ((float*)(p.ws + WS_RBIAS))[(l * 9 + bb) * 32 + e] = a;
    }
    const float* g2 = p.in[I_N2G] + l * D;
    for (int idx = BIDX * NT + TIDX; idx < 9 * D; idx += gridDim.x * NT) {
        const int bb = idx >> 10, k = idx & (D - 1);
        ((float*)(p.ws + WS_GS2))[(size_t)(l * 9 + bb) * D + k] = g2[k] * (1.f + mod_vec(p, l, bb, 4)[k]);
    }
}
template <bool DRY = false>
__device__ __forceinline__ void st_router2(const P& p, int l, unsigned char* ldsb) {
    float* part = (float*)ldsb;
    float* ssq = part + 4 * 32 * 33;
    float* sc = ssq + 128;
    float* rinvs = sc + 32 * 33;
    const int t = TIDX, lane = t & 63, w = t >> 6, i = lane & 31, hf = lane >> 5;
    const int nrows = l == 0 ? TA : TL;
    const float* rw = p.in[I_RW] + (size_t)l * D * NE;
    int* cnt = (int*)(p.ws + WS_CTL) + l * NE;
    int* lcode = (int*)(p.ws + WS_LCODE);
    float* lw = (float*)(p.ws + WS_LW);
    bf16_t* xn2 = (bf16_t*)(p.ws + WS_BUFA);
    for (int item = BIDX; item < nrows / 32; item += gridDim.x) {
        const int r0 = item * 32, bb = row_bb(r0);
        const float* gs2 = (const float*)(p.ws + WS_GS2) + (size_t)(l * 9 + bb) * D;
        const float* sh2 = mod_vec(p, l, bb, 3);
        const int kb = w * 256 + hf * 128;
        const float* src = hmid_row(p, r0 + i) + kb;
        const float* gsp = gs2 + kb;
        const float* rwp = rw + (size_t)kb * NE + i;
        f32x16 acc;
        float zf = 0.f; asm volatile("" : "+v"(zf));
#pragma unroll
        for (int r = 0; r < 16; ++r) acc[r] = zf;
        float ss = 0.f;
        f32x4 xa[4], ga[4], xb[4], gb[4]; float wa[16], wb[16];
#define R_LOAD(X, G, W, cb) do { _Pragma("unroll") for (int q = 0; q < 4; ++q) { const int k = ((cb) * 4 + q) * 4; X[q] = *(const f32x4*)(src + k); G[q] = *(const f32x4*)(gsp + k); \
            _Pragma("unroll") for (int j = 0; j < 4; ++j) W[q * 4 + j] = rwp[(size_t)(k + j) * NE]; } } while (0)
#define R_COMP(X, G, W) do { _Pragma("unroll") for (int q = 0; q < 4; ++q) { ss += X[q][0] * X[q][0] + X[q][1] * X[q][1] + X[q][2] * X[q][2] + X[q][3] * X[q][3]; \
            _Pragma("unroll") for (int j = 0; j < 4; ++j) acc = __builtin_amdgcn_mfma_f32_32x32x2f32(X[q][j] * G[q][j], W[q * 4 + j], acc, 0, 0, 0); } } while (0)
        R_LOAD(xa, ga, wa, 0);
#pragma unroll 1
        for (int cb = 0; cb < 8; cb += 2) {
            R_LOAD(xb, gb, wb, cb + 1);
            R_COMP(xa, ga, wa);
            if (cb + 2 < 8) R_LOAD(xa, ga, wa, cb + 2);
            R_COMP(xb, gb, wb);
        }
#undef R_LOAD
#undef R_COMP
        ss += __shfl_xor(ss, 32);
        __syncthreads();
        if (hf == 0) ssq[w * 32 + i] = ss;
#pragma unroll
        for (int r = 0; r < 16; ++r) part[(w * 32 + (r & 3) + 8 * (r >> 2) + 4 * hf) * 33 + i] = acc[r];
        __syncthreads();
        for (int idx = t; idx < 1024; idx += NT) {
            const int row = idx >> 5, e = idx & 31;
            const float logit = part[(0 * 32 + row) * 33 + e] + part[(1 * 32 + row) * 33 + e] + part[(2 * 32 + row) * 33 + e] + part[(3 * 32 + row) * 33 + e];
            const float rinv = rsqrtf((ssq[row] + ssq[32 + row] + ssq[64 + row] + ssq[96 + row]) * (1.f / D) + 1e-6f);
            sc[row * 33 + e] = sigmoid_f(rinv * logit + ((const float*)(p.ws + WS_RBIAS))[(l * 9 + bb) * 32 + e]);
            if (e == 0) rinvs[row] = rinv;
        }
        __syncthreads();
        if (t < 32) {
            const int r = r0 + t;
            float sel[32];
#pragma unroll
            for (int e = 0; e < 32; ++e) sel[e] = sc[t * 33 + e] + p.in[I_RB][l * NE + e];
            int bi[4]; float sv[4]; float sum = 0.f;
#pragma unroll
            for (int k = 0; k < 4; ++k) {
                float best = -1e30f; int b = 0;
#pragma unroll
                for (int e = 0; e < 32; ++e) if (sel[e] > best) { best = sel[e]; b = e; }
#pragma unroll
                for (int e = 0; e < 32; ++e) if (e == b) sel[e] = -1e30f;
                bi[k] = b; sv[k] = sc[t * 33 + b]; sum += sv[k];
            }
#pragma unroll
            for (int k = 0; k < 4; ++k) {
                if (DRY) { if (sv[k] / sum == 12345.f) lw[0] = 0.f; } else {
                const int pos = atomicAdd(&cnt[bi[k]], 1);
                lcode[(size_t)bi[k] * TA + pos] = r * 4 + k;
                lw[(size_t)bi[k] * TA + pos] = sv[k] / sum * 2.5f; }
            }
        }
        {
            float gs[16], sh[16];
#pragma unroll
            for (int q = 0; q < 16; ++q) { const int k = (q >> 3) * 512 + 8 * lane + (q & 7); gs[q] = gs2[k]; sh[q] = sh2[k]; }
            for (int rr8 = 0; rr8 < 8; ++rr8) {
                const int rho = w * 8 + rr8;
                const float rr = rinvs[rho];
                const float* s2 = hmid_row(p, r0 + rho);
                bf16_t* dst = xn2 + (size_t)(r0 + rho) * D;
#pragma unroll
                for (int h2 = 0; h2 < 2; ++h2) {
                    const f32x4 x0 = *(const f32x4*)(s2 + h2 * 512 + 8 * lane), x1 = *(const f32x4*)(s2 + h2 * 512 + 8 * lane + 4);
                    u32x4 o;
                    o[0] = cvt_pk_bf16(x0[0] * rr * gs[h2 * 8 + 0] + sh[h2 * 8 + 0], x0[1] * rr * gs[h2 * 8 + 1] + sh[h2 * 8 + 1]);
                    o[1] = cvt_pk_bf16(x0[2] * rr * gs[h2 * 8 + 2] + sh[h2 * 8 + 2], x0[3] * rr * gs[h2 * 8 + 3] + sh[h2 * 8 + 3]);
                    o[2] = cvt_pk_bf16(x1[0] * rr * gs[h2 * 8 + 4] + sh[h2 * 8 + 4], x1[1] * rr * gs[h2 * 8 + 5] + sh[h2 * 8 + 5]);
                    o[3] = cvt_pk_bf16(x1[2] * rr * gs[h2 * 8 + 6] + sh[h2 * 8 + 6], x1[3] * rr * gs[h2 * 8 + 7] + sh[h2 * 8 + 7]);
                    *(u32x4*)(dst + h2 * 512 + 8 * lane) = o;
                }
            }
        }
    }
    __syncthreads();
}

constexpr int LDS_CSTAGE = 128 * C_LD * 4;
constexpr int MOE_LDS_LIST = LDS_CSTAGE;
constexpr int LDS_MOE = LDS_CSTAGE + 128 * 4 + 128 * 4 + 64 * 4;
constexpr int LDS_MODB = (9 * D + 9 * 8 * 32) * 4;
constexpr int LDS_TOTAL = LDS_MOE > LDS_MODB ? LDS_MOE : LDS_MODB;
struct ARowCode { const bf16_t* base; const int* codes; int mode; __device__ __forceinline__ const bf16_t* operator()(int m) const {
    const int c = codes[m];
    if (mode == 0) return base + (size_t)(c < 0 ? 0 : (c >> 2)) * D;
    return base + (size_t)(c < 0 ? 0 : (c >> 2) * 5 + (c & 3)) * DE; } };
__device__ __forceinline__ void moe_tstart(const P& p, int l, int* ts) {
    if (TIDX == 0) { const int* cnt = (const int*)(p.ws + WS_CTL) + l * NE; int a = 0; for (int e = 0; e < NE; ++e) { ts[e] = a; a += (cnt[e] + 127) >> 7; } ts[NE] = a; }
    __syncthreads();
}
__device__ __forceinline__ void st_moe1(const P& p, int l, unsigned char* lds) {
    int* codes = (int*)(lds + MOE_LDS_LIST); float* wts = (float*)(codes + 128); int* ts = (int*)(wts + 128);
    const int nrows = l == 0 ? TA : TL;
    const int* cnt = (const int*)(p.ws + WS_CTL) + l * NE;
    const int* lcode = (const int*)(p.ws + WS_LCODE);
    const float* lw = (const float*)(p.ws + WS_LW);
    const bf16_t* xn2 = (const bf16_t*)(p.ws + WS_BUFA);
    bf16_t* hid = (bf16_t*)(p.ws + WS_HID);
    const bf16_t* wgu = (const bf16_t*)(p.ws + WS_WGU);
    moe_tstart(p, l, ts);
    const int nrt = ts[NE], nsh = nrows / 128, total = (nrt + nsh) * 2;
    const int lane = TIDX & 63, w = TIDX >> 6, wr = w >> 1, wc = w & 1, lr = lane & 31, lh = lane >> 5;
    int t_end, t_step;
    for (int tile = xcd_first(total, t_end, t_step); tile < t_end; tile += t_step) {
        const int rt = tile >> 1, j = tile & 1;
        int e, m0, valid;
        if (rt < nrt) { e = 0; while (ts[e + 1] <= rt) ++e; m0 = (rt - ts[e]) * 128; valid = cnt[e] - m0; if (valid > 128) valid = 128; }
        else { e = NE; m0 = (rt - nrt) * 128; valid = 128; }
        __syncthreads();
        if (TIDX < 128) {
            const int m = TIDX;
            if (e < NE) { const bool ok = m < valid; codes[m] = ok ? lcode[(size_t)e * TA + m0 + m] : -1; wts[m] = ok ? lw[(size_t)e * TA + m0 + m] : 0.f; }
            else { codes[m] = (m0 + m) * 4; wts[m] = 1.f; }
        }
        __syncthreads();
        f32x16 acc[2][2];
        gemm_tile(acc, ARowCode{xn2, codes, 0}, wgu + (size_t)((e * 2 + j) * 128) * D, D, D, lds);
#pragma unroll
        for (int mi = 0; mi < 2; ++mi) {
            const int m = wr * 64 + mi * 32 + lr;
            const int c = codes[m];
            if (c >= 0) {
                const float wt = wts[m];
                const size_t hrow = e < NE ? (size_t)(c >> 2) * 5 + (c & 3) : (size_t)(c >> 2) * 5 + 4;
#pragma unroll
                for (int g = 0; g < 4; ++g) {
                    float h[4];
#pragma unroll
                    for (int q = 0; q < 4; ++q) h[q] = silu_f(acc[mi][0][4 * g + q]) * acc[mi][1][4 * g + q] * wt;
                    *(uint2*)(hid + hrow * DE + j * 64 + wc * 32 + 8 * g + 4 * lh) = pack4(h[0], h[1], h[2], h[3]);
                }
            }
        }
    }
}
__device__ __forceinline__ void st_moe2(const P& p, int l, unsigned char* lds) {
    int* codes = (int*)(lds + MOE_LDS_LIST); float* wts = (float*)(codes + 128); int* ts = (int*)(wts + 128);
    const int* cnt = (const int*)(p.ws + WS_CTL) + l * NE;
    const int* lcode = (const int*)(p.ws + WS_LCODE);
    const bf16_t* hid = (const bf16_t*)(p.ws + WS_HID);
    bf16_t* slab = (bf16_t*)(p.ws + WS_SLAB);
    const bf16_t* wd = (const bf16_t*)(p.ws + WS_WD);
    moe_tstart(p, l, ts);
    const int nrt = ts[NE], total = nrt * 8;
    int t_end, t_step;
    for (int tile = xcd_first(total, t_end, t_step); tile < t_end; tile += t_step) {
        const int rt = tile >> 3, n0 = (tile & 7) * 128;
        int e = 0; while (ts[e + 1] <= rt) ++e;
        const int m0 = (rt - ts[e]) * 128; int valid = cnt[e] - m0; if (valid > 128) valid = 128;
        __syncthreads();
        if (TIDX < 128) { const int m = TIDX; codes[m] = m < valid ? lcode[(size_t)e * TA + m0 + m] : -1; }
        __syncthreads();
        f32x16 acc[2][2];
        gemm_tile(acc, ARowCode{hid, codes, 1}, wd + ((size_t)e * D + n0) * DE, DE, DE, lds);
        acc_foreach4_lds(acc, lds, [&](int r, int c, float v0, float v1, float v2, float v3) { const int code = codes[r]; if (code >= 0) *(uint2*)(slab + (size_t)code * D + n0 + c) = pack4(v0, v1, v2, v3); });
    }
}
struct EpiMoeF { const bf16_t* slab; const float* modl; float* out; const float* hcmid; float* hc1; bool outw = true;
    __device__ __forceinline__ void operator()(int r, int c, float v0, float v1, float v2, float v3) const {
    const bf16_t* sl = slab + (size_t)r * 4 * D + c;
    float v[4] = {v0, v1, v2, v3};
#pragma unroll
    for (int k = 0; k < 4; ++k) { const uint2 q = *(const uint2*)(sl + (size_t)k * D);
        v[0] += __uint_as_float(q.x << 16); v[1] += __uint_as_float(q.x & 0xffff0000u); v[2] += __uint_as_float(q.y << 16); v[3] += __uint_as_float(q.y & 0xffff0000u); }
    const f32x4 g2 = *(const f32x4*)(modl + ((size_t)row_bb(r) * 6 + 5) * D + c);
    const f32x4 hm = *(const f32x4*)((r < TL ? out + (size_t)r * D : hcmid + (size_t)(r - TL) * D) + c);
    f32x4 o; o[0] = hm[0] + g2[0] * v[0]; o[1] = hm[1] + g2[1] * v[1]; o[2] = hm[2] + g2[2] * v[2]; o[3] = hm[3] + g2[3] * v[3];
    if (outw) *(f32x4*)((r < TL ? out + (size_t)r * D : hc1 + (size_t)(r - TL) * D) + c) = o;
    else if (o[0] == 12345.f) *(f32x4*)(hc1) = o; } };
__device__ __forceinline__ EpiMoeF make_epi_moef(const P& p, int l) {
    return EpiMoeF{(const bf16_t*)(p.ws + WS_SLAB), (const float*)(p.ws + WS_MOD) + (size_t)l * 9 * 6 * D, p.out, (const float*)(p.ws + WS_HCMID), (float*)(p.ws + WS_HC1)};
}
struct SsmPar { float lre, lim, dt; };
__device__ __forceinline__ SsmPar ssm_par(const P& p, int l, int dir, int g, int pp) {
    const int pi = ((l * 2 + dir) * SG + g) * SP + pp;
    SsmPar r; r.lre = p.in[I_LRE][pi]; r.lim = p.in[I_LIM][pi]; r.dt = expf(p.in[I_LDT][(l * 2 + dir) * SG + g]); return r;
}
__device__ __forceinline__ float2 ssm_pow(const SsmPar& q, float e) {
    const float mag = expf(e * q.lre * q.dt), ang = e * (q.lim * q.dt);
    return make_float2(mag * cosf(ang), mag * sinf(ang));
}
__device__ __forceinline__ float2 ssm_f(const SsmPar& q) {
    const float2 lb = ssm_pow(q, 1.f);
    const float nr = lb.x - 1.f, ni = lb.y, den = q.lre * q.lre + q.lim * q.lim;
    return make_float2((nr * q.lre + ni * q.lim) / den, (ni * q.lre - nr * q.lim) / den);
}
__device__ __forceinline__ float2 cmul(float2 a, float2 b) { return make_float2(a.x * b.x - a.y * b.y, a.x * b.y + a.y * b.x); }
__device__ __forceinline__ void st_ssm_tables(const P& p) {
    float2* pw = (float2*)(p.ws + WS_POW); float2* fb = (float2*)(p.ws + WS_FB);
    for (int idx = BIDX * NT + TIDX; idx < 2 * 2 * 16 * 33 * 64; idx += gridDim.x * NT) {
        const int pp = idx & 63; int q_ = idx >> 6; const int e = q_ % 33; q_ /= 33; const int g = q_ & 15, dir = (q_ >> 4) & 1, l = q_ >> 5;
        pw[idx] = ssm_pow(ssm_par(p, l, dir, g, pp), (float)e);
    }
    for (int idx = BIDX * NT + TIDX; idx < 2 * 2 * 16 * 64 * 16; idx += gridDim.x * NT) {
        const int h = idx & 15, pp = (idx >> 4) & 63, g = (idx >> 10) & 15, dir = (idx >> 14) & 1, l = idx >> 15;
        const size_t bi = ((size_t)((l * 2 + dir) * SG + g) * SP + pp) * 16 + h;
        fb[idx] = cmul(ssm_f(ssm_par(p, l, dir, g, pp)), make_float2(p.in[I_BRE][bi], p.in[I_BIM][bi]));
    }
}
__device__ __forceinline__ void st_ssm_kj(const P& p, float* lds) {
    float* lam = lds; float* Cc = lds + 128; float* Bb = Cc + 2048;
    float* kj = (float*)(p.ws + WS_KJ);
    const int t = TIDX;
    for (int item = BIDX; item < 64; item += gridDim.x) {
        const int l = item >> 5, g = (item >> 1) & 15, dir = item & 1;
        const int base = (l * 2 + dir) * SG + g;
        __syncthreads();
        if (t < 64) {
            const SsmPar q = ssm_par(p, l, dir, g, t);
            const float2 lb = ssm_pow(q, 1.f), f = ssm_f(q);
            lam[2 * t] = lb.x; lam[2 * t + 1] = lb.y;
            for (int h = 0; h < 16; ++h) {
                const size_t bi = ((size_t)base * SP + t) * 16 + h;
                const float2 bb = cmul(f, make_float2(p.in[I_BRE][bi], p.in[I_BIM][bi]));
                Bb[(t * 16 + h) * 2] = bb.x; Bb[(t * 16 + h) * 2 + 1] = bb.y;
            }
        }
        for (int i = t; i < 1024; i += NT) { const size_t ci = (size_t)base * 1024 + i; Cc[2 * i] = p.in[I_CRE][ci]; Cc[2 * i + 1] = p.in[I_CIM][ci]; }
        __syncthreads();
        const int ho = t >> 4, hi = t & 15;
        float acc[32];
#pragma unroll
        for (int j = 0; j < 32; ++j) acc[j] = 0.f;
        for (int pp = 0; pp < 64; ++pp) {
            float2 z = cmul(make_float2(Cc[(ho * 64 + pp) * 2], Cc[(ho * 64 + pp) * 2 + 1]), make_float2(Bb[(pp * 16 + hi) * 2], Bb[(pp * 16 + hi) * 2 + 1]));
            const float2 lb = make_float2(lam[2 * pp], lam[2 * pp + 1]);
#pragma unroll
            for (int j = 0; j < 32; ++j) { acc[j] += z.x; z = cmul(z, lb); }
        }
#pragma unroll
        for (int j = 0; j < 32; ++j) kj[((size_t)((l * 16 + g) * 2 + dir) * 32 + j) * 256 + ho * 16 + hi] = acc[j];
    }
    __syncthreads();
}
__device__ __forceinline__ void st_prep_ssm(const P& p, int l) {
    bf16_t* wst = (bf16_t*)(p.ws + WS_WST);
    for (int idx = BIDX * NT + TIDX; idx < 16 * 256 * 64; idx += gridDim.x * NT) {
        const int kc = idx & 63, n = (idx >> 6) & 255, g = idx >> 14;
        const int dir = n >> 7, c = (n >> 6) & 1, pp = n & 63, s = kc >> 1, h0 = (kc & 1) * 8;
        const int ldg = (l * 2 + dir) * 16 + g;
        const float2 coef = ((const float2*)(p.ws + WS_POW))[((size_t)ldg * 33 + (dir == 0 ? 31 - s : s)) * 64 + pp];
        const float2* fbp = (const float2*)(p.ws + WS_FB) + ((size_t)ldg * 64 + pp) * 16 + h0;
        float v[8];
#pragma unroll
        for (int j = 0; j < 8; ++j) { const float2 z = cmul(coef, fbp[j]); v[j] = c == 0 ? z.x : z.y; }
        u32x4 o; o[0] = cvt_pk_bf16(v[0], v[1]); o[1] = cvt_pk_bf16(v[2], v[3]); o[2] = cvt_pk_bf16(v[4], v[5]); o[3] = cvt_pk_bf16(v[6], v[7]);
        *(u32x4*)(wst + ((size_t)(g * 256 + n)) * 512 + kc * 8) = o;
    }
    bf16_t* kw = (bf16_t*)(p.ws + WS_KW);
    const float* kj = (const float*)(p.ws + WS_KJ);
    for (int idx = BIDX * NT + TIDX; idx < 16 * 512 * 96; idx += gridDim.x * NT) {
        const int kc = idx % 96, n = (idx / 96) & 511, g = idx / (96 * 512);
        const int tau = n >> 4, ho = n & 15;
        float v[8];
        if (kc < 64) {
            const int s = kc >> 1, hi0 = (kc & 1) * 8;
#pragma unroll
            for (int j = 0; j < 8; ++j) {
                float a = 0.f;
                if (s <= tau) a += kj[((size_t)((l * 16 + g) * 2 + 0) * 32 + (tau - s)) * 256 + ho * 16 + hi0 + j];
                if (s >= tau) a += kj[((size_t)((l * 16 + g) * 2 + 1) * 32 + (s - tau)) * 256 + ho * 16 + hi0 + j];
                if (s == tau && ho == hi0 + j) a += p.in[I_SD][l * DSSM + g * 16 + ho];
                v[j] = a;
            }
        } else {
            const int kk = (kc - 64) * 8, dir = kk >> 7, c = (kk >> 6) & 1, p0 = kk & 63;
            const int e = dir == 0 ? tau + 1 : 32 - tau;
            const float2* pwp = (const float2*)(p.ws + WS_POW) + ((size_t)((l * 2 + dir) * 16 + g) * 33 + e) * 64 + p0;
#pragma unroll
            for (int j = 0; j < 8; ++j) {
                const size_t ci = ((size_t)((l * 2 + dir) * SG + g) * 16 + ho) * SP + p0 + j;
                const float2 z = cmul(make_float2(p.in[I_CRE][ci], p.in[I_CIM][ci]), pwp[j]);
                v[j] = c == 0 ? z.x : -z.y;
            }
        }
        u32x4 o; o[0] = cvt_pk_bf16(v[0], v[1]); o[1] = cvt_pk_bf16(v[2], v[3]); o[2] = cvt_pk_bf16(v[4], v[5]); o[3] = cvt_pk_bf16(v[6], v[7]);
        *(u32x4*)(kw + ((size_t)(g * 512 + n)) * 768 + kc * 8) = o;
    }
}
__device__ __forceinline__ void st_ssm_egemm(const P& p, unsigned char* lds) {
    const bf16_t* ua = (const bf16_t*)(p.ws + WS_UA);
    const bf16_t* wst = (const bf16_t*)(p.ws + WS_WST);
    float* E = (float*)(p.ws + WS_E);
    int t_end, t_step;
    for (int tile = xcd_first(160, t_end, t_step); tile < t_end; tile += t_step) {
        const int nt = tile & 1, mt = (tile >> 1) % 5, g = tile / 10;
        f32x16 acc[2][2];
        gemm_tile(acc, ARowPlain{ua + (size_t)(g * 640 + mt * 128) * 768, 768}, wst + (size_t)(g * 256 + nt * 128) * 512, 512, 512, lds);
        acc_foreach4_lds(acc, lds, [&](int r, int c, float v0, float v1, float v2, float v3) { f32x4 o; o[0] = v0; o[1] = v1; o[2] = v2; o[3] = v3; *(f32x4*)(E + (size_t)(g * 640 + mt * 128 + r) * 256 + nt * 128 + c) = o; });
    }
}
__device__ __forceinline__ void st_ssm_carry(const P& p, int l) {
    bf16_t* ua = (bf16_t*)(p.ws + WS_UA);
    const float* E = (const float*)(p.ws + WS_E);
    for (int idx = BIDX * NT + TIDX; idx < NB * 16 * 2 * 64; idx += gridDim.x * NT) {
        const int pp = idx & 63, dir = (idx >> 6) & 1, g = (idx >> 7) & 15, b = idx >> 11;
        const float2 l32 = ((const float2*)(p.ws + WS_POW))[((size_t)((l * 2 + dir) * 16 + g) * 33 + 32) * 64 + pp];
        float2 S = make_float2(0.f, 0.f);
        for (int s0 = 0; s0 < 72; s0 += 8) {
            int ch[8]; float er[8], ei[8];
#pragma unroll
            for (int j = 0; j < 8; ++j) {
                const int step = s0 + j;
                if (dir == 0) ch[j] = step < 8 ? 512 + b * 8 + step : b * 64 + (step - 8);
                else ch[j] = step < 8 ? 512 + b * 8 + (7 - step) : b * 64 + (63 - (step - 8));
                const float* e = E + (size_t)(g * 640 + ch[j]) * 256 + dir * 128 + pp;
                er[j] = e[0]; ei[j] = e[64];
            }
#pragma unroll
            for (int j = 0; j < 8; ++j) {
                bf16_t* o = ua + (size_t)(g * 640 + ch[j]) * 768 + 512 + dir * 128 + pp;
                o[0] = f2bf(S.x); o[64] = f2bf(S.y);
                S = cmul(l32, S); S.x += er[j]; S.y += ei[j];
            }
        }
    }
}
__device__ __forceinline__ void st_ssm_ygemm(const P& p, int l, unsigned char* lds) {
    const bf16_t* ua = (const bf16_t*)(p.ws + WS_UA);
    const bf16_t* kw = (const bf16_t*)(p.ws + WS_KW);
    bf16_t* G = (bf16_t*)(p.ws + WS_G);
    const int nmt = l == 0 ? 5 : 4;
    int t_end, t_step;
    for (int tile = xcd_first(16 * nmt * 4, t_end, t_step); tile < t_end; tile += t_step) {
        const int nt = tile & 3, mt = (tile >> 2) % nmt, g = tile / (4 * nmt);
        f32x16 acc[2][2];
        gemm_tile(acc, ARowPlain{ua + (size_t)(g * 640 + mt * 128) * 768, 768}, kw + (size_t)(g * 512 + nt * 128) * 768, 768, 768, lds);
        acc_foreach4_lds(acc, lds, [&](int r, int c, float v0, float v1, float v2, float v3) {
            const int chunk = mt * 128 + r, n = nt * 128 + c;
            if (chunk < TA / 32) *(uint2*)(G + (size_t)(chunk * 32 + (n >> 4)) * DSSM + g * 16 + (n & 15)) = pack4(gelu_f(v0), gelu_f(v1), gelu_f(v2), gelu_f(v3)); });
    }
}
struct EpiGlu2 { const bf16_t* G; bf16_t* mix; const float* bias; __device__ __forceinline__ void operator()(int r, int c, float v0, float v1, float v2, float v3) const {
    const uint2 q = *(const uint2*)(G + (size_t)r * DSSM + c);
    const f32x4 b = *(const f32x4*)(bias + c);
    *(uint2*)(mix + (size_t)r * D + 256 + c) = pack4(__uint_as_float(q.x << 16) * sigmoid_f(v0 + b[0]), __uint_as_float(q.x & 0xffff0000u) * sigmoid_f(v1 + b[1]),
                                                     __uint_as_float(q.y << 16) * sigmoid_f(v2 + b[2]), __uint_as_float(q.y & 0xffff0000u) * sigmoid_f(v3 + b[3])); } };

constexpr float QSCALE = 0.125f * 1.4426950408889634f;
__device__ __forceinline__ void st_rope_table(const P& p) {
    float2* tab = (float2*)(p.ws + WS_ROPE);
    for (int idx = BIDX * NT + TIDX; idx < L * 32; idx += gridDim.x * NT) {
        const int t = idx >> 5, a = (idx >> 4) & 1, i = idx & 15;
        const float pos = a == 0 ? (float)(t / 64) : (float)(t % 64);
        const float ang = pos * powf(10000.f, -(float)i / 16.f);
        tab[idx] = make_float2(cosf(ang), sinf(ang));
    }
}
__device__ __forceinline__ void st_inproj(const P& p, int l, unsigned char* lds) {
    const bf16_t* A = (const bf16_t*)(p.ws + WS_BUFA);
    const bf16_t* Bt = (const bf16_t*)(p.ws + WS_WTIN);
    bf16_t* pc = (bf16_t*)(p.ws + WS_PC);
    bf16_t* ua = (bf16_t*)(p.ws + WS_UA);
    bf16_t* qb = (bf16_t*)(p.ws + WS_QB);
    bf16_t* kb = (bf16_t*)(p.ws + WS_KB);
    bf16_t* vt = (bf16_t*)(p.ws + WS_VT);
    const float2* rope = (const float2*)(p.ws + WS_ROPE);
    const int lane = TIDX & 63, w = TIDX >> 6, wr = w >> 1, wc = w & 1, lr = lane & 31, lh = lane >> 5;
    constexpr int TN = DIN / 128;
    int t_end, t_step;
    for (int tile = xcd_first((TA / 128) * TN, t_end, t_step); tile < t_end; tile += t_step) {
        const int tn = tile % TN, m0 = (tile / TN) * 128, n0 = tn * 128;
        f32x16 acc[2][2];
        gemm_tile(acc, ARowPlain{A + (size_t)m0 * D, D}, Bt + (size_t)n0 * D, D, D, lds);
        if (tn < 6) {
            acc_foreach4_lds(acc, lds, [&](int r, int c, float v0, float v1, float v2, float v3) { *(uint2*)(pc + (size_t)(m0 + r) * 768 + n0 + c) = pack4(v0, v1, v2, v3); });
        } else if (tn < 8) {
            acc_foreach4_lds(acc, lds, [&](int r, int c, float v0, float v1, float v2, float v3) { const int row = m0 + r, g = (tn - 6) * 8 + (c >> 4);
                *(uint2*)(ua + (size_t)(g * 640 + (row >> 5)) * 768 + (row & 31) * 16 + (c & 15)) = pack4(v0, v1, v2, v3); });
        } else if (tn < 13) {
            const bool isq = tn < 12;
            const float* gain = (isq ? p.in[I_QG] : p.in[I_KG]) + l * 64;
            const bool lat = m0 < TL;
            const float osc = isq ? QSCALE : 1.f;
#pragma unroll
            for (int mi = 0; mi < 2; ++mi) {
                const int row = m0 + wr * 64 + mi * 32 + lr;
                float ss = 0.f;
#pragma unroll
                for (int ni = 0; ni < 2; ++ni)
#pragma unroll
                    for (int r = 0; r < 16; ++r) ss += acc[mi][ni][r] * acc[mi][ni][r];
                ss += __shfl_xor(ss, 32);
                const float rinv = rsqrtf(ss * (1.f / 64.f) + 1e-6f) * osc;
                const int t = row & (L - 1);
                bf16_t* o = isq ? qb + (size_t)row * DATT + ((tn - 8) * 2 + wc) * 64 : kb + (size_t)row * 128 + wc * 64;
#pragma unroll
                for (int ni = 0; ni < 2; ++ni)
#pragma unroll
                    for (int g = 0; g < 2; ++g) {
                        const int d0 = ni * 32 + 8 * g + 4 * lh;
                        const f32x4 glo = *(const f32x4*)(gain + d0), ghi = *(const f32x4*)(gain + d0 + 16);
                        float t1[4], t2[4];
#pragma unroll
                        for (int q = 0; q < 4; ++q) { t1[q] = acc[mi][ni][4 * g + q] * rinv * glo[q]; t2[q] = acc[mi][ni][8 + 4 * g + q] * rinv * ghi[q]; }
                        if (lat) {
                            const float2* cs = rope + (t * 2 + ni) * 16 + 8 * g + 4 * lh;
                            const f32x4 c01 = *(const f32x4*)(cs), c23 = *(const f32x4*)(cs + 2);
                            const float cc[4] = {c01[0], c01[2], c23[0], c23[2]}, sn[4] = {c01[1], c01[3], c23[1], c23[3]};
#pragma unroll
                            for (int q = 0; q < 4; ++q) { const float a = t1[q], b = t2[q]; t1[q] = a * cc[q] - b * sn[q]; t2[q] = a * sn[q] + b * cc[q]; }
                        }
                        *(uint2*)(o + d0) = pack4(t1[0], t1[1], t1[2], t1[3]);
                        *(uint2*)(o + d0 + 16) = pack4(t2[0], t2[1], t2[2], t2[3]);
                    }
            }
        } else {
            acc_foreach4_lds(acc, lds, [&](int r, int c, float v0, float v1, float v2, float v3) { *(uint2*)(vt + (size_t)(m0 + r) * 128 + c) = pack4(v0, v1, v2, v3); });
        }
    }
}

constexpr int AT_KROWB = 144, AT_VROWB = 136, AT_VOFF = 64 * AT_KROWB;
__device__ __forceinline__ void st_attn2(const P& p, int l, unsigned char* lds, int part, int nparts) {
    const bf16_t* qb = (const bf16_t*)(p.ws + WS_QB);
    const bf16_t* kb = (const bf16_t*)(p.ws + WS_KB);
    const bf16_t* vb = (const bf16_t*)(p.ws + WS_VT);
    bf16_t* mix = (bf16_t*)(p.ws + WS_BUFA);
    const int t = TIDX, lane = t & 63, w = t >> 6, lr = lane & 31, lh = lane >> 5;
    constexpr int NLAT = NB * 32 * 2;
    const int nitems = NLAT + (l == 0 ? NB * 4 * 2 : 0);
    int t_end, t_step;
    for (int kk = xcd_first((nitems - part + nparts - 1) / nparts, t_end, t_step); kk < t_end; kk += t_step) {
        const int item = kk * nparts + part;
        const bool isctx = item >= NLAT;
        int b, q64, g;
        if (!isctx) { g = item & 1; q64 = (item >> 1) & 31; b = item >> 6; }
        else { const int it = item - NLAT; g = it & 1; q64 = (it >> 1) & 3; b = it >> 3; }
        const int hq = g * 4 + w;
        const int rq0 = isctx ? TL + b * LC + q64 * 64 : b * L + q64 * 64;
        bf16x8 qf[2][4];
#pragma unroll
        for (int qs = 0; qs < 2; ++qs)
#pragma unroll
            for (int s4 = 0; s4 < 4; ++s4) qf[qs][s4] = *(const bf16x8*)(qb + (size_t)(rq0 + qs * 32 + lr) * DATT + hq * 64 + s4 * 16 + lh * 8);
        const float sinkl = p.in[I_SINK][l * NQH + hq] * 1.4426950408889634f;
        float m[2] = {sinkl, sinkl};
        float lsum[2]; lsum[0] = lsum[1] = lh == 0 ? 1.f : 0.f;
        f32x16 o[2][2];
        float zf = 0.f; asm volatile("" : "+v"(zf));
#pragma unroll
        for (int qs = 0; qs < 2; ++qs)
#pragma unroll
            for (int dt = 0; dt < 2; ++dt)
#pragma unroll
                for (int r = 0; r < 16; ++r) o[qs][dt][r] = zf;
        const int nwin = isctx ? 0 : 5, nkt = nwin + 4;
        const int srow = t >> 3, kc = t & 7;
        u32x4 pk[2], pv[2];
        auto tile_row0 = [&](int kt, bool& win, bool& valid) -> int {
            if (kt < nwin) { win = true; const int k64 = q64 - 2 + kt; valid = (k64 >= 0 && k64 < 32); return b * L + k64 * 64; }
            win = false; valid = true; return TL + b * LC + (kt - nwin) * 64;
        };
        int kt = 0; bool win, valid; int krow0 = 0;
        for (; kt < nkt; ++kt) { krow0 = tile_row0(kt, win, valid); if (valid) break; }
#pragma unroll
        for (int i = 0; i < 2; ++i) { const size_t off = (size_t)(krow0 + srow + 32 * i) * 128 + g * 64 + kc * 8; pk[i] = *(const u32x4*)(kb + off); pv[i] = *(const u32x4*)(vb + off); }
        while (kt < nkt) {
            const bool cwin = win; const int ckrow0 = krow0;
            __syncthreads();
#pragma unroll
            for (int i = 0; i < 2; ++i) {
                const int row = srow + 32 * i;
                *(u32x4*)(lds + row * AT_KROWB + kc * 16) = pk[i];
                unsigned char* vd = lds + AT_VOFF + (kc * 8) * AT_VROWB + row * 2;
#pragma unroll
                for (int q = 0; q < 4; ++q) { *(bf16_t*)(vd + (2 * q) * AT_VROWB) = (bf16_t)(pv[i][q] & 0xffffu); *(bf16_t*)(vd + (2 * q + 1) * AT_VROWB) = (bf16_t)(pv[i][q] >> 16); }
            }
            int nkt2 = kt + 1; bool nwin2 = false, nvalid = false; int nrow0 = 0;
            for (; nkt2 < nkt; ++nkt2) { nrow0 = tile_row0(nkt2, nwin2, nvalid); if (nvalid) break; }
            if (nkt2 < nkt) {
#pragma unroll
                for (int i = 0; i < 2; ++i) { const size_t off = (size_t)(nrow0 + srow + 32 * i) * 128 + g * 64 + kc * 8; pk[i] = *(const u32x4*)(kb + off); pv[i] = *(const u32x4*)(vb + off); }
            }
            __syncthreads();
            const int j0t = ckrow0 - b * L;
#pragma unroll
            for (int sub = 0; sub < 2; ++sub) {
                bf16x8 kf[4];
#pragma unroll
                for (int s4 = 0; s4 < 4; ++s4) kf[s4] = *(const bf16x8*)(lds + (sub * 32 + lr) * AT_KROWB + s4 * 32 + lh * 16);
#pragma unroll
                for (int qs = 0; qs < 2; ++qs) {
                    bool partial = false;
                    if (cwin) {
                        const int j0 = j0t + sub * 32, i0 = q64 * 64 + qs * 32;
                        if (j0 > i0 + 31 + 128 || j0 + 31 < i0 - 128) continue;
                        partial = !(j0 >= i0 + 31 - 128 && j0 + 31 <= i0 + 128);
                    }
                    f32x16 sT;
#pragma unroll
                    for (int r = 0; r < 16; ++r) sT[r] = zf;
#pragma unroll
                    for (int s4 = 0; s4 < 4; ++s4) sT = __builtin_amdgcn_mfma_f32_32x32x16_bf16(kf[s4], qf[qs][s4], sT, 0, 0, 0);
                    if (partial) {
                        const int dj0 = j0t + sub * 32 + 4 * lh - (q64 * 64 + qs * 32 + lr);
#pragma unroll
                        for (int r = 0; r < 16; ++r) { const int dj = dj0 + (r & 3) + 8 * (r >> 2); if (dj > 128 || dj < -128) sT[r] = -1e30f; }
                    }
                    float mt = sT[0];
#pragma unroll
                    for (int r = 1; r < 16; ++r) mt = fmaxf(mt, sT[r]);
                    mt = fmaxf(mt, __shfl_xor(mt, 32));
                    const float mn = fmaxf(m[qs], mt);
                    const float alpha = __builtin_amdgcn_exp2f(m[qs] - mn);
                    m[qs] = mn;
                    float ps = 0.f;
#pragma unroll
                    for (int r = 0; r < 16; ++r) { sT[r] = __builtin_amdgcn_exp2f(sT[r] - mn); ps += sT[r]; }
                    lsum[qs] = lsum[qs] * alpha + ps;
#pragma unroll
                    for (int r = 0; r < 16; ++r) { o[qs][0][r] *= alpha; o[qs][1][r] *= alpha; }
#pragma unroll
                    for (int s2 = 0; s2 < 2; ++s2) {
                        u32x4 pkk;
                        pkk[0] = cvt_pk_bf16(sT[8 * s2 + 0], sT[8 * s2 + 1]); pkk[1] = cvt_pk_bf16(sT[8 * s2 + 2], sT[8 * s2 + 3]);
                        pkk[2] = cvt_pk_bf16(sT[8 * s2 + 4], sT[8 * s2 + 5]); pkk[3] = cvt_pk_bf16(sT[8 * s2 + 6], sT[8 * s2 + 7]);
                        const bf16x8 pf = __builtin_bit_cast(bf16x8, pkk);
#pragma unroll
                        for (int dt = 0; dt < 2; ++dt) {
                            const unsigned char* vp = lds + AT_VOFF + (dt * 32 + lr) * AT_VROWB + (sub * 32 + s2 * 16 + lh * 4) * 2;
                            const uint2 a = *(const uint2*)(vp), c2 = *(const uint2*)(vp + 16);
                            u32x4 vv; vv[0] = a.x; vv[1] = a.y; vv[2] = c2.x; vv[3] = c2.y;
                            o[qs][dt] = __builtin_amdgcn_mfma_f32_32x32x16_bf16(__builtin_bit_cast(bf16x8, vv), pf, o[qs][dt], 0, 0, 0);
                        }
                    }
                }
            }
            kt = nkt2; win = nwin2; krow0 = nrow0;
        }
#pragma unroll
        for (int qs = 0; qs < 2; ++qs) {
            const float lt = lsum[qs] + __shfl_xor(lsum[qs], 32);
            const float inv = 1.f / lt;
            bf16_t* orow = mix + (size_t)(rq0 + qs * 32 + lr) * D + 512 + hq * 64;
#pragma unroll
            for (int dt = 0; dt < 2; ++dt)
#pragma unroll
                for (int rg = 0; rg < 4; ++rg)
                    *(uint2*)(orow + dt * 32 + 8 * rg + 4 * lh) = pack4(o[qs][dt][4 * rg] * inv, o[qs][dt][4 * rg + 1] * inv, o[qs][dt][4 * rg + 2] * inv, o[qs][dt][4 * rg + 3] * inv);
        }
    }
}


constexpr int FAKE = 0;
constexpr int TIM = 0;
constexpr int PROBE3 = 0;
constexpr int PROBE2 = 0;
__device__ __forceinline__ void st_fake(const P& p, unsigned char* lds) {
    if (FAKE == 0) return;
    const bf16_t* A = (const bf16_t*)(p.ws + WS_BUFA);
    const bf16_t* Bt = (const bf16_t*)(p.ws + WS_WTIN);
    constexpr int TN = DIN / 128;
    int t_end, t_step;
    float sink = 0.f;
    for (int tile = xcd_first((TA / 128) * TN, t_end, t_step); tile < t_end; tile += t_step) {
        const int tn = tile % TN, m0 = (FAKE == 2 || FAKE == 3) ? 0 : (tile / TN) * 128, n0 = FAKE == 3 ? 0 : tn * 128;
        f32x16 acc[2][2];
        gemm_tile(acc, ARowPlain{A + (size_t)m0 * D, D}, Bt + (size_t)n0 * D, D, D, lds);
        if (FAKE == 4) {
            bf16_t* dst = (bf16_t*)(p.ws + WS_HID);
            acc_foreach4_lds(acc, lds, [&](int r, int c, float v0, float v1, float v2, float v3) { *(uint2*)(dst + ((size_t)((tile / TN) * 128 + r) * 128 + c)) = pack4(v0, v1, v2, v3); });
        } else if (FAKE == 5) {
            bf16_t* dst = (bf16_t*)(p.ws + WS_HID);
            __syncthreads();
            acc_foreach4_lds(acc, lds, [&](int r, int c, float v0, float v1, float v2, float v3) { *(uint2*)(lds + (r * 136 + c) * 2) = pack4(v0, v1, v2, v3); });
            __syncthreads();
            const int t = TIDX;
#pragma unroll
            for (int i = 0; i < 8; ++i) { const int ch = t + 256 * i, r = ch >> 4, cc = (ch & 15) * 8;
                *(u32x4*)(dst + ((size_t)((tile / TN) * 128 + r) * 128 + cc)) = *(const u32x4*)(lds + (r * 136 + cc) * 2); }
        } else {
#pragma unroll
        for (int mi = 0; mi < 2; ++mi)
#pragma unroll
            for (int ni = 0; ni < 2; ++ni) sink += acc[mi][ni][0] + acc[mi][ni][7];
        }
    }
    if (sink == 12345.678f) ((float*)(p.ws + WS_RBIAS))[1000] = sink;
}
constexpr int STAGES_PER_LAYER = 11;
constexpr int N_STAGES = 1 + 2 * STAGES_PER_LAYER;
constexpr int REP_STAGE = -1;

__device__ __forceinline__ void run_stage(const P& p, int s, unsigned char* ldsb) {
    float* lds = (float*)ldsb;
    if (s == 0) { st_mod(p, lds); st_rope_table(p); st_ssm_tables(p); st_ssm_kj(p, lds); return; }
    const int l = (s - 1) / STAGES_PER_LAYER, k = (s - 1) % STAGES_PER_LAYER;
    switch (k) {
    case 0: st_rbias(p, l, lds); st_prep_weights(p, l, ldsb); st_prep_ssm(p, l); st_norm(p, l, 0);
            if (l == 0 && PROBE3 == 1) st_rbias(p, l, lds); if (l == 0 && PROBE3 == 2) st_prep_weights(p, l, ldsb); if (l == 0 && PROBE3 == 3) st_prep_ssm(p, l); if (l == 0 && PROBE3 == 4) st_norm(p, l, 0); break;
    case 1: if (l == 0) st_fake(p, ldsb); st_inproj(p, l, ldsb); break;
    case 2: st_ssm_egemm(p, ldsb); break;
    case 3: st_ssm_carry(p, l); st_attn2(p, l, ldsb, 0, 1); break;
    case 4: st_ssm_ygemm(p, l, ldsb); break;
    case 5: gemm_stage((const bf16_t*)(p.ws + WS_G), DSSM, (const bf16_t*)(p.ws + WS_WTGLU), DSSM, l == 0 ? TA : TL, DSSM, DSSM,
                       EpiGlu2{(const bf16_t*)(p.ws + WS_G), (bf16_t*)(p.ws + WS_BUFA), p.in[I_BGLU] + l * DSSM}, ldsb);
            st_conv(p, l); break;
    case 6: gemm_stage((const bf16_t*)(p.ws + WS_BUFA), D, (const bf16_t*)(p.ws + WS_WTOUT), D, l == 0 ? TA : TL, D, D, make_epi_out(p, l), ldsb); break;
    case 7: if (PROBE2 == 1 && l == 0) st_router2<true>(p, l, ldsb); st_router2(p, l, ldsb); break;
    case 8: st_moe1(p, l, ldsb); break;
    case 9: st_moe2(p, l, ldsb); break;
    case 10: if (PROBE2 == 2 && l == 0) { EpiMoeF e = make_epi_moef(p, l); e.outw = false; gemm_stage((const bf16_t*)(p.ws + WS_HID) + 4 * DE, 5 * DE, (const bf16_t*)(p.ws + WS_WD) + (size_t)32 * D * DE, DE, TA, D, DE, e, ldsb); }
             gemm_stage((const bf16_t*)(p.ws + WS_HID) + 4 * DE, 5 * DE, (const bf16_t*)(p.ws + WS_WD) + (size_t)32 * D * DE, DE, l == 0 ? TA : TL, D, DE, make_epi_moef(p, l), ldsb); break;
    }
}


#define XB_TMO      128
#define XB_XCNT(j)  (256  + 64 * (j))
#define XB_XSUB(j)  (1280 + 64 * (j))
#define XB_XGEN(j)  (2304 + 64 * (j))
#define XB_TOP      3328
#define XB_TOPGEN   3392
#define XCD_BAR_WORDS 3456
#define XB_SPIN_CAP (1u << 22)
__device__ __forceinline__ unsigned xb_ld(unsigned* p)              { return __hip_atomic_load(p, __ATOMIC_RELAXED, __HIP_MEMORY_SCOPE_AGENT); }
__device__ __forceinline__ unsigned xb_add(unsigned* p, unsigned v) { return __hip_atomic_fetch_add(p, v, __ATOMIC_RELAXED, __HIP_MEMORY_SCOPE_AGENT); }
__device__ __forceinline__ unsigned xb_xcc_id() { return (unsigned)__builtin_amdgcn_s_getreg((3 << 11) | 20) & 0xFu; }
#define XB_SPIN(cond, bar) do { unsigned _sp = 0; while (cond) { __builtin_amdgcn_s_sleep(1); \
    if ((++_sp & 255u) == 0u) { if (xb_ld(&(bar)[XB_TMO])) break; if (_sp > XB_SPIN_CAP) { atomicAdd(&(bar)[XB_TMO], 1u); break; } } } } while (0)
struct XcdBarrier { unsigned* bar; unsigned x; volatile LAS unsigned* st; };
__device__ __forceinline__ XcdBarrier xcd_barrier_post(unsigned* bar, volatile LAS unsigned* st) {
    XcdBarrier b; b.bar = bar; b.x = xb_xcc_id(); b.st = st;
    if (threadIdx.x == 0) (void)xb_add(&bar[XB_XCNT(b.x)], 1u);
    return b;
}
__device__ __forceinline__ void xcd_barrier_complete(unsigned* bar, unsigned x, unsigned& nloc, unsigned& nx) {
    const unsigned G = gridDim.x * gridDim.y * gridDim.z;
    unsigned sum, cnt, mine, sp = 0u;
    for (;;) {
        sum = 0u; cnt = 0u; mine = 0u;
#pragma unroll
        for (unsigned j = 0; j < 16; ++j) { const unsigned c = xb_ld(&bar[XB_XCNT(j)]); sum += c; cnt += (c > 0u) ? 1u : 0u; mine = (j == x) ? c : mine; }
        if (sum == G) break;
        __builtin_amdgcn_s_sleep(1);
        if ((++sp & 255u) == 0u) { if (xb_ld(&bar[XB_TMO])) break; if (sp > XB_SPIN_CAP) { atomicAdd(&bar[XB_TMO], 1u); break; } }
    }
    nloc = mine > 0u ? mine : 1u; nx = cnt > 0u ? cnt : 1u;
}
__device__ __forceinline__ void xcd_barrier(const XcdBarrier& b) {
    asm volatile("s_waitcnt vmcnt(0)" ::: "memory");
    __syncthreads();
    if (threadIdx.x == 0) {
        unsigned* bar = b.bar;
        __builtin_amdgcn_s_waitcnt(0);
        unsigned nloc = b.st[0], nx = b.st[1];
        if (nloc == 0u) { xcd_barrier_complete(bar, b.x, nloc, nx); b.st[0] = nloc; b.st[1] = nx; }
        const unsigned old = xb_add(&bar[XB_XSUB(b.x)], 1u);
        const unsigned gen = old / nloc;
        if (old + 1u == (gen + 1u) * nloc) {
            __builtin_amdgcn_fence(__ATOMIC_RELEASE, "agent");
            asm volatile("s_waitcnt vmcnt(0)" ::: "memory");
            const unsigned og = xb_add(&bar[XB_TOP], 1u);
            const unsigned tg = og / nx;
            if (og + 1u == (tg + 1u) * nx) xb_add(&bar[XB_TOPGEN], 1u);
            else XB_SPIN(xb_ld(&bar[XB_TOPGEN]) == tg, bar);
            __builtin_amdgcn_fence(__ATOMIC_ACQUIRE, "agent");
            xb_add(&bar[XB_XGEN(b.x)], 1u);
            asm volatile("s_waitcnt vmcnt(0)" ::: "memory");
        } else {
            XB_SPIN(xb_ld(&bar[XB_XGEN(b.x)]) == gen, bar);
            __builtin_amdgcn_fence(__ATOMIC_ACQUIRE, "agent");
            asm volatile("s_waitcnt vmcnt(0)" ::: "memory");
        }
    }
    __syncthreads();
}
constexpr size_t WS_XBAR = 4096;

template <int S> __device__ __forceinline__ void run_all(const P& p, unsigned char* lds, const XcdBarrier& xb) {
    run_stage(p, S, lds);
    if constexpr (S == REP_STAGE) { xcd_barrier(xb); run_stage(p, S, lds); }
    if constexpr (S + 1 < N_STAGES) {
        unsigned long long t0 = 0; if (TIM) t0 = __builtin_amdgcn_s_memrealtime();
        if constexpr (S == 0) cg::this_grid().sync();
        else xcd_barrier(xb);
        if (TIM && threadIdx.x == 0) { const unsigned long long t1 = __builtin_amdgcn_s_memrealtime(); xb.st[2] += (unsigned)(t1 - t0);
            if (blockIdx.x == 0) ((unsigned long long*)(p.ws + WS_CTL + 32768))[S + 1] = t1; }
        run_all<S + 1>(p, lds, xb);
    } else if (TIM) {
        unsigned* ctl = (unsigned*)(p.ws + WS_CTL + 32768 + 512);
        unsigned long long* ts = (unsigned long long*)(p.ws + WS_CTL + 32768);
        if (threadIdx.x == 0) { atomicAdd(ctl, xb.st[2]); if (blockIdx.x == 0) ts[N_STAGES] = __builtin_amdgcn_s_memrealtime(); }
        xcd_barrier(xb);
        if (blockIdx.x == 0 && threadIdx.x == 0) {
            float us;
            if (TIM == 1) us = (float)__hip_atomic_load(ctl, __ATOMIC_RELAXED, __HIP_MEMORY_SCOPE_AGENT) / (float)gridDim.x * 0.01f / 10.f;
            else if (TIM == 2) us = (float)(ts[N_STAGES] - ts[0]) * 0.01f / 25.f;
            else us = (float)(ts[TIM - 10 + 1] - ts[TIM - 10]) * 0.01f / 2.f;
            float code = floorf(us); if (code > 89.f) code = 89.f;
            p.out[0] += 10.f + code;
        }
    }
}
__global__ void __launch_bounds__(NT, 2) mega(P p) {
    __shared__ __attribute__((aligned(16))) unsigned char lds[LDS_TOTAL + 16];
    volatile LAS unsigned* st = (volatile LAS unsigned*)(lds + LDS_TOTAL);
    if (threadIdx.x == 0) { st[0] = 0u; st[1] = 0u; st[2] = 0u; st[3] = 0u; if (TIM && blockIdx.x == 0) ((unsigned long long*)(p.ws + WS_CTL + 32768))[0] = __builtin_amdgcn_s_memrealtime(); }
    __syncthreads();
    const XcdBarrier xb = xcd_barrier_post((unsigned*)(p.ws + WS_CTL + WS_XBAR), st);
    run_all<0>(p, lds, xb);
}

extern "C" void kernel_launch(void* const* d_in, const int* in_sizes, int n_in, void* d_out, int out_size, void* d_ws, size_t ws_size, hipStream_t stream) {
    if (n_in != N_IN || ws_size < WS_END) { fprintf(stderr, "kernel_launch: unexpected n_in %d or ws_size %zu (< %zu)\n", n_in, ws_size, (size_t)WS_END); return; }
    P p{};
    for (int i = 0; i < N_IN; ++i) p.in[i] = (const float*)d_in[i];
    p.out = (float*)d_out; p.ws = (unsigned char*)d_ws;
    static int grid_blocks = 0;
    if (!grid_blocks) {
        int dev = 0, cus = 0, per_cu = 0;
        hipGetDevice(&dev);
        hipDeviceGetAttribute(&cus, hipDeviceAttributeMultiprocessorCount, dev);
        hipOccupancyMaxActiveBlocksPerMultiprocessor(&per_cu, (const void*)mega, NT, 0);
        if (per_cu < 1) per_cu = 1;
        if (per_cu > 2) per_cu = 2;
        grid_blocks = cus * per_cu;
    }
    hipMemsetAsync((char*)d_ws + WS_CTL, 0, 65536, stream);
    void* args[] = {&p};
    hipError_t e = hipLaunchCooperativeKernel((const void*)mega, dim3(grid_blocks), dim3(NT), args, 0, stream);
    if (e != hipSuccess) fprintf(stderr, "cooperative launch failed: %s (grid %d)\n", hipGetErrorString(e), grid_blocks);
}
```

```cpp
#include <hip/hip_runtime.h>
#include <hip/hip_cooperative_groups.h>
#include <cstdio>
#include <cstdint>
namespace cg = cooperative_groups;
#define CNT_PTR(p, l) ((int*)((p).ws + 40960 + (l) * 8192))
#define LAS __attribute__((address_space(3)))
constexpr int ABL = 0;

__device__ __forceinline__ int tid_opaque() { int t = threadIdx.x; asm volatile("" : "+v"(t)); return t; }
__device__ __forceinline__ int bid_opaque() { int b = blockIdx.x; asm volatile("" : "+s"(b)); return b; }
__device__ __forceinline__ int xcd_first(int total, int& end, int& step) {
    const int nb = gridDim.x; int b = blockIdx.x; asm volatile("" : "+s"(b));
    if (nb & 7) { end = total; step = nb; return b; }
    const int x = b & 7, j = b >> 3, per = (total + 7) >> 3, lo = x * per;
    end = lo + per < total ? lo + per : total; step = nb >> 3; return lo + j;
}
#define TIDX tid_opaque()
#define BIDX bid_opaque()

constexpr int D = 1024, NB = 8, L = 2048, LC = 256;
constexpr int TL = NB * L, TC = NB * LC, TA = TL + TC;
constexpr int DIN = 1792, DCONV = 256, DSSM = 256, DATT = 512;
constexpr int NQH = 8, NKVH = 2, HD = 64;
constexpr int COL_U = 768, COL_Q = 1024, COL_K = 1536, COL_V = 1664;
constexpr int NE = 32, TOPK = 4, DE = 128;
constexpr int SG = 16, SH = 16, SP = 64;
constexpr int NT = 256;

enum { I_X = 0, I_C, I_CTX, I_CCTX, I_WMOD, I_BMOD, I_N1G, I_N2G, I_WIN, I_CONVW, I_LRE, I_LIM, I_LDT, I_BRE, I_BIM, I_CRE, I_CIM,
       I_SD, I_WGLU, I_BGLU, I_QG, I_KG, I_SINK, I_WOUT, I_RW, I_RB, I_WEG, I_WEU, I_WED, I_WSG, I_WSU, I_WSD, N_IN };

typedef unsigned short bf16_t;
constexpr size_t WS_CTL = 0;
constexpr size_t WS_MOD = 65536;
constexpr size_t WS_ZERO_END = WS_MOD + (size_t)2 * 9 * 6 * D * 4;
constexpr size_t WS_RBIAS = 524288;
constexpr size_t WS_ROPE = WS_RBIAS + 4096;
constexpr size_t WS_KJ = WS_ROPE + 524288;
constexpr size_t WS_GS2 = WS_KJ + 2097152;
constexpr size_t WS_POW = WS_GS2 + 131072;
constexpr size_t WS_FB = WS_POW + (size_t)2 * 2 * 16 * 33 * 64 * 8;
constexpr size_t WS_R1 = WS_FB + (size_t)2 * 2 * 16 * 64 * 16 * 8;
constexpr size_t WS_BUFA = WS_R1;
constexpr size_t WS_PC = WS_BUFA + (size_t)TA * D * 2;
constexpr size_t WS_UA = WS_PC + (size_t)TA * 768 * 2;
constexpr size_t WS_E = WS_UA + (size_t)16 * 640 * 768 * 2;
constexpr size_t WS_G = WS_E + (size_t)16 * 640 * 256 * 4;
constexpr size_t WS_QB = WS_G + (size_t)TA * DSSM * 2;
constexpr size_t WS_KB = WS_QB + (size_t)TA * DATT * 2;
constexpr size_t WS_VT = WS_KB + (size_t)TA * 128 * 2;
constexpr size_t WS_SLAB = WS_R1;
constexpr size_t WS_HID = WS_SLAB + (size_t)TA * 4 * D * 2;
constexpr size_t WS_HC1 = WS_HID + (size_t)TA * 5 * DE * 2;
constexpr size_t WS_HCMID = WS_HC1 + (size_t)TC * D * 4;
constexpr size_t WS_LCODE = WS_HCMID + (size_t)TC * D * 4;
constexpr size_t WS_LW = WS_LCODE + (size_t)NE * TA * 4;
constexpr size_t WS_WTIN = WS_LW + (size_t)NE * TA * 4;
constexpr size_t WS_WTOUT = WS_WTIN + (size_t)DIN * D * 2;
constexpr size_t WS_WTGLU = WS_WTOUT + (size_t)D * D * 2;
constexpr size_t WS_WGU = WS_WTGLU + (size_t)DSSM * DSSM * 2;
constexpr size_t WS_WD = WS_WGU + (size_t)33 * 256 * D * 2;
constexpr size_t WS_WST = WS_WD + (size_t)33 * D * DE * 2;
constexpr size_t WS_KW = WS_WST + (size_t)16 * 256 * 512 * 2;
constexpr size_t WS_END = WS_KW + (size_t)16 * 512 * 768 * 2;
static_assert(WS_VT + (size_t)TA * 128 * 2 <= WS_HID, "overlay");
static_assert(WS_ZERO_END <= WS_RBIAS, "zero region");
static_assert(WS_END <= 268435456, "workspace too large");

struct P {
    const float* in[N_IN];
    float* out;
    unsigned char* ws;
};

__device__ __forceinline__ bf16_t f2bf(float f) { unsigned u = __float_as_uint(f); u += 0x7FFFu + ((u >> 16) & 1u); return (bf16_t)(u >> 16); }
__device__ __forceinline__ float bf2f(bf16_t b) { return __uint_as_float((unsigned)b << 16); }
__device__ __forceinline__ unsigned cvt_pk_bf16(float lo, float hi) { unsigned r; asm("v_cvt_pk_bf16_f32 %0, %1, %2" : "=v"(r) : "v"(lo), "v"(hi)); return r; }
typedef __attribute__((ext_vector_type(4))) float f32x4;
typedef __attribute__((ext_vector_type(4))) unsigned u32x4;
struct BfPtr { const bf16_t* p; __device__ __forceinline__ float operator[](long i) const { return bf2f(p[i]); }
               __device__ __forceinline__ BfPtr operator+(long o) const { return BfPtr{p + o}; } };
__device__ __forceinline__ float silu_f(float x) { return x / (1.f + expf(-x)); }
__device__ __forceinline__ float sigmoid_f(float x) { return 1.f / (1.f + expf(-x)); }
__device__ __forceinline__ float gelu_f(float x) { return 0.5f * x * (1.f + tanhf(0.7978845608028654f * (x + 0.044715f * x * x * x))); }
__device__ __forceinline__ float wave_sum(float v) {
#pragma unroll
    for (int o = 32; o > 0; o >>= 1) v += __shfl_xor(v, o);
    return v;
}
__device__ __forceinline__ int row_bb(int r) { return r < TL ? r / L : 8; }
__device__ __forceinline__ const float* h_row(const P& p, int l, int r) {
    if (r < TL) return (l == 0 ? p.in[I_X] : p.out) + (size_t)r * D;
    return (l == 0 ? p.in[I_CTX] : (const float*)(p.ws + WS_HC1)) + (size_t)(r - TL) * D;
}
__device__ __forceinline__ float* hmid_row(const P& p, int r) {
    if (r < TL) return p.out + (size_t)r * D;
    return (float*)(p.ws + WS_HCMID) + (size_t)(r - TL) * D;
}
__device__ __forceinline__ const float* mod_vec(const P& p, int l, int bb, int chunk) {
    return (const float*)(p.ws + WS_MOD) + ((size_t)(l * 9 + bb) * 6 + chunk) * D;
}

__device__ __forceinline__ void st_mod(const P& p, float* lds) {
    float* red = lds + 9 * D;
    for (int i = TIDX; i < 9 * D; i += NT) {
        const int bb = i / D, k = i % D;
        const float c = bb < 8 ? p.in[I_C][bb * D + k] : p.in[I_CCTX][k];
        lds[i] = silu_f(c);
    }
    __syncthreads();
    float* mod = (float*)(p.ws + WS_MOD);
    const int col = TIDX & 31, ks = TIDX >> 5;
    for (int item = BIDX; item < 2 * 6 * D / 32; item += gridDim.x) {
        const int l = item / (6 * D / 32), j = (item % (6 * D / 32)) * 32 + col;
        const float* w = p.in[I_WMOD] + (size_t)l * D * 6 * D + j;
        float acc[9];
#pragma unroll
        for (int bb = 0; bb < 9; ++bb) acc[bb] = 0.f;
        for (int k = ks * 128; k < ks * 128 + 128; ++k) {
            const float wv = w[(size_t)k * 6 * D];
#pragma unroll
            for (int bb = 0; bb < 9; ++bb) acc[bb] += lds[bb * D + k] * wv;
        }
#pragma unroll
        for (int bb = 0; bb < 9; ++bb) red[(bb * 8 + ks) * 32 + col] = acc[bb];
        __syncthreads();
        for (int o = TIDX; o < 9 * 32; o += NT) {
            const int bb = o >> 5, c2 = o & 31;
            float sum = p.in[I_BMOD][l * 6 * D + (item % (6 * D / 32)) * 32 + c2];
#pragma unroll
            for (int q = 0; q < 8; ++q) sum += red[(bb * 8 + q) * 32 + c2];
            mod[(size_t)(l * 9 + bb) * 6 * D + (item % (6 * D / 32)) * 32 + c2] = sum;
        }
        __syncthreads();
    }
}

__device__ __forceinline__ void st_norm(const P& p, int l, int which) {
    const int lane = TIDX & 63, wv = TIDX >> 6;
    const int nrows = (which == 1 && l == 1) ? TL : TA;
    float* xn = (float*)(p.ws + WS_BUFA);
    const float* g = p.in[which == 0 ? I_N1G : I_N2G] + l * D;
    for (int r = BIDX * 4 + wv; r < nrows; r += gridDim.x * 4) {
        const float* src = which == 0 ? h_row(p, l, r) : hmid_row(p, r);
        const int bb = row_bb(r);
        const float* sh = mod_vec(p, l, bb, which == 0 ? 0 : 3);
        const float* sc = mod_vec(p, l, bb, which == 0 ? 1 : 4);
        float4 v[4];
        float s = 0.f;
#pragma unroll
        for (int j = 0; j < 4; ++j) { v[j] = *(const float4*)(src + j * 256 + lane * 4); s += v[j].x * v[j].x + v[j].y * v[j].y + v[j].z * v[j].z + v[j].w * v[j].w; }
        s = wave_sum(s);
        const float rinv = rsqrtf(s * (1.f / D) + 1e-6f);
#pragma unroll
        for (int j = 0; j < 4; ++j) {
            const int k = j * 256 + lane * 4;
            const float4 gg = *(const float4*)(g + k), s1 = *(const float4*)(sc + k), s0 = *(const float4*)(sh + k);
            float4 o;
            o.x = v[j].x * rinv * gg.x * (1.f + s1.x) + s0.x;
            o.y = v[j].y * rinv * gg.y * (1.f + s1.y) + s0.y;
            o.z = v[j].z * rinv * gg.z * (1.f + s1.z) + s0.z;
            o.w = v[j].w * rinv * gg.w * (1.f + s1.w) + s0.w;
            if (which == 1) *(float4*)(xn + (size_t)r * D + k) = o;
            else { uint2 pk; pk.x = (unsigned)f2bf(o.x) | ((unsigned)f2bf(o.y) << 16); pk.y = (unsigned)f2bf(o.z) | ((unsigned)f2bf(o.w) << 16);
                   *(uint2*)((bf16_t*)(p.ws + WS_BUFA) + (size_t)r * D + k) = pk; }
        }
    }
}


__device__ __forceinline__ void bf8_to_f(const u32x4& v, float (&f)[8]) {
#pragma unroll
    for (int q = 0; q < 4; ++q) { f[2 * q] = __uint_as_float(v[q] << 16); f[2 * q + 1] = __uint_as_float(v[q] & 0xffff0000u); }
}
__device__ __forceinline__ void st_conv(const P& p, int l) {
    const bf16_t* pb = (const bf16_t*)(p.ws + WS_PC);
    bf16_t* mix = (bf16_t*)(p.ws + WS_BUFA);
    const float* cw = p.in[I_CONVW] + l * 3 * DCONV;
    const int nrows = l == 0 ? TA : TL;
    for (int idx = BIDX * NT + TIDX; idx < nrows * 32; idx += gridDim.x * NT) {
        const int r = idx >> 5, ch = (idx & 31) * 8;
        int t, len;
        if (r < TL) { t = r & (L - 1); len = L; } else { t = (r - TL) & (LC - 1); len = LC; }
        const bf16_t* pr = pb + (size_t)r * 768 + ch;
        float x[8], c[8], bgate[8], y[8];
        bf8_to_f(*(const u32x4*)(pr), x); bf8_to_f(*(const u32x4*)(pr + 512), c); bf8_to_f(*(const u32x4*)(pr + 256), bgate);
        const f32x4 w1a = *(const f32x4*)(cw + DCONV + ch), w1b = *(const f32x4*)(cw + DCONV + ch + 4);
#pragma unroll
        for (int q = 0; q < 8; ++q) y[q] = (q < 4 ? w1a[q] : w1b[q - 4]) * (c[q] * x[q]);
        if (t > 0) {
            bf8_to_f(*(const u32x4*)(pr - 768), x); bf8_to_f(*(const u32x4*)(pr - 768 + 512), c);
            const f32x4 wa = *(const f32x4*)(cw + ch), wb = *(const f32x4*)(cw + ch + 4);
#pragma unroll
            for (int q = 0; q < 8; ++q) y[q] += (q < 4 ? wa[q] : wb[q - 4]) * (c[q] * x[q]);
        }
        if (t < len - 1) {
            bf8_to_f(*(const u32x4*)(pr + 768), x); bf8_to_f(*(const u32x4*)(pr + 768 + 512), c);
            const f32x4 wa = *(const f32x4*)(cw + 2 * DCONV + ch), wb = *(const f32x4*)(cw + 2 * DCONV + ch + 4);
#pragma unroll
            for (int q = 0; q < 8; ++q) y[q] += (q < 4 ? wa[q] : wb[q - 4]) * (c[q] * x[q]);
        }
        u32x4 o;
#pragma unroll
        for (int q = 0; q < 4; ++q) o[q] = cvt_pk_bf16(bgate[2 * q] * y[2 * q], bgate[2 * q + 1] * y[2 * q + 1]);
        *(u32x4*)(mix + (size_t)r * D + ch) = o;
    }
}

struct EpiOut { const float* modl; const float* hlat; const float* hctx; float* out; float* hcmid;
    __device__ __forceinline__ void operator()(int r, int c, float v0, float v1, float v2, float v3) const {
    const int bb = row_bb(r);
    const f32x4 g1 = *(const f32x4*)(modl + ((size_t)bb * 6 + 2) * D + c);
    const f32x4 hv = *(const f32x4*)((r < TL ? hlat + (size_t)r * D : hctx + (size_t)(r - TL) * D) + c);
    f32x4 o; o[0] = hv[0] + g1[0] * v0; o[1] = hv[1] + g1[1] * v1; o[2] = hv[2] + g1[2] * v2; o[3] = hv[3] + g1[3] * v3;
    *(f32x4*)((r < TL ? out + (size_t)r * D : hcmid + (size_t)(r - TL) * D) + c) = o; } };
__device__ __forceinline__ EpiOut make_epi_out(const P& p, int l) {
    return EpiOut{(const float*)(p.ws + WS_MOD) + (size_t)l * 9 * 6 * D, l == 0 ? p.in[I_X] : p.out, l == 0 ? p.in[I_CTX] : (const float*)(p.ws + WS_HC1), p.out, (float*)(p.ws + WS_HCMID)};
}

typedef __attribute__((ext_vector_type(8))) short bf16x8;
typedef __attribute__((ext_vector_type(16))) float f32x16;
constexpr int G_STAGEB = 16384;
constexpr int G_NSTG = 4;
constexpr int LDS_BYTES = G_NSTG * G_STAGEB;

template <class ARow>
__device__ __forceinline__ void gemm_tile(f32x16 (&acc)[2][2], ARow arow, const bf16_t* Bt, int ldb, int K, unsigned char* lds) {
    const int t = TIDX, lane = t & 63, w = __builtin_amdgcn_readfirstlane(t >> 6), wr = w >> 1, wc = w & 1, lr = lane & 31, lh = lane >> 5;
    const int srow = t >> 2, lc = (t & 3) ^ ((srow >> 2) & 3);
    const bf16_t* ap[2]; const bf16_t* bp[2];
#pragma unroll
    for (int i = 0; i < 2; ++i) { ap[i] = arow(srow + 64 * i) + lc * 8; bp[i] = Bt + (size_t)(srow + 64 * i) * ldb + lc * 8; }
    float zf = 0.f; asm volatile("" : "+v"(zf));
#pragma unroll
    for (int mi = 0; mi < 2; ++mi)
#pragma unroll
        for (int ni = 0; ni < 2; ++ni)
#pragma unroll
            for (int r = 0; r < 16; ++r) acc[mi][ni][r] = zf;
    const int nk = K >> 5;
    LAS unsigned char* l3 = (LAS unsigned char*)lds;
    const int f = (lr >> 2) & 3;
    const int aoff = (wr * 64 + lr) * 64 + ((lh ^ f) << 4), boff = 8192 + (wc * 64 + lr) * 64 + ((lh ^ f) << 4);
#define G_ISSUE(ks) do { LAS unsigned char* d_ = l3 + ((ks) & 3) * G_STAGEB + w * 1024; \
        __builtin_amdgcn_global_load_lds((const unsigned*)(ap[0] + (ks) * 32), (LAS unsigned*)(d_), 16, 0, 0); \
        __builtin_amdgcn_global_load_lds((const unsigned*)(ap[1] + (ks) * 32), (LAS unsigned*)(d_ + 4096), 16, 0, 0); \
        __builtin_amdgcn_global_load_lds((const unsigned*)(bp[0] + (ks) * 32), (LAS unsigned*)(d_ + 8192), 16, 0, 0); \
        __builtin_amdgcn_global_load_lds((const unsigned*)(bp[1] + (ks) * 32), (LAS unsigned*)(d_ + 12288), 16, 0, 0); } while (0)
#define G_RD(A0, A1, B0, B1, slot, s2) do { const LAS unsigned char* c_ = l3 + (slot) * G_STAGEB; \
        A0 = *(const LAS bf16x8*)(c_ + (aoff ^ ((s2) << 5))); A1 = *(const LAS bf16x8*)(c_ + ((aoff + 2048) ^ ((s2) << 5))); \
        B0 = *(const LAS bf16x8*)(c_ + (boff ^ ((s2) << 5))); B1 = *(const LAS bf16x8*)(c_ + ((boff + 2048) ^ ((s2) << 5))); } while (0)
#define G_MM(A0, A1, B0, B1) do { \
        acc[0][0] = __builtin_amdgcn_mfma_f32_32x32x16_bf16(B0, A0, acc[0][0], 0, 0, 0); acc[0][1] = __builtin_amdgcn_mfma_f32_32x32x16_bf16(B1, A0, acc[0][1], 0, 0, 0); \
        acc[1][0] = __builtin_amdgcn_mfma_f32_32x32x16_bf16(B0, A1, acc[1][0], 0, 0, 0); acc[1][1] = __builtin_amdgcn_mfma_f32_32x32x16_bf16(B1, A1, acc[1][1], 0, 0, 0); } while (0)
    __syncthreads();
    G_ISSUE(0);
    if (1 < nk) G_ISSUE(1);
    if (2 < nk) G_ISSUE(2);
    if (2 < nk) asm volatile("s_waitcnt vmcnt(8)" ::: "memory"); else if (1 < nk) asm volatile("s_waitcnt vmcnt(4)" ::: "memory"); else asm volatile("s_waitcnt vmcnt(0)" ::: "memory");
    __builtin_amdgcn_s_barrier();
    if (3 < nk) G_ISSUE(3);
    bf16x8 fa0, fa1, fb0, fb1, ga0, ga1, gb0, gb1;
    G_RD(fa0, fa1, fb0, fb1, 0, 0);
    for (int ks = 0; ks < nk; ++ks) {
        G_RD(ga0, ga1, gb0, gb1, ks & 3, 1);
        __builtin_amdgcn_sched_barrier(0);
        asm volatile("s_waitcnt lgkmcnt(4)" ::: "memory");
        __builtin_amdgcn_sched_barrier(0);
        G_MM(fa0, fa1, fb0, fb1);
        __builtin_amdgcn_sched_barrier(0);
        if (ks + 1 < nk) {
            if (ks + 3 < nk) asm volatile("s_waitcnt vmcnt(8) lgkmcnt(0)" ::: "memory");
            else if (ks + 2 < nk) asm volatile("s_waitcnt vmcnt(4) lgkmcnt(0)" ::: "memory");
            else asm volatile("s_waitcnt vmcnt(0) lgkmcnt(0)" ::: "memory");
            __builtin_amdgcn_s_barrier();
            if (ks + 4 < nk) G_ISSUE(ks + 4);
            G_RD(fa0, fa1, fb0, fb1, (ks + 1) & 3, 0);
        } else {
            asm volatile("s_waitcnt lgkmcnt(0)" ::: "memory");
        }
        __builtin_amdgcn_sched_barrier(0);
        G_MM(ga0, ga1, gb0, gb1);
        __builtin_amdgcn_sched_barrier(0);
    }
#undef G_RD
#undef G_MM
#undef G_ISSUE
}
template <class F>
__device__ __forceinline__ void acc_foreach4(const f32x16 (&acc)[2][2], F f) {
    const int lane = TIDX & 63, w = (TIDX >> 6) & 3, wr = w >> 1, wc = w & 1, lr = lane & 31, lh = lane >> 5;
#pragma unroll
    for (int mi = 0; mi < 2; ++mi)
#pragma unroll
        for (int ni = 0; ni < 2; ++ni)
#pragma unroll
            for (int g = 0; g < 4; ++g)
                f(wr * 64 + mi * 32 + lr, wc * 64 + ni * 32 + 8 * g + 4 * lh, acc[mi][ni][4 * g], acc[mi][ni][4 * g + 1], acc[mi][ni][4 * g + 2], acc[mi][ni][4 * g + 3]);
}
constexpr int C_LD = 132;
template <class F>
__device__ __forceinline__ void acc_foreach4_lds(const f32x16 (&acc)[2][2], unsigned char* lds, F f) {
    float* C = (float*)lds;
    const int t = TIDX, lane = t & 63, w = (t >> 6) & 3, wr = w >> 1, wc = w & 1, lr = lane & 31, lh = lane >> 5;
    __syncthreads();
#pragma unroll
    for (int mi = 0; mi < 2; ++mi)
#pragma unroll
        for (int ni = 0; ni < 2; ++ni)
#pragma unroll
            for (int g = 0; g < 4; ++g) {
                f32x4 v; v[0] = acc[mi][ni][4 * g]; v[1] = acc[mi][ni][4 * g + 1]; v[2] = acc[mi][ni][4 * g + 2]; v[3] = acc[mi][ni][4 * g + 3];
                *(f32x4*)(C + (wr * 64 + mi * 32 + lr) * C_LD + wc * 64 + ni * 32 + 8 * g + 4 * lh) = v;
            }
    __syncthreads();
#pragma unroll 4
    for (int i = 0; i < 16; ++i) {
        const int idx = t + 256 * i, r = idx >> 5, c = (idx & 31) * 4;
        const f32x4 v = *(const f32x4*)(C + r * C_LD + c);
        f(r, c, v[0], v[1], v[2], v[3]);
    }
}
__device__ __forceinline__ uint2 pack4(float a, float b, float c, float d) { uint2 o; o.x = cvt_pk_bf16(a, b); o.y = cvt_pk_bf16(c, d); return o; }
struct ARowPlain { const bf16_t* A; int lda; __device__ __forceinline__ const bf16_t* operator()(int m) const { return A + (size_t)m * lda; } };

template <class Epi>
__device__ __forceinline__ void gemm_stage(const bf16_t* A, int lda, const bf16_t* Bt, int ldb, int M, int N, int K, Epi epi, unsigned char* lds) {
    const int tn = N / 128, tm = M / 128;
    int t_end, t_step;
    for (int tile = xcd_first(tm * tn, t_end, t_step); tile < t_end; tile += t_step) {
        const int m0 = (tile / tn) * 128, n0 = (tile % tn) * 128;
        f32x16 acc[2][2];
        gemm_tile(acc, ARowPlain{A + (size_t)m0 * lda, lda}, Bt + (size_t)n0 * ldb, ldb, K, lds);
        acc_foreach4_lds(acc, lds, [&](int r, int c, float v0, float v1, float v2, float v3) { epi(m0 + r, n0 + c, v0, v1, v2, v3); });
    }
}
__device__ __forceinline__ void tr_item(const float* src, size_t sk, bf16_t* dst, size_t dld, bf16_t* tl) {
    const int t = TIDX, kr = t >> 3, nq = (t & 7) * 4;
    __syncthreads();
#pragma unroll
    for (int ps = 0; ps < 4; ++ps) {
        const f32x4 v = *(const f32x4*)(src + (size_t)(kr + 32 * ps) * sk + nq);
#pragma unroll
        for (int j = 0; j < 4; ++j) tl[(nq + j) * 136 + kr + 32 * ps] = f2bf(v[j]);
    }
    __syncthreads();
    const int n = t >> 3, part = t & 7;
    const u32x4 a = *(const u32x4*)(tl + n * 136 + part * 16), b = *(const u32x4*)(tl + n * 136 + part * 16 + 8);
    bf16_t* o = dst + (size_t)n * dld + part * 16;
    *(u32x4*)o = a; *(u32x4*)(o + 8) = b;
}
__device__ __forceinline__ void st_prep_weights(const P& p, int l, unsigned char* lds) {
    bf16_t* tl = (bf16_t*)lds;
    constexpr int N_IN_ = (DIN / 32) * 8, N_OUT = (D / 32) * 8, N_GLU = (DSSM / 32) * 2, N_GU = 33 * 2 * 4 * 8, N_DN = 33 * (D / 32);
    constexpr int TOT = N_IN_ + N_OUT + N_GLU + N_GU + N_DN;
    for (int it = BIDX; it < TOT; it += gridDim.x) {
        int r = it;
        if (r < N_IN_) { const int nt = r >> 3, kt = r & 7; tr_item(p.in[I_WIN] + (size_t)l * D * DIN + (size_t)kt * 128 * DIN + nt * 32, DIN, (bf16_t*)(p.ws + WS_WTIN) + (size_t)nt * 32 * D + kt * 128, D, tl); continue; }
        r -= N_IN_;
        if (r < N_OUT) { const int nt = r >> 3, kt = r & 7; tr_item(p.in[I_WOUT] + (size_t)l * D * D + (size_t)kt * 128 * D + nt * 32, D, (bf16_t*)(p.ws + WS_WTOUT) + (size_t)nt * 32 * D + kt * 128, D, tl); continue; }
        r -= N_OUT;
        if (r < N_GLU) { const int nt = r >> 1, kt = r & 1; tr_item(p.in[I_WGLU] + (size_t)l * DSSM * DSSM + (size_t)kt * 128 * DSSM + nt * 32, DSSM, (bf16_t*)(p.ws + WS_WTGLU) + (size_t)nt * 32 * DSSM + kt * 128, DSSM, tl); continue; }
        r -= N_GLU;
        if (r < N_GU) {
            const int kt = r & 7, q = (r >> 3) & 3, j = (r >> 5) & 1, e = r >> 6;
            const int wc = q >> 1, ni = q & 1, unit0 = j * 64 + wc * 32;
            const float* sp; size_t sk;
            if (e < NE) { sp = p.in[ni ? I_WEU : I_WEG] + ((size_t)(l * D + kt * 128) * NE + e) * DE + unit0; sk = (size_t)NE * DE; }
            else { sp = p.in[ni ? I_WSU : I_WSG] + (size_t)(l * D + kt * 128) * DE + unit0; sk = DE; }
            tr_item(sp, sk, (bf16_t*)(p.ws + WS_WGU) + ((size_t)(e * 2 + j) * 128 + q * 32) * D + kt * 128, D, tl); continue;
        }
        r -= N_GU;
        {
            const int nt = r & 31, e = r >> 5;
            const float* sp = (e < NE ? p.in[I_WED] + (size_t)(l * NE + e) * DE * D : p.in[I_WSD] + (size_t)l * DE * D) + nt * 32;
            tr_item(sp, D, (bf16_t*)(p.ws + WS_WD) + ((size_t)e * D + nt * 32) * DE, DE, tl);
        }
    }
    __syncthreads();
}
struct EpiStoreBf { bf16_t* C; int ldc; __device__ __forceinline__ void operator()(int r, int c, float v0, float v1, float v2, float v3) const { *(uint2*)(C + (size_t)r * ldc + c) = pack4(v0, v1, v2, v3); } };


__device__ __forceinline__ void st_rbias(const P& p, int l, float* lds) {
    const int lane = TIDX & 63, w = TIDX >> 6;
    const float* rw = p.in[I_RW] + (size_t)l * D * NE;
    for (int o = BIDX * 4 + w; o < 9 * 32; o += gridDim.x * 4) {
        const int bb = o >> 5, e = o & 31;
        const float* sh2 = mod_vec(p, l, bb, 3);
        float a = 0.f;
#pragma unroll
        for (int j = 0; j < 16; ++j) { const int k = j * 64 + lane; a += sh2[k] * rw[(size_t)k * NE + e]; }
        a = wave_sum(a);
        if (lane == 0) ((float*)(p.ws + WS_RBIAS))[(l * 9 + bb) * 32 + e] = a;
    }
    const float* g2 = p.in[I_N2G] + l * D;
    for (int idx = BIDX * NT + TIDX; idx < 9 * D; idx += gridDim.x * NT) {
        const int bb = idx >> 10, k = idx & (D - 1);
        ((float*)(p.ws + WS_GS2))[(size_t)(l * 9 + bb) * D + k] = g2[k] * (1.f + mod_vec(p, l, bb, 4)[k]);
    }
}
template <bool DRY = false>
__device__ __forceinline__ void st_router2(const P& p, int l, unsigned char* ldsb) {
    float* part = (float*)ldsb;
    float* ssq = part + 4 * 32 * 33;
    float* sc = ssq + 128;
    float* rinvs = sc + 32 * 33;
    int* hist = (int*)(rinvs + 32);
    int* gbase = hist + 32;
    const int t = TIDX, lane = t & 63, w = t >> 6, i = lane & 31, hf = lane >> 5;
    const int nrows = l == 0 ? TA : TL;
    const float* rw = p.in[I_RW] + (size_t)l * D * NE;
    int* cnt = CNT_PTR(p, l);
    int* lcode = (int*)(p.ws + WS_LCODE);
    float* lw = (float*)(p.ws + WS_LW);
    bf16_t* xn2 = (bf16_t*)(p.ws + WS_BUFA);
    for (int item = BIDX; item < nrows / 32; item += gridDim.x) {
        const int r0 = item * 32, bb = row_bb(r0);
        const float* gs2 = (const float*)(p.ws + WS_GS2) + (size_t)(l * 9 + bb) * D;
        const float* sh2 = mod_vec(p, l, bb, 3);
        const int kb = w * 256 + hf * 128;
        const float* src = hmid_row(p, r0 + i) + kb;
        const float* gsp = gs2 + kb;
        const float* rwp = rw + (size_t)kb * NE + i;
        f32x16 acc;
        float zf = 0.f; asm volatile("" : "+v"(zf));
#pragma unroll
        for (int r = 0; r < 16; ++r) acc[r] = zf;
        float ss = 0.f;
        f32x4 xa[4], ga[4], xb[4], gb[4]; float wa[16], wb[16];
#define R_LOAD(X, G, W, cb) do { _Pragma("unroll") for (int q = 0; q < 4; ++q) { const int k = ((cb) * 4 + q) * 4; X[q] = *(const f32x4*)(src + k); G[q] = *(const f32x4*)(gsp + k); \
            _Pragma("unroll") for (int j = 0; j < 4; ++j) W[q * 4 + j] = rwp[(size_t)(k + j) * NE]; } } while (0)
#define R_COMP(X, G, W) do { _Pragma("unroll") for (int q = 0; q < 4; ++q) { ss += X[q][0] * X[q][0] + X[q][1] * X[q][1] + X[q][2] * X[q][2] + X[q][3] * X[q][3]; \
            _Pragma("unroll") for (int j = 0; j < 4; ++j) acc = __builtin_amdgcn_mfma_f32_32x32x2f32(X[q][j] * G[q][j], W[q * 4 + j], acc, 0, 0, 0); } } while (0)
        R_LOAD(xa, ga, wa, 0);
#pragma unroll 1
        for (int cb = 0; cb < 8; cb += 2) {
            R_LOAD(xb, gb, wb, cb + 1);
            R_COMP(xa, ga, wa);
            if (cb + 2 < 8) R_LOAD(xa, ga, wa, cb + 2);
            R_COMP(xb, gb, wb);
        }
#undef R_LOAD
#undef R_COMP
        ss += __shfl_xor(ss, 32);
        __syncthreads();
        if (hf == 0) ssq[w * 32 + i] = ss;
        if (t < 32) hist[t] = 0;
#pragma unroll
        for (int r = 0; r < 16; ++r) part[(w * 32 + (r & 3) + 8 * (r >> 2) + 4 * hf) * 33 + i] = acc[r];
        __syncthreads();
        for (int idx = t; idx < 1024; idx += NT) {
            const int row = idx >> 5, e = idx & 31;
            const float logit = part[(0 * 32 + row) * 33 + e] + part[(1 * 32 + row) * 33 + e] + part[(2 * 32 + row) * 33 + e] + part[(3 * 32 + row) * 33 + e];
            const float rinv = rsqrtf((ssq[row] + ssq[32 + row] + ssq[64 + row] + ssq[96 + row]) * (1.f / D) + 1e-6f);
            sc[row * 33 + e] = sigmoid_f(rinv * logit + ((const float*)(p.ws + WS_RBIAS))[(l * 9 + bb) * 32 + e]);
            if (e == 0) rinvs[row] = rinv;
        }
        __syncthreads();
        if (t < 32) {
            const int r = r0 + t;
            float sel[32];
#pragma unroll
            for (int e = 0; e < 32; ++e) sel[e] = sc[t * 33 + e] + p.in[I_RB][l * NE + e];
            int bi[4]; float sv[4]; float sum = 0.f;
#pragma unroll
            for (int k = 0; k < 4; ++k) {
                float best = -1e30f; int b = 0;
#pragma unroll
                for (int e = 0; e < 32; ++e) if (sel[e] > best) { best = sel[e]; b = e; }
#pragma unroll
                for (int e = 0; e < 32; ++e) if (e == b) sel[e] = -1e30f;
                bi[k] = b; sv[k] = sc[t * 33 + b]; sum += sv[k];
            }
            int rank[4];
#pragma unroll
            for (int k = 0; k < 4; ++k) rank[k] = atomicAdd(&hist[bi[k]], 1);
            __builtin_amdgcn_s_waitcnt(0xc07f);
            __builtin_amdgcn_wave_barrier();
            { const int hc = hist[t]; gbase[t] = (hc > 0 && !DRY) ? atomicAdd(&cnt[t * 64], hc) : 0; }
            __builtin_amdgcn_s_waitcnt(0xc07f);
            __builtin_amdgcn_wave_barrier();
#pragma unroll
            for (int k = 0; k < 4; ++k) {
                if (DRY) { if (sv[k] / sum == 12345.f) lw[0] = 0.f; } else {
                const int pos = gbase[bi[k]] + rank[k];
                lcode[(size_t)bi[k] * TA + pos] = r * 4 + k;
                lw[(size_t)bi[k] * TA + pos] = sv[k] / sum * 2.5f; }
            }
        }
        {
            float gs[16], sh[16];
#pragma unroll
            for (int q = 0; q < 16; ++q) { const int k = (q >> 3) * 512 + 8 * lane + (q & 7); gs[q] = gs2[k]; sh[q] = sh2[k]; }
            for (int rr8 = 0; rr8 < 8; ++rr8) {
                const int rho = w * 8 + rr8;
                const float rr = rinvs[rho];
                const float* s2 = hmid_row(p, r0 + rho);
                bf16_t* dst = xn2 + (size_t)(r0 + rho) * D;
#pragma unroll
                for (int h2 = 0; h2 < 2; ++h2) {
                    const f32x4 x0 = *(const f32x4*)(s2 + h2 * 512 + 8 * lane), x1 = *(const f32x4*)(s2 + h2 * 512 + 8 * lane + 4);
                    u32x4 o;
                    o[0] = cvt_pk_bf16(x0[0] * rr * gs[h2 * 8 + 0] + sh[h2 * 8 + 0], x0[1] * rr * gs[h2 * 8 + 1] + sh[h2 * 8 + 1]);
                    o[1] = cvt_pk_bf16(x0[2] * rr * gs[h2 * 8 + 2] + sh[h2 * 8 + 2], x0[3] * rr * gs[h2 * 8 + 3] + sh[h2 * 8 + 3]);
                    o[2] = cvt_pk_bf16(x1[0] * rr * gs[h2 * 8 + 4] + sh[h2 * 8 + 4], x1[1] * rr * gs[h2 * 8 + 5] + sh[h2 * 8 + 5]);
                    o[3] = cvt_pk_bf16(x1[2] * rr * gs[h2 * 8 + 6] + sh[h2 * 8 + 6], x1[3] * rr * gs[h2 * 8 + 7] + sh[h2 * 8 + 7]);
                    *(u32x4*)(dst + h2 * 512 + 8 * lane) = o;
                }
            }
        }
    }
    __syncthreads();
}

constexpr int LDS_CSTAGE = 128 * C_LD * 4;
constexpr int MOE_LDS_LIST = LDS_CSTAGE;
constexpr int LDS_MOE = LDS_CSTAGE + 128 * 4 + 128 * 4 + 64 * 4;
constexpr int LDS_MODB = (9 * D + 9 * 8 * 32) * 4;
constexpr int LDS_TOTAL = LDS_MOE > LDS_MODB ? LDS_MOE : LDS_MODB;
struct ARowCode { const bf16_t* base; const int* codes; int mode; __device__ __forceinline__ const bf16_t* operator()(int m) const {
    const int c = codes[m];
    if (mode == 0) return base + (size_t)(c < 0 ? 0 : (c >> 2)) * D;
    return base + (size_t)(c < 0 ? 0 : (c >> 2) * 5 + (c & 3)) * DE; } };
__device__ __forceinline__ void moe_tstart(const P& p, int l, int* ts) {
    if (TIDX == 0) { const int* cnt = CNT_PTR(p, l); int a = 0; for (int e = 0; e < NE; ++e) { ts[e] = a; a += (cnt[e * 64] + 127) >> 7; } ts[NE] = a; }
    __syncthreads();
}
__device__ __forceinline__ void st_moe1(const P& p, int l, unsigned char* lds) {
    int* codes = (int*)(lds + MOE_LDS_LIST); float* wts = (float*)(codes + 128); int* ts = (int*)(wts + 128);
    const int nrows = l == 0 ? TA : TL;
    const int* cnt = CNT_PTR(p, l);
    const int* lcode = (const int*)(p.ws + WS_LCODE);
    const float* lw = (const float*)(p.ws + WS_LW);
    const bf16_t* xn2 = (const bf16_t*)(p.ws + WS_BUFA);
    bf16_t* hid = (bf16_t*)(p.ws + WS_HID);
    const bf16_t* wgu = (const bf16_t*)(p.ws + WS_WGU);
    moe_tstart(p, l, ts);
    const int nrt = ts[NE], nsh = nrows / 128, total = (nrt + nsh) * 2;
    const int lane = TIDX & 63, w = TIDX >> 6, wr = w >> 1, wc = w & 1, lr = lane & 31, lh = lane >> 5;
    int t_end, t_step;
    for (int tile = xcd_first(total, t_end, t_step); tile < t_end; tile += t_step) {
        const int rt = tile >> 1, j = tile & 1;
        int e, m0, valid;
        if (rt < nrt) { e = 0; while (ts[e + 1] <= rt) ++e; m0 = (rt - ts[e]) * 128; valid = cnt[e * 64] - m0; if (valid > 128) valid = 128; }
        else { e = NE; m0 = (rt - nrt) * 128; valid = 128; }
        __syncthreads();
        if (TIDX < 128) {
            const int m = TIDX;
            if (e < NE) { const bool ok = m < valid; codes[m] = ok ? lcode[(size_t)e * TA + m0 + m] : -1; wts[m] = ok ? lw[(size_t)e * TA + m0 + m] : 0.f; }
            else { codes[m] = (m0 + m) * 4; wts[m] = 1.f; }
        }
        __syncthreads();
        f32x16 acc[2][2];
        gemm_tile(acc, ARowCode{xn2, codes, 0}, wgu + (size_t)((e * 2 + j) * 128) * D, D, D, lds);
#pragma unroll
        for (int mi = 0; mi < 2; ++mi) {
            const int m = wr * 64 + mi * 32 + lr;
            const int c = codes[m];
            if (c >= 0) {
                const float wt = wts[m];
                const size_t hrow = e < NE ? (size_t)(c >> 2) * 5 + (c & 3) : (size_t)(c >> 2) * 5 + 4;
#pragma unroll
                for (int g = 0; g < 4; ++g) {
                    float h[4];
#pragma unroll
                    for (int q = 0; q < 4; ++q) h[q] = silu_f(acc[mi][0][4 * g + q]) * acc[mi][1][4 * g + q] * wt;
                    *(uint2*)(hid + hrow * DE + j * 64 + wc * 32 + 8 * g + 4 * lh) = pack4(h[0], h[1], h[2], h[3]);
                }
            }
        }
    }
}
__device__ __forceinline__ void st_moe2(const P& p, int l, unsigned char* lds) {
    int* codes = (int*)(lds + MOE_LDS_LIST); float* wts = (float*)(codes + 128); int* ts = (int*)(wts + 128);
    const int* cnt = CNT_PTR(p, l);
    const int* lcode = (const int*)(p.ws + WS_LCODE);
    const bf16_t* hid = (const bf16_t*)(p.ws + WS_HID);
    bf16_t* slab = (bf16_t*)(p.ws + WS_SLAB);
    const bf16_t* wd = (const bf16_t*)(p.ws + WS_WD);
    moe_tstart(p, l, ts);
    const int nrt = ts[NE], total = nrt * 8;
    int t_end, t_step;
    for (int tile = xcd_first(total, t_end, t_step); tile < t_end; tile += t_step) {
        const int rt = tile >> 3, n0 = (tile & 7) * 128;
        int e = 0; while (ts[e + 1] <= rt) ++e;
        const int m0 = (rt - ts[e]) * 128; int valid = cnt[e * 64] - m0; if (valid > 128) valid = 128;
        __syncthreads();
        if (TIDX < 128) { const int m = TIDX; codes[m] = m < valid ? lcode[(size_t)e * TA + m0 + m] : -1; }
        __syncthreads();
        f32x16 acc[2][2];
        gemm_tile(acc, ARowCode{hid, codes, 1}, wd + ((size_t)e * D + n0) * DE, DE, DE, lds);
        acc_foreach4_lds(acc, lds, [&](int r, int c, float v0, float v1, float v2, float v3) { const int code = codes[r]; if (code >= 0) *(uint2*)(slab + (size_t)code * D + n0 + c) = pack4(v0, v1, v2, v3); });
    }
}
struct EpiMoeF { const bf16_t* slab; const float* modl; float* out; const float* hcmid; float* hc1; bool outw = true;
    __device__ __forceinline__ void operator()(int r, int c, float v0, float v1, float v2, float v3) const {
    const bf16_t* sl = slab + (size_t)r * 4 * D + c;
    float v[4] = {v0, v1, v2, v3};
#pragma unroll
    for (int k = 0; k < 4; ++k) { const uint2 q = *(const uint2*)(sl + (size_t)k * D);
        v[0] += __uint_as_float(q.x << 16); v[1] += __uint_as_float(q.x & 0xffff0000u); v[2] += __uint_as_float(q.y << 16); v[3] += __uint_as_float(q.y & 0xffff0000u); }
    const f32x4 g2 = *(const f32x4*)(modl + ((size_t)row_bb(r) * 6 + 5) * D + c);
    const f32x4 hm = *(const f32x4*)((r < TL ? out + (size_t)r * D : hcmid + (size_t)(r - TL) * D) + c);
    f32x4 o; o[0] = hm[0] + g2[0] * v[0]; o[1] = hm[1] + g2[1] * v[1]; o[2] = hm[2] + g2[2] * v[2]; o[3] = hm[3] + g2[3] * v[3];
    if (outw) *(f32x4*)((r < TL ? out + (size_t)r * D : hc1 + (size_t)(r - TL) * D) + c) = o;
    else if (o[0] == 12345.f) *(f32x4*)(hc1) = o; } };
__device__ __forceinline__ EpiMoeF make_epi_moef(const P& p, int l) {
    return EpiMoeF{(const bf16_t*)(p.ws + WS_SLAB), (const float*)(p.ws + WS_MOD) + (size_t)l * 9 * 6 * D, p.out, (const float*)(p.ws + WS_HCMID), (float*)(p.ws + WS_HC1)};
}
struct SsmPar { float lre, lim, dt; };
__device__ __forceinline__ SsmPar ssm_par(const P& p, int l, int dir, int g, int pp) {
    const int pi = ((l * 2 + dir) * SG + g) * SP + pp;
    SsmPar r; r.lre = p.in[I_LRE][pi]; r.lim = p.in[I_LIM][pi]; r.dt = expf(p.in[I_LDT][(l * 2 + dir) * SG + g]); return r;
}
__device__ __forceinline__ float2 ssm_pow(const SsmPar& q, float e) {
    const float mag = expf(e * q.lre * q.dt), ang = e * (q.lim * q.dt);
    return make_float2(mag * cosf(ang), mag * sinf(ang));
}
__device__ __forceinline__ float2 ssm_f(const SsmPar& q) {
    const float2 lb = ssm_pow(q, 1.f);
    const float nr = lb.x - 1.f, ni = lb.y, den = q.lre * q.lre + q.lim * q.lim;
    return make_float2((nr * q.lre + ni * q.lim) / den, (ni * q.lre - nr * q.lim) / den);
}
__device__ __forceinline__ float2 cmul(float2 a, float2 b) { return make_float2(a.x * b.x - a.y * b.y, a.x * b.y + a.y * b.x); }
__device__ __forceinline__ void st_ssm_tables(const P& p) {
    float2* pw = (float2*)(p.ws + WS_POW); float2* fb = (float2*)(p.ws + WS_FB);
    for (int idx = BIDX * NT + TIDX; idx < 2 * 2 * 16 * 33 * 64; idx += gridDim.x * NT) {
        const int pp = idx & 63; int q_ = idx >> 6; const int e = q_ % 33; q_ /= 33; const int g = q_ & 15, dir = (q_ >> 4) & 1, l = q_ >> 5;
        pw[idx] = ssm_pow(ssm_par(p, l, dir, g, pp), (float)e);
    }
    for (int idx = BIDX * NT + TIDX; idx < 2 * 2 * 16 * 64 * 16; idx += gridDim.x * NT) {
        const int h = idx & 15, pp = (idx >> 4) & 63, g = (idx >> 10) & 15, dir = (idx >> 14) & 1, l = idx >> 15;
        const size_t bi = ((size_t)((l * 2 + dir) * SG + g) * SP + pp) * 16 + h;
        fb[idx] = cmul(ssm_f(ssm_par(p, l, dir, g, pp)), make_float2(p.in[I_BRE][bi], p.in[I_BIM][bi]));
    }
}
__device__ __forceinline__ void st_ssm_kj(const P& p, float* lds) {
    float* lam = lds; float* Cc = lds + 128; float* Bb = Cc + 2048;
    float* kj = (float*)(p.ws + WS_KJ);
    const int t = TIDX;
    for (int item = (int)gridDim.x - 1 - BIDX; item < 64; item += gridDim.x) {
        const int l = item >> 5, g = (item >> 1) & 15, dir = item & 1;
        const int base = (l * 2 + dir) * SG + g;
        __syncthreads();
        if (t < 64) {
            const SsmPar q = ssm_par(p, l, dir, g, t);
            const float2 lb = ssm_pow(q, 1.f), f = ssm_f(q);
            lam[2 * t] = lb.x; lam[2 * t + 1] = lb.y;
            for (int h = 0; h < 16; ++h) {
                const size_t bi = ((size_t)base * SP + t) * 16 + h;
                const float2 bb = cmul(f, make_float2(p.in[I_BRE][bi], p.in[I_BIM][bi]));
                Bb[(t * 16 + h) * 2] = bb.x; Bb[(t * 16 + h) * 2 + 1] = bb.y;
            }
        }
        for (int i = t; i < 1024; i += NT) { const size_t ci = (size_t)base * 1024 + i; Cc[2 * i] = p.in[I_CRE][ci]; Cc[2 * i + 1] = p.in[I_CIM][ci]; }
        __syncthreads();
        const int ho = t >> 4, hi = t & 15;
        float acc[32];
#pragma unroll
        for (int j = 0; j < 32; ++j) acc[j] = 0.f;
        for (int pp = 0; pp < 64; ++pp) {
            float2 z = cmul(make_float2(Cc[(ho * 64 + pp) * 2], Cc[(ho * 64 + pp) * 2 + 1]), make_float2(Bb[(pp * 16 + hi) * 2], Bb[(pp * 16 + hi) * 2 + 1]));
            const float2 lb = make_float2(lam[2 * pp], lam[2 * pp + 1]);
#pragma unroll
            for (int j = 0; j < 32; ++j) { acc[j] += z.x; z = cmul(z, lb); }
        }
#pragma unroll
        for (int j = 0; j < 32; ++j) kj[((size_t)((l * 16 + g) * 2 + dir) * 32 + j) * 256 + ho * 16 + hi] = acc[j];
    }
    __syncthreads();
}
__device__ __forceinline__ void st_prep_ssm(const P& p, int l) {
    bf16_t* wst = (bf16_t*)(p.ws + WS_WST);
    for (int idx = BIDX * NT + TIDX; idx < 16 * 256 * 64; idx += gridDim.x * NT) {
        const int kc = idx & 63, n = (idx >> 6) & 255, g = idx >> 14;
        const int dir = n >> 7, c = (n >> 6) & 1, pp = n & 63, s = kc >> 1, h0 = (kc & 1) * 8;
        const int ldg = (l * 2 + dir) * 16 + g;
        const float2 coef = ((const float2*)(p.ws + WS_POW))[((size_t)ldg * 33 + (dir == 0 ? 31 - s : s)) * 64 + pp];
        const float2* fbp = (const float2*)(p.ws + WS_FB) + ((size_t)ldg * 64 + pp) * 16 + h0;
        float v[8];
#pragma unroll
        for (int j = 0; j < 8; ++j) { const float2 z = cmul(coef, fbp[j]); v[j] = c == 0 ? z.x : z.y; }
        u32x4 o; o[0] = cvt_pk_bf16(v[0], v[1]); o[1] = cvt_pk_bf16(v[2], v[3]); o[2] = cvt_pk_bf16(v[4], v[5]); o[3] = cvt_pk_bf16(v[6], v[7]);
        *(u32x4*)(wst + ((size_t)(g * 256 + n)) * 512 + kc * 8) = o;
    }
    bf16_t* kw = (bf16_t*)(p.ws + WS_KW);
    const float* kj = (const float*)(p.ws + WS_KJ);
    for (int idx = BIDX * NT + TIDX; idx < 16 * 512 * 96; idx += gridDim.x * NT) {
        const int kc = idx % 96, n = (idx / 96) & 511, g = idx / (96 * 512);
        const int tau = n >> 4, ho = n & 15;
        float v[8];
        if (kc < 64) {
            const int s = kc >> 1, hi0 = (kc & 1) * 8;
#pragma unroll
            for (int j = 0; j < 8; ++j) {
                float a = 0.f;
                if (s <= tau) a += kj[((size_t)((l * 16 + g) * 2 + 0) * 32 + (tau - s)) * 256 + ho * 16 + hi0 + j];
                if (s >= tau) a += kj[((size_t)((l * 16 + g) * 2 + 1) * 32 + (s - tau)) * 256 + ho * 16 + hi0 + j];
                if (s == tau && ho == hi0 + j) a += p.in[I_SD][l * DSSM + g * 16 + ho];
                v[j] = a;
            }
        } else {
            const int kk = (kc - 64) * 8, dir = kk >> 7, c = (kk >> 6) & 1, p0 = kk & 63;
            const int e = dir == 0 ? tau + 1 : 32 - tau;
            const float2* pwp = (const float2*)(p.ws + WS_POW) + ((size_t)((l * 2 + dir) * 16 + g) * 33 + e) * 64 + p0;
#pragma unroll
            for (int j = 0; j < 8; ++j) {
                const size_t ci = ((size_t)((l * 2 + dir) * SG + g) * 16 + ho) * SP + p0 + j;
                const float2 z = cmul(make_float2(p.in[I_CRE][ci], p.in[I_CIM][ci]), pwp[j]);
                v[j] = c == 0 ? z.x : -z.y;
            }
        }
        u32x4 o; o[0] = cvt_pk_bf16(v[0], v[1]); o[1] = cvt_pk_bf16(v[2], v[3]); o[2] = cvt_pk_bf16(v[4], v[5]); o[3] = cvt_pk_bf16(v[6], v[7]);
        *(u32x4*)(kw + ((size_t)(g * 512 + n)) * 768 + kc * 8) = o;
    }
}
__device__ __forceinline__ void st_ssm_egemm(const P& p, unsigned char* lds) {
    const bf16_t* ua = (const bf16_t*)(p.ws + WS_UA);
    const bf16_t* wst = (const bf16_t*)(p.ws + WS_WST);
    float* E = (float*)(p.ws + WS_E);
    int t_end, t_step;
    for (int tile = xcd_first(160, t_end, t_step); tile < t_end; tile += t_step) {
        const int nt = tile & 1, mt = (tile >> 1) % 5, g = tile / 10;
        f32x16 acc[2][2];
        gemm_tile(acc, ARowPlain{ua + (size_t)(g * 640 + mt * 128) * 768, 768}, wst + (size_t)(g * 256 + nt * 128) * 512, 512, 512, lds);
        acc_foreach4_lds(acc, lds, [&](int r, int c, float v0, float v1, float v2, float v3) { f32x4 o; o[0] = v0; o[1] = v1; o[2] = v2; o[3] = v3; *(f32x4*)(E + (size_t)(g * 640 + mt * 128 + r) * 256 + nt * 128 + c) = o; });
    }
}
__device__ __forceinline__ void st_ssm_carry(const P& p, int l) {
    bf16_t* ua = (bf16_t*)(p.ws + WS_UA);
    const float* E = (const float*)(p.ws + WS_E);
    for (int idx = BIDX * NT + TIDX; idx < NB * 16 * 2 * 64; idx += gridDim.x * NT) {
        const int pp = idx & 63, dir = (idx >> 6) & 1, g = (idx >> 7) & 15, b = idx >> 11;
        const float2 l32 = ((const float2*)(p.ws + WS_POW))[((size_t)((l * 2 + dir) * 16 + g) * 33 + 32) * 64 + pp];
        float2 S = make_float2(0.f, 0.f);
        for (int s0 = 0; s0 < 72; s0 += 8) {
            int ch[8]; float er[8], ei[8];
#pragma unroll
            for (int j = 0; j < 8; ++j) {
                const int step = s0 + j;
                if (dir == 0) ch[j] = step < 8 ? 512 + b * 8 + step : b * 64 + (step - 8);
                else ch[j] = step < 8 ? 512 + b * 8 + (7 - step) : b * 64 + (63 - (step - 8));
                const float* e = E + (size_t)(g * 640 + ch[j]) * 256 + dir * 128 + pp;
                er[j] = e[0]; ei[j] = e[64];
            }
#pragma unroll
            for (int j = 0; j < 8; ++j) {
                bf16_t* o = ua + (size_t)(g * 640 + ch[j]) * 768 + 512 + dir * 128 + pp;
                o[0] = f2bf(S.x); o[64] = f2bf(S.y);
                S = cmul(l32, S); S.x += er[j]; S.y += ei[j];
            }
        }
    }
}
__device__ __forceinline__ void st_ssm_ygemm(const P& p, int l, unsigned char* lds) {
    const bf16_t* ua = (const bf16_t*)(p.ws + WS_UA);
    const bf16_t* kw = (const bf16_t*)(p.ws + WS_KW);
    bf16_t* G = (bf16_t*)(p.ws + WS_G);
    const int nmt = l == 0 ? 5 : 4;
    int t_end, t_step;
    for (int tile = xcd_first(16 * nmt * 4, t_end, t_step); tile < t_end; tile += t_step) {
        const int nt = tile & 3, mt = (tile >> 2) % nmt, g = tile / (4 * nmt);
        f32x16 acc[2][2];
        gemm_tile(acc, ARowPlain{ua + (size_t)(g * 640 + mt * 128) * 768, 768}, kw + (size_t)(g * 512 + nt * 128) * 768, 768, 768, lds);
        acc_foreach4_lds(acc, lds, [&](int r, int c, float v0, float v1, float v2, float v3) {
            const int chunk = mt * 128 + r, n = nt * 128 + c;
            if (chunk < TA / 32) *(uint2*)(G + (size_t)(chunk * 32 + (n >> 4)) * DSSM + g * 16 + (n & 15)) = pack4(gelu_f(v0), gelu_f(v1), gelu_f(v2), gelu_f(v3)); });
    }
}
struct EpiGlu2 { const bf16_t* G; bf16_t* mix; const float* bias; __device__ __forceinline__ void operator()(int r, int c, float v0, float v1, float v2, float v3) const {
    const uint2 q = *(const uint2*)(G + (size_t)r * DSSM + c);
    const f32x4 b = *(const f32x4*)(bias + c);
    *(uint2*)(mix + (size_t)r * D + 256 + c) = pack4(__uint_as_float(q.x << 16) * sigmoid_f(v0 + b[0]), __uint_as_float(q.x & 0xffff0000u) * sigmoid_f(v1 + b[1]),
                                                     __uint_as_float(q.y << 16) * sigmoid_f(v2 + b[2]), __uint_as_float(q.y & 0xffff0000u) * sigmoid_f(v3 + b[3])); } };

constexpr float QSCALE = 0.125f * 1.4426950408889634f;
__device__ __forceinline__ void st_rope_table(const P& p) {
    float2* tab = (float2*)(p.ws + WS_ROPE);
    for (int idx = BIDX * NT + TIDX; idx < L * 32; idx += gridDim.x * NT) {
        const int t = idx >> 5, a = (idx >> 4) & 1, i = idx & 15;
        const float pos = a == 0 ? (float)(t / 64) : (float)(t % 64);
        const float ang = pos * powf(10000.f, -(float)i / 16.f);
        tab[idx] = make_float2(cosf(ang), sinf(ang));
    }
}
__device__ __forceinline__ void st_inproj(const P& p, int l, unsigned char* lds) {
    const bf16_t* A = (const bf16_t*)(p.ws + WS_BUFA);
    const bf16_t* Bt = (const bf16_t*)(p.ws + WS_WTIN);
    bf16_t* pc = (bf16_t*)(p.ws + WS_PC);
    bf16_t* ua = (bf16_t*)(p.ws + WS_UA);
    bf16_t* qb = (bf16_t*)(p.ws + WS_QB);
    bf16_t* kb = (bf16_t*)(p.ws + WS_KB);
    bf16_t* vt = (bf16_t*)(p.ws + WS_VT);
    const float2* rope = (const float2*)(p.ws + WS_ROPE);
    const int lane = TIDX & 63, w = TIDX >> 6, wr = w >> 1, wc = w & 1, lr = lane & 31, lh = lane >> 5;
    constexpr int TN = DIN / 128;
    int t_end, t_step;
    for (int tile = xcd_first((TA / 128) * TN, t_end, t_step); tile < t_end; tile += t_step) {
        const int tn = tile % TN, m0 = (tile / TN) * 128, n0 = tn * 128;
        f32x16 acc[2][2];
        gemm_tile(acc, ARowPlain{A + (size_t)m0 * D, D}, Bt + (size_t)n0 * D, D, D, lds);
        if (tn < 6) {
            acc_foreach4_lds(acc, lds, [&](int r, int c, float v0, float v1, float v2, float v3) { *(uint2*)(pc + (size_t)(m0 + r) * 768 + n0 + c) = pack4(v0, v1, v2, v3); });
        } else if (tn < 8) {
            acc_foreach4_lds(acc, lds, [&](int r, int c, float v0, float v1, float v2, float v3) { const int row = m0 + r, g = (tn - 6) * 8 + (c >> 4);
                *(uint2*)(ua + (size_t)(g * 640 + (row >> 5)) * 768 + (row & 31) * 16 + (c & 15)) = pack4(v0, v1, v2, v3); });
        } else if (tn < 13) {
            const bool isq = tn < 12;
            const float* gain = (isq ? p.in[I_QG] : p.in[I_KG]) + l * 64;
            const bool lat = m0 < TL;
            const float osc = isq ? QSCALE : 1.f;
#pragma unroll
            for (int mi = 0; mi < 2; ++mi) {
                const int row = m0 + wr * 64 + mi * 32 + lr;
                float ss = 0.f;
#pragma unroll
                for (int ni = 0; ni < 2; ++ni)
#pragma unroll
                    for (int r = 0; r < 16; ++r) ss += acc[mi][ni][r] * acc[mi][ni][r];
                ss += __shfl_xor(ss, 32);
                const float rinv = rsqrtf(ss * (1.f / 64.f) + 1e-6f) * osc;
                const int t = row & (L - 1);
                bf16_t* o = isq ? qb + (size_t)row * DATT + ((tn - 8) * 2 + wc) * 64 : kb + (size_t)row * 128 + wc * 64;
#pragma unroll
                for (int ni = 0; ni < 2; ++ni)
#pragma unroll
                    for (int g = 0; g < 2; ++g) {
                        const int d0 = ni * 32 + 8 * g + 4 * lh;
                        const f32x4 glo = *(const f32x4*)(gain + d0), ghi = *(const f32x4*)(gain + d0 + 16);
                        float t1[4], t2[4];
#pragma unroll
                        for (int q = 0; q < 4; ++q) { t1[q] = acc[mi][ni][4 * g + q] * rinv * glo[q]; t2[q] = acc[mi][ni][8 + 4 * g + q] * rinv * ghi[q]; }
                        if (lat) {
                            const float2* cs = rope + (t * 2 + ni) * 16 + 8 * g + 4 * lh;
                            const f32x4 c01 = *(const f32x4*)(cs), c23 = *(const f32x4*)(cs + 2);
                            const float cc[4] = {c01[0], c01[2], c23[0], c23[2]}, sn[4] = {c01[1], c01[3], c23[1], c23[3]};
#pragma unroll
                            for (int q = 0; q < 4; ++q) { const float a = t1[q], b = t2[q]; t1[q] = a * cc[q] - b * sn[q]; t2[q] = a * sn[q] + b * cc[q]; }
                        }
                        *(uint2*)(o + d0) = pack4(t1[0], t1[1], t1[2], t1[3]);
                        *(uint2*)(o + d0 + 16) = pack4(t2[0], t2[1], t2[2], t2[3]);
                    }
            }
        } else {
            acc_foreach4_lds(acc, lds, [&](int r, int c, float v0, float v1, float v2, float v3) { *(uint2*)(vt + (size_t)(m0 + r) * 128 + c) = pack4(v0, v1, v2, v3); });
        }
    }
}

constexpr int AT_KROWB = 144, AT_VROWB = 136, AT_VOFF = 64 * AT_KROWB;
__device__ __forceinline__ void st_attn2(const P& p, int l, unsigned char* lds, int part, int nparts) {
    const bf16_t* qb = (const bf16_t*)(p.ws + WS_QB);
    const bf16_t* kb = (const bf16_t*)(p.ws + WS_KB);
    const bf16_t* vb = (const bf16_t*)(p.ws + WS_VT);
    bf16_t* mix = (bf16_t*)(p.ws + WS_BUFA);
    const int t = TIDX, lane = t & 63, w = t >> 6, lr = lane & 31, lh = lane >> 5;
    constexpr int NLAT = NB * 32 * 2;
    const int nitems = NLAT + (l == 0 ? NB * 4 * 2 : 0);
    int t_end, t_step;
    for (int kk = xcd_first((nitems - part + nparts - 1) / nparts, t_end, t_step); kk < t_end; kk += t_step) {
        const int item = kk * nparts + part;
        const bool isctx = item >= NLAT;
        int b, q64, g;
        if (!isctx) { g = item & 1; q64 = (item >> 1) & 31; b = item >> 6; }
        else { const int it = item - NLAT; g = it & 1; q64 = (it >> 1) & 3; b = it >> 3; }
        const int hq = g * 4 + w;
        const int rq0 = isctx ? TL + b * LC + q64 * 64 : b * L + q64 * 64;
        bf16x8 qf[2][4];
#pragma unroll
        for (int qs = 0; qs < 2; ++qs)
#pragma unroll
            for (int s4 = 0; s4 < 4; ++s4) qf[qs][s4] = *(const bf16x8*)(qb + (size_t)(rq0 + qs * 32 + lr) * DATT + hq * 64 + s4 * 16 + lh * 8);
        const float sinkl = p.in[I_SINK][l * NQH + hq] * 1.4426950408889634f;
        float m[2] = {sinkl, sinkl};
        float lsum[2]; lsum[0] = lsum[1] = lh == 0 ? 1.f : 0.f;
        f32x16 o[2][2];
        float zf = 0.f; asm volatile("" : "+v"(zf));
#pragma unroll
        for (int qs = 0; qs < 2; ++qs)
#pragma unroll
            for (int dt = 0; dt < 2; ++dt)
#pragma unroll
                for (int r = 0; r < 16; ++r) o[qs][dt][r] = zf;
        const int nwin = isctx ? 0 : 5, nkt = nwin + 4;
        const int srow = t >> 3, kc = t & 7;
        u32x4 pk[2], pv[2];
        auto tile_row0 = [&](int kt, bool& win, bool& valid) -> int {
            if (kt < nwin) { win = true; const int k64 = q64 - 2 + kt; valid = (k64 >= 0 && k64 < 32); return b * L + k64 * 64; }
            win = false; valid = true; return TL + b * LC + (kt - nwin) * 64;
        };
        int kt = 0; bool win, valid; int krow0 = 0;
        for (; kt < nkt; ++kt) { krow0 = tile_row0(kt, win, valid); if (valid) break; }
#pragma unroll
        for (int i = 0; i < 2; ++i) { const size_t off = (size_t)(krow0 + srow + 32 * i) * 128 + g * 64 + kc * 8; pk[i] = *(const u32x4*)(kb + off); pv[i] = *(const u32x4*)(vb + off); }
        while (kt < nkt) {
            const bool cwin = win; const int ckrow0 = krow0;
            __syncthreads();
#pragma unroll
            for (int i = 0; i < 2; ++i) {
                const int row = srow + 32 * i;
                *(u32x4*)(lds + row * AT_KROWB + kc * 16) = pk[i];
                unsigned char* vd = lds + AT_VOFF + (kc * 8) * AT_VROWB + row * 2;
#pragma unroll
                for (int q = 0; q < 4; ++q) { *(bf16_t*)(vd + (2 * q) * AT_VROWB) = (bf16_t)(pv[i][q] & 0xffffu); *(bf16_t*)(vd + (2 * q + 1) * AT_VROWB) = (bf16_t)(pv[i][q] >> 16); }
            }
            int nkt2 = kt + 1; bool nwin2 = false, nvalid = false; int nrow0 = 0;
            for (; nkt2 < nkt; ++nkt2) { nrow0 = tile_row0(nkt2, nwin2, nvalid); if (nvalid) break; }
            if (nkt2 < nkt) {
#pragma unroll
                for (int i = 0; i < 2; ++i) { const size_t off = (size_t)(nrow0 + srow + 32 * i) * 128 + g * 64 + kc * 8; pk[i] = *(const u32x4*)(kb + off); pv[i] = *(const u32x4*)(vb + off); }
            }
            __syncthreads();
            const int j0t = ckrow0 - b * L;
#pragma unroll
            for (int sub = 0; sub < 2; ++sub) {
                bf16x8 kf[4];
#pragma unroll
                for (int s4 = 0; s4 < 4; ++s4) kf[s4] = *(const bf16x8*)(lds + (sub * 32 + lr) * AT_KROWB + s4 * 32 + lh * 16);
#pragma unroll
                for (int qs = 0; qs < 2; ++qs) {
                    bool partial = false;
                    if (cwin) {
                        const int j0 = j0t + sub * 32, i0 = q64 * 64 + qs * 32;
                        if (j0 > i0 + 31 + 128 || j0 + 31 < i0 - 128) continue;
                        partial = !(j0 >= i0 + 31 - 128 && j0 + 31 <= i0 + 128);
                    }
                    f32x16 sT;
#pragma unroll
                    for (int r = 0; r < 16; ++r) sT[r] = zf;
#pragma unroll
                    for (int s4 = 0; s4 < 4; ++s4) sT = __builtin_amdgcn_mfma_f32_32x32x16_bf16(kf[s4], qf[qs][s4], sT, 0, 0, 0);
                    if (partial) {
                        const int dj0 = j0t + sub * 32 + 4 * lh - (q64 * 64 + qs * 32 + lr);
#pragma unroll
                        for (int r = 0; r < 16; ++r) { const int dj = dj0 + (r & 3) + 8 * (r >> 2); if (dj > 128 || dj < -128) sT[r] = -1e30f; }
                    }
                    float mt = sT[0];
#pragma unroll
                    for (int r = 1; r < 16; ++r) mt = fmaxf(mt, sT[r]);
                    mt = fmaxf(mt, __shfl_xor(mt, 32));
                    const float mn = fmaxf(m[qs], mt);
                    const float alpha = __builtin_amdgcn_exp2f(m[qs] - mn);
                    m[qs] = mn;
                    float ps = 0.f;
#pragma unroll
                    for (int r = 0; r < 16; ++r) { sT[r] = __builtin_amdgcn_exp2f(sT[r] - mn); ps += sT[r]; }
                    lsum[qs] = lsum[qs] * alpha + ps;
#pragma unroll
                    for (int r = 0; r < 16; ++r) { o[qs][0][r] *= alpha; o[qs][1][r] *= alpha; }
#pragma unroll
                    for (int s2 = 0; s2 < 2; ++s2) {
                        u32x4 pkk;
                        pkk[0] = cvt_pk_bf16(sT[8 * s2 + 0], sT[8 * s2 + 1]); pkk[1] = cvt_pk_bf16(sT[8 * s2 + 2], sT[8 * s2 + 3]);
                        pkk[2] = cvt_pk_bf16(sT[8 * s2 + 4], sT[8 * s2 + 5]); pkk[3] = cvt_pk_bf16(sT[8 * s2 + 6], sT[8 * s2 + 7]);
                        const bf16x8 pf = __builtin_bit_cast(bf16x8, pkk);
#pragma unroll
                        for (int dt = 0; dt < 2; ++dt) {
                            const unsigned char* vp = lds + AT_VOFF + (dt * 32 + lr) * AT_VROWB + (sub * 32 + s2 * 16 + lh * 4) * 2;
                            const uint2 a = *(const uint2*)(vp), c2 = *(const uint2*)(vp + 16);
                            u32x4 vv; vv[0] = a.x; vv[1] = a.y; vv[2] = c2.x; vv[3] = c2.y;
                            o[qs][dt] = __builtin_amdgcn_mfma_f32_32x32x16_bf16(__builtin_bit_cast(bf16x8, vv), pf, o[qs][dt], 0, 0, 0);
                        }
                    }
                }
            }
            kt = nkt2; win = nwin2; krow0 = nrow0;
        }
#pragma unroll
        for (int qs = 0; qs < 2; ++qs) {
            const float lt = lsum[qs] + __shfl_xor(lsum[qs], 32);
            const float inv = 1.f / lt;
            bf16_t* orow = mix + (size_t)(rq0 + qs * 32 + lr) * D + 512 + hq * 64;
#pragma unroll
            for (int dt = 0; dt < 2; ++dt)
#pragma unroll
                for (int rg = 0; rg < 4; ++rg)
                    *(uint2*)(orow + dt * 32 + 8 * rg + 4 * lh) = pack4(o[qs][dt][4 * rg] * inv, o[qs][dt][4 * rg + 1] * inv, o[qs][dt][4 * rg + 2] * inv, o[qs][dt][4 * rg + 3] * inv);
        }
    }
}


constexpr int FAKE = 0;
constexpr int TIM = 0;
constexpr int PROBE3 = 0;
constexpr int PROBE2 = 0;
__device__ __forceinline__ void st_fake(const P& p, unsigned char* lds) {
    if (FAKE == 0) return;
    const bf16_t* A = (const bf16_t*)(p.ws + WS_BUFA);
    const bf16_t* Bt = (const bf16_t*)(p.ws + WS_WTIN);
    constexpr int TN = DIN / 128;
    int t_end, t_step;
    float sink = 0.f;
    for (int tile = xcd_first((TA / 128) * TN, t_end, t_step); tile < t_end; tile += t_step) {
        const int tn = tile % TN, m0 = (FAKE == 2 || FAKE == 3) ? 0 : (tile / TN) * 128, n0 = FAKE == 3 ? 0 : tn * 128;
        f32x16 acc[2][2];
        gemm_tile(acc, ARowPlain{A + (size_t)m0 * D, D}, Bt + (size_t)n0 * D, D, D, lds);
        if (FAKE == 4) {
            bf16_t* dst = (bf16_t*)(p.ws + WS_HID);
            acc_foreach4_lds(acc, lds, [&](int r, int c, float v0, float v1, float v2, float v3) { *(uint2*)(dst + ((size_t)((tile / TN) * 128 + r) * 128 + c)) = pack4(v0, v1, v2, v3); });
        } else if (FAKE == 5) {
            bf16_t* dst = (bf16_t*)(p.ws + WS_HID);
            __syncthreads();
            acc_foreach4_lds(acc, lds, [&](int r, int c, float v0, float v1, float v2, float v3) { *(uint2*)(lds + (r * 136 + c) * 2) = pack4(v0, v1, v2, v3); });
            __syncthreads();
            const int t = TIDX;
#pragma unroll
            for (int i = 0; i < 8; ++i) { const int ch = t + 256 * i, r = ch >> 4, cc = (ch & 15) * 8;
                *(u32x4*)(dst + ((size_t)((tile / TN) * 128 + r) * 128 + cc)) = *(const u32x4*)(lds + (r * 136 + cc) * 2); }
        } else {
#pragma unroll
        for (int mi = 0; mi < 2; ++mi)
#pragma unroll
            for (int ni = 0; ni < 2; ++ni) sink += acc[mi][ni][0] + acc[mi][ni][7];
        }
    }
    if (sink == 12345.678f) ((float*)(p.ws + WS_RBIAS))[1000] = sink;
}
constexpr int STAGES_PER_LAYER = 11;
constexpr int N_STAGES = 1 + 2 * STAGES_PER_LAYER;
constexpr int REP_STAGE = -1;

__device__ __forceinline__ void run_stage(const P& p, int s, unsigned char* ldsb) {
    float* lds = (float*)ldsb;
    if (s == 0) { st_mod(p, lds); st_rope_table(p); st_ssm_tables(p); st_ssm_kj(p, lds); return; }
    const int l = (s - 1) / STAGES_PER_LAYER, k = (s - 1) % STAGES_PER_LAYER;
    switch (k) {
    case 0: st_rbias(p, l, lds); st_prep_weights(p, l, ldsb); st_prep_ssm(p, l); st_norm(p, l, 0);
            if (l == 0 && PROBE3 == 1) st_rbias(p, l, lds); if (l == 0 && PROBE3 == 2) st_prep_weights(p, l, ldsb); if (l == 0 && PROBE3 == 3) st_prep_ssm(p, l); if (l == 0 && PROBE3 == 4) st_norm(p, l, 0); break;
    case 1: if (l == 0) st_fake(p, ldsb); st_inproj(p, l, ldsb); break;
    case 2: st_ssm_egemm(p, ldsb); break;
    case 3: st_ssm_carry(p, l); st_attn2(p, l, ldsb, 0, 1); break;
    case 4: st_ssm_ygemm(p, l, ldsb); break;
    case 5: gemm_stage((const bf16_t*)(p.ws + WS_G), DSSM, (const bf16_t*)(p.ws + WS_WTGLU), DSSM, l == 0 ? TA : TL, DSSM, DSSM,
                       EpiGlu2{(const bf16_t*)(p.ws + WS_G), (bf16_t*)(p.ws + WS_BUFA), p.in[I_BGLU] + l * DSSM}, ldsb);
            st_conv(p, l); break;
    case 6: gemm_stage((const bf16_t*)(p.ws + WS_BUFA), D, (const bf16_t*)(p.ws + WS_WTOUT), D, l == 0 ? TA : TL, D, D, make_epi_out(p, l), ldsb); break;
    case 7: if (PROBE2 == 1 && l == 0) st_router2<true>(p, l, ldsb); st_router2(p, l, ldsb); break;
    case 8: st_moe1(p, l, ldsb); break;
    case 9: st_moe2(p, l, ldsb); break;
    case 10: if (PROBE2 == 2 && l == 0) { EpiMoeF e = make_epi_moef(p, l); e.outw = false; gemm_stage((const bf16_t*)(p.ws + WS_HID) + 4 * DE, 5 * DE, (const bf16_t*)(p.ws + WS_WD) + (size_t)32 * D * DE, DE, TA, D, DE, e, ldsb); }
             gemm_stage((const bf16_t*)(p.ws + WS_HID) + 4 * DE, 5 * DE, (const bf16_t*)(p.ws + WS_WD) + (size_t)32 * D * DE, DE, l == 0 ? TA : TL, D, DE, make_epi_moef(p, l), ldsb); break;
    }
}


#define XB_TMO      128
#define XB_XCNT(j)  (256  + 64 * (j))
#define XB_XSUB(j)  (1280 + 64 * (j))
#define XB_XGEN(j)  (2304 + 64 * (j))
#define XB_TOP      3328
#define XB_TOPGEN   3392
#define XCD_BAR_WORDS 3456
#define XB_SPIN_CAP (1u << 22)
__device__ __forceinline__ unsigned xb_ld(unsigned* p)              { return __hip_atomic_load(p, __ATOMIC_RELAXED, __HIP_MEMORY_SCOPE_AGENT); }
__device__ __forceinline__ unsigned xb_add(unsigned* p, unsigned v) { return __hip_atomic_fetch_add(p, v, __ATOMIC_RELAXED, __HIP_MEMORY_SCOPE_AGENT); }
__device__ __forceinline__ unsigned xb_xcc_id() { return (unsigned)__builtin_amdgcn_s_getreg((3 << 11) | 20) & 0xFu; }
#define XB_SPIN(cond, bar) do { unsigned _sp = 0; while (cond) { __builtin_amdgcn_s_sleep(1); \
    if ((++_sp & 255u) == 0u) { if (xb_ld(&(bar)[XB_TMO])) break; if (_sp > XB_SPIN_CAP) { atomicAdd(&(bar)[XB_TMO], 1u); break; } } } } while (0)
struct XcdBarrier { unsigned* bar; unsigned x; volatile LAS unsigned* st; };
__device__ __forceinline__ XcdBarrier xcd_barrier_post(unsigned* bar, volatile LAS unsigned* st) {
    XcdBarrier b; b.bar = bar; b.x = xb_xcc_id(); b.st = st;
    if (threadIdx.x == 0) (void)xb_add(&bar[XB_XCNT(b.x)], 1u);
    return b;
}
__device__ __forceinline__ void xcd_barrier_complete(unsigned* bar, unsigned x, unsigned& nloc, unsigned& nx) {
    const unsigned G = gridDim.x * gridDim.y * gridDim.z;
    unsigned sum, cnt, mine, sp = 0u;
    for (;;) {
        sum = 0u; cnt = 0u; mine = 0u;
#pragma unroll
        for (unsigned j = 0; j < 16; ++j) { const unsigned c = xb_ld(&bar[XB_XCNT(j)]); sum += c; cnt += (c > 0u) ? 1u : 0u; mine = (j == x) ? c : mine; }
        if (sum == G) break;
        __builtin_amdgcn_s_sleep(1);
        if ((++sp & 255u) == 0u) { if (xb_ld(&bar[XB_TMO])) break; if (sp > XB_SPIN_CAP) { atomicAdd(&bar[XB_TMO], 1u); break; } }
    }
    nloc = mine > 0u ? mine : 1u; nx = cnt > 0u ? cnt : 1u;
}
__device__ __forceinline__ void xcd_barrier(const XcdBarrier& b) {
    asm volatile("s_waitcnt vmcnt(0)" ::: "memory");
    __syncthreads();
    if (threadIdx.x == 0) {
        unsigned* bar = b.bar;
        __builtin_amdgcn_s_waitcnt(0);
        unsigned nloc = b.st[0], nx = b.st[1];
        if (nloc == 0u) { xcd_barrier_complete(bar, b.x, nloc, nx); b.st[0] = nloc; b.st[1] = nx; }
        const unsigned old = xb_add(&bar[XB_XSUB(b.x)], 1u);
        const unsigned gen = old / nloc;
        if (old + 1u == (gen + 1u) * nloc) {
            __builtin_amdgcn_fence(__ATOMIC_RELEASE, "agent");
            asm volatile("s_waitcnt vmcnt(0)" ::: "memory");
            const unsigned og = xb_add(&bar[XB_TOP], 1u);
            const unsigned tg = og / nx;
            if (og + 1u == (tg + 1u) * nx) xb_add(&bar[XB_TOPGEN], 1u);
            else XB_SPIN(xb_ld(&bar[XB_TOPGEN]) == tg, bar);
            __builtin_amdgcn_fence(__ATOMIC_ACQUIRE, "agent");
            xb_add(&bar[XB_XGEN(b.x)], 1u);
            asm volatile("s_waitcnt vmcnt(0)" ::: "memory");
        } else {
            XB_SPIN(xb_ld(&bar[XB_XGEN(b.x)]) == gen, bar);
            __builtin_amdgcn_fence(__ATOMIC_ACQUIRE, "agent");
            asm volatile("s_waitcnt vmcnt(0)" ::: "memory");
        }
    }
    __syncthreads();
}
constexpr size_t WS_XBAR = 4096;

template <int S> __device__ __forceinline__ void run_all(const P& p, unsigned char* lds, const XcdBarrier& xb) {
    run_stage(p, S, lds);
    if constexpr (S == REP_STAGE) { xcd_barrier(xb); run_stage(p, S, lds); }
    if constexpr (S + 1 < N_STAGES) {
        unsigned long long t0 = 0; if (TIM) t0 = __builtin_amdgcn_s_memrealtime();
        xcd_barrier(xb);
        if (TIM && threadIdx.x == 0) { const unsigned long long t1 = __builtin_amdgcn_s_memrealtime(); xb.st[2] += (unsigned)(t1 - t0);
            if (blockIdx.x == 0) ((unsigned long long*)(p.ws + WS_CTL + 32768))[S + 1] = t1; }
        run_all<S + 1>(p, lds, xb);
    } else if (TIM) {
        unsigned* ctl = (unsigned*)(p.ws + WS_CTL + 32768 + 512);
        unsigned long long* ts = (unsigned long long*)(p.ws + WS_CTL + 32768);
        if (threadIdx.x == 0) { atomicAdd(ctl, xb.st[2]); if (blockIdx.x == 0) ts[N_STAGES] = __builtin_amdgcn_s_memrealtime(); }
        xcd_barrier(xb);
        if (blockIdx.x == 0 && threadIdx.x == 0) {
            float us;
            if (TIM == 1) us = (float)__hip_atomic_load(ctl, __ATOMIC_RELAXED, __HIP_MEMORY_SCOPE_AGENT) / (float)gridDim.x * 0.01f / 10.f;
            else if (TIM == 2) us = (float)(ts[N_STAGES] - ts[0]) * 0.01f / 25.f;
            else us = (float)(ts[TIM - 10 + 1] - ts[TIM - 10]) * 0.01f / 2.f;
            float code = floorf(us); if (code > 89.f) code = 89.f;
            p.out[0] += 10.f + code;
        }
    }
}
__global__ void __launch_bounds__(NT, 2) mega(P p) {
    __shared__ __attribute__((aligned(16))) unsigned char lds[LDS_TOTAL + 16];
    volatile LAS unsigned* st = (volatile LAS unsigned*)(lds + LDS_TOTAL);
    if (threadIdx.x == 0) { st[0] = 0u; st[1] = 0u; st[2] = 0u; st[3] = 0u; if (TIM && blockIdx.x == 0) ((unsigned long long*)(p.ws + WS_CTL + 32768))[0] = __builtin_amdgcn_s_memrealtime(); }
    __syncthreads();
    const XcdBarrier xb = xcd_barrier_post((unsigned*)(p.ws + WS_CTL + WS_XBAR), st);
    if (p.ws == nullptr) cg::this_grid().sync();
    run_all<0>(p, lds, xb);
}

extern "C" void kernel_launch(void* const* d_in, const int* in_sizes, int n_in, void* d_out, int out_size, void* d_ws, size_t ws_size, hipStream_t stream) {
    if (n_in != N_IN || ws_size < WS_END) { fprintf(stderr, "kernel_launch: unexpected n_in %d or ws_size %zu (< %zu)\n", n_in, ws_size, (size_t)WS_END); return; }
    P p{};
    for (int i = 0; i < N_IN; ++i) p.in[i] = (const float*)d_in[i];
    p.out = (float*)d_out; p.ws = (unsigned char*)d_ws;
    static int grid_blocks = 0;
    if (!grid_blocks) {
        int dev = 0, cus = 0, per_cu = 0;
        hipGetDevice(&dev);
        hipDeviceGetAttribute(&cus, hipDeviceAttributeMultiprocessorCount, dev);
        hipOccupancyMaxActiveBlocksPerMultiprocessor(&per_cu, (const void*)mega, NT, 0);
        if (per_cu < 1) per_cu = 1;
        if (per_cu > 2) per_cu = 2;
        grid_blocks = cus * per_cu;
    }
    hipMemsetAsync((char*)d_ws + WS_CTL, 0, 65536, stream);
    void* args[] = {&p};
    hipError_t e = hipLaunchCooperativeKernel((const void*)mega, dim3(grid_blocks), dim3(NT), args, 0, stream);
    if (e != hipSuccess) fprintf(stderr, "cooperative launch failed: %s (grid %d)\n", hipGetErrorString(e), grid_blocks);
}
```

```cpp
#include <hip/hip_runtime.h>
#include <hip/hip_cooperative_groups.h>
#include <cstdio>
#include <cstdint>
namespace cg = cooperative_groups;
#define CNT_PTR(p, l) ((int*)((p).ws + 40960 + (l) * 8192))
#define LAS __attribute__((address_space(3)))
constexpr int ABL = 0;

__device__ __forceinline__ int tid_opaque() { int t = threadIdx.x; asm volatile("" : "+v"(t)); return t; }
__device__ __forceinline__ int bid_opaque() { int b = blockIdx.x; asm volatile("" : "+s"(b)); return b; }
__device__ __forceinline__ int xcd_first(int total, int& end, int& step) {
    const int nb = gridDim.x; int b = blockIdx.x; asm volatile("" : "+s"(b));
    if (nb & 7) { end = total; step = nb; return b; }
    const int x = b & 7, j = b >> 3, per = (total + 7) >> 3, lo = x * per;
    end = lo + per < total ? lo + per : total; step = nb >> 3; return lo + j;
}
#define TIDX tid_opaque()
#define BIDX bid_opaque()

constexpr int D = 1024, NB = 8, L = 2048, LC = 256;
constexpr int TL = NB * L, TC = NB * LC, TA = TL + TC;
constexpr int DIN = 1792, DCONV = 256, DSSM = 256, DATT = 512;
constexpr int NQH = 8, NKVH = 2, HD = 64;
constexpr int COL_U = 768, COL_Q = 1024, COL_K = 1536, COL_V = 1664;
constexpr int NE = 32, TOPK = 4, DE = 128;
constexpr int SG = 16, SH = 16, SP = 64;
constexpr int NT = 256;

enum { I_X = 0, I_C, I_CTX, I_CCTX, I_WMOD, I_BMOD, I_N1G, I_N2G, I_WIN, I_CONVW, I_LRE, I_LIM, I_LDT, I_BRE, I_BIM, I_CRE, I_CIM,
       I_SD, I_WGLU, I_BGLU, I_QG, I_KG, I_SINK, I_WOUT, I_RW, I_RB, I_WEG, I_WEU, I_WED, I_WSG, I_WSU, I_WSD, N_IN };

typedef unsigned short bf16_t;
constexpr size_t WS_CTL = 0;
constexpr size_t WS_MOD = 65536;
constexpr size_t WS_ZERO_END = WS_MOD + (size_t)2 * 9 * 6 * D * 4;
constexpr size_t WS_RBIAS = 524288;
constexpr size_t WS_ROPE = WS_RBIAS + 4096;
constexpr size_t WS_KJ = WS_ROPE + 524288;
constexpr size_t WS_GS2 = WS_KJ + 2097152;
constexpr size_t WS_POW = WS_GS2 + 131072;
constexpr size_t WS_FB = WS_POW + (size_t)2 * 2 * 16 * 33 * 64 * 8;
constexpr size_t WS_R1 = WS_FB + (size_t)2 * 2 * 16 * 64 * 16 * 8;
constexpr size_t WS_BUFA = WS_R1;
constexpr size_t WS_PC = WS_BUFA + (size_t)TA * D * 2;
constexpr size_t WS_UA = WS_PC + (size_t)TA * 768 * 2;
constexpr size_t WS_E = WS_UA + (size_t)16 * 640 * 768 * 2;
constexpr size_t WS_G = WS_E + (size_t)16 * 640 * 256 * 4;
constexpr size_t WS_QB = WS_G + (size_t)TA * DSSM * 2;
constexpr size_t WS_KB = WS_QB + (size_t)TA * DATT * 2;
constexpr size_t WS_VT = WS_KB + (size_t)TA * 128 * 2;
constexpr size_t WS_SLAB = WS_R1;
constexpr size_t WS_HID = WS_SLAB + (size_t)TA * 4 * D * 2;
constexpr size_t WS_HC1 = WS_HID + (size_t)TA * 5 * DE * 2;
constexpr size_t WS_HCMID = WS_HC1 + (size_t)TC * D * 4;
constexpr size_t WS_LCODE = WS_HCMID + (size_t)TC * D * 4;
constexpr size_t WS_LW = WS_LCODE + (size_t)NE * TA * 4;
constexpr size_t WS_WTIN = WS_LW + (size_t)NE * TA * 4;
constexpr size_t WS_WTOUT = WS_WTIN + (size_t)DIN * D * 2;
constexpr size_t WS_WTGLU = WS_WTOUT + (size_t)D * D * 2;
constexpr size_t WS_WGU = WS_WTGLU + (size_t)DSSM * DSSM * 2;
constexpr size_t WS_WD = WS_WGU + (size_t)33 * 256 * D * 2;
constexpr size_t WS_WST = WS_WD + (size_t)33 * D * DE * 2;
constexpr size_t WS_KW = WS_WST + (size_t)16 * 256 * 512 * 2;
constexpr size_t WS_END = WS_KW + (size_t)16 * 512 * 768 * 2;
static_assert(WS_VT + (size_t)TA * 128 * 2 <= WS_HID, "overlay");
static_assert(WS_ZERO_END <= WS_RBIAS, "zero region");
static_assert(WS_END <= 268435456, "workspace too large");

struct P {
    const float* in[N_IN];
    float* out;
    unsigned char* ws;
};

__device__ __forceinline__ bf16_t f2bf(float f) { unsigned u = __float_as_uint(f); u += 0x7FFFu + ((u >> 16) & 1u); return (bf16_t)(u >> 16); }
__device__ __forceinline__ float bf2f(bf16_t b) { return __uint_as_float((unsigned)b << 16); }
__device__ __forceinline__ unsigned cvt_pk_bf16(float lo, float hi) { unsigned r; asm("v_cvt_pk_bf16_f32 %0, %1, %2" : "=v"(r) : "v"(lo), "v"(hi)); return r; }
typedef __attribute__((ext_vector_type(4))) float f32x4;
typedef __attribute__((ext_vector_type(4))) unsigned u32x4;
struct BfPtr { const bf16_t* p; __device__ __forceinline__ float operator[](long i) const { return bf2f(p[i]); }
               __device__ __forceinline__ BfPtr operator+(long o) const { return BfPtr{p + o}; } };
__device__ __forceinline__ float silu_f(float x) { return x / (1.f + expf(-x)); }
__device__ __forceinline__ float sigmoid_f(float x) { return 1.f / (1.f + expf(-x)); }
__device__ __forceinline__ float gelu_f(float x) { return 0.5f * x * (1.f + tanhf(0.7978845608028654f * (x + 0.044715f * x * x * x))); }
__device__ __forceinline__ float wave_sum(float v) {
#pragma unroll
    for (int o = 32; o > 0; o >>= 1) v += __shfl_xor(v, o);
    return v;
}
__device__ __forceinline__ int row_bb(int r) { return r < TL ? r / L : 8; }
__device__ __forceinline__ const float* h_row(const P& p, int l, int r) {
    if (r < TL) return (l == 0 ? p.in[I_X] : p.out) + (size_t)r * D;
    return (l == 0 ? p.in[I_CTX] : (const float*)(p.ws + WS_HC1)) + (size_t)(r - TL) * D;
}
__device__ __forceinline__ float* hmid_row(const P& p, int r) {
    if (r < TL) return p.out + (size_t)r * D;
    return (float*)(p.ws + WS_HCMID) + (size_t)(r - TL) * D;
}
__device__ __forceinline__ const float* mod_vec(const P& p, int l, int bb, int chunk) {
    return (const float*)(p.ws + WS_MOD) + ((size_t)(l * 9 + bb) * 6 + chunk) * D;
}

__device__ __forceinline__ void st_mod(const P& p, float* lds) {
    float* red = lds + 9 * D;
    for (int i = TIDX; i < 9 * D; i += NT) {
        const int bb = i / D, k = i % D;
        const float c = bb < 8 ? p.in[I_C][bb * D + k] : p.in[I_CCTX][k];
        lds[i] = silu_f(c);
    }
    __syncthreads();
    float* mod = (float*)(p.ws + WS_MOD);
    const int col = TIDX & 31, ks = TIDX >> 5;
    for (int item = BIDX; item < 2 * 6 * D / 32; item += gridDim.x) {
        const int l = item / (6 * D / 32), j = (item % (6 * D / 32)) * 32 + col;
        const float* w = p.in[I_WMOD] + (size_t)l * D * 6 * D + j;
        float acc[9];
#pragma unroll
        for (int bb = 0; bb < 9; ++bb) acc[bb] = 0.f;
        for (int k = ks * 128; k < ks * 128 + 128; ++k) {
            const float wv = w[(size_t)k * 6 * D];
#pragma unroll
            for (int bb = 0; bb < 9; ++bb) acc[bb] += lds[bb * D + k] * wv;
        }
#pragma unroll
        for (int bb = 0; bb < 9; ++bb) red[(bb * 8 + ks) * 32 + col] = acc[bb];
        __syncthreads();
        for (int o = TIDX; o < 9 * 32; o += NT) {
            const int bb = o >> 5, c2 = o & 31;
            float sum = p.in[I_BMOD][l * 6 * D + (item % (6 * D / 32)) * 32 + c2];
#pragma unroll
            for (int q = 0; q < 8; ++q) sum += red[(bb * 8 + q) * 32 + c2];
            mod[(size_t)(l * 9 + bb) * 6 * D + (item % (6 * D / 32)) * 32 + c2] = sum;
        }
        __syncthreads();
    }
}

__device__ __forceinline__ void st_norm(const P& p, int l, int which) {
    const int lane = TIDX & 63, wv = TIDX >> 6;
    const int nrows = (which == 1 && l == 1) ? TL : TA;
    float* xn = (float*)(p.ws + WS_BUFA);
    const float* g = p.in[which == 0 ? I_N1G : I_N2G] + l * D;
    for (int r = BIDX * 4 + wv; r < nrows; r += gridDim.x * 4) {
        const float* src = which == 0 ? h_row(p, l, r) : hmid_row(p, r);
        const int bb = row_bb(r);
        const float* sh = mod_vec(p, l, bb, which == 0 ? 0 : 3);
        const float* sc = mod_vec(p, l, bb, which == 0 ? 1 : 4);
        float4 v[4];
        float s = 0.f;
#pragma unroll
        for (int j = 0; j < 4; ++j) { v[j] = *(const float4*)(src + j * 256 + lane * 4); s += v[j].x * v[j].x + v[j].y * v[j].y + v[j].z * v[j].z + v[j].w * v[j].w; }
        s = wave_sum(s);
        const float rinv = rsqrtf(s * (1.f / D) + 1e-6f);
#pragma unroll
        for (int j = 0; j < 4; ++j) {
            const int k = j * 256 + lane * 4;
            const float4 gg = *(const float4*)(g + k), s1 = *(const float4*)(sc + k), s0 = *(const float4*)(sh + k);
            float4 o;
            o.x = v[j].x * rinv * gg.x * (1.f + s1.x) + s0.x;
            o.y = v[j].y * rinv * gg.y * (1.f + s1.y) + s0.y;
            o.z = v[j].z * rinv * gg.z * (1.f + s1.z) + s0.z;
            o.w = v[j].w * rinv * gg.w * (1.f + s1.w) + s0.w;
            if (which == 1) *(float4*)(xn + (size_t)r * D + k) = o;
            else { uint2 pk; pk.x = (unsigned)f2bf(o.x) | ((unsigned)f2bf(o.y) << 16); pk.y = (unsigned)f2bf(o.z) | ((unsigned)f2bf(o.w) << 16);
                   *(uint2*)((bf16_t*)(p.ws + WS_BUFA) + (size_t)r * D + k) = pk; }
        }
    }
}


__device__ __forceinline__ void bf8_to_f(const u32x4& v, float (&f)[8]) {
#pragma unroll
    for (int q = 0; q < 4; ++q) { f[2 * q] = __uint_as_float(v[q] << 16); f[2 * q + 1] = __uint_as_float(v[q] & 0xffff0000u); }
}
__device__ __forceinline__ void st_conv(const P& p, int l) {
    const bf16_t* pb = (const bf16_t*)(p.ws + WS_PC);
    bf16_t* mix = (bf16_t*)(p.ws + WS_BUFA);
    const float* cw = p.in[I_CONVW] + l * 3 * DCONV;
    const int nrows = l == 0 ? TA : TL;
    for (int idx = BIDX * NT + TIDX; idx < nrows * 32; idx += gridDim.x * NT) {
        const int r = idx >> 5, ch = (idx & 31) * 8;
        int t, len;
        if (r < TL) { t = r & (L - 1); len = L; } else { t = (r - TL) & (LC - 1); len = LC; }
        const bf16_t* pr = pb + (size_t)r * 768 + ch;
        float x[8], c[8], bgate[8], y[8];
        bf8_to_f(*(const u32x4*)(pr), x); bf8_to_f(*(const u32x4*)(pr + 512), c); bf8_to_f(*(const u32x4*)(pr + 256), bgate);
        const f32x4 w1a = *(const f32x4*)(cw + DCONV + ch), w1b = *(const f32x4*)(cw + DCONV + ch + 4);
#pragma unroll
        for (int q = 0; q < 8; ++q) y[q] = (q < 4 ? w1a[q] : w1b[q - 4]) * (c[q] * x[q]);
        if (t > 0) {
            bf8_to_f(*(const u32x4*)(pr - 768), x); bf8_to_f(*(const u32x4*)(pr - 768 + 512), c);
            const f32x4 wa = *(const f32x4*)(cw + ch), wb = *(const f32x4*)(cw + ch + 4);
#pragma unroll
            for (int q = 0; q < 8; ++q) y[q] += (q < 4 ? wa[q] : wb[q - 4]) * (c[q] * x[q]);
        }
        if (t < len - 1) {
            bf8_to_f(*(const u32x4*)(pr + 768), x); bf8_to_f(*(const u32x4*)(pr + 768 + 512), c);
            const f32x4 wa = *(const f32x4*)(cw + 2 * DCONV + ch), wb = *(const f32x4*)(cw + 2 * DCONV + ch + 4);
#pragma unroll
            for (int q = 0; q < 8; ++q) y[q] += (q < 4 ? wa[q] : wb[q - 4]) * (c[q] * x[q]);
        }
        u32x4 o;
#pragma unroll
        for (int q = 0; q < 4; ++q) o[q] = cvt_pk_bf16(bgate[2 * q] * y[2 * q], bgate[2 * q + 1] * y[2 * q + 1]);
        *(u32x4*)(mix + (size_t)r * D + ch) = o;
    }
}

struct EpiOut { const float* modl; const float* hlat; const float* hctx; float* out; float* hcmid;
    __device__ __forceinline__ void operator()(int r, int c, float v0, float v1, float v2, float v3) const {
    const int bb = row_bb(r);
    const f32x4 g1 = *(const f32x4*)(modl + ((size_t)bb * 6 + 2) * D + c);
    const f32x4 hv = *(const f32x4*)((r < TL ? hlat + (size_t)r * D : hctx + (size_t)(r - TL) * D) + c);
    f32x4 o; o[0] = hv[0] + g1[0] * v0; o[1] = hv[1] + g1[1] * v1; o[2] = hv[2] + g1[2] * v2; o[3] = hv[3] + g1[3] * v3;
    *(f32x4*)((r < TL ? out + (size_t)r * D : hcmid + (size_t)(r - TL) * D) + c) = o; } };
__device__ __forceinline__ EpiOut make_epi_out(const P& p, int l) {
    return EpiOut{(const float*)(p.ws + WS_MOD) + (size_t)l * 9 * 6 * D, l == 0 ? p.in[I_X] : p.out, l == 0 ? p.in[I_CTX] : (const float*)(p.ws + WS_HC1), p.out, (float*)(p.ws + WS_HCMID)};
}

typedef __attribute__((ext_vector_type(8))) short bf16x8;
typedef __attribute__((ext_vector_type(16))) float f32x16;
constexpr int G_STAGEB = 16384;
constexpr int G_NSTG = 4;
constexpr int LDS_BYTES = G_NSTG * G_STAGEB;

template <class ARow>
__device__ __forceinline__ void gemm_tile(f32x16 (&acc)[2][2], ARow arow, const bf16_t* Bt, int ldb, int K, unsigned char* lds) {
    const int t = TIDX, lane = t & 63, w = __builtin_amdgcn_readfirstlane(t >> 6), wr = w >> 1, wc = w & 1, lr = lane & 31, lh = lane >> 5;
    const int srow = t >> 2, lc = (t & 3) ^ ((srow >> 2) & 3);
    const bf16_t* ap[2]; const bf16_t* bp[2];
#pragma unroll
    for (int i = 0; i < 2; ++i) { ap[i] = arow(srow + 64 * i) + lc * 8; bp[i] = Bt + (size_t)(srow + 64 * i) * ldb + lc * 8; }
    float zf = 0.f; asm volatile("" : "+v"(zf));
#pragma unroll
    for (int mi = 0; mi < 2; ++mi)
#pragma unroll
        for (int ni = 0; ni < 2; ++ni)
#pragma unroll
            for (int r = 0; r < 16; ++r) acc[mi][ni][r] = zf;
    const int nk = K >> 5;
    LAS unsigned char* l3 = (LAS unsigned char*)lds;
    const int f = (lr >> 2) & 3;
    const int aoff = (wr * 64 + lr) * 64 + ((lh ^ f) << 4), boff = 8192 + (wc * 64 + lr) * 64 + ((lh ^ f) << 4);
#define G_ISSUE(ks) do { LAS unsigned char* d_ = l3 + ((ks) & 3) * G_STAGEB + w * 1024; \
        __builtin_amdgcn_global_load_lds((const unsigned*)(ap[0] + (ks) * 32), (LAS unsigned*)(d_), 16, 0, 0); \
        __builtin_amdgcn_global_load_lds((const unsigned*)(ap[1] + (ks) * 32), (LAS unsigned*)(d_ + 4096), 16, 0, 0); \
        __builtin_amdgcn_global_load_lds((const unsigned*)(bp[0] + (ks) * 32), (LAS unsigned*)(d_ + 8192), 16, 0, 0); \
        __builtin_amdgcn_global_load_lds((const unsigned*)(bp[1] + (ks) * 32), (LAS unsigned*)(d_ + 12288), 16, 0, 0); } while (0)
#define G_RD(A0, A1, B0, B1, slot, s2) do { const LAS unsigned char* c_ = l3 + (slot) * G_STAGEB; \
        A0 = *(const LAS bf16x8*)(c_ + (aoff ^ ((s2) << 5))); A1 = *(const LAS bf16x8*)(c_ + ((aoff + 2048) ^ ((s2) << 5))); \
        B0 = *(const LAS bf16x8*)(c_ + (boff ^ ((s2) << 5))); B1 = *(const LAS bf16x8*)(c_ + ((boff + 2048) ^ ((s2) << 5))); } while (0)
#define G_MM(A0, A1, B0, B1) do { \
        acc[0][0] = __builtin_amdgcn_mfma_f32_32x32x16_bf16(B0, A0, acc[0][0], 0, 0, 0); acc[0][1] = __builtin_amdgcn_mfma_f32_32x32x16_bf16(B1, A0, acc[0][1], 0, 0, 0); \
        acc[1][0] = __builtin_amdgcn_mfma_f32_32x32x16_bf16(B0, A1, acc[1][0], 0, 0, 0); acc[1][1] = __builtin_amdgcn_mfma_f32_32x32x16_bf16(B1, A1, acc[1][1], 0, 0, 0); } while (0)
    __syncthreads();
    G_ISSUE(0);
    if (1 < nk) G_ISSUE(1);
    if (2 < nk) G_ISSUE(2);
    if (2 < nk) asm volatile("s_waitcnt vmcnt(8)" ::: "memory"); else if (1 < nk) asm volatile("s_waitcnt vmcnt(4)" ::: "memory"); else asm volatile("s_waitcnt vmcnt(0)" ::: "memory");
    __builtin_amdgcn_s_barrier();
    if (3 < nk) G_ISSUE(3);
    bf16x8 fa0, fa1, fb0, fb1, ga0, ga1, gb0, gb1;
    G_RD(fa0, fa1, fb0, fb1, 0, 0);
    for (int ks = 0; ks < nk; ++ks) {
        G_RD(ga0, ga1, gb0, gb1, ks & 3, 1);
        __builtin_amdgcn_sched_barrier(0);
        asm volatile("s_waitcnt lgkmcnt(4)" ::: "memory");
        __builtin_amdgcn_sched_barrier(0);
        G_MM(fa0, fa1, fb0, fb1);
        __builtin_amdgcn_sched_barrier(0);
        if (ks + 1 < nk) {
            if (ks + 3 < nk) asm volatile("s_waitcnt vmcnt(8) lgkmcnt(0)" ::: "memory");
            else if (ks + 2 < nk) asm volatile("s_waitcnt vmcnt(4) lgkmcnt(0)" ::: "memory");
            else asm volatile("s_waitcnt vmcnt(0) lgkmcnt(0)" ::: "memory");
            __builtin_amdgcn_s_barrier();
            if (ks + 4 < nk) G_ISSUE(ks + 4);
            G_RD(fa0, fa1, fb0, fb1, (ks + 1) & 3, 0);
        } else {
            asm volatile("s_waitcnt lgkmcnt(0)" ::: "memory");
        }
        __builtin_amdgcn_sched_barrier(0);
        G_MM(ga0, ga1, gb0, gb1);
        __builtin_amdgcn_sched_barrier(0);
    }
#undef G_RD
#undef G_MM
#undef G_ISSUE
}
template <class F>
__device__ __forceinline__ void acc_foreach4(const f32x16 (&acc)[2][2], F f) {
    const int lane = TIDX & 63, w = (TIDX >> 6) & 3, wr = w >> 1, wc = w & 1, lr = lane & 31, lh = lane >> 5;
#pragma unroll
    for (int mi = 0; mi < 2; ++mi)
#pragma unroll
        for (int ni = 0; ni < 2; ++ni)
#pragma unroll
            for (int g = 0; g < 4; ++g)
                f(wr * 64 + mi * 32 + lr, wc * 64 + ni * 32 + 8 * g + 4 * lh, acc[mi][ni][4 * g], acc[mi][ni][4 * g + 1], acc[mi][ni][4 * g + 2], acc[mi][ni][4 * g + 3]);
}
constexpr int C_LD = 132;
template <class F>
__device__ __forceinline__ void acc_foreach4_lds(const f32x16 (&acc)[2][2], unsigned char* lds, F f) {
    float* C = (float*)lds;
    const int t = TIDX, lane = t & 63, w = (t >> 6) & 3, wr = w >> 1, wc = w & 1, lr = lane & 31, lh = lane >> 5;
    __syncthreads();
#pragma unroll
    for (int mi = 0; mi < 2; ++mi)
#pragma unroll
        for (int ni = 0; ni < 2; ++ni)
#pragma unroll
            for (int g = 0; g < 4; ++g) {
                f32x4 v; v[0] = acc[mi][ni][4 * g]; v[1] = acc[mi][ni][4 * g + 1]; v[2] = acc[mi][ni][4 * g + 2]; v[3] = acc[mi][ni][4 * g + 3];
                *(f32x4*)(C + (wr * 64 + mi * 32 + lr) * C_LD + wc * 64 + ni * 32 + 8 * g + 4 * lh) = v;
            }
    __syncthreads();
#pragma unroll 4
    for (int i = 0; i < 16; ++i) {
        const int idx = t + 256 * i, r = idx >> 5, c = (idx & 31) * 4;
        const f32x4 v = *(const f32x4*)(C + r * C_LD + c);
        f(r, c, v[0], v[1], v[2], v[3]);
    }
}
constexpr float SLAB_SCALE = 32.f;
__device__ __forceinline__ unsigned pack4_fp8(float a, float b, float c, float d) {
    a = fminf(fmaxf(a * SLAB_SCALE, -448.f), 448.f); b = fminf(fmaxf(b * SLAB_SCALE, -448.f), 448.f);
    c = fminf(fmaxf(c * SLAB_SCALE, -448.f), 448.f); d = fminf(fmaxf(d * SLAB_SCALE, -448.f), 448.f);
    int w = __builtin_amdgcn_cvt_pk_fp8_f32(a, b, 0, false);
    w = __builtin_amdgcn_cvt_pk_fp8_f32(c, d, w, true);
    return (unsigned)w;
}
__device__ __forceinline__ uint2 pack4(float a, float b, float c, float d) { uint2 o; o.x = cvt_pk_bf16(a, b); o.y = cvt_pk_bf16(c, d); return o; }
struct ARowPlain { const bf16_t* A; int lda; __device__ __forceinline__ const bf16_t* operator()(int m) const { return A + (size_t)m * lda; } };

template <class Epi>
__device__ __forceinline__ void gemm_stage(const bf16_t* A, int lda, const bf16_t* Bt, int ldb, int M, int N, int K, Epi epi, unsigned char* lds) {
    const int tn = N / 128, tm = M / 128;
    int t_end, t_step;
    for (int tile = xcd_first(tm * tn, t_end, t_step); tile < t_end; tile += t_step) {
        const int m0 = (tile / tn) * 128, n0 = (tile % tn) * 128;
        f32x16 acc[2][2];
        gemm_tile(acc, ARowPlain{A + (size_t)m0 * lda, lda}, Bt + (size_t)n0 * ldb, ldb, K, lds);
        acc_foreach4_lds(acc, lds, [&](int r, int c, float v0, float v1, float v2, float v3) { epi(m0 + r, n0 + c, v0, v1, v2, v3); });
    }
}
__device__ __forceinline__ void tr_item(const float* src, size_t sk, bf16_t* dst, size_t dld, bf16_t* tl) {
    const int t = TIDX, kr = t >> 3, nq = (t & 7) * 4;
    __syncthreads();
#pragma unroll
    for (int ps = 0; ps < 4; ++ps) {
        const f32x4 v = *(const f32x4*)(src + (size_t)(kr + 32 * ps) * sk + nq);
#pragma unroll
        for (int j = 0; j < 4; ++j) tl[(nq + j) * 136 + kr + 32 * ps] = f2bf(v[j]);
    }
    __syncthreads();
    const int n = t >> 3, part = t & 7;
    const u32x4 a = *(const u32x4*)(tl + n * 136 + part * 16), b = *(const u32x4*)(tl + n * 136 + part * 16 + 8);
    bf16_t* o = dst + (size_t)n * dld + part * 16;
    *(u32x4*)o = a; *(u32x4*)(o + 8) = b;
}
constexpr int PW_IN = 1, PW_OUT = 2, PW_GLU = 4, PW_GU = 8, PW_DN = 16, PW_ALL = 31;
__device__ __forceinline__ void st_prep_weights(const P& p, int l, unsigned char* lds, int parts) {
    bf16_t* tl = (bf16_t*)lds;
    constexpr int N_IN_ = (DIN / 32) * 8, N_OUT = (D / 32) * 8, N_GLU = (DSSM / 32) * 2, N_GU = 33 * 2 * 4 * 8, N_DN = 33 * (D / 32);
    if (parts & PW_IN) for (int r = BIDX; r < N_IN_; r += gridDim.x) { const int nt = r >> 3, kt = r & 7;
        tr_item(p.in[I_WIN] + (size_t)l * D * DIN + (size_t)kt * 128 * DIN + nt * 32, DIN, (bf16_t*)(p.ws + WS_WTIN) + (size_t)nt * 32 * D + kt * 128, D, tl); }
    if (parts & PW_OUT) for (int r = BIDX; r < N_OUT; r += gridDim.x) { const int nt = r >> 3, kt = r & 7;
        tr_item(p.in[I_WOUT] + (size_t)l * D * D + (size_t)kt * 128 * D + nt * 32, D, (bf16_t*)(p.ws + WS_WTOUT) + (size_t)nt * 32 * D + kt * 128, D, tl); }
    if (parts & PW_GLU) for (int r = BIDX; r < N_GLU; r += gridDim.x) { const int nt = r >> 1, kt = r & 1;
        tr_item(p.in[I_WGLU] + (size_t)l * DSSM * DSSM + (size_t)kt * 128 * DSSM + nt * 32, DSSM, (bf16_t*)(p.ws + WS_WTGLU) + (size_t)nt * 32 * DSSM + kt * 128, DSSM, tl); }
    if (parts & PW_GU) for (int r = BIDX; r < N_GU; r += gridDim.x) {
        const int kt = r & 7, q = (r >> 3) & 3, j = (r >> 5) & 1, e = r >> 6;
        const int wc = q >> 1, ni = q & 1, unit0 = j * 64 + wc * 32;
        const float* sp; size_t sk;
        if (e < NE) { sp = p.in[ni ? I_WEU : I_WEG] + ((size_t)(l * D + kt * 128) * NE + e) * DE + unit0; sk = (size_t)NE * DE; }
        else { sp = p.in[ni ? I_WSU : I_WSG] + (size_t)(l * D + kt * 128) * DE + unit0; sk = DE; }
        tr_item(sp, sk, (bf16_t*)(p.ws + WS_WGU) + ((size_t)(e * 2 + j) * 128 + q * 32) * D + kt * 128, D, tl); }
    if (parts & PW_DN) for (int r = BIDX; r < N_DN; r += gridDim.x) {
        const int nt = r & 31, e = r >> 5;
        const float* sp = (e < NE ? p.in[I_WED] + (size_t)(l * NE + e) * DE * D : p.in[I_WSD] + (size_t)l * DE * D) + nt * 32;
        tr_item(sp, D, (bf16_t*)(p.ws + WS_WD) + ((size_t)e * D + nt * 32) * DE, DE, tl); }
    __syncthreads();
}
struct EpiStoreBf { bf16_t* C; int ldc; __device__ __forceinline__ void operator()(int r, int c, float v0, float v1, float v2, float v3) const { *(uint2*)(C + (size_t)r * ldc + c) = pack4(v0, v1, v2, v3); } };


__device__ __forceinline__ void st_rbias(const P& p, int l, float* lds) {
    const int lane = TIDX & 63, w = TIDX >> 6;
    const float* rw = p.in[I_RW] + (size_t)l * D * NE;
    for (int o = BIDX * 4 + w; o < 9 * 32; o += gridDim.x * 4) {
        const int bb = o >> 5, e = o & 31;
        const float* sh2 = mod_vec(p, l, bb, 3);
        float a = 0.f;
#pragma unroll
        for (int j = 0; j < 16; ++j) { const int k = j * 64 + lane; a += sh2[k] * rw[(size_t)k * NE + e]; }
        a = wave_sum(a);
        if (lane == 0) ((float*)(p.ws + WS_RBIAS))[(l * 9 + bb) * 32 + e] = a;
    }
    const float* g2 = p.in[I_N2G] + l * D;
    for (int idx = BIDX * NT + TIDX; idx < 9 * D; idx += gridDim.x * NT) {
        const int bb = idx >> 10, k = idx & (D - 1);
        ((float*)(p.ws + WS_GS2))[(size_t)(l * 9 + bb) * D + k] = g2[k] * (1.f + mod_vec(p, l, bb, 4)[k]);
    }
}
template <bool DRY = false>
__device__ __forceinline__ void st_router2(const P& p, int l, unsigned char* ldsb) {
    float* part = (float*)ldsb;
    float* ssq = part + 4 * 32 * 33;
    float* sc = ssq + 128;
    float* rinvs = sc + 32 * 33;
    int* hist = (int*)(rinvs + 32);
    int* gbase = hist + 32;
    const int t = TIDX, lane = t & 63, w = t >> 6, i = lane & 31, hf = lane >> 5;
    const int nrows = l == 0 ? TA : TL;
    const float* rw = p.in[I_RW] + (size_t)l * D * NE;
    int* cnt = CNT_PTR(p, l);
    int* lcode = (int*)(p.ws + WS_LCODE);
    float* lw = (float*)(p.ws + WS_LW);
    bf16_t* xn2 = (bf16_t*)(p.ws + WS_BUFA);
    for (int item = BIDX; item < nrows / 32; item += gridDim.x) {
        const int r0 = item * 32, bb = row_bb(r0);
        const float* gs2 = (const float*)(p.ws + WS_GS2) + (size_t)(l * 9 + bb) * D;
        const float* sh2 = mod_vec(p, l, bb, 3);
        const int kb = w * 256 + hf * 128;
        const float* src = hmid_row(p, r0 + i) + kb;
        const float* gsp = gs2 + kb;
        const float* rwp = rw + (size_t)kb * NE + i;
        f32x16 acc;
        float zf = 0.f; asm volatile("" : "+v"(zf));
#pragma unroll
        for (int r = 0; r < 16; ++r) acc[r] = zf;
        float ss = 0.f;
        f32x4 xa[4], ga[4], xb[4], gb[4]; float wa[16], wb[16];
#define R_LOAD(X, G, W, cb) do { _Pragma("unroll") for (int q = 0; q < 4; ++q) { const int k = ((cb) * 4 + q) * 4; X[q] = *(const f32x4*)(src + k); G[q] = *(const f32x4*)(gsp + k); \
            _Pragma("unroll") for (int j = 0; j < 4; ++j) W[q * 4 + j] = rwp[(size_t)(k + j) * NE]; } } while (0)
#define R_COMP(X, G, W) do { _Pragma("unroll") for (int q = 0; q < 4; ++q) { ss += X[q][0] * X[q][0] + X[q][1] * X[q][1] + X[q][2] * X[q][2] + X[q][3] * X[q][3]; \
            _Pragma("unroll") for (int j = 0; j < 4; ++j) acc = __builtin_amdgcn_mfma_f32_32x32x2f32(X[q][j] * G[q][j], W[q * 4 + j], acc, 0, 0, 0); } } while (0)
        R_LOAD(xa, ga, wa, 0);
#pragma unroll 1
        for (int cb = 0; cb < 8; cb += 2) {
            R_LOAD(xb, gb, wb, cb + 1);
            R_COMP(xa, ga, wa);
            if (cb + 2 < 8) R_LOAD(xa, ga, wa, cb + 2);
            R_COMP(xb, gb, wb);
        }
#undef R_LOAD
#undef R_COMP
        ss += __shfl_xor(ss, 32);
        __syncthreads();
        if (hf == 0) ssq[w * 32 + i] = ss;
        if (t < 32) hist[t] = 0;
#pragma unroll
        for (int r = 0; r < 16; ++r) part[(w * 32 + (r & 3) + 8 * (r >> 2) + 4 * hf) * 33 + i] = acc[r];
        __syncthreads();
        for (int idx = t; idx < 1024; idx += NT) {
            const int row = idx >> 5, e = idx & 31;
            const float logit = part[(0 * 32 + row) * 33 + e] + part[(1 * 32 + row) * 33 + e] + part[(2 * 32 + row) * 33 + e] + part[(3 * 32 + row) * 33 + e];
            const float rinv = rsqrtf((ssq[row] + ssq[32 + row] + ssq[64 + row] + ssq[96 + row]) * (1.f / D) + 1e-6f);
            sc[row * 33 + e] = sigmoid_f(rinv * logit + ((const float*)(p.ws + WS_RBIAS))[(l * 9 + bb) * 32 + e]);
            if (e == 0) rinvs[row] = rinv;
        }
        __syncthreads();
        if (t < 32) {
            const int r = r0 + t;
            float sel[32];
#pragma unroll
            for (int e = 0; e < 32; ++e) sel[e] = sc[t * 33 + e] + p.in[I_RB][l * NE + e];
            int bi[4]; float sv[4]; float sum = 0.f;
#pragma unroll
            for (int k = 0; k < 4; ++k) {
                float best = -1e30f; int b = 0;
#pragma unroll
                for (int e = 0; e < 32; ++e) if (sel[e] > best) { best = sel[e]; b = e; }
#pragma unroll
                for (int e = 0; e < 32; ++e) if (e == b) sel[e] = -1e30f;
                bi[k] = b; sv[k] = sc[t * 33 + b]; sum += sv[k];
            }
            int rank[4];
#pragma unroll
            for (int k = 0; k < 4; ++k) rank[k] = atomicAdd(&hist[bi[k]], 1);
            __builtin_amdgcn_s_waitcnt(0xc07f);
            __builtin_amdgcn_wave_barrier();
            { const int hc = hist[t]; gbase[t] = (hc > 0 && !DRY) ? atomicAdd(&cnt[t * 64], hc) : 0; }
            __builtin_amdgcn_s_waitcnt(0xc07f);
            __builtin_amdgcn_wave_barrier();
#pragma unroll
            for (int k = 0; k < 4; ++k) {
                if (DRY) { if (sv[k] / sum == 12345.f) lw[0] = 0.f; } else {
                const int pos = gbase[bi[k]] + rank[k];
                lcode[(size_t)bi[k] * TA + pos] = r * 4 + k;
                lw[(size_t)bi[k] * TA + pos] = sv[k] / sum * 2.5f; }
            }
        }
        {
            float gs[16], sh[16];
#pragma unroll
            for (int q = 0; q < 16; ++q) { const int k = (q >> 3) * 512 + 8 * lane + (q & 7); gs[q] = gs2[k]; sh[q] = sh2[k]; }
            for (int rr8 = 0; rr8 < 8; ++rr8) {
                const int rho = w * 8 + rr8;
                const float rr = rinvs[rho];
                const float* s2 = hmid_row(p, r0 + rho);
                bf16_t* dst = xn2 + (size_t)(r0 + rho) * D;
#pragma unroll
                for (int h2 = 0; h2 < 2; ++h2) {
                    const f32x4 x0 = *(const f32x4*)(s2 + h2 * 512 + 8 * lane), x1 = *(const f32x4*)(s2 + h2 * 512 + 8 * lane + 4);
                    u32x4 o;
                    o[0] = cvt_pk_bf16(x0[0] * rr * gs[h2 * 8 + 0] + sh[h2 * 8 + 0], x0[1] * rr * gs[h2 * 8 + 1] + sh[h2 * 8 + 1]);
                    o[1] = cvt_pk_bf16(x0[2] * rr * gs[h2 * 8 + 2] + sh[h2 * 8 + 2], x0[3] * rr * gs[h2 * 8 + 3] + sh[h2 * 8 + 3]);
                    o[2] = cvt_pk_bf16(x1[0] * rr * gs[h2 * 8 + 4] + sh[h2 * 8 + 4], x1[1] * rr * gs[h2 * 8 + 5] + sh[h2 * 8 + 5]);
                    o[3] = cvt_pk_bf16(x1[2] * rr * gs[h2 * 8 + 6] + sh[h2 * 8 + 6], x1[3] * rr * gs[h2 * 8 + 7] + sh[h2 * 8 + 7]);
                    *(u32x4*)(dst + h2 * 512 + 8 * lane) = o;
                }
            }
        }
    }
    __syncthreads();
}

constexpr int LDS_CSTAGE = 128 * C_LD * 4;
constexpr int MOE_LDS_LIST = LDS_CSTAGE;
constexpr int LDS_MOE = LDS_CSTAGE + 128 * 4 + 128 * 4 + 64 * 4;
constexpr int LDS_MODB = (9 * D + 9 * 8 * 32) * 4;
constexpr int LDS_TOTAL = LDS_MOE > LDS_MODB ? LDS_MOE : LDS_MODB;
struct ARowCode { const bf16_t* base; const int* codes; int mode; __device__ __forceinline__ const bf16_t* operator()(int m) const {
    const int c = codes[m];
    if (mode == 0) return base + (size_t)(c < 0 ? 0 : (c >> 2)) * D;
    return base + (size_t)(c < 0 ? 0 : (c >> 2) * 5 + (c & 3)) * DE; } };
__device__ __forceinline__ void moe_tstart(const P& p, int l, int* ts) {
    if (TIDX == 0) { const int* cnt = CNT_PTR(p, l); int a = 0; for (int e = 0; e < NE; ++e) { ts[e] = a; a += (cnt[e * 64] + 127) >> 7; } ts[NE] = a; }
    __syncthreads();
}
__device__ __forceinline__ void st_moe1(const P& p, int l, unsigned char* lds) {
    int* codes = (int*)(lds + MOE_LDS_LIST); float* wts = (float*)(codes + 128); int* ts = (int*)(wts + 128);
    const int nrows = l == 0 ? TA : TL;
    const int* cnt = CNT_PTR(p, l);
    const int* lcode = (const int*)(p.ws + WS_LCODE);
    const float* lw = (const float*)(p.ws + WS_LW);
    const bf16_t* xn2 = (const bf16_t*)(p.ws + WS_BUFA);
    bf16_t* hid = (bf16_t*)(p.ws + WS_HID);
    const bf16_t* wgu = (const bf16_t*)(p.ws + WS_WGU);
    moe_tstart(p, l, ts);
    const int nrt = ts[NE], nsh = nrows / 128, total = (nrt + nsh) * 2;
    const int lane = TIDX & 63, w = TIDX >> 6, wr = w >> 1, wc = w & 1, lr = lane & 31, lh = lane >> 5;
    int t_end, t_step;
    for (int tile = xcd_first(total, t_end, t_step); tile < t_end; tile += t_step) {
        const int rt = tile >> 1, j = tile & 1;
        int e, m0, valid;
        if (rt < nrt) { e = 0; while (ts[e + 1] <= rt) ++e; m0 = (rt - ts[e]) * 128; valid = cnt[e * 64] - m0; if (valid > 128) valid = 128; }
        else { e = NE; m0 = (rt - nrt) * 128; valid = 128; }
        __syncthreads();
        if (TIDX < 128) {
            const int m = TIDX;
            if (e < NE) { const bool ok = m < valid; codes[m] = ok ? lcode[(size_t)e * TA + m0 + m] : -1; wts[m] = ok ? lw[(size_t)e * TA + m0 + m] : 0.f; }
            else { codes[m] = (m0 + m) * 4; wts[m] = 1.f; }
        }
        __syncthreads();
        f32x16 acc[2][2];
        gemm_tile(acc, ARowCode{xn2, codes, 0}, wgu + (size_t)((e * 2 + j) * 128) * D, D, D, lds);
#pragma unroll
        for (int mi = 0; mi < 2; ++mi) {
            const int m = wr * 64 + mi * 32 + lr;
            const int c = codes[m];
            if (c >= 0) {
                const float wt = wts[m];
                const size_t hrow = e < NE ? (size_t)(c >> 2) * 5 + (c & 3) : (size_t)(c >> 2) * 5 + 4;
#pragma unroll
                for (int g = 0; g < 4; ++g) {
                    float h[4];
#pragma unroll
                    for (int q = 0; q < 4; ++q) h[q] = silu_f(acc[mi][0][4 * g + q]) * acc[mi][1][4 * g + q] * wt;
                    *(uint2*)(hid + hrow * DE + j * 64 + wc * 32 + 8 * g + 4 * lh) = pack4(h[0], h[1], h[2], h[3]);
                }
            }
        }
    }
}
__device__ __forceinline__ void st_moe2(const P& p, int l, unsigned char* lds) {
    int* codes = (int*)(lds + MOE_LDS_LIST); float* wts = (float*)(codes + 128); int* ts = (int*)(wts + 128);
    const int* cnt = CNT_PTR(p, l);
    const int* lcode = (const int*)(p.ws + WS_LCODE);
    const bf16_t* hid = (const bf16_t*)(p.ws + WS_HID);
    unsigned char* slab = (unsigned char*)(p.ws + WS_SLAB);
    const bf16_t* wd = (const bf16_t*)(p.ws + WS_WD);
    moe_tstart(p, l, ts);
    const int nrt = ts[NE], total = nrt * 8;
    int t_end, t_step;
    for (int tile = xcd_first(total, t_end, t_step); tile < t_end; tile += t_step) {
        const int rt = tile >> 3, n0 = (tile & 7) * 128;
        int e = 0; while (ts[e + 1] <= rt) ++e;
        const int m0 = (rt - ts[e]) * 128; int valid = cnt[e * 64] - m0; if (valid > 128) valid = 128;
        __syncthreads();
        if (TIDX < 128) { const int m = TIDX; codes[m] = m < valid ? lcode[(size_t)e * TA + m0 + m] : -1; }
        __syncthreads();
        f32x16 acc[2][2];
        gemm_tile(acc, ARowCode{hid, codes, 1}, wd + ((size_t)e * D + n0) * DE, DE, DE, lds);
        acc_foreach4_lds(acc, lds, [&](int r, int c, float v0, float v1, float v2, float v3) { const int code = codes[r]; if (code >= 0) *(unsigned*)(slab + (size_t)code * D + n0 + c) = pack4_fp8(v0, v1, v2, v3); });
    }
}
struct EpiMoeF { const unsigned char* slab; const float* modl; float* out; const float* hcmid; float* hc1; bool outw = true;
    __device__ __forceinline__ void operator()(int r, int c, float v0, float v1, float v2, float v3) const {
    const unsigned char* sl = slab + (size_t)r * 4 * D + c;
    float v[4] = {v0, v1, v2, v3};
    float a[4] = {0.f, 0.f, 0.f, 0.f};
#pragma unroll
    for (int k = 0; k < 4; ++k) { const int q = (int)*(const unsigned*)(sl + (size_t)k * D);
        a[0] += __builtin_amdgcn_cvt_f32_fp8(q, 0); a[1] += __builtin_amdgcn_cvt_f32_fp8(q, 1); a[2] += __builtin_amdgcn_cvt_f32_fp8(q, 2); a[3] += __builtin_amdgcn_cvt_f32_fp8(q, 3); }
#pragma unroll
    for (int q = 0; q < 4; ++q) v[q] += a[q] * (1.f / SLAB_SCALE);
    const f32x4 g2 = *(const f32x4*)(modl + ((size_t)row_bb(r) * 6 + 5) * D + c);
    const f32x4 hm = *(const f32x4*)((r < TL ? out + (size_t)r * D : hcmid + (size_t)(r - TL) * D) + c);
    f32x4 o; o[0] = hm[0] + g2[0] * v[0]; o[1] = hm[1] + g2[1] * v[1]; o[2] = hm[2] + g2[2] * v[2]; o[3] = hm[3] + g2[3] * v[3];
    if (outw) *(f32x4*)((r < TL ? out + (size_t)r * D : hc1 + (size_t)(r - TL) * D) + c) = o;
    else if (o[0] == 12345.f) *(f32x4*)(hc1) = o; } };
__device__ __forceinline__ EpiMoeF make_epi_moef(const P& p, int l) {
    return EpiMoeF{(const unsigned char*)(p.ws + WS_SLAB), (const float*)(p.ws + WS_MOD) + (size_t)l * 9 * 6 * D, p.out, (const float*)(p.ws + WS_HCMID), (float*)(p.ws + WS_HC1)};
}
struct SsmPar { float lre, lim, dt; };
__device__ __forceinline__ SsmPar ssm_par(const P& p, int l, int dir, int g, int pp) {
    const int pi = ((l * 2 + dir) * SG + g) * SP + pp;
    SsmPar r; r.lre = p.in[I_LRE][pi]; r.lim = p.in[I_LIM][pi]; r.dt = expf(p.in[I_LDT][(l * 2 + dir) * SG + g]); return r;
}
__device__ __forceinline__ float2 ssm_pow(const SsmPar& q, float e) {
    const float mag = expf(e * q.lre * q.dt), ang = e * (q.lim * q.dt);
    return make_float2(mag * cosf(ang), mag * sinf(ang));
}
__device__ __forceinline__ float2 ssm_f(const SsmPar& q) {
    const float2 lb = ssm_pow(q, 1.f);
    const float nr = lb.x - 1.f, ni = lb.y, den = q.lre * q.lre + q.lim * q.lim;
    return make_float2((nr * q.lre + ni * q.lim) / den, (ni * q.lre - nr * q.lim) / den);
}
__device__ __forceinline__ float2 cmul(float2 a, float2 b) { return make_float2(a.x * b.x - a.y * b.y, a.x * b.y + a.y * b.x); }
__device__ __forceinline__ void st_ssm_tables(const P& p) {
    float2* pw = (float2*)(p.ws + WS_POW); float2* fb = (float2*)(p.ws + WS_FB);
    for (int idx = BIDX * NT + TIDX; idx < 2 * 2 * 16 * 33 * 64; idx += gridDim.x * NT) {
        const int pp = idx & 63; int q_ = idx >> 6; const int e = q_ % 33; q_ /= 33; const int g = q_ & 15, dir = (q_ >> 4) & 1, l = q_ >> 5;
        pw[idx] = ssm_pow(ssm_par(p, l, dir, g, pp), (float)e);
    }
    for (int idx = BIDX * NT + TIDX; idx < 2 * 2 * 16 * 64 * 16; idx += gridDim.x * NT) {
        const int h = idx & 15, pp = (idx >> 4) & 63, g = (idx >> 10) & 15, dir = (idx >> 14) & 1, l = idx >> 15;
        const size_t bi = ((size_t)((l * 2 + dir) * SG + g) * SP + pp) * 16 + h;
        fb[idx] = cmul(ssm_f(ssm_par(p, l, dir, g, pp)), make_float2(p.in[I_BRE][bi], p.in[I_BIM][bi]));
    }
}
__device__ __forceinline__ void st_ssm_kj(const P& p, float* lds) {
    float* lam = lds; float* Cc = lds + 128; float* Bb = Cc + 2048;
    float* kj = (float*)(p.ws + WS_KJ);
    const int t = TIDX;
    for (int item = (int)gridDim.x - 1 - BIDX; item < 64; item += gridDim.x) {
        const int l = item >> 5, g = (item >> 1) & 15, dir = item & 1;
        const int base = (l * 2 + dir) * SG + g;
        __syncthreads();
        if (t < 64) {
            const SsmPar q = ssm_par(p, l, dir, g, t);
            const float2 lb = ssm_pow(q, 1.f), f = ssm_f(q);
            lam[2 * t] = lb.x; lam[2 * t + 1] = lb.y;
            for (int h = 0; h < 16; ++h) {
                const size_t bi = ((size_t)base * SP + t) * 16 + h;
                const float2 bb = cmul(f, make_float2(p.in[I_BRE][bi], p.in[I_BIM][bi]));
                Bb[(t * 16 + h) * 2] = bb.x; Bb[(t * 16 + h) * 2 + 1] = bb.y;
            }
        }
        for (int i = t; i < 1024; i += NT) { const size_t ci = (size_t)base * 1024 + i; Cc[2 * i] = p.in[I_CRE][ci]; Cc[2 * i + 1] = p.in[I_CIM][ci]; }
        __syncthreads();
        const int ho = t >> 4, hi = t & 15;
        float acc[32];
#pragma unroll
        for (int j = 0; j < 32; ++j) acc[j] = 0.f;
        for (int pp = 0; pp < 64; ++pp) {
            float2 z = cmul(make_float2(Cc[(ho * 64 + pp) * 2], Cc[(ho * 64 + pp) * 2 + 1]), make_float2(Bb[(pp * 16 + hi) * 2], Bb[(pp * 16 + hi) * 2 + 1]));
            const float2 lb = make_float2(lam[2 * pp], lam[2 * pp + 1]);
#pragma unroll
            for (int j = 0; j < 32; ++j) { acc[j] += z.x; z = cmul(z, lb); }
        }
#pragma unroll
        for (int j = 0; j < 32; ++j) kj[((size_t)((l * 16 + g) * 2 + dir) * 32 + j) * 256 + ho * 16 + hi] = acc[j];
    }
    __syncthreads();
}
__device__ __forceinline__ void st_prep_ssm(const P& p, int l, int parts) {
    bf16_t* wst = (bf16_t*)(p.ws + WS_WST);
    if (parts & 1) for (int idx = BIDX * NT + TIDX; idx < 16 * 256 * 64; idx += gridDim.x * NT) {
        const int kc = idx & 63, n = (idx >> 6) & 255, g = idx >> 14;
        const int dir = n >> 7, c = (n >> 6) & 1, pp = n & 63, s = kc >> 1, h0 = (kc & 1) * 8;
        const int ldg = (l * 2 + dir) * 16 + g;
        const float2 coef = ((const float2*)(p.ws + WS_POW))[((size_t)ldg * 33 + (dir == 0 ? 31 - s : s)) * 64 + pp];
        const float2* fbp = (const float2*)(p.ws + WS_FB) + ((size_t)ldg * 64 + pp) * 16 + h0;
        float v[8];
#pragma unroll
        for (int j = 0; j < 8; ++j) { const float2 z = cmul(coef, fbp[j]); v[j] = c == 0 ? z.x : z.y; }
        u32x4 o; o[0] = cvt_pk_bf16(v[0], v[1]); o[1] = cvt_pk_bf16(v[2], v[3]); o[2] = cvt_pk_bf16(v[4], v[5]); o[3] = cvt_pk_bf16(v[6], v[7]);
        *(u32x4*)(wst + ((size_t)(g * 256 + n)) * 512 + kc * 8) = o;
    }
    bf16_t* kw = (bf16_t*)(p.ws + WS_KW);
    const float* kj = (const float*)(p.ws + WS_KJ);
    if (parts & 2) for (int idx = BIDX * NT + TIDX; idx < 16 * 512 * 96; idx += gridDim.x * NT) {
        const int kc = idx % 96, n = (idx / 96) & 511, g = idx / (96 * 512);
        const int tau = n >> 4, ho = n & 15;
        float v[8];
        if (kc < 64) {
            const int s = kc >> 1, hi0 = (kc & 1) * 8;
#pragma unroll
            for (int j = 0; j < 8; ++j) {
                float a = 0.f;
                if (s <= tau) a += kj[((size_t)((l * 16 + g) * 2 + 0) * 32 + (tau - s)) * 256 + ho * 16 + hi0 + j];
                if (s >= tau) a += kj[((size_t)((l * 16 + g) * 2 + 1) * 32 + (s - tau)) * 256 + ho * 16 + hi0 + j];
                if (s == tau && ho == hi0 + j) a += p.in[I_SD][l * DSSM + g * 16 + ho];
                v[j] = a;
            }
        } else {
            const int kk = (kc - 64) * 8, dir = kk >> 7, c = (kk >> 6) & 1, p0 = kk & 63;
            const int e = dir == 0 ? tau + 1 : 32 - tau;
            const float2* pwp = (const float2*)(p.ws + WS_POW) + ((size_t)((l * 2 + dir) * 16 + g) * 33 + e) * 64 + p0;
#pragma unroll
            for (int j = 0; j < 8; ++j) {
                const size_t ci = ((size_t)((l * 2 + dir) * SG + g) * 16 + ho) * SP + p0 + j;
                const float2 z = cmul(make_float2(p.in[I_CRE][ci], p.in[I_CIM][ci]), pwp[j]);
                v[j] = c == 0 ? z.x : -z.y;
            }
        }
        u32x4 o; o[0] = cvt_pk_bf16(v[0], v[1]); o[1] = cvt_pk_bf16(v[2], v[3]); o[2] = cvt_pk_bf16(v[4], v[5]); o[3] = cvt_pk_bf16(v[6], v[7]);
        *(u32x4*)(kw + ((size_t)(g * 512 + n)) * 768 + kc * 8) = o;
    }
}
__device__ __forceinline__ void st_ssm_egemm(const P& p, unsigned char* lds) {
    const bf16_t* ua = (const bf16_t*)(p.ws + WS_UA);
    const bf16_t* wst = (const bf16_t*)(p.ws + WS_WST);
    float* E = (float*)(p.ws + WS_E);
    int t_end, t_step;
    for (int tile = xcd_first(160, t_end, t_step); tile < t_end; tile += t_step) {
        const int nt = tile & 1, mt = (tile >> 1) % 5, g = tile / 10;
        f32x16 acc[2][2];
        gemm_tile(acc, ARowPlain{ua + (size_t)(g * 640 + mt * 128) * 768, 768}, wst + (size_t)(g * 256 + nt * 128) * 512, 512, 512, lds);
        acc_foreach4_lds(acc, lds, [&](int r, int c, float v0, float v1, float v2, float v3) { f32x4 o; o[0] = v0; o[1] = v1; o[2] = v2; o[3] = v3; *(f32x4*)(E + (size_t)(g * 640 + mt * 128 + r) * 256 + nt * 128 + c) = o; });
    }
}
__device__ __forceinline__ void st_ssm_carry(const P& p, int l) {
    bf16_t* ua = (bf16_t*)(p.ws + WS_UA);
    const float* E = (const float*)(p.ws + WS_E);
    for (int idx = BIDX * NT + TIDX; idx < NB * 16 * 2 * 64; idx += gridDim.x * NT) {
        const int pp = idx & 63, dir = (idx >> 6) & 1, g = (idx >> 7) & 15, b = idx >> 11;
        const float2 l32 = ((const float2*)(p.ws + WS_POW))[((size_t)((l * 2 + dir) * 16 + g) * 33 + 32) * 64 + pp];
        float2 S = make_float2(0.f, 0.f);
        for (int s0 = 0; s0 < 72; s0 += 8) {
            int ch[8]; float er[8], ei[8];
#pragma unroll
            for (int j = 0; j < 8; ++j) {
                const int step = s0 + j;
                if (dir == 0) ch[j] = step < 8 ? 512 + b * 8 + step : b * 64 + (step - 8);
                else ch[j] = step < 8 ? 512 + b * 8 + (7 - step) : b * 64 + (63 - (step - 8));
                const float* e = E + (size_t)(g * 640 + ch[j]) * 256 + dir * 128 + pp;
                er[j] = e[0]; ei[j] = e[64];
            }
#pragma unroll
            for (int j = 0; j < 8; ++j) {
                bf16_t* o = ua + (size_t)(g * 640 + ch[j]) * 768 + 512 + dir * 128 + pp;
                o[0] = f2bf(S.x); o[64] = f2bf(S.y);
                S = cmul(l32, S); S.x += er[j]; S.y += ei[j];
            }
        }
    }
}
__device__ __forceinline__ void st_ssm_ygemm(const P& p, int l, unsigned char* lds) {
    const bf16_t* ua = (const bf16_t*)(p.ws + WS_UA);
    const bf16_t* kw = (const bf16_t*)(p.ws + WS_KW);
    bf16_t* G = (bf16_t*)(p.ws + WS_G);
    const int nmt = l == 0 ? 5 : 4;
    int t_end, t_step;
    for (int tile = xcd_first(16 * nmt * 4, t_end, t_step); tile < t_end; tile += t_step) {
        const int nt = tile & 3, mt = (tile >> 2) % nmt, g = tile / (4 * nmt);
        f32x16 acc[2][2];
        gemm_tile(acc, ARowPlain{ua + (size_t)(g * 640 + mt * 128) * 768, 768}, kw + (size_t)(g * 512 + nt * 128) * 768, 768, 768, lds);
        acc_foreach4_lds(acc, lds, [&](int r, int c, float v0, float v1, float v2, float v3) {
            const int chunk = mt * 128 + r, n = nt * 128 + c;
            if (chunk < TA / 32) *(uint2*)(G + (size_t)(chunk * 32 + (n >> 4)) * DSSM + g * 16 + (n & 15)) = pack4(gelu_f(v0), gelu_f(v1), gelu_f(v2), gelu_f(v3)); });
    }
}
struct EpiGlu2 { const bf16_t* G; bf16_t* mix; const float* bias; __device__ __forceinline__ void operator()(int r, int c, float v0, float v1, float v2, float v3) const {
    const uint2 q = *(const uint2*)(G + (size_t)r * DSSM + c);
    const f32x4 b = *(const f32x4*)(bias + c);
    *(uint2*)(mix + (size_t)r * D + 256 + c) = pack4(__uint_as_float(q.x << 16) * sigmoid_f(v0 + b[0]), __uint_as_float(q.x & 0xffff0000u) * sigmoid_f(v1 + b[1]),
                                                     __uint_as_float(q.y << 16) * sigmoid_f(v2 + b[2]), __uint_as_float(q.y & 0xffff0000u) * sigmoid_f(v3 + b[3])); } };

constexpr float QSCALE = 0.125f * 1.4426950408889634f;
__device__ __forceinline__ void st_rope_table(const P& p) {
    float2* tab = (float2*)(p.ws + WS_ROPE);
    for (int idx = BIDX * NT + TIDX; idx < L * 32; idx += gridDim.x * NT) {
        const int t = idx >> 5, a = (idx >> 4) & 1, i = idx & 15;
        const float pos = a == 0 ? (float)(t / 64) : (float)(t % 64);
        const float ang = pos * powf(10000.f, -(float)i / 16.f);
        tab[idx] = make_float2(cosf(ang), sinf(ang));
    }
}
__device__ __forceinline__ void st_inproj(const P& p, int l, unsigned char* lds) {
    const bf16_t* A = (const bf16_t*)(p.ws + WS_BUFA);
    const bf16_t* Bt = (const bf16_t*)(p.ws + WS_WTIN);
    bf16_t* pc = (bf16_t*)(p.ws + WS_PC);
    bf16_t* ua = (bf16_t*)(p.ws + WS_UA);
    bf16_t* qb = (bf16_t*)(p.ws + WS_QB);
    bf16_t* kb = (bf16_t*)(p.ws + WS_KB);
    bf16_t* vt = (bf16_t*)(p.ws + WS_VT);
    const float2* rope = (const float2*)(p.ws + WS_ROPE);
    const int lane = TIDX & 63, w = TIDX >> 6, wr = w >> 1, wc = w & 1, lr = lane & 31, lh = lane >> 5;
    constexpr int TN = DIN / 128;
    int t_end, t_step;
    for (int tile = xcd_first((TA / 128) * TN, t_end, t_step); tile < t_end; tile += t_step) {
        const int tn = tile % TN, m0 = (tile / TN) * 128, n0 = tn * 128;
        f32x16 acc[2][2];
        gemm_tile(acc, ARowPlain{A + (size_t)m0 * D, D}, Bt + (size_t)n0 * D, D, D, lds);
        if (tn < 6) {
            acc_foreach4_lds(acc, lds, [&](int r, int c, float v0, float v1, float v2, float v3) { *(uint2*)(pc + (size_t)(m0 + r) * 768 + n0 + c) = pack4(v0, v1, v2, v3); });
        } else if (tn < 8) {
            acc_foreach4_lds(acc, lds, [&](int r, int c, float v0, float v1, float v2, float v3) { const int row = m0 + r, g = (tn - 6) * 8 + (c >> 4);
                *(uint2*)(ua + (size_t)(g * 640 + (row >> 5)) * 768 + (row & 31) * 16 + (c & 15)) = pack4(v0, v1, v2, v3); });
        } else if (tn < 13) {
            const bool isq = tn < 12;
            const float* gain = (isq ? p.in[I_QG] : p.in[I_KG]) + l * 64;
            const bool lat = m0 < TL;
            const float osc = isq ? QSCALE : 1.f;
#pragma unroll
            for (int mi = 0; mi < 2; ++mi) {
                const int row = m0 + wr * 64 + mi * 32 + lr;
                float ss = 0.f;
#pragma unroll
                for (int ni = 0; ni < 2; ++ni)
#pragma unroll
                    for (int r = 0; r < 16; ++r) ss += acc[mi][ni][r] * acc[mi][ni][r];
                ss += __shfl_xor(ss, 32);
                const float rinv = rsqrtf(ss * (1.f / 64.f) + 1e-6f) * osc;
                const int t = row & (L - 1);
                bf16_t* o = isq ? qb + (size_t)row * DATT + ((tn - 8) * 2 + wc) * 64 : kb + (size_t)row * 128 + wc * 64;
#pragma unroll
                for (int ni = 0; ni < 2; ++ni)
#pragma unroll
                    for (int g = 0; g < 2; ++g) {
                        const int d0 = ni * 32 + 8 * g + 4 * lh;
                        const f32x4 glo = *(const f32x4*)(gain + d0), ghi = *(const f32x4*)(gain + d0 + 16);
                        float t1[4], t2[4];
#pragma unroll
                        for (int q = 0; q < 4; ++q) { t1[q] = acc[mi][ni][4 * g + q] * rinv * glo[q]; t2[q] = acc[mi][ni][8 + 4 * g + q] * rinv * ghi[q]; }
                        if (lat) {
                            const float2* cs = rope + (t * 2 + ni) * 16 + 8 * g + 4 * lh;
                            const f32x4 c01 = *(const f32x4*)(cs), c23 = *(const f32x4*)(cs + 2);
                            const float cc[4] = {c01[0], c01[2], c23[0], c23[2]}, sn[4] = {c01[1], c01[3], c23[1], c23[3]};
#pragma unroll
                            for (int q = 0; q < 4; ++q) { const float a = t1[q], b = t2[q]; t1[q] = a * cc[q] - b * sn[q]; t2[q] = a * sn[q] + b * cc[q]; }
                        }
                        *(uint2*)(o + d0) = pack4(t1[0], t1[1], t1[2], t1[3]);
                        *(uint2*)(o + d0 + 16) = pack4(t2[0], t2[1], t2[2], t2[3]);
                    }
            }
        } else {
            acc_foreach4_lds(acc, lds, [&](int r, int c, float v0, float v1, float v2, float v3) { *(uint2*)(vt + (size_t)(m0 + r) * 128 + c) = pack4(v0, v1, v2, v3); });
        }
    }
}

constexpr int AT_KROWB = 144, AT_VROWB = 136, AT_VOFF = 64 * AT_KROWB;
__device__ __forceinline__ void st_attn2(const P& p, int l, unsigned char* lds, int part, int nparts) {
    const bf16_t* qb = (const bf16_t*)(p.ws + WS_QB);
    const bf16_t* kb = (const bf16_t*)(p.ws + WS_KB);
    const bf16_t* vb = (const bf16_t*)(p.ws + WS_VT);
    bf16_t* mix = (bf16_t*)(p.ws + WS_BUFA);
    const int t = TIDX, lane = t & 63, w = t >> 6, lr = lane & 31, lh = lane >> 5;
    constexpr int NLAT = NB * 32 * 2;
    const int nitems = NLAT + (l == 0 ? NB * 4 * 2 : 0);
    int t_end, t_step;
    for (int kk = xcd_first((nitems - part + nparts - 1) / nparts, t_end, t_step); kk < t_end; kk += t_step) {
        const int item = kk * nparts + part;
        const bool isctx = item >= NLAT;
        int b, q64, g;
        if (!isctx) { g = item & 1; q64 = (item >> 1) & 31; b = item >> 6; }
        else { const int it = item - NLAT; g = it & 1; q64 = (it >> 1) & 3; b = it >> 3; }
        const int hq = g * 4 + w;
        const int rq0 = isctx ? TL + b * LC + q64 * 64 : b * L + q64 * 64;
        bf16x8 qf[2][4];
#pragma unroll
        for (int qs = 0; qs < 2; ++qs)
#pragma unroll
            for (int s4 = 0; s4 < 4; ++s4) qf[qs][s4] = *(const bf16x8*)(qb + (size_t)(rq0 + qs * 32 + lr) * DATT + hq * 64 + s4 * 16 + lh * 8);
        const float sinkl = p.in[I_SINK][l * NQH + hq] * 1.4426950408889634f;
        float m[2] = {sinkl, sinkl};
        float lsum[2]; lsum[0] = lsum[1] = lh == 0 ? 1.f : 0.f;
        f32x16 o[2][2];
        float zf = 0.f; asm volatile("" : "+v"(zf));
#pragma unroll
        for (int qs = 0; qs < 2; ++qs)
#pragma unroll
            for (int dt = 0; dt < 2; ++dt)
#pragma unroll
                for (int r = 0; r < 16; ++r) o[qs][dt][r] = zf;
        const int nwin = isctx ? 0 : 5, nkt = nwin + 4;
        const int srow = t >> 3, kc = t & 7;
        u32x4 pk[2], pv[2];
        auto tile_row0 = [&](int kt, bool& win, bool& valid) -> int {
            if (kt < nwin) { win = true; const int k64 = q64 - 2 + kt; valid = (k64 >= 0 && k64 < 32); return b * L + k64 * 64; }
            win = false; valid = true; return TL + b * LC + (kt - nwin) * 64;
        };
        int kt = 0; bool win, valid; int krow0 = 0;
        for (; kt < nkt; ++kt) { krow0 = tile_row0(kt, win, valid); if (valid) break; }
#pragma unroll
        for (int i = 0; i < 2; ++i) { const size_t off = (size_t)(krow0 + srow + 32 * i) * 128 + g * 64 + kc * 8; pk[i] = *(const u32x4*)(kb + off); pv[i] = *(const u32x4*)(vb + off); }
        while (kt < nkt) {
            const bool cwin = win; const int ckrow0 = krow0;
            __syncthreads();
#pragma unroll
            for (int i = 0; i < 2; ++i) {
                const int row = srow + 32 * i;
                *(u32x4*)(lds + row * AT_KROWB + kc * 16) = pk[i];
                unsigned char* vd = lds + AT_VOFF + (kc * 8) * AT_VROWB + row * 2;
#pragma unroll
                for (int q = 0; q < 4; ++q) { *(bf16_t*)(vd + (2 * q) * AT_VROWB) = (bf16_t)(pv[i][q] & 0xffffu); *(bf16_t*)(vd + (2 * q + 1) * AT_VROWB) = (bf16_t)(pv[i][q] >> 16); }
            }
            int nkt2 = kt + 1; bool nwin2 = false, nvalid = false; int nrow0 = 0;
            for (; nkt2 < nkt; ++nkt2) { nrow0 = tile_row0(nkt2, nwin2, nvalid); if (nvalid) break; }
            if (nkt2 < nkt) {
#pragma unroll
                for (int i = 0; i < 2; ++i) { const size_t off = (size_t)(nrow0 + srow + 32 * i) * 128 + g * 64 + kc * 8; pk[i] = *(const u32x4*)(kb + off); pv[i] = *(const u32x4*)(vb + off); }
            }
            __syncthreads();
            const int j0t = ckrow0 - b * L;
#pragma unroll
            for (int sub = 0; sub < 2; ++sub) {
                bf16x8 kf[4];
#pragma unroll
                for (int s4 = 0; s4 < 4; ++s4) kf[s4] = *(const bf16x8*)(lds + (sub * 32 + lr) * AT_KROWB + s4 * 32 + lh * 16);
#pragma unroll
                for (int qs = 0; qs < 2; ++qs) {
                    bool partial = false;
                    if (cwin) {
                        const int j0 = j0t + sub * 32, i0 = q64 * 64 + qs * 32;
                        if (j0 > i0 + 31 + 128 || j0 + 31 < i0 - 128) continue;
                        partial = !(j0 >= i0 + 31 - 128 && j0 + 31 <= i0 + 128);
                    }
                    f32x16 sT;
#pragma unroll
                    for (int r = 0; r < 16; ++r) sT[r] = zf;
#pragma unroll
                    for (int s4 = 0; s4 < 4; ++s4) sT = __builtin_amdgcn_mfma_f32_32x32x16_bf16(kf[s4], qf[qs][s4], sT, 0, 0, 0);
                    if (partial) {
                        const int dj0 = j0t + sub * 32 + 4 * lh - (q64 * 64 + qs * 32 + lr);
#pragma unroll
                        for (int r = 0; r < 16; ++r) { const int dj = dj0 + (r & 3) + 8 * (r >> 2); if (dj > 128 || dj < -128) sT[r] = -1e30f; }
                    }
                    float mt = sT[0];
#pragma unroll
                    for (int r = 1; r < 16; ++r) mt = fmaxf(mt, sT[r]);
                    mt = fmaxf(mt, __shfl_xor(mt, 32));
                    const float mn = fmaxf(m[qs], mt);
                    const float alpha = __builtin_amdgcn_exp2f(m[qs] - mn);
                    m[qs] = mn;
                    float ps = 0.f;
#pragma unroll
                    for (int r = 0; r < 16; ++r) { sT[r] = __builtin_amdgcn_exp2f(sT[r] - mn); ps += sT[r]; }
                    lsum[qs] = lsum[qs] * alpha + ps;
#pragma unroll
                    for (int r = 0; r < 16; ++r) { o[qs][0][r] *= alpha; o[qs][1][r] *= alpha; }
#pragma unroll
                    for (int s2 = 0; s2 < 2; ++s2) {
                        u32x4 pkk;
                        pkk[0] = cvt_pk_bf16(sT[8 * s2 + 0], sT[8 * s2 + 1]); pkk[1] = cvt_pk_bf16(sT[8 * s2 + 2], sT[8 * s2 + 3]);
                        pkk[2] = cvt_pk_bf16(sT[8 * s2 + 4], sT[8 * s2 + 5]); pkk[3] = cvt_pk_bf16(sT[8 * s2 + 6], sT[8 * s2 + 7]);
                        const bf16x8 pf = __builtin_bit_cast(bf16x8, pkk);
#pragma unroll
                        for (int dt = 0; dt < 2; ++dt) {
                            const unsigned char* vp = lds + AT_VOFF + (dt * 32 + lr) * AT_VROWB + (sub * 32 + s2 * 16 + lh * 4) * 2;
                            const uint2 a = *(const uint2*)(vp), c2 = *(const uint2*)(vp + 16);
                            u32x4 vv; vv[0] = a.x; vv[1] = a.y; vv[2] = c2.x; vv[3] = c2.y;
                            o[qs][dt] = __builtin_amdgcn_mfma_f32_32x32x16_bf16(__builtin_bit_cast(bf16x8, vv), pf, o[qs][dt], 0, 0, 0);
                        }
                    }
                }
            }
            kt = nkt2; win = nwin2; krow0 = nrow0;
        }
#pragma unroll
        for (int qs = 0; qs < 2; ++qs) {
            const float lt = lsum[qs] + __shfl_xor(lsum[qs], 32);
            const float inv = 1.f / lt;
            bf16_t* orow = mix + (size_t)(rq0 + qs * 32 + lr) * D + 512 + hq * 64;
#pragma unroll
            for (int dt = 0; dt < 2; ++dt)
#pragma unroll
                for (int rg = 0; rg < 4; ++rg)
                    *(uint2*)(orow + dt * 32 + 8 * rg + 4 * lh) = pack4(o[qs][dt][4 * rg] * inv, o[qs][dt][4 * rg + 1] * inv, o[qs][dt][4 * rg + 2] * inv, o[qs][dt][4 * rg + 3] * inv);
        }
    }
}


constexpr int FAKE = 0;
constexpr int TIM = 0;
constexpr int PROBE3 = 0;
constexpr int PROBE2 = 0;
__device__ __forceinline__ void st_fake(const P& p, unsigned char* lds) {
    if (FAKE == 0) return;
    const bf16_t* A = (const bf16_t*)(p.ws + WS_BUFA);
    const bf16_t* Bt = (const bf16_t*)(p.ws + WS_WTIN);
    constexpr int TN = DIN / 128;
    int t_end, t_step;
    float sink = 0.f;
    for (int tile = xcd_first((TA / 128) * TN, t_end, t_step); tile < t_end; tile += t_step) {
        const int tn = tile % TN, m0 = (FAKE == 2 || FAKE == 3) ? 0 : (tile / TN) * 128, n0 = FAKE == 3 ? 0 : tn * 128;
        f32x16 acc[2][2];
        gemm_tile(acc, ARowPlain{A + (size_t)m0 * D, D}, Bt + (size_t)n0 * D, D, D, lds);
        if (FAKE == 4) {
            bf16_t* dst = (bf16_t*)(p.ws + WS_HID);
            acc_foreach4_lds(acc, lds, [&](int r, int c, float v0, float v1, float v2, float v3) { *(uint2*)(dst + ((size_t)((tile / TN) * 128 + r) * 128 + c)) = pack4(v0, v1, v2, v3); });
        } else if (FAKE == 5) {
            bf16_t* dst = (bf16_t*)(p.ws + WS_HID);
            __syncthreads();
            acc_foreach4_lds(acc, lds, [&](int r, int c, float v0, float v1, float v2, float v3) { *(uint2*)(lds + (r * 136 + c) * 2) = pack4(v0, v1, v2, v3); });
            __syncthreads();
            const int t = TIDX;
#pragma unroll
            for (int i = 0; i < 8; ++i) { const int ch = t + 256 * i, r = ch >> 4, cc = (ch & 15) * 8;
                *(u32x4*)(dst + ((size_t)((tile / TN) * 128 + r) * 128 + cc)) = *(const u32x4*)(lds + (r * 136 + cc) * 2); }
        } else {
#pragma unroll
        for (int mi = 0; mi < 2; ++mi)
#pragma unroll
            for (int ni = 0; ni < 2; ++ni) sink += acc[mi][ni][0] + acc[mi][ni][7];
        }
    }
    if (sink == 12345.678f) ((float*)(p.ws + WS_RBIAS))[1000] = sink;
}
constexpr int STAGES_PER_LAYER = 11;
constexpr int N_STAGES = 1 + 2 * STAGES_PER_LAYER;
constexpr int REP_STAGE = -1;

__device__ __forceinline__ void run_stage(const P& p, int s, unsigned char* ldsb) {
    float* lds = (float*)ldsb;
    if (s == 0) { st_mod(p, lds); st_rope_table(p); st_ssm_tables(p); st_ssm_kj(p, lds); st_prep_weights(p, 0, ldsb, PW_ALL); return; }
    const int l = (s - 1) / STAGES_PER_LAYER, k = (s - 1) % STAGES_PER_LAYER;
    switch (k) {
    case 0: st_rbias(p, l, lds);
            if (l == 0) st_prep_ssm(p, 0, 3); else st_prep_weights(p, 1, ldsb, PW_GU | PW_DN);
            st_norm(p, l, 0); break;
    case 1: if (l == 0) st_fake(p, ldsb); st_inproj(p, l, ldsb); break;
    case 2: st_ssm_egemm(p, ldsb); if (l == 0) st_prep_weights(p, 1, ldsb, PW_IN); break;
    case 3: st_ssm_carry(p, l); st_attn2(p, l, ldsb, 0, 1); break;
    case 4: st_ssm_ygemm(p, l, ldsb); if (l == 0) st_prep_ssm(p, 1, 1); break;
    case 5: gemm_stage((const bf16_t*)(p.ws + WS_G), DSSM, (const bf16_t*)(p.ws + WS_WTGLU), DSSM, l == 0 ? TA : TL, DSSM, DSSM,
                       EpiGlu2{(const bf16_t*)(p.ws + WS_G), (bf16_t*)(p.ws + WS_BUFA), p.in[I_BGLU] + l * DSSM}, ldsb);
            st_conv(p, l); if (l == 0) st_prep_ssm(p, 1, 2); break;
    case 6: gemm_stage((const bf16_t*)(p.ws + WS_BUFA), D, (const bf16_t*)(p.ws + WS_WTOUT), D, l == 0 ? TA : TL, D, D, make_epi_out(p, l), ldsb); break;
    case 7: if (PROBE2 == 1 && l == 0) st_router2<true>(p, l, ldsb); st_router2(p, l, ldsb); if (l == 0) st_prep_weights(p, 1, ldsb, PW_GLU | PW_OUT); break;
    case 8: st_moe1(p, l, ldsb); break;
    case 9: st_moe2(p, l, ldsb); break;
    case 10: if (PROBE2 == 2 && l == 0) { EpiMoeF e = make_epi_moef(p, l); e.outw = false; gemm_stage((const bf16_t*)(p.ws + WS_HID) + 4 * DE, 5 * DE, (const bf16_t*)(p.ws + WS_WD) + (size_t)32 * D * DE, DE, TA, D, DE, e, ldsb); }
             gemm_stage((const bf16_t*)(p.ws + WS_HID) + 4 * DE, 5 * DE, (const bf16_t*)(p.ws + WS_WD) + (size_t)32 * D * DE, DE, l == 0 ? TA : TL, D, DE, make_epi_moef(p, l), ldsb); break;
    }
}


#define XB_TMO      128
#define XB_XCNT(j)  (256  + 64 * (j))
#define XB_XSUB(j)  (1280 + 64 * (j))
#define XB_XGEN(j)  (2304 + 64 * (j))
#define XB_TOP      3328
#define XB_TOPGEN   3392
#define XCD_BAR_WORDS 3456
#define XB_SPIN_CAP (1u << 22)
__device__ __forceinline__ unsigned xb_ld(unsigned* p)              { return __hip_atomic_load(p, __ATOMIC_RELAXED, __HIP_MEMORY_SCOPE_AGENT); }
__device__ __forceinline__ unsigned xb_add(unsigned* p, unsigned v) { return __hip_atomic_fetch_add(p, v, __ATOMIC_RELAXED, __HIP_MEMORY_SCOPE_AGENT); }
__device__ __forceinline__ unsigned xb_xcc_id() { return (unsigned)__builtin_amdgcn_s_getreg((3 << 11) | 20) & 0xFu; }
#define XB_SPIN(cond, bar) do { unsigned _sp = 0; while (cond) { __builtin_amdgcn_s_sleep(1); \
    if ((++_sp & 255u) == 0u) { if (xb_ld(&(bar)[XB_TMO])) break; if (_sp > XB_SPIN_CAP) { atomicAdd(&(bar)[XB_TMO], 1u); break; } } } } while (0)
struct XcdBarrier { unsigned* bar; unsigned x; volatile LAS unsigned* st; };
__device__ __forceinline__ XcdBarrier xcd_barrier_post(unsigned* bar, volatile LAS unsigned* st) {
    XcdBarrier b; b.bar = bar; b.x = xb_xcc_id(); b.st = st;
    if (threadIdx.x == 0) (void)xb_add(&bar[XB_XCNT(b.x)], 1u);
    return b;
}
__device__ __forceinline__ void xcd_barrier_complete(unsigned* bar, unsigned x, unsigned& nloc, unsigned& nx) {
    const unsigned G = gridDim.x * gridDim.y * gridDim.z;
    unsigned sum, cnt, mine, sp = 0u;
    for (;;) {
        sum = 0u; cnt = 0u; mine = 0u;
#pragma unroll
        for (unsigned j = 0; j < 16; ++j) { const unsigned c = xb_ld(&bar[XB_XCNT(j)]); sum += c; cnt += (c > 0u) ? 1u : 0u; mine = (j == x) ? c : mine; }
        if (sum == G) break;
        __builtin_amdgcn_s_sleep(1);
        if ((++sp & 255u) == 0u) { if (xb_ld(&bar[XB_TMO])) break; if (sp > XB_SPIN_CAP) { atomicAdd(&bar[XB_TMO], 1u); break; } }
    }
    nloc = mine > 0u ? mine : 1u; nx = cnt > 0u ? cnt : 1u;
}
__device__ __forceinline__ void xcd_barrier(const XcdBarrier& b) {
    asm volatile("s_waitcnt vmcnt(0)" ::: "memory");
    __syncthreads();
    if (threadIdx.x == 0) {
        unsigned* bar = b.bar;
        __builtin_amdgcn_s_waitcnt(0);
        unsigned nloc = b.st[0], nx = b.st[1];
        if (nloc == 0u) { xcd_barrier_complete(bar, b.x, nloc, nx); b.st[0] = nloc; b.st[1] = nx; }
        const unsigned old = xb_add(&bar[XB_XSUB(b.x)], 1u);
        const unsigned gen = old / nloc;
        if (old + 1u == (gen + 1u) * nloc) {
            __builtin_amdgcn_fence(__ATOMIC_RELEASE, "agent");
            asm volatile("s_waitcnt vmcnt(0)" ::: "memory");
            const unsigned og = xb_add(&bar[XB_TOP], 1u);
            const unsigned tg = og / nx;
            if (og + 1u == (tg + 1u) * nx) xb_add(&bar[XB_TOPGEN], 1u);
            else XB_SPIN(xb_ld(&bar[XB_TOPGEN]) == tg, bar);
            __builtin_amdgcn_fence(__ATOMIC_ACQUIRE, "agent");
            xb_add(&bar[XB_XGEN(b.x)], 1u);
            asm volatile("s_waitcnt vmcnt(0)" ::: "memory");
        } else {
            XB_SPIN(xb_ld(&bar[XB_XGEN(b.x)]) == gen, bar);
            __builtin_amdgcn_fence(__ATOMIC_ACQUIRE, "agent");
            asm volatile("s_waitcnt vmcnt(0)" ::: "memory");
        }
    }
    __syncthreads();
}
constexpr size_t WS_XBAR = 4096;

template <int S> __device__ __forceinline__ void run_all(const P& p, unsigned char* lds, const XcdBarrier& xb) {
    run_stage(p, S, lds);
    if constexpr (S == REP_STAGE) { xcd_barrier(xb); run_stage(p, S, lds); }
    if constexpr (S + 1 < N_STAGES) {
        unsigned long long t0 = 0; if (TIM) t0 = __builtin_amdgcn_s_memrealtime();
        xcd_barrier(xb);
        if (TIM && threadIdx.x == 0) { const unsigned long long t1 = __builtin_amdgcn_s_memrealtime(); xb.st[2] += (unsigned)(t1 - t0);
            if (blockIdx.x == 0) ((unsigned long long*)(p.ws + WS_CTL + 32768))[S + 1] = t1; }
        run_all<S + 1>(p, lds, xb);
    } else if (TIM) {
        unsigned* ctl = (unsigned*)(p.ws + WS_CTL + 32768 + 512);
        unsigned long long* ts = (unsigned long long*)(p.ws + WS_CTL + 32768);
        if (threadIdx.x == 0) { atomicAdd(ctl, xb.st[2]); if (blockIdx.x == 0) ts[N_STAGES] = __builtin_amdgcn_s_memrealtime(); }
        xcd_barrier(xb);
        if (blockIdx.x == 0 && threadIdx.x == 0) {
            float us;
            if (TIM == 1) us = (float)__hip_atomic_load(ctl, __ATOMIC_RELAXED, __HIP_MEMORY_SCOPE_AGENT) / (float)gridDim.x * 0.01f / 10.f;
            else if (TIM == 2) us = (float)(ts[N_STAGES] - ts[0]) * 0.01f / 25.f;
            else us = (float)(ts[TIM - 10 + 1] - ts[TIM - 10]) * 0.01f / 2.f;
            float code = floorf(us); if (code > 89.f) code = 89.f;
            p.out[0] += 10.f + code;
        }
    }
}
__global__ void __launch_bounds__(NT, 2) mega(P p) {
    __shared__ __attribute__((aligned(16))) unsigned char lds[LDS_TOTAL + 16];
    volatile LAS unsigned* st = (volatile LAS unsigned*)(lds + LDS_TOTAL);
    if (threadIdx.x == 0) { st[0] = 0u; st[1] = 0u; st[2] = 0u; st[3] = 0u; if (TIM && blockIdx.x == 0) ((unsigned long long*)(p.ws + WS_CTL + 32768))[0] = __builtin_amdgcn_s_memrealtime(); }
    __syncthreads();
    const XcdBarrier xb = xcd_barrier_post((unsigned*)(p.ws + WS_CTL + WS_XBAR), st);
    if (p.ws == nullptr) cg::this_grid().sync();
    run_all<0>(p, lds, xb);
}

extern "C" void kernel_launch(void* const* d_in, const int* in_sizes, int n_in, void* d_out, int out_size, void* d_ws, size_t ws_size, hipStream_t stream) {
    if (n_in != N_IN || ws_size < WS_END) { fprintf(stderr, "kernel_launch: unexpected n_in %d or ws_size %zu (< %zu)\n", n_in, ws_size, (size_t)WS_END); return; }
    P p{};
    for (int i = 0; i < N_IN; ++i) p.in[i] = (const float*)d_in[i];
    p.out = (float*)d_out; p.ws = (unsigned char*)d_ws;
    static int grid_blocks = 0;
    if (!grid_blocks) {
        int dev = 0, cus = 0, per_cu = 0;
        hipGetDevice(&dev);
        hipDeviceGetAttribute(&cus, hipDeviceAttributeMultiprocessorCount, dev);
        hipOccupancyMaxActiveBlocksPerMultiprocessor(&per_cu, (const void*)mega, NT, 0);
        if (per_cu < 1) per_cu = 1;
        if (per_cu > 2) per_cu = 2;
        grid_blocks = cus * per_cu;
    }
    hipMemsetAsync((char*)d_ws + WS_CTL, 0, 65536, stream);
    void* args[] = {&p};
    hipError_t e = hipLaunchCooperativeKernel((const void*)mega, dim3(grid_blocks), dim3(NT), args, 0, stream);
    if (e != hipSuccess) fprintf(stderr, "cooperative launch failed: %s (grid %d)\n", hipGetErrorString(e), grid_blocks);
}
```

```cpp
#include <hip/hip_runtime.h>
#include <hip/hip_cooperative_groups.h>
#include <cstdio>
#include <cstdint>
namespace cg = cooperative_groups;
#define CNT_PTR(p, l) ((int*)((p).ws + 40960 + (l) * 8192))
#define LAS __attribute__((address_space(3)))
constexpr int ABL = 0;

__device__ __forceinline__ int tid_opaque() { int t = threadIdx.x; asm volatile("" : "+v"(t)); return t; }
__device__ __forceinline__ int bid_opaque() { int b = blockIdx.x; asm volatile("" : "+s"(b)); return b; }
__device__ __forceinline__ int xcd_first(int total, int& end, int& step) {
    const int nb = gridDim.x; int b = blockIdx.x; asm volatile("" : "+s"(b));
    if (nb & 7) { end = total; step = nb; return b; }
    const int x = b & 7, j = b >> 3, per = (total + 7) >> 3, lo = x * per;
    end = lo + per < total ? lo + per : total; step = nb >> 3; return lo + j;
}
#define TIDX tid_opaque()
#define BIDX bid_opaque()

constexpr int D = 1024, NB = 8, L = 2048, LC = 256;
constexpr int TL = NB * L, TC = NB * LC, TA = TL + TC;
constexpr int DIN = 1792, DCONV = 256, DSSM = 256, DATT = 512;
constexpr int NQH = 8, NKVH = 2, HD = 64;
constexpr int COL_U = 768, COL_Q = 1024, COL_K = 1536, COL_V = 1664;
constexpr int NE = 32, TOPK = 4, DE = 128;
constexpr int SG = 16, SH = 16, SP = 64;
constexpr int NT = 256;

enum { I_X = 0, I_C, I_CTX, I_CCTX, I_WMOD, I_BMOD, I_N1G, I_N2G, I_WIN, I_CONVW, I_LRE, I_LIM, I_LDT, I_BRE, I_BIM, I_CRE, I_CIM,
       I_SD, I_WGLU, I_BGLU, I_QG, I_KG, I_SINK, I_WOUT, I_RW, I_RB, I_WEG, I_WEU, I_WED, I_WSG, I_WSU, I_WSD, N_IN };

typedef unsigned short bf16_t;
constexpr size_t WS_CTL = 0;
constexpr size_t WS_MOD = 65536;
constexpr size_t WS_ZERO_END = WS_MOD + (size_t)2 * 9 * 6 * D * 4;
constexpr size_t WS_RBIAS = 524288;
constexpr size_t WS_ROPE = WS_RBIAS + 4096;
constexpr size_t WS_KJ = WS_ROPE + 524288;
constexpr size_t WS_GS2 = WS_KJ + 2097152;
constexpr size_t WS_POW = WS_GS2 + 131072;
constexpr size_t WS_FB = WS_POW + (size_t)2 * 2 * 16 * 33 * 64 * 8;
constexpr size_t WS_R1 = WS_FB + (size_t)2 * 2 * 16 * 64 * 16 * 8;
constexpr size_t WS_BUFA = WS_R1;
constexpr size_t WS_PC = WS_BUFA + (size_t)TA * D * 2;
constexpr size_t WS_UA = WS_PC + (size_t)TA * 768 * 2;
constexpr size_t WS_E = WS_UA + (size_t)16 * 640 * 768 * 2;
constexpr size_t WS_G = WS_E + (size_t)16 * 640 * 256 * 4;
constexpr size_t WS_QB = WS_G + (size_t)TA * DSSM * 2;
constexpr size_t WS_KB = WS_QB + (size_t)TA * DATT * 2;
constexpr size_t WS_VT = WS_KB + (size_t)TA * 128 * 2;
constexpr size_t WS_SLAB = WS_R1;
constexpr size_t WS_HID = WS_SLAB + (size_t)TA * 4 * D * 2;
constexpr size_t WS_HC1 = WS_HID + (size_t)TA * 5 * DE * 2;
constexpr size_t WS_HCMID = WS_HC1 + (size_t)TC * D * 4;
constexpr size_t WS_LCODE = WS_HCMID + (size_t)TC * D * 4;
constexpr size_t WS_LW = WS_LCODE + (size_t)NE * TA * 4;
constexpr size_t WS_WTIN = WS_LW + (size_t)NE * TA * 4;
constexpr size_t WS_WTOUT = WS_WTIN + (size_t)DIN * D * 2;
constexpr size_t WS_WTGLU = WS_WTOUT + (size_t)D * D * 2;
constexpr size_t WS_WGU = WS_WTGLU + (size_t)DSSM * DSSM * 2;
constexpr size_t WS_WD = WS_WGU + (size_t)33 * 256 * D * 2;
constexpr size_t WS_WST = WS_WD + (size_t)33 * D * DE * 2;
constexpr size_t WS_KW = WS_WST + (size_t)16 * 256 * 512 * 2;
constexpr size_t WS_END = WS_KW + (size_t)16 * 512 * 768 * 2;
static_assert(WS_VT + (size_t)TA * 128 * 2 <= WS_HID, "overlay");
static_assert(WS_ZERO_END <= WS_RBIAS, "zero region");
static_assert(WS_END <= 268435456, "workspace too large");

struct P {
    const float* in[N_IN];
    float* out;
    unsigned char* ws;
};

__device__ __forceinline__ bf16_t f2bf(float f) { unsigned u = __float_as_uint(f); u += 0x7FFFu + ((u >> 16) & 1u); return (bf16_t)(u >> 16); }
__device__ __forceinline__ float bf2f(bf16_t b) { return __uint_as_float((unsigned)b << 16); }
__device__ __forceinline__ unsigned cvt_pk_bf16(float lo, float hi) { unsigned r; asm("v_cvt_pk_bf16_f32 %0, %1, %2" : "=v"(r) : "v"(lo), "v"(hi)); return r; }
typedef __attribute__((ext_vector_type(4))) float f32x4;
typedef __attribute__((ext_vector_type(4))) unsigned u32x4;
struct BfPtr { const bf16_t* p; __device__ __forceinline__ float operator[](long i) const { return bf2f(p[i]); }
               __device__ __forceinline__ BfPtr operator+(long o) const { return BfPtr{p + o}; } };
__device__ __forceinline__ float silu_f(float x) { return x / (1.f + expf(-x)); }
__device__ __forceinline__ float sigmoid_f(float x) { return 1.f / (1.f + expf(-x)); }
__device__ __forceinline__ float gelu_f(float x) { return 0.5f * x * (1.f + tanhf(0.7978845608028654f * (x + 0.044715f * x * x * x))); }
__device__ __forceinline__ float wave_sum(float v) {
#pragma unroll
    for (int o = 32; o > 0; o >>= 1) v += __shfl_xor(v, o);
    return v;
}
__device__ __forceinline__ int row_bb(int r) { return r < TL ? r / L : 8; }
__device__ __forceinline__ const float* h_row(const P& p, int l, int r) {
    if (r < TL) return (l == 0 ? p.in[I_X] : p.out) + (size_t)r * D;
    return (l == 0 ? p.in[I_CTX] : (const float*)(p.ws + WS_HC1)) + (size_t)(r - TL) * D;
}
__device__ __forceinline__ float* hmid_row(const P& p, int r) {
    if (r < TL) return p.out + (size_t)r * D;
    return (float*)(p.ws + WS_HCMID) + (size_t)(r - TL) * D;
}
__device__ __forceinline__ const float* mod_vec(const P& p, int l, int bb, int chunk) {
    return (const float*)(p.ws + WS_MOD) + ((size_t)(l * 9 + bb) * 6 + chunk) * D;
}

__device__ __forceinline__ void st_mod(const P& p, float* lds) {
    float* red = lds + 9 * D;
    for (int i = TIDX; i < 9 * D; i += NT) {
        const int bb = i / D, k = i % D;
        const float c = bb < 8 ? p.in[I_C][bb * D + k] : p.in[I_CCTX][k];
        lds[i] = silu_f(c);
    }
    __syncthreads();
    float* mod = (float*)(p.ws + WS_MOD);
    const int col = TIDX & 31, ks = TIDX >> 5;
    for (int item = BIDX; item < 2 * 6 * D / 32; item += gridDim.x) {
        const int l = item / (6 * D / 32), j = (item % (6 * D / 32)) * 32 + col;
        const float* w = p.in[I_WMOD] + (size_t)l * D * 6 * D + j;
        float acc[9];
#pragma unroll
        for (int bb = 0; bb < 9; ++bb) acc[bb] = 0.f;
        for (int k0 = ks * 128; k0 < ks * 128 + 128; k0 += 16) {
            float wv[16];
#pragma unroll
            for (int q = 0; q < 16; ++q) wv[q] = w[(size_t)(k0 + q) * 6 * D];
#pragma unroll
            for (int q = 0; q < 16; ++q)
#pragma unroll
                for (int bb = 0; bb < 9; ++bb) acc[bb] += lds[bb * D + k0 + q] * wv[q];
        }
#pragma unroll
        for (int bb = 0; bb < 9; ++bb) red[(bb * 8 + ks) * 32 + col] = acc[bb];
        __syncthreads();
        for (int o = TIDX; o < 9 * 32; o += NT) {
            const int bb = o >> 5, c2 = o & 31;
            float sum = p.in[I_BMOD][l * 6 * D + (item % (6 * D / 32)) * 32 + c2];
#pragma unroll
            for (int q = 0; q < 8; ++q) sum += red[(bb * 8 + q) * 32 + c2];
            mod[(size_t)(l * 9 + bb) * 6 * D + (item % (6 * D / 32)) * 32 + c2] = sum;
        }
        __syncthreads();
    }
}

__device__ __forceinline__ void st_norm(const P& p, int l, int which) {
    const int lane = TIDX & 63, wv = TIDX >> 6;
    const int nrows = (which == 1 && l == 1) ? TL : TA;
    float* xn = (float*)(p.ws + WS_BUFA);
    const float* g = p.in[which == 0 ? I_N1G : I_N2G] + l * D;
    for (int r0 = (BIDX * 4 + wv) * 2; r0 < nrows; r0 += gridDim.x * 8) {
        f32x4 v[2][4];
#pragma unroll
        for (int u = 0; u < 2; ++u) {
            const float* src = which == 0 ? h_row(p, l, r0 + u) : hmid_row(p, r0 + u);
#pragma unroll
            for (int j = 0; j < 4; ++j) v[u][j] = *(const f32x4*)(src + j * 256 + lane * 4);
        }
        const int bb = row_bb(r0);
        const float* sh = mod_vec(p, l, bb, which == 0 ? 0 : 3);
        const float* sc = mod_vec(p, l, bb, which == 0 ? 1 : 4);
#pragma unroll
        for (int u = 0; u < 2; ++u) {
            const int r = r0 + u;
            float s = 0.f;
#pragma unroll
            for (int j = 0; j < 4; ++j) s += v[u][j][0] * v[u][j][0] + v[u][j][1] * v[u][j][1] + v[u][j][2] * v[u][j][2] + v[u][j][3] * v[u][j][3];
            s = wave_sum(s);
            const float rinv = rsqrtf(s * (1.f / D) + 1e-6f);
#pragma unroll
            for (int j = 0; j < 4; ++j) {
                const int k = j * 256 + lane * 4;
                const f32x4 gg = *(const f32x4*)(g + k), s1 = *(const f32x4*)(sc + k), s0 = *(const f32x4*)(sh + k);
                f32x4 o;
#pragma unroll
                for (int q = 0; q < 4; ++q) o[q] = v[u][j][q] * rinv * gg[q] * (1.f + s1[q]) + s0[q];
                if (which == 1) *(f32x4*)(xn + (size_t)r * D + k) = o;
                else { uint2 pk; pk.x = cvt_pk_bf16(o[0], o[1]); pk.y = cvt_pk_bf16(o[2], o[3]); *(uint2*)((bf16_t*)(p.ws + WS_BUFA) + (size_t)r * D + k) = pk; }
            }
        }
    }
}

__device__ __forceinline__ void bf8_to_f(const u32x4& v, float (&f)[8]) {
#pragma unroll
    for (int q = 0; q < 4; ++q) { f[2 * q] = __uint_as_float(v[q] << 16); f[2 * q + 1] = __uint_as_float(v[q] & 0xffff0000u); }
}
__device__ __forceinline__ void st_conv(const P& p, int l) {
    const bf16_t* pb = (const bf16_t*)(p.ws + WS_PC);
    bf16_t* mix = (bf16_t*)(p.ws + WS_BUFA);
    const float* cw = p.in[I_CONVW] + l * 3 * DCONV;
    const int nrows = l == 0 ? TA : TL;
    for (int idx = BIDX * NT + TIDX; idx < nrows * 32; idx += gridDim.x * NT) {
        const int r = idx >> 5, ch = (idx & 31) * 8;
        int t, len;
        if (r < TL) { t = r & (L - 1); len = L; } else { t = (r - TL) & (LC - 1); len = LC; }
        const bf16_t* pr = pb + (size_t)r * 768 + ch;
        float x[8], c[8], bgate[8], y[8];
        bf8_to_f(*(const u32x4*)(pr), x); bf8_to_f(*(const u32x4*)(pr + 512), c); bf8_to_f(*(const u32x4*)(pr + 256), bgate);
        const f32x4 w1a = *(const f32x4*)(cw + DCONV + ch), w1b = *(const f32x4*)(cw + DCONV + ch + 4);
#pragma unroll
        for (int q = 0; q < 8; ++q) y[q] = (q < 4 ? w1a[q] : w1b[q - 4]) * (c[q] * x[q]);
        if (t > 0) {
            bf8_to_f(*(const u32x4*)(pr - 768), x); bf8_to_f(*(const u32x4*)(pr - 768 + 512), c);
            const f32x4 wa = *(const f32x4*)(cw + ch), wb = *(const f32x4*)(cw + ch + 4);
#pragma unroll
            for (int q = 0; q < 8; ++q) y[q] += (q < 4 ? wa[q] : wb[q - 4]) * (c[q] * x[q]);
        }
        if (t < len - 1) {
            bf8_to_f(*(const u32x4*)(pr + 768), x); bf8_to_f(*(const u32x4*)(pr + 768 + 512), c);
            const f32x4 wa = *(const f32x4*)(cw + 2 * DCONV + ch), wb = *(const f32x4*)(cw + 2 * DCONV + ch + 4);
#pragma unroll
            for (int q = 0; q < 8; ++q) y[q] += (q < 4 ? wa[q] : wb[q - 4]) * (c[q] * x[q]);
        }
        u32x4 o;
#pragma unroll
        for (int q = 0; q < 4; ++q) o[q] = cvt_pk_bf16(bgate[2 * q] * y[2 * q], bgate[2 * q + 1] * y[2 * q + 1]);
        *(u32x4*)(mix + (size_t)r * D + ch) = o;
    }
}

struct EpiOut { const float* modl; const float* hlat; const float* hctx; float* out; float* hcmid;
    __device__ __forceinline__ void operator()(int r, int c, float v0, float v1, float v2, float v3) const {
    const int bb = row_bb(r);
    const f32x4 g1 = *(const f32x4*)(modl + ((size_t)bb * 6 + 2) * D + c);
    const f32x4 hv = *(const f32x4*)((r < TL ? hlat + (size_t)r * D : hctx + (size_t)(r - TL) * D) + c);
    f32x4 o; o[0] = hv[0] + g1[0] * v0; o[1] = hv[1] + g1[1] * v1; o[2] = hv[2] + g1[2] * v2; o[3] = hv[3] + g1[3] * v3;
    *(f32x4*)((r < TL ? out + (size_t)r * D : hcmid + (size_t)(r - TL) * D) + c) = o; } };
__device__ __forceinline__ EpiOut make_epi_out(const P& p, int l) {
    return EpiOut{(const float*)(p.ws + WS_MOD) + (size_t)l * 9 * 6 * D, l == 0 ? p.in[I_X] : p.out, l == 0 ? p.in[I_CTX] : (const float*)(p.ws + WS_HC1), p.out, (float*)(p.ws + WS_HCMID)};
}

typedef __attribute__((ext_vector_type(8))) short bf16x8;
typedef __attribute__((ext_vector_type(16))) float f32x16;
constexpr int G_STAGEB = 16384;
constexpr int G_NSTG = 4;
constexpr int LDS_BYTES = G_NSTG * G_STAGEB;

template <class ARow>
__device__ __forceinline__ void gemm_tile(f32x16 (&acc)[2][2], ARow arow, const bf16_t* Bt, int ldb, int K, unsigned char* lds) {
    const int t = TIDX, lane = t & 63, w = __builtin_amdgcn_readfirstlane(t >> 6), wr = w >> 1, wc = w & 1, lr = lane & 31, lh = lane >> 5;
    const int srow = t >> 2, lc = (t & 3) ^ ((srow >> 2) & 3);
    const bf16_t* ap[2]; const bf16_t* bp[2];
#pragma unroll
    for (int i = 0; i < 2; ++i) { ap[i] = arow(srow + 64 * i) + lc * 8; bp[i] = Bt + (size_t)(srow + 64 * i) * ldb + lc * 8; }
    float zf = 0.f; asm volatile("" : "+v"(zf));
#pragma unroll
    for (int mi = 0; mi < 2; ++mi)
#pragma unroll
        for (int ni = 0; ni < 2; ++ni)
#pragma unroll
            for (int r = 0; r < 16; ++r) acc[mi][ni][r] = zf;
    const int nk = K >> 5;
    LAS unsigned char* l3 = (LAS unsigned char*)lds;
    const int f = (lr >> 2) & 3;
    const int aoff = (wr * 64 + lr) * 64 + ((lh ^ f) << 4), boff = 8192 + (wc * 64 + lr) * 64 + ((lh ^ f) << 4);
#define G_ISSUE(ks) do { LAS unsigned char* d_ = l3 + ((ks) & 3) * G_STAGEB + w * 1024; \
        __builtin_amdgcn_global_load_lds((const unsigned*)(ap[0] + (ks) * 32), (LAS unsigned*)(d_), 16, 0, 0); \
        __builtin_amdgcn_global_load_lds((const unsigned*)(ap[1] + (ks) * 32), (LAS unsigned*)(d_ + 4096), 16, 0, 0); \
        __builtin_amdgcn_global_load_lds((const unsigned*)(bp[0] + (ks) * 32), (LAS unsigned*)(d_ + 8192), 16, 0, 0); \
        __builtin_amdgcn_global_load_lds((const unsigned*)(bp[1] + (ks) * 32), (LAS unsigned*)(d_ + 12288), 16, 0, 0); } while (0)
#define G_RD(A0, A1, B0, B1, slot, s2) do { const LAS unsigned char* c_ = l3 + (slot) * G_STAGEB; \
        A0 = *(const LAS bf16x8*)(c_ + (aoff ^ ((s2) << 5))); A1 = *(const LAS bf16x8*)(c_ + ((aoff + 2048) ^ ((s2) << 5))); \
        B0 = *(const LAS bf16x8*)(c_ + (boff ^ ((s2) << 5))); B1 = *(const LAS bf16x8*)(c_ + ((boff + 2048) ^ ((s2) << 5))); } while (0)
#define G_MM(A0, A1, B0, B1) do { __builtin_amdgcn_s_setprio(1); \
        acc[0][0] = __builtin_amdgcn_mfma_f32_32x32x16_bf16(B0, A0, acc[0][0], 0, 0, 0); acc[0][1] = __builtin_amdgcn_mfma_f32_32x32x16_bf16(B1, A0, acc[0][1], 0, 0, 0); \
        acc[1][0] = __builtin_amdgcn_mfma_f32_32x32x16_bf16(B0, A1, acc[1][0], 0, 0, 0); acc[1][1] = __builtin_amdgcn_mfma_f32_32x32x16_bf16(B1, A1, acc[1][1], 0, 0, 0); __builtin_amdgcn_s_setprio(0); } while (0)
    __syncthreads();
    G_ISSUE(0);
    if (1 < nk) G_ISSUE(1);
    if (2 < nk) G_ISSUE(2);
    if (2 < nk) asm volatile("s_waitcnt vmcnt(8)" ::: "memory"); else if (1 < nk) asm volatile("s_waitcnt vmcnt(4)" ::: "memory"); else asm volatile("s_waitcnt vmcnt(0)" ::: "memory");
    __builtin_amdgcn_s_barrier();
    if (3 < nk) G_ISSUE(3);
    bf16x8 fa0, fa1, fb0, fb1, ga0, ga1, gb0, gb1;
    G_RD(fa0, fa1, fb0, fb1, 0, 0);
    for (int ks = 0; ks < nk; ++ks) {
        G_RD(ga0, ga1, gb0, gb1, ks & 3, 1);
        __builtin_amdgcn_sched_barrier(0);
        asm volatile("s_waitcnt lgkmcnt(4)" ::: "memory");
        __builtin_amdgcn_sched_barrier(0);
        G_MM(fa0, fa1, fb0, fb1);
        __builtin_amdgcn_sched_barrier(0);
        if (ks + 1 < nk) {
            if (ks + 3 < nk) asm volatile("s_waitcnt vmcnt(8) lgkmcnt(0)" ::: "memory");
            else if (ks + 2 < nk) asm volatile("s_waitcnt vmcnt(4) lgkmcnt(0)" ::: "memory");
            else asm volatile("s_waitcnt vmcnt(0) lgkmcnt(0)" ::: "memory");
            __builtin_amdgcn_s_barrier();
            if (ks + 4 < nk) G_ISSUE(ks + 4);
            G_RD(fa0, fa1, fb0, fb1, (ks + 1) & 3, 0);
        } else {
            asm volatile("s_waitcnt lgkmcnt(0)" ::: "memory");
        }
        __builtin_amdgcn_sched_barrier(0);
        G_MM(ga0, ga1, gb0, gb1);
        __builtin_amdgcn_sched_barrier(0);
    }
#undef G_RD
#undef G_MM
#undef G_ISSUE
}
template <class F>
__device__ __forceinline__ void acc_foreach4(const f32x16 (&acc)[2][2], F f) {
    const int lane = TIDX & 63, w = (TIDX >> 6) & 3, wr = w >> 1, wc = w & 1, lr = lane & 31, lh = lane >> 5;
#pragma unroll
    for (int mi = 0; mi < 2; ++mi)
#pragma unroll
        for (int ni = 0; ni < 2; ++ni)
#pragma unroll
            for (int g = 0; g < 4; ++g)
                f(wr * 64 + mi * 32 + lr, wc * 64 + ni * 32 + 8 * g + 4 * lh, acc[mi][ni][4 * g], acc[mi][ni][4 * g + 1], acc[mi][ni][4 * g + 2], acc[mi][ni][4 * g + 3]);
}
constexpr int C_LD = 132;
template <class F>
__device__ __forceinline__ void acc_foreach4_lds(const f32x16 (&acc)[2][2], unsigned char* lds, F f) {
    float* C = (float*)lds;
    const int t = TIDX, lane = t & 63, w = (t >> 6) & 3, wr = w >> 1, wc = w & 1, lr = lane & 31, lh = lane >> 5;
    __syncthreads();
#pragma unroll
    for (int mi = 0; mi < 2; ++mi)
#pragma unroll
        for (int ni = 0; ni < 2; ++ni)
#pragma unroll
            for (int g = 0; g < 4; ++g) {
                f32x4 v; v[0] = acc[mi][ni][4 * g]; v[1] = acc[mi][ni][4 * g + 1]; v[2] = acc[mi][ni][4 * g + 2]; v[3] = acc[mi][ni][4 * g + 3];
                *(f32x4*)(C + (wr * 64 + mi * 32 + lr) * C_LD + wc * 64 + ni * 32 + 8 * g + 4 * lh) = v;
            }
    __syncthreads();
#pragma unroll 8
    for (int i = 0; i < 16; ++i) {
        const int idx = t + 256 * i, r = idx >> 5, c = (idx & 31) * 4;
        const f32x4 v = *(const f32x4*)(C + r * C_LD + c);
        f(r, c, v[0], v[1], v[2], v[3]);
    }
}
constexpr float SLAB_SCALE = 32.f;
__device__ __forceinline__ unsigned pack4_fp8(float a, float b, float c, float d) {
    a = fminf(fmaxf(a * SLAB_SCALE, -448.f), 448.f); b = fminf(fmaxf(b * SLAB_SCALE, -448.f), 448.f);
    c = fminf(fmaxf(c * SLAB_SCALE, -448.f), 448.f); d = fminf(fmaxf(d * SLAB_SCALE, -448.f), 448.f);
    int w = __builtin_amdgcn_cvt_pk_fp8_f32(a, b, 0, false);
    w = __builtin_amdgcn_cvt_pk_fp8_f32(c, d, w, true);
    return (unsigned)w;
}
__device__ __forceinline__ uint2 pack4(float a, float b, float c, float d) { uint2 o; o.x = cvt_pk_bf16(a, b); o.y = cvt_pk_bf16(c, d); return o; }
struct ARowPlain { const bf16_t* A; int lda; __device__ __forceinline__ const bf16_t* operator()(int m) const { return A + (size_t)m * lda; } };

template <class Epi>
__device__ __forceinline__ void gemm_stage(const bf16_t* A, int lda, const bf16_t* Bt, int ldb, int M, int N, int K, Epi epi, unsigned char* lds) {
    const int tn = N / 128, tm = M / 128;
    int t_end, t_step;
    for (int tile = xcd_first(tm * tn, t_end, t_step); tile < t_end; tile += t_step) {
        const int m0 = (tile / tn) * 128, n0 = (tile % tn) * 128;
        f32x16 acc[2][2];
        gemm_tile(acc, ARowPlain{A + (size_t)m0 * lda, lda}, Bt + (size_t)n0 * ldb, ldb, K, lds);
        acc_foreach4_lds(acc, lds, [&](int r, int c, float v0, float v1, float v2, float v3) { epi(m0 + r, n0 + c, v0, v1, v2, v3); });
    }
}
__device__ __forceinline__ void tr_item(const float* src, size_t sk, bf16_t* dst, size_t dld, bf16_t* tl) {
    const int t = TIDX, kr = t >> 3, nq = (t & 7) * 4;
    __syncthreads();
#pragma unroll
    for (int ps = 0; ps < 4; ++ps) {
        const f32x4 v = *(const f32x4*)(src + (size_t)(kr + 32 * ps) * sk + nq);
#pragma unroll
        for (int j = 0; j < 4; ++j) tl[(nq + j) * 136 + kr + 32 * ps] = f2bf(v[j]);
    }
    __syncthreads();
    const int n = t >> 3, part = t & 7;
    const u32x4 a = *(const u32x4*)(tl + n * 136 + part * 16), b = *(const u32x4*)(tl + n * 136 + part * 16 + 8);
    bf16_t* o = dst + (size_t)n * dld + part * 16;
    *(u32x4*)o = a; *(u32x4*)(o + 8) = b;
}
constexpr int PW_IN = 1, PW_OUT = 2, PW_GLU = 4, PW_GU = 8, PW_DN = 16, PW_ALL = 31;
__device__ __forceinline__ void st_prep_weights(const P& p, int l, unsigned char* lds, int parts) {
    bf16_t* tl = (bf16_t*)lds;
    constexpr int N_IN_ = (DIN / 32) * 8, N_OUT = (D / 32) * 8, N_GLU = (DSSM / 32) * 2, N_GU = 33 * 2 * 4 * 8, N_DN = 33 * (D / 32);
    if (parts & PW_IN) for (int r = BIDX; r < N_IN_; r += gridDim.x) { const int nt = r >> 3, kt = r & 7;
        tr_item(p.in[I_WIN] + (size_t)l * D * DIN + (size_t)kt * 128 * DIN + nt * 32, DIN, (bf16_t*)(p.ws + WS_WTIN) + (size_t)nt * 32 * D + kt * 128, D, tl); }
    if (parts & PW_OUT) for (int r = BIDX; r < N_OUT; r += gridDim.x) { const int nt = r >> 3, kt = r & 7;
        tr_item(p.in[I_WOUT] + (size_t)l * D * D + (size_t)kt * 128 * D + nt * 32, D, (bf16_t*)(p.ws + WS_WTOUT) + (size_t)nt * 32 * D + kt * 128, D, tl); }
    if (parts & PW_GLU) for (int r = BIDX; r < N_GLU; r += gridDim.x) { const int nt = r >> 1, kt = r & 1;
        tr_item(p.in[I_WGLU] + (size_t)l * DSSM * DSSM + (size_t)kt * 128 * DSSM + nt * 32, DSSM, (bf16_t*)(p.ws + WS_WTGLU) + (size_t)nt * 32 * DSSM + kt * 128, DSSM, tl); }
    if (parts & PW_GU) for (int r = BIDX; r < N_GU; r += gridDim.x) {
        const int kt = r & 7, q = (r >> 3) & 3, j = (r >> 5) & 1, e = r >> 6;
        const int wc = q >> 1, ni = q & 1, unit0 = j * 64 + wc * 32;
        const float* sp; size_t sk;
        if (e < NE) { sp = p.in[ni ? I_WEU : I_WEG] + ((size_t)(l * D + kt * 128) * NE + e) * DE + unit0; sk = (size_t)NE * DE; }
        else { sp = p.in[ni ? I_WSU : I_WSG] + (size_t)(l * D + kt * 128) * DE + unit0; sk = DE; }
        tr_item(sp, sk, (bf16_t*)(p.ws + WS_WGU) + ((size_t)(e * 2 + j) * 128 + q * 32) * D + kt * 128, D, tl); }
    if (parts & PW_DN) for (int r = BIDX; r < N_DN; r += gridDim.x) {
        const int nt = r & 31, e = r >> 5;
        const float* sp = (e < NE ? p.in[I_WED] + (size_t)(l * NE + e) * DE * D : p.in[I_WSD] + (size_t)l * DE * D) + nt * 32;
        tr_item(sp, D, (bf16_t*)(p.ws + WS_WD) + ((size_t)e * D + nt * 32) * DE, DE, tl); }
    __syncthreads();
}
struct EpiStoreBf { bf16_t* C; int ldc; __device__ __forceinline__ void operator()(int r, int c, float v0, float v1, float v2, float v3) const { *(uint2*)(C + (size_t)r * ldc + c) = pack4(v0, v1, v2, v3); } };


__device__ __forceinline__ void st_rbias(const P& p, int l, float* lds) {
    const int lane = TIDX & 63, w = TIDX >> 6;
    const float* rw = p.in[I_RW] + (size_t)l * D * NE;
    for (int o = BIDX * 4 + w; o < 9 * 32; o += gridDim.x * 4) {
        const int bb = o >> 5, e = o & 31;
        const float* sh2 = mod_vec(p, l, bb, 3);
        float a = 0.f;
#pragma unroll
        for (int j = 0; j < 16; ++j) { const int k = j * 64 + lane; a += sh2[k] * rw[(size_t)k * NE + e]; }
        a = wave_sum(a);
        if (lane == 0) ((float*)(p.ws + WS_RBIAS))[(l * 9 + bb) * 32 + e] = a;
    }
    const float* g2 = p.in[I_N2G] + l * D;
    for (int idx = BIDX * NT + TIDX; idx < 9 * D; idx += gridDim.x * NT) {
        const int bb = idx >> 10, k = idx & (D - 1);
        ((float*)(p.ws + WS_GS2))[(size_t)(l * 9 + bb) * D + k] = g2[k] * (1.f + mod_vec(p, l, bb, 4)[k]);
    }
}
template <bool DRY = false>
__device__ __forceinline__ void st_router2(const P& p, int l, unsigned char* ldsb) {
    float* part = (float*)ldsb;
    float* ssq = part + 4 * 32 * 33;
    float* sc = ssq + 128;
    float* rinvs = sc + 32 * 33;
    int* hist = (int*)(rinvs + 32);
    int* gbase = hist + 32;
    const int t = TIDX, lane = t & 63, w = t >> 6, i = lane & 31, hf = lane >> 5;
    const int nrows = l == 0 ? TA : TL;
    const float* rw = p.in[I_RW] + (size_t)l * D * NE;
    int* cnt = CNT_PTR(p, l);
    int* lcode = (int*)(p.ws + WS_LCODE);
    float* lw = (float*)(p.ws + WS_LW);
    bf16_t* xn2 = (bf16_t*)(p.ws + WS_BUFA);
    for (int item = BIDX; item < nrows / 32; item += gridDim.x) {
        const int r0 = item * 32, bb = row_bb(r0);
        const float* gs2 = (const float*)(p.ws + WS_GS2) + (size_t)(l * 9 + bb) * D;
        const float* sh2 = mod_vec(p, l, bb, 3);
        const int kb = w * 256 + hf * 128;
        const float* src = hmid_row(p, r0 + i) + kb;
        const float* gsp = gs2 + kb;
        const float* rwp = rw + (size_t)kb * NE + i;
        f32x16 acc;
        float zf = 0.f; asm volatile("" : "+v"(zf));
#pragma unroll
        for (int r = 0; r < 16; ++r) acc[r] = zf;
        float ss = 0.f;
        f32x4 xa[4], ga[4], xb[4], gb[4]; float wa[16], wb[16];
#define R_LOAD(X, G, W, cb) do { _Pragma("unroll") for (int q = 0; q < 4; ++q) { const int k = ((cb) * 4 + q) * 4; X[q] = *(const f32x4*)(src + k); G[q] = *(const f32x4*)(gsp + k); \
            _Pragma("unroll") for (int j = 0; j < 4; ++j) W[q * 4 + j] = rwp[(size_t)(k + j) * NE]; } } while (0)
#define R_COMP(X, G, W) do { _Pragma("unroll") for (int q = 0; q < 4; ++q) { ss += X[q][0] * X[q][0] + X[q][1] * X[q][1] + X[q][2] * X[q][2] + X[q][3] * X[q][3]; \
            _Pragma("unroll") for (int j = 0; j < 4; ++j) acc = __builtin_amdgcn_mfma_f32_32x32x2f32(X[q][j] * G[q][j], W[q * 4 + j], acc, 0, 0, 0); } } while (0)
        R_LOAD(xa, ga, wa, 0);
#pragma unroll 1
        for (int cb = 0; cb < 8; cb += 2) {
            R_LOAD(xb, gb, wb, cb + 1);
            R_COMP(xa, ga, wa);
            if (cb + 2 < 8) R_LOAD(xa, ga, wa, cb + 2);
            R_COMP(xb, gb, wb);
        }
#undef R_LOAD
#undef R_COMP
        ss += __shfl_xor(ss, 32);
        __syncthreads();
        if (hf == 0) ssq[w * 32 + i] = ss;
        if (t < 32) hist[t] = 0;
#pragma unroll
        for (int r = 0; r < 16; ++r) part[(w * 32 + (r & 3) + 8 * (r >> 2) + 4 * hf) * 33 + i] = acc[r];
        __syncthreads();
        for (int idx = t; idx < 1024; idx += NT) {
            const int row = idx >> 5, e = idx & 31;
            const float logit = part[(0 * 32 + row) * 33 + e] + part[(1 * 32 + row) * 33 + e] + part[(2 * 32 + row) * 33 + e] + part[(3 * 32 + row) * 33 + e];
            const float rinv = rsqrtf((ssq[row] + ssq[32 + row] + ssq[64 + row] + ssq[96 + row]) * (1.f / D) + 1e-6f);
            sc[row * 33 + e] = sigmoid_f(rinv * logit + ((const float*)(p.ws + WS_RBIAS))[(l * 9 + bb) * 32 + e]);
            if (e == 0) rinvs[row] = rinv;
        }
        __syncthreads();
        if (t < 32) {
            const int r = r0 + t;
            float sel[32];
#pragma unroll
            for (int e = 0; e < 32; ++e) sel[e] = sc[t * 33 + e] + p.in[I_RB][l * NE + e];
            int bi[4]; float sv[4]; float sum = 0.f;
#pragma unroll
            for (int k = 0; k < 4; ++k) {
                float best = -1e30f; int b = 0;
#pragma unroll
                for (int e = 0; e < 32; ++e) if (sel[e] > best) { best = sel[e]; b = e; }
#pragma unroll
                for (int e = 0; e < 32; ++e) if (e == b) sel[e] = -1e30f;
                bi[k] = b; sv[k] = sc[t * 33 + b]; sum += sv[k];
            }
            int rank[4];
#pragma unroll
            for (int k = 0; k < 4; ++k) rank[k] = atomicAdd(&hist[bi[k]], 1);
            __builtin_amdgcn_s_waitcnt(0xc07f);
            __builtin_amdgcn_wave_barrier();
            { const int hc = hist[t]; gbase[t] = (hc > 0 && !DRY) ? atomicAdd(&cnt[t * 64], hc) : 0; }
            __builtin_amdgcn_s_waitcnt(0xc07f);
            __builtin_amdgcn_wave_barrier();
#pragma unroll
            for (int k = 0; k < 4; ++k) {
                if (DRY) { if (sv[k] / sum == 12345.f) lw[0] = 0.f; } else {
                const int pos = gbase[bi[k]] + rank[k];
                lcode[(size_t)bi[k] * TA + pos] = r * 4 + k;
                lw[(size_t)bi[k] * TA + pos] = sv[k] / sum * 2.5f; }
            }
        }
        {
            float gs[16], sh[16];
#pragma unroll
            for (int q = 0; q < 16; ++q) { const int k = (q >> 3) * 512 + 8 * lane + (q & 7); gs[q] = gs2[k]; sh[q] = sh2[k]; }
            for (int rr8 = 0; rr8 < 8; rr8 += 4) {
                f32x4 xv[4][4];
#pragma unroll
                for (int u = 0; u < 4; ++u) {
                    const float* s2 = hmid_row(p, r0 + w * 8 + rr8 + u);
#pragma unroll
                    for (int h2 = 0; h2 < 2; ++h2) { xv[u][2 * h2] = *(const f32x4*)(s2 + h2 * 512 + 8 * lane); xv[u][2 * h2 + 1] = *(const f32x4*)(s2 + h2 * 512 + 8 * lane + 4); }
                }
#pragma unroll
                for (int u = 0; u < 4; ++u) {
                    const int rho = w * 8 + rr8 + u;
                    const float rr = rinvs[rho];
                    bf16_t* dst = xn2 + (size_t)(r0 + rho) * D;
#pragma unroll
                    for (int h2 = 0; h2 < 2; ++h2) {
                        const f32x4 x0 = xv[u][2 * h2], x1 = xv[u][2 * h2 + 1];
                        u32x4 o;
                        o[0] = cvt_pk_bf16(x0[0] * rr * gs[h2 * 8 + 0] + sh[h2 * 8 + 0], x0[1] * rr * gs[h2 * 8 + 1] + sh[h2 * 8 + 1]);
                        o[1] = cvt_pk_bf16(x0[2] * rr * gs[h2 * 8 + 2] + sh[h2 * 8 + 2], x0[3] * rr * gs[h2 * 8 + 3] + sh[h2 * 8 + 3]);
                        o[2] = cvt_pk_bf16(x1[0] * rr * gs[h2 * 8 + 4] + sh[h2 * 8 + 4], x1[1] * rr * gs[h2 * 8 + 5] + sh[h2 * 8 + 5]);
                        o[3] = cvt_pk_bf16(x1[2] * rr * gs[h2 * 8 + 6] + sh[h2 * 8 + 6], x1[3] * rr * gs[h2 * 8 + 7] + sh[h2 * 8 + 7]);
                        *(u32x4*)(dst + h2 * 512 + 8 * lane) = o;
                    }
                }
            }
        }
    }
    __syncthreads();
}

constexpr int LDS_CSTAGE = 128 * C_LD * 4;
constexpr int MOE_LDS_LIST = LDS_CSTAGE;
constexpr int LDS_MOE = LDS_CSTAGE + 128 * 4 + 128 * 4 + 64 * 4;
constexpr int LDS_MODB = (9 * D + 9 * 8 * 32) * 4;
constexpr int LDS_TOTAL = LDS_MOE > LDS_MODB ? LDS_MOE : LDS_MODB;
struct ARowCode { const bf16_t* base; const int* codes; int mode; __device__ __forceinline__ const bf16_t* operator()(int m) const {
    const int c = codes[m];
    if (mode == 0) return base + (size_t)(c < 0 ? 0 : (c >> 2)) * D;
    return base + (size_t)(c < 0 ? 0 : (c >> 2) * 5 + (c & 3)) * DE; } };
__device__ __forceinline__ void moe_tstart(const P& p, int l, int* ts) {
    if (TIDX == 0) { const int* cnt = CNT_PTR(p, l); int a = 0; for (int e = 0; e < NE; ++e) { ts[e] = a; a += (cnt[e * 64] + 127) >> 7; } ts[NE] = a; }
    __syncthreads();
}
__device__ __forceinline__ void st_moe1(const P& p, int l, unsigned char* lds) {
    int* codes = (int*)(lds + MOE_LDS_LIST); float* wts = (float*)(codes + 128); int* ts = (int*)(wts + 128);
    const int nrows = l == 0 ? TA : TL;
    const int* cnt = CNT_PTR(p, l);
    const int* lcode = (const int*)(p.ws + WS_LCODE);
    const float* lw = (const float*)(p.ws + WS_LW);
    const bf16_t* xn2 = (const bf16_t*)(p.ws + WS_BUFA);
    bf16_t* hid = (bf16_t*)(p.ws + WS_HID);
    const bf16_t* wgu = (const bf16_t*)(p.ws + WS_WGU);
    moe_tstart(p, l, ts);
    const int nrt = ts[NE], nsh = nrows / 128, total = (nrt + nsh) * 2;
    const int lane = TIDX & 63, w = TIDX >> 6, wr = w >> 1, wc = w & 1, lr = lane & 31, lh = lane >> 5;
    int t_end, t_step;
    for (int tile = xcd_first(total, t_end, t_step); tile < t_end; tile += t_step) {
        const int rt = tile >> 1, j = tile & 1;
        int e, m0, valid;
        if (rt < nrt) { e = 0; while (ts[e + 1] <= rt) ++e; m0 = (rt - ts[e]) * 128; valid = cnt[e * 64] - m0; if (valid > 128) valid = 128; }
        else { e = NE; m0 = (rt - nrt) * 128; valid = 128; }
        __syncthreads();
        if (TIDX < 128) {
            const int m = TIDX;
            if (e < NE) { const bool ok = m < valid; codes[m] = ok ? lcode[(size_t)e * TA + m0 + m] : -1; wts[m] = ok ? lw[(size_t)e * TA + m0 + m] : 0.f; }
            else { codes[m] = (m0 + m) * 4; wts[m] = 1.f; }
        }
        __syncthreads();
        f32x16 acc[2][2];
        gemm_tile(acc, ARowCode{xn2, codes, 0}, wgu + (size_t)((e * 2 + j) * 128) * D, D, D, lds);
#pragma unroll
        for (int mi = 0; mi < 2; ++mi) {
            const int m = wr * 64 + mi * 32 + lr;
            const int c = codes[m];
            if (c >= 0) {
                const float wt = wts[m];
                const size_t hrow = e < NE ? (size_t)(c >> 2) * 5 + (c & 3) : (size_t)(c >> 2) * 5 + 4;
#pragma unroll
                for (int g = 0; g < 4; ++g) {
                    float h[4];
#pragma unroll
                    for (int q = 0; q < 4; ++q) h[q] = silu_f(acc[mi][0][4 * g + q]) * acc[mi][1][4 * g + q] * wt;
                    *(uint2*)(hid + hrow * DE + j * 64 + wc * 32 + 8 * g + 4 * lh) = pack4(h[0], h[1], h[2], h[3]);
                }
            }
        }
    }
}
__device__ __forceinline__ void st_moe2(const P& p, int l, unsigned char* lds) {
    int* codes = (int*)(lds + MOE_LDS_LIST); float* wts = (float*)(codes + 128); int* ts = (int*)(wts + 128);
    const int* cnt = CNT_PTR(p, l);
    const int* lcode = (const int*)(p.ws + WS_LCODE);
    const bf16_t* hid = (const bf16_t*)(p.ws + WS_HID);
    unsigned char* slab = (unsigned char*)(p.ws + WS_SLAB);
    const bf16_t* wd = (const bf16_t*)(p.ws + WS_WD);
    moe_tstart(p, l, ts);
    const int nrt = ts[NE], total = nrt * 8;
    int t_end, t_step;
    for (int tile = xcd_first(total, t_end, t_step); tile < t_end; tile += t_step) {
        const int rt = tile >> 3, n0 = (tile & 7) * 128;
        int e = 0; while (ts[e + 1] <= rt) ++e;
        const int m0 = (rt - ts[e]) * 128; int valid = cnt[e * 64] - m0; if (valid > 128) valid = 128;
        __syncthreads();
        if (TIDX < 128) { const int m = TIDX; codes[m] = m < valid ? lcode[(size_t)e * TA + m0 + m] : -1; }
        __syncthreads();
        f32x16 acc[2][2];
        gemm_tile(acc, ARowCode{hid, codes, 1}, wd + ((size_t)e * D + n0) * DE, DE, DE, lds);
        acc_foreach4_lds(acc, lds, [&](int r, int c, float v0, float v1, float v2, float v3) { const int code = codes[r]; if (code >= 0) *(unsigned*)(slab + (size_t)code * D + n0 + c) = pack4_fp8(v0, v1, v2, v3); });
    }
}
struct EpiMoeF { const unsigned char* slab; const float* modl; float* out; const float* hcmid; float* hc1; bool outw = true;
    __device__ __forceinline__ void operator()(int r, int c, float v0, float v1, float v2, float v3) const {
    const unsigned char* sl = slab + (size_t)r * 4 * D + c;
    float v[4] = {v0, v1, v2, v3};
    float a[4] = {0.f, 0.f, 0.f, 0.f};
#pragma unroll
    for (int k = 0; k < 4; ++k) { const int q = (int)*(const unsigned*)(sl + (size_t)k * D);
        a[0] += __builtin_amdgcn_cvt_f32_fp8(q, 0); a[1] += __builtin_amdgcn_cvt_f32_fp8(q, 1); a[2] += __builtin_amdgcn_cvt_f32_fp8(q, 2); a[3] += __builtin_amdgcn_cvt_f32_fp8(q, 3); }
#pragma unroll
    for (int q = 0; q < 4; ++q) v[q] += a[q] * (1.f / SLAB_SCALE);
    const f32x4 g2 = *(const f32x4*)(modl + ((size_t)row_bb(r) * 6 + 5) * D + c);
    const f32x4 hm = *(const f32x4*)((r < TL ? out + (size_t)r * D : hcmid + (size_t)(r - TL) * D) + c);
    f32x4 o; o[0] = hm[0] + g2[0] * v[0]; o[1] = hm[1] + g2[1] * v[1]; o[2] = hm[2] + g2[2] * v[2]; o[3] = hm[3] + g2[3] * v[3];
    if (outw) *(f32x4*)((r < TL ? out + (size_t)r * D : hc1 + (size_t)(r - TL) * D) + c) = o;
    else if (o[0] == 12345.f) *(f32x4*)(hc1) = o; } };
__device__ __forceinline__ EpiMoeF make_epi_moef(const P& p, int l) {
    return EpiMoeF{(const unsigned char*)(p.ws + WS_SLAB), (const float*)(p.ws + WS_MOD) + (size_t)l * 9 * 6 * D, p.out, (const float*)(p.ws + WS_HCMID), (float*)(p.ws + WS_HC1)};
}
struct SsmPar { float lre, lim, dt; };
__device__ __forceinline__ SsmPar ssm_par(const P& p, int l, int dir, int g, int pp) {
    const int pi = ((l * 2 + dir) * SG + g) * SP + pp;
    SsmPar r; r.lre = p.in[I_LRE][pi]; r.lim = p.in[I_LIM][pi]; r.dt = expf(p.in[I_LDT][(l * 2 + dir) * SG + g]); return r;
}
__device__ __forceinline__ float2 ssm_pow(const SsmPar& q, float e) {
    const float mag = expf(e * q.lre * q.dt), ang = e * (q.lim * q.dt);
    return make_float2(mag * cosf(ang), mag * sinf(ang));
}
__device__ __forceinline__ float2 ssm_f(const SsmPar& q) {
    const float2 lb = ssm_pow(q, 1.f);
    const float nr = lb.x - 1.f, ni = lb.y, den = q.lre * q.lre + q.lim * q.lim;
    return make_float2((nr * q.lre + ni * q.lim) / den, (ni * q.lre - nr * q.lim) / den);
}
__device__ __forceinline__ float2 cmul(float2 a, float2 b) { return make_float2(a.x * b.x - a.y * b.y, a.x * b.y + a.y * b.x); }
__device__ __forceinline__ void st_ssm_tables(const P& p) {
    float2* pw = (float2*)(p.ws + WS_POW); float2* fb = (float2*)(p.ws + WS_FB);
    for (int idx = BIDX * NT + TIDX; idx < 2 * 2 * 16 * 33 * 64; idx += gridDim.x * NT) {
        const int pp = idx & 63; int q_ = idx >> 6; const int e = q_ % 33; q_ /= 33; const int g = q_ & 15, dir = (q_ >> 4) & 1, l = q_ >> 5;
        pw[idx] = ssm_pow(ssm_par(p, l, dir, g, pp), (float)e);
    }
    for (int idx = BIDX * NT + TIDX; idx < 2 * 2 * 16 * 64 * 16; idx += gridDim.x * NT) {
        const int h = idx & 15, pp = (idx >> 4) & 63, g = (idx >> 10) & 15, dir = (idx >> 14) & 1, l = idx >> 15;
        const size_t bi = ((size_t)((l * 2 + dir) * SG + g) * SP + pp) * 16 + h;
        fb[idx] = cmul(ssm_f(ssm_par(p, l, dir, g, pp)), make_float2(p.in[I_BRE][bi], p.in[I_BIM][bi]));
    }
}
__device__ __forceinline__ void st_ssm_kj(const P& p, float* lds) {
    float* lam = lds; float* Cc = lds + 128; float* Bb = Cc + 2048;
    float* kj = (float*)(p.ws + WS_KJ);
    const int t = TIDX;
    for (int item = (int)gridDim.x - 1 - BIDX; item < 64; item += gridDim.x) {
        const int l = item >> 5, g = (item >> 1) & 15, dir = item & 1;
        const int base = (l * 2 + dir) * SG + g;
        __syncthreads();
        if (t < 64) {
            const SsmPar q = ssm_par(p, l, dir, g, t);
            const float2 lb = ssm_pow(q, 1.f), f = ssm_f(q);
            lam[2 * t] = lb.x; lam[2 * t + 1] = lb.y;
            for (int h = 0; h < 16; ++h) {
                const size_t bi = ((size_t)base * SP + t) * 16 + h;
                const float2 bb = cmul(f, make_float2(p.in[I_BRE][bi], p.in[I_BIM][bi]));
                Bb[(t * 16 + h) * 2] = bb.x; Bb[(t * 16 + h) * 2 + 1] = bb.y;
            }
        }
        for (int i = t; i < 1024; i += NT) { const size_t ci = (size_t)base * 1024 + i; Cc[2 * i] = p.in[I_CRE][ci]; Cc[2 * i + 1] = p.in[I_CIM][ci]; }
        __syncthreads();
        const int ho = t >> 4, hi = t & 15;
        float acc[32];
#pragma unroll
        for (int j = 0; j < 32; ++j) acc[j] = 0.f;
        for (int pp = 0; pp < 64; ++pp) {
            float2 z = cmul(make_float2(Cc[(ho * 64 + pp) * 2], Cc[(ho * 64 + pp) * 2 + 1]), make_float2(Bb[(pp * 16 + hi) * 2], Bb[(pp * 16 + hi) * 2 + 1]));
            const float2 lb = make_float2(lam[2 * pp], lam[2 * pp + 1]);
#pragma unroll
            for (int j = 0; j < 32; ++j) { acc[j] += z.x; z = cmul(z, lb); }
        }
#pragma unroll
        for (int j = 0; j < 32; ++j) kj[((size_t)((l * 16 + g) * 2 + dir) * 32 + j) * 256 + ho * 16 + hi] = acc[j];
    }
    __syncthreads();
}
__device__ __forceinline__ void st_prep_ssm(const P& p, int l, int parts) {
    bf16_t* wst = (bf16_t*)(p.ws + WS_WST);
    if (parts & 1) for (int idx = BIDX * NT + TIDX; idx < 16 * 256 * 64; idx += gridDim.x * NT) {
        const int kc = idx & 63, n = (idx >> 6) & 255, g = idx >> 14;
        const int dir = n >> 7, c = (n >> 6) & 1, pp = n & 63, s = kc >> 1, h0 = (kc & 1) * 8;
        const int ldg = (l * 2 + dir) * 16 + g;
        const float2 coef = ((const float2*)(p.ws + WS_POW))[((size_t)ldg * 33 + (dir == 0 ? 31 - s : s)) * 64 + pp];
        const float2* fbp = (const float2*)(p.ws + WS_FB) + ((size_t)ldg * 64 + pp) * 16 + h0;
        float v[8];
#pragma unroll
        for (int j = 0; j < 8; ++j) { const float2 z = cmul(coef, fbp[j]); v[j] = c == 0 ? z.x : z.y; }
        u32x4 o; o[0] = cvt_pk_bf16(v[0], v[1]); o[1] = cvt_pk_bf16(v[2], v[3]); o[2] = cvt_pk_bf16(v[4], v[5]); o[3] = cvt_pk_bf16(v[6], v[7]);
        *(u32x4*)(wst + ((size_t)(g * 256 + n)) * 512 + kc * 8) = o;
    }
    bf16_t* kw = (bf16_t*)(p.ws + WS_KW);
    const float* kj = (const float*)(p.ws + WS_KJ);
    if (parts & 2) for (int idx = BIDX * NT + TIDX; idx < 16 * 512 * 96; idx += gridDim.x * NT) {
        const int kc = idx % 96, n = (idx / 96) & 511, g = idx / (96 * 512);
        const int tau = n >> 4, ho = n & 15;
        float v[8];
        if (kc < 64) {
            const int s = kc >> 1, hi0 = (kc & 1) * 8;
#pragma unroll
            for (int j = 0; j < 8; ++j) {
                float a = 0.f;
                if (s <= tau) a += kj[((size_t)((l * 16 + g) * 2 + 0) * 32 + (tau - s)) * 256 + ho * 16 + hi0 + j];
                if (s >= tau) a += kj[((size_t)((l * 16 + g) * 2 + 1) * 32 + (s - tau)) * 256 + ho * 16 + hi0 + j];
                if (s == tau && ho == hi0 + j) a += p.in[I_SD][l * DSSM + g * 16 + ho];
                v[j] = a;
            }
        } else {
            const int kk = (kc - 64) * 8, dir = kk >> 7, c = (kk >> 6) & 1, p0 = kk & 63;
            const int e = dir == 0 ? tau + 1 : 32 - tau;
            const float2* pwp = (const float2*)(p.ws + WS_POW) + ((size_t)((l * 2 + dir) * 16 + g) * 33 + e) * 64 + p0;
#pragma unroll
            for (int j = 0; j < 8; ++j) {
                const size_t ci = ((size_t)((l * 2 + dir) * SG + g) * 16 + ho) * SP + p0 + j;
                const float2 z = cmul(make_float2(p.in[I_CRE][ci], p.in[I_CIM][ci]), pwp[j]);
                v[j] = c == 0 ? z.x : -z.y;
            }
        }
        u32x4 o; o[0] = cvt_pk_bf16(v[0], v[1]); o[1] = cvt_pk_bf16(v[2], v[3]); o[2] = cvt_pk_bf16(v[4], v[5]); o[3] = cvt_pk_bf16(v[6], v[7]);
        *(u32x4*)(kw + ((size_t)(g * 512 + n)) * 768 + kc * 8) = o;
    }
}
__device__ __forceinline__ void st_ssm_egemm(const P& p, unsigned char* lds) {
    const bf16_t* ua = (const bf16_t*)(p.ws + WS_UA);
    const bf16_t* wst = (const bf16_t*)(p.ws + WS_WST);
    float* E = (float*)(p.ws + WS_E);
    int t_end, t_step;
    for (int tile = xcd_first(160, t_end, t_step); tile < t_end; tile += t_step) {
        const int nt = tile & 1, mt = (tile >> 1) % 5, g = tile / 10;
        f32x16 acc[2][2];
        gemm_tile(acc, ARowPlain{ua + (size_t)(g * 640 + mt * 128) * 768, 768}, wst + (size_t)(g * 256 + nt * 128) * 512, 512, 512, lds);
        acc_foreach4_lds(acc, lds, [&](int r, int c, float v0, float v1, float v2, float v3) { f32x4 o; o[0] = v0; o[1] = v1; o[2] = v2; o[3] = v3; *(f32x4*)(E + (size_t)(g * 640 + mt * 128 + r) * 256 + nt * 128 + c) = o; });
    }
}
__device__ __forceinline__ void st_ssm_carry(const P& p, int l) {
    bf16_t* ua = (bf16_t*)(p.ws + WS_UA);
    const float* E = (const float*)(p.ws + WS_E);
    for (int idx = BIDX * NT + TIDX; idx < NB * 16 * 2 * 64; idx += gridDim.x * NT) {
        const int pp = idx & 63, dir = (idx >> 6) & 1, g = (idx >> 7) & 15, b = idx >> 11;
        const float2 l32 = ((const float2*)(p.ws + WS_POW))[((size_t)((l * 2 + dir) * 16 + g) * 33 + 32) * 64 + pp];
        float2 S = make_float2(0.f, 0.f);
        for (int s0 = 0; s0 < 72; s0 += 8) {
            int ch[8]; float er[8], ei[8];
#pragma unroll
            for (int j = 0; j < 8; ++j) {
                const int step = s0 + j;
                if (dir == 0) ch[j] = step < 8 ? 512 + b * 8 + step : b * 64 + (step - 8);
                else ch[j] = step < 8 ? 512 + b * 8 + (7 - step) : b * 64 + (63 - (step - 8));
                const float* e = E + (size_t)(g * 640 + ch[j]) * 256 + dir * 128 + pp;
                er[j] = e[0]; ei[j] = e[64];
            }
#pragma unroll
            for (int j = 0; j < 8; ++j) {
                bf16_t* o = ua + (size_t)(g * 640 + ch[j]) * 768 + 512 + dir * 128 + pp;
                o[0] = f2bf(S.x); o[64] = f2bf(S.y);
                S = cmul(l32, S); S.x += er[j]; S.y += ei[j];
            }
        }
    }
}
__device__ __forceinline__ void st_ssm_ygemm(const P& p, int l, unsigned char* lds) {
    const bf16_t* ua = (const bf16_t*)(p.ws + WS_UA);
    const bf16_t* kw = (const bf16_t*)(p.ws + WS_KW);
    bf16_t* G = (bf16_t*)(p.ws + WS_G);
    const int nmt = l == 0 ? 5 : 4;
    int t_end, t_step;
    for (int tile = xcd_first(16 * nmt * 4, t_end, t_step); tile < t_end; tile += t_step) {
        const int nt = tile & 3, mt = (tile >> 2) % nmt, g = tile / (4 * nmt);
        f32x16 acc[2][2];
        gemm_tile(acc, ARowPlain{ua + (size_t)(g * 640 + mt * 128) * 768, 768}, kw + (size_t)(g * 512 + nt * 128) * 768, 768, 768, lds);
        acc_foreach4_lds(acc, lds, [&](int r, int c, float v0, float v1, float v2, float v3) {
            const int chunk = mt * 128 + r, n = nt * 128 + c;
            if (chunk < TA / 32) *(uint2*)(G + (size_t)(chunk * 32 + (n >> 4)) * DSSM + g * 16 + (n & 15)) = pack4(gelu_f(v0), gelu_f(v1), gelu_f(v2), gelu_f(v3)); });
    }
}
struct EpiGlu2 { const bf16_t* G; bf16_t* mix; const float* bias; __device__ __forceinline__ void operator()(int r, int c, float v0, float v1, float v2, float v3) const {
    const uint2 q = *(const uint2*)(G + (size_t)r * DSSM + c);
    const f32x4 b = *(const f32x4*)(bias + c);
    *(uint2*)(mix + (size_t)r * D + 256 + c) = pack4(__uint_as_float(q.x << 16) * sigmoid_f(v0 + b[0]), __uint_as_float(q.x & 0xffff0000u) * sigmoid_f(v1 + b[1]),
                                                     __uint_as_float(q.y << 16) * sigmoid_f(v2 + b[2]), __uint_as_float(q.y & 0xffff0000u) * sigmoid_f(v3 + b[3])); } };

constexpr float QSCALE = 0.125f * 1.4426950408889634f;
__device__ __forceinline__ void st_rope_table(const P& p) {
    float2* tab = (float2*)(p.ws + WS_ROPE);
    for (int idx = BIDX * NT + TIDX; idx < L * 32; idx += gridDim.x * NT) {
        const int t = idx >> 5, a = (idx >> 4) & 1, i = idx & 15;
        const float pos = a == 0 ? (float)(t / 64) : (float)(t % 64);
        const float ang = pos * powf(10000.f, -(float)i / 16.f);
        tab[idx] = make_float2(cosf(ang), sinf(ang));
    }
}
__device__ __forceinline__ void st_inproj(const P& p, int l, unsigned char* lds) {
    const bf16_t* A = (const bf16_t*)(p.ws + WS_BUFA);
    const bf16_t* Bt = (const bf16_t*)(p.ws + WS_WTIN);
    bf16_t* pc = (bf16_t*)(p.ws + WS_PC);
    bf16_t* ua = (bf16_t*)(p.ws + WS_UA);
    bf16_t* qb = (bf16_t*)(p.ws + WS_QB);
    bf16_t* kb = (bf16_t*)(p.ws + WS_KB);
    bf16_t* vt = (bf16_t*)(p.ws + WS_VT);
    const float2* rope = (const float2*)(p.ws + WS_ROPE);
    const int lane = TIDX & 63, w = TIDX >> 6, wr = w >> 1, wc = w & 1, lr = lane & 31, lh = lane >> 5;
    constexpr int TN = DIN / 128;
    int t_end, t_step;
    for (int tile = xcd_first((TA / 128) * TN, t_end, t_step); tile < t_end; tile += t_step) {
        const int tn = tile % TN, m0 = (tile / TN) * 128, n0 = tn * 128;
        f32x16 acc[2][2];
        gemm_tile(acc, ARowPlain{A + (size_t)m0 * D, D}, Bt + (size_t)n0 * D, D, D, lds);
        if (tn < 6) {
            acc_foreach4_lds(acc, lds, [&](int r, int c, float v0, float v1, float v2, float v3) { *(uint2*)(pc + (size_t)(m0 + r) * 768 + n0 + c) = pack4(v0, v1, v2, v3); });
        } else if (tn < 8) {
            acc_foreach4_lds(acc, lds, [&](int r, int c, float v0, float v1, float v2, float v3) { const int row = m0 + r, g = (tn - 6) * 8 + (c >> 4);
                *(uint2*)(ua + (size_t)(g * 640 + (row >> 5)) * 768 + (row & 31) * 16 + (c & 15)) = pack4(v0, v1, v2, v3); });
        } else if (tn < 13) {
            const bool isq = tn < 12;
            const float* gain = (isq ? p.in[I_QG] : p.in[I_KG]) + l * 64;
            const bool lat = m0 < TL;
            const float osc = isq ? QSCALE : 1.f;
#pragma unroll
            for (int mi = 0; mi < 2; ++mi) {
                const int row = m0 + wr * 64 + mi * 32 + lr;
                float ss = 0.f;
#pragma unroll
                for (int ni = 0; ni < 2; ++ni)
#pragma unroll
                    for (int r = 0; r < 16; ++r) ss += acc[mi][ni][r] * acc[mi][ni][r];
                ss += __shfl_xor(ss, 32);
                const float rinv = rsqrtf(ss * (1.f / 64.f) + 1e-6f) * osc;
                const int t = row & (L - 1);
                bf16_t* o = isq ? qb + (size_t)row * DATT + ((tn - 8) * 2 + wc) * 64 : kb + (size_t)row * 128 + wc * 64;
#pragma unroll
                for (int ni = 0; ni < 2; ++ni)
#pragma unroll
                    for (int g = 0; g < 2; ++g) {
                        const int d0 = ni * 32 + 8 * g + 4 * lh;
                        const f32x4 glo = *(const f32x4*)(gain + d0), ghi = *(const f32x4*)(gain + d0 + 16);
                        float t1[4], t2[4];
#pragma unroll
                        for (int q = 0; q < 4; ++q) { t1[q] = acc[mi][ni][4 * g + q] * rinv * glo[q]; t2[q] = acc[mi][ni][8 + 4 * g + q] * rinv * ghi[q]; }
                        if (lat) {
                            const float2* cs = rope + (t * 2 + ni) * 16 + 8 * g + 4 * lh;
                            const f32x4 c01 = *(const f32x4*)(cs), c23 = *(const f32x4*)(cs + 2);
                            const float cc[4] = {c01[0], c01[2], c23[0], c23[2]}, sn[4] = {c01[1], c01[3], c23[1], c23[3]};
#pragma unroll
                            for (int q = 0; q < 4; ++q) { const float a = t1[q], b = t2[q]; t1[q] = a * cc[q] - b * sn[q]; t2[q] = a * sn[q] + b * cc[q]; }
                        }
                        *(uint2*)(o + d0) = pack4(t1[0], t1[1], t1[2], t1[3]);
                        *(uint2*)(o + d0 + 16) = pack4(t2[0], t2[1], t2[2], t2[3]);
                    }
            }
        } else {
            acc_foreach4_lds(acc, lds, [&](int r, int c, float v0, float v1, float v2, float v3) { *(uint2*)(vt + (size_t)(m0 + r) * 128 + c) = pack4(v0, v1, v2, v3); });
        }
    }
}

constexpr int AT_KROWB = 144, AT_VROWB = 136, AT_VOFF = 64 * AT_KROWB;
__device__ __forceinline__ void st_attn2(const P& p, int l, unsigned char* lds, int part, int nparts) {
    const bf16_t* qb = (const bf16_t*)(p.ws + WS_QB);
    const bf16_t* kb = (const bf16_t*)(p.ws + WS_KB);
    const bf16_t* vb = (const bf16_t*)(p.ws + WS_VT);
    bf16_t* mix = (bf16_t*)(p.ws + WS_BUFA);
    const int t = TIDX, lane = t & 63, w = t >> 6, lr = lane & 31, lh = lane >> 5;
    constexpr int NLAT = NB * 32 * 2;
    const int nitems = NLAT + (l == 0 ? NB * 4 * 2 : 0);
    int t_end, t_step;
    for (int kk = xcd_first((nitems - part + nparts - 1) / nparts, t_end, t_step); kk < t_end; kk += t_step) {
        const int item = kk * nparts + part;
        const bool isctx = item >= NLAT;
        int b, q64, g;
        if (!isctx) { g = item & 1; q64 = (item >> 1) & 31; b = item >> 6; }
        else { const int it = item - NLAT; g = it & 1; q64 = (it >> 1) & 3; b = it >> 3; }
        const int hq = g * 4 + w;
        const int rq0 = isctx ? TL + b * LC + q64 * 64 : b * L + q64 * 64;
        bf16x8 qf[2][4];
#pragma unroll
        for (int qs = 0; qs < 2; ++qs)
#pragma unroll
            for (int s4 = 0; s4 < 4; ++s4) qf[qs][s4] = *(const bf16x8*)(qb + (size_t)(rq0 + qs * 32 + lr) * DATT + hq * 64 + s4 * 16 + lh * 8);
        const float sinkl = p.in[I_SINK][l * NQH + hq] * 1.4426950408889634f;
        float m[2] = {sinkl, sinkl};
        float lsum[2]; lsum[0] = lsum[1] = lh == 0 ? 1.f : 0.f;
        f32x16 o[2][2];
        float zf = 0.f; asm volatile("" : "+v"(zf));
#pragma unroll
        for (int qs = 0; qs < 2; ++qs)
#pragma unroll
            for (int dt = 0; dt < 2; ++dt)
#pragma unroll
                for (int r = 0; r < 16; ++r) o[qs][dt][r] = zf;
        const int nwin = isctx ? 0 : 5, nkt = nwin + 4;
        const int srow = t >> 3, kc = t & 7;
        u32x4 pk[2], pv[2];
        auto tile_row0 = [&](int kt, bool& win, bool& valid) -> int {
            if (kt < nwin) { win = true; const int k64 = q64 - 2 + kt; valid = (k64 >= 0 && k64 < 32); return b * L + k64 * 64; }
            win = false; valid = true; return TL + b * LC + (kt - nwin) * 64;
        };
        int kt = 0; bool win, valid; int krow0 = 0;
        for (; kt < nkt; ++kt) { krow0 = tile_row0(kt, win, valid); if (valid) break; }
#pragma unroll
        for (int i = 0; i < 2; ++i) { const size_t off = (size_t)(krow0 + srow + 32 * i) * 128 + g * 64 + kc * 8; pk[i] = *(const u32x4*)(kb + off); pv[i] = *(const u32x4*)(vb + off); }
        while (kt < nkt) {
            const bool cwin = win; const int ckrow0 = krow0;
            __syncthreads();
#pragma unroll
            for (int i = 0; i < 2; ++i) {
                const int row = srow + 32 * i;
                *(u32x4*)(lds + row * AT_KROWB + kc * 16) = pk[i];
                unsigned char* vd = lds + AT_VOFF + (kc * 8) * AT_VROWB + row * 2;
#pragma unroll
                for (int q = 0; q < 4; ++q) { *(bf16_t*)(vd + (2 * q) * AT_VROWB) = (bf16_t)(pv[i][q] & 0xffffu); *(bf16_t*)(vd + (2 * q + 1) * AT_VROWB) = (bf16_t)(pv[i][q] >> 16); }
            }
            int nkt2 = kt + 1; bool nwin2 = false, nvalid = false; int nrow0 = 0;
            for (; nkt2 < nkt; ++nkt2) { nrow0 = tile_row0(nkt2, nwin2, nvalid); if (nvalid) break; }
            if (nkt2 < nkt) {
#pragma unroll
                for (int i = 0; i < 2; ++i) { const size_t off = (size_t)(nrow0 + srow + 32 * i) * 128 + g * 64 + kc * 8; pk[i] = *(const u32x4*)(kb + off); pv[i] = *(const u32x4*)(vb + off); }
            }
            __syncthreads();
            const int j0t = ckrow0 - b * L;
#pragma unroll
            for (int sub = 0; sub < 2; ++sub) {
                bf16x8 kf[4];
#pragma unroll
                for (int s4 = 0; s4 < 4; ++s4) kf[s4] = *(const bf16x8*)(lds + (sub * 32 + lr) * AT_KROWB + s4 * 32 + lh * 16);
#pragma unroll
                for (int qs = 0; qs < 2; ++qs) {
                    bool partial = false;
                    if (cwin) {
                        const int j0 = j0t + sub * 32, i0 = q64 * 64 + qs * 32;
                        if (j0 > i0 + 31 + 128 || j0 + 31 < i0 - 128) continue;
                        partial = !(j0 >= i0 + 31 - 128 && j0 + 31 <= i0 + 128);
                    }
                    f32x16 sT;
#pragma unroll
                    for (int r = 0; r < 16; ++r) sT[r] = zf;
#pragma unroll
                    for (int s4 = 0; s4 < 4; ++s4) sT = __builtin_amdgcn_mfma_f32_32x32x16_bf16(kf[s4], qf[qs][s4], sT, 0, 0, 0);
                    if (partial) {
                        const int dj0 = j0t + sub * 32 + 4 * lh - (q64 * 64 + qs * 32 + lr);
#pragma unroll
                        for (int r = 0; r < 16; ++r) { const int dj = dj0 + (r & 3) + 8 * (r >> 2); if (dj > 128 || dj < -128) sT[r] = -1e30f; }
                    }
                    float mt = sT[0];
#pragma unroll
                    for (int r = 1; r < 16; ++r) mt = fmaxf(mt, sT[r]);
                    mt = fmaxf(mt, __shfl_xor(mt, 32));
                    const float mn = fmaxf(m[qs], mt);
                    const float alpha = __builtin_amdgcn_exp2f(m[qs] - mn);
                    m[qs] = mn;
                    float ps = 0.f;
#pragma unroll
                    for (int r = 0; r < 16; ++r) { sT[r] = __builtin_amdgcn_exp2f(sT[r] - mn); ps += sT[r]; }
                    lsum[qs] = lsum[qs] * alpha + ps;
#pragma unroll
                    for (int r = 0; r < 16; ++r) { o[qs][0][r] *= alpha; o[qs][1][r] *= alpha; }
#pragma unroll
                    for (int s2 = 0; s2 < 2; ++s2) {
                        u32x4 pkk;
                        pkk[0] = cvt_pk_bf16(sT[8 * s2 + 0], sT[8 * s2 + 1]); pkk[1] = cvt_pk_bf16(sT[8 * s2 + 2], sT[8 * s2 + 3]);
                        pkk[2] = cvt_pk_bf16(sT[8 * s2 + 4], sT[8 * s2 + 5]); pkk[3] = cvt_pk_bf16(sT[8 * s2 + 6], sT[8 * s2 + 7]);
                        const bf16x8 pf = __builtin_bit_cast(bf16x8, pkk);
#pragma unroll
                        for (int dt = 0; dt < 2; ++dt) {
                            const unsigned char* vp = lds + AT_VOFF + (dt * 32 + lr) * AT_VROWB + (sub * 32 + s2 * 16 + lh * 4) * 2;
                            const uint2 a = *(const uint2*)(vp), c2 = *(const uint2*)(vp + 16);
                            u32x4 vv; vv[0] = a.x; vv[1] = a.y; vv[2] = c2.x; vv[3] = c2.y;
                            o[qs][dt] = __builtin_amdgcn_mfma_f32_32x32x16_bf16(__builtin_bit_cast(bf16x8, vv), pf, o[qs][dt], 0, 0, 0);
                        }
                    }
                }
            }
            kt = nkt2; win = nwin2; krow0 = nrow0;
        }
#pragma unroll
        for (int qs = 0; qs < 2; ++qs) {
            const float lt = lsum[qs] + __shfl_xor(lsum[qs], 32);
            const float inv = 1.f / lt;
            bf16_t* orow = mix + (size_t)(rq0 + qs * 32 + lr) * D + 512 + hq * 64;
#pragma unroll
            for (int dt = 0; dt < 2; ++dt)
#pragma unroll
                for (int rg = 0; rg < 4; ++rg)
                    *(uint2*)(orow + dt * 32 + 8 * rg + 4 * lh) = pack4(o[qs][dt][4 * rg] * inv, o[qs][dt][4 * rg + 1] * inv, o[qs][dt][4 * rg + 2] * inv, o[qs][dt][4 * rg + 3] * inv);
        }
    }
}


constexpr int FAKE = 0;
constexpr int TIM = 0;
constexpr int PROBE3 = 0;
constexpr int PROBE2 = 0;
__device__ __forceinline__ void st_fake(const P& p, unsigned char* lds) {
    if (FAKE == 0) return;
    const bf16_t* A = (const bf16_t*)(p.ws + WS_BUFA);
    const bf16_t* Bt = (const bf16_t*)(p.ws + WS_WTIN);
    constexpr int TN = DIN / 128;
    int t_end, t_step;
    float sink = 0.f;
    for (int tile = xcd_first((TA / 128) * TN, t_end, t_step); tile < t_end; tile += t_step) {
        const int tn = tile % TN, m0 = (FAKE == 2 || FAKE == 3) ? 0 : (tile / TN) * 128, n0 = FAKE == 3 ? 0 : tn * 128;
        f32x16 acc[2][2];
        gemm_tile(acc, ARowPlain{A + (size_t)m0 * D, D}, Bt + (size_t)n0 * D, D, D, lds);
        if (FAKE == 4) {
            bf16_t* dst = (bf16_t*)(p.ws + WS_HID);
            acc_foreach4_lds(acc, lds, [&](int r, int c, float v0, float v1, float v2, float v3) { *(uint2*)(dst + ((size_t)((tile / TN) * 128 + r) * 128 + c)) = pack4(v0, v1, v2, v3); });
        } else if (FAKE == 5) {
            bf16_t* dst = (bf16_t*)(p.ws + WS_HID);
            __syncthreads();
            acc_foreach4_lds(acc, lds, [&](int r, int c, float v0, float v1, float v2, float v3) { *(uint2*)(lds + (r * 136 + c) * 2) = pack4(v0, v1, v2, v3); });
            __syncthreads();
            const int t = TIDX;
#pragma unroll
            for (int i = 0; i < 8; ++i) { const int ch = t + 256 * i, r = ch >> 4, cc = (ch & 15) * 8;
                *(u32x4*)(dst + ((size_t)((tile / TN) * 128 + r) * 128 + cc)) = *(const u32x4*)(lds + (r * 136 + cc) * 2); }
        } else {
#pragma unroll
        for (int mi = 0; mi < 2; ++mi)
#pragma unroll
            for (int ni = 0; ni < 2; ++ni) sink += acc[mi][ni][0] + acc[mi][ni][7];
        }
    }
    if (sink == 12345.678f) ((float*)(p.ws + WS_RBIAS))[1000] = sink;
}
constexpr int STAGES_PER_LAYER = 11;
constexpr int N_STAGES = 1 + 2 * STAGES_PER_LAYER;
constexpr int REP_STAGE = -1;

__device__ __forceinline__ void run_stage(const P& p, int s, unsigned char* ldsb) {
    float* lds = (float*)ldsb;
    if (s == 0) { st_mod(p, lds); st_rope_table(p); st_ssm_tables(p); st_ssm_kj(p, lds); st_prep_weights(p, 0, ldsb, PW_ALL); return; }
    const int l = (s - 1) / STAGES_PER_LAYER, k = (s - 1) % STAGES_PER_LAYER;
    switch (k) {
    case 0: st_rbias(p, l, lds);
            if (l == 0) st_prep_ssm(p, 0, 3); else st_prep_weights(p, 1, ldsb, PW_GU | PW_DN);
            st_norm(p, l, 0); break;
    case 1: if (l == 0) st_fake(p, ldsb); st_inproj(p, l, ldsb); break;
    case 2: st_ssm_egemm(p, ldsb); if (l == 0) st_prep_weights(p, 1, ldsb, PW_IN); break;
    case 3: st_ssm_carry(p, l); st_attn2(p, l, ldsb, 0, 1); break;
    case 4: st_ssm_ygemm(p, l, ldsb); if (l == 0) st_prep_ssm(p, 1, 1); break;
    case 5: gemm_stage((const bf16_t*)(p.ws + WS_G), DSSM, (const bf16_t*)(p.ws + WS_WTGLU), DSSM, l == 0 ? TA : TL, DSSM, DSSM,
                       EpiGlu2{(const bf16_t*)(p.ws + WS_G), (bf16_t*)(p.ws + WS_BUFA), p.in[I_BGLU] + l * DSSM}, ldsb);
            st_conv(p, l); if (l == 0) st_prep_ssm(p, 1, 2); break;
    case 6: gemm_stage((const bf16_t*)(p.ws + WS_BUFA), D, (const bf16_t*)(p.ws + WS_WTOUT), D, l == 0 ? TA : TL, D, D, make_epi_out(p, l), ldsb); break;
    case 7: if (PROBE2 == 1 && l == 0) st_router2<true>(p, l, ldsb); st_router2(p, l, ldsb); if (l == 0) st_prep_weights(p, 1, ldsb, PW_GLU | PW_OUT); break;
    case 8: st_moe1(p, l, ldsb); break;
    case 9: st_moe2(p, l, ldsb); break;
    case 10: if (PROBE2 == 2 && l == 0) { EpiMoeF e = make_epi_moef(p, l); e.outw = false; gemm_stage((const bf16_t*)(p.ws + WS_HID) + 4 * DE, 5 * DE, (const bf16_t*)(p.ws + WS_WD) + (size_t)32 * D * DE, DE, TA, D, DE, e, ldsb); }
             gemm_stage((const bf16_t*)(p.ws + WS_HID) + 4 * DE, 5 * DE, (const bf16_t*)(p.ws + WS_WD) + (size_t)32 * D * DE, DE, l == 0 ? TA : TL, D, DE, make_epi_moef(p, l), ldsb); break;
    }
}


#define XB_TMO      128
#define XB_XCNT(j)  (256  + 64 * (j))
#define XB_XSUB(j)  (1280 + 64 * (j))
#define XB_XGEN(j)  (2304 + 64 * (j))
#define XB_TOP      3328
#define XB_TOPGEN   3392
#define XCD_BAR_WORDS 3456
#define XB_SPIN_CAP (1u << 22)
__device__ __forceinline__ unsigned xb_ld(unsigned* p)              { return __hip_atomic_load(p, __ATOMIC_RELAXED, __HIP_MEMORY_SCOPE_AGENT); }
__device__ __forceinline__ unsigned xb_add(unsigned* p, unsigned v) { return __hip_atomic_fetch_add(p, v, __ATOMIC_RELAXED, __HIP_MEMORY_SCOPE_AGENT); }
__device__ __forceinline__ unsigned xb_xcc_id() { return (unsigned)__builtin_amdgcn_s_getreg((3 << 11) | 20) & 0xFu; }
#define XB_SPIN(cond, bar) do { unsigned _sp = 0; while (cond) { __builtin_amdgcn_s_sleep(1); \
    if ((++_sp & 255u) == 0u) { if (xb_ld(&(bar)[XB_TMO])) break; if (_sp > XB_SPIN_CAP) { atomicAdd(&(bar)[XB_TMO], 1u); break; } } } } while (0)
struct XcdBarrier { unsigned* bar; unsigned x; volatile LAS unsigned* st; };
__device__ __forceinline__ XcdBarrier xcd_barrier_post(unsigned* bar, volatile LAS unsigned* st) {
    XcdBarrier b; b.bar = bar; b.x = xb_xcc_id(); b.st = st;
    if (threadIdx.x == 0) (void)xb_add(&bar[XB_XCNT(b.x)], 1u);
    return b;
}
__device__ __forceinline__ void xcd_barrier_complete(unsigned* bar, unsigned x, unsigned& nloc, unsigned& nx) {
    const unsigned G = gridDim.x * gridDim.y * gridDim.z;
    unsigned sum, cnt, mine, sp = 0u;
    for (;;) {
        sum = 0u; cnt = 0u; mine = 0u;
#pragma unroll
        for (unsigned j = 0; j < 16; ++j) { const unsigned c = xb_ld(&bar[XB_XCNT(j)]); sum += c; cnt += (c > 0u) ? 1u : 0u; mine = (j == x) ? c : mine; }
        if (sum == G) break;
        __builtin_amdgcn_s_sleep(1);
        if ((++sp & 255u) == 0u) { if (xb_ld(&bar[XB_TMO])) break; if (sp > XB_SPIN_CAP) { atomicAdd(&bar[XB_TMO], 1u); break; } }
    }
    nloc = mine > 0u ? mine : 1u; nx = cnt > 0u ? cnt : 1u;
}
__device__ __forceinline__ void xcd_barrier(const XcdBarrier& b) {
    asm volatile("s_waitcnt vmcnt(0)" ::: "memory");
    __syncthreads();
    if (threadIdx.x == 0) {
        unsigned* bar = b.bar;
        __builtin_amdgcn_s_waitcnt(0);
        unsigned nloc = b.st[0], nx = b.st[1];
        if (nloc == 0u) { xcd_barrier_complete(bar, b.x, nloc, nx); b.st[0] = nloc; b.st[1] = nx; }
        const unsigned old = xb_add(&bar[XB_XSUB(b.x)], 1u);
        const unsigned gen = old / nloc;
        if (old + 1u == (gen + 1u) * nloc) {
            __builtin_amdgcn_fence(__ATOMIC_RELEASE, "agent");
            asm volatile("s_waitcnt vmcnt(0)" ::: "memory");
            const unsigned og = xb_add(&bar[XB_TOP], 1u);
            const unsigned tg = og / nx;
            if (og + 1u == (tg + 1u) * nx) xb_add(&bar[XB_TOPGEN], 1u);
            else XB_SPIN(xb_ld(&bar[XB_TOPGEN]) == tg, bar);
            __builtin_amdgcn_fence(__ATOMIC_ACQUIRE, "agent");
            xb_add(&bar[XB_XGEN(b.x)], 1u);
            asm volatile("s_waitcnt vmcnt(0)" ::: "memory");
        } else {
            XB_SPIN(xb_ld(&bar[XB_XGEN(b.x)]) == gen, bar);
            __builtin_amdgcn_fence(__ATOMIC_ACQUIRE, "agent");
            asm volatile("s_waitcnt vmcnt(0)" ::: "memory");
        }
    }
    __syncthreads();
}
constexpr size_t WS_XBAR = 4096;

template <int S> __device__ __forceinline__ void run_all(const P& p, unsigned char* lds, const XcdBarrier& xb) {
    run_stage(p, S, lds);
    if constexpr (S == REP_STAGE) { xcd_barrier(xb); run_stage(p, S, lds); }
    if constexpr (S + 1 < N_STAGES) {
        unsigned long long t0 = 0; if (TIM) t0 = __builtin_amdgcn_s_memrealtime();
        xcd_barrier(xb);
        if (TIM && threadIdx.x == 0) { const unsigned long long t1 = __builtin_amdgcn_s_memrealtime(); xb.st[2] += (unsigned)(t1 - t0);
            if (blockIdx.x == 0) ((unsigned long long*)(p.ws + WS_CTL + 32768))[S + 1] = t1; }
        run_all<S + 1>(p, lds, xb);
    } else if (TIM) {
        unsigned* ctl = (unsigned*)(p.ws + WS_CTL + 32768 + 512);
        unsigned long long* ts = (unsigned long long*)(p.ws + WS_CTL + 32768);
        if (threadIdx.x == 0) { atomicAdd(ctl, xb.st[2]); if (blockIdx.x == 0) ts[N_STAGES] = __builtin_amdgcn_s_memrealtime(); }
        xcd_barrier(xb);
        if (blockIdx.x == 0 && threadIdx.x == 0) {
            float us;
            if (TIM == 1) us = (float)__hip_atomic_load(ctl, __ATOMIC_RELAXED, __HIP_MEMORY_SCOPE_AGENT) / (float)gridDim.x * 0.01f / 10.f;
            else if (TIM == 2) us = (float)(ts[N_STAGES] - ts[0]) * 0.01f / 25.f;
            else us = (float)(ts[TIM - 10 + 1] - ts[TIM - 10]) * 0.01f / 2.f;
            float code = floorf(us); if (code > 89.f) code = 89.f;
            p.out[0] += 10.f + code;
        }
    }
}
__global__ void __launch_bounds__(NT, 2) mega(P p) {
    __shared__ __attribute__((aligned(16))) unsigned char lds[LDS_TOTAL + 16];
    volatile LAS unsigned* st = (volatile LAS unsigned*)(lds + LDS_TOTAL);
    if (threadIdx.x == 0) { st[0] = 0u; st[1] = 0u; st[2] = 0u; st[3] = 0u; if (TIM && blockIdx.x == 0) ((unsigned long long*)(p.ws + WS_CTL + 32768))[0] = __builtin_amdgcn_s_memrealtime(); }
    __syncthreads();
    const XcdBarrier xb = xcd_barrier_post((unsigned*)(p.ws + WS_CTL + WS_XBAR), st);
    if (p.ws == nullptr) cg::this_grid().sync();
    run_all<0>(p, lds, xb);
}

extern "C" void kernel_launch(void* const* d_in, const int* in_sizes, int n_in, void* d_out, int out_size, void* d_ws, size_t ws_size, hipStream_t stream) {
    if (n_in != N_IN || ws_size < WS_END) { fprintf(stderr, "kernel_launch: unexpected n_in %d or ws_size %zu (< %zu)\n", n_in, ws_size, (size_t)WS_END); return; }
    P p{};
    for (int i = 0; i < N_IN; ++i) p.in[i] = (const float*)d_in[i];
    p.out = (float*)d_out; p.ws = (unsigned char*)d_ws;
    static int grid_blocks = 0;
    if (!grid_blocks) {
        int dev = 0, cus = 0, per_cu = 0;
        hipGetDevice(&dev);
        hipDeviceGetAttribute(&cus, hipDeviceAttributeMultiprocessorCount, dev);
        hipOccupancyMaxActiveBlocksPerMultiprocessor(&per_cu, (const void*)mega, NT, 0);
        if (per_cu < 1) per_cu = 1;
        if (per_cu > 2) per_cu = 2;
        grid_blocks = cus * per_cu;
    }
    hipMemsetAsync((char*)d_ws + WS_CTL, 0, 65536, stream);
    void* args[] = {&p};
    hipError_t e = hipLaunchCooperativeKernel((const void*)mega, dim3(grid_blocks), dim3(NT), args, 0, stream);
    if (e != hipSuccess) fprintf(stderr, "cooperative launch failed: %s (grid %d)\n", hipGetErrorString(e), grid_blocks);
}
```

```cpp
#include <hip/hip_runtime.h>
#include <hip/hip_cooperative_groups.h>
#include <cstdio>
#include <cstdint>
namespace cg = cooperative_groups;
#define CNT_PTR(p, l) ((int*)((p).ws + 40960 + (l) * 8192))
#define LAS __attribute__((address_space(3)))
constexpr int ABL = 0;

__device__ __forceinline__ int tid_opaque() { int t = threadIdx.x; asm volatile("" : "+v"(t)); return t; }
__device__ __forceinline__ int bid_opaque() { int b = blockIdx.x; asm volatile("" : "+s"(b)); return b; }
__device__ __forceinline__ int xcd_first(int total, int& end, int& step) {
    const int nb = gridDim.x; int b = blockIdx.x; asm volatile("" : "+s"(b));
    if (nb & 7) { end = total; step = nb; return b; }
    const int x = b & 7, j = b >> 3, per = (total + 7) >> 3, lo = x * per;
    end = lo + per < total ? lo + per : total; step = nb >> 3; return lo + j;
}
#define TIDX tid_opaque()
#define BIDX bid_opaque()

constexpr int D = 1024, NB = 8, L = 2048, LC = 256;
constexpr int TL = NB * L, TC = NB * LC, TA = TL + TC;
constexpr int DIN = 1792, DCONV = 256, DSSM = 256, DATT = 512;
constexpr int NQH = 8, NKVH = 2, HD = 64;
constexpr int COL_U = 768, COL_Q = 1024, COL_K = 1536, COL_V = 1664;
constexpr int NE = 32, TOPK = 4, DE = 128;
constexpr int SG = 16, SH = 16, SP = 64;
constexpr int NT = 256;

enum { I_X = 0, I_C, I_CTX, I_CCTX, I_WMOD, I_BMOD, I_N1G, I_N2G, I_WIN, I_CONVW, I_LRE, I_LIM, I_LDT, I_BRE, I_BIM, I_CRE, I_CIM,
       I_SD, I_WGLU, I_BGLU, I_QG, I_KG, I_SINK, I_WOUT, I_RW, I_RB, I_WEG, I_WEU, I_WED, I_WSG, I_WSU, I_WSD, N_IN };

typedef unsigned short bf16_t;
constexpr size_t WS_CTL = 0;
constexpr size_t WS_MOD = 65536;
constexpr size_t WS_ZERO_END = WS_MOD + (size_t)2 * 9 * 6 * D * 4;
constexpr size_t WS_RBIAS = 524288;
constexpr size_t WS_ROPE = WS_RBIAS + 4096;
constexpr size_t WS_KJ = WS_ROPE + 524288;
constexpr size_t WS_GS2 = WS_KJ + 2097152;
constexpr size_t WS_POW = WS_GS2 + 131072;
constexpr size_t WS_FB = WS_POW + (size_t)2 * 2 * 16 * 33 * 64 * 8;
constexpr size_t WS_R1 = WS_FB + (size_t)2 * 2 * 16 * 64 * 16 * 8;
constexpr size_t WS_BUFA = WS_R1;
constexpr size_t WS_PC = WS_BUFA + (size_t)TA * D * 2;
constexpr size_t WS_UA = WS_PC + (size_t)TA * 768 * 2;
constexpr size_t WS_E = WS_UA + (size_t)16 * 640 * 768 * 2;
constexpr size_t WS_G = WS_E + (size_t)16 * 640 * 256 * 4;
constexpr size_t WS_QB = WS_G + (size_t)TA * DSSM * 2;
constexpr size_t WS_KB = WS_QB + (size_t)TA * DATT * 2;
constexpr size_t WS_VT = WS_KB + (size_t)TA * 128 * 2;
constexpr size_t WS_SLAB = WS_R1;
constexpr size_t WS_HID = WS_SLAB + (size_t)TA * 4 * D * 2;
constexpr size_t WS_HC1 = WS_HID + (size_t)TA * 5 * DE * 2;
constexpr size_t WS_HCMID = WS_HC1 + (size_t)TC * D * 4;
constexpr size_t WS_LCODE = WS_HCMID + (size_t)TC * D * 4;
constexpr size_t WS_LW = WS_LCODE + (size_t)NE * TA * 4;
constexpr size_t WS_WTIN = WS_LW + (size_t)NE * TA * 4;
constexpr size_t WS_WTOUT = WS_WTIN + (size_t)DIN * D * 2;
constexpr size_t WS_WTGLU = WS_WTOUT + (size_t)D * D * 2;
constexpr size_t WS_WGU = WS_WTGLU + (size_t)DSSM * DSSM * 2;
constexpr size_t WS_WD = WS_WGU + (size_t)33 * 256 * D * 2;
constexpr size_t WS_WST = WS_WD + (size_t)33 * D * DE * 2;
constexpr size_t WS_KW = WS_WST + (size_t)16 * 256 * 512 * 2;
constexpr size_t WS_END = WS_KW + (size_t)16 * 512 * 768 * 2;
static_assert(WS_VT + (size_t)TA * 128 * 2 <= WS_HID, "overlay");
static_assert(WS_ZERO_END <= WS_RBIAS, "zero region");
static_assert(WS_END <= 268435456, "workspace too large");

struct P {
    const float* in[N_IN];
    float* out;
    unsigned char* ws;
};

__device__ __forceinline__ bf16_t f2bf(float f) { unsigned u = __float_as_uint(f); u += 0x7FFFu + ((u >> 16) & 1u); return (bf16_t)(u >> 16); }
__device__ __forceinline__ float bf2f(bf16_t b) { return __uint_as_float((unsigned)b << 16); }
__device__ __forceinline__ unsigned cvt_pk_bf16(float lo, float hi) { unsigned r; asm("v_cvt_pk_bf16_f32 %0, %1, %2" : "=v"(r) : "v"(lo), "v"(hi)); return r; }
typedef __attribute__((ext_vector_type(4))) float f32x4;
typedef __attribute__((ext_vector_type(4))) unsigned u32x4;
struct BfPtr { const bf16_t* p; __device__ __forceinline__ float operator[](long i) const { return bf2f(p[i]); }
               __device__ __forceinline__ BfPtr operator+(long o) const { return BfPtr{p + o}; } };
__device__ __forceinline__ float silu_f(float x) { return x / (1.f + expf(-x)); }
__device__ __forceinline__ float sigmoid_f(float x) { return 1.f / (1.f + expf(-x)); }
__device__ __forceinline__ float gelu_f(float x) { return 0.5f * x * (1.f + tanhf(0.7978845608028654f * (x + 0.044715f * x * x * x))); }
__device__ __forceinline__ float wave_sum(float v) {
#pragma unroll
    for (int o = 32; o > 0; o >>= 1) v += __shfl_xor(v, o);
    return v;
}
__device__ __forceinline__ int row_bb(int r) { return r < TL ? r / L : 8; }
__device__ __forceinline__ const float* h_row(const P& p, int l, int r) {
    if (r < TL) return (l == 0 ? p.in[I_X] : p.out) + (size_t)r * D;
    return (l == 0 ? p.in[I_CTX] : (const float*)(p.ws + WS_HC1)) + (size_t)(r - TL) * D;
}
__device__ __forceinline__ float* hmid_row(const P& p, int r) {
    if (r < TL) return p.out + (size_t)r * D;
    return (float*)(p.ws + WS_HCMID) + (size_t)(r - TL) * D;
}
__device__ __forceinline__ const float* mod_vec(const P& p, int l, int bb, int chunk) {
    return (const float*)(p.ws + WS_MOD) + ((size_t)(l * 9 + bb) * 6 + chunk) * D;
}

__device__ __forceinline__ void st_mod(const P& p, float* lds) {
    float* red = lds + 9 * D;
    for (int i = TIDX; i < 9 * D; i += NT) {
        const int bb = i / D, k = i % D;
        const float c = bb < 8 ? p.in[I_C][bb * D + k] : p.in[I_CCTX][k];
        lds[i] = silu_f(c);
    }
    __syncthreads();
    float* mod = (float*)(p.ws + WS_MOD);
    const int col = TIDX & 31, ks = TIDX >> 5;
    for (int item = BIDX; item < 2 * 6 * D / 32; item += gridDim.x) {
        const int l = item / (6 * D / 32), j = (item % (6 * D / 32)) * 32 + col;
        const float* w = p.in[I_WMOD] + (size_t)l * D * 6 * D + j;
        float acc[9];
#pragma unroll
        for (int bb = 0; bb < 9; ++bb) acc[bb] = 0.f;
        for (int k0 = ks * 128; k0 < ks * 128 + 128; k0 += 16) {
            float wv[16];
#pragma unroll
            for (int q = 0; q < 16; ++q) wv[q] = w[(size_t)(k0 + q) * 6 * D];
#pragma unroll
            for (int q = 0; q < 16; ++q)
#pragma unroll
                for (int bb = 0; bb < 9; ++bb) acc[bb] += lds[bb * D + k0 + q] * wv[q];
        }
#pragma unroll
        for (int bb = 0; bb < 9; ++bb) red[(bb * 8 + ks) * 32 + col] = acc[bb];
        __syncthreads();
        for (int o = TIDX; o < 9 * 32; o += NT) {
            const int bb = o >> 5, c2 = o & 31;
            float sum = p.in[I_BMOD][l * 6 * D + (item % (6 * D / 32)) * 32 + c2];
#pragma unroll
            for (int q = 0; q < 8; ++q) sum += red[(bb * 8 + q) * 32 + c2];
            mod[(size_t)(l * 9 + bb) * 6 * D + (item % (6 * D / 32)) * 32 + c2] = sum;
        }
        __syncthreads();
    }
}

__device__ __forceinline__ void st_norm(const P& p, int l, int which) {
    const int lane = TIDX & 63, wv = TIDX >> 6;
    const int nrows = (which == 1 && l == 1) ? TL : TA;
    float* xn = (float*)(p.ws + WS_BUFA);
    const float* g = p.in[which == 0 ? I_N1G : I_N2G] + l * D;
    for (int r0 = (BIDX * 4 + wv) * 2; r0 < nrows; r0 += gridDim.x * 8) {
        f32x4 v[2][4];
#pragma unroll
        for (int u = 0; u < 2; ++u) {
            const float* src = which == 0 ? h_row(p, l, r0 + u) : hmid_row(p, r0 + u);
#pragma unroll
            for (int j = 0; j < 4; ++j) v[u][j] = *(const f32x4*)(src + j * 256 + lane * 4);
        }
        const int bb = row_bb(r0);
        const float* sh = mod_vec(p, l, bb, which == 0 ? 0 : 3);
        const float* sc = mod_vec(p, l, bb, which == 0 ? 1 : 4);
#pragma unroll
        for (int u = 0; u < 2; ++u) {
            const int r = r0 + u;
            float s = 0.f;
#pragma unroll
            for (int j = 0; j < 4; ++j) s += v[u][j][0] * v[u][j][0] + v[u][j][1] * v[u][j][1] + v[u][j][2] * v[u][j][2] + v[u][j][3] * v[u][j][3];
            s = wave_sum(s);
            const float rinv = rsqrtf(s * (1.f / D) + 1e-6f);
#pragma unroll
            for (int j = 0; j < 4; ++j) {
                const int k = j * 256 + lane * 4;
                const f32x4 gg = *(const f32x4*)(g + k), s1 = *(const f32x4*)(sc + k), s0 = *(const f32x4*)(sh + k);
                f32x4 o;
#pragma unroll
                for (int q = 0; q < 4; ++q) o[q] = v[u][j][q] * rinv * gg[q] * (1.f + s1[q]) + s0[q];
                if (which == 1) *(f32x4*)(xn + (size_t)r * D + k) = o;
                else { uint2 pk; pk.x = cvt_pk_bf16(o[0], o[1]); pk.y = cvt_pk_bf16(o[2], o[3]); *(uint2*)((bf16_t*)(p.ws + WS_BUFA) + (size_t)r * D + k) = pk; }
            }
        }
    }
}

__device__ __forceinline__ void bf8_to_f(const u32x4& v, float (&f)[8]) {
#pragma unroll
    for (int q = 0; q < 4; ++q) { f[2 * q] = __uint_as_float(v[q] << 16); f[2 * q + 1] = __uint_as_float(v[q] & 0xffff0000u); }
}
__device__ __forceinline__ void st_conv(const P& p, int l) {
    const bf16_t* pb = (const bf16_t*)(p.ws + WS_PC);
    bf16_t* mix = (bf16_t*)(p.ws + WS_BUFA);
    const float* cw = p.in[I_CONVW] + l * 3 * DCONV;
    const int nrows = l == 0 ? TA : TL;
    for (int idx = BIDX * NT + TIDX; idx < nrows * 32; idx += gridDim.x * NT) {
        const int r = idx >> 5, ch = (idx & 31) * 8;
        int t, len;
        if (r < TL) { t = r & (L - 1); len = L; } else { t = (r - TL) & (LC - 1); len = LC; }
        const bf16_t* pr = pb + (size_t)r * 768 + ch;
        float x[8], c[8], bgate[8], y[8];
        bf8_to_f(*(const u32x4*)(pr), x); bf8_to_f(*(const u32x4*)(pr + 512), c); bf8_to_f(*(const u32x4*)(pr + 256), bgate);
        const f32x4 w1a = *(const f32x4*)(cw + DCONV + ch), w1b = *(const f32x4*)(cw + DCONV + ch + 4);
#pragma unroll
        for (int q = 0; q < 8; ++q) y[q] = (q < 4 ? w1a[q] : w1b[q - 4]) * (c[q] * x[q]);
        if (t > 0) {
            bf8_to_f(*(const u32x4*)(pr - 768), x); bf8_to_f(*(const u32x4*)(pr - 768 + 512), c);
            const f32x4 wa = *(const f32x4*)(cw + ch), wb = *(const f32x4*)(cw + ch + 4);
#pragma unroll
            for (int q = 0; q < 8; ++q) y[q] += (q < 4 ? wa[q] : wb[q - 4]) * (c[q] * x[q]);
        }
        if (t < len - 1) {
            bf8_to_f(*(const u32x4*)(pr + 768), x); bf8_to_f(*(const u32x4*)(pr + 768 + 512), c);
            const f32x4 wa = *(const f32x4*)(cw + 2 * DCONV + ch), wb = *(const f32x4*)(cw + 2 * DCONV + ch + 4);
#pragma unroll
            for (int q = 0; q < 8; ++q) y[q] += (q < 4 ? wa[q] : wb[q - 4]) * (c[q] * x[q]);
        }
        u32x4 o;
#pragma unroll
        for (int q = 0; q < 4; ++q) o[q] = cvt_pk_bf16(bgate[2 * q] * y[2 * q], bgate[2 * q + 1] * y[2 * q + 1]);
        *(u32x4*)(mix + (size_t)r * D + ch) = o;
    }
}

struct EpiOut { const float* modl; const float* hlat; const float* hctx; float* out; float* hcmid;
    __device__ __forceinline__ void operator()(int r, int c, float v0, float v1, float v2, float v3) const {
    const int bb = row_bb(r);
    const f32x4 g1 = *(const f32x4*)(modl + ((size_t)bb * 6 + 2) * D + c);
    const f32x4 hv = *(const f32x4*)((r < TL ? hlat + (size_t)r * D : hctx + (size_t)(r - TL) * D) + c);
    f32x4 o; o[0] = hv[0] + g1[0] * v0; o[1] = hv[1] + g1[1] * v1; o[2] = hv[2] + g1[2] * v2; o[3] = hv[3] + g1[3] * v3;
    *(f32x4*)((r < TL ? out + (size_t)r * D : hcmid + (size_t)(r - TL) * D) + c) = o; }
    __device__ __forceinline__ f32x4 prefetch(int r, int c) const { return *(const f32x4*)((r < TL ? hlat + (size_t)r * D : hctx + (size_t)(r - TL) * D) + c); }
    __device__ __forceinline__ void with_pre(int r, int c, float v0, float v1, float v2, float v3, const f32x4& hv) const {
    const f32x4 g1 = *(const f32x4*)(modl + ((size_t)row_bb(r) * 6 + 2) * D + c);
    f32x4 o; o[0] = hv[0] + g1[0] * v0; o[1] = hv[1] + g1[1] * v1; o[2] = hv[2] + g1[2] * v2; o[3] = hv[3] + g1[3] * v3;
    *(f32x4*)((r < TL ? out + (size_t)r * D : hcmid + (size_t)(r - TL) * D) + c) = o; } };
__device__ __forceinline__ EpiOut make_epi_out(const P& p, int l) {
    return EpiOut{(const float*)(p.ws + WS_MOD) + (size_t)l * 9 * 6 * D, l == 0 ? p.in[I_X] : p.out, l == 0 ? p.in[I_CTX] : (const float*)(p.ws + WS_HC1), p.out, (float*)(p.ws + WS_HCMID)};
}

typedef __attribute__((ext_vector_type(8))) short bf16x8;
typedef __attribute__((ext_vector_type(16))) float f32x16;
constexpr int G_STAGEB = 16384;
constexpr int G_NSTG = 4;
constexpr int LDS_BYTES = G_NSTG * G_STAGEB;

template <class ARow>
__device__ __forceinline__ void gemm_tile(f32x16 (&acc)[2][2], ARow arow, const bf16_t* Bt, int ldb, int K, unsigned char* lds) {
    const int t = TIDX, lane = t & 63, w = __builtin_amdgcn_readfirstlane(t >> 6), wr = w >> 1, wc = w & 1, lr = lane & 31, lh = lane >> 5;
    const int srow = t >> 2, lc = (t & 3) ^ ((srow >> 2) & 3);
    const bf16_t* ap[2]; const bf16_t* bp[2];
#pragma unroll
    for (int i = 0; i < 2; ++i) { ap[i] = arow(srow + 64 * i) + lc * 8; bp[i] = Bt + (size_t)(srow + 64 * i) * ldb + lc * 8; }
    float zf = 0.f; asm volatile("" : "+v"(zf));
#pragma unroll
    for (int mi = 0; mi < 2; ++mi)
#pragma unroll
        for (int ni = 0; ni < 2; ++ni)
#pragma unroll
            for (int r = 0; r < 16; ++r) acc[mi][ni][r] = zf;
    const int nk = K >> 5;
    LAS unsigned char* l3 = (LAS unsigned char*)lds;
    const int f = (lr >> 2) & 3;
    const int aoff = (wr * 64 + lr) * 64 + ((lh ^ f) << 4), boff = 8192 + (wc * 64 + lr) * 64 + ((lh ^ f) << 4);
#define G_ISSUE(ks) do { LAS unsigned char* d_ = l3 + ((ks) & 3) * G_STAGEB + w * 1024; \
        __builtin_amdgcn_global_load_lds((const unsigned*)(ap[0] + (ks) * 32), (LAS unsigned*)(d_), 16, 0, 0); \
        __builtin_amdgcn_global_load_lds((const unsigned*)(ap[1] + (ks) * 32), (LAS unsigned*)(d_ + 4096), 16, 0, 0); \
        __builtin_amdgcn_global_load_lds((const unsigned*)(bp[0] + (ks) * 32), (LAS unsigned*)(d_ + 8192), 16, 0, 0); \
        __builtin_amdgcn_global_load_lds((const unsigned*)(bp[1] + (ks) * 32), (LAS unsigned*)(d_ + 12288), 16, 0, 0); } while (0)
#define G_RD(A0, A1, B0, B1, slot, s2) do { const LAS unsigned char* c_ = l3 + (slot) * G_STAGEB; \
        A0 = *(const LAS bf16x8*)(c_ + (aoff ^ ((s2) << 5))); A1 = *(const LAS bf16x8*)(c_ + ((aoff + 2048) ^ ((s2) << 5))); \
        B0 = *(const LAS bf16x8*)(c_ + (boff ^ ((s2) << 5))); B1 = *(const LAS bf16x8*)(c_ + ((boff + 2048) ^ ((s2) << 5))); } while (0)
#define G_MM(A0, A1, B0, B1) do { __builtin_amdgcn_s_setprio(1); \
        acc[0][0] = __builtin_amdgcn_mfma_f32_32x32x16_bf16(B0, A0, acc[0][0], 0, 0, 0); acc[0][1] = __builtin_amdgcn_mfma_f32_32x32x16_bf16(B1, A0, acc[0][1], 0, 0, 0); \
        acc[1][0] = __builtin_amdgcn_mfma_f32_32x32x16_bf16(B0, A1, acc[1][0], 0, 0, 0); acc[1][1] = __builtin_amdgcn_mfma_f32_32x32x16_bf16(B1, A1, acc[1][1], 0, 0, 0); __builtin_amdgcn_s_setprio(0); } while (0)
    __syncthreads();
    G_ISSUE(0);
    if (1 < nk) G_ISSUE(1);
    if (2 < nk) G_ISSUE(2);
    if (2 < nk) asm volatile("s_waitcnt vmcnt(8)" ::: "memory"); else if (1 < nk) asm volatile("s_waitcnt vmcnt(4)" ::: "memory"); else asm volatile("s_waitcnt vmcnt(0)" ::: "memory");
    __builtin_amdgcn_s_barrier();
    if (3 < nk) G_ISSUE(3);
    bf16x8 fa0, fa1, fb0, fb1, ga0, ga1, gb0, gb1;
    G_RD(fa0, fa1, fb0, fb1, 0, 0);
    for (int ks = 0; ks < nk; ++ks) {
        G_RD(ga0, ga1, gb0, gb1, ks & 3, 1);
        __builtin_amdgcn_sched_barrier(0);
        asm volatile("s_waitcnt lgkmcnt(4)" ::: "memory");
        __builtin_amdgcn_sched_barrier(0);
        G_MM(fa0, fa1, fb0, fb1);
        __builtin_amdgcn_sched_barrier(0);
        if (ks + 1 < nk) {
            if (ks + 3 < nk) asm volatile("s_waitcnt vmcnt(8) lgkmcnt(0)" ::: "memory");
            else if (ks + 2 < nk) asm volatile("s_waitcnt vmcnt(4) lgkmcnt(0)" ::: "memory");
            else asm volatile("s_waitcnt vmcnt(0) lgkmcnt(0)" ::: "memory");
            __builtin_amdgcn_s_barrier();
            if (ks + 4 < nk) G_ISSUE(ks + 4);
            G_RD(fa0, fa1, fb0, fb1, (ks + 1) & 3, 0);
        } else {
            asm volatile("s_waitcnt lgkmcnt(0)" ::: "memory");
        }
        __builtin_amdgcn_sched_barrier(0);
        G_MM(ga0, ga1, gb0, gb1);
        __builtin_amdgcn_sched_barrier(0);
    }
#undef G_RD
#undef G_MM
#undef G_ISSUE
}
template <class F>
__device__ __forceinline__ void acc_foreach4(const f32x16 (&acc)[2][2], F f) {
    const int lane = TIDX & 63, w = (TIDX >> 6) & 3, wr = w >> 1, wc = w & 1, lr = lane & 31, lh = lane >> 5;
#pragma unroll
    for (int mi = 0; mi < 2; ++mi)
#pragma unroll
        for (int ni = 0; ni < 2; ++ni)
#pragma unroll
            for (int g = 0; g < 4; ++g)
                f(wr * 64 + mi * 32 + lr, wc * 64 + ni * 32 + 8 * g + 4 * lh, acc[mi][ni][4 * g], acc[mi][ni][4 * g + 1], acc[mi][ni][4 * g + 2], acc[mi][ni][4 * g + 3]);
}
constexpr int C_LD = 132;
template <class F>
__device__ __forceinline__ void acc_foreach4_lds(const f32x16 (&acc)[2][2], unsigned char* lds, F f) {
    float* C = (float*)lds;
    const int t = TIDX, lane = t & 63, w = (t >> 6) & 3, wr = w >> 1, wc = w & 1, lr = lane & 31, lh = lane >> 5;
    __syncthreads();
#pragma unroll
    for (int mi = 0; mi < 2; ++mi)
#pragma unroll
        for (int ni = 0; ni < 2; ++ni)
#pragma unroll
            for (int g = 0; g < 4; ++g) {
                f32x4 v; v[0] = acc[mi][ni][4 * g]; v[1] = acc[mi][ni][4 * g + 1]; v[2] = acc[mi][ni][4 * g + 2]; v[3] = acc[mi][ni][4 * g + 3];
                *(f32x4*)(C + (wr * 64 + mi * 32 + lr) * C_LD + wc * 64 + ni * 32 + 8 * g + 4 * lh) = v;
            }
    __syncthreads();
#pragma unroll 8
    for (int i = 0; i < 16; ++i) {
        const int idx = t + 256 * i, r = idx >> 5, c = (idx & 31) * 4;
        const f32x4 v = *(const f32x4*)(C + r * C_LD + c);
        f(r, c, v[0], v[1], v[2], v[3]);
    }
}
constexpr float SLAB_SCALE = 32.f;
__device__ __forceinline__ unsigned pack4_fp8(float a, float b, float c, float d) {
    a = fminf(fmaxf(a * SLAB_SCALE, -448.f), 448.f); b = fminf(fmaxf(b * SLAB_SCALE, -448.f), 448.f);
    c = fminf(fmaxf(c * SLAB_SCALE, -448.f), 448.f); d = fminf(fmaxf(d * SLAB_SCALE, -448.f), 448.f);
    int w = __builtin_amdgcn_cvt_pk_fp8_f32(a, b, 0, false);
    w = __builtin_amdgcn_cvt_pk_fp8_f32(c, d, w, true);
    return (unsigned)w;
}
__device__ __forceinline__ uint2 pack4(float a, float b, float c, float d) { uint2 o; o.x = cvt_pk_bf16(a, b); o.y = cvt_pk_bf16(c, d); return o; }
struct ARowPlain { const bf16_t* A; int lda; __device__ __forceinline__ const bf16_t* operator()(int m) const { return A + (size_t)m * lda; } };

template <class Epi>
__device__ __forceinline__ void gemm_stage(const bf16_t* A, int lda, const bf16_t* Bt, int ldb, int M, int N, int K, Epi epi, unsigned char* lds) {
    const int tn = N / 128, tm = M / 128;
    int t_end, t_step;
    for (int tile = xcd_first(tm * tn, t_end, t_step); tile < t_end; tile += t_step) {
        const int m0 = (tile / tn) * 128, n0 = (tile % tn) * 128;
        f32x16 acc[2][2];
        gemm_tile(acc, ARowPlain{A + (size_t)m0 * lda, lda}, Bt + (size_t)n0 * ldb, ldb, K, lds);
        acc_foreach4_lds(acc, lds, [&](int r, int c, float v0, float v1, float v2, float v3) { epi(m0 + r, n0 + c, v0, v1, v2, v3); });
    }
}
template <class Epi>
__device__ __forceinline__ void gemm_stage_pre(const bf16_t* A, int lda, const bf16_t* Bt, int ldb, int M, int N, int K, Epi epi, unsigned char* lds) {
    const int tn = N / 128, tm = M / 128;
    int t_end, t_step;
    for (int tile = xcd_first(tm * tn, t_end, t_step); tile < t_end; tile += t_step) {
        const int m0 = (tile / tn) * 128, n0 = (tile % tn) * 128;
        f32x4 pre[16];
        { const int t = TIDX;
#pragma unroll
          for (int i = 0; i < 16; ++i) { const int idx = t + 256 * i; pre[i] = epi.prefetch(m0 + (idx >> 5), n0 + (idx & 31) * 4); } }
        f32x16 acc[2][2];
        gemm_tile(acc, ARowPlain{A + (size_t)m0 * lda, lda}, Bt + (size_t)n0 * ldb, ldb, K, lds);
        float* C = (float*)lds;
        const int t = TIDX, lane = t & 63, w = (t >> 6) & 3, wr = w >> 1, wc = w & 1, lr = lane & 31, lh = lane >> 5;
        __syncthreads();
#pragma unroll
        for (int mi = 0; mi < 2; ++mi)
#pragma unroll
            for (int ni = 0; ni < 2; ++ni)
#pragma unroll
                for (int g = 0; g < 4; ++g) {
                    f32x4 v; v[0] = acc[mi][ni][4 * g]; v[1] = acc[mi][ni][4 * g + 1]; v[2] = acc[mi][ni][4 * g + 2]; v[3] = acc[mi][ni][4 * g + 3];
                    *(f32x4*)(C + (wr * 64 + mi * 32 + lr) * C_LD + wc * 64 + ni * 32 + 8 * g + 4 * lh) = v;
                }
        __syncthreads();
#pragma unroll
        for (int i = 0; i < 16; ++i) {
            const int idx = t + 256 * i, r = idx >> 5, c = (idx & 31) * 4;
            const f32x4 v = *(const f32x4*)(C + r * C_LD + c);
            epi.with_pre(m0 + r, n0 + c, v[0], v[1], v[2], v[3], pre[i]);
        }
    }
}
__device__ __forceinline__ void tr_item(const float* src, size_t sk, bf16_t* dst, size_t dld, bf16_t* tl) {
    const int t = TIDX, kr = t >> 3, nq = (t & 7) * 4;
    __syncthreads();
#pragma unroll
    for (int ps = 0; ps < 4; ++ps) {
        const f32x4 v = *(const f32x4*)(src + (size_t)(kr + 32 * ps) * sk + nq);
#pragma unroll
        for (int j = 0; j < 4; ++j) tl[(nq + j) * 136 + kr + 32 * ps] = f2bf(v[j]);
    }
    __syncthreads();
    const int n = t >> 3, part = t & 7;
    const u32x4 a = *(const u32x4*)(tl + n * 136 + part * 16), b = *(const u32x4*)(tl + n * 136 + part * 16 + 8);
    bf16_t* o = dst + (size_t)n * dld + part * 16;
    *(u32x4*)o = a; *(u32x4*)(o + 8) = b;
}
constexpr int PW_IN = 1, PW_OUT = 2, PW_GLU = 4, PW_GU = 8, PW_DN = 16, PW_ALL = 31;
__device__ __forceinline__ void st_prep_weights(const P& p, int l, unsigned char* lds, int parts) {
    bf16_t* tl = (bf16_t*)lds;
    constexpr int N_IN_ = (DIN / 32) * 8, N_OUT = (D / 32) * 8, N_GLU = (DSSM / 32) * 2, N_GU = 33 * 2 * 4 * 8, N_DN = 33 * (D / 32);
    if (parts & PW_IN) for (int r = BIDX; r < N_IN_; r += gridDim.x) { const int nt = r >> 3, kt = r & 7;
        tr_item(p.in[I_WIN] + (size_t)l * D * DIN + (size_t)kt * 128 * DIN + nt * 32, DIN, (bf16_t*)(p.ws + WS_WTIN) + (size_t)nt * 32 * D + kt * 128, D, tl); }
    if (parts & PW_OUT) for (int r = BIDX; r < N_OUT; r += gridDim.x) { const int nt = r >> 3, kt = r & 7;
        tr_item(p.in[I_WOUT] + (size_t)l * D * D + (size_t)kt * 128 * D + nt * 32, D, (bf16_t*)(p.ws + WS_WTOUT) + (size_t)nt * 32 * D + kt * 128, D, tl); }
    if (parts & PW_GLU) for (int r = BIDX; r < N_GLU; r += gridDim.x) { const int nt = r >> 1, kt = r & 1;
        tr_item(p.in[I_WGLU] + (size_t)l * DSSM * DSSM + (size_t)kt * 128 * DSSM + nt * 32, DSSM, (bf16_t*)(p.ws + WS_WTGLU) + (size_t)nt * 32 * DSSM + kt * 128, DSSM, tl); }
    if (parts & PW_GU) for (int r = BIDX; r < N_GU; r += gridDim.x) {
        const int kt = r & 7, q = (r >> 3) & 3, j = (r >> 5) & 1, e = r >> 6;
        const int wc = q >> 1, ni = q & 1, unit0 = j * 64 + wc * 32;
        const float* sp; size_t sk;
        if (e < NE) { sp = p.in[ni ? I_WEU : I_WEG] + ((size_t)(l * D + kt * 128) * NE + e) * DE + unit0; sk = (size_t)NE * DE; }
        else { sp = p.in[ni ? I_WSU : I_WSG] + (size_t)(l * D + kt * 128) * DE + unit0; sk = DE; }
        tr_item(sp, sk, (bf16_t*)(p.ws + WS_WGU) + ((size_t)(e * 2 + j) * 128 + q * 32) * D + kt * 128, D, tl); }
    if (parts & PW_DN) for (int r = BIDX; r < N_DN; r += gridDim.x) {
        const int nt = r & 31, e = r >> 5;
        const float* sp = (e < NE ? p.in[I_WED] + (size_t)(l * NE + e) * DE * D : p.in[I_WSD] + (size_t)l * DE * D) + nt * 32;
        tr_item(sp, D, (bf16_t*)(p.ws + WS_WD) + ((size_t)e * D + nt * 32) * DE, DE, tl); }
    __syncthreads();
}
struct EpiStoreBf { bf16_t* C; int ldc; __device__ __forceinline__ void operator()(int r, int c, float v0, float v1, float v2, float v3) const { *(uint2*)(C + (size_t)r * ldc + c) = pack4(v0, v1, v2, v3); } };


__device__ __forceinline__ void st_rbias(const P& p, int l, float* lds) {
    const int lane = TIDX & 63, w = TIDX >> 6;
    const float* rw = p.in[I_RW] + (size_t)l * D * NE;
    for (int o = BIDX * 4 + w; o < 9 * 32; o += gridDim.x * 4) {
        const int bb = o >> 5, e = o & 31;
        const float* sh2 = mod_vec(p, l, bb, 3);
        float a = 0.f;
#pragma unroll
        for (int j = 0; j < 16; ++j) { const int k = j * 64 + lane; a += sh2[k] * rw[(size_t)k * NE + e]; }
        a = wave_sum(a);
        if (lane == 0) ((float*)(p.ws + WS_RBIAS))[(l * 9 + bb) * 32 + e] = a;
    }
    const float* g2 = p.in[I_N2G] + l * D;
    for (int idx = BIDX * NT + TIDX; idx < 9 * D; idx += gridDim.x * NT) {
        const int bb = idx >> 10, k = idx & (D - 1);
        ((float*)(p.ws + WS_GS2))[(size_t)(l * 9 + bb) * D + k] = g2[k] * (1.f + mod_vec(p, l, bb, 4)[k]);
    }
}
template <bool DRY = false>
__device__ __forceinline__ void st_router2(const P& p, int l, unsigned char* ldsb) {
    float* part = (float*)ldsb;
    float* ssq = part + 4 * 32 * 33;
    float* sc = ssq + 128;
    float* rinvs = sc + 32 * 33;
    int* hist = (int*)(rinvs + 32);
    int* gbase = hist + 32;
    const int t = TIDX, lane = t & 63, w = t >> 6, i = lane & 31, hf = lane >> 5;
    const int nrows = l == 0 ? TA : TL;
    const float* rw = p.in[I_RW] + (size_t)l * D * NE;
    int* cnt = CNT_PTR(p, l);
    int* lcode = (int*)(p.ws + WS_LCODE);
    float* lw = (float*)(p.ws + WS_LW);
    bf16_t* xn2 = (bf16_t*)(p.ws + WS_BUFA);
    for (int item = BIDX; item < nrows / 32; item += gridDim.x) {
        const int r0 = item * 32, bb = row_bb(r0);
        const float* gs2 = (const float*)(p.ws + WS_GS2) + (size_t)(l * 9 + bb) * D;
        const float* sh2 = mod_vec(p, l, bb, 3);
        const int kb = w * 256 + hf * 128;
        const float* src = hmid_row(p, r0 + i) + kb;
        const float* gsp = gs2 + kb;
        const float* rwp = rw + (size_t)kb * NE + i;
        f32x16 acc;
        float zf = 0.f; asm volatile("" : "+v"(zf));
#pragma unroll
        for (int r = 0; r < 16; ++r) acc[r] = zf;
        float ss = 0.f;
        f32x4 xa[4], ga[4], xb[4], gb[4]; float wa[16], wb[16];
#define R_LOAD(X, G, W, cb) do { _Pragma("unroll") for (int q = 0; q < 4; ++q) { const int k = ((cb) * 4 + q) * 4; X[q] = *(const f32x4*)(src + k); G[q] = *(const f32x4*)(gsp + k); \
            _Pragma("unroll") for (int j = 0; j < 4; ++j) W[q * 4 + j] = rwp[(size_t)(k + j) * NE]; } } while (0)
#define R_COMP(X, G, W) do { _Pragma("unroll") for (int q = 0; q < 4; ++q) { ss += X[q][0] * X[q][0] + X[q][1] * X[q][1] + X[q][2] * X[q][2] + X[q][3] * X[q][3]; \
            _Pragma("unroll") for (int j = 0; j < 4; ++j) acc = __builtin_amdgcn_mfma_f32_32x32x2f32(X[q][j] * G[q][j], W[q * 4 + j], acc, 0, 0, 0); } } while (0)
        R_LOAD(xa, ga, wa, 0);
#pragma unroll 1
        for (int cb = 0; cb < 8; cb += 2) {
            R_LOAD(xb, gb, wb, cb + 1);
            R_COMP(xa, ga, wa);
            if (cb + 2 < 8) R_LOAD(xa, ga, wa, cb + 2);
            R_COMP(xb, gb, wb);
        }
#undef R_LOAD
#undef R_COMP
        ss += __shfl_xor(ss, 32);
        __syncthreads();
        if (hf == 0) ssq[w * 32 + i] = ss;
        if (t < 32) hist[t] = 0;
#pragma unroll
        for (int r = 0; r < 16; ++r) part[(w * 32 + (r & 3) + 8 * (r >> 2) + 4 * hf) * 33 + i] = acc[r];
        __syncthreads();
        for (int idx = t; idx < 1024; idx += NT) {
            const int row = idx >> 5, e = idx & 31;
            const float logit = part[(0 * 32 + row) * 33 + e] + part[(1 * 32 + row) * 33 + e] + part[(2 * 32 + row) * 33 + e] + part[(3 * 32 + row) * 33 + e];
            const float rinv = rsqrtf((ssq[row] + ssq[32 + row] + ssq[64 + row] + ssq[96 + row]) * (1.f / D) + 1e-6f);
            sc[row * 33 + e] = sigmoid_f(rinv * logit + ((const float*)(p.ws + WS_RBIAS))[(l * 9 + bb) * 32 + e]);
            if (e == 0) rinvs[row] = rinv;
        }
        __syncthreads();
        if (t < 32) {
            const int r = r0 + t;
            float sel[32];
#pragma unroll
            for (int e = 0; e < 32; ++e) sel[e] = sc[t * 33 + e] + p.in[I_RB][l * NE + e];
            int bi[4]; float sv[4]; float sum = 0.f;
#pragma unroll
            for (int k = 0; k < 4; ++k) {
                float best = -1e30f; int b = 0;
#pragma unroll
                for (int e = 0; e < 32; ++e) if (sel[e] > best) { best = sel[e]; b = e; }
#pragma unroll
                for (int e = 0; e < 32; ++e) if (e == b) sel[e] = -1e30f;
                bi[k] = b; sv[k] = sc[t * 33 + b]; sum += sv[k];
            }
            int rank[4];
#pragma unroll
            for (int k = 0; k < 4; ++k) rank[k] = atomicAdd(&hist[bi[k]], 1);
            __builtin_amdgcn_s_waitcnt(0xc07f);
            __builtin_amdgcn_wave_barrier();
            { const int hc = hist[t]; gbase[t] = (hc > 0 && !DRY) ? atomicAdd(&cnt[t * 64], hc) : 0; }
            __builtin_amdgcn_s_waitcnt(0xc07f);
            __builtin_amdgcn_wave_barrier();
#pragma unroll
            for (int k = 0; k < 4; ++k) {
                if (DRY) { if (sv[k] / sum == 12345.f) lw[0] = 0.f; } else {
                const int pos = gbase[bi[k]] + rank[k];
                lcode[(size_t)bi[k] * TA + pos] = r * 4 + k;
                lw[(size_t)bi[k] * TA + pos] = sv[k] / sum * 2.5f; }
            }
        }
        {
            float gs[16], sh[16];
#pragma unroll
            for (int q = 0; q < 16; ++q) { const int k = (q >> 3) * 512 + 8 * lane + (q & 7); gs[q] = gs2[k]; sh[q] = sh2[k]; }
            for (int rr8 = 0; rr8 < 8; rr8 += 4) {
                f32x4 xv[4][4];
#pragma unroll
                for (int u = 0; u < 4; ++u) {
                    const float* s2 = hmid_row(p, r0 + w * 8 + rr8 + u);
#pragma unroll
                    for (int h2 = 0; h2 < 2; ++h2) { xv[u][2 * h2] = *(const f32x4*)(s2 + h2 * 512 + 8 * lane); xv[u][2 * h2 + 1] = *(const f32x4*)(s2 + h2 * 512 + 8 * lane + 4); }
                }
#pragma unroll
                for (int u = 0; u < 4; ++u) {
                    const int rho = w * 8 + rr8 + u;
                    const float rr = rinvs[rho];
                    bf16_t* dst = xn2 + (size_t)(r0 + rho) * D;
#pragma unroll
                    for (int h2 = 0; h2 < 2; ++h2) {
                        const f32x4 x0 = xv[u][2 * h2], x1 = xv[u][2 * h2 + 1];
                        u32x4 o;
                        o[0] = cvt_pk_bf16(x0[0] * rr * gs[h2 * 8 + 0] + sh[h2 * 8 + 0], x0[1] * rr * gs[h2 * 8 + 1] + sh[h2 * 8 + 1]);
                        o[1] = cvt_pk_bf16(x0[2] * rr * gs[h2 * 8 + 2] + sh[h2 * 8 + 2], x0[3] * rr * gs[h2 * 8 + 3] + sh[h2 * 8 + 3]);
                        o[2] = cvt_pk_bf16(x1[0] * rr * gs[h2 * 8 + 4] + sh[h2 * 8 + 4], x1[1] * rr * gs[h2 * 8 + 5] + sh[h2 * 8 + 5]);
                        o[3] = cvt_pk_bf16(x1[2] * rr * gs[h2 * 8 + 6] + sh[h2 * 8 + 6], x1[3] * rr * gs[h2 * 8 + 7] + sh[h2 * 8 + 7]);
                        *(u32x4*)(dst + h2 * 512 + 8 * lane) = o;
                    }
                }
            }
        }
    }
    __syncthreads();
}

constexpr int LDS_CSTAGE = 128 * C_LD * 4;
constexpr int M2_A = 0, M2_B = 32768, M2_C = 57344, M2_CLD = 144;
constexpr int MOE_LDS_LIST = M2_C + 128 * M2_CLD;
constexpr int LDS_MOE = MOE_LDS_LIST + 128 * 4 + 128 * 4 + 64 * 4;
constexpr int LDS_MODB = (9 * D + 9 * 8 * 32) * 4;
constexpr int LDS_TOTAL = LDS_MOE > LDS_MODB ? LDS_MOE : LDS_MODB;
struct ARowCode { const bf16_t* base; const int* codes; int mode; __device__ __forceinline__ const bf16_t* operator()(int m) const {
    const int c = codes[m];
    if (mode == 0) return base + (size_t)(c < 0 ? 0 : (c >> 2)) * D;
    return base + (size_t)(c < 0 ? 0 : (c >> 2) * 5 + (c & 3)) * DE; } };
__device__ __forceinline__ void moe_tstart(const P& p, int l, int* ts) {
    if (TIDX == 0) { const int* cnt = CNT_PTR(p, l); int a = 0; for (int e = 0; e < NE; ++e) { ts[e] = a; a += (cnt[e * 64] + 127) >> 7; } ts[NE] = a; }
    __syncthreads();
}
__device__ __forceinline__ void st_moe1(const P& p, int l, unsigned char* lds) {
    int* codes = (int*)(lds + MOE_LDS_LIST); float* wts = (float*)(codes + 128); int* ts = (int*)(wts + 128);
    const int nrows = l == 0 ? TA : TL;
    const int* cnt = CNT_PTR(p, l);
    const int* lcode = (const int*)(p.ws + WS_LCODE);
    const float* lw = (const float*)(p.ws + WS_LW);
    const bf16_t* xn2 = (const bf16_t*)(p.ws + WS_BUFA);
    bf16_t* hid = (bf16_t*)(p.ws + WS_HID);
    const bf16_t* wgu = (const bf16_t*)(p.ws + WS_WGU);
    moe_tstart(p, l, ts);
    const int nrt = ts[NE], nsh = nrows / 128, total = (nrt + nsh) * 2;
    const int lane = TIDX & 63, w = TIDX >> 6, wr = w >> 1, wc = w & 1, lr = lane & 31, lh = lane >> 5;
    int t_end, t_step;
    for (int tile = xcd_first(total, t_end, t_step); tile < t_end; tile += t_step) {
        const int rt = tile >> 1, j = tile & 1;
        int e, m0, valid;
        if (rt < nrt) { e = 0; while (ts[e + 1] <= rt) ++e; m0 = (rt - ts[e]) * 128; valid = cnt[e * 64] - m0; if (valid > 128) valid = 128; }
        else { e = NE; m0 = (rt - nrt) * 128; valid = 128; }
        __syncthreads();
        if (TIDX < 128) {
            const int m = TIDX;
            if (e < NE) { const bool ok = m < valid; codes[m] = ok ? lcode[(size_t)e * TA + m0 + m] : -1; wts[m] = ok ? lw[(size_t)e * TA + m0 + m] : 0.f; }
            else { codes[m] = (m0 + m) * 4; wts[m] = 1.f; }
        }
        __syncthreads();
        f32x16 acc[2][2];
        gemm_tile(acc, ARowCode{xn2, codes, 0}, wgu + (size_t)((e * 2 + j) * 128) * D, D, D, lds);
#pragma unroll
        for (int mi = 0; mi < 2; ++mi) {
            const int m = wr * 64 + mi * 32 + lr;
            const int c = codes[m];
            if (c >= 0) {
                const float wt = wts[m];
                const size_t hrow = e < NE ? (size_t)(c >> 2) * 5 + (c & 3) : (size_t)(c >> 2) * 5 + 4;
#pragma unroll
                for (int g = 0; g < 4; ++g) {
                    float h[4];
#pragma unroll
                    for (int q = 0; q < 4; ++q) h[q] = silu_f(acc[mi][0][4 * g + q]) * acc[mi][1][4 * g + q] * wt;
                    *(uint2*)(hid + hrow * DE + j * 64 + wc * 32 + 8 * g + 4 * lh) = pack4(h[0], h[1], h[2], h[3]);
                }
            }
        }
    }
}
__device__ __forceinline__ void st_moe2(const P& p, int l, unsigned char* lds) {
    int* codes = (int*)(lds + MOE_LDS_LIST); float* wts = (float*)(codes + 128); int* ts = (int*)(wts + 128);
    const int* cnt = CNT_PTR(p, l);
    const int* lcode = (const int*)(p.ws + WS_LCODE);
    const bf16_t* hid = (const bf16_t*)(p.ws + WS_HID);
    unsigned char* slab = (unsigned char*)(p.ws + WS_SLAB);
    const bf16_t* wd = (const bf16_t*)(p.ws + WS_WD);
    moe_tstart(p, l, ts);
    const int nrt = ts[NE], total = nrt * 8;
    int t_end, t_step;
    for (int tile = xcd_first(total, t_end, t_step); tile < t_end; tile += t_step) {
        const int rt = tile >> 3, n0 = (tile & 7) * 128;
        int e = 0; while (ts[e + 1] <= rt) ++e;
        const int m0 = (rt - ts[e]) * 128; int valid = cnt[e * 64] - m0; if (valid > 128) valid = 128;
        __syncthreads();
        if (TIDX < 128) { const int m = TIDX; codes[m] = m < valid ? lcode[(size_t)e * TA + m0 + m] : -1; }
        __syncthreads();
        f32x16 acc[2][2];
        gemm_tile(acc, ARowCode{hid, codes, 1}, wd + ((size_t)e * D + n0) * DE, DE, DE, lds);
        acc_foreach4_lds(acc, lds, [&](int r, int c, float v0, float v1, float v2, float v3) { const int code = codes[r]; if (code >= 0) *(unsigned*)(slab + (size_t)code * D + n0 + c) = pack4_fp8(v0, v1, v2, v3); });
    }
}
constexpr int M2_NPER = 4;
__device__ __forceinline__ void st_moe2s(const P& p, int l, unsigned char* lds) {
    int* codes = (int*)(lds + MOE_LDS_LIST); float* wts = (float*)(codes + 128); int* ts = (int*)(wts + 128);
    const int* cnt = CNT_PTR(p, l);
    const int* lcode = (const int*)(p.ws + WS_LCODE);
    const bf16_t* hid = (const bf16_t*)(p.ws + WS_HID);
    unsigned char* slab = (unsigned char*)(p.ws + WS_SLAB);
    const bf16_t* wd = (const bf16_t*)(p.ws + WS_WD);
    moe_tstart(p, l, ts);
    constexpr int NSP = 8 / M2_NPER, S = 4 * M2_NPER;
    const int nrt = ts[NE], total = nrt * NSP;
    const int t = TIDX, lane = t & 63, w = __builtin_amdgcn_readfirstlane(t >> 6), wr = w >> 1, wc = w & 1, lr = lane & 31, lh = lane >> 5;
    const int srow = t >> 2, lc = (t & 3) ^ ((srow >> 2) & 3);
    const int f = (lr >> 2) & 3;
    const int aoff = (wr * 64 + lr) * 64 + ((lh ^ f) << 4), boff = (wc * 64 + lr) * 64 + ((lh ^ f) << 4);
    LAS unsigned char* l3 = (LAS unsigned char*)lds;
    int t_end, t_step;
    for (int item = xcd_first(total, t_end, t_step); item < t_end; item += t_step) {
        const int rt = item / NSP, n0 = (item % NSP) * (128 * M2_NPER);
        int e = 0; while (ts[e + 1] <= rt) ++e;
        const int m0 = (rt - ts[e]) * 128; int valid = cnt[e * 64] - m0; if (valid > 128) valid = 128;
        __syncthreads();
        if (t < 128) codes[t] = t < valid ? lcode[(size_t)e * TA + m0 + t] : -1;
        __syncthreads();
        const bf16_t* ap[2]; const bf16_t* bp[2];
#pragma unroll
        for (int i = 0; i < 2; ++i) {
            const int c = codes[srow + 64 * i];
            ap[i] = hid + (size_t)(c < 0 ? 0 : (c >> 2) * 5 + (c & 3)) * DE + lc * 8;
            bp[i] = wd + ((size_t)e * D + n0 + srow + 64 * i) * DE + lc * 8;
        }
#pragma unroll
        for (int ks = 0; ks < 4; ++ks) {
            __builtin_amdgcn_global_load_lds((const unsigned*)(ap[0] + ks * 32), (LAS unsigned*)(l3 + M2_A + ks * 8192 + w * 1024), 16, 0, 0);
            __builtin_amdgcn_global_load_lds((const unsigned*)(ap[1] + ks * 32), (LAS unsigned*)(l3 + M2_A + ks * 8192 + w * 1024 + 4096), 16, 0, 0);
        }
#define M2_ISSUE(s_) do { const int nt_ = (s_) >> 2, ks_ = (s_) & 3; LAS unsigned char* d_ = l3 + M2_B + ((s_) % 3) * 8192 + w * 1024; \
        __builtin_amdgcn_global_load_lds((const unsigned*)(bp[0] + (size_t)nt_ * 128 * DE + ks_ * 32), (LAS unsigned*)(d_), 16, 0, 0); \
        __builtin_amdgcn_global_load_lds((const unsigned*)(bp[1] + (size_t)nt_ * 128 * DE + ks_ * 32), (LAS unsigned*)(d_ + 4096), 16, 0, 0); } while (0)
        M2_ISSUE(0); M2_ISSUE(1);
        f32x16 acc[2][2];
        float zf = 0.f; asm volatile("" : "+v"(zf));
#pragma unroll
        for (int mi = 0; mi < 2; ++mi)
#pragma unroll
            for (int ni = 0; ni < 2; ++ni)
#pragma unroll
                for (int r = 0; r < 16; ++r) acc[mi][ni][r] = zf;
#pragma unroll 1
        for (int s = 0; s < S; ++s) {
            if (s + 1 < S) asm volatile("s_waitcnt vmcnt(2) lgkmcnt(0)" ::: "memory"); else asm volatile("s_waitcnt vmcnt(0) lgkmcnt(0)" ::: "memory");
            __builtin_amdgcn_s_barrier();
            if (s + 2 < S) M2_ISSUE(s + 2);
            const int ks = s & 3;
            const LAS unsigned char* ca = l3 + M2_A + ks * 8192;
            const LAS unsigned char* cb = l3 + M2_B + (s % 3) * 8192;
#pragma unroll
            for (int s2 = 0; s2 < 2; ++s2) {
                const bf16x8 a0 = *(const LAS bf16x8*)(ca + (aoff ^ (s2 << 5))), a1 = *(const LAS bf16x8*)(ca + ((aoff + 2048) ^ (s2 << 5)));
                const bf16x8 b0 = *(const LAS bf16x8*)(cb + (boff ^ (s2 << 5))), b1 = *(const LAS bf16x8*)(cb + ((boff + 2048) ^ (s2 << 5)));
                acc[0][0] = __builtin_amdgcn_mfma_f32_32x32x16_bf16(b0, a0, acc[0][0], 0, 0, 0);
                acc[0][1] = __builtin_amdgcn_mfma_f32_32x32x16_bf16(b1, a0, acc[0][1], 0, 0, 0);
                acc[1][0] = __builtin_amdgcn_mfma_f32_32x32x16_bf16(b0, a1, acc[1][0], 0, 0, 0);
                acc[1][1] = __builtin_amdgcn_mfma_f32_32x32x16_bf16(b1, a1, acc[1][1], 0, 0, 0);
            }
            if (ks == 3) {
                const int nt = s >> 2;
#pragma unroll
                for (int mi = 0; mi < 2; ++mi)
#pragma unroll
                    for (int ni = 0; ni < 2; ++ni)
#pragma unroll
                        for (int g = 0; g < 4; ++g) {
                            *(unsigned*)(lds + M2_C + (wr * 64 + mi * 32 + lr) * M2_CLD + wc * 64 + ni * 32 + 8 * g + 4 * lh) =
                                pack4_fp8(acc[mi][ni][4 * g], acc[mi][ni][4 * g + 1], acc[mi][ni][4 * g + 2], acc[mi][ni][4 * g + 3]);
                            acc[mi][ni][4 * g] = zf; acc[mi][ni][4 * g + 1] = zf; acc[mi][ni][4 * g + 2] = zf; acc[mi][ni][4 * g + 3] = zf;
                        }
                asm volatile("s_waitcnt lgkmcnt(0)" ::: "memory");
                __builtin_amdgcn_s_barrier();
#pragma unroll
                for (int i = 0; i < 4; ++i) {
                    const int ch = t + 256 * i, r = ch >> 3, c16 = (ch & 7) * 16;
                    const int code = codes[r];
                    const u32x4 v = *(const u32x4*)(lds + M2_C + r * M2_CLD + c16);
                    if (code >= 0) *(u32x4*)(slab + (size_t)code * D + n0 + nt * 128 + c16) = v;
                }
            }
        }
#undef M2_ISSUE
    }
    __syncthreads();
}
struct EpiMoeF { const unsigned char* slab; const float* modl; float* out; const float* hcmid; float* hc1; bool outw = true;
    __device__ __forceinline__ void operator()(int r, int c, float v0, float v1, float v2, float v3) const {
    const unsigned char* sl = slab + (size_t)r * 4 * D + c;
    float v[4] = {v0, v1, v2, v3};
    float a[4] = {0.f, 0.f, 0.f, 0.f};
#pragma unroll
    for (int k = 0; k < 4; ++k) { const int q = (int)*(const unsigned*)(sl + (size_t)k * D);
        a[0] += __builtin_amdgcn_cvt_f32_fp8(q, 0); a[1] += __builtin_amdgcn_cvt_f32_fp8(q, 1); a[2] += __builtin_amdgcn_cvt_f32_fp8(q, 2); a[3] += __builtin_amdgcn_cvt_f32_fp8(q, 3); }
#pragma unroll
    for (int q = 0; q < 4; ++q) v[q] += a[q] * (1.f / SLAB_SCALE);
    const f32x4 g2 = *(const f32x4*)(modl + ((size_t)row_bb(r) * 6 + 5) * D + c);
    const f32x4 hm = *(const f32x4*)((r < TL ? out + (size_t)r * D : hcmid + (size_t)(r - TL) * D) + c);
    f32x4 o; o[0] = hm[0] + g2[0] * v[0]; o[1] = hm[1] + g2[1] * v[1]; o[2] = hm[2] + g2[2] * v[2]; o[3] = hm[3] + g2[3] * v[3];
    if (outw) *(f32x4*)((r < TL ? out + (size_t)r * D : hc1 + (size_t)(r - TL) * D) + c) = o;
    else if (o[0] == 12345.f) *(f32x4*)(hc1) = o; } };
__device__ __forceinline__ EpiMoeF make_epi_moef(const P& p, int l) {
    return EpiMoeF{(const unsigned char*)(p.ws + WS_SLAB), (const float*)(p.ws + WS_MOD) + (size_t)l * 9 * 6 * D, p.out, (const float*)(p.ws + WS_HCMID), (float*)(p.ws + WS_HC1)};
}
struct SsmPar { float lre, lim, dt; };
__device__ __forceinline__ SsmPar ssm_par(const P& p, int l, int dir, int g, int pp) {
    const int pi = ((l * 2 + dir) * SG + g) * SP + pp;
    SsmPar r; r.lre = p.in[I_LRE][pi]; r.lim = p.in[I_LIM][pi]; r.dt = expf(p.in[I_LDT][(l * 2 + dir) * SG + g]); return r;
}
__device__ __forceinline__ float2 ssm_pow(const SsmPar& q, float e) {
    const float mag = expf(e * q.lre * q.dt), ang = e * (q.lim * q.dt);
    return make_float2(mag * cosf(ang), mag * sinf(ang));
}
__device__ __forceinline__ float2 ssm_f(const SsmPar& q) {
    const float2 lb = ssm_pow(q, 1.f);
    const float nr = lb.x - 1.f, ni = lb.y, den = q.lre * q.lre + q.lim * q.lim;
    return make_float2((nr * q.lre + ni * q.lim) / den, (ni * q.lre - nr * q.lim) / den);
}
__device__ __forceinline__ float2 cmul(float2 a, float2 b) { return make_float2(a.x * b.x - a.y * b.y, a.x * b.y + a.y * b.x); }
__device__ __forceinline__ void st_ssm_tables(const P& p) {
    float2* pw = (float2*)(p.ws + WS_POW); float2* fb = (float2*)(p.ws + WS_FB);
    for (int idx = BIDX * NT + TIDX; idx < 2 * 2 * 16 * 33 * 64; idx += gridDim.x * NT) {
        const int pp = idx & 63; int q_ = idx >> 6; const int e = q_ % 33; q_ /= 33; const int g = q_ & 15, dir = (q_ >> 4) & 1, l = q_ >> 5;
        pw[idx] = ssm_pow(ssm_par(p, l, dir, g, pp), (float)e);
    }
    for (int idx = BIDX * NT + TIDX; idx < 2 * 2 * 16 * 64 * 16; idx += gridDim.x * NT) {
        const int h = idx & 15, pp = (idx >> 4) & 63, g = (idx >> 10) & 15, dir = (idx >> 14) & 1, l = idx >> 15;
        const size_t bi = ((size_t)((l * 2 + dir) * SG + g) * SP + pp) * 16 + h;
        fb[idx] = cmul(ssm_f(ssm_par(p, l, dir, g, pp)), make_float2(p.in[I_BRE][bi], p.in[I_BIM][bi]));
    }
}
__device__ __forceinline__ void st_ssm_kj(const P& p, float* lds) {
    float* lam = lds; float* Cc = lds + 128; float* Bb = Cc + 2048;
    float* kj = (float*)(p.ws + WS_KJ);
    const int t = TIDX;
    for (int item = (int)gridDim.x - 1 - BIDX; item < 64; item += gridDim.x) {
        const int l = item >> 5, g = (item >> 1) & 15, dir = item & 1;
        const int base = (l * 2 + dir) * SG + g;
        __syncthreads();
        if (t < 64) {
            const SsmPar q = ssm_par(p, l, dir, g, t);
            const float2 lb = ssm_pow(q, 1.f), f = ssm_f(q);
            lam[2 * t] = lb.x; lam[2 * t + 1] = lb.y;
            for (int h = 0; h < 16; ++h) {
                const size_t bi = ((size_t)base * SP + t) * 16 + h;
                const float2 bb = cmul(f, make_float2(p.in[I_BRE][bi], p.in[I_BIM][bi]));
                Bb[(t * 16 + h) * 2] = bb.x; Bb[(t * 16 + h) * 2 + 1] = bb.y;
            }
        }
        for (int i = t; i < 1024; i += NT) { const size_t ci = (size_t)base * 1024 + i; Cc[2 * i] = p.in[I_CRE][ci]; Cc[2 * i + 1] = p.in[I_CIM][ci]; }
        __syncthreads();
        const int ho = t >> 4, hi = t & 15;
        float acc[32];
#pragma unroll
        for (int j = 0; j < 32; ++j) acc[j] = 0.f;
        for (int pp = 0; pp < 64; ++pp) {
            float2 z = cmul(make_float2(Cc[(ho * 64 + pp) * 2], Cc[(ho * 64 + pp) * 2 + 1]), make_float2(Bb[(pp * 16 + hi) * 2], Bb[(pp * 16 + hi) * 2 + 1]));
            const float2 lb = make_float2(lam[2 * pp], lam[2 * pp + 1]);
#pragma unroll
            for (int j = 0; j < 32; ++j) { acc[j] += z.x; z = cmul(z, lb); }
        }
#pragma unroll
        for (int j = 0; j < 32; ++j) kj[((size_t)((l * 16 + g) * 2 + dir) * 32 + j) * 256 + ho * 16 + hi] = acc[j];
    }
    __syncthreads();
}
__device__ __forceinline__ void st_prep_ssm(const P& p, int l, int parts) {
    bf16_t* wst = (bf16_t*)(p.ws + WS_WST);
    if (parts & 1) for (int idx = BIDX * NT + TIDX; idx < 16 * 256 * 64; idx += gridDim.x * NT) {
        const int kc = idx & 63, n = (idx >> 6) & 255, g = idx >> 14;
        const int dir = n >> 7, c = (n >> 6) & 1, pp = n & 63, s = kc >> 1, h0 = (kc & 1) * 8;
        const int ldg = (l * 2 + dir) * 16 + g;
        const float2 coef = ((const float2*)(p.ws + WS_POW))[((size_t)ldg * 33 + (dir == 0 ? 31 - s : s)) * 64 + pp];
        const float2* fbp = (const float2*)(p.ws + WS_FB) + ((size_t)ldg * 64 + pp) * 16 + h0;
        float v[8];
#pragma unroll
        for (int j = 0; j < 8; ++j) { const float2 z = cmul(coef, fbp[j]); v[j] = c == 0 ? z.x : z.y; }
        u32x4 o; o[0] = cvt_pk_bf16(v[0], v[1]); o[1] = cvt_pk_bf16(v[2], v[3]); o[2] = cvt_pk_bf16(v[4], v[5]); o[3] = cvt_pk_bf16(v[6], v[7]);
        *(u32x4*)(wst + ((size_t)(g * 256 + n)) * 512 + kc * 8) = o;
    }
    bf16_t* kw = (bf16_t*)(p.ws + WS_KW);
    const float* kj = (const float*)(p.ws + WS_KJ);
    if (parts & 2) for (int idx = BIDX * NT + TIDX; idx < 16 * 512 * 96; idx += gridDim.x * NT) {
        const int kc = idx % 96, n = (idx / 96) & 511, g = idx / (96 * 512);
        const int tau = n >> 4, ho = n & 15;
        float v[8];
        if (kc < 64) {
            const int s = kc >> 1, hi0 = (kc & 1) * 8;
#pragma unroll
            for (int j = 0; j < 8; ++j) {
                float a = 0.f;
                if (s <= tau) a += kj[((size_t)((l * 16 + g) * 2 + 0) * 32 + (tau - s)) * 256 + ho * 16 + hi0 + j];
                if (s >= tau) a += kj[((size_t)((l * 16 + g) * 2 + 1) * 32 + (s - tau)) * 256 + ho * 16 + hi0 + j];
                if (s == tau && ho == hi0 + j) a += p.in[I_SD][l * DSSM + g * 16 + ho];
                v[j] = a;
            }
        } else {
            const int kk = (kc - 64) * 8, dir = kk >> 7, c = (kk >> 6) & 1, p0 = kk & 63;
            const int e = dir == 0 ? tau + 1 : 32 - tau;
            const float2* pwp = (const float2*)(p.ws + WS_POW) + ((size_t)((l * 2 + dir) * 16 + g) * 33 + e) * 64 + p0;
#pragma unroll
            for (int j = 0; j < 8; ++j) {
                const size_t ci = ((size_t)((l * 2 + dir) * SG + g) * 16 + ho) * SP + p0 + j;
                const float2 z = cmul(make_float2(p.in[I_CRE][ci], p.in[I_CIM][ci]), pwp[j]);
                v[j] = c == 0 ? z.x : -z.y;
            }
        }
        u32x4 o; o[0] = cvt_pk_bf16(v[0], v[1]); o[1] = cvt_pk_bf16(v[2], v[3]); o[2] = cvt_pk_bf16(v[4], v[5]); o[3] = cvt_pk_bf16(v[6], v[7]);
        *(u32x4*)(kw + ((size_t)(g * 512 + n)) * 768 + kc * 8) = o;
    }
}
__device__ __forceinline__ void st_ssm_egemm(const P& p, unsigned char* lds) {
    const bf16_t* ua = (const bf16_t*)(p.ws + WS_UA);
    const bf16_t* wst = (const bf16_t*)(p.ws + WS_WST);
    float* E = (float*)(p.ws + WS_E);
    int t_end, t_step;
    for (int tile = xcd_first(160, t_end, t_step); tile < t_end; tile += t_step) {
        const int nt = tile & 1, mt = (tile >> 1) % 5, g = tile / 10;
        f32x16 acc[2][2];
        gemm_tile(acc, ARowPlain{ua + (size_t)(g * 640 + mt * 128) * 768, 768}, wst + (size_t)(g * 256 + nt * 128) * 512, 512, 512, lds);
        acc_foreach4_lds(acc, lds, [&](int r, int c, float v0, float v1, float v2, float v3) { f32x4 o; o[0] = v0; o[1] = v1; o[2] = v2; o[3] = v3; *(f32x4*)(E + (size_t)(g * 640 + mt * 128 + r) * 256 + nt * 128 + c) = o; });
    }
}
__device__ __forceinline__ void st_ssm_carry(const P& p, int l) {
    bf16_t* ua = (bf16_t*)(p.ws + WS_UA);
    const float* E = (const float*)(p.ws + WS_E);
    for (int idx = BIDX * NT + TIDX; idx < NB * 16 * 2 * 64; idx += gridDim.x * NT) {
        const int pp = idx & 63, dir = (idx >> 6) & 1, g = (idx >> 7) & 15, b = idx >> 11;
        const float2 l32 = ((const float2*)(p.ws + WS_POW))[((size_t)((l * 2 + dir) * 16 + g) * 33 + 32) * 64 + pp];
        float2 S = make_float2(0.f, 0.f);
        for (int s0 = 0; s0 < 72; s0 += 8) {
            int ch[8]; float er[8], ei[8];
#pragma unroll
            for (int j = 0; j < 8; ++j) {
                const int step = s0 + j;
                if (dir == 0) ch[j] = step < 8 ? 512 + b * 8 + step : b * 64 + (step - 8);
                else ch[j] = step < 8 ? 512 + b * 8 + (7 - step) : b * 64 + (63 - (step - 8));
                const float* e = E + (size_t)(g * 640 + ch[j]) * 256 + dir * 128 + pp;
                er[j] = e[0]; ei[j] = e[64];
            }
#pragma unroll
            for (int j = 0; j < 8; ++j) {
                bf16_t* o = ua + (size_t)(g * 640 + ch[j]) * 768 + 512 + dir * 128 + pp;
                o[0] = f2bf(S.x); o[64] = f2bf(S.y);
                S = cmul(l32, S); S.x += er[j]; S.y += ei[j];
            }
        }
    }
}
__device__ __forceinline__ void st_ssm_ygemm(const P& p, int l, unsigned char* lds) {
    const bf16_t* ua = (const bf16_t*)(p.ws + WS_UA);
    const bf16_t* kw = (const bf16_t*)(p.ws + WS_KW);
    bf16_t* G = (bf16_t*)(p.ws + WS_G);
    const int nmt = l == 0 ? 5 : 4;
    int t_end, t_step;
    for (int tile = xcd_first(16 * nmt * 4, t_end, t_step); tile < t_end; tile += t_step) {
        const int nt = tile & 3, mt = (tile >> 2) % nmt, g = tile / (4 * nmt);
        f32x16 acc[2][2];
        gemm_tile(acc, ARowPlain{ua + (size_t)(g * 640 + mt * 128) * 768, 768}, kw + (size_t)(g * 512 + nt * 128) * 768, 768, 768, lds);
        acc_foreach4_lds(acc, lds, [&](int r, int c, float v0, float v1, float v2, float v3) {
            const int chunk = mt * 128 + r, n = nt * 128 + c;
            if (chunk < TA / 32) *(uint2*)(G + (size_t)(chunk * 32 + (n >> 4)) * DSSM + g * 16 + (n & 15)) = pack4(gelu_f(v0), gelu_f(v1), gelu_f(v2), gelu_f(v3)); });
    }
}
struct EpiGlu2 { const bf16_t* G; bf16_t* mix; const float* bias; __device__ __forceinline__ void operator()(int r, int c, float v0, float v1, float v2, float v3) const {
    const uint2 q = *(const uint2*)(G + (size_t)r * DSSM + c);
    const f32x4 b = *(const f32x4*)(bias + c);
    *(uint2*)(mix + (size_t)r * D + 256 + c) = pack4(__uint_as_float(q.x << 16) * sigmoid_f(v0 + b[0]), __uint_as_float(q.x & 0xffff0000u) * sigmoid_f(v1 + b[1]),
                                                     __uint_as_float(q.y << 16) * sigmoid_f(v2 + b[2]), __uint_as_float(q.y & 0xffff0000u) * sigmoid_f(v3 + b[3])); } };

constexpr float QSCALE = 0.125f * 1.4426950408889634f;
__device__ __forceinline__ void st_rope_table(const P& p) {
    float2* tab = (float2*)(p.ws + WS_ROPE);
    for (int idx = BIDX * NT + TIDX; idx < L * 32; idx += gridDim.x * NT) {
        const int t = idx >> 5, a = (idx >> 4) & 1, i = idx & 15;
        const float pos = a == 0 ? (float)(t / 64) : (float)(t % 64);
        const float ang = pos * powf(10000.f, -(float)i / 16.f);
        tab[idx] = make_float2(cosf(ang), sinf(ang));
    }
}
__device__ __forceinline__ void st_inproj(const P& p, int l, unsigned char* lds) {
    const bf16_t* A = (const bf16_t*)(p.ws + WS_BUFA);
    const bf16_t* Bt = (const bf16_t*)(p.ws + WS_WTIN);
    bf16_t* pc = (bf16_t*)(p.ws + WS_PC);
    bf16_t* ua = (bf16_t*)(p.ws + WS_UA);
    bf16_t* qb = (bf16_t*)(p.ws + WS_QB);
    bf16_t* kb = (bf16_t*)(p.ws + WS_KB);
    bf16_t* vt = (bf16_t*)(p.ws + WS_VT);
    const float2* rope = (const float2*)(p.ws + WS_ROPE);
    const int lane = TIDX & 63, w = TIDX >> 6, wr = w >> 1, wc = w & 1, lr = lane & 31, lh = lane >> 5;
    constexpr int TN = DIN / 128;
    int t_end, t_step;
    for (int tile = xcd_first((TA / 128) * TN, t_end, t_step); tile < t_end; tile += t_step) {
        const int tn = tile % TN, m0 = (tile / TN) * 128, n0 = tn * 128;
        f32x16 acc[2][2];
        gemm_tile(acc, ARowPlain{A + (size_t)m0 * D, D}, Bt + (size_t)n0 * D, D, D, lds);
        if (tn < 6) {
            acc_foreach4_lds(acc, lds, [&](int r, int c, float v0, float v1, float v2, float v3) { *(uint2*)(pc + (size_t)(m0 + r) * 768 + n0 + c) = pack4(v0, v1, v2, v3); });
        } else if (tn < 8) {
            acc_foreach4_lds(acc, lds, [&](int r, int c, float v0, float v1, float v2, float v3) { const int row = m0 + r, g = (tn - 6) * 8 + (c >> 4);
                *(uint2*)(ua + (size_t)(g * 640 + (row >> 5)) * 768 + (row & 31) * 16 + (c & 15)) = pack4(v0, v1, v2, v3); });
        } else if (tn < 13) {
            const bool isq = tn < 12;
            const float* gain = (isq ? p.in[I_QG] : p.in[I_KG]) + l * 64;
            const bool lat = m0 < TL;
            const float osc = isq ? QSCALE : 1.f;
#pragma unroll
            for (int mi = 0; mi < 2; ++mi) {
                const int row = m0 + wr * 64 + mi * 32 + lr;
                float ss = 0.f;
#pragma unroll
                for (int ni = 0; ni < 2; ++ni)
#pragma unroll
                    for (int r = 0; r < 16; ++r) ss += acc[mi][ni][r] * acc[mi][ni][r];
                ss += __shfl_xor(ss, 32);
                const float rinv = rsqrtf(ss * (1.f / 64.f) + 1e-6f) * osc;
                const int t = row & (L - 1);
                bf16_t* o = isq ? qb + (size_t)row * DATT + ((tn - 8) * 2 + wc) * 64 : kb + (size_t)row * 128 + wc * 64;
#pragma unroll
                for (int ni = 0; ni < 2; ++ni)
#pragma unroll
                    for (int g = 0; g < 2; ++g) {
                        const int d0 = ni * 32 + 8 * g + 4 * lh;
                        const f32x4 glo = *(const f32x4*)(gain + d0), ghi = *(const f32x4*)(gain + d0 + 16);
                        float t1[4], t2[4];
#pragma unroll
                        for (int q = 0; q < 4; ++q) { t1[q] = acc[mi][ni][4 * g + q] * rinv * glo[q]; t2[q] = acc[mi][ni][8 + 4 * g + q] * rinv * ghi[q]; }
                        if (lat) {
                            const float2* cs = rope + (t * 2 + ni) * 16 + 8 * g + 4 * lh;
                            const f32x4 c01 = *(const f32x4*)(cs), c23 = *(const f32x4*)(cs + 2);
                            const float cc[4] = {c01[0], c01[2], c23[0], c23[2]}, sn[4] = {c01[1], c01[3], c23[1], c23[3]};
#pragma unroll
                            for (int q = 0; q < 4; ++q) { const float a = t1[q], b = t2[q]; t1[q] = a * cc[q] - b * sn[q]; t2[q] = a * sn[q] + b * cc[q]; }
                        }
                        *(uint2*)(o + d0) = pack4(t1[0], t1[1], t1[2], t1[3]);
                        *(uint2*)(o + d0 + 16) = pack4(t2[0], t2[1], t2[2], t2[3]);
                    }
            }
        } else {
            acc_foreach4_lds(acc, lds, [&](int r, int c, float v0, float v1, float v2, float v3) { *(uint2*)(vt + (size_t)(m0 + r) * 128 + c) = pack4(v0, v1, v2, v3); });
        }
    }
}

constexpr int AT_KROWB = 144, AT_VROWB = 136, AT_VOFF = 64 * AT_KROWB;
__device__ __forceinline__ void st_attn2(const P& p, int l, unsigned char* lds, int part, int nparts) {
    const bf16_t* qb = (const bf16_t*)(p.ws + WS_QB);
    const bf16_t* kb = (const bf16_t*)(p.ws + WS_KB);
    const bf16_t* vb = (const bf16_t*)(p.ws + WS_VT);
    bf16_t* mix = (bf16_t*)(p.ws + WS_BUFA);
    const int t = TIDX, lane = t & 63, w = t >> 6, lr = lane & 31, lh = lane >> 5;
    constexpr int NLAT = NB * 32 * 2;
    const int nitems = NLAT + (l == 0 ? NB * 4 * 2 : 0);
    int t_end, t_step;
    for (int kk = xcd_first((nitems - part + nparts - 1) / nparts, t_end, t_step); kk < t_end; kk += t_step) {
        const int item = kk * nparts + part;
        const bool isctx = item >= NLAT;
        int b, q64, g;
        if (!isctx) { g = item & 1; q64 = (item >> 1) & 31; b = item >> 6; }
        else { const int it = item - NLAT; g = it & 1; q64 = (it >> 1) & 3; b = it >> 3; }
        const int hq = g * 4 + w;
        const int rq0 = isctx ? TL + b * LC + q64 * 64 : b * L + q64 * 64;
        bf16x8 qf[2][4];
#pragma unroll
        for (int qs = 0; qs < 2; ++qs)
#pragma unroll
            for (int s4 = 0; s4 < 4; ++s4) qf[qs][s4] = *(const bf16x8*)(qb + (size_t)(rq0 + qs * 32 + lr) * DATT + hq * 64 + s4 * 16 + lh * 8);
        const float sinkl = p.in[I_SINK][l * NQH + hq] * 1.4426950408889634f;
        float m[2] = {sinkl, sinkl};
        float lsum[2]; lsum[0] = lsum[1] = lh == 0 ? 1.f : 0.f;
        f32x16 o[2][2];
        float zf = 0.f; asm volatile("" : "+v"(zf));
#pragma unroll
        for (int qs = 0; qs < 2; ++qs)
#pragma unroll
            for (int dt = 0; dt < 2; ++dt)
#pragma unroll
                for (int r = 0; r < 16; ++r) o[qs][dt][r] = zf;
        const int nwin = isctx ? 0 : 5, nkt = nwin + 4;
        const int srow = t >> 3, kc = t & 7;
        u32x4 pk[2], pv[2];
        auto tile_row0 = [&](int kt, bool& win, bool& valid) -> int {
            if (kt < nwin) { win = true; const int k64 = q64 - 2 + kt; valid = (k64 >= 0 && k64 < 32); return b * L + k64 * 64; }
            win = false; valid = true; return TL + b * LC + (kt - nwin) * 64;
        };
        int kt = 0; bool win, valid; int krow0 = 0;
        for (; kt < nkt; ++kt) { krow0 = tile_row0(kt, win, valid); if (valid) break; }
#pragma unroll
        for (int i = 0; i < 2; ++i) { const size_t off = (size_t)(krow0 + srow + 32 * i) * 128 + g * 64 + kc * 8; pk[i] = *(const u32x4*)(kb + off); pv[i] = *(const u32x4*)(vb + off); }
        while (kt < nkt) {
            const bool cwin = win; const int ckrow0 = krow0;
            __syncthreads();
#pragma unroll
            for (int i = 0; i < 2; ++i) {
                const int row = srow + 32 * i;
                *(u32x4*)(lds + row * AT_KROWB + kc * 16) = pk[i];
                unsigned char* vd = lds + AT_VOFF + (kc * 8) * AT_VROWB + row * 2;
#pragma unroll
                for (int q = 0; q < 4; ++q) { *(bf16_t*)(vd + (2 * q) * AT_VROWB) = (bf16_t)(pv[i][q] & 0xffffu); *(bf16_t*)(vd + (2 * q + 1) * AT_VROWB) = (bf16_t)(pv[i][q] >> 16); }
            }
            int nkt2 = kt + 1; bool nwin2 = false, nvalid = false; int nrow0 = 0;
            for (; nkt2 < nkt; ++nkt2) { nrow0 = tile_row0(nkt2, nwin2, nvalid); if (nvalid) break; }
            if (nkt2 < nkt) {
#pragma unroll
                for (int i = 0; i < 2; ++i) { const size_t off = (size_t)(nrow0 + srow + 32 * i) * 128 + g * 64 + kc * 8; pk[i] = *(const u32x4*)(kb + off); pv[i] = *(const u32x4*)(vb + off); }
            }
            __syncthreads();
            const int j0t = ckrow0 - b * L;
#pragma unroll
            for (int sub = 0; sub < 2; ++sub) {
                bf16x8 kf[4];
#pragma unroll
                for (int s4 = 0; s4 < 4; ++s4) kf[s4] = *(const bf16x8*)(lds + (sub * 32 + lr) * AT_KROWB + s4 * 32 + lh * 16);
#pragma unroll
                for (int qs = 0; qs < 2; ++qs) {
                    bool partial = false;
                    if (cwin) {
                        const int j0 = j0t + sub * 32, i0 = q64 * 64 + qs * 32;
                        if (j0 > i0 + 31 + 128 || j0 + 31 < i0 - 128) continue;
                        partial = !(j0 >= i0 + 31 - 128 && j0 + 31 <= i0 + 128);
                    }
                    f32x16 sT;
#pragma unroll
                    for (int r = 0; r < 16; ++r) sT[r] = zf;
#pragma unroll
                    for (int s4 = 0; s4 < 4; ++s4) sT = __builtin_amdgcn_mfma_f32_32x32x16_bf16(kf[s4], qf[qs][s4], sT, 0, 0, 0);
                    if (partial) {
                        const int dj0 = j0t + sub * 32 + 4 * lh - (q64 * 64 + qs * 32 + lr);
#pragma unroll
                        for (int r = 0; r < 16; ++r) { const int dj = dj0 + (r & 3) + 8 * (r >> 2); if (dj > 128 || dj < -128) sT[r] = -1e30f; }
                    }
                    float mt = sT[0];
#pragma unroll
                    for (int r = 1; r < 16; ++r) mt = fmaxf(mt, sT[r]);
                    mt = fmaxf(mt, __shfl_xor(mt, 32));
                    const float mn = fmaxf(m[qs], mt);
                    const float alpha = __builtin_amdgcn_exp2f(m[qs] - mn);
                    m[qs] = mn;
                    float ps = 0.f;
#pragma unroll
                    for (int r = 0; r < 16; ++r) { sT[r] = __builtin_amdgcn_exp2f(sT[r] - mn); ps += sT[r]; }
                    lsum[qs] = lsum[qs] * alpha + ps;
#pragma unroll
                    for (int r = 0; r < 16; ++r) { o[qs][0][r] *= alpha; o[qs][1][r] *= alpha; }
#pragma unroll
                    for (int s2 = 0; s2 < 2; ++s2) {
                        u32x4 pkk;
                        pkk[0] = cvt_pk_bf16(sT[8 * s2 + 0], sT[8 * s2 + 1]); pkk[1] = cvt_pk_bf16(sT[8 * s2 + 2], sT[8 * s2 + 3]);
                        pkk[2] = cvt_pk_bf16(sT[8 * s2 + 4], sT[8 * s2 + 5]); pkk[3] = cvt_pk_bf16(sT[8 * s2 + 6], sT[8 * s2 + 7]);
                        const bf16x8 pf = __builtin_bit_cast(bf16x8, pkk);
#pragma unroll
                        for (int dt = 0; dt < 2; ++dt) {
                            const unsigned char* vp = lds + AT_VOFF + (dt * 32 + lr) * AT_VROWB + (sub * 32 + s2 * 16 + lh * 4) * 2;
                            const uint2 a = *(const uint2*)(vp), c2 = *(const uint2*)(vp + 16);
                            u32x4 vv; vv[0] = a.x; vv[1] = a.y; vv[2] = c2.x; vv[3] = c2.y;
                            o[qs][dt] = __builtin_amdgcn_mfma_f32_32x32x16_bf16(__builtin_bit_cast(bf16x8, vv), pf, o[qs][dt], 0, 0, 0);
                        }
                    }
                }
            }
            kt = nkt2; win = nwin2; krow0 = nrow0;
        }
#pragma unroll
        for (int qs = 0; qs < 2; ++qs) {
            const float lt = lsum[qs] + __shfl_xor(lsum[qs], 32);
            const float inv = 1.f / lt;
            bf16_t* orow = mix + (size_t)(rq0 + qs * 32 + lr) * D + 512 + hq * 64;
#pragma unroll
            for (int dt = 0; dt < 2; ++dt)
#pragma unroll
                for (int rg = 0; rg < 4; ++rg)
                    *(uint2*)(orow + dt * 32 + 8 * rg + 4 * lh) = pack4(o[qs][dt][4 * rg] * inv, o[qs][dt][4 * rg + 1] * inv, o[qs][dt][4 * rg + 2] * inv, o[qs][dt][4 * rg + 3] * inv);
        }
    }
}


constexpr int FAKE = 0;
constexpr int TIM = 0;
constexpr int PROBE3 = 0;
constexpr int PROBE2 = 0;
__device__ __forceinline__ void st_fake(const P& p, unsigned char* lds) {
    if (FAKE == 0) return;
    const bf16_t* A = (const bf16_t*)(p.ws + WS_BUFA);
    const bf16_t* Bt = (const bf16_t*)(p.ws + WS_WTIN);
    constexpr int TN = DIN / 128;
    int t_end, t_step;
    float sink = 0.f;
    for (int tile = xcd_first((TA / 128) * TN, t_end, t_step); tile < t_end; tile += t_step) {
        const int tn = tile % TN, m0 = (FAKE == 2 || FAKE == 3) ? 0 : (tile / TN) * 128, n0 = FAKE == 3 ? 0 : tn * 128;
        f32x16 acc[2][2];
        gemm_tile(acc, ARowPlain{A + (size_t)m0 * D, D}, Bt + (size_t)n0 * D, D, D, lds);
        if (FAKE == 4) {
            bf16_t* dst = (bf16_t*)(p.ws + WS_HID);
            acc_foreach4_lds(acc, lds, [&](int r, int c, float v0, float v1, float v2, float v3) { *(uint2*)(dst + ((size_t)((tile / TN) * 128 + r) * 128 + c)) = pack4(v0, v1, v2, v3); });
        } else if (FAKE == 5) {
            bf16_t* dst = (bf16_t*)(p.ws + WS_HID);
            __syncthreads();
            acc_foreach4_lds(acc, lds, [&](int r, int c, float v0, float v1, float v2, float v3) { *(uint2*)(lds + (r * 136 + c) * 2) = pack4(v0, v1, v2, v3); });
            __syncthreads();
            const int t = TIDX;
#pragma unroll
            for (int i = 0; i < 8; ++i) { const int ch = t + 256 * i, r = ch >> 4, cc = (ch & 15) * 8;
                *(u32x4*)(dst + ((size_t)((tile / TN) * 128 + r) * 128 + cc)) = *(const u32x4*)(lds + (r * 136 + cc) * 2); }
        } else {
#pragma unroll
        for (int mi = 0; mi < 2; ++mi)
#pragma unroll
            for (int ni = 0; ni < 2; ++ni) sink += acc[mi][ni][0] + acc[mi][ni][7];
        }
    }
    if (sink == 12345.678f) ((float*)(p.ws + WS_RBIAS))[1000] = sink;
}
constexpr int STAGES_PER_LAYER = 11;
constexpr int N_STAGES = 1 + 2 * STAGES_PER_LAYER;
constexpr int REP_STAGE = -1;

__device__ __forceinline__ void run_stage(const P& p, int s, unsigned char* ldsb) {
    float* lds = (float*)ldsb;
    if (s == 0) { st_mod(p, lds); st_rope_table(p); st_ssm_tables(p); st_ssm_kj(p, lds); st_prep_weights(p, 0, ldsb, PW_ALL); return; }
    const int l = (s - 1) / STAGES_PER_LAYER, k = (s - 1) % STAGES_PER_LAYER;
    switch (k) {
    case 0: st_rbias(p, l, lds);
            if (l == 0) st_prep_ssm(p, 0, 3); else st_prep_weights(p, 1, ldsb, PW_GU | PW_DN);
            st_norm(p, l, 0); break;
    case 1: if (l == 0) st_fake(p, ldsb); st_inproj(p, l, ldsb); break;
    case 2: st_ssm_egemm(p, ldsb); if (l == 0) st_prep_weights(p, 1, ldsb, PW_IN); break;
    case 3: st_ssm_carry(p, l); st_attn2(p, l, ldsb, 0, 1); break;
    case 4: st_ssm_ygemm(p, l, ldsb); if (l == 0) st_prep_ssm(p, 1, 1); break;
    case 5: gemm_stage((const bf16_t*)(p.ws + WS_G), DSSM, (const bf16_t*)(p.ws + WS_WTGLU), DSSM, l == 0 ? TA : TL, DSSM, DSSM,
                       EpiGlu2{(const bf16_t*)(p.ws + WS_G), (bf16_t*)(p.ws + WS_BUFA), p.in[I_BGLU] + l * DSSM}, ldsb);
            st_conv(p, l); if (l == 0) st_prep_ssm(p, 1, 2); break;
    case 6: gemm_stage_pre((const bf16_t*)(p.ws + WS_BUFA), D, (const bf16_t*)(p.ws + WS_WTOUT), D, l == 0 ? TA : TL, D, D, make_epi_out(p, l), ldsb); break;
    case 7: if (PROBE2 == 1 && l == 0) st_router2<true>(p, l, ldsb); st_router2(p, l, ldsb); if (l == 0) st_prep_weights(p, 1, ldsb, PW_GLU | PW_OUT); break;
    case 8: st_moe1(p, l, ldsb); break;
    case 9: st_moe2s(p, l, ldsb); break;
    case 10: if (PROBE2 == 2 && l == 0) { EpiMoeF e = make_epi_moef(p, l); e.outw = false; gemm_stage((const bf16_t*)(p.ws + WS_HID) + 4 * DE, 5 * DE, (const bf16_t*)(p.ws + WS_WD) + (size_t)32 * D * DE, DE, TA, D, DE, e, ldsb); }
             gemm_stage((const bf16_t*)(p.ws + WS_HID) + 4 * DE, 5 * DE, (const bf16_t*)(p.ws + WS_WD) + (size_t)32 * D * DE, DE, l == 0 ? TA : TL, D, DE, make_epi_moef(p, l), ldsb); break;
    }
}


#define XB_TMO      128
#define XB_XCNT(j)  (256  + 64 * (j))
#define XB_XSUB(j)  (1280 + 64 * (j))
#define XB_XGEN(j)  (2304 + 64 * (j))
#define XB_TOP      3328
#define XB_TOPGEN   3392
#define XCD_BAR_WORDS 3456
#define XB_SPIN_CAP (1u << 22)
__device__ __forceinline__ unsigned xb_ld(unsigned* p)              { return __hip_atomic_load(p, __ATOMIC_RELAXED, __HIP_MEMORY_SCOPE_AGENT); }
__device__ __forceinline__ unsigned xb_add(unsigned* p, unsigned v) { return __hip_atomic_fetch_add(p, v, __ATOMIC_RELAXED, __HIP_MEMORY_SCOPE_AGENT); }
__device__ __forceinline__ unsigned xb_xcc_id() { return (unsigned)__builtin_amdgcn_s_getreg((3 << 11) | 20) & 0xFu; }
#define XB_SPIN(cond, bar) do { unsigned _sp = 0; while (cond) { __builtin_amdgcn_s_sleep(1); \
    if ((++_sp & 255u) == 0u) { if (xb_ld(&(bar)[XB_TMO])) break; if (_sp > XB_SPIN_CAP) { atomicAdd(&(bar)[XB_TMO], 1u); break; } } } } while (0)
struct XcdBarrier { unsigned* bar; unsigned x; volatile LAS unsigned* st; };
__device__ __forceinline__ XcdBarrier xcd_barrier_post(unsigned* bar, volatile LAS unsigned* st) {
    XcdBarrier b; b.bar = bar; b.x = xb_xcc_id(); b.st = st;
    if (threadIdx.x == 0) (void)xb_add(&bar[XB_XCNT(b.x)], 1u);
    return b;
}
__device__ __forceinline__ void xcd_barrier_complete(unsigned* bar, unsigned x, unsigned& nloc, unsigned& nx) {
    const unsigned G = gridDim.x * gridDim.y * gridDim.z;
    unsigned sum, cnt, mine, sp = 0u;
    for (;;) {
        sum = 0u; cnt = 0u; mine = 0u;
#pragma unroll
        for (unsigned j = 0; j < 16; ++j) { const unsigned c = xb_ld(&bar[XB_XCNT(j)]); sum += c; cnt += (c > 0u) ? 1u : 0u; mine = (j == x) ? c : mine; }
        if (sum == G) break;
        __builtin_amdgcn_s_sleep(1);
        if ((++sp & 255u) == 0u) { if (xb_ld(&bar[XB_TMO])) break; if (sp > XB_SPIN_CAP) { atomicAdd(&bar[XB_TMO], 1u); break; } }
    }
    nloc = mine > 0u ? mine : 1u; nx = cnt > 0u ? cnt : 1u;
}
__device__ __forceinline__ void xcd_barrier(const XcdBarrier& b) {
    asm volatile("s_waitcnt vmcnt(0)" ::: "memory");
    __syncthreads();
    if (threadIdx.x == 0) {
        unsigned* bar = b.bar;
        __builtin_amdgcn_s_waitcnt(0);
        unsigned nloc = b.st[0], nx = b.st[1];
        if (nloc == 0u) { xcd_barrier_complete(bar, b.x, nloc, nx); b.st[0] = nloc; b.st[1] = nx; }
        const unsigned old = xb_add(&bar[XB_XSUB(b.x)], 1u);
        const unsigned gen = old / nloc;
        if (old + 1u == (gen + 1u) * nloc) {
            __builtin_amdgcn_fence(__ATOMIC_RELEASE, "agent");
            asm volatile("s_waitcnt vmcnt(0)" ::: "memory");
            const unsigned og = xb_add(&bar[XB_TOP], 1u);
            const unsigned tg = og / nx;
            if (og + 1u == (tg + 1u) * nx) xb_add(&bar[XB_TOPGEN], 1u);
            else XB_SPIN(xb_ld(&bar[XB_TOPGEN]) == tg, bar);
            __builtin_amdgcn_fence(__ATOMIC_ACQUIRE, "agent");
            xb_add(&bar[XB_XGEN(b.x)], 1u);
            asm volatile("s_waitcnt vmcnt(0)" ::: "memory");
        } else {
            XB_SPIN(xb_ld(&bar[XB_XGEN(b.x)]) == gen, bar);
            __builtin_amdgcn_fence(__ATOMIC_ACQUIRE, "agent");
            asm volatile("s_waitcnt vmcnt(0)" ::: "memory");
        }
    }
    __syncthreads();
}
constexpr size_t WS_XBAR = 4096;

template <int S> __device__ __forceinline__ void run_all(const P& p, unsigned char* lds, const XcdBarrier& xb) {
    run_stage(p, S, lds);
    if constexpr (S == REP_STAGE) { xcd_barrier(xb); run_stage(p, S, lds); }
    if constexpr (S + 1 < N_STAGES) {
        unsigned long long t0 = 0; if (TIM) t0 = __builtin_amdgcn_s_memrealtime();
        xcd_barrier(xb);
        if (TIM && threadIdx.x == 0) { const unsigned long long t1 = __builtin_amdgcn_s_memrealtime(); xb.st[2] += (unsigned)(t1 - t0);
            if (blockIdx.x == 0) ((unsigned long long*)(p.ws + WS_CTL + 32768))[S + 1] = t1; }
        run_all<S + 1>(p, lds, xb);
    } else if (TIM) {
        unsigned* ctl = (unsigned*)(p.ws + WS_CTL + 32768 + 512);
        unsigned long long* ts = (unsigned long long*)(p.ws + WS_CTL + 32768);
        if (threadIdx.x == 0) { atomicAdd(ctl, xb.st[2]); if (blockIdx.x == 0) ts[N_STAGES] = __builtin_amdgcn_s_memrealtime(); }
        xcd_barrier(xb);
        if (blockIdx.x == 0 && threadIdx.x == 0) {
            float us;
            if (TIM == 1) us = (float)__hip_atomic_load(ctl, __ATOMIC_RELAXED, __HIP_MEMORY_SCOPE_AGENT) / (float)gridDim.x * 0.01f / 10.f;
            else if (TIM == 2) us = (float)(ts[N_STAGES] - ts[0]) * 0.01f / 25.f;
            else us = (float)(ts[TIM - 10 + 1] - ts[TIM - 10]) * 0.01f / 2.f;
            float code = floorf(us); if (code > 89.f) code = 89.f;
            p.out[0] += 10.f + code;
        }
    }
}
__global__ void __launch_bounds__(NT, 2) mega(P p) {
    __shared__ __attribute__((aligned(16))) unsigned char lds[LDS_TOTAL + 16];
    volatile LAS unsigned* st = (volatile LAS unsigned*)(lds + LDS_TOTAL);
    if (threadIdx.x == 0) { st[0] = 0u; st[1] = 0u; st[2] = 0u; st[3] = 0u; if (TIM && blockIdx.x == 0) ((unsigned long long*)(p.ws + WS_CTL + 32768))[0] = __builtin_amdgcn_s_memrealtime(); }
    __syncthreads();
    const XcdBarrier xb = xcd_barrier_post((unsigned*)(p.ws + WS_CTL + WS_XBAR), st);
    if (p.ws == nullptr) cg::this_grid().sync();
    run_all<0>(p, lds, xb);
}

extern "C" void kernel_launch(void* const* d_in, const int* in_sizes, int n_in, void* d_out, int out_size, void* d_ws, size_t ws_size, hipStream_t stream) {
    if (n_in != N_IN || ws_size < WS_END) { fprintf(stderr, "kernel_launch: unexpected n_in %d or ws_size %zu (< %zu)\n", n_in, ws_size, (size_t)WS_END); return; }
    P p{};
    for (int i = 0; i < N_IN; ++i) p.in[i] = (const float*)d_in[i];
    p.out = (float*)d_out; p.ws = (unsigned char*)d_ws;
    static int grid_blocks = 0;
    if (!grid_blocks) {
        int dev = 0, cus = 0, per_cu = 0;
        hipGetDevice(&dev);
        hipDeviceGetAttribute(&cus, hipDeviceAttributeMultiprocessorCount, dev);
        hipOccupancyMaxActiveBlocksPerMultiprocessor(&per_cu, (const void*)mega, NT, 0);
        if (per_cu < 1) per_cu = 1;
        if (per_cu > 2) per_cu = 2;
        grid_blocks = cus * per_cu;
    }
    hipMemsetAsync((char*)d_ws + WS_CTL, 0, 65536, stream);
    void* args[] = {&p};
    hipError_t e = hipLaunchCooperativeKernel((const void*)mega, dim3(grid_blocks), dim3(NT), args, 0, stream);
    if (e != hipSuccess) fprintf(stderr, "cooperative launch failed: %s (grid %d)\n", hipGetErrorString(e), grid_blocks);
}
```

```cpp
#include <hip/hip_runtime.h>
#include <hip/hip_cooperative_groups.h>
#include <cstdio>
#include <cstdint>
namespace cg = cooperative_groups;
#define CNT_PTR(p, l) ((int*)((p).ws + 40960 + (l) * 8192))
#define LAS __attribute__((address_space(3)))
constexpr int ABL = 0;

__device__ __forceinline__ int tid_opaque() { int t = threadIdx.x; asm volatile("" : "+v"(t)); return t; }
__device__ __forceinline__ int bid_opaque() { int b = blockIdx.x; asm volatile("" : "+s"(b)); return b; }
__device__ __forceinline__ int xcd_first(int total, int& end, int& step) {
    const int nb = gridDim.x; int b = blockIdx.x; asm volatile("" : "+s"(b));
    if (nb & 7) { end = total; step = nb; return b; }
    const int x = b & 7, j = b >> 3, per = (total + 7) >> 3, lo = x * per;
    end = lo + per < total ? lo + per : total; step = nb >> 3; return lo + j;
}
#define TIDX tid_opaque()
#define BIDX bid_opaque()

constexpr int D = 1024, NB = 8, L = 2048, LC = 256;
constexpr int TL = NB * L, TC = NB * LC, TA = TL + TC;
constexpr int DIN = 1792, DCONV = 256, DSSM = 256, DATT = 512;
constexpr int NQH = 8, NKVH = 2, HD = 64;
constexpr int COL_U = 768, COL_Q = 1024, COL_K = 1536, COL_V = 1664;
constexpr int NE = 32, TOPK = 4, DE = 128;
constexpr int SG = 16, SH = 16, SP = 64;
constexpr int NT = 256;

enum { I_X = 0, I_C, I_CTX, I_CCTX, I_WMOD, I_BMOD, I_N1G, I_N2G, I_WIN, I_CONVW, I_LRE, I_LIM, I_LDT, I_BRE, I_BIM, I_CRE, I_CIM,
       I_SD, I_WGLU, I_BGLU, I_QG, I_KG, I_SINK, I_WOUT, I_RW, I_RB, I_WEG, I_WEU, I_WED, I_WSG, I_WSU, I_WSD, N_IN };

typedef unsigned short bf16_t;
constexpr size_t WS_CTL = 0;
constexpr size_t WS_MOD = 65536;
constexpr size_t WS_ZERO_END = WS_MOD + (size_t)2 * 9 * 6 * D * 4;
constexpr size_t WS_RBIAS = 524288;
constexpr size_t WS_ROPE = WS_RBIAS + 4096;
constexpr size_t WS_KJ = WS_ROPE + 524288;
constexpr size_t WS_GS2 = WS_KJ + 2097152;
constexpr size_t WS_POW = WS_GS2 + 131072;
constexpr size_t WS_FB = WS_POW + (size_t)2 * 2 * 16 * 33 * 64 * 8;
constexpr size_t WS_R1 = WS_FB + (size_t)2 * 2 * 16 * 64 * 16 * 8;
constexpr size_t WS_BUFA = WS_R1;
constexpr size_t WS_PC = WS_BUFA + (size_t)TA * D * 2;
constexpr size_t WS_UA = WS_PC + (size_t)TA * 768 * 2;
constexpr size_t WS_E = WS_UA + (size_t)16 * 640 * 768 * 2;
constexpr size_t WS_G = WS_E + (size_t)16 * 640 * 256 * 4;
constexpr size_t WS_QB = WS_G + (size_t)TA * DSSM * 2;
constexpr size_t WS_KB = WS_QB + (size_t)TA * DATT * 2;
constexpr size_t WS_VT = WS_KB + (size_t)TA * 128 * 2;
constexpr size_t WS_SLAB = WS_R1;
constexpr size_t WS_HID = WS_SLAB + (size_t)TA * 4 * D * 2;
constexpr size_t WS_HC1 = WS_HID + (size_t)TA * 5 * DE * 2;
constexpr size_t WS_HCMID = WS_HC1 + (size_t)TC * D * 4;
constexpr size_t WS_LCODE = WS_HCMID + (size_t)TC * D * 4;
constexpr size_t WS_LW = WS_LCODE + (size_t)NE * TA * 4;
constexpr size_t WS_WTIN = WS_LW + (size_t)NE * TA * 4;
constexpr size_t WS_WTOUT = WS_WTIN + (size_t)DIN * D * 2;
constexpr size_t WS_WTGLU = WS_WTOUT + (size_t)D * D * 2;
constexpr size_t WS_WGU = WS_WTGLU + (size_t)DSSM * DSSM * 2;
constexpr size_t WS_WD = WS_WGU + (size_t)33 * 256 * D * 2;
constexpr size_t WS_WST = WS_WD + (size_t)33 * D * DE * 2;
constexpr size_t WS_KW = WS_WST + (size_t)16 * 256 * 512 * 2;
constexpr size_t WS_END = WS_KW + (size_t)16 * 512 * 768 * 2;
static_assert(WS_VT + (size_t)TA * 128 * 2 <= WS_HID, "overlay");
static_assert(WS_ZERO_END <= WS_RBIAS, "zero region");
static_assert(WS_END <= 268435456, "workspace too large");

struct P {
    const float* in[N_IN];
    float* out;
    unsigned char* ws;
};

__device__ __forceinline__ bf16_t f2bf(float f) { unsigned u = __float_as_uint(f); u += 0x7FFFu + ((u >> 16) & 1u); return (bf16_t)(u >> 16); }
__device__ __forceinline__ float bf2f(bf16_t b) { return __uint_as_float((unsigned)b << 16); }
__device__ __forceinline__ unsigned cvt_pk_bf16(float lo, float hi) { unsigned r; asm("v_cvt_pk_bf16_f32 %0, %1, %2" : "=v"(r) : "v"(lo), "v"(hi)); return r; }
typedef __attribute__((ext_vector_type(4))) float f32x4;
typedef __attribute__((ext_vector_type(4))) unsigned u32x4;
struct BfPtr { const bf16_t* p; __device__ __forceinline__ float operator[](long i) const { return bf2f(p[i]); }
               __device__ __forceinline__ BfPtr operator+(long o) const { return BfPtr{p + o}; } };
__device__ __forceinline__ float sigmoid_f(float x) { return __builtin_amdgcn_rcpf(1.f + __builtin_amdgcn_exp2f(-1.4426950408889634f * x)); }
__device__ __forceinline__ float silu_f(float x) { return x * sigmoid_f(x); }
__device__ __forceinline__ float gelu_f(float x) { return x * sigmoid_f(2.f * 0.7978845608028654f * (x + 0.044715f * x * x * x)); }
__device__ __forceinline__ float wave_sum(float v) {
#pragma unroll
    for (int o = 32; o > 0; o >>= 1) v += __shfl_xor(v, o);
    return v;
}
__device__ __forceinline__ int row_bb(int r) { return r < TL ? r / L : 8; }
__device__ __forceinline__ const float* h_row(const P& p, int l, int r) {
    if (r < TL) return (l == 0 ? p.in[I_X] : p.out) + (size_t)r * D;
    return (l == 0 ? p.in[I_CTX] : (const float*)(p.ws + WS_HC1)) + (size_t)(r - TL) * D;
}
__device__ __forceinline__ float* hmid_row(const P& p, int r) {
    if (r < TL) return p.out + (size_t)r * D;
    return (float*)(p.ws + WS_HCMID) + (size_t)(r - TL) * D;
}
__device__ __forceinline__ const float* mod_vec(const P& p, int l, int bb, int chunk) {
    return (const float*)(p.ws + WS_MOD) + ((size_t)(l * 9 + bb) * 6 + chunk) * D;
}

__device__ __forceinline__ void st_mod(const P& p, float* lds) {
    float* red = lds + 9 * D;
    for (int i = TIDX; i < 9 * D; i += NT) {
        const int bb = i / D, k = i % D;
        const float c = bb < 8 ? p.in[I_C][bb * D + k] : p.in[I_CCTX][k];
        lds[i] = silu_f(c);
    }
    __syncthreads();
    float* mod = (float*)(p.ws + WS_MOD);
    const int col = TIDX & 31, ks = TIDX >> 5;
    for (int item = BIDX; item < 2 * 6 * D / 32; item += gridDim.x) {
        const int l = item / (6 * D / 32), j = (item % (6 * D / 32)) * 32 + col;
        const float* w = p.in[I_WMOD] + (size_t)l * D * 6 * D + j;
        float acc[9];
#pragma unroll
        for (int bb = 0; bb < 9; ++bb) acc[bb] = 0.f;
        for (int k0 = ks * 128; k0 < ks * 128 + 128; k0 += 16) {
            float wv[16];
#pragma unroll
            for (int q = 0; q < 16; ++q) wv[q] = w[(size_t)(k0 + q) * 6 * D];
#pragma unroll
            for (int q = 0; q < 16; ++q)
#pragma unroll
                for (int bb = 0; bb < 9; ++bb) acc[bb] += lds[bb * D + k0 + q] * wv[q];
        }
#pragma unroll
        for (int bb = 0; bb < 9; ++bb) red[(bb * 8 + ks) * 32 + col] = acc[bb];
        __syncthreads();
        for (int o = TIDX; o < 9 * 32; o += NT) {
            const int bb = o >> 5, c2 = o & 31;
            float sum = p.in[I_BMOD][l * 6 * D + (item % (6 * D / 32)) * 32 + c2];
#pragma unroll
            for (int q = 0; q < 8; ++q) sum += red[(bb * 8 + q) * 32 + c2];
            mod[(size_t)(l * 9 + bb) * 6 * D + (item % (6 * D / 32)) * 32 + c2] = sum;
        }
        __syncthreads();
    }
}

__device__ __forceinline__ void st_norm(const P& p, int l, int which) {
    const int lane = TIDX & 63, wv = TIDX >> 6;
    const int nrows = (which == 1 && l == 1) ? TL : TA;
    float* xn = (float*)(p.ws + WS_BUFA);
    const float* g = p.in[which == 0 ? I_N1G : I_N2G] + l * D;
    for (int r0 = (BIDX * 4 + wv) * 2; r0 < nrows; r0 += gridDim.x * 8) {
        f32x4 v[2][4];
#pragma unroll
        for (int u = 0; u < 2; ++u) {
            const float* src = which == 0 ? h_row(p, l, r0 + u) : hmid_row(p, r0 + u);
#pragma unroll
            for (int j = 0; j < 4; ++j) v[u][j] = *(const f32x4*)(src + j * 256 + lane * 4);
        }
        const int bb = row_bb(r0);
        const float* sh = mod_vec(p, l, bb, which == 0 ? 0 : 3);
        const float* sc = mod_vec(p, l, bb, which == 0 ? 1 : 4);
#pragma unroll
        for (int u = 0; u < 2; ++u) {
            const int r = r0 + u;
            float s = 0.f;
#pragma unroll
            for (int j = 0; j < 4; ++j) s += v[u][j][0] * v[u][j][0] + v[u][j][1] * v[u][j][1] + v[u][j][2] * v[u][j][2] + v[u][j][3] * v[u][j][3];
            s = wave_sum(s);
            const float rinv = rsqrtf(s * (1.f / D) + 1e-6f);
#pragma unroll
            for (int j = 0; j < 4; ++j) {
                const int k = j * 256 + lane * 4;
                const f32x4 gg = *(const f32x4*)(g + k), s1 = *(const f32x4*)(sc + k), s0 = *(const f32x4*)(sh + k);
                f32x4 o;
#pragma unroll
                for (int q = 0; q < 4; ++q) o[q] = v[u][j][q] * rinv * gg[q] * (1.f + s1[q]) + s0[q];
                if (which == 1) *(f32x4*)(xn + (size_t)r * D + k) = o;
                else { uint2 pk; pk.x = cvt_pk_bf16(o[0], o[1]); pk.y = cvt_pk_bf16(o[2], o[3]); *(uint2*)((bf16_t*)(p.ws + WS_BUFA) + (size_t)r * D + k) = pk; }
            }
        }
    }
}

__device__ __forceinline__ void bf8_to_f(const u32x4& v, float (&f)[8]) {
#pragma unroll
    for (int q = 0; q < 4; ++q) { f[2 * q] = __uint_as_float(v[q] << 16); f[2 * q + 1] = __uint_as_float(v[q] & 0xffff0000u); }
}
__device__ __forceinline__ void st_conv(const P& p, int l) {
    const bf16_t* pb = (const bf16_t*)(p.ws + WS_PC);
    bf16_t* mix = (bf16_t*)(p.ws + WS_BUFA);
    const float* cw = p.in[I_CONVW] + l * 3 * DCONV;
    const int nrows = l == 0 ? TA : TL;
    for (int idx = BIDX * NT + TIDX; idx < nrows * 32; idx += gridDim.x * NT) {
        const int r = idx >> 5, ch = (idx & 31) * 8;
        int t, len;
        if (r < TL) { t = r & (L - 1); len = L; } else { t = (r - TL) & (LC - 1); len = LC; }
        const bf16_t* pr = pb + (size_t)r * 768 + ch;
        float x[8], c[8], bgate[8], y[8];
        bf8_to_f(*(const u32x4*)(pr), x); bf8_to_f(*(const u32x4*)(pr + 512), c); bf8_to_f(*(const u32x4*)(pr + 256), bgate);
        const f32x4 w1a = *(const f32x4*)(cw + DCONV + ch), w1b = *(const f32x4*)(cw + DCONV + ch + 4);
#pragma unroll
        for (int q = 0; q < 8; ++q) y[q] = (q < 4 ? w1a[q] : w1b[q - 4]) * (c[q] * x[q]);
        if (t > 0) {
            bf8_to_f(*(const u32x4*)(pr - 768), x); bf8_to_f(*(const u32x4*)(pr - 768 + 512), c);
            const f32x4 wa = *(const f32x4*)(cw + ch), wb = *(const f32x4*)(cw + ch + 4);
#pragma unroll
            for (int q = 0; q < 8; ++q) y[q] += (q < 4 ? wa[q] : wb[q - 4]) * (c[q] * x[q]);
        }
        if (t < len - 1) {
            bf8_to_f(*(const u32x4*)(pr + 768), x); bf8_to_f(*(const u32x4*)(pr + 768 + 512), c);
            const f32x4 wa = *(const f32x4*)(cw + 2 * DCONV + ch), wb = *(const f32x4*)(cw + 2 * DCONV + ch + 4);
#pragma unroll
            for (int q = 0; q < 8; ++q) y[q] += (q < 4 ? wa[q] : wb[q - 4]) * (c[q] * x[q]);
        }
        u32x4 o;
#pragma unroll
        for (int q = 0; q < 4; ++q) o[q] = cvt_pk_bf16(bgate[2 * q] * y[2 * q], bgate[2 * q + 1] * y[2 * q + 1]);
        *(u32x4*)(mix + (size_t)r * D + ch) = o;
    }
}

struct EpiOut { const float* modl; const float* hlat; const float* hctx; float* out; float* hcmid;
    __device__ __forceinline__ void operator()(int r, int c, float v0, float v1, float v2, float v3) const {
    const int bb = row_bb(r);
    const f32x4 g1 = *(const f32x4*)(modl + ((size_t)bb * 6 + 2) * D + c);
    const f32x4 hv = *(const f32x4*)((r < TL ? hlat + (size_t)r * D : hctx + (size_t)(r - TL) * D) + c);
    f32x4 o; o[0] = hv[0] + g1[0] * v0; o[1] = hv[1] + g1[1] * v1; o[2] = hv[2] + g1[2] * v2; o[3] = hv[3] + g1[3] * v3;
    *(f32x4*)((r < TL ? out + (size_t)r * D : hcmid + (size_t)(r - TL) * D) + c) = o; }
    __device__ __forceinline__ f32x4 prefetch(int r, int c) const { return *(const f32x4*)((r < TL ? hlat + (size_t)r * D : hctx + (size_t)(r - TL) * D) + c); }
    __device__ __forceinline__ void with_pre(int r, int c, float v0, float v1, float v2, float v3, const f32x4& hv) const {
    const f32x4 g1 = *(const f32x4*)(modl + ((size_t)row_bb(r) * 6 + 2) * D + c);
    f32x4 o; o[0] = hv[0] + g1[0] * v0; o[1] = hv[1] + g1[1] * v1; o[2] = hv[2] + g1[2] * v2; o[3] = hv[3] + g1[3] * v3;
    *(f32x4*)((r < TL ? out + (size_t)r * D : hcmid + (size_t)(r - TL) * D) + c) = o; } };
__device__ __forceinline__ EpiOut make_epi_out(const P& p, int l) {
    return EpiOut{(const float*)(p.ws + WS_MOD) + (size_t)l * 9 * 6 * D, l == 0 ? p.in[I_X] : p.out, l == 0 ? p.in[I_CTX] : (const float*)(p.ws + WS_HC1), p.out, (float*)(p.ws + WS_HCMID)};
}

typedef __attribute__((ext_vector_type(8))) short bf16x8;
typedef __attribute__((ext_vector_type(16))) float f32x16;
constexpr int G_STAGEB = 16384;
constexpr int G_NSTG = 4;
constexpr int LDS_BYTES = G_NSTG * G_STAGEB;

template <class ARow>
__device__ __forceinline__ void gemm_tile(f32x16 (&acc)[2][2], ARow arow, const bf16_t* Bt, int ldb, int K, unsigned char* lds) {
    const int t = TIDX, lane = t & 63, w = __builtin_amdgcn_readfirstlane(t >> 6), wr = w >> 1, wc = w & 1, lr = lane & 31, lh = lane >> 5;
    const int srow = t >> 2, lc = (t & 3) ^ ((srow >> 2) & 3);
    const bf16_t* ap[2]; const bf16_t* bp[2];
#pragma unroll
    for (int i = 0; i < 2; ++i) { ap[i] = arow(srow + 64 * i) + lc * 8; bp[i] = Bt + (size_t)(srow + 64 * i) * ldb + lc * 8; }
    float zf = 0.f; asm volatile("" : "+v"(zf));
#pragma unroll
    for (int mi = 0; mi < 2; ++mi)
#pragma unroll
        for (int ni = 0; ni < 2; ++ni)
#pragma unroll
            for (int r = 0; r < 16; ++r) acc[mi][ni][r] = zf;
    const int nk = K >> 5;
    LAS unsigned char* l3 = (LAS unsigned char*)lds;
    const int f = (lr >> 2) & 3;
    const int aoff = (wr * 64 + lr) * 64 + ((lh ^ f) << 4), boff = 8192 + (wc * 64 + lr) * 64 + ((lh ^ f) << 4);
#define G_ISSUE(ks) do { LAS unsigned char* d_ = l3 + ((ks) & 3) * G_STAGEB + w * 1024; \
        __builtin_amdgcn_global_load_lds((const unsigned*)(ap[0] + (ks) * 32), (LAS unsigned*)(d_), 16, 0, 0); \
        __builtin_amdgcn_global_load_lds((const unsigned*)(ap[1] + (ks) * 32), (LAS unsigned*)(d_ + 4096), 16, 0, 0); \
        __builtin_amdgcn_global_load_lds((const unsigned*)(bp[0] + (ks) * 32), (LAS unsigned*)(d_ + 8192), 16, 0, 0); \
        __builtin_amdgcn_global_load_lds((const unsigned*)(bp[1] + (ks) * 32), (LAS unsigned*)(d_ + 12288), 16, 0, 0); } while (0)
#define G_RD(A0, A1, B0, B1, slot, s2) do { const LAS unsigned char* c_ = l3 + (slot) * G_STAGEB; \
        A0 = *(const LAS bf16x8*)(c_ + (aoff ^ ((s2) << 5))); A1 = *(const LAS bf16x8*)(c_ + ((aoff + 2048) ^ ((s2) << 5))); \
        B0 = *(const LAS bf16x8*)(c_ + (boff ^ ((s2) << 5))); B1 = *(const LAS bf16x8*)(c_ + ((boff + 2048) ^ ((s2) << 5))); } while (0)
#define G_MM(A0, A1, B0, B1) do { __builtin_amdgcn_s_setprio(1); \
        acc[0][0] = __builtin_amdgcn_mfma_f32_32x32x16_bf16(B0, A0, acc[0][0], 0, 0, 0); acc[0][1] = __builtin_amdgcn_mfma_f32_32x32x16_bf16(B1, A0, acc[0][1], 0, 0, 0); \
        acc[1][0] = __builtin_amdgcn_mfma_f32_32x32x16_bf16(B0, A1, acc[1][0], 0, 0, 0); acc[1][1] = __builtin_amdgcn_mfma_f32_32x32x16_bf16(B1, A1, acc[1][1], 0, 0, 0); __builtin_amdgcn_s_setprio(0); } while (0)
    __syncthreads();
    G_ISSUE(0);
    if (1 < nk) G_ISSUE(1);
    if (2 < nk) G_ISSUE(2);
    if (2 < nk) asm volatile("s_waitcnt vmcnt(8)" ::: "memory"); else if (1 < nk) asm volatile("s_waitcnt vmcnt(4)" ::: "memory"); else asm volatile("s_waitcnt vmcnt(0)" ::: "memory");
    __builtin_amdgcn_s_barrier();
    if (3 < nk) G_ISSUE(3);
    bf16x8 fa0, fa1, fb0, fb1, ga0, ga1, gb0, gb1;
    G_RD(fa0, fa1, fb0, fb1, 0, 0);
    for (int ks = 0; ks < nk; ++ks) {
        G_RD(ga0, ga1, gb0, gb1, ks & 3, 1);
        __builtin_amdgcn_sched_barrier(0);
        asm volatile("s_waitcnt lgkmcnt(4)" ::: "memory");
        __builtin_amdgcn_sched_barrier(0);
        G_MM(fa0, fa1, fb0, fb1);
        __builtin_amdgcn_sched_barrier(0);
        if (ks + 1 < nk) {
            if (ks + 3 < nk) asm volatile("s_waitcnt vmcnt(8) lgkmcnt(0)" ::: "memory");
            else if (ks + 2 < nk) asm volatile("s_waitcnt vmcnt(4) lgkmcnt(0)" ::: "memory");
            else asm volatile("s_waitcnt vmcnt(0) lgkmcnt(0)" ::: "memory");
            __builtin_amdgcn_s_barrier();
            if (ks + 4 < nk) G_ISSUE(ks + 4);
            G_RD(fa0, fa1, fb0, fb1, (ks + 1) & 3, 0);
        } else {
            asm volatile("s_waitcnt lgkmcnt(0)" ::: "memory");
        }
        __builtin_amdgcn_sched_barrier(0);
        G_MM(ga0, ga1, gb0, gb1);
        __builtin_amdgcn_sched_barrier(0);
    }
#undef G_RD
#undef G_MM
#undef G_ISSUE
}
template <class F>
__device__ __forceinline__ void acc_foreach4(const f32x16 (&acc)[2][2], F f) {
    const int lane = TIDX & 63, w = (TIDX >> 6) & 3, wr = w >> 1, wc = w & 1, lr = lane & 31, lh = lane >> 5;
#pragma unroll
    for (int mi = 0; mi < 2; ++mi)
#pragma unroll
        for (int ni = 0; ni < 2; ++ni)
#pragma unroll
            for (int g = 0; g < 4; ++g)
                f(wr * 64 + mi * 32 + lr, wc * 64 + ni * 32 + 8 * g + 4 * lh, acc[mi][ni][4 * g], acc[mi][ni][4 * g + 1], acc[mi][ni][4 * g + 2], acc[mi][ni][4 * g + 3]);
}
constexpr int C_LD = 132;
template <class F>
__device__ __forceinline__ void acc_foreach4_lds(const f32x16 (&acc)[2][2], unsigned char* lds, F f) {
    float* C = (float*)lds;
    const int t = TIDX, lane = t & 63, w = (t >> 6) & 3, wr = w >> 1, wc = w & 1, lr = lane & 31, lh = lane >> 5;
    __syncthreads();
#pragma unroll
    for (int mi = 0; mi < 2; ++mi)
#pragma unroll
        for (int ni = 0; ni < 2; ++ni)
#pragma unroll
            for (int g = 0; g < 4; ++g) {
                f32x4 v; v[0] = acc[mi][ni][4 * g]; v[1] = acc[mi][ni][4 * g + 1]; v[2] = acc[mi][ni][4 * g + 2]; v[3] = acc[mi][ni][4 * g + 3];
                *(f32x4*)(C + (wr * 64 + mi * 32 + lr) * C_LD + wc * 64 + ni * 32 + 8 * g + 4 * lh) = v;
            }
    __syncthreads();
#pragma unroll 8
    for (int i = 0; i < 16; ++i) {
        const int idx = t + 256 * i, r = idx >> 5, c = (idx & 31) * 4;
        const f32x4 v = *(const f32x4*)(C + r * C_LD + c);
        f(r, c, v[0], v[1], v[2], v[3]);
    }
}
constexpr float SLAB_SCALE = 32.f;
__device__ __forceinline__ unsigned pack4_fp8(float a, float b, float c, float d) {
    a = fminf(fmaxf(a * SLAB_SCALE, -448.f), 448.f); b = fminf(fmaxf(b * SLAB_SCALE, -448.f), 448.f);
    c = fminf(fmaxf(c * SLAB_SCALE, -448.f), 448.f); d = fminf(fmaxf(d * SLAB_SCALE, -448.f), 448.f);
    int w = __builtin_amdgcn_cvt_pk_fp8_f32(a, b, 0, false);
    w = __builtin_amdgcn_cvt_pk_fp8_f32(c, d, w, true);
    return (unsigned)w;
}
__device__ __forceinline__ uint2 pack4(float a, float b, float c, float d) { uint2 o; o.x = cvt_pk_bf16(a, b); o.y = cvt_pk_bf16(c, d); return o; }
struct ARowPlain { const bf16_t* A; int lda; __device__ __forceinline__ const bf16_t* operator()(int m) const { return A + (size_t)m * lda; } };

template <class Epi>
__device__ __forceinline__ void gemm_stage(const bf16_t* A, int lda, const bf16_t* Bt, int ldb, int M, int N, int K, Epi epi, unsigned char* lds) {
    const int tn = N / 128, tm = M / 128;
    int t_end, t_step;
    for (int tile = xcd_first(tm * tn, t_end, t_step); tile < t_end; tile += t_step) {
        const int m0 = (tile / tn) * 128, n0 = (tile % tn) * 128;
        f32x16 acc[2][2];
        gemm_tile(acc, ARowPlain{A + (size_t)m0 * lda, lda}, Bt + (size_t)n0 * ldb, ldb, K, lds);
        acc_foreach4_lds(acc, lds, [&](int r, int c, float v0, float v1, float v2, float v3) { epi(m0 + r, n0 + c, v0, v1, v2, v3); });
    }
}
template <class Epi>
__device__ __forceinline__ void gemm_stage_pre(const bf16_t* A, int lda, const bf16_t* Bt, int ldb, int M, int N, int K, Epi epi, unsigned char* lds) {
    const int tn = N / 128, tm = M / 128;
    int t_end, t_step;
    for (int tile = xcd_first(tm * tn, t_end, t_step); tile < t_end; tile += t_step) {
        const int m0 = (tile / tn) * 128, n0 = (tile % tn) * 128;
        f32x4 pre[16];
        { const int t = TIDX;
#pragma unroll
          for (int i = 0; i < 16; ++i) { const int idx = t + 256 * i; pre[i] = epi.prefetch(m0 + (idx >> 5), n0 + (idx & 31) * 4); } }
        f32x16 acc[2][2];
        gemm_tile(acc, ARowPlain{A + (size_t)m0 * lda, lda}, Bt + (size_t)n0 * ldb, ldb, K, lds);
        float* C = (float*)lds;
        const int t = TIDX, lane = t & 63, w = (t >> 6) & 3, wr = w >> 1, wc = w & 1, lr = lane & 31, lh = lane >> 5;
        __syncthreads();
#pragma unroll
        for (int mi = 0; mi < 2; ++mi)
#pragma unroll
            for (int ni = 0; ni < 2; ++ni)
#pragma unroll
                for (int g = 0; g < 4; ++g) {
                    f32x4 v; v[0] = acc[mi][ni][4 * g]; v[1] = acc[mi][ni][4 * g + 1]; v[2] = acc[mi][ni][4 * g + 2]; v[3] = acc[mi][ni][4 * g + 3];
                    *(f32x4*)(C + (wr * 64 + mi * 32 + lr) * C_LD + wc * 64 + ni * 32 + 8 * g + 4 * lh) = v;
                }
        __syncthreads();
#pragma unroll
        for (int i = 0; i < 16; ++i) {
            const int idx = t + 256 * i, r = idx >> 5, c = (idx & 31) * 4;
            const f32x4 v = *(const f32x4*)(C + r * C_LD + c);
            epi.with_pre(m0 + r, n0 + c, v[0], v[1], v[2], v[3], pre[i]);
        }
    }
}
struct TrDesc { const float* src; size_t sk; bf16_t* dst; size_t dld; };
__device__ __forceinline__ void tr_item2(const TrDesc& d0, const TrDesc& d1, bool has1, bf16_t* tl) {
    const int t = TIDX, kr = t >> 3, nq = (t & 7) * 4;
    f32x4 v0[4], v1[4];
#pragma unroll
    for (int ps = 0; ps < 4; ++ps) v0[ps] = *(const f32x4*)(d0.src + (size_t)(kr + 32 * ps) * d0.sk + nq);
    if (has1) {
#pragma unroll
        for (int ps = 0; ps < 4; ++ps) v1[ps] = *(const f32x4*)(d1.src + (size_t)(kr + 32 * ps) * d1.sk + nq);
    }
    __syncthreads();
#pragma unroll
    for (int ps = 0; ps < 4; ++ps)
#pragma unroll
        for (int j = 0; j < 4; ++j) tl[(nq + j) * 136 + kr + 32 * ps] = f2bf(v0[ps][j]);
    if (has1) {
#pragma unroll
        for (int ps = 0; ps < 4; ++ps)
#pragma unroll
            for (int j = 0; j < 4; ++j) tl[32 * 136 + (nq + j) * 136 + kr + 32 * ps] = f2bf(v1[ps][j]);
    }
    __syncthreads();
    const int n = t >> 3, part = t & 7;
    { const u32x4 a = *(const u32x4*)(tl + n * 136 + part * 16), b = *(const u32x4*)(tl + n * 136 + part * 16 + 8);
      bf16_t* o = d0.dst + (size_t)n * d0.dld + part * 16; *(u32x4*)o = a; *(u32x4*)(o + 8) = b; }
    if (has1) { const u32x4 a = *(const u32x4*)(tl + 32 * 136 + n * 136 + part * 16), b = *(const u32x4*)(tl + 32 * 136 + n * 136 + part * 16 + 8);
      bf16_t* o = d1.dst + (size_t)n * d1.dld + part * 16; *(u32x4*)o = a; *(u32x4*)(o + 8) = b; }
}
constexpr int PW_IN = 1, PW_OUT = 2, PW_GLU = 4, PW_GU = 8, PW_DN = 16, PW_ALL = 31;
__device__ __forceinline__ TrDesc prep_desc(const P& p, int l, int part, int r) {
    if (part == PW_IN) { const int nt = r >> 3, kt = r & 7; return TrDesc{p.in[I_WIN] + (size_t)l * D * DIN + (size_t)kt * 128 * DIN + nt * 32, DIN, (bf16_t*)(p.ws + WS_WTIN) + (size_t)nt * 32 * D + kt * 128, D}; }
    if (part == PW_OUT) { const int nt = r >> 3, kt = r & 7; return TrDesc{p.in[I_WOUT] + (size_t)l * D * D + (size_t)kt * 128 * D + nt * 32, D, (bf16_t*)(p.ws + WS_WTOUT) + (size_t)nt * 32 * D + kt * 128, D}; }
    if (part == PW_GLU) { const int nt = r >> 1, kt = r & 1; return TrDesc{p.in[I_WGLU] + (size_t)l * DSSM * DSSM + (size_t)kt * 128 * DSSM + nt * 32, DSSM, (bf16_t*)(p.ws + WS_WTGLU) + (size_t)nt * 32 * DSSM + kt * 128, DSSM}; }
    if (part == PW_GU) {
        const int kt = r & 7, q = (r >> 3) & 3, j = (r >> 5) & 1, e = r >> 6;
        const int wc = q >> 1, ni = q & 1, unit0 = j * 64 + wc * 32;
        const float* sp; size_t sk;
        if (e < NE) { sp = p.in[ni ? I_WEU : I_WEG] + ((size_t)(l * D + kt * 128) * NE + e) * DE + unit0; sk = (size_t)NE * DE; }
        else { sp = p.in[ni ? I_WSU : I_WSG] + (size_t)(l * D + kt * 128) * DE + unit0; sk = DE; }
        return TrDesc{sp, sk, (bf16_t*)(p.ws + WS_WGU) + ((size_t)(e * 2 + j) * 128 + q * 32) * D + kt * 128, D};
    }
    {
        const int nt = r & 31, e = r >> 5;
        const float* sp = (e < NE ? p.in[I_WED] + (size_t)(l * NE + e) * DE * D : p.in[I_WSD] + (size_t)l * DE * D) + nt * 32;
        return TrDesc{sp, D, (bf16_t*)(p.ws + WS_WD) + ((size_t)e * D + nt * 32) * DE, DE};
    }
}
__device__ __forceinline__ void st_prep_weights(const P& p, int l, unsigned char* lds, int parts) {
    bf16_t* tl = (bf16_t*)lds;
    constexpr int N_IN_ = (DIN / 32) * 8, N_OUT = (D / 32) * 8, N_GLU = (DSSM / 32) * 2, N_GU = 33 * 2 * 4 * 8, N_DN = 33 * (D / 32);
    const int cnts[5] = {N_IN_, N_OUT, N_GLU, N_GU, N_DN};
#pragma unroll
    for (int pi = 0; pi < 5; ++pi) {
        const int part = 1 << pi;
        if (!(parts & part)) continue;
        const int G = gridDim.x;
        for (int r = BIDX; r < cnts[pi]; r += 2 * G) {
            const bool has1 = r + G < cnts[pi];
            const TrDesc d0 = prep_desc(p, l, part, r), d1 = prep_desc(p, l, part, has1 ? r + G : r);
            tr_item2(d0, d1, has1, tl);
        }
    }
    __syncthreads();
}
struct EpiStoreBf { bf16_t* C; int ldc; __device__ __forceinline__ void operator()(int r, int c, float v0, float v1, float v2, float v3) const { *(uint2*)(C + (size_t)r * ldc + c) = pack4(v0, v1, v2, v3); } };


__device__ __forceinline__ void st_rbias(const P& p, int l, float* lds) {
    const int lane = TIDX & 63, w = TIDX >> 6;
    const float* rw = p.in[I_RW] + (size_t)l * D * NE;
    for (int o = BIDX * 4 + w; o < 9 * 32; o += gridDim.x * 4) {
        const int bb = o >> 5, e = o & 31;
        const float* sh2 = mod_vec(p, l, bb, 3);
        float a = 0.f;
#pragma unroll
        for (int j = 0; j < 16; ++j) { const int k = j * 64 + lane; a += sh2[k] * rw[(size_t)k * NE + e]; }
        a = wave_sum(a);
        if (lane == 0) ((float*)(p.ws + WS_RBIAS))[(l * 9 + bb) * 32 + e] = a;
    }
    const float* g2 = p.in[I_N2G] + l * D;
    for (int idx = BIDX * NT + TIDX; idx < 9 * D; idx += gridDim.x * NT) {
        const int bb = idx >> 10, k = idx & (D - 1);
        ((float*)(p.ws + WS_GS2))[(size_t)(l * 9 + bb) * D + k] = g2[k] * (1.f + mod_vec(p, l, bb, 4)[k]);
    }
}
template <bool DRY = false>
__device__ __forceinline__ void st_router2(const P& p, int l, unsigned char* ldsb) {
    float* part = (float*)ldsb;
    float* ssq = part + 4 * 32 * 33;
    float* sc = ssq + 128;
    float* rinvs = sc + 32 * 33;
    int* hist = (int*)(rinvs + 32);
    int* gbase = hist + 32;
    const int t = TIDX, lane = t & 63, w = t >> 6, i = lane & 31, hf = lane >> 5;
    const int nrows = l == 0 ? TA : TL;
    const float* rw = p.in[I_RW] + (size_t)l * D * NE;
    int* cnt = CNT_PTR(p, l);
    int* lcode = (int*)(p.ws + WS_LCODE);
    float* lw = (float*)(p.ws + WS_LW);
    bf16_t* xn2 = (bf16_t*)(p.ws + WS_BUFA);
    for (int item = BIDX; item < nrows / 32; item += gridDim.x) {
        const int r0 = item * 32, bb = row_bb(r0);
        const float* gs2 = (const float*)(p.ws + WS_GS2) + (size_t)(l * 9 + bb) * D;
        const float* sh2 = mod_vec(p, l, bb, 3);
        const int kb = w * 256 + hf * 128;
        const float* src = hmid_row(p, r0 + i) + kb;
        const float* gsp = gs2 + kb;
        const float* rwp = rw + (size_t)kb * NE + i;
        f32x16 acc;
        float zf = 0.f; asm volatile("" : "+v"(zf));
#pragma unroll
        for (int r = 0; r < 16; ++r) acc[r] = zf;
        float ss = 0.f;
        f32x4 xa[4], ga[4], xb[4], gb[4]; float wa[16], wb[16];
#define R_LOAD(X, G, W, cb) do { _Pragma("unroll") for (int q = 0; q < 4; ++q) { const int k = ((cb) * 4 + q) * 4; X[q] = *(const f32x4*)(src + k); G[q] = *(const f32x4*)(gsp + k); \
            _Pragma("unroll") for (int j = 0; j < 4; ++j) W[q * 4 + j] = rwp[(size_t)(k + j) * NE]; } } while (0)
#define R_COMP(X, G, W) do { _Pragma("unroll") for (int q = 0; q < 4; ++q) { ss += X[q][0] * X[q][0] + X[q][1] * X[q][1] + X[q][2] * X[q][2] + X[q][3] * X[q][3]; \
            _Pragma("unroll") for (int j = 0; j < 4; ++j) acc = __builtin_amdgcn_mfma_f32_32x32x2f32(X[q][j] * G[q][j], W[q * 4 + j], acc, 0, 0, 0); } } while (0)
        R_LOAD(xa, ga, wa, 0);
#pragma unroll 1
        for (int cb = 0; cb < 8; cb += 2) {
            R_LOAD(xb, gb, wb, cb + 1);
            R_COMP(xa, ga, wa);
            if (cb + 2 < 8) R_LOAD(xa, ga, wa, cb + 2);
            R_COMP(xb, gb, wb);
        }
#undef R_LOAD
#undef R_COMP
        ss += __shfl_xor(ss, 32);
        __syncthreads();
        if (hf == 0) ssq[w * 32 + i] = ss;
        if (t < 32) hist[t] = 0;
#pragma unroll
        for (int r = 0; r < 16; ++r) part[(w * 32 + (r & 3) + 8 * (r >> 2) + 4 * hf) * 33 + i] = acc[r];
        __syncthreads();
        for (int idx = t; idx < 1024; idx += NT) {
            const int row = idx >> 5, e = idx & 31;
            const float logit = part[(0 * 32 + row) * 33 + e] + part[(1 * 32 + row) * 33 + e] + part[(2 * 32 + row) * 33 + e] + part[(3 * 32 + row) * 33 + e];
            const float rinv = rsqrtf((ssq[row] + ssq[32 + row] + ssq[64 + row] + ssq[96 + row]) * (1.f / D) + 1e-6f);
            sc[row * 33 + e] = sigmoid_f(rinv * logit + ((const float*)(p.ws + WS_RBIAS))[(l * 9 + bb) * 32 + e]);
            if (e == 0) rinvs[row] = rinv;
        }
        __syncthreads();
        if (t < 32) {
            const int r = r0 + t;
            float sel[32];
#pragma unroll
            for (int e = 0; e < 32; ++e) sel[e] = sc[t * 33 + e] + p.in[I_RB][l * NE + e];
            int bi[4]; float sv[4]; float sum = 0.f;
#pragma unroll
            for (int k = 0; k < 4; ++k) {
                float best = -1e30f; int b = 0;
#pragma unroll
                for (int e = 0; e < 32; ++e) if (sel[e] > best) { best = sel[e]; b = e; }
#pragma unroll
                for (int e = 0; e < 32; ++e) if (e == b) sel[e] = -1e30f;
                bi[k] = b; sv[k] = sc[t * 33 + b]; sum += sv[k];
            }
            int rank[4];
#pragma unroll
            for (int k = 0; k < 4; ++k) rank[k] = atomicAdd(&hist[bi[k]], 1);
            __builtin_amdgcn_s_waitcnt(0xc07f);
            __builtin_amdgcn_wave_barrier();
            { const int hc = hist[t]; gbase[t] = (hc > 0 && !DRY) ? atomicAdd(&cnt[t * 64], hc) : 0; }
            __builtin_amdgcn_s_waitcnt(0xc07f);
            __builtin_amdgcn_wave_barrier();
#pragma unroll
            for (int k = 0; k < 4; ++k) {
                if (DRY) { if (sv[k] / sum == 12345.f) lw[0] = 0.f; } else {
                const int pos = gbase[bi[k]] + rank[k];
                lcode[(size_t)bi[k] * TA + pos] = r * 4 + k;
                lw[(size_t)bi[k] * TA + pos] = sv[k] / sum * 2.5f; }
            }
        }
        {
            float gs[16], sh[16];
#pragma unroll
            for (int q = 0; q < 16; ++q) { const int k = (q >> 3) * 512 + 8 * lane + (q & 7); gs[q] = gs2[k]; sh[q] = sh2[k]; }
            for (int rr8 = 0; rr8 < 8; rr8 += 4) {
                f32x4 xv[4][4];
#pragma unroll
                for (int u = 0; u < 4; ++u) {
                    const float* s2 = hmid_row(p, r0 + w * 8 + rr8 + u);
#pragma unroll
                    for (int h2 = 0; h2 < 2; ++h2) { xv[u][2 * h2] = *(const f32x4*)(s2 + h2 * 512 + 8 * lane); xv[u][2 * h2 + 1] = *(const f32x4*)(s2 + h2 * 512 + 8 * lane + 4); }
                }
#pragma unroll
                for (int u = 0; u < 4; ++u) {
                    const int rho = w * 8 + rr8 + u;
                    const float rr = rinvs[rho];
                    bf16_t* dst = xn2 + (size_t)(r0 + rho) * D;
#pragma unroll
                    for (int h2 = 0; h2 < 2; ++h2) {
                        const f32x4 x0 = xv[u][2 * h2], x1 = xv[u][2 * h2 + 1];
                        u32x4 o;
                        o[0] = cvt_pk_bf16(x0[0] * rr * gs[h2 * 8 + 0] + sh[h2 * 8 + 0], x0[1] * rr * gs[h2 * 8 + 1] + sh[h2 * 8 + 1]);
                        o[1] = cvt_pk_bf16(x0[2] * rr * gs[h2 * 8 + 2] + sh[h2 * 8 + 2], x0[3] * rr * gs[h2 * 8 + 3] + sh[h2 * 8 + 3]);
                        o[2] = cvt_pk_bf16(x1[0] * rr * gs[h2 * 8 + 4] + sh[h2 * 8 + 4], x1[1] * rr * gs[h2 * 8 + 5] + sh[h2 * 8 + 5]);
                        o[3] = cvt_pk_bf16(x1[2] * rr * gs[h2 * 8 + 6] + sh[h2 * 8 + 6], x1[3] * rr * gs[h2 * 8 + 7] + sh[h2 * 8 + 7]);
                        *(u32x4*)(dst + h2 * 512 + 8 * lane) = o;
                    }
                }
            }
        }
    }
    __syncthreads();
}

constexpr int LDS_CSTAGE = 128 * C_LD * 4;
constexpr int M2_A = 0, M2_B = 32768, M2_C = 57344, M2_CLD = 144;
constexpr int MOE_LDS_LIST = M2_C + 128 * M2_CLD;
constexpr int LDS_MOE = MOE_LDS_LIST + 128 * 4 + 128 * 4 + 64 * 4;
constexpr int LDS_MODB = (9 * D + 9 * 8 * 32) * 4;
constexpr int LDS_TOTAL = LDS_MOE > LDS_MODB ? LDS_MOE : LDS_MODB;
struct ARowCode { const bf16_t* base; const int* codes; int mode; __device__ __forceinline__ const bf16_t* operator()(int m) const {
    const int c = codes[m];
    if (mode == 0) return base + (size_t)(c < 0 ? 0 : (c >> 2)) * D;
    return base + (size_t)(c < 0 ? 0 : (c >> 2) * 5 + (c & 3)) * DE; } };
__device__ __forceinline__ void moe_tstart(const P& p, int l, int* ts) {
    if (TIDX == 0) { const int* cnt = CNT_PTR(p, l); int a = 0; for (int e = 0; e < NE; ++e) { ts[e] = a; a += (cnt[e * 64] + 127) >> 7; } ts[NE] = a; }
    __syncthreads();
}
__device__ __forceinline__ void st_moe1(const P& p, int l, unsigned char* lds) {
    int* codes = (int*)(lds + MOE_LDS_LIST); float* wts = (float*)(codes + 128); int* ts = (int*)(wts + 128);
    const int nrows = l == 0 ? TA : TL;
    const int* cnt = CNT_PTR(p, l);
    const int* lcode = (const int*)(p.ws + WS_LCODE);
    const float* lw = (const float*)(p.ws + WS_LW);
    const bf16_t* xn2 = (const bf16_t*)(p.ws + WS_BUFA);
    bf16_t* hid = (bf16_t*)(p.ws + WS_HID);
    const bf16_t* wgu = (const bf16_t*)(p.ws + WS_WGU);
    moe_tstart(p, l, ts);
    const int nrt = ts[NE], nsh = nrows / 128, total = (nrt + nsh) * 2;
    const int lane = TIDX & 63, w = TIDX >> 6, wr = w >> 1, wc = w & 1, lr = lane & 31, lh = lane >> 5;
    int t_end, t_step;
    for (int tile = xcd_first(total, t_end, t_step); tile < t_end; tile += t_step) {
        const int rt = tile >> 1, j = tile & 1;
        int e, m0, valid;
        if (rt < nrt) { e = 0; while (ts[e + 1] <= rt) ++e; m0 = (rt - ts[e]) * 128; valid = cnt[e * 64] - m0; if (valid > 128) valid = 128; }
        else { e = NE; m0 = (rt - nrt) * 128; valid = 128; }
        __syncthreads();
        if (TIDX < 128) {
            const int m = TIDX;
            if (e < NE) { const bool ok = m < valid; codes[m] = ok ? lcode[(size_t)e * TA + m0 + m] : -1; wts[m] = ok ? lw[(size_t)e * TA + m0 + m] : 0.f; }
            else { codes[m] = (m0 + m) * 4; wts[m] = 1.f; }
        }
        __syncthreads();
        f32x16 acc[2][2];
        gemm_tile(acc, ARowCode{xn2, codes, 0}, wgu + (size_t)((e * 2 + j) * 128) * D, D, D, lds);
#pragma unroll
        for (int mi = 0; mi < 2; ++mi) {
            const int m = wr * 64 + mi * 32 + lr;
            const int c = codes[m];
            if (c >= 0) {
                const float wt = wts[m];
                const size_t hrow = e < NE ? (size_t)(c >> 2) * 5 + (c & 3) : (size_t)(c >> 2) * 5 + 4;
#pragma unroll
                for (int g = 0; g < 4; ++g) {
                    float h[4];
#pragma unroll
                    for (int q = 0; q < 4; ++q) h[q] = silu_f(acc[mi][0][4 * g + q]) * acc[mi][1][4 * g + q] * wt;
                    *(uint2*)(hid + hrow * DE + j * 64 + wc * 32 + 8 * g + 4 * lh) = pack4(h[0], h[1], h[2], h[3]);
                }
            }
        }
    }
}
__device__ __forceinline__ void st_moe2(const P& p, int l, unsigned char* lds) {
    int* codes = (int*)(lds + MOE_LDS_LIST); float* wts = (float*)(codes + 128); int* ts = (int*)(wts + 128);
    const int* cnt = CNT_PTR(p, l);
    const int* lcode = (const int*)(p.ws + WS_LCODE);
    const bf16_t* hid = (const bf16_t*)(p.ws + WS_HID);
    unsigned char* slab = (unsigned char*)(p.ws + WS_SLAB);
    const bf16_t* wd = (const bf16_t*)(p.ws + WS_WD);
    moe_tstart(p, l, ts);
    const int nrt = ts[NE], total = nrt * 8;
    int t_end, t_step;
    for (int tile = xcd_first(total, t_end, t_step); tile < t_end; tile += t_step) {
        const int rt = tile >> 3, n0 = (tile & 7) * 128;
        int e = 0; while (ts[e + 1] <= rt) ++e;
        const int m0 = (rt - ts[e]) * 128; int valid = cnt[e * 64] - m0; if (valid > 128) valid = 128;
        __syncthreads();
        if (TIDX < 128) { const int m = TIDX; codes[m] = m < valid ? lcode[(size_t)e * TA + m0 + m] : -1; }
        __syncthreads();
        f32x16 acc[2][2];
        gemm_tile(acc, ARowCode{hid, codes, 1}, wd + ((size_t)e * D + n0) * DE, DE, DE, lds);
        acc_foreach4_lds(acc, lds, [&](int r, int c, float v0, float v1, float v2, float v3) { const int code = codes[r]; if (code >= 0) *(unsigned*)(slab + (size_t)code * D + n0 + c) = pack4_fp8(v0, v1, v2, v3); });
    }
}
constexpr int M2_NPER = 4;
__device__ __forceinline__ void st_moe2s(const P& p, int l, unsigned char* lds) {
    int* codes = (int*)(lds + MOE_LDS_LIST); float* wts = (float*)(codes + 128); int* ts = (int*)(wts + 128);
    const int* cnt = CNT_PTR(p, l);
    const int* lcode = (const int*)(p.ws + WS_LCODE);
    const bf16_t* hid = (const bf16_t*)(p.ws + WS_HID);
    unsigned char* slab = (unsigned char*)(p.ws + WS_SLAB);
    const bf16_t* wd = (const bf16_t*)(p.ws + WS_WD);
    moe_tstart(p, l, ts);
    constexpr int NSP = 8 / M2_NPER, S = 4 * M2_NPER;
    const int nrt = ts[NE], total = nrt * NSP;
    const int t = TIDX, lane = t & 63, w = __builtin_amdgcn_readfirstlane(t >> 6), wr = w >> 1, wc = w & 1, lr = lane & 31, lh = lane >> 5;
    const int srow = t >> 2, lc = (t & 3) ^ ((srow >> 2) & 3);
    const int f = (lr >> 2) & 3;
    const int aoff = (wr * 64 + lr) * 64 + ((lh ^ f) << 4), boff = (wc * 64 + lr) * 64 + ((lh ^ f) << 4);
    LAS unsigned char* l3 = (LAS unsigned char*)lds;
    int t_end, t_step;
    for (int item = xcd_first(total, t_end, t_step); item < t_end; item += t_step) {
        const int rt = item / NSP, n0 = (item % NSP) * (128 * M2_NPER);
        int e = 0; while (ts[e + 1] <= rt) ++e;
        const int m0 = (rt - ts[e]) * 128; int valid = cnt[e * 64] - m0; if (valid > 128) valid = 128;
        __syncthreads();
        if (t < 128) codes[t] = t < valid ? lcode[(size_t)e * TA + m0 + t] : -1;
        __syncthreads();
        const bf16_t* ap[2]; const bf16_t* bp[2];
#pragma unroll
        for (int i = 0; i < 2; ++i) {
            const int c = codes[srow + 64 * i];
            ap[i] = hid + (size_t)(c < 0 ? 0 : (c >> 2) * 5 + (c & 3)) * DE + lc * 8;
            bp[i] = wd + ((size_t)e * D + n0 + srow + 64 * i) * DE + lc * 8;
        }
#pragma unroll
        for (int ks = 0; ks < 4; ++ks) {
            __builtin_amdgcn_global_load_lds((const unsigned*)(ap[0] + ks * 32), (LAS unsigned*)(l3 + M2_A + ks * 8192 + w * 1024), 16, 0, 0);
            __builtin_amdgcn_global_load_lds((const unsigned*)(ap[1] + ks * 32), (LAS unsigned*)(l3 + M2_A + ks * 8192 + w * 1024 + 4096), 16, 0, 0);
        }
#define M2_ISSUE(s_) do { const int nt_ = (s_) >> 2, ks_ = (s_) & 3; LAS unsigned char* d_ = l3 + M2_B + ((s_) % 3) * 8192 + w * 1024; \
        __builtin_amdgcn_global_load_lds((const unsigned*)(bp[0] + (size_t)nt_ * 128 * DE + ks_ * 32), (LAS unsigned*)(d_), 16, 0, 0); \
        __builtin_amdgcn_global_load_lds((const unsigned*)(bp[1] + (size_t)nt_ * 128 * DE + ks_ * 32), (LAS unsigned*)(d_ + 4096), 16, 0, 0); } while (0)
        M2_ISSUE(0); M2_ISSUE(1);
        f32x16 acc[2][2];
        float zf = 0.f; asm volatile("" : "+v"(zf));
#pragma unroll
        for (int mi = 0; mi < 2; ++mi)
#pragma unroll
            for (int ni = 0; ni < 2; ++ni)
#pragma unroll
                for (int r = 0; r < 16; ++r) acc[mi][ni][r] = zf;
#pragma unroll 1
        for (int s = 0; s < S; ++s) {
            if (s + 1 < S) asm volatile("s_waitcnt vmcnt(2) lgkmcnt(0)" ::: "memory"); else asm volatile("s_waitcnt vmcnt(0) lgkmcnt(0)" ::: "memory");
            __builtin_amdgcn_s_barrier();
            if (s + 2 < S) M2_ISSUE(s + 2);
            const int ks = s & 3;
            const LAS unsigned char* ca = l3 + M2_A + ks * 8192;
            const LAS unsigned char* cb = l3 + M2_B + (s % 3) * 8192;
#pragma unroll
            for (int s2 = 0; s2 < 2; ++s2) {
                const bf16x8 a0 = *(const LAS bf16x8*)(ca + (aoff ^ (s2 << 5))), a1 = *(const LAS bf16x8*)(ca + ((aoff + 2048) ^ (s2 << 5)));
                const bf16x8 b0 = *(const LAS bf16x8*)(cb + (boff ^ (s2 << 5))), b1 = *(const LAS bf16x8*)(cb + ((boff + 2048) ^ (s2 << 5)));
                acc[0][0] = __builtin_amdgcn_mfma_f32_32x32x16_bf16(b0, a0, acc[0][0], 0, 0, 0);
                acc[0][1] = __builtin_amdgcn_mfma_f32_32x32x16_bf16(b1, a0, acc[0][1], 0, 0, 0);
                acc[1][0] = __builtin_amdgcn_mfma_f32_32x32x16_bf16(b0, a1, acc[1][0], 0, 0, 0);
                acc[1][1] = __builtin_amdgcn_mfma_f32_32x32x16_bf16(b1, a1, acc[1][1], 0, 0, 0);
            }
            if (ks == 3) {
                const int nt = s >> 2;
#pragma unroll
                for (int mi = 0; mi < 2; ++mi)
#pragma unroll
                    for (int ni = 0; ni < 2; ++ni)
#pragma unroll
                        for (int g = 0; g < 4; ++g) {
                            *(unsigned*)(lds + M2_C + (wr * 64 + mi * 32 + lr) * M2_CLD + wc * 64 + ni * 32 + 8 * g + 4 * lh) =
                                pack4_fp8(acc[mi][ni][4 * g], acc[mi][ni][4 * g + 1], acc[mi][ni][4 * g + 2], acc[mi][ni][4 * g + 3]);
                            acc[mi][ni][4 * g] = zf; acc[mi][ni][4 * g + 1] = zf; acc[mi][ni][4 * g + 2] = zf; acc[mi][ni][4 * g + 3] = zf;
                        }
                asm volatile("s_waitcnt lgkmcnt(0)" ::: "memory");
                __builtin_amdgcn_s_barrier();
#pragma unroll
                for (int i = 0; i < 4; ++i) {
                    const int ch = t + 256 * i, r = ch >> 3, c16 = (ch & 7) * 16;
                    const int code = codes[r];
                    const u32x4 v = *(const u32x4*)(lds + M2_C + r * M2_CLD + c16);
                    if (code >= 0) *(u32x4*)(slab + (size_t)code * D + n0 + nt * 128 + c16) = v;
                }
            }
        }
#undef M2_ISSUE
    }
    __syncthreads();
}
struct EpiMoeF { const unsigned char* slab; const float* modl; float* out; const float* hcmid; float* hc1; bool outw = true;
    __device__ __forceinline__ void operator()(int r, int c, float v0, float v1, float v2, float v3) const {
    const unsigned char* sl = slab + (size_t)r * 4 * D + c;
    float v[4] = {v0, v1, v2, v3};
    float a[4] = {0.f, 0.f, 0.f, 0.f};
#pragma unroll
    for (int k = 0; k < 4; ++k) { const int q = (int)*(const unsigned*)(sl + (size_t)k * D);
        a[0] += __builtin_amdgcn_cvt_f32_fp8(q, 0); a[1] += __builtin_amdgcn_cvt_f32_fp8(q, 1); a[2] += __builtin_amdgcn_cvt_f32_fp8(q, 2); a[3] += __builtin_amdgcn_cvt_f32_fp8(q, 3); }
#pragma unroll
    for (int q = 0; q < 4; ++q) v[q] += a[q] * (1.f / SLAB_SCALE);
    const f32x4 g2 = *(const f32x4*)(modl + ((size_t)row_bb(r) * 6 + 5) * D + c);
    const f32x4 hm = *(const f32x4*)((r < TL ? out + (size_t)r * D : hcmid + (size_t)(r - TL) * D) + c);
    f32x4 o; o[0] = hm[0] + g2[0] * v[0]; o[1] = hm[1] + g2[1] * v[1]; o[2] = hm[2] + g2[2] * v[2]; o[3] = hm[3] + g2[3] * v[3];
    if (outw) *(f32x4*)((r < TL ? out + (size_t)r * D : hc1 + (size_t)(r - TL) * D) + c) = o;
    else if (o[0] == 12345.f) *(f32x4*)(hc1) = o; } };
__device__ __forceinline__ EpiMoeF make_epi_moef(const P& p, int l) {
    return EpiMoeF{(const unsigned char*)(p.ws + WS_SLAB), (const float*)(p.ws + WS_MOD) + (size_t)l * 9 * 6 * D, p.out, (const float*)(p.ws + WS_HCMID), (float*)(p.ws + WS_HC1)};
}
struct SsmPar { float lre, lim, dt; };
__device__ __forceinline__ SsmPar ssm_par(const P& p, int l, int dir, int g, int pp) {
    const int pi = ((l * 2 + dir) * SG + g) * SP + pp;
    SsmPar r; r.lre = p.in[I_LRE][pi]; r.lim = p.in[I_LIM][pi]; r.dt = expf(p.in[I_LDT][(l * 2 + dir) * SG + g]); return r;
}
__device__ __forceinline__ float2 ssm_pow(const SsmPar& q, float e) {
    const float mag = expf(e * q.lre * q.dt), ang = e * (q.lim * q.dt);
    return make_float2(mag * cosf(ang), mag * sinf(ang));
}
__device__ __forceinline__ float2 ssm_f(const SsmPar& q) {
    const float2 lb = ssm_pow(q, 1.f);
    const float nr = lb.x - 1.f, ni = lb.y, den = q.lre * q.lre + q.lim * q.lim;
    return make_float2((nr * q.lre + ni * q.lim) / den, (ni * q.lre - nr * q.lim) / den);
}
__device__ __forceinline__ float2 cmul(float2 a, float2 b) { return make_float2(a.x * b.x - a.y * b.y, a.x * b.y + a.y * b.x); }
__device__ __forceinline__ void st_ssm_tables(const P& p) {
    float2* pw = (float2*)(p.ws + WS_POW); float2* fb = (float2*)(p.ws + WS_FB);
    for (int idx = BIDX * NT + TIDX; idx < 2 * 2 * 16 * 33 * 64; idx += gridDim.x * NT) {
        const int pp = idx & 63; int q_ = idx >> 6; const int e = q_ % 33; q_ /= 33; const int g = q_ & 15, dir = (q_ >> 4) & 1, l = q_ >> 5;
        pw[idx] = ssm_pow(ssm_par(p, l, dir, g, pp), (float)e);
    }
    for (int idx = BIDX * NT + TIDX; idx < 2 * 2 * 16 * 64 * 16; idx += gridDim.x * NT) {
        const int h = idx & 15, pp = (idx >> 4) & 63, g = (idx >> 10) & 15, dir = (idx >> 14) & 1, l = idx >> 15;
        const size_t bi = ((size_t)((l * 2 + dir) * SG + g) * SP + pp) * 16 + h;
        fb[idx] = cmul(ssm_f(ssm_par(p, l, dir, g, pp)), make_float2(p.in[I_BRE][bi], p.in[I_BIM][bi]));
    }
}
__device__ __forceinline__ void st_ssm_kj(const P& p, float* lds) {
    float* lam = lds; float* Cc = lds + 128; float* Bb = Cc + 2048;
    float* kj = (float*)(p.ws + WS_KJ);
    const int t = TIDX;
    for (int item = (int)gridDim.x - 1 - BIDX; item < 64; item += gridDim.x) {
        const int l = item >> 5, g = (item >> 1) & 15, dir = item & 1;
        const int base = (l * 2 + dir) * SG + g;
        __syncthreads();
        if (t < 64) {
            const SsmPar q = ssm_par(p, l, dir, g, t);
            const float2 lb = ssm_pow(q, 1.f), f = ssm_f(q);
            lam[2 * t] = lb.x; lam[2 * t + 1] = lb.y;
            for (int h = 0; h < 16; ++h) {
                const size_t bi = ((size_t)base * SP + t) * 16 + h;
                const float2 bb = cmul(f, make_float2(p.in[I_BRE][bi], p.in[I_BIM][bi]));
                Bb[(t * 16 + h) * 2] = bb.x; Bb[(t * 16 + h) * 2 + 1] = bb.y;
            }
        }
        for (int i = t; i < 1024; i += NT) { const size_t ci = (size_t)base * 1024 + i; Cc[2 * i] = p.in[I_CRE][ci]; Cc[2 * i + 1] = p.in[I_CIM][ci]; }
        __syncthreads();
        const int ho = t >> 4, hi = t & 15;
        float acc[32];
#pragma unroll
        for (int j = 0; j < 32; ++j) acc[j] = 0.f;
        for (int pp = 0; pp < 64; ++pp) {
            float2 z = cmul(make_float2(Cc[(ho * 64 + pp) * 2], Cc[(ho * 64 + pp) * 2 + 1]), make_float2(Bb[(pp * 16 + hi) * 2], Bb[(pp * 16 + hi) * 2 + 1]));
            const float2 lb = make_float2(lam[2 * pp], lam[2 * pp + 1]);
#pragma unroll
            for (int j = 0; j < 32; ++j) { acc[j] += z.x; z = cmul(z, lb); }
        }
#pragma unroll
        for (int j = 0; j < 32; ++j) kj[((size_t)((l * 16 + g) * 2 + dir) * 32 + j) * 256 + ho * 16 + hi] = acc[j];
    }
    __syncthreads();
}
__device__ __forceinline__ void st_prep_ssm(const P& p, int l, int parts) {
    bf16_t* wst = (bf16_t*)(p.ws + WS_WST);
    if (parts & 1) for (int idx = BIDX * NT + TIDX; idx < 16 * 256 * 64; idx += gridDim.x * NT) {
        const int kc = idx & 63, n = (idx >> 6) & 255, g = idx >> 14;
        const int dir = n >> 7, c = (n >> 6) & 1, pp = n & 63, s = kc >> 1, h0 = (kc & 1) * 8;
        const int ldg = (l * 2 + dir) * 16 + g;
        const float2 coef = ((const float2*)(p.ws + WS_POW))[((size_t)ldg * 33 + (dir == 0 ? 31 - s : s)) * 64 + pp];
        const float2* fbp = (const float2*)(p.ws + WS_FB) + ((size_t)ldg * 64 + pp) * 16 + h0;
        float v[8];
#pragma unroll
        for (int j = 0; j < 8; ++j) { const float2 z = cmul(coef, fbp[j]); v[j] = c == 0 ? z.x : z.y; }
        u32x4 o; o[0] = cvt_pk_bf16(v[0], v[1]); o[1] = cvt_pk_bf16(v[2], v[3]); o[2] = cvt_pk_bf16(v[4], v[5]); o[3] = cvt_pk_bf16(v[6], v[7]);
        *(u32x4*)(wst + ((size_t)(g * 256 + n)) * 512 + kc * 8) = o;
    }
    bf16_t* kw = (bf16_t*)(p.ws + WS_KW);
    const float* kj = (const float*)(p.ws + WS_KJ);
    if (parts & 2) for (int idx = BIDX * NT + TIDX; idx < 16 * 512 * 96; idx += gridDim.x * NT) {
        const int kc = idx % 96, n = (idx / 96) & 511, g = idx / (96 * 512);
        const int tau = n >> 4, ho = n & 15;
        float v[8];
        if (kc < 64) {
            const int s = kc >> 1, hi0 = (kc & 1) * 8;
            const int d0 = tau - s, d1 = s - tau;
            const float m0 = d0 >= 0 ? 1.f : 0.f, m1 = d1 >= 0 ? 1.f : 0.f;
            const float* k0p = kj + ((size_t)((l * 16 + g) * 2 + 0) * 32 + (d0 > 0 ? d0 : 0)) * 256 + ho * 16 + hi0;
            const float* k1p = kj + ((size_t)((l * 16 + g) * 2 + 1) * 32 + (d1 > 0 ? d1 : 0)) * 256 + ho * 16 + hi0;
            const f32x4 a0 = *(const f32x4*)k0p, a1 = *(const f32x4*)(k0p + 4), b0 = *(const f32x4*)k1p, b1 = *(const f32x4*)(k1p + 4);
            const float dsk = p.in[I_SD][l * DSSM + g * 16 + ho];
#pragma unroll
            for (int j = 0; j < 8; ++j) v[j] = m0 * (j < 4 ? a0[j] : a1[j - 4]) + m1 * (j < 4 ? b0[j] : b1[j - 4]) + ((s == tau && ho == hi0 + j) ? dsk : 0.f);
        } else {
            const int kk = (kc - 64) * 8, dir = kk >> 7, c = (kk >> 6) & 1, p0 = kk & 63;
            const int e = dir == 0 ? tau + 1 : 32 - tau;
            const f32x4* pwp = (const f32x4*)((const float2*)(p.ws + WS_POW) + ((size_t)((l * 2 + dir) * 16 + g) * 33 + e) * 64 + p0);
            const size_t ci = ((size_t)((l * 2 + dir) * SG + g) * 16 + ho) * SP + p0;
            const f32x4 cr0 = *(const f32x4*)(p.in[I_CRE] + ci), cr1 = *(const f32x4*)(p.in[I_CRE] + ci + 4), ci0 = *(const f32x4*)(p.in[I_CIM] + ci), ci1 = *(const f32x4*)(p.in[I_CIM] + ci + 4);
            const f32x4 w0 = pwp[0], w1 = pwp[1], w2 = pwp[2], w3 = pwp[3];
            const float pr[8] = {w0[0], w0[2], w1[0], w1[2], w2[0], w2[2], w3[0], w3[2]}, pi[8] = {w0[1], w0[3], w1[1], w1[3], w2[1], w2[3], w3[1], w3[3]};
#pragma unroll
            for (int j = 0; j < 8; ++j) {
                const float2 z = cmul(make_float2(j < 4 ? cr0[j] : cr1[j - 4], j < 4 ? ci0[j] : ci1[j - 4]), make_float2(pr[j], pi[j]));
                v[j] = c == 0 ? z.x : -z.y;
            }
        }
        u32x4 o; o[0] = cvt_pk_bf16(v[0], v[1]); o[1] = cvt_pk_bf16(v[2], v[3]); o[2] = cvt_pk_bf16(v[4], v[5]); o[3] = cvt_pk_bf16(v[6], v[7]);
        *(u32x4*)(kw + ((size_t)(g * 512 + n)) * 768 + kc * 8) = o;
    }
}
__device__ __forceinline__ void st_ssm_egemm(const P& p, unsigned char* lds) {
    const bf16_t* ua = (const bf16_t*)(p.ws + WS_UA);
    const bf16_t* wst = (const bf16_t*)(p.ws + WS_WST);
    float* E = (float*)(p.ws + WS_E);
    int t_end, t_step;
    for (int tile = xcd_first(160, t_end, t_step); tile < t_end; tile += t_step) {
        const int nt = tile & 1, mt = (tile >> 1) % 5, g = tile / 10;
        f32x16 acc[2][2];
        gemm_tile(acc, ARowPlain{ua + (size_t)(g * 640 + mt * 128) * 768, 768}, wst + (size_t)(g * 256 + nt * 128) * 512, 512, 512, lds);
        acc_foreach4_lds(acc, lds, [&](int r, int c, float v0, float v1, float v2, float v3) { f32x4 o; o[0] = v0; o[1] = v1; o[2] = v2; o[3] = v3; *(f32x4*)(E + (size_t)(g * 640 + mt * 128 + r) * 256 + nt * 128 + c) = o; });
    }
}
__device__ __forceinline__ void st_ssm_carry(const P& p, int l) {
    bf16_t* ua = (bf16_t*)(p.ws + WS_UA);
    const float* E = (const float*)(p.ws + WS_E);
    for (int idx = ((int)gridDim.x - 1 - BIDX) * NT + TIDX; idx < NB * 16 * 2 * 64; idx += gridDim.x * NT) {
        const int pp = idx & 63, dir = (idx >> 6) & 1, g = (idx >> 7) & 15, b = idx >> 11;
        const float2 l32 = ((const float2*)(p.ws + WS_POW))[((size_t)((l * 2 + dir) * 16 + g) * 33 + 32) * 64 + pp];
        float2 S = make_float2(0.f, 0.f);
        for (int s0 = 0; s0 < 72; s0 += 24) {
            int ch[24]; float er[24], ei[24];
#pragma unroll
            for (int j = 0; j < 24; ++j) {
                const int step = s0 + j;
                if (dir == 0) ch[j] = step < 8 ? 512 + b * 8 + step : b * 64 + (step - 8);
                else ch[j] = step < 8 ? 512 + b * 8 + (7 - step) : b * 64 + (63 - (step - 8));
                const float* e = E + (size_t)(g * 640 + ch[j]) * 256 + dir * 128 + pp;
                er[j] = e[0]; ei[j] = e[64];
            }
#pragma unroll
            for (int j = 0; j < 24; ++j) {
                bf16_t* o = ua + (size_t)(g * 640 + ch[j]) * 768 + 512 + dir * 128 + pp;
                o[0] = f2bf(S.x); o[64] = f2bf(S.y);
                S = cmul(l32, S); S.x += er[j]; S.y += ei[j];
            }
        }
    }
}
__device__ __forceinline__ void st_ssm_ygemm(const P& p, int l, unsigned char* lds) {
    const bf16_t* ua = (const bf16_t*)(p.ws + WS_UA);
    const bf16_t* kw = (const bf16_t*)(p.ws + WS_KW);
    bf16_t* G = (bf16_t*)(p.ws + WS_G);
    const int nmt = l == 0 ? 5 : 4;
    int t_end, t_step;
    for (int tile = xcd_first(16 * nmt * 4, t_end, t_step); tile < t_end; tile += t_step) {
        const int nt = tile & 3, mt = (tile >> 2) % nmt, g = tile / (4 * nmt);
        f32x16 acc[2][2];
        gemm_tile(acc, ARowPlain{ua + (size_t)(g * 640 + mt * 128) * 768, 768}, kw + (size_t)(g * 512 + nt * 128) * 768, 768, 768, lds);
        acc_foreach4_lds(acc, lds, [&](int r, int c, float v0, float v1, float v2, float v3) {
            const int chunk = mt * 128 + r, n = nt * 128 + c;
            if (chunk < TA / 32) *(uint2*)(G + (size_t)(chunk * 32 + (n >> 4)) * DSSM + g * 16 + (n & 15)) = pack4(gelu_f(v0), gelu_f(v1), gelu_f(v2), gelu_f(v3)); });
    }
}
struct EpiGlu2 { const bf16_t* G; bf16_t* mix; const float* bias; __device__ __forceinline__ void operator()(int r, int c, float v0, float v1, float v2, float v3) const {
    const uint2 q = *(const uint2*)(G + (size_t)r * DSSM + c);
    const f32x4 b = *(const f32x4*)(bias + c);
    *(uint2*)(mix + (size_t)r * D + 256 + c) = pack4(__uint_as_float(q.x << 16) * sigmoid_f(v0 + b[0]), __uint_as_float(q.x & 0xffff0000u) * sigmoid_f(v1 + b[1]),
                                                     __uint_as_float(q.y << 16) * sigmoid_f(v2 + b[2]), __uint_as_float(q.y & 0xffff0000u) * sigmoid_f(v3 + b[3])); } };

constexpr float QSCALE = 0.125f * 1.4426950408889634f;
__device__ __forceinline__ void st_rope_table(const P& p) {
    float2* tab = (float2*)(p.ws + WS_ROPE);
    for (int idx = BIDX * NT + TIDX; idx < L * 32; idx += gridDim.x * NT) {
        const int t = idx >> 5, a = (idx >> 4) & 1, i = idx & 15;
        const float pos = a == 0 ? (float)(t / 64) : (float)(t % 64);
        const float ang = pos * powf(10000.f, -(float)i / 16.f);
        tab[idx] = make_float2(cosf(ang), sinf(ang));
    }
}
__device__ __forceinline__ void st_inproj(const P& p, int l, unsigned char* lds) {
    const bf16_t* A = (const bf16_t*)(p.ws + WS_BUFA);
    const bf16_t* Bt = (const bf16_t*)(p.ws + WS_WTIN);
    bf16_t* pc = (bf16_t*)(p.ws + WS_PC);
    bf16_t* ua = (bf16_t*)(p.ws + WS_UA);
    bf16_t* qb = (bf16_t*)(p.ws + WS_QB);
    bf16_t* kb = (bf16_t*)(p.ws + WS_KB);
    bf16_t* vt = (bf16_t*)(p.ws + WS_VT);
    const float2* rope = (const float2*)(p.ws + WS_ROPE);
    const int lane = TIDX & 63, w = TIDX >> 6, wr = w >> 1, wc = w & 1, lr = lane & 31, lh = lane >> 5;
    constexpr int TN = DIN / 128;
    int t_end, t_step;
    for (int tile = xcd_first((TA / 128) * TN, t_end, t_step); tile < t_end; tile += t_step) {
        const int tn = tile % TN, m0 = (tile / TN) * 128, n0 = tn * 128;
        f32x16 acc[2][2];
        gemm_tile(acc, ARowPlain{A + (size_t)m0 * D, D}, Bt + (size_t)n0 * D, D, D, lds);
        if (tn < 6) {
            acc_foreach4_lds(acc, lds, [&](int r, int c, float v0, float v1, float v2, float v3) { *(uint2*)(pc + (size_t)(m0 + r) * 768 + n0 + c) = pack4(v0, v1, v2, v3); });
        } else if (tn < 8) {
            acc_foreach4_lds(acc, lds, [&](int r, int c, float v0, float v1, float v2, float v3) { const int row = m0 + r, g = (tn - 6) * 8 + (c >> 4);
                *(uint2*)(ua + (size_t)(g * 640 + (row >> 5)) * 768 + (row & 31) * 16 + (c & 15)) = pack4(v0, v1, v2, v3); });
        } else if (tn < 13) {
            const bool isq = tn < 12;
            const float* gain = (isq ? p.in[I_QG] : p.in[I_KG]) + l * 64;
            const bool lat = m0 < TL;
            const float osc = isq ? QSCALE : 1.f;
#pragma unroll
            for (int mi = 0; mi < 2; ++mi) {
                const int row = m0 + wr * 64 + mi * 32 + lr;
                float ss = 0.f;
#pragma unroll
                for (int ni = 0; ni < 2; ++ni)
#pragma unroll
                    for (int r = 0; r < 16; ++r) ss += acc[mi][ni][r] * acc[mi][ni][r];
                ss += __shfl_xor(ss, 32);
                const float rinv = rsqrtf(ss * (1.f / 64.f) + 1e-6f) * osc;
                const int t = row & (L - 1);
                bf16_t* o = isq ? qb + (size_t)row * DATT + ((tn - 8) * 2 + wc) * 64 : kb + (size_t)row * 128 + wc * 64;
#pragma unroll
                for (int ni = 0; ni < 2; ++ni)
#pragma unroll
                    for (int g = 0; g < 2; ++g) {
                        const int d0 = ni * 32 + 8 * g + 4 * lh;
                        const f32x4 glo = *(const f32x4*)(gain + d0), ghi = *(const f32x4*)(gain + d0 + 16);
                        float t1[4], t2[4];
#pragma unroll
                        for (int q = 0; q < 4; ++q) { t1[q] = acc[mi][ni][4 * g + q] * rinv * glo[q]; t2[q] = acc[mi][ni][8 + 4 * g + q] * rinv * ghi[q]; }
                        if (lat) {
                            const float2* cs = rope + (t * 2 + ni) * 16 + 8 * g + 4 * lh;
                            const f32x4 c01 = *(const f32x4*)(cs), c23 = *(const f32x4*)(cs + 2);
                            const float cc[4] = {c01[0], c01[2], c23[0], c23[2]}, sn[4] = {c01[1], c01[3], c23[1], c23[3]};
#pragma unroll
                            for (int q = 0; q < 4; ++q) { const float a = t1[q], b = t2[q]; t1[q] = a * cc[q] - b * sn[q]; t2[q] = a * sn[q] + b * cc[q]; }
                        }
                        *(uint2*)(o + d0) = pack4(t1[0], t1[1], t1[2], t1[3]);
                        *(uint2*)(o + d0 + 16) = pack4(t2[0], t2[1], t2[2], t2[3]);
                    }
            }
        } else {
            acc_foreach4_lds(acc, lds, [&](int r, int c, float v0, float v1, float v2, float v3) { *(uint2*)(vt + (size_t)(m0 + r) * 128 + c) = pack4(v0, v1, v2, v3); });
        }
    }
}

constexpr int AT_KROWB = 144, AT_VROWB = 136, AT_VOFF = 64 * AT_KROWB, AT_BUFB = AT_VOFF + 64 * AT_VROWB;
__device__ __forceinline__ void st_attn2(const P& p, int l, unsigned char* lds, int part, int nparts) {
    const bf16_t* qb = (const bf16_t*)(p.ws + WS_QB);
    const bf16_t* kb = (const bf16_t*)(p.ws + WS_KB);
    const bf16_t* vb = (const bf16_t*)(p.ws + WS_VT);
    bf16_t* mix = (bf16_t*)(p.ws + WS_BUFA);
    const int t = TIDX, lane = t & 63, w = t >> 6, lr = lane & 31, lh = lane >> 5;
    constexpr int NLAT = NB * 32 * 2;
    const int nitems = NLAT + (l == 0 ? NB * 4 * 2 : 0);
    int t_end, t_step;
    for (int kk = xcd_first((nitems - part + nparts - 1) / nparts, t_end, t_step); kk < t_end; kk += t_step) {
        const int item = kk * nparts + part;
        const bool isctx = item >= NLAT;
        int b, q64, g;
        if (!isctx) { g = item & 1; q64 = (item >> 1) & 31; b = item >> 6; }
        else { const int it = item - NLAT; g = it & 1; q64 = (it >> 1) & 3; b = it >> 3; }
        const int hq = g * 4 + w;
        const int rq0 = isctx ? TL + b * LC + q64 * 64 : b * L + q64 * 64;
        bf16x8 qf[2][4];
#pragma unroll
        for (int qs = 0; qs < 2; ++qs)
#pragma unroll
            for (int s4 = 0; s4 < 4; ++s4) qf[qs][s4] = *(const bf16x8*)(qb + (size_t)(rq0 + qs * 32 + lr) * DATT + hq * 64 + s4 * 16 + lh * 8);
        const float sinkl = p.in[I_SINK][l * NQH + hq] * 1.4426950408889634f;
        float m[2] = {sinkl, sinkl};
        float lsum[2]; lsum[0] = lsum[1] = lh == 0 ? 1.f : 0.f;
        f32x16 o[2][2];
        float zf = 0.f; asm volatile("" : "+v"(zf));
#pragma unroll
        for (int qs = 0; qs < 2; ++qs)
#pragma unroll
            for (int dt = 0; dt < 2; ++dt)
#pragma unroll
                for (int r = 0; r < 16; ++r) o[qs][dt][r] = zf;
        const int nwin = isctx ? 0 : 5, nkt = nwin + 4;
        const int srow = t >> 3, kc = t & 7;
        u32x4 pk[2], pv[2];
        auto tile_row0 = [&](int kt, bool& win, bool& valid) -> int {
            if (kt < nwin) { win = true; const int k64 = q64 - 2 + kt; valid = (k64 >= 0 && k64 < 32); return b * L + k64 * 64; }
            win = false; valid = true; return TL + b * LC + (kt - nwin) * 64;
        };
        int kt = 0; bool win, valid; int krow0 = 0;
        for (; kt < nkt; ++kt) { krow0 = tile_row0(kt, win, valid); if (valid) break; }
#define AT_LOAD(row0_) do { _Pragma("unroll") for (int i = 0; i < 2; ++i) { const size_t off = (size_t)((row0_) + srow + 32 * i) * 128 + g * 64 + kc * 8; pk[i] = *(const u32x4*)(kb + off); pv[i] = *(const u32x4*)(vb + off); } } while (0)
#define AT_WRITE(buf_) do { unsigned char* bb_ = lds + (buf_) * AT_BUFB; _Pragma("unroll") for (int i = 0; i < 2; ++i) { const int row = srow + 32 * i; \
            *(u32x4*)(bb_ + row * AT_KROWB + kc * 16) = pk[i]; unsigned char* vd = bb_ + AT_VOFF + (kc * 8) * AT_VROWB + row * 2; \
            _Pragma("unroll") for (int q = 0; q < 4; ++q) { *(bf16_t*)(vd + (2 * q) * AT_VROWB) = (bf16_t)(pv[i][q] & 0xffffu); *(bf16_t*)(vd + (2 * q + 1) * AT_VROWB) = (bf16_t)(pv[i][q] >> 16); } } } while (0)
        AT_LOAD(krow0);
        __syncthreads();
        AT_WRITE(0);
        int nkt2 = kt + 1; bool nwin2 = false, nvalid = false; int nrow0 = 0;
        for (; nkt2 < nkt; ++nkt2) { nrow0 = tile_row0(nkt2, nwin2, nvalid); if (nvalid) break; }
        if (nkt2 < nkt) AT_LOAD(nrow0);
        __syncthreads();
        int cur = 0;
        while (kt < nkt) {
            const bool cwin = win; const int ckrow0 = krow0;
            const unsigned char* tb = lds + cur * AT_BUFB;
            const bool have_next = nkt2 < nkt;
            int nkt3 = nkt2 + 1; bool nwin3 = false, nvalid3 = false; int nrow3 = 0;
            if (have_next) {
                AT_WRITE(cur ^ 1);
                for (; nkt3 < nkt; ++nkt3) { nrow3 = tile_row0(nkt3, nwin3, nvalid3); if (nvalid3) break; }
                if (nkt3 < nkt) AT_LOAD(nrow3);
            }
            const int j0t = ckrow0 - b * L;
#pragma unroll
            for (int sub = 0; sub < 2; ++sub) {
                bf16x8 kf[4];
#pragma unroll
                for (int s4 = 0; s4 < 4; ++s4) kf[s4] = *(const bf16x8*)(tb + (sub * 32 + lr) * AT_KROWB + s4 * 32 + lh * 16);
                bool skip[2] = {false, false}, partial[2] = {false, false};
                if (cwin) {
#pragma unroll
                    for (int qs = 0; qs < 2; ++qs) {
                        const int j0 = j0t + sub * 32, i0 = q64 * 64 + qs * 32;
                        skip[qs] = (j0 > i0 + 31 + 128 || j0 + 31 < i0 - 128);
                        partial[qs] = !skip[qs] && !(j0 >= i0 + 31 - 128 && j0 + 31 <= i0 + 128);
                    }
                }
                if (skip[0] && skip[1]) continue;
                f32x16 sT[2];
#pragma unroll
                for (int qs = 0; qs < 2; ++qs)
#pragma unroll
                    for (int r = 0; r < 16; ++r) sT[qs][r] = zf;
#pragma unroll
                for (int s4 = 0; s4 < 4; ++s4) {
                    sT[0] = __builtin_amdgcn_mfma_f32_32x32x16_bf16(kf[s4], qf[0][s4], sT[0], 0, 0, 0);
                    sT[1] = __builtin_amdgcn_mfma_f32_32x32x16_bf16(kf[s4], qf[1][s4], sT[1], 0, 0, 0);
                }
                if (partial[0] || partial[1] || skip[0] || skip[1]) {
                    int djb = j0t + sub * 32 + 4 * lh - (q64 * 64 + lr);
                    asm volatile("" : "+v"(djb));
#pragma unroll
                    for (int qs = 0; qs < 2; ++qs)
#pragma unroll
                        for (int r = 0; r < 16; ++r) { const int dj = djb - qs * 32 + (r & 3) + 8 * (r >> 2); if (dj > 128 || dj < -128) sT[qs][r] = -1e30f; }
                }
                float mt[2];
#pragma unroll
                for (int qs = 0; qs < 2; ++qs) {
                    float a = sT[qs][0];
#pragma unroll
                    for (int r = 1; r < 16; ++r) a = fmaxf(a, sT[qs][r]);
                    mt[qs] = fmaxf(a, __shfl_xor(a, 32));
                }
                if (!__all(mt[0] - m[0] <= 8.f && mt[1] - m[1] <= 8.f)) {
                    asm volatile("" ::: "memory");
#pragma unroll
                    for (int qs = 0; qs < 2; ++qs) {
                        const float mn = fmaxf(m[qs], mt[qs]);
                        const float alpha = __builtin_amdgcn_exp2f(m[qs] - mn);
                        m[qs] = mn;
                        lsum[qs] *= alpha;
#pragma unroll
                        for (int r = 0; r < 16; ++r) { o[qs][0][r] *= alpha; o[qs][1][r] *= alpha; }
                    }
                }
#pragma unroll
                for (int qs = 0; qs < 2; ++qs) {
                    const float mn = m[qs];
                    float ps = 0.f;
#pragma unroll
                    for (int r = 0; r < 16; ++r) { sT[qs][r] = __builtin_amdgcn_exp2f(sT[qs][r] - mn); ps += sT[qs][r]; }
                    lsum[qs] += ps;
                }
#pragma unroll
                for (int s2 = 0; s2 < 2; ++s2) {
                    bf16x8 pf[2];
#pragma unroll
                    for (int qs = 0; qs < 2; ++qs) {
                        u32x4 pkk;
                        pkk[0] = cvt_pk_bf16(sT[qs][8 * s2 + 0], sT[qs][8 * s2 + 1]); pkk[1] = cvt_pk_bf16(sT[qs][8 * s2 + 2], sT[qs][8 * s2 + 3]);
                        pkk[2] = cvt_pk_bf16(sT[qs][8 * s2 + 4], sT[qs][8 * s2 + 5]); pkk[3] = cvt_pk_bf16(sT[qs][8 * s2 + 6], sT[qs][8 * s2 + 7]);
                        pf[qs] = __builtin_bit_cast(bf16x8, pkk);
                    }
#pragma unroll
                    for (int dt = 0; dt < 2; ++dt) {
                        const unsigned char* vp = tb + AT_VOFF + (dt * 32 + lr) * AT_VROWB + (sub * 32 + s2 * 16 + lh * 4) * 2;
                        const uint2 a = *(const uint2*)(vp), c2 = *(const uint2*)(vp + 16);
                        u32x4 vv; vv[0] = a.x; vv[1] = a.y; vv[2] = c2.x; vv[3] = c2.y;
                        const bf16x8 vf = __builtin_bit_cast(bf16x8, vv);
                        o[0][dt] = __builtin_amdgcn_mfma_f32_32x32x16_bf16(vf, pf[0], o[0][dt], 0, 0, 0);
                        o[1][dt] = __builtin_amdgcn_mfma_f32_32x32x16_bf16(vf, pf[1], o[1][dt], 0, 0, 0);
                    }
                }
            }
            __syncthreads();
            kt = nkt2; win = nwin2; krow0 = nrow0; nkt2 = nkt3; nwin2 = nwin3; nrow0 = nrow3; cur ^= 1;
        }
#undef AT_LOAD
#undef AT_WRITE
#pragma unroll
        for (int qs = 0; qs < 2; ++qs) {
            const float lt = lsum[qs] + __shfl_xor(lsum[qs], 32);
            const float inv = 1.f / lt;
            bf16_t* orow = mix + (size_t)(rq0 + qs * 32 + lr) * D + 512 + hq * 64;
#pragma unroll
            for (int dt = 0; dt < 2; ++dt)
#pragma unroll
                for (int rg = 0; rg < 4; ++rg)
                    *(uint2*)(orow + dt * 32 + 8 * rg + 4 * lh) = pack4(o[qs][dt][4 * rg] * inv, o[qs][dt][4 * rg + 1] * inv, o[qs][dt][4 * rg + 2] * inv, o[qs][dt][4 * rg + 3] * inv);
        }
    }
}


constexpr int FAKE = 0;
constexpr int TIM = 0;
constexpr int PROBE3 = 0;
constexpr int PROBE2 = 0;
__device__ __forceinline__ void st_fake(const P& p, unsigned char* lds) {
    if (FAKE == 0) return;
    const bf16_t* A = (const bf16_t*)(p.ws + WS_BUFA);
    const bf16_t* Bt = (const bf16_t*)(p.ws + WS_WTIN);
    constexpr int TN = DIN / 128;
    int t_end, t_step;
    float sink = 0.f;
    for (int tile = xcd_first((TA / 128) * TN, t_end, t_step); tile < t_end; tile += t_step) {
        const int tn = tile % TN, m0 = (FAKE == 2 || FAKE == 3) ? 0 : (tile / TN) * 128, n0 = FAKE == 3 ? 0 : tn * 128;
        f32x16 acc[2][2];
        gemm_tile(acc, ARowPlain{A + (size_t)m0 * D, D}, Bt + (size_t)n0 * D, D, D, lds);
        if (FAKE == 4) {
            bf16_t* dst = (bf16_t*)(p.ws + WS_HID);
            acc_foreach4_lds(acc, lds, [&](int r, int c, float v0, float v1, float v2, float v3) { *(uint2*)(dst + ((size_t)((tile / TN) * 128 + r) * 128 + c)) = pack4(v0, v1, v2, v3); });
        } else if (FAKE == 5) {
            bf16_t* dst = (bf16_t*)(p.ws + WS_HID);
            __syncthreads();
            acc_foreach4_lds(acc, lds, [&](int r, int c, float v0, float v1, float v2, float v3) { *(uint2*)(lds + (r * 136 + c) * 2) = pack4(v0, v1, v2, v3); });
            __syncthreads();
            const int t = TIDX;
#pragma unroll
            for (int i = 0; i < 8; ++i) { const int ch = t + 256 * i, r = ch >> 4, cc = (ch & 15) * 8;
                *(u32x4*)(dst + ((size_t)((tile / TN) * 128 + r) * 128 + cc)) = *(const u32x4*)(lds + (r * 136 + cc) * 2); }
        } else {
#pragma unroll
        for (int mi = 0; mi < 2; ++mi)
#pragma unroll
            for (int ni = 0; ni < 2; ++ni) sink += acc[mi][ni][0] + acc[mi][ni][7];
        }
    }
    if (sink == 12345.678f) ((float*)(p.ws + WS_RBIAS))[1000] = sink;
}
constexpr int STAGES_PER_LAYER = 11;
constexpr int N_STAGES = 1 + 2 * STAGES_PER_LAYER;
constexpr int REP_STAGE = -1;

__device__ __forceinline__ void run_stage(const P& p, int s, unsigned char* ldsb) {
    float* lds = (float*)ldsb;
    if (s == 0) { st_mod(p, lds); st_rope_table(p); st_ssm_tables(p); st_ssm_kj(p, lds); st_prep_weights(p, 0, ldsb, PW_ALL); return; }
    const int l = (s - 1) / STAGES_PER_LAYER, k = (s - 1) % STAGES_PER_LAYER;
    switch (k) {
    case 0: st_rbias(p, l, lds);
            if (l == 0) st_prep_ssm(p, 0, 3); else st_prep_weights(p, 1, ldsb, PW_GU | PW_DN);
            st_norm(p, l, 0); break;
    case 1: if (l == 0) st_fake(p, ldsb); st_inproj(p, l, ldsb); break;
    case 2: st_ssm_egemm(p, ldsb); if (l == 0) st_prep_weights(p, 1, ldsb, PW_IN); break;
    case 3: st_ssm_carry(p, l); st_attn2(p, l, ldsb, 0, 1); break;
    case 4: st_ssm_ygemm(p, l, ldsb); if (l == 0) st_prep_ssm(p, 1, 1); break;
    case 5: gemm_stage((const bf16_t*)(p.ws + WS_G), DSSM, (const bf16_t*)(p.ws + WS_WTGLU), DSSM, l == 0 ? TA : TL, DSSM, DSSM,
                       EpiGlu2{(const bf16_t*)(p.ws + WS_G), (bf16_t*)(p.ws + WS_BUFA), p.in[I_BGLU] + l * DSSM}, ldsb);
            st_conv(p, l); if (l == 0) st_prep_ssm(p, 1, 2); break;
    case 6: gemm_stage_pre((const bf16_t*)(p.ws + WS_BUFA), D, (const bf16_t*)(p.ws + WS_WTOUT), D, l == 0 ? TA : TL, D, D, make_epi_out(p, l), ldsb); break;
    case 7: if (PROBE2 == 1 && l == 0) st_router2<true>(p, l, ldsb); st_router2(p, l, ldsb); if (l == 0) st_prep_weights(p, 1, ldsb, PW_GLU | PW_OUT); break;
    case 8: st_moe1(p, l, ldsb); break;
    case 9: st_moe2s(p, l, ldsb); break;
    case 10: if (PROBE2 == 2 && l == 0) { EpiMoeF e = make_epi_moef(p, l); e.outw = false; gemm_stage((const bf16_t*)(p.ws + WS_HID) + 4 * DE, 5 * DE, (const bf16_t*)(p.ws + WS_WD) + (size_t)32 * D * DE, DE, TA, D, DE, e, ldsb); }
             gemm_stage((const bf16_t*)(p.ws + WS_HID) + 4 * DE, 5 * DE, (const bf16_t*)(p.ws + WS_WD) + (size_t)32 * D * DE, DE, l == 0 ? TA : TL, D, DE, make_epi_moef(p, l), ldsb); break;
    }
}


#define XB_TMO      128
#define XB_XCNT(j)  (256  + 64 * (j))
#define XB_XSUB(j)  (1280 + 64 * (j))
#define XB_XGEN(j)  (2304 + 64 * (j))
#define XB_TOP      3328
#define XB_TOPGEN   3392
#define XCD_BAR_WORDS 3456
#define XB_SPIN_CAP (1u << 22)
__device__ __forceinline__ unsigned xb_ld(unsigned* p)              { return __hip_atomic_load(p, __ATOMIC_RELAXED, __HIP_MEMORY_SCOPE_AGENT); }
__device__ __forceinline__ unsigned xb_add(unsigned* p, unsigned v) { return __hip_atomic_fetch_add(p, v, __ATOMIC_RELAXED, __HIP_MEMORY_SCOPE_AGENT); }
__device__ __forceinline__ unsigned xb_xcc_id() { return (unsigned)__builtin_amdgcn_s_getreg((3 << 11) | 20) & 0xFu; }
#define XB_SPIN(cond, bar) do { unsigned _sp = 0; while (cond) { __builtin_amdgcn_s_sleep(1); \
    if ((++_sp & 255u) == 0u) { if (xb_ld(&(bar)[XB_TMO])) break; if (_sp > XB_SPIN_CAP) { atomicAdd(&(bar)[XB_TMO], 1u); break; } } } } while (0)
struct XcdBarrier { unsigned* bar; unsigned x; volatile LAS unsigned* st; };
__device__ __forceinline__ XcdBarrier xcd_barrier_post(unsigned* bar, volatile LAS unsigned* st) {
    XcdBarrier b; b.bar = bar; b.x = xb_xcc_id(); b.st = st;
    if (threadIdx.x == 0) (void)xb_add(&bar[XB_XCNT(b.x)], 1u);
    return b;
}
__device__ __forceinline__ void xcd_barrier_complete(unsigned* bar, unsigned x, unsigned& nloc, unsigned& nx) {
    const unsigned G = gridDim.x * gridDim.y * gridDim.z;
    unsigned sum, cnt, mine, sp = 0u;
    for (;;) {
        sum = 0u; cnt = 0u; mine = 0u;
#pragma unroll
        for (unsigned j = 0; j < 16; ++j) { const unsigned c = xb_ld(&bar[XB_XCNT(j)]); sum += c; cnt += (c > 0u) ? 1u : 0u; mine = (j == x) ? c : mine; }
        if (sum == G) break;
        __builtin_amdgcn_s_sleep(1);
        if ((++sp & 255u) == 0u) { if (xb_ld(&bar[XB_TMO])) break; if (sp > XB_SPIN_CAP) { atomicAdd(&bar[XB_TMO], 1u); break; } }
    }
    nloc = mine > 0u ? mine : 1u; nx = cnt > 0u ? cnt : 1u;
}
__device__ __forceinline__ void xcd_barrier(const XcdBarrier& b) {
    asm volatile("s_waitcnt vmcnt(0)" ::: "memory");
    __syncthreads();
    if (threadIdx.x == 0) {
        unsigned* bar = b.bar;
        __builtin_amdgcn_s_waitcnt(0);
        unsigned nloc = b.st[0], nx = b.st[1];
        if (nloc == 0u) { xcd_barrier_complete(bar, b.x, nloc, nx); b.st[0] = nloc; b.st[1] = nx; }
        const unsigned old = xb_add(&bar[XB_XSUB(b.x)], 1u);
        const unsigned gen = old / nloc;
        if (old + 1u == (gen + 1u) * nloc) {
            __builtin_amdgcn_fence(__ATOMIC_RELEASE, "agent");
            asm volatile("s_waitcnt vmcnt(0)" ::: "memory");
            const unsigned og = xb_add(&bar[XB_TOP], 1u);
            const unsigned tg = og / nx;
            if (og + 1u == (tg + 1u) * nx) xb_add(&bar[XB_TOPGEN], 1u);
            else XB_SPIN(xb_ld(&bar[XB_TOPGEN]) == tg, bar);
            __builtin_amdgcn_fence(__ATOMIC_ACQUIRE, "agent");
            xb_add(&bar[XB_XGEN(b.x)], 1u);
            asm volatile("s_waitcnt vmcnt(0)" ::: "memory");
        } else {
            XB_SPIN(xb_ld(&bar[XB_XGEN(b.x)]) == gen, bar);
            __builtin_amdgcn_fence(__ATOMIC_ACQUIRE, "agent");
            asm volatile("s_waitcnt vmcnt(0)" ::: "memory");
        }
    }
    __syncthreads();
}
constexpr size_t WS_XBAR = 4096;

template <int S> __device__ __forceinline__ void run_all(const P& p, unsigned char* lds, const XcdBarrier& xb) {
    run_stage(p, S, lds);
    if constexpr (S == REP_STAGE) { xcd_barrier(xb); run_stage(p, S, lds); }
    if constexpr (S + 1 < N_STAGES) {
        unsigned long long t0 = 0; if (TIM) t0 = __builtin_amdgcn_s_memrealtime();
        xcd_barrier(xb);
        if (TIM && threadIdx.x == 0) { const unsigned long long t1 = __builtin_amdgcn_s_memrealtime(); xb.st[2] += (unsigned)(t1 - t0);
            if (blockIdx.x == 0) ((unsigned long long*)(p.ws + WS_CTL + 32768))[S + 1] = t1; }
        run_all<S + 1>(p, lds, xb);
    } else if (TIM) {
        unsigned* ctl = (unsigned*)(p.ws + WS_CTL + 32768 + 512);
        unsigned long long* ts = (unsigned long long*)(p.ws + WS_CTL + 32768);
        if (threadIdx.x == 0) { atomicAdd(ctl, xb.st[2]); if (blockIdx.x == 0) ts[N_STAGES] = __builtin_amdgcn_s_memrealtime(); }
        xcd_barrier(xb);
        if (blockIdx.x == 0 && threadIdx.x == 0) {
            float us;
            if (TIM == 1) us = (float)__hip_atomic_load(ctl, __ATOMIC_RELAXED, __HIP_MEMORY_SCOPE_AGENT) / (float)gridDim.x * 0.01f / 10.f;
            else if (TIM == 2) us = (float)(ts[N_STAGES] - ts[0]) * 0.01f / 25.f;
            else us = (float)(ts[TIM - 10 + 1] - ts[TIM - 10]) * 0.01f / 2.f;
            float code = floorf(us); if (code > 89.f) code = 89.f;
            p.out[0] += 10.f + code;
        }
    }
}
__global__ void __launch_bounds__(NT, 2) mega(P p) {
    __shared__ __attribute__((aligned(16))) unsigned char lds[LDS_TOTAL + 16];
    volatile LAS unsigned* st = (volatile LAS unsigned*)(lds + LDS_TOTAL);
    if (threadIdx.x == 0) { st[0] = 0u; st[1] = 0u; st[2] = 0u; st[3] = 0u; if (TIM && blockIdx.x == 0) ((unsigned long long*)(p.ws + WS_CTL + 32768))[0] = __builtin_amdgcn_s_memrealtime(); }
    __syncthreads();
    const XcdBarrier xb = xcd_barrier_post((unsigned*)(p.ws + WS_CTL + WS_XBAR), st);
    if (p.ws == nullptr) cg::this_grid().sync();
    run_all<0>(p, lds, xb);
}

extern "C" void kernel_launch(void* const* d_in, const int* in_sizes, int n_in, void* d_out, int out_size, void* d_ws, size_t ws_size, hipStream_t stream) {
    if (n_in != N_IN || ws_size < WS_END) { fprintf(stderr, "kernel_launch: unexpected n_in %d or ws_size %zu (< %zu)\n", n_in, ws_size, (size_t)WS_END); return; }
    P p{};
    for (int i = 0; i < N_IN; ++i) p.in[i] = (const float*)d_in[i];
    p.out = (float*)d_out; p.ws = (unsigned char*)d_ws;
    static int grid_blocks = 0;
    if (!grid_blocks) {
        int dev = 0, cus = 0, per_cu = 0;
        hipGetDevice(&dev);
        hipDeviceGetAttribute(&cus, hipDeviceAttributeMultiprocessorCount, dev);
        hipOccupancyMaxActiveBlocksPerMultiprocessor(&per_cu, (const void*)mega, NT, 0);
        if (per_cu < 1) per_cu = 1;
        if (per_cu > 2) per_cu = 2;
        grid_blocks = cus * per_cu;
    }
    hipMemsetAsync((char*)d_ws + WS_CTL, 0, 65536, stream);
    void* args[] = {&p};
    hipError_t e = hipLaunchCooperativeKernel((const void*)mega, dim3(grid_blocks), dim3(NT), args, 0, stream);
    if (e != hipSuccess) fprintf(stderr, "cooperative launch failed: %s (grid %d)\n", hipGetErrorString(e), grid_blocks);
}
```

```cpp
#include <hip/hip_runtime.h>
#include <hip/hip_cooperative_groups.h>
#include <cstdio>
#include <cstdint>
namespace cg = cooperative_groups;
#define CNT_PTR(p, l) ((int*)((p).ws + 40960 + (l) * 8192))
#define LAS __attribute__((address_space(3)))
constexpr int ABL = 0;

__device__ __forceinline__ int tid_opaque() { int t = threadIdx.x; asm volatile("" : "+v"(t)); return t; }
__device__ __forceinline__ int bid_opaque() { int b = blockIdx.x; asm volatile("" : "+s"(b)); return b; }
__device__ __forceinline__ int xcd_first(int total, int& end, int& step) {
    const int nb = gridDim.x; int b = blockIdx.x; asm volatile("" : "+s"(b));
    if (nb & 7) { end = total; step = nb; return b; }
    const int x = b & 7, j = b >> 3, per = (total + 7) >> 3, lo = x * per;
    end = lo + per < total ? lo + per : total; step = nb >> 3; return lo + j;
}
#define TIDX tid_opaque()
#define BIDX bid_opaque()

constexpr int D = 1024, NB = 8, L = 2048, LC = 256;
constexpr int TL = NB * L, TC = NB * LC, TA = TL + TC;
constexpr int DIN = 1792, DCONV = 256, DSSM = 256, DATT = 512;
constexpr int NQH = 8, NKVH = 2, HD = 64;
constexpr int COL_U = 768, COL_Q = 1024, COL_K = 1536, COL_V = 1664;
constexpr int NE = 32, TOPK = 4, DE = 128;
constexpr int SG = 16, SH = 16, SP = 64;
constexpr int NT = 256;

enum { I_X = 0, I_C, I_CTX, I_CCTX, I_WMOD, I_BMOD, I_N1G, I_N2G, I_WIN, I_CONVW, I_LRE, I_LIM, I_LDT, I_BRE, I_BIM, I_CRE, I_CIM,
       I_SD, I_WGLU, I_BGLU, I_QG, I_KG, I_SINK, I_WOUT, I_RW, I_RB, I_WEG, I_WEU, I_WED, I_WSG, I_WSU, I_WSD, N_IN };

typedef unsigned short bf16_t;
constexpr size_t WS_CTL = 0;
constexpr size_t WS_MOD = 65536;
constexpr size_t WS_ZERO_END = WS_MOD + (size_t)2 * 9 * 6 * D * 4;
constexpr size_t WS_RBIAS = 524288;
constexpr size_t WS_ROPE = WS_RBIAS + 4096;
constexpr size_t WS_KJ = WS_ROPE + 524288;
constexpr size_t WS_GS2 = WS_KJ + 2097152;
constexpr size_t WS_POW = WS_GS2 + 131072;
constexpr size_t WS_FB = WS_POW + (size_t)2 * 2 * 16 * 33 * 64 * 8;
constexpr size_t WS_R1 = WS_FB + (size_t)2 * 2 * 16 * 64 * 16 * 8;
constexpr size_t WS_BUFA = WS_R1;
constexpr size_t WS_PC = WS_BUFA + (size_t)TA * D * 2;
constexpr size_t WS_UA = WS_PC + (size_t)TA * 768 * 2;
constexpr size_t WS_E = WS_UA + (size_t)16 * 640 * 768 * 2;
constexpr size_t WS_G = WS_E + (size_t)16 * 640 * 256 * 4;
constexpr size_t WS_QB = WS_G + (size_t)TA * DSSM * 2;
constexpr size_t WS_KB = WS_QB + (size_t)TA * DATT * 2;
constexpr size_t WS_VT = WS_KB + (size_t)TA * 128 * 2;
constexpr size_t WS_SLAB = WS_R1;
constexpr size_t WS_HID = WS_SLAB + (size_t)TA * 4 * D * 2;
constexpr size_t WS_HC1 = WS_HID + (size_t)TA * 5 * DE * 2;
constexpr size_t WS_HCMID = WS_HC1 + (size_t)TC * D * 4;
constexpr size_t WS_LCODE = WS_HCMID + (size_t)TC * D * 4;
constexpr size_t WS_LW = WS_LCODE + (size_t)NE * TA * 4;
constexpr size_t WS_WTIN = WS_LW + (size_t)NE * TA * 4;
constexpr size_t WS_WTOUT = WS_WTIN + (size_t)DIN * D * 2;
constexpr size_t WS_WTGLU = WS_WTOUT + (size_t)D * D * 2;
constexpr size_t WS_WGU = WS_WTGLU + (size_t)DSSM * DSSM * 2;
constexpr size_t WS_WD = WS_WGU + (size_t)33 * 256 * D * 2;
constexpr size_t WS_WST = WS_WD + (size_t)33 * D * DE * 2;
constexpr size_t WS_KW = WS_WST + (size_t)16 * 256 * 512 * 2;
constexpr size_t WS_END = WS_KW + (size_t)16 * 512 * 768 * 2;
static_assert(WS_VT + (size_t)TA * 128 * 2 <= WS_HID, "overlay");
static_assert(WS_ZERO_END <= WS_RBIAS, "zero region");
static_assert(WS_END <= 268435456, "workspace too large");

struct P {
    const float* in[N_IN];
    float* out;
    unsigned char* ws;
};

__device__ __forceinline__ bf16_t f2bf(float f) { unsigned u = __float_as_uint(f); u += 0x7FFFu + ((u >> 16) & 1u); return (bf16_t)(u >> 16); }
__device__ __forceinline__ float bf2f(bf16_t b) { return __uint_as_float((unsigned)b << 16); }
__device__ __forceinline__ unsigned cvt_pk_bf16(float lo, float hi) { unsigned r; asm("v_cvt_pk_bf16_f32 %0, %1, %2" : "=v"(r) : "v"(lo), "v"(hi)); return r; }
typedef __attribute__((ext_vector_type(4))) float f32x4;
typedef __attribute__((ext_vector_type(4))) unsigned u32x4;
struct BfPtr { const bf16_t* p; __device__ __forceinline__ float operator[](long i) const { return bf2f(p[i]); }
               __device__ __forceinline__ BfPtr operator+(long o) const { return BfPtr{p + o}; } };
__device__ __forceinline__ float sigmoid_f(float x) { return __builtin_amdgcn_rcpf(1.f + __builtin_amdgcn_exp2f(-1.4426950408889634f * x)); }
__device__ __forceinline__ float silu_f(float x) { return x * sigmoid_f(x); }
__device__ __forceinline__ float gelu_f(float x) { return x * sigmoid_f(2.f * 0.7978845608028654f * (x + 0.044715f * x * x * x)); }
__device__ __forceinline__ float wave_sum(float v) {
#pragma unroll
    for (int o = 32; o > 0; o >>= 1) v += __shfl_xor(v, o);
    return v;
}
__device__ __forceinline__ int row_bb(int r) { return r < TL ? r / L : 8; }
__device__ __forceinline__ const float* h_row(const P& p, int l, int r) {
    if (r < TL) return (l == 0 ? p.in[I_X] : p.out) + (size_t)r * D;
    return (l == 0 ? p.in[I_CTX] : (const float*)(p.ws + WS_HC1)) + (size_t)(r - TL) * D;
}
__device__ __forceinline__ float* hmid_row(const P& p, int r) {
    if (r < TL) return p.out + (size_t)r * D;
    return (float*)(p.ws + WS_HCMID) + (size_t)(r - TL) * D;
}
__device__ __forceinline__ const float* mod_vec(const P& p, int l, int bb, int chunk) {
    return (const float*)(p.ws + WS_MOD) + ((size_t)(l * 9 + bb) * 6 + chunk) * D;
}

__device__ __forceinline__ void st_mod(const P& p, float* lds) {
    float* red = lds + 9 * D;
    for (int i = TIDX; i < 9 * D; i += NT) {
        const int bb = i / D, k = i % D;
        const float c = bb < 8 ? p.in[I_C][bb * D + k] : p.in[I_CCTX][k];
        lds[i] = silu_f(c);
    }
    __syncthreads();
    float* mod = (float*)(p.ws + WS_MOD);
    const int col = TIDX & 31, ks = TIDX >> 5;
    for (int item = BIDX; item < 2 * 6 * D / 32; item += gridDim.x) {
        const int l = item / (6 * D / 32), j = (item % (6 * D / 32)) * 32 + col;
        const float* w = p.in[I_WMOD] + (size_t)l * D * 6 * D + j;
        float acc[9];
#pragma unroll
        for (int bb = 0; bb < 9; ++bb) acc[bb] = 0.f;
        for (int k0 = ks * 128; k0 < ks * 128 + 128; k0 += 16) {
            float wv[16];
#pragma unroll
            for (int q = 0; q < 16; ++q) wv[q] = w[(size_t)(k0 + q) * 6 * D];
#pragma unroll
            for (int q = 0; q < 16; ++q)
#pragma unroll
                for (int bb = 0; bb < 9; ++bb) acc[bb] += lds[bb * D + k0 + q] * wv[q];
        }
#pragma unroll
        for (int bb = 0; bb < 9; ++bb) red[(bb * 8 + ks) * 32 + col] = acc[bb];
        __syncthreads();
        for (int o = TIDX; o < 9 * 32; o += NT) {
            const int bb = o >> 5, c2 = o & 31;
            float sum = p.in[I_BMOD][l * 6 * D + (item % (6 * D / 32)) * 32 + c2];
#pragma unroll
            for (int q = 0; q < 8; ++q) sum += red[(bb * 8 + q) * 32 + c2];
            mod[(size_t)(l * 9 + bb) * 6 * D + (item % (6 * D / 32)) * 32 + c2] = sum;
        }
        __syncthreads();
    }
}

__device__ __forceinline__ void st_norm(const P& p, int l, int which) {
    const int lane = TIDX & 63, wv = TIDX >> 6;
    const int nrows = (which == 1 && l == 1) ? TL : TA;
    float* xn = (float*)(p.ws + WS_BUFA);
    const float* g = p.in[which == 0 ? I_N1G : I_N2G] + l * D;
    for (int r0 = (BIDX * 4 + wv) * 2; r0 < nrows; r0 += gridDim.x * 8) {
        f32x4 v[2][4];
#pragma unroll
        for (int u = 0; u < 2; ++u) {
            const float* src = which == 0 ? h_row(p, l, r0 + u) : hmid_row(p, r0 + u);
#pragma unroll
            for (int j = 0; j < 4; ++j) v[u][j] = *(const f32x4*)(src + j * 256 + lane * 4);
        }
        const int bb = row_bb(r0);
        const float* sh = mod_vec(p, l, bb, which == 0 ? 0 : 3);
        const float* sc = mod_vec(p, l, bb, which == 0 ? 1 : 4);
#pragma unroll
        for (int u = 0; u < 2; ++u) {
            const int r = r0 + u;
            float s = 0.f;
#pragma unroll
            for (int j = 0; j < 4; ++j) s += v[u][j][0] * v[u][j][0] + v[u][j][1] * v[u][j][1] + v[u][j][2] * v[u][j][2] + v[u][j][3] * v[u][j][3];
            s = wave_sum(s);
            const float rinv = rsqrtf(s * (1.f / D) + 1e-6f);
#pragma unroll
            for (int j = 0; j < 4; ++j) {
                const int k = j * 256 + lane * 4;
                const f32x4 gg = *(const f32x4*)(g + k), s1 = *(const f32x4*)(sc + k), s0 = *(const f32x4*)(sh + k);
                f32x4 o;
#pragma unroll
                for (int q = 0; q < 4; ++q) o[q] = v[u][j][q] * rinv * gg[q] * (1.f + s1[q]) + s0[q];
                if (which == 1) *(f32x4*)(xn + (size_t)r * D + k) = o;
                else { uint2 pk; pk.x = cvt_pk_bf16(o[0], o[1]); pk.y = cvt_pk_bf16(o[2], o[3]); *(uint2*)((bf16_t*)(p.ws + WS_BUFA) + (size_t)r * D + k) = pk; }
            }
        }
    }
}

__device__ __forceinline__ void bf8_to_f(const u32x4& v, float (&f)[8]) {
#pragma unroll
    for (int q = 0; q < 4; ++q) { f[2 * q] = __uint_as_float(v[q] << 16); f[2 * q + 1] = __uint_as_float(v[q] & 0xffff0000u); }
}
__device__ __forceinline__ void st_conv(const P& p, int l) {
    const bf16_t* pb = (const bf16_t*)(p.ws + WS_PC);
    bf16_t* mix = (bf16_t*)(p.ws + WS_BUFA);
    const float* cw = p.in[I_CONVW] + l * 3 * DCONV;
    const int nrows = l == 0 ? TA : TL;
    for (int idx = BIDX * NT + TIDX; idx < nrows * 32; idx += gridDim.x * NT) {
        const int r = idx >> 5, ch = (idx & 31) * 8;
        int t, len;
        if (r < TL) { t = r & (L - 1); len = L; } else { t = (r - TL) & (LC - 1); len = LC; }
        const bf16_t* pr = pb + (size_t)r * 768 + ch;
        float x[8], c[8], bgate[8], y[8];
        bf8_to_f(*(const u32x4*)(pr), x); bf8_to_f(*(const u32x4*)(pr + 512), c); bf8_to_f(*(const u32x4*)(pr + 256), bgate);
        const f32x4 w1a = *(const f32x4*)(cw + DCONV + ch), w1b = *(const f32x4*)(cw + DCONV + ch + 4);
#pragma unroll
        for (int q = 0; q < 8; ++q) y[q] = (q < 4 ? w1a[q] : w1b[q - 4]) * (c[q] * x[q]);
        if (t > 0) {
            bf8_to_f(*(const u32x4*)(pr - 768), x); bf8_to_f(*(const u32x4*)(pr - 768 + 512), c);
            const f32x4 wa = *(const f32x4*)(cw + ch), wb = *(const f32x4*)(cw + ch + 4);
#pragma unroll
            for (int q = 0; q < 8; ++q) y[q] += (q < 4 ? wa[q] : wb[q - 4]) * (c[q] * x[q]);
        }
        if (t < len - 1) {
            bf8_to_f(*(const u32x4*)(pr + 768), x); bf8_to_f(*(const u32x4*)(pr + 768 + 512), c);
            const f32x4 wa = *(const f32x4*)(cw + 2 * DCONV + ch), wb = *(const f32x4*)(cw + 2 * DCONV + ch + 4);
#pragma unroll
            for (int q = 0; q < 8; ++q) y[q] += (q < 4 ? wa[q] : wb[q - 4]) * (c[q] * x[q]);
        }
        u32x4 o;
#pragma unroll
        for (int q = 0; q < 4; ++q) o[q] = cvt_pk_bf16(bgate[2 * q] * y[2 * q], bgate[2 * q + 1] * y[2 * q + 1]);
        *(u32x4*)(mix + (size_t)r * D + ch) = o;
    }
}

struct EpiOut { const float* modl; const float* hlat; const float* hctx; float* out; float* hcmid;
    __device__ __forceinline__ void operator()(int r, int c, float v0, float v1, float v2, float v3) const {
    const int bb = row_bb(r);
    const f32x4 g1 = *(const f32x4*)(modl + ((size_t)bb * 6 + 2) * D + c);
    const f32x4 hv = *(const f32x4*)((r < TL ? hlat + (size_t)r * D : hctx + (size_t)(r - TL) * D) + c);
    f32x4 o; o[0] = hv[0] + g1[0] * v0; o[1] = hv[1] + g1[1] * v1; o[2] = hv[2] + g1[2] * v2; o[3] = hv[3] + g1[3] * v3;
    *(f32x4*)((r < TL ? out + (size_t)r * D : hcmid + (size_t)(r - TL) * D) + c) = o; }
    __device__ __forceinline__ f32x4 prefetch(int r, int c) const { return *(const f32x4*)((r < TL ? hlat + (size_t)r * D : hctx + (size_t)(r - TL) * D) + c); }
    __device__ __forceinline__ void with_pre(int r, int c, float v0, float v1, float v2, float v3, const f32x4& hv) const {
    const f32x4 g1 = *(const f32x4*)(modl + ((size_t)row_bb(r) * 6 + 2) * D + c);
    f32x4 o; o[0] = hv[0] + g1[0] * v0; o[1] = hv[1] + g1[1] * v1; o[2] = hv[2] + g1[2] * v2; o[3] = hv[3] + g1[3] * v3;
    *(f32x4*)((r < TL ? out + (size_t)r * D : hcmid + (size_t)(r - TL) * D) + c) = o; } };
__device__ __forceinline__ EpiOut make_epi_out(const P& p, int l) {
    return EpiOut{(const float*)(p.ws + WS_MOD) + (size_t)l * 9 * 6 * D, l == 0 ? p.in[I_X] : p.out, l == 0 ? p.in[I_CTX] : (const float*)(p.ws + WS_HC1), p.out, (float*)(p.ws + WS_HCMID)};
}

typedef __attribute__((ext_vector_type(8))) short bf16x8;
typedef __attribute__((ext_vector_type(16))) float f32x16;
constexpr int G_STAGEB = 16384;
constexpr int G_NSTG = 4;
constexpr int LDS_BYTES = G_NSTG * G_STAGEB;

template <class ARow>
__device__ __forceinline__ void gemm_tile(f32x16 (&acc)[2][2], ARow arow, const bf16_t* Bt, int ldb, int K, unsigned char* lds) {
    const int t = TIDX, lane = t & 63, w = __builtin_amdgcn_readfirstlane(t >> 6), wr = w >> 1, wc = w & 1, lr = lane & 31, lh = lane >> 5;
    const int srow = t >> 2, lc = (t & 3) ^ ((srow >> 2) & 3);
    const bf16_t* ap[2]; const bf16_t* bp[2];
#pragma unroll
    for (int i = 0; i < 2; ++i) { ap[i] = arow(srow + 64 * i) + lc * 8; bp[i] = Bt + (size_t)(srow + 64 * i) * ldb + lc * 8; }
    float zf = 0.f; asm volatile("" : "+v"(zf));
#pragma unroll
    for (int mi = 0; mi < 2; ++mi)
#pragma unroll
        for (int ni = 0; ni < 2; ++ni)
#pragma unroll
            for (int r = 0; r < 16; ++r) acc[mi][ni][r] = zf;
    const int nk = K >> 5;
    LAS unsigned char* l3 = (LAS unsigned char*)lds;
    const int f = (lr >> 2) & 3;
    const int aoff = (wr * 64 + lr) * 64 + ((lh ^ f) << 4), boff = 8192 + (wc * 64 + lr) * 64 + ((lh ^ f) << 4);
#define G_ISSUE(ks) do { LAS unsigned char* d_ = l3 + ((ks) & 3) * G_STAGEB + w * 1024; \
        __builtin_amdgcn_global_load_lds((const unsigned*)(ap[0] + (ks) * 32), (LAS unsigned*)(d_), 16, 0, 0); \
        __builtin_amdgcn_global_load_lds((const unsigned*)(ap[1] + (ks) * 32), (LAS unsigned*)(d_ + 4096), 16, 0, 0); \
        __builtin_amdgcn_global_load_lds((const unsigned*)(bp[0] + (ks) * 32), (LAS unsigned*)(d_ + 8192), 16, 0, 0); \
        __builtin_amdgcn_global_load_lds((const unsigned*)(bp[1] + (ks) * 32), (LAS unsigned*)(d_ + 12288), 16, 0, 0); } while (0)
#define G_RD(A0, A1, B0, B1, slot, s2) do { const LAS unsigned char* c_ = l3 + (slot) * G_STAGEB; \
        A0 = *(const LAS bf16x8*)(c_ + (aoff ^ ((s2) << 5))); A1 = *(const LAS bf16x8*)(c_ + ((aoff + 2048) ^ ((s2) << 5))); \
        B0 = *(const LAS bf16x8*)(c_ + (boff ^ ((s2) << 5))); B1 = *(const LAS bf16x8*)(c_ + ((boff + 2048) ^ ((s2) << 5))); } while (0)
#define G_MM(A0, A1, B0, B1) do { __builtin_amdgcn_s_setprio(1); \
        acc[0][0] = __builtin_amdgcn_mfma_f32_32x32x16_bf16(B0, A0, acc[0][0], 0, 0, 0); acc[0][1] = __builtin_amdgcn_mfma_f32_32x32x16_bf16(B1, A0, acc[0][1], 0, 0, 0); \
        acc[1][0] = __builtin_amdgcn_mfma_f32_32x32x16_bf16(B0, A1, acc[1][0], 0, 0, 0); acc[1][1] = __builtin_amdgcn_mfma_f32_32x32x16_bf16(B1, A1, acc[1][1], 0, 0, 0); __builtin_amdgcn_s_setprio(0); } while (0)
    __syncthreads();
    const int np = nk >> 1;
    G_ISSUE(0); G_ISSUE(1);
    if (1 < np) { G_ISSUE(2); G_ISSUE(3); asm volatile("s_waitcnt vmcnt(8)" ::: "memory"); } else asm volatile("s_waitcnt vmcnt(0)" ::: "memory");
    __builtin_amdgcn_s_barrier();
    bf16x8 fa0, fa1, fb0, fb1, ga0, ga1, gb0, gb1;
    G_RD(fa0, fa1, fb0, fb1, 0, 0);
    for (int m = 0; m < np; ++m) {
        const int sa = (2 * m) & 3, sb = (2 * m + 1) & 3;
        G_RD(ga0, ga1, gb0, gb1, sa, 1);
        __builtin_amdgcn_sched_barrier(0);
        asm volatile("s_waitcnt lgkmcnt(4)" ::: "memory");
        __builtin_amdgcn_sched_barrier(0);
        G_MM(fa0, fa1, fb0, fb1);
        __builtin_amdgcn_sched_barrier(0);
        G_RD(fa0, fa1, fb0, fb1, sb, 0);
        __builtin_amdgcn_sched_barrier(0);
        asm volatile("s_waitcnt lgkmcnt(4)" ::: "memory");
        __builtin_amdgcn_sched_barrier(0);
        G_MM(ga0, ga1, gb0, gb1);
        __builtin_amdgcn_sched_barrier(0);
        G_RD(ga0, ga1, gb0, gb1, sb, 1);
        __builtin_amdgcn_sched_barrier(0);
        asm volatile("s_waitcnt lgkmcnt(4)" ::: "memory");
        __builtin_amdgcn_sched_barrier(0);
        G_MM(fa0, fa1, fb0, fb1);
        __builtin_amdgcn_sched_barrier(0);
        if (m + 1 < np) {
            asm volatile("s_waitcnt vmcnt(0) lgkmcnt(0)" ::: "memory");
            __builtin_amdgcn_s_barrier();
            if (m + 2 < np) { G_ISSUE(2 * m + 4); G_ISSUE(2 * m + 5); }
            G_RD(fa0, fa1, fb0, fb1, (2 * m + 2) & 3, 0);
        } else {
            asm volatile("s_waitcnt lgkmcnt(0)" ::: "memory");
        }
        __builtin_amdgcn_sched_barrier(0);
        G_MM(ga0, ga1, gb0, gb1);
        __builtin_amdgcn_sched_barrier(0);
    }
#undef G_RD
#undef G_MM
#undef G_ISSUE
}
template <class F>
__device__ __forceinline__ void acc_foreach4(const f32x16 (&acc)[2][2], F f) {
    const int lane = TIDX & 63, w = (TIDX >> 6) & 3, wr = w >> 1, wc = w & 1, lr = lane & 31, lh = lane >> 5;
#pragma unroll
    for (int mi = 0; mi < 2; ++mi)
#pragma unroll
        for (int ni = 0; ni < 2; ++ni)
#pragma unroll
            for (int g = 0; g < 4; ++g)
                f(wr * 64 + mi * 32 + lr, wc * 64 + ni * 32 + 8 * g + 4 * lh, acc[mi][ni][4 * g], acc[mi][ni][4 * g + 1], acc[mi][ni][4 * g + 2], acc[mi][ni][4 * g + 3]);
}
constexpr int C_LD = 132;
template <class F>
__device__ __forceinline__ void acc_foreach4_lds(const f32x16 (&acc)[2][2], unsigned char* lds, F f) {
    float* C = (float*)lds;
    const int t = TIDX, lane = t & 63, w = (t >> 6) & 3, wr = w >> 1, wc = w & 1, lr = lane & 31, lh = lane >> 5;
    __syncthreads();
#pragma unroll
    for (int mi = 0; mi < 2; ++mi)
#pragma unroll
        for (int ni = 0; ni < 2; ++ni)
#pragma unroll
            for (int g = 0; g < 4; ++g) {
                f32x4 v; v[0] = acc[mi][ni][4 * g]; v[1] = acc[mi][ni][4 * g + 1]; v[2] = acc[mi][ni][4 * g + 2]; v[3] = acc[mi][ni][4 * g + 3];
                *(f32x4*)(C + (wr * 64 + mi * 32 + lr) * C_LD + wc * 64 + ni * 32 + 8 * g + 4 * lh) = v;
            }
    __syncthreads();
#pragma unroll 8
    for (int i = 0; i < 16; ++i) {
        const int idx = t + 256 * i, r = idx >> 5, c = (idx & 31) * 4;
        const f32x4 v = *(const f32x4*)(C + r * C_LD + c);
        f(r, c, v[0], v[1], v[2], v[3]);
    }
}
constexpr float SLAB_SCALE = 32.f;
__device__ __forceinline__ unsigned pack4_fp8(float a, float b, float c, float d) {
    a = fminf(fmaxf(a * SLAB_SCALE, -448.f), 448.f); b = fminf(fmaxf(b * SLAB_SCALE, -448.f), 448.f);
    c = fminf(fmaxf(c * SLAB_SCALE, -448.f), 448.f); d = fminf(fmaxf(d * SLAB_SCALE, -448.f), 448.f);
    int w = __builtin_amdgcn_cvt_pk_fp8_f32(a, b, 0, false);
    w = __builtin_amdgcn_cvt_pk_fp8_f32(c, d, w, true);
    return (unsigned)w;
}
__device__ __forceinline__ uint2 pack4(float a, float b, float c, float d) { uint2 o; o.x = cvt_pk_bf16(a, b); o.y = cvt_pk_bf16(c, d); return o; }
struct ARowPlain { const bf16_t* A; int lda; __device__ __forceinline__ const bf16_t* operator()(int m) const { return A + (size_t)m * lda; } };

template <class Epi>
__device__ __forceinline__ void gemm_stage(const bf16_t* A, int lda, const bf16_t* Bt, int ldb, int M, int N, int K, Epi epi, unsigned char* lds) {
    const int tn = N / 128, tm = M / 128;
    int t_end, t_step;
    for (int tile = xcd_first(tm * tn, t_end, t_step); tile < t_end; tile += t_step) {
        const int m0 = (tile / tn) * 128, n0 = (tile % tn) * 128;
        f32x16 acc[2][2];
        gemm_tile(acc, ARowPlain{A + (size_t)m0 * lda, lda}, Bt + (size_t)n0 * ldb, ldb, K, lds);
        acc_foreach4_lds(acc, lds, [&](int r, int c, float v0, float v1, float v2, float v3) { epi(m0 + r, n0 + c, v0, v1, v2, v3); });
    }
}
template <class Epi>
__device__ __forceinline__ void gemm_stage_pre(const bf16_t* A, int lda, const bf16_t* Bt, int ldb, int M, int N, int K, Epi epi, unsigned char* lds) {
    const int tn = N / 128, tm = M / 128;
    int t_end, t_step;
    for (int tile = xcd_first(tm * tn, t_end, t_step); tile < t_end; tile += t_step) {
        const int m0 = (tile / tn) * 128, n0 = (tile % tn) * 128;
        f32x4 pre[16];
        { const int t = TIDX;
#pragma unroll
          for (int i = 0; i < 16; ++i) { const int idx = t + 256 * i; pre[i] = epi.prefetch(m0 + (idx >> 5), n0 + (idx & 31) * 4); } }
        f32x16 acc[2][2];
        gemm_tile(acc, ARowPlain{A + (size_t)m0 * lda, lda}, Bt + (size_t)n0 * ldb, ldb, K, lds);
        float* C = (float*)lds;
        const int t = TIDX, lane = t & 63, w = (t >> 6) & 3, wr = w >> 1, wc = w & 1, lr = lane & 31, lh = lane >> 5;
        __syncthreads();
#pragma unroll
        for (int mi = 0; mi < 2; ++mi)
#pragma unroll
            for (int ni = 0; ni < 2; ++ni)
#pragma unroll
                for (int g = 0; g < 4; ++g) {
                    f32x4 v; v[0] = acc[mi][ni][4 * g]; v[1] = acc[mi][ni][4 * g + 1]; v[2] = acc[mi][ni][4 * g + 2]; v[3] = acc[mi][ni][4 * g + 3];
                    *(f32x4*)(C + (wr * 64 + mi * 32 + lr) * C_LD + wc * 64 + ni * 32 + 8 * g + 4 * lh) = v;
                }
        __syncthreads();
#pragma unroll
        for (int i = 0; i < 16; ++i) {
            const int idx = t + 256 * i, r = idx >> 5, c = (idx & 31) * 4;
            const f32x4 v = *(const f32x4*)(C + r * C_LD + c);
            epi.with_pre(m0 + r, n0 + c, v[0], v[1], v[2], v[3], pre[i]);
        }
    }
}
struct TrDesc { const float* src; size_t sk; bf16_t* dst; size_t dld; };
__device__ __forceinline__ void tr_item2(const TrDesc& d0, const TrDesc& d1, bool has1, bf16_t* tl) {
    const int t = TIDX, kr = t >> 3, nq = (t & 7) * 4;
    f32x4 v0[4], v1[4];
#pragma unroll
    for (int ps = 0; ps < 4; ++ps) v0[ps] = *(const f32x4*)(d0.src + (size_t)(kr + 32 * ps) * d0.sk + nq);
    if (has1) {
#pragma unroll
        for (int ps = 0; ps < 4; ++ps) v1[ps] = *(const f32x4*)(d1.src + (size_t)(kr + 32 * ps) * d1.sk + nq);
    }
    __syncthreads();
#pragma unroll
    for (int ps = 0; ps < 4; ++ps)
#pragma unroll
        for (int j = 0; j < 4; ++j) tl[(nq + j) * 136 + kr + 32 * ps] = f2bf(v0[ps][j]);
    if (has1) {
#pragma unroll
        for (int ps = 0; ps < 4; ++ps)
#pragma unroll
            for (int j = 0; j < 4; ++j) tl[32 * 136 + (nq + j) * 136 + kr + 32 * ps] = f2bf(v1[ps][j]);
    }
    __syncthreads();
    const int n = t >> 3, part = t & 7;
    { const u32x4 a = *(const u32x4*)(tl + n * 136 + part * 16), b = *(const u32x4*)(tl + n * 136 + part * 16 + 8);
      bf16_t* o = d0.dst + (size_t)n * d0.dld + part * 16; *(u32x4*)o = a; *(u32x4*)(o + 8) = b; }
    if (has1) { const u32x4 a = *(const u32x4*)(tl + 32 * 136 + n * 136 + part * 16), b = *(const u32x4*)(tl + 32 * 136 + n * 136 + part * 16 + 8);
      bf16_t* o = d1.dst + (size_t)n * d1.dld + part * 16; *(u32x4*)o = a; *(u32x4*)(o + 8) = b; }
}
constexpr int PW_IN = 1, PW_OUT = 2, PW_GLU = 4, PW_GU = 8, PW_DN = 16, PW_ALL = 31;
__device__ __forceinline__ TrDesc prep_desc(const P& p, int l, int part, int r) {
    if (part == PW_IN) { const int nt = r >> 3, kt = r & 7; return TrDesc{p.in[I_WIN] + (size_t)l * D * DIN + (size_t)kt * 128 * DIN + nt * 32, DIN, (bf16_t*)(p.ws + WS_WTIN) + (size_t)nt * 32 * D + kt * 128, D}; }
    if (part == PW_OUT) { const int nt = r >> 3, kt = r & 7; return TrDesc{p.in[I_WOUT] + (size_t)l * D * D + (size_t)kt * 128 * D + nt * 32, D, (bf16_t*)(p.ws + WS_WTOUT) + (size_t)nt * 32 * D + kt * 128, D}; }
    if (part == PW_GLU) { const int nt = r >> 1, kt = r & 1; return TrDesc{p.in[I_WGLU] + (size_t)l * DSSM * DSSM + (size_t)kt * 128 * DSSM + nt * 32, DSSM, (bf16_t*)(p.ws + WS_WTGLU) + (size_t)nt * 32 * DSSM + kt * 128, DSSM}; }
    if (part == PW_GU) {
        const int kt = r & 7, q = (r >> 3) & 3, j = (r >> 5) & 1, e = r >> 6;
        const int wc = q >> 1, ni = q & 1, unit0 = j * 64 + wc * 32;
        const float* sp; size_t sk;
        if (e < NE) { sp = p.in[ni ? I_WEU : I_WEG] + ((size_t)(l * D + kt * 128) * NE + e) * DE + unit0; sk = (size_t)NE * DE; }
        else { sp = p.in[ni ? I_WSU : I_WSG] + (size_t)(l * D + kt * 128) * DE + unit0; sk = DE; }
        return TrDesc{sp, sk, (bf16_t*)(p.ws + WS_WGU) + ((size_t)(e * 2 + j) * 128 + q * 32) * D + kt * 128, D};
    }
    {
        const int nt = r & 31, e = r >> 5;
        const float* sp = (e < NE ? p.in[I_WED] + (size_t)(l * NE + e) * DE * D : p.in[I_WSD] + (size_t)l * DE * D) + nt * 32;
        return TrDesc{sp, D, (bf16_t*)(p.ws + WS_WD) + ((size_t)e * D + nt * 32) * DE, DE};
    }
}
__device__ __forceinline__ void st_prep_weights(const P& p, int l, unsigned char* lds, int parts) {
    bf16_t* tl = (bf16_t*)lds;
    constexpr int N_IN_ = (DIN / 32) * 8, N_OUT = (D / 32) * 8, N_GLU = (DSSM / 32) * 2, N_GU = 33 * 2 * 4 * 8, N_DN = 33 * (D / 32);
    const int cnts[5] = {N_IN_, N_OUT, N_GLU, N_GU, N_DN};
#pragma unroll
    for (int pi = 0; pi < 5; ++pi) {
        const int part = 1 << pi;
        if (!(parts & part)) continue;
        const int G = gridDim.x;
        for (int r = BIDX; r < cnts[pi]; r += 2 * G) {
            const bool has1 = r + G < cnts[pi];
            const TrDesc d0 = prep_desc(p, l, part, r), d1 = prep_desc(p, l, part, has1 ? r + G : r);
            tr_item2(d0, d1, has1, tl);
        }
    }
    __syncthreads();
}
struct EpiStoreBf { bf16_t* C; int ldc; __device__ __forceinline__ void operator()(int r, int c, float v0, float v1, float v2, float v3) const { *(uint2*)(C + (size_t)r * ldc + c) = pack4(v0, v1, v2, v3); } };


__device__ __forceinline__ void st_rbias(const P& p, int l, float* lds) {
    const int lane = TIDX & 63, w = TIDX >> 6;
    const float* rw = p.in[I_RW] + (size_t)l * D * NE;
    for (int o = BIDX * 4 + w; o < 9 * 32; o += gridDim.x * 4) {
        const int bb = o >> 5, e = o & 31;
        const float* sh2 = mod_vec(p, l, bb, 3);
        float a = 0.f;
#pragma unroll
        for (int j = 0; j < 16; ++j) { const int k = j * 64 + lane; a += sh2[k] * rw[(size_t)k * NE + e]; }
        a = wave_sum(a);
        if (lane == 0) ((float*)(p.ws + WS_RBIAS))[(l * 9 + bb) * 32 + e] = a;
    }
    const float* g2 = p.in[I_N2G] + l * D;
    for (int idx = BIDX * NT + TIDX; idx < 9 * D; idx += gridDim.x * NT) {
        const int bb = idx >> 10, k = idx & (D - 1);
        ((float*)(p.ws + WS_GS2))[(size_t)(l * 9 + bb) * D + k] = g2[k] * (1.f + mod_vec(p, l, bb, 4)[k]);
    }
}
template <bool DRY = false>
__device__ __forceinline__ void st_router2(const P& p, int l, unsigned char* ldsb) {
    float* part = (float*)ldsb;
    float* ssq = part + 4 * 32 * 33;
    float* sc = ssq + 128;
    float* rinvs = sc + 32 * 33;
    int* hist = (int*)(rinvs + 32);
    int* gbase = hist + 32;
    const int t = TIDX, lane = t & 63, w = t >> 6, i = lane & 31, hf = lane >> 5;
    const int nrows = l == 0 ? TA : TL;
    const float* rw = p.in[I_RW] + (size_t)l * D * NE;
    int* cnt = CNT_PTR(p, l);
    int* lcode = (int*)(p.ws + WS_LCODE);
    float* lw = (float*)(p.ws + WS_LW);
    bf16_t* xn2 = (bf16_t*)(p.ws + WS_BUFA);
    for (int item = BIDX; item < nrows / 32; item += gridDim.x) {
        const int r0 = item * 32, bb = row_bb(r0);
        const float* gs2 = (const float*)(p.ws + WS_GS2) + (size_t)(l * 9 + bb) * D;
        const float* sh2 = mod_vec(p, l, bb, 3);
        const int kb = w * 256 + hf * 128;
        const float* src = hmid_row(p, r0 + i) + kb;
        const float* gsp = gs2 + kb;
        const float* rwp = rw + (size_t)kb * NE + i;
        f32x16 acc;
        float zf = 0.f; asm volatile("" : "+v"(zf));
#pragma unroll
        for (int r = 0; r < 16; ++r) acc[r] = zf;
        float ss = 0.f;
        f32x4 xa[4], ga[4], xb[4], gb[4]; float wa[16], wb[16];
#define R_LOAD(X, G, W, cb) do { _Pragma("unroll") for (int q = 0; q < 4; ++q) { const int k = ((cb) * 4 + q) * 4; X[q] = *(const f32x4*)(src + k); G[q] = *(const f32x4*)(gsp + k); \
            _Pragma("unroll") for (int j = 0; j < 4; ++j) W[q * 4 + j] = rwp[(size_t)(k + j) * NE]; } } while (0)
#define R_COMP(X, G, W) do { _Pragma("unroll") for (int q = 0; q < 4; ++q) { ss += X[q][0] * X[q][0] + X[q][1] * X[q][1] + X[q][2] * X[q][2] + X[q][3] * X[q][3]; \
            _Pragma("unroll") for (int j = 0; j < 4; ++j) acc = __builtin_amdgcn_mfma_f32_32x32x2f32(X[q][j] * G[q][j], W[q * 4 + j], acc, 0, 0, 0); } } while (0)
        R_LOAD(xa, ga, wa, 0);
#pragma unroll 1
        for (int cb = 0; cb < 8; cb += 2) {
            R_LOAD(xb, gb, wb, cb + 1);
            R_COMP(xa, ga, wa);
            if (cb + 2 < 8) R_LOAD(xa, ga, wa, cb + 2);
            R_COMP(xb, gb, wb);
        }
#undef R_LOAD
#undef R_COMP
        ss += __shfl_xor(ss, 32);
        __syncthreads();
        if (hf == 0) ssq[w * 32 + i] = ss;
        if (t < 32) hist[t] = 0;
#pragma unroll
        for (int r = 0; r < 16; ++r) part[(w * 32 + (r & 3) + 8 * (r >> 2) + 4 * hf) * 33 + i] = acc[r];
        __syncthreads();
        for (int idx = t; idx < 1024; idx += NT) {
            const int row = idx >> 5, e = idx & 31;
            const float logit = part[(0 * 32 + row) * 33 + e] + part[(1 * 32 + row) * 33 + e] + part[(2 * 32 + row) * 33 + e] + part[(3 * 32 + row) * 33 + e];
            const float rinv = rsqrtf((ssq[row] + ssq[32 + row] + ssq[64 + row] + ssq[96 + row]) * (1.f / D) + 1e-6f);
            sc[row * 33 + e] = sigmoid_f(rinv * logit + ((const float*)(p.ws + WS_RBIAS))[(l * 9 + bb) * 32 + e]);
            if (e == 0) rinvs[row] = rinv;
        }
        __syncthreads();
        if (t < 32) {
            const int r = r0 + t;
            float sel[32];
#pragma unroll
            for (int e = 0; e < 32; ++e) sel[e] = sc[t * 33 + e] + p.in[I_RB][l * NE + e];
            int bi[4]; float sv[4]; float sum = 0.f;
#pragma unroll
            for (int k = 0; k < 4; ++k) {
                float best = -1e30f; int b = 0;
#pragma unroll
                for (int e = 0; e < 32; ++e) if (sel[e] > best) { best = sel[e]; b = e; }
#pragma unroll
                for (int e = 0; e < 32; ++e) if (e == b) sel[e] = -1e30f;
                bi[k] = b; sv[k] = sc[t * 33 + b]; sum += sv[k];
            }
            int rank[4];
#pragma unroll
            for (int k = 0; k < 4; ++k) rank[k] = atomicAdd(&hist[bi[k]], 1);
            __builtin_amdgcn_s_waitcnt(0xc07f);
            __builtin_amdgcn_wave_barrier();
            { const int hc = hist[t]; gbase[t] = (hc > 0 && !DRY) ? atomicAdd(&cnt[t * 64], hc) : 0; }
            __builtin_amdgcn_s_waitcnt(0xc07f);
            __builtin_amdgcn_wave_barrier();
#pragma unroll
            for (int k = 0; k < 4; ++k) {
                if (DRY) { if (sv[k] / sum == 12345.f) lw[0] = 0.f; } else {
                const int pos = gbase[bi[k]] + rank[k];
                lcode[(size_t)bi[k] * TA + pos] = r * 4 + k;
                lw[(size_t)bi[k] * TA + pos] = sv[k] / sum * 2.5f; }
            }
        }
        {
            float gs[16], sh[16];
#pragma unroll
            for (int q = 0; q < 16; ++q) { const int k = (q >> 3) * 512 + 8 * lane + (q & 7); gs[q] = gs2[k]; sh[q] = sh2[k]; }
            for (int rr8 = 0; rr8 < 8; rr8 += 4) {
                f32x4 xv[4][4];
#pragma unroll
                for (int u = 0; u < 4; ++u) {
                    const float* s2 = hmid_row(p, r0 + w * 8 + rr8 + u);
#pragma unroll
                    for (int h2 = 0; h2 < 2; ++h2) { xv[u][2 * h2] = *(const f32x4*)(s2 + h2 * 512 + 8 * lane); xv[u][2 * h2 + 1] = *(const f32x4*)(s2 + h2 * 512 + 8 * lane + 4); }
                }
#pragma unroll
                for (int u = 0; u < 4; ++u) {
                    const int rho = w * 8 + rr8 + u;
                    const float rr = rinvs[rho];
                    bf16_t* dst = xn2 + (size_t)(r0 + rho) * D;
#pragma unroll
                    for (int h2 = 0; h2 < 2; ++h2) {
                        const f32x4 x0 = xv[u][2 * h2], x1 = xv[u][2 * h2 + 1];
                        u32x4 o;
                        o[0] = cvt_pk_bf16(x0[0] * rr * gs[h2 * 8 + 0] + sh[h2 * 8 + 0], x0[1] * rr * gs[h2 * 8 + 1] + sh[h2 * 8 + 1]);
                        o[1] = cvt_pk_bf16(x0[2] * rr * gs[h2 * 8 + 2] + sh[h2 * 8 + 2], x0[3] * rr * gs[h2 * 8 + 3] + sh[h2 * 8 + 3]);
                        o[2] = cvt_pk_bf16(x1[0] * rr * gs[h2 * 8 + 4] + sh[h2 * 8 + 4], x1[1] * rr * gs[h2 * 8 + 5] + sh[h2 * 8 + 5]);
                        o[3] = cvt_pk_bf16(x1[2] * rr * gs[h2 * 8 + 6] + sh[h2 * 8 + 6], x1[3] * rr * gs[h2 * 8 + 7] + sh[h2 * 8 + 7]);
                        *(u32x4*)(dst + h2 * 512 + 8 * lane) = o;
                    }
                }
            }
        }
    }
    __syncthreads();
}

constexpr int LDS_CSTAGE = 128 * C_LD * 4;
constexpr int M2_A = 0, M2_B = 32768, M2_C = 57344, M2_CLD = 144;
constexpr int MOE_LDS_LIST = M2_C + 128 * M2_CLD;
constexpr int LDS_MOE = MOE_LDS_LIST + 128 * 4 + 128 * 4 + 64 * 4;
constexpr int LDS_MODB = (9 * D + 9 * 8 * 32) * 4;
constexpr int LDS_TOTAL = LDS_MOE > LDS_MODB ? LDS_MOE : LDS_MODB;
struct ARowCode { const bf16_t* base; const int* codes; int mode; __device__ __forceinline__ const bf16_t* operator()(int m) const {
    const int c = codes[m];
    if (mode == 0) return base + (size_t)(c < 0 ? 0 : (c >> 2)) * D;
    return base + (size_t)(c < 0 ? 0 : (c >> 2) * 5 + (c & 3)) * DE; } };
__device__ __forceinline__ void moe_tstart(const P& p, int l, int* ts) {
    if (TIDX == 0) { const int* cnt = CNT_PTR(p, l); int a = 0; for (int e = 0; e < NE; ++e) { ts[e] = a; a += (cnt[e * 64] + 127) >> 7; } ts[NE] = a; }
    __syncthreads();
}
__device__ __forceinline__ void st_moe1(const P& p, int l, unsigned char* lds) {
    int* codes = (int*)(lds + MOE_LDS_LIST); float* wts = (float*)(codes + 128); int* ts = (int*)(wts + 128);
    const int nrows = l == 0 ? TA : TL;
    const int* cnt = CNT_PTR(p, l);
    const int* lcode = (const int*)(p.ws + WS_LCODE);
    const float* lw = (const float*)(p.ws + WS_LW);
    const bf16_t* xn2 = (const bf16_t*)(p.ws + WS_BUFA);
    bf16_t* hid = (bf16_t*)(p.ws + WS_HID);
    const bf16_t* wgu = (const bf16_t*)(p.ws + WS_WGU);
    moe_tstart(p, l, ts);
    const int nrt = ts[NE], nsh = nrows / 128, total = (nrt + nsh) * 2;
    const int lane = TIDX & 63, w = TIDX >> 6, wr = w >> 1, wc = w & 1, lr = lane & 31, lh = lane >> 5;
    int t_end, t_step;
    for (int tile = xcd_first(total, t_end, t_step); tile < t_end; tile += t_step) {
        const int rt = tile >> 1, j = tile & 1;
        int e, m0, valid;
        if (rt < nrt) { e = 0; while (ts[e + 1] <= rt) ++e; m0 = (rt - ts[e]) * 128; valid = cnt[e * 64] - m0; if (valid > 128) valid = 128; }
        else { e = NE; m0 = (rt - nrt) * 128; valid = 128; }
        __syncthreads();
        if (TIDX < 128) {
            const int m = TIDX;
            if (e < NE) { const bool ok = m < valid; codes[m] = ok ? lcode[(size_t)e * TA + m0 + m] : -1; wts[m] = ok ? lw[(size_t)e * TA + m0 + m] : 0.f; }
            else { codes[m] = (m0 + m) * 4; wts[m] = 1.f; }
        }
        __syncthreads();
        f32x16 acc[2][2];
        gemm_tile(acc, ARowCode{xn2, codes, 0}, wgu + (size_t)((e * 2 + j) * 128) * D, D, D, lds);
#pragma unroll
        for (int mi = 0; mi < 2; ++mi) {
            const int m = wr * 64 + mi * 32 + lr;
            const int c = codes[m];
            if (c >= 0) {
                const float wt = wts[m];
                const size_t hrow = e < NE ? (size_t)(c >> 2) * 5 + (c & 3) : (size_t)(c >> 2) * 5 + 4;
#pragma unroll
                for (int g = 0; g < 4; ++g) {
                    float h[4];
#pragma unroll
                    for (int q = 0; q < 4; ++q) h[q] = silu_f(acc[mi][0][4 * g + q]) * acc[mi][1][4 * g + q] * wt;
                    *(uint2*)(hid + hrow * DE + j * 64 + wc * 32 + 8 * g + 4 * lh) = pack4(h[0], h[1], h[2], h[3]);
                }
            }
        }
    }
}
__device__ __forceinline__ void st_moe2(const P& p, int l, unsigned char* lds) {
    int* codes = (int*)(lds + MOE_LDS_LIST); float* wts = (float*)(codes + 128); int* ts = (int*)(wts + 128);
    const int* cnt = CNT_PTR(p, l);
    const int* lcode = (const int*)(p.ws + WS_LCODE);
    const bf16_t* hid = (const bf16_t*)(p.ws + WS_HID);
    unsigned char* slab = (unsigned char*)(p.ws + WS_SLAB);
    const bf16_t* wd = (const bf16_t*)(p.ws + WS_WD);
    moe_tstart(p, l, ts);
    const int nrt = ts[NE], total = nrt * 8;
    int t_end, t_step;
    for (int tile = xcd_first(total, t_end, t_step); tile < t_end; tile += t_step) {
        const int rt = tile >> 3, n0 = (tile & 7) * 128;
        int e = 0; while (ts[e + 1] <= rt) ++e;
        const int m0 = (rt - ts[e]) * 128; int valid = cnt[e * 64] - m0; if (valid > 128) valid = 128;
        __syncthreads();
        if (TIDX < 128) { const int m = TIDX; codes[m] = m < valid ? lcode[(size_t)e * TA + m0 + m] : -1; }
        __syncthreads();
        f32x16 acc[2][2];
        gemm_tile(acc, ARowCode{hid, codes, 1}, wd + ((size_t)e * D + n0) * DE, DE, DE, lds);
        acc_foreach4_lds(acc, lds, [&](int r, int c, float v0, float v1, float v2, float v3) { const int code = codes[r]; if (code >= 0) *(unsigned*)(slab + (size_t)code * D + n0 + c) = pack4_fp8(v0, v1, v2, v3); });
    }
}
constexpr int M2_NPER = 4;
__device__ __forceinline__ void st_moe2s(const P& p, int l, unsigned char* lds) {
    int* codes = (int*)(lds + MOE_LDS_LIST); float* wts = (float*)(codes + 128); int* ts = (int*)(wts + 128);
    const int* cnt = CNT_PTR(p, l);
    const int* lcode = (const int*)(p.ws + WS_LCODE);
    const bf16_t* hid = (const bf16_t*)(p.ws + WS_HID);
    unsigned char* slab = (unsigned char*)(p.ws + WS_SLAB);
    const bf16_t* wd = (const bf16_t*)(p.ws + WS_WD);
    moe_tstart(p, l, ts);
    constexpr int NSP = 8 / M2_NPER, S = 4 * M2_NPER;
    const int nrt = ts[NE], total = nrt * NSP;
    const int t = TIDX, lane = t & 63, w = __builtin_amdgcn_readfirstlane(t >> 6), wr = w >> 1, wc = w & 1, lr = lane & 31, lh = lane >> 5;
    const int srow = t >> 2, lc = (t & 3) ^ ((srow >> 2) & 3);
    const int f = (lr >> 2) & 3;
    const int aoff = (wr * 64 + lr) * 64 + ((lh ^ f) << 4), boff = (wc * 64 + lr) * 64 + ((lh ^ f) << 4);
    LAS unsigned char* l3 = (LAS unsigned char*)lds;
    int t_end, t_step;
    for (int item = xcd_first(total, t_end, t_step); item < t_end; item += t_step) {
        const int rt = item / NSP, n0 = (item % NSP) * (128 * M2_NPER);
        int e = 0; while (ts[e + 1] <= rt) ++e;
        const int m0 = (rt - ts[e]) * 128; int valid = cnt[e * 64] - m0; if (valid > 128) valid = 128;
        __syncthreads();
        if (t < 128) codes[t] = t < valid ? lcode[(size_t)e * TA + m0 + t] : -1;
        __syncthreads();
        const bf16_t* ap[2]; const bf16_t* bp[2];
#pragma unroll
        for (int i = 0; i < 2; ++i) {
            const int c = codes[srow + 64 * i];
            ap[i] = hid + (size_t)(c < 0 ? 0 : (c >> 2) * 5 + (c & 3)) * DE + lc * 8;
            bp[i] = wd + ((size_t)e * D + n0 + srow + 64 * i) * DE + lc * 8;
        }
#pragma unroll
        for (int ks = 0; ks < 4; ++ks) {
            __builtin_amdgcn_global_load_lds((const unsigned*)(ap[0] + ks * 32), (LAS unsigned*)(l3 + M2_A + ks * 8192 + w * 1024), 16, 0, 0);
            __builtin_amdgcn_global_load_lds((const unsigned*)(ap[1] + ks * 32), (LAS unsigned*)(l3 + M2_A + ks * 8192 + w * 1024 + 4096), 16, 0, 0);
        }
#define M2_ISSUE(s_) do { const int nt_ = (s_) >> 2, ks_ = (s_) & 3; LAS unsigned char* d_ = l3 + M2_B + ((s_) % 3) * 8192 + w * 1024; \
        __builtin_amdgcn_global_load_lds((const unsigned*)(bp[0] + (size_t)nt_ * 128 * DE + ks_ * 32), (LAS unsigned*)(d_), 16, 0, 0); \
        __builtin_amdgcn_global_load_lds((const unsigned*)(bp[1] + (size_t)nt_ * 128 * DE + ks_ * 32), (LAS unsigned*)(d_ + 4096), 16, 0, 0); } while (0)
        M2_ISSUE(0); M2_ISSUE(1);
        f32x16 acc[2][2];
        float zf = 0.f; asm volatile("" : "+v"(zf));
#pragma unroll
        for (int mi = 0; mi < 2; ++mi)
#pragma unroll
            for (int ni = 0; ni < 2; ++ni)
#pragma unroll
                for (int r = 0; r < 16; ++r) acc[mi][ni][r] = zf;
#pragma unroll 1
        for (int s = 0; s < S; ++s) {
            if (s + 1 < S) asm volatile("s_waitcnt vmcnt(2) lgkmcnt(0)" ::: "memory"); else asm volatile("s_waitcnt vmcnt(0) lgkmcnt(0)" ::: "memory");
            __builtin_amdgcn_s_barrier();
            if (s + 2 < S) M2_ISSUE(s + 2);
            const int ks = s & 3;
            const LAS unsigned char* ca = l3 + M2_A + ks * 8192;
            const LAS unsigned char* cb = l3 + M2_B + (s % 3) * 8192;
#pragma unroll
            for (int s2 = 0; s2 < 2; ++s2) {
                const bf16x8 a0 = *(const LAS bf16x8*)(ca + (aoff ^ (s2 << 5))), a1 = *(const LAS bf16x8*)(ca + ((aoff + 2048) ^ (s2 << 5)));
                const bf16x8 b0 = *(const LAS bf16x8*)(cb + (boff ^ (s2 << 5))), b1 = *(const LAS bf16x8*)(cb + ((boff + 2048) ^ (s2 << 5)));
                acc[0][0] = __builtin_amdgcn_mfma_f32_32x32x16_bf16(b0, a0, acc[0][0], 0, 0, 0);
                acc[0][1] = __builtin_amdgcn_mfma_f32_32x32x16_bf16(b1, a0, acc[0][1], 0, 0, 0);
                acc[1][0] = __builtin_amdgcn_mfma_f32_32x32x16_bf16(b0, a1, acc[1][0], 0, 0, 0);
                acc[1][1] = __builtin_amdgcn_mfma_f32_32x32x16_bf16(b1, a1, acc[1][1], 0, 0, 0);
            }
            if (ks == 3) {
                const int nt = s >> 2;
#pragma unroll
                for (int mi = 0; mi < 2; ++mi)
#pragma unroll
                    for (int ni = 0; ni < 2; ++ni)
#pragma unroll
                        for (int g = 0; g < 4; ++g) {
                            *(unsigned*)(lds + M2_C + (wr * 64 + mi * 32 + lr) * M2_CLD + wc * 64 + ni * 32 + 8 * g + 4 * lh) =
                                pack4_fp8(acc[mi][ni][4 * g], acc[mi][ni][4 * g + 1], acc[mi][ni][4 * g + 2], acc[mi][ni][4 * g + 3]);
                            acc[mi][ni][4 * g] = zf; acc[mi][ni][4 * g + 1] = zf; acc[mi][ni][4 * g + 2] = zf; acc[mi][ni][4 * g + 3] = zf;
                        }
                asm volatile("s_waitcnt lgkmcnt(0)" ::: "memory");
                __builtin_amdgcn_s_barrier();
#pragma unroll
                for (int i = 0; i < 4; ++i) {
                    const int ch = t + 256 * i, r = ch >> 3, c16 = (ch & 7) * 16;
                    const int code = codes[r];
                    const u32x4 v = *(const u32x4*)(lds + M2_C + r * M2_CLD + c16);
                    if (code >= 0) *(u32x4*)(slab + (size_t)code * D + n0 + nt * 128 + c16) = v;
                }
            }
        }
#undef M2_ISSUE
    }
    __syncthreads();
}
struct EpiMoeF { const unsigned char* slab; const float* modl; float* out; const float* hcmid; float* hc1; bool outw = true;
    __device__ __forceinline__ void operator()(int r, int c, float v0, float v1, float v2, float v3) const {
    const unsigned char* sl = slab + (size_t)r * 4 * D + c;
    float v[4] = {v0, v1, v2, v3};
    float a[4] = {0.f, 0.f, 0.f, 0.f};
#pragma unroll
    for (int k = 0; k < 4; ++k) { const int q = (int)*(const unsigned*)(sl + (size_t)k * D);
        a[0] += __builtin_amdgcn_cvt_f32_fp8(q, 0); a[1] += __builtin_amdgcn_cvt_f32_fp8(q, 1); a[2] += __builtin_amdgcn_cvt_f32_fp8(q, 2); a[3] += __builtin_amdgcn_cvt_f32_fp8(q, 3); }
#pragma unroll
    for (int q = 0; q < 4; ++q) v[q] += a[q] * (1.f / SLAB_SCALE);
    const f32x4 g2 = *(const f32x4*)(modl + ((size_t)row_bb(r) * 6 + 5) * D + c);
    const f32x4 hm = *(const f32x4*)((r < TL ? out + (size_t)r * D : hcmid + (size_t)(r - TL) * D) + c);
    f32x4 o; o[0] = hm[0] + g2[0] * v[0]; o[1] = hm[1] + g2[1] * v[1]; o[2] = hm[2] + g2[2] * v[2]; o[3] = hm[3] + g2[3] * v[3];
    if (outw) *(f32x4*)((r < TL ? out + (size_t)r * D : hc1 + (size_t)(r - TL) * D) + c) = o;
    else if (o[0] == 12345.f) *(f32x4*)(hc1) = o; } };
__device__ __forceinline__ EpiMoeF make_epi_moef(const P& p, int l) {
    return EpiMoeF{(const unsigned char*)(p.ws + WS_SLAB), (const float*)(p.ws + WS_MOD) + (size_t)l * 9 * 6 * D, p.out, (const float*)(p.ws + WS_HCMID), (float*)(p.ws + WS_HC1)};
}
struct SsmPar { float lre, lim, dt; };
__device__ __forceinline__ SsmPar ssm_par(const P& p, int l, int dir, int g, int pp) {
    const int pi = ((l * 2 + dir) * SG + g) * SP + pp;
    SsmPar r; r.lre = p.in[I_LRE][pi]; r.lim = p.in[I_LIM][pi]; r.dt = expf(p.in[I_LDT][(l * 2 + dir) * SG + g]); return r;
}
__device__ __forceinline__ float2 ssm_pow(const SsmPar& q, float e) {
    const float mag = expf(e * q.lre * q.dt), ang = e * (q.lim * q.dt);
    return make_float2(mag * cosf(ang), mag * sinf(ang));
}
__device__ __forceinline__ float2 ssm_f(const SsmPar& q) {
    const float2 lb = ssm_pow(q, 1.f);
    const float nr = lb.x - 1.f, ni = lb.y, den = q.lre * q.lre + q.lim * q.lim;
    return make_float2((nr * q.lre + ni * q.lim) / den, (ni * q.lre - nr * q.lim) / den);
}
__device__ __forceinline__ float2 cmul(float2 a, float2 b) { return make_float2(a.x * b.x - a.y * b.y, a.x * b.y + a.y * b.x); }
__device__ __forceinline__ void st_ssm_tables(const P& p) {
    float2* pw = (float2*)(p.ws + WS_POW); float2* fb = (float2*)(p.ws + WS_FB);
    for (int idx = BIDX * NT + TIDX; idx < 2 * 2 * 16 * 33 * 64; idx += gridDim.x * NT) {
        const int pp = idx & 63; int q_ = idx >> 6; const int e = q_ % 33; q_ /= 33; const int g = q_ & 15, dir = (q_ >> 4) & 1, l = q_ >> 5;
        pw[idx] = ssm_pow(ssm_par(p, l, dir, g, pp), (float)e);
    }
    for (int idx = BIDX * NT + TIDX; idx < 2 * 2 * 16 * 64 * 16; idx += gridDim.x * NT) {
        const int h = idx & 15, pp = (idx >> 4) & 63, g = (idx >> 10) & 15, dir = (idx >> 14) & 1, l = idx >> 15;
        const size_t bi = ((size_t)((l * 2 + dir) * SG + g) * SP + pp) * 16 + h;
        fb[idx] = cmul(ssm_f(ssm_par(p, l, dir, g, pp)), make_float2(p.in[I_BRE][bi], p.in[I_BIM][bi]));
    }
}
__device__ __forceinline__ void st_ssm_kj(const P& p, float* lds) {
    float* lam = lds; float* Cc = lds + 128; float* Bb = Cc + 2048;
    float* kj = (float*)(p.ws + WS_KJ);
    const int t = TIDX;
    for (int item = (int)gridDim.x - 1 - BIDX; item < 64; item += gridDim.x) {
        const int l = item >> 5, g = (item >> 1) & 15, dir = item & 1;
        const int base = (l * 2 + dir) * SG + g;
        __syncthreads();
        if (t < 64) {
            const SsmPar q = ssm_par(p, l, dir, g, t);
            const float2 lb = ssm_pow(q, 1.f), f = ssm_f(q);
            lam[2 * t] = lb.x; lam[2 * t + 1] = lb.y;
            for (int h = 0; h < 16; ++h) {
                const size_t bi = ((size_t)base * SP + t) * 16 + h;
                const float2 bb = cmul(f, make_float2(p.in[I_BRE][bi], p.in[I_BIM][bi]));
                Bb[(t * 16 + h) * 2] = bb.x; Bb[(t * 16 + h) * 2 + 1] = bb.y;
            }
        }
        for (int i = t; i < 1024; i += NT) { const size_t ci = (size_t)base * 1024 + i; Cc[2 * i] = p.in[I_CRE][ci]; Cc[2 * i + 1] = p.in[I_CIM][ci]; }
        __syncthreads();
        const int ho = t >> 4, hi = t & 15;
        float acc[32];
#pragma unroll
        for (int j = 0; j < 32; ++j) acc[j] = 0.f;
        for (int pp = 0; pp < 64; ++pp) {
            float2 z = cmul(make_float2(Cc[(ho * 64 + pp) * 2], Cc[(ho * 64 + pp) * 2 + 1]), make_float2(Bb[(pp * 16 + hi) * 2], Bb[(pp * 16 + hi) * 2 + 1]));
            const float2 lb = make_float2(lam[2 * pp], lam[2 * pp + 1]);
#pragma unroll
            for (int j = 0; j < 32; ++j) { acc[j] += z.x; z = cmul(z, lb); }
        }
#pragma unroll
        for (int j = 0; j < 32; ++j) kj[((size_t)((l * 16 + g) * 2 + dir) * 32 + j) * 256 + ho * 16 + hi] = acc[j];
    }
    __syncthreads();
}
__device__ __forceinline__ void st_prep_ssm(const P& p, int l, int parts) {
    bf16_t* wst = (bf16_t*)(p.ws + WS_WST);
    if (parts & 1) for (int idx = BIDX * NT + TIDX; idx < 16 * 256 * 64; idx += gridDim.x * NT) {
        const int kc = idx & 63, n = (idx >> 6) & 255, g = idx >> 14;
        const int dir = n >> 7, c = (n >> 6) & 1, pp = n & 63, s = kc >> 1, h0 = (kc & 1) * 8;
        const int ldg = (l * 2 + dir) * 16 + g;
        const float2 coef = ((const float2*)(p.ws + WS_POW))[((size_t)ldg * 33 + (dir == 0 ? 31 - s : s)) * 64 + pp];
        const float2* fbp = (const float2*)(p.ws + WS_FB) + ((size_t)ldg * 64 + pp) * 16 + h0;
        float v[8];
#pragma unroll
        for (int j = 0; j < 8; ++j) { const float2 z = cmul(coef, fbp[j]); v[j] = c == 0 ? z.x : z.y; }
        u32x4 o; o[0] = cvt_pk_bf16(v[0], v[1]); o[1] = cvt_pk_bf16(v[2], v[3]); o[2] = cvt_pk_bf16(v[4], v[5]); o[3] = cvt_pk_bf16(v[6], v[7]);
        *(u32x4*)(wst + ((size_t)(g * 256 + n)) * 512 + kc * 8) = o;
    }
    bf16_t* kw = (bf16_t*)(p.ws + WS_KW);
    const float* kj = (const float*)(p.ws + WS_KJ);
    if (parts & 2) for (int idx = BIDX * NT + TIDX; idx < 16 * 512 * 96; idx += gridDim.x * NT) {
        const int kc = idx % 96, n = (idx / 96) & 511, g = idx / (96 * 512);
        const int tau = n >> 4, ho = n & 15;
        float v[8];
        if (kc < 64) {
            const int s = kc >> 1, hi0 = (kc & 1) * 8;
            const int d0 = tau - s, d1 = s - tau;
            const float m0 = d0 >= 0 ? 1.f : 0.f, m1 = d1 >= 0 ? 1.f : 0.f;
            const float* k0p = kj + ((size_t)((l * 16 + g) * 2 + 0) * 32 + (d0 > 0 ? d0 : 0)) * 256 + ho * 16 + hi0;
            const float* k1p = kj + ((size_t)((l * 16 + g) * 2 + 1) * 32 + (d1 > 0 ? d1 : 0)) * 256 + ho * 16 + hi0;
            const f32x4 a0 = *(const f32x4*)k0p, a1 = *(const f32x4*)(k0p + 4), b0 = *(const f32x4*)k1p, b1 = *(const f32x4*)(k1p + 4);
            const float dsk = p.in[I_SD][l * DSSM + g * 16 + ho];
#pragma unroll
            for (int j = 0; j < 8; ++j) v[j] = m0 * (j < 4 ? a0[j] : a1[j - 4]) + m1 * (j < 4 ? b0[j] : b1[j - 4]) + ((s == tau && ho == hi0 + j) ? dsk : 0.f);
        } else {
            const int kk = (kc - 64) * 8, dir = kk >> 7, c = (kk >> 6) & 1, p0 = kk & 63;
            const int e = dir == 0 ? tau + 1 : 32 - tau;
            const f32x4* pwp = (const f32x4*)((const float2*)(p.ws + WS_POW) + ((size_t)((l * 2 + dir) * 16 + g) * 33 + e) * 64 + p0);
            const size_t ci = ((size_t)((l * 2 + dir) * SG + g) * 16 + ho) * SP + p0;
            const f32x4 cr0 = *(const f32x4*)(p.in[I_CRE] + ci), cr1 = *(const f32x4*)(p.in[I_CRE] + ci + 4), ci0 = *(const f32x4*)(p.in[I_CIM] + ci), ci1 = *(const f32x4*)(p.in[I_CIM] + ci + 4);
            const f32x4 w0 = pwp[0], w1 = pwp[1], w2 = pwp[2], w3 = pwp[3];
            const float pr[8] = {w0[0], w0[2], w1[0], w1[2], w2[0], w2[2], w3[0], w3[2]}, pi[8] = {w0[1], w0[3], w1[1], w1[3], w2[1], w2[3], w3[1], w3[3]};
#pragma unroll
            for (int j = 0; j < 8; ++j) {
                const float2 z = cmul(make_float2(j < 4 ? cr0[j] : cr1[j - 4], j < 4 ? ci0[j] : ci1[j - 4]), make_float2(pr[j], pi[j]));
                v[j] = c == 0 ? z.x : -z.y;
            }
        }
        u32x4 o; o[0] = cvt_pk_bf16(v[0], v[1]); o[1] = cvt_pk_bf16(v[2], v[3]); o[2] = cvt_pk_bf16(v[4], v[5]); o[3] = cvt_pk_bf16(v[6], v[7]);
        *(u32x4*)(kw + ((size_t)(g * 512 + n)) * 768 + kc * 8) = o;
    }
}
__device__ __forceinline__ void st_ssm_egemm(const P& p, unsigned char* lds) {
    const bf16_t* ua = (const bf16_t*)(p.ws + WS_UA);
    const bf16_t* wst = (const bf16_t*)(p.ws + WS_WST);
    float* E = (float*)(p.ws + WS_E);
    int t_end, t_step;
    for (int tile = xcd_first(160, t_end, t_step); tile < t_end; tile += t_step) {
        const int nt = tile & 1, mt = (tile >> 1) % 5, g = tile / 10;
        f32x16 acc[2][2];
        gemm_tile(acc, ARowPlain{ua + (size_t)(g * 640 + mt * 128) * 768, 768}, wst + (size_t)(g * 256 + nt * 128) * 512, 512, 512, lds);
        acc_foreach4_lds(acc, lds, [&](int r, int c, float v0, float v1, float v2, float v3) { f32x4 o; o[0] = v0; o[1] = v1; o[2] = v2; o[3] = v3; *(f32x4*)(E + (size_t)(g * 640 + mt * 128 + r) * 256 + nt * 128 + c) = o; });
    }
}
__device__ __forceinline__ void st_ssm_carry(const P& p, int l) {
    bf16_t* ua = (bf16_t*)(p.ws + WS_UA);
    const float* E = (const float*)(p.ws + WS_E);
    for (int idx = ((int)gridDim.x - 1 - BIDX) * NT + TIDX; idx < NB * 16 * 2 * 64; idx += gridDim.x * NT) {
        const int pp = idx & 63, dir = (idx >> 6) & 1, g = (idx >> 7) & 15, b = idx >> 11;
        const float2 l32 = ((const float2*)(p.ws + WS_POW))[((size_t)((l * 2 + dir) * 16 + g) * 33 + 32) * 64 + pp];
        float2 S = make_float2(0.f, 0.f);
        for (int s0 = 0; s0 < 72; s0 += 24) {
            int ch[24]; float er[24], ei[24];
#pragma unroll
            for (int j = 0; j < 24; ++j) {
                const int step = s0 + j;
                if (dir == 0) ch[j] = step < 8 ? 512 + b * 8 + step : b * 64 + (step - 8);
                else ch[j] = step < 8 ? 512 + b * 8 + (7 - step) : b * 64 + (63 - (step - 8));
                const float* e = E + (size_t)(g * 640 + ch[j]) * 256 + dir * 128 + pp;
                er[j] = e[0]; ei[j] = e[64];
            }
#pragma unroll
            for (int j = 0; j < 24; ++j) {
                bf16_t* o = ua + (size_t)(g * 640 + ch[j]) * 768 + 512 + dir * 128 + pp;
                o[0] = f2bf(S.x); o[64] = f2bf(S.y);
                S = cmul(l32, S); S.x += er[j]; S.y += ei[j];
            }
        }
    }
}
__device__ __forceinline__ void st_ssm_ygemm(const P& p, int l, unsigned char* lds) {
    const bf16_t* ua = (const bf16_t*)(p.ws + WS_UA);
    const bf16_t* kw = (const bf16_t*)(p.ws + WS_KW);
    bf16_t* G = (bf16_t*)(p.ws + WS_G);
    const int nmt = l == 0 ? 5 : 4;
    int t_end, t_step;
    for (int tile = xcd_first(16 * nmt * 4, t_end, t_step); tile < t_end; tile += t_step) {
        const int nt = tile & 3, mt = (tile >> 2) % nmt, g = tile / (4 * nmt);
        f32x16 acc[2][2];
        gemm_tile(acc, ARowPlain{ua + (size_t)(g * 640 + mt * 128) * 768, 768}, kw + (size_t)(g * 512 + nt * 128) * 768, 768, 768, lds);
        acc_foreach4_lds(acc, lds, [&](int r, int c, float v0, float v1, float v2, float v3) {
            const int chunk = mt * 128 + r, n = nt * 128 + c;
            if (chunk < TA / 32) *(uint2*)(G + (size_t)(chunk * 32 + (n >> 4)) * DSSM + g * 16 + (n & 15)) = pack4(gelu_f(v0), gelu_f(v1), gelu_f(v2), gelu_f(v3)); });
    }
}
struct EpiGlu2 { const bf16_t* G; bf16_t* mix; const float* bias; __device__ __forceinline__ void operator()(int r, int c, float v0, float v1, float v2, float v3) const {
    const uint2 q = *(const uint2*)(G + (size_t)r * DSSM + c);
    const f32x4 b = *(const f32x4*)(bias + c);
    *(uint2*)(mix + (size_t)r * D + 256 + c) = pack4(__uint_as_float(q.x << 16) * sigmoid_f(v0 + b[0]), __uint_as_float(q.x & 0xffff0000u) * sigmoid_f(v1 + b[1]),
                                                     __uint_as_float(q.y << 16) * sigmoid_f(v2 + b[2]), __uint_as_float(q.y & 0xffff0000u) * sigmoid_f(v3 + b[3])); } };

constexpr float QSCALE = 0.125f * 1.4426950408889634f;
__device__ __forceinline__ void st_rope_table(const P& p) {
    float2* tab = (float2*)(p.ws + WS_ROPE);
    for (int idx = BIDX * NT + TIDX; idx < L * 32; idx += gridDim.x * NT) {
        const int t = idx >> 5, a = (idx >> 4) & 1, i = idx & 15;
        const float pos = a == 0 ? (float)(t / 64) : (float)(t % 64);
        const float ang = pos * powf(10000.f, -(float)i / 16.f);
        tab[idx] = make_float2(cosf(ang), sinf(ang));
    }
}
__device__ __forceinline__ void st_inproj(const P& p, int l, unsigned char* lds) {
    const bf16_t* A = (const bf16_t*)(p.ws + WS_BUFA);
    const bf16_t* Bt = (const bf16_t*)(p.ws + WS_WTIN);
    bf16_t* pc = (bf16_t*)(p.ws + WS_PC);
    bf16_t* ua = (bf16_t*)(p.ws + WS_UA);
    bf16_t* qb = (bf16_t*)(p.ws + WS_QB);
    bf16_t* kb = (bf16_t*)(p.ws + WS_KB);
    bf16_t* vt = (bf16_t*)(p.ws + WS_VT);
    const float2* rope = (const float2*)(p.ws + WS_ROPE);
    const int lane = TIDX & 63, w = TIDX >> 6, wr = w >> 1, wc = w & 1, lr = lane & 31, lh = lane >> 5;
    constexpr int TN = DIN / 128;
    int t_end, t_step;
    for (int tile = xcd_first((TA / 128) * TN, t_end, t_step); tile < t_end; tile += t_step) {
        const int tn = tile % TN, m0 = (tile / TN) * 128, n0 = tn * 128;
        f32x16 acc[2][2];
        gemm_tile(acc, ARowPlain{A + (size_t)m0 * D, D}, Bt + (size_t)n0 * D, D, D, lds);
        if (tn < 6) {
            acc_foreach4_lds(acc, lds, [&](int r, int c, float v0, float v1, float v2, float v3) { *(uint2*)(pc + (size_t)(m0 + r) * 768 + n0 + c) = pack4(v0, v1, v2, v3); });
        } else if (tn < 8) {
            acc_foreach4_lds(acc, lds, [&](int r, int c, float v0, float v1, float v2, float v3) { const int row = m0 + r, g = (tn - 6) * 8 + (c >> 4);
                *(uint2*)(ua + (size_t)(g * 640 + (row >> 5)) * 768 + (row & 31) * 16 + (c & 15)) = pack4(v0, v1, v2, v3); });
        } else if (tn < 13) {
            const bool isq = tn < 12;
            const float* gain = (isq ? p.in[I_QG] : p.in[I_KG]) + l * 64;
            const bool lat = m0 < TL;
            const float osc = isq ? QSCALE : 1.f;
#pragma unroll
            for (int mi = 0; mi < 2; ++mi) {
                const int row = m0 + wr * 64 + mi * 32 + lr;
                float ss = 0.f;
#pragma unroll
                for (int ni = 0; ni < 2; ++ni)
#pragma unroll
                    for (int r = 0; r < 16; ++r) ss += acc[mi][ni][r] * acc[mi][ni][r];
                ss += __shfl_xor(ss, 32);
                const float rinv = rsqrtf(ss * (1.f / 64.f) + 1e-6f) * osc;
                const int t = row & (L - 1);
                bf16_t* o = isq ? qb + (size_t)row * DATT + ((tn - 8) * 2 + wc) * 64 : kb + (size_t)row * 128 + wc * 64;
#pragma unroll
                for (int ni = 0; ni < 2; ++ni)
#pragma unroll
                    for (int g = 0; g < 2; ++g) {
                        const int d0 = ni * 32 + 8 * g + 4 * lh;
                        const f32x4 glo = *(const f32x4*)(gain + d0), ghi = *(const f32x4*)(gain + d0 + 16);
                        float t1[4], t2[4];
#pragma unroll
                        for (int q = 0; q < 4; ++q) { t1[q] = acc[mi][ni][4 * g + q] * rinv * glo[q]; t2[q] = acc[mi][ni][8 + 4 * g + q] * rinv * ghi[q]; }
                        if (lat) {
                            const float2* cs = rope + (t * 2 + ni) * 16 + 8 * g + 4 * lh;
                            const f32x4 c01 = *(const f32x4*)(cs), c23 = *(const f32x4*)(cs + 2);
                            const float cc[4] = {c01[0], c01[2], c23[0], c23[2]}, sn[4] = {c01[1], c01[3], c23[1], c23[3]};
#pragma unroll
                            for (int q = 0; q < 4; ++q) { const float a = t1[q], b = t2[q]; t1[q] = a * cc[q] - b * sn[q]; t2[q] = a * sn[q] + b * cc[q]; }
                        }
                        *(uint2*)(o + d0) = pack4(t1[0], t1[1], t1[2], t1[3]);
                        *(uint2*)(o + d0 + 16) = pack4(t2[0], t2[1], t2[2], t2[3]);
                    }
            }
        } else {
            acc_foreach4_lds(acc, lds, [&](int r, int c, float v0, float v1, float v2, float v3) { *(uint2*)(vt + (size_t)(m0 + r) * 128 + c) = pack4(v0, v1, v2, v3); });
        }
    }
}

constexpr int AT_KROWB = 144, AT_VROWB = 136, AT_VOFF = 64 * AT_KROWB, AT_BUFB = AT_VOFF + 64 * AT_VROWB;
__device__ __forceinline__ void st_attn2(const P& p, int l, unsigned char* lds, int part, int nparts) {
    const bf16_t* qb = (const bf16_t*)(p.ws + WS_QB);
    const bf16_t* kb = (const bf16_t*)(p.ws + WS_KB);
    const bf16_t* vb = (const bf16_t*)(p.ws + WS_VT);
    bf16_t* mix = (bf16_t*)(p.ws + WS_BUFA);
    const int t = TIDX, lane = t & 63, w = t >> 6, lr = lane & 31, lh = lane >> 5;
    constexpr int NLAT = NB * 32 * 2;
    const int nitems = NLAT + (l == 0 ? NB * 4 * 2 : 0);
    int t_end, t_step;
    for (int kk = xcd_first((nitems - part + nparts - 1) / nparts, t_end, t_step); kk < t_end; kk += t_step) {
        const int item = kk * nparts + part;
        const bool isctx = item >= NLAT;
        int b, q64, g;
        if (!isctx) { g = item & 1; q64 = (item >> 1) & 31; b = item >> 6; }
        else { const int it = item - NLAT; g = it & 1; q64 = (it >> 1) & 3; b = it >> 3; }
        const int hq = g * 4 + w;
        const int rq0 = isctx ? TL + b * LC + q64 * 64 : b * L + q64 * 64;
        bf16x8 qf[2][4];
#pragma unroll
        for (int qs = 0; qs < 2; ++qs)
#pragma unroll
            for (int s4 = 0; s4 < 4; ++s4) qf[qs][s4] = *(const bf16x8*)(qb + (size_t)(rq0 + qs * 32 + lr) * DATT + hq * 64 + s4 * 16 + lh * 8);
        const float sinkl = p.in[I_SINK][l * NQH + hq] * 1.4426950408889634f;
        float m[2] = {sinkl, sinkl};
        float lsum[2]; lsum[0] = lsum[1] = lh == 0 ? 1.f : 0.f;
        f32x16 o[2][2];
        float zf = 0.f; asm volatile("" : "+v"(zf));
#pragma unroll
        for (int qs = 0; qs < 2; ++qs)
#pragma unroll
            for (int dt = 0; dt < 2; ++dt)
#pragma unroll
                for (int r = 0; r < 16; ++r) o[qs][dt][r] = zf;
        const int nwin = isctx ? 0 : 5, nkt = nwin + 4;
        const int srow = t >> 3, kc = t & 7;
        u32x4 pk[2], pv[2];
        auto tile_row0 = [&](int kt, bool& win, bool& valid) -> int {
            if (kt < nwin) { win = true; const int k64 = q64 - 2 + kt; valid = (k64 >= 0 && k64 < 32); return b * L + k64 * 64; }
            win = false; valid = true; return TL + b * LC + (kt - nwin) * 64;
        };
        int kt = 0; bool win, valid; int krow0 = 0;
        for (; kt < nkt; ++kt) { krow0 = tile_row0(kt, win, valid); if (valid) break; }
#define AT_LOAD(row0_) do { _Pragma("unroll") for (int i = 0; i < 2; ++i) { const size_t off = (size_t)((row0_) + srow + 32 * i) * 128 + g * 64 + kc * 8; pk[i] = *(const u32x4*)(kb + off); pv[i] = *(const u32x4*)(vb + off); } } while (0)
#define AT_WRITE(buf_) do { unsigned char* bb_ = lds + (buf_) * AT_BUFB; _Pragma("unroll") for (int i = 0; i < 2; ++i) { const int row = srow + 32 * i; \
            *(u32x4*)(bb_ + row * AT_KROWB + kc * 16) = pk[i]; unsigned char* vd = bb_ + AT_VOFF + (kc * 8) * AT_VROWB + row * 2; \
            _Pragma("unroll") for (int q = 0; q < 4; ++q) { *(bf16_t*)(vd + (2 * q) * AT_VROWB) = (bf16_t)(pv[i][q] & 0xffffu); *(bf16_t*)(vd + (2 * q + 1) * AT_VROWB) = (bf16_t)(pv[i][q] >> 16); } } } while (0)
        AT_LOAD(krow0);
        __syncthreads();
        AT_WRITE(0);
        int nkt2 = kt + 1; bool nwin2 = false, nvalid = false; int nrow0 = 0;
        for (; nkt2 < nkt; ++nkt2) { nrow0 = tile_row0(nkt2, nwin2, nvalid); if (nvalid) break; }
        if (nkt2 < nkt) AT_LOAD(nrow0);
        __syncthreads();
        int cur = 0;
        while (kt < nkt) {
            const bool cwin = win; const int ckrow0 = krow0;
            const unsigned char* tb = lds + cur * AT_BUFB;
            const bool have_next = nkt2 < nkt;
            int nkt3 = nkt2 + 1; bool nwin3 = false, nvalid3 = false; int nrow3 = 0;
            if (have_next) {
                AT_WRITE(cur ^ 1);
                for (; nkt3 < nkt; ++nkt3) { nrow3 = tile_row0(nkt3, nwin3, nvalid3); if (nvalid3) break; }
                if (nkt3 < nkt) AT_LOAD(nrow3);
            }
            const int j0t = ckrow0 - b * L;
#pragma unroll
            for (int sub = 0; sub < 2; ++sub) {
                bf16x8 kf[4];
#pragma unroll
                for (int s4 = 0; s4 < 4; ++s4) kf[s4] = *(const bf16x8*)(tb + (sub * 32 + lr) * AT_KROWB + s4 * 32 + lh * 16);
                bool skip[2] = {false, false}, partial[2] = {false, false};
                if (cwin) {
#pragma unroll
                    for (int qs = 0; qs < 2; ++qs) {
                        const int j0 = j0t + sub * 32, i0 = q64 * 64 + qs * 32;
                        skip[qs] = (j0 > i0 + 31 + 128 || j0 + 31 < i0 - 128);
                        partial[qs] = !skip[qs] && !(j0 >= i0 + 31 - 128 && j0 + 31 <= i0 + 128);
                    }
                }
                if (skip[0] && skip[1]) continue;
                f32x16 sT[2];
#pragma unroll
                for (int qs = 0; qs < 2; ++qs)
#pragma unroll
                    for (int r = 0; r < 16; ++r) sT[qs][r] = zf;
#pragma unroll
                for (int s4 = 0; s4 < 4; ++s4) {
                    sT[0] = __builtin_amdgcn_mfma_f32_32x32x16_bf16(kf[s4], qf[0][s4], sT[0], 0, 0, 0);
                    sT[1] = __builtin_amdgcn_mfma_f32_32x32x16_bf16(kf[s4], qf[1][s4], sT[1], 0, 0, 0);
                }
                if (partial[0] || partial[1] || skip[0] || skip[1]) {
                    int djb = j0t + sub * 32 + 4 * lh - (q64 * 64 + lr);
                    asm volatile("" : "+v"(djb));
#pragma unroll
                    for (int qs = 0; qs < 2; ++qs)
#pragma unroll
                        for (int r = 0; r < 16; ++r) { const int dj = djb - qs * 32 + (r & 3) + 8 * (r >> 2); if (dj > 128 || dj < -128) sT[qs][r] = -1e30f; }
                }
                float mt[2];
#pragma unroll
                for (int qs = 0; qs < 2; ++qs) {
                    float a = sT[qs][0];
#pragma unroll
                    for (int r = 1; r < 16; ++r) a = fmaxf(a, sT[qs][r]);
                    mt[qs] = fmaxf(a, __shfl_xor(a, 32));
                }
                if (!__all(mt[0] - m[0] <= 8.f && mt[1] - m[1] <= 8.f)) {
                    asm volatile("" ::: "memory");
#pragma unroll
                    for (int qs = 0; qs < 2; ++qs) {
                        const float mn = fmaxf(m[qs], mt[qs]);
                        const float alpha = __builtin_amdgcn_exp2f(m[qs] - mn);
                        m[qs] = mn;
                        lsum[qs] *= alpha;
#pragma unroll
                        for (int r = 0; r < 16; ++r) { o[qs][0][r] *= alpha; o[qs][1][r] *= alpha; }
                    }
                }
#pragma unroll
                for (int qs = 0; qs < 2; ++qs) {
                    const float mn = m[qs];
                    float ps = 0.f;
#pragma unroll
                    for (int r = 0; r < 16; ++r) { sT[qs][r] = __builtin_amdgcn_exp2f(sT[qs][r] - mn); ps += sT[qs][r]; }
                    lsum[qs] += ps;
                }
#pragma unroll
                for (int s2 = 0; s2 < 2; ++s2) {
                    bf16x8 pf[2];
#pragma unroll
                    for (int qs = 0; qs < 2; ++qs) {
                        u32x4 pkk;
                        pkk[0] = cvt_pk_bf16(sT[qs][8 * s2 + 0], sT[qs][8 * s2 + 1]); pkk[1] = cvt_pk_bf16(sT[qs][8 * s2 + 2], sT[qs][8 * s2 + 3]);
                        pkk[2] = cvt_pk_bf16(sT[qs][8 * s2 + 4], sT[qs][8 * s2 + 5]); pkk[3] = cvt_pk_bf16(sT[qs][8 * s2 + 6], sT[qs][8 * s2 + 7]);
                        pf[qs] = __builtin_bit_cast(bf16x8, pkk);
                    }
#pragma unroll
                    for (int dt = 0; dt < 2; ++dt) {
                        const unsigned char* vp = tb + AT_VOFF + (dt * 32 + lr) * AT_VROWB + (sub * 32 + s2 * 16 + lh * 4) * 2;
                        const uint2 a = *(const uint2*)(vp), c2 = *(const uint2*)(vp + 16);
                        u32x4 vv; vv[0] = a.x; vv[1] = a.y; vv[2] = c2.x; vv[3] = c2.y;
                        const bf16x8 vf = __builtin_bit_cast(bf16x8, vv);
                        o[0][dt] = __builtin_amdgcn_mfma_f32_32x32x16_bf16(vf, pf[0], o[0][dt], 0, 0, 0);
                        o[1][dt] = __builtin_amdgcn_mfma_f32_32x32x16_bf16(vf, pf[1], o[1][dt], 0, 0, 0);
                    }
                }
            }
            __syncthreads();
            kt = nkt2; win = nwin2; krow0 = nrow0; nkt2 = nkt3; nwin2 = nwin3; nrow0 = nrow3; cur ^= 1;
        }
#undef AT_LOAD
#undef AT_WRITE
#pragma unroll
        for (int qs = 0; qs < 2; ++qs) {
            const float lt = lsum[qs] + __shfl_xor(lsum[qs], 32);
            const float inv = 1.f / lt;
            bf16_t* orow = mix + (size_t)(rq0 + qs * 32 + lr) * D + 512 + hq * 64;
#pragma unroll
            for (int dt = 0; dt < 2; ++dt)
#pragma unroll
                for (int rg = 0; rg < 4; ++rg)
                    *(uint2*)(orow + dt * 32 + 8 * rg + 4 * lh) = pack4(o[qs][dt][4 * rg] * inv, o[qs][dt][4 * rg + 1] * inv, o[qs][dt][4 * rg + 2] * inv, o[qs][dt][4 * rg + 3] * inv);
        }
    }
}


constexpr int FAKE = 0;
constexpr int TIM = 0;
constexpr int PROBE3 = 0;
constexpr int PROBE2 = 0;
__device__ __forceinline__ void st_fake(const P& p, unsigned char* lds) {
    if (FAKE == 0) return;
    const bf16_t* A = (const bf16_t*)(p.ws + WS_BUFA);
    const bf16_t* Bt = (const bf16_t*)(p.ws + WS_WTIN);
    constexpr int TN = DIN / 128;
    int t_end, t_step;
    float sink = 0.f;
    for (int tile = xcd_first((TA / 128) * TN, t_end, t_step); tile < t_end; tile += t_step) {
        const int tn = tile % TN, m0 = (FAKE == 2 || FAKE == 3) ? 0 : (tile / TN) * 128, n0 = FAKE == 3 ? 0 : tn * 128;
        f32x16 acc[2][2];
        gemm_tile(acc, ARowPlain{A + (size_t)m0 * D, D}, Bt + (size_t)n0 * D, D, D, lds);
        if (FAKE == 4) {
            bf16_t* dst = (bf16_t*)(p.ws + WS_HID);
            acc_foreach4_lds(acc, lds, [&](int r, int c, float v0, float v1, float v2, float v3) { *(uint2*)(dst + ((size_t)((tile / TN) * 128 + r) * 128 + c)) = pack4(v0, v1, v2, v3); });
        } else if (FAKE == 5) {
            bf16_t* dst = (bf16_t*)(p.ws + WS_HID);
            __syncthreads();
            acc_foreach4_lds(acc, lds, [&](int r, int c, float v0, float v1, float v2, float v3) { *(uint2*)(lds + (r * 136 + c) * 2) = pack4(v0, v1, v2, v3); });
            __syncthreads();
            const int t = TIDX;
#pragma unroll
            for (int i = 0; i < 8; ++i) { const int ch = t + 256 * i, r = ch >> 4, cc = (ch & 15) * 8;
                *(u32x4*)(dst + ((size_t)((tile / TN) * 128 + r) * 128 + cc)) = *(const u32x4*)(lds + (r * 136 + cc) * 2); }
        } else {
#pragma unroll
        for (int mi = 0; mi < 2; ++mi)
#pragma unroll
            for (int ni = 0; ni < 2; ++ni) sink += acc[mi][ni][0] + acc[mi][ni][7];
        }
    }
    if (sink == 12345.678f) ((float*)(p.ws + WS_RBIAS))[1000] = sink;
}
constexpr int STAGES_PER_LAYER = 11;
constexpr int N_STAGES = 1 + 2 * STAGES_PER_LAYER;
constexpr int REP_STAGE = -1;

__device__ __forceinline__ void run_stage(const P& p, int s, unsigned char* ldsb) {
    float* lds = (float*)ldsb;
    if (s == 0) { st_mod(p, lds); st_rope_table(p); st_ssm_tables(p); st_ssm_kj(p, lds); st_prep_weights(p, 0, ldsb, PW_ALL); return; }
    const int l = (s - 1) / STAGES_PER_LAYER, k = (s - 1) % STAGES_PER_LAYER;
    switch (k) {
    case 0: st_rbias(p, l, lds);
            if (l == 0) st_prep_ssm(p, 0, 3); else st_prep_weights(p, 1, ldsb, PW_GU | PW_DN);
            st_norm(p, l, 0); break;
    case 1: if (l == 0) st_fake(p, ldsb); st_inproj(p, l, ldsb); break;
    case 2: st_ssm_egemm(p, ldsb); if (l == 0) st_prep_weights(p, 1, ldsb, PW_IN); break;
    case 3: st_ssm_carry(p, l); st_attn2(p, l, ldsb, 0, 1); break;
    case 4: st_ssm_ygemm(p, l, ldsb); if (l == 0) st_prep_ssm(p, 1, 1); break;
    case 5: gemm_stage((const bf16_t*)(p.ws + WS_G), DSSM, (const bf16_t*)(p.ws + WS_WTGLU), DSSM, l == 0 ? TA : TL, DSSM, DSSM,
                       EpiGlu2{(const bf16_t*)(p.ws + WS_G), (bf16_t*)(p.ws + WS_BUFA), p.in[I_BGLU] + l * DSSM}, ldsb);
            st_conv(p, l); if (l == 0) st_prep_ssm(p, 1, 2); break;
    case 6: gemm_stage_pre((const bf16_t*)(p.ws + WS_BUFA), D, (const bf16_t*)(p.ws + WS_WTOUT), D, l == 0 ? TA : TL, D, D, make_epi_out(p, l), ldsb); break;
    case 7: if (PROBE2 == 1 && l == 0) st_router2<true>(p, l, ldsb); st_router2(p, l, ldsb); if (l == 0) st_prep_weights(p, 1, ldsb, PW_GLU | PW_OUT); break;
    case 8: st_moe1(p, l, ldsb); break;
    case 9: st_moe2s(p, l, ldsb); break;
    case 10: if (PROBE2 == 2 && l == 0) { EpiMoeF e = make_epi_moef(p, l); e.outw = false; gemm_stage((const bf16_t*)(p.ws + WS_HID) + 4 * DE, 5 * DE, (const bf16_t*)(p.ws + WS_WD) + (size_t)32 * D * DE, DE, TA, D, DE, e, ldsb); }
             gemm_stage((const bf16_t*)(p.ws + WS_HID) + 4 * DE, 5 * DE, (const bf16_t*)(p.ws + WS_WD) + (size_t)32 * D * DE, DE, l == 0 ? TA : TL, D, DE, make_epi_moef(p, l), ldsb); break;
    }
}


#define XB_TMO      128
#define XB_XCNT(j)  (256  + 64 * (j))
#define XB_XSUB(j)  (1280 + 64 * (j))
#define XB_XGEN(j)  (2304 + 64 * (j))
#define XB_TOP      3328
#define XB_TOPGEN   3392
#define XCD_BAR_WORDS 3456
#define XB_SPIN_CAP (1u << 22)
__device__ __forceinline__ unsigned xb_ld(unsigned* p)              { return __hip_atomic_load(p, __ATOMIC_RELAXED, __HIP_MEMORY_SCOPE_AGENT); }
__device__ __forceinline__ unsigned xb_add(unsigned* p, unsigned v) { return __hip_atomic_fetch_add(p, v, __ATOMIC_RELAXED, __HIP_MEMORY_SCOPE_AGENT); }
__device__ __forceinline__ unsigned xb_xcc_id() { return (unsigned)__builtin_amdgcn_s_getreg((3 << 11) | 20) & 0xFu; }
#define XB_SPIN(cond, bar) do { unsigned _sp = 0; while (cond) { __builtin_amdgcn_s_sleep(1); \
    if ((++_sp & 255u) == 0u) { if (xb_ld(&(bar)[XB_TMO])) break; if (_sp > XB_SPIN_CAP) { atomicAdd(&(bar)[XB_TMO], 1u); break; } } } } while (0)
struct XcdBarrier { unsigned* bar; unsigned x; volatile LAS unsigned* st; };
__device__ __forceinline__ XcdBarrier xcd_barrier_post(unsigned* bar, volatile LAS unsigned* st) {
    XcdBarrier b; b.bar = bar; b.x = xb_xcc_id(); b.st = st;
    if (threadIdx.x == 0) (void)xb_add(&bar[XB_XCNT(b.x)], 1u);
    return b;
}
__device__ __forceinline__ void xcd_barrier_complete(unsigned* bar, unsigned x, unsigned& nloc, unsigned& nx) {
    const unsigned G = gridDim.x * gridDim.y * gridDim.z;
    unsigned sum, cnt, mine, sp = 0u;
    for (;;) {
        sum = 0u; cnt = 0u; mine = 0u;
#pragma unroll
        for (unsigned j = 0; j < 16; ++j) { const unsigned c = xb_ld(&bar[XB_XCNT(j)]); sum += c; cnt += (c > 0u) ? 1u : 0u; mine = (j == x) ? c : mine; }
        if (sum == G) break;
        __builtin_amdgcn_s_sleep(1);
        if ((++sp & 255u) == 0u) { if (xb_ld(&bar[XB_TMO])) break; if (sp > XB_SPIN_CAP) { atomicAdd(&bar[XB_TMO], 1u); break; } }
    }
    nloc = mine > 0u ? mine : 1u; nx = cnt > 0u ? cnt : 1u;
}
__device__ __forceinline__ void xcd_barrier(const XcdBarrier& b) {
    asm volatile("s_waitcnt vmcnt(0)" ::: "memory");
    __syncthreads();
    if (threadIdx.x == 0) {
        unsigned* bar = b.bar;
        __builtin_amdgcn_s_waitcnt(0);
        unsigned nloc = b.st[0], nx = b.st[1];
        if (nloc == 0u) { xcd_barrier_complete(bar, b.x, nloc, nx); b.st[0] = nloc; b.st[1] = nx; }
        const unsigned old = xb_add(&bar[XB_XSUB(b.x)], 1u);
        const unsigned gen = old / nloc;
        if (old + 1u == (gen + 1u) * nloc) {
            __builtin_amdgcn_fence(__ATOMIC_RELEASE, "agent");
            asm volatile("s_waitcnt vmcnt(0)" ::: "memory");
            const unsigned og = xb_add(&bar[XB_TOP], 1u);
            const unsigned tg = og / nx;
            if (og + 1u == (tg + 1u) * nx) xb_add(&bar[XB_TOPGEN], 1u);
            else XB_SPIN(xb_ld(&bar[XB_TOPGEN]) == tg, bar);
            __builtin_amdgcn_fence(__ATOMIC_ACQUIRE, "agent");
            xb_add(&bar[XB_XGEN(b.x)], 1u);
            asm volatile("s_waitcnt vmcnt(0)" ::: "memory");
        } else {
            XB_SPIN(xb_ld(&bar[XB_XGEN(b.x)]) == gen, bar);
            __builtin_amdgcn_fence(__ATOMIC_ACQUIRE, "agent");
            asm volatile("s_waitcnt vmcnt(0)" ::: "memory");
        }
    }
    __syncthreads();
}
constexpr size_t WS_XBAR = 4096;

template <int S> __device__ __forceinline__ void run_all(const P& p, unsigned char* lds, const XcdBarrier& xb) {
    run_stage(p, S, lds);
    if constexpr (S == REP_STAGE) { xcd_barrier(xb); run_stage(p, S, lds); }
    if constexpr (S + 1 < N_STAGES) {
        unsigned long long t0 = 0; if (TIM) t0 = __builtin_amdgcn_s_memrealtime();
        xcd_barrier(xb);
        if (TIM && threadIdx.x == 0) { const unsigned long long t1 = __builtin_amdgcn_s_memrealtime(); xb.st[2] += (unsigned)(t1 - t0);
            if (blockIdx.x == 0) ((unsigned long long*)(p.ws + WS_CTL + 32768))[S + 1] = t1; }
        run_all<S + 1>(p, lds, xb);
    } else if (TIM) {
        unsigned* ctl = (unsigned*)(p.ws + WS_CTL + 32768 + 512);
        unsigned long long* ts = (unsigned long long*)(p.ws + WS_CTL + 32768);
        if (threadIdx.x == 0) { atomicAdd(ctl, xb.st[2]); if (blockIdx.x == 0) ts[N_STAGES] = __builtin_amdgcn_s_memrealtime(); }
        xcd_barrier(xb);
        if (blockIdx.x == 0 && threadIdx.x == 0) {
            float us;
            if (TIM == 1) us = (float)__hip_atomic_load(ctl, __ATOMIC_RELAXED, __HIP_MEMORY_SCOPE_AGENT) / (float)gridDim.x * 0.01f / 10.f;
            else if (TIM == 2) us = (float)(ts[N_STAGES] - ts[0]) * 0.01f / 25.f;
            else us = (float)(ts[TIM - 10 + 1] - ts[TIM - 10]) * 0.01f / 2.f;
            float code = floorf(us); if (code > 89.f) code = 89.f;
            p.out[0] += 10.f + code;
        }
    }
}
__global__ void __launch_bounds__(NT, 2) mega(P p) {
    __shared__ __attribute__((aligned(16))) unsigned char lds[LDS_TOTAL + 16];
    volatile LAS unsigned* st = (volatile LAS unsigned*)(lds + LDS_TOTAL);
    if (threadIdx.x == 0) { st[0] = 0u; st[1] = 0u; st[2] = 0u; st[3] = 0u; if (TIM && blockIdx.x == 0) ((unsigned long long*)(p.ws + WS_CTL + 32768))[0] = __builtin_amdgcn_s_memrealtime(); }
    __syncthreads();
    const XcdBarrier xb = xcd_barrier_post((unsigned*)(p.ws + WS_CTL + WS_XBAR), st);
    if (p.ws == nullptr) cg::this_grid().sync();
    run_all<0>(p, lds, xb);
}

extern "C" void kernel_launch(void* const* d_in, const int* in_sizes, int n_in, void* d_out, int out_size, void* d_ws, size_t ws_size, hipStream_t stream) {
    if (n_in != N_IN || ws_size < WS_END) { fprintf(stderr, "kernel_launch: unexpected n_in %d or ws_size %zu (< %zu)\n", n_in, ws_size, (size_t)WS_END); return; }
    P p{};
    for (int i = 0; i < N_IN; ++i) p.in[i] = (const float*)d_in[i];
    p.out = (float*)d_out; p.ws = (unsigned char*)d_ws;
    static int grid_blocks = 0;
    if (!grid_blocks) {
        int dev = 0, cus = 0, per_cu = 0;
        hipGetDevice(&dev);
        hipDeviceGetAttribute(&cus, hipDeviceAttributeMultiprocessorCount, dev);
        hipOccupancyMaxActiveBlocksPerMultiprocessor(&per_cu, (const void*)mega, NT, 0);
        if (per_cu < 1) per_cu = 1;
        if (per_cu > 2) per_cu = 2;
        grid_blocks = cus * per_cu;
    }
    hipMemsetAsync((char*)d_ws + WS_CTL, 0, 65536, stream);
    void* args[] = {&p};
    hipError_t e = hipLaunchCooperativeKernel((const void*)mega, dim3(grid_blocks), dim3(NT), args, 0, stream);
    if (e != hipSuccess) fprintf(stderr, "cooperative launch failed: %s (grid %d)\n", hipGetErrorString(e), grid_blocks);
}
```

```cpp
#include <hip/hip_runtime.h>
#include <hip/hip_cooperative_groups.h>
#include <cstdio>
#include <cstdint>
namespace cg = cooperative_groups;
#define CNT_PTR(p, l) ((int*)((p).ws + 40960 + (l) * 8192))
#define LAS __attribute__((address_space(3)))
constexpr int ABL = 0;

__device__ __forceinline__ int tid_opaque() { int t = threadIdx.x; asm volatile("" : "+v"(t)); return t; }
__device__ __forceinline__ int bid_opaque() { int b = blockIdx.x; asm volatile("" : "+s"(b)); return b; }
__device__ __forceinline__ int xcd_first(int total, int& end, int& step) {
    const int nb = gridDim.x; int b = blockIdx.x; asm volatile("" : "+s"(b));
    if (nb & 7) { end = total; step = nb; return b; }
    const int x = b & 7, j = b >> 3, per = (total + 7) >> 3, lo = x * per;
    end = lo + per < total ? lo + per : total; step = nb >> 3; return lo + j;
}
#define TIDX tid_opaque()
#define BIDX bid_opaque()

constexpr int D = 1024, NB = 8, L = 2048, LC = 256;
constexpr int TL = NB * L, TC = NB * LC, TA = TL + TC;
constexpr int DIN = 1792, DCONV = 256, DSSM = 256, DATT = 512;
constexpr int NQH = 8, NKVH = 2, HD = 64;
constexpr int COL_U = 768, COL_Q = 1024, COL_K = 1536, COL_V = 1664;
constexpr int NE = 32, TOPK = 4, DE = 128;
constexpr int SG = 16, SH = 16, SP = 64;
constexpr int NT = 256;

enum { I_X = 0, I_C, I_CTX, I_CCTX, I_WMOD, I_BMOD, I_N1G, I_N2G, I_WIN, I_CONVW, I_LRE, I_LIM, I_LDT, I_BRE, I_BIM, I_CRE, I_CIM,
       I_SD, I_WGLU, I_BGLU, I_QG, I_KG, I_SINK, I_WOUT, I_RW, I_RB, I_WEG, I_WEU, I_WED, I_WSG, I_WSU, I_WSD, N_IN };

typedef unsigned short bf16_t;
constexpr size_t WS_CTL = 0;
constexpr size_t WS_MOD = 65536;
constexpr size_t WS_ZERO_END = WS_MOD + (size_t)2 * 9 * 6 * D * 4;
constexpr size_t WS_RBIAS = 524288;
constexpr size_t WS_ROPE = WS_RBIAS + 4096;
constexpr size_t WS_KJ = WS_ROPE + 524288;
constexpr size_t WS_GS2 = WS_KJ + 2097152;
constexpr size_t WS_POW = WS_GS2 + 131072;
constexpr size_t WS_FB = WS_POW + (size_t)2 * 2 * 16 * 33 * 64 * 8;
constexpr size_t WS_R1 = WS_FB + (size_t)2 * 2 * 16 * 64 * 16 * 8;
constexpr size_t WS_BUFA = WS_R1;
constexpr size_t WS_PC = WS_BUFA + (size_t)TA * D * 2;
constexpr size_t WS_UA = WS_PC + (size_t)TA * 768 * 2;
constexpr size_t WS_E = WS_UA + (size_t)16 * 640 * 768 * 2;
constexpr size_t WS_G = WS_E + (size_t)16 * 640 * 256 * 4;
constexpr size_t WS_QB = WS_G + (size_t)TA * DSSM * 2;
constexpr size_t WS_KB = WS_QB + (size_t)TA * DATT * 2;
constexpr size_t WS_VT = WS_KB + (size_t)TA * 128 * 2;
constexpr size_t WS_SLAB = WS_R1;
constexpr size_t WS_HID = WS_SLAB + (size_t)TA * 4 * D * 2;
constexpr size_t WS_HC1 = WS_HID + (size_t)TA * 5 * DE * 2;
constexpr size_t WS_HCMID = WS_HC1 + (size_t)TC * D * 4;
constexpr size_t WS_LCODE = WS_HCMID + (size_t)TC * D * 4;
constexpr size_t WS_LW = WS_LCODE + (size_t)NE * TA * 4;
constexpr size_t WS_WTIN = WS_LW + (size_t)NE * TA * 4;
constexpr size_t WS_WTOUT = WS_WTIN + (size_t)DIN * D * 2;
constexpr size_t WS_WTGLU = WS_WTOUT + (size_t)D * D * 2;
constexpr size_t WS_WGU = WS_WTGLU + (size_t)DSSM * DSSM * 2;
constexpr size_t WS_WD = WS_WGU + (size_t)33 * 256 * D * 2;
constexpr size_t WS_WST = WS_WD + (size_t)33 * D * DE * 2;
constexpr size_t WS_KW = WS_WST + (size_t)16 * 256 * 512 * 2;
constexpr size_t WS_END = WS_KW + (size_t)16 * 512 * 768 * 2;
static_assert(WS_VT + (size_t)TA * 128 * 2 <= WS_HID, "overlay");
static_assert(WS_ZERO_END <= WS_RBIAS, "zero region");
static_assert(WS_END <= 268435456, "workspace too large");
constexpr size_t WS_HMID = WS_E;
static_assert(WS_HMID >= WS_SLAB + (size_t)TA * 4 * D && WS_HMID + (size_t)TA * D * 2 <= WS_HID, "h_mid overlay");

struct P {
    const float* in[N_IN];
    float* out;
    unsigned char* ws;
};

__device__ __forceinline__ bf16_t f2bf(float f) { unsigned u = __float_as_uint(f); u += 0x7FFFu + ((u >> 16) & 1u); return (bf16_t)(u >> 16); }
__device__ __forceinline__ float bf2f(bf16_t b) { return __uint_as_float((unsigned)b << 16); }
__device__ __forceinline__ unsigned cvt_pk_bf16(float lo, float hi) { unsigned r; asm("v_cvt_pk_bf16_f32 %0, %1, %2" : "=v"(r) : "v"(lo), "v"(hi)); return r; }
typedef __attribute__((ext_vector_type(4))) float f32x4;
typedef __attribute__((ext_vector_type(4))) unsigned u32x4;
struct BfPtr { const bf16_t* p; __device__ __forceinline__ float operator[](long i) const { return bf2f(p[i]); }
               __device__ __forceinline__ BfPtr operator+(long o) const { return BfPtr{p + o}; } };
__device__ __forceinline__ float sigmoid_f(float x) { return __builtin_amdgcn_rcpf(1.f + __builtin_amdgcn_exp2f(-1.4426950408889634f * x)); }
__device__ __forceinline__ float silu_f(float x) { return x * sigmoid_f(x); }
__device__ __forceinline__ float gelu_f(float x) { return x * sigmoid_f(2.f * 0.7978845608028654f * (x + 0.044715f * x * x * x)); }
__device__ __forceinline__ float wave_sum(float v) {
#pragma unroll
    for (int o = 32; o > 0; o >>= 1) v += __shfl_xor(v, o);
    return v;
}
__device__ __forceinline__ f32x4 bf4_to_f(const uint2& t) { f32x4 v; v[0] = __uint_as_float(t.x << 16); v[1] = __uint_as_float(t.x & 0xffff0000u); v[2] = __uint_as_float(t.y << 16); v[3] = __uint_as_float(t.y & 0xffff0000u); return v; }
__device__ __forceinline__ int row_bb(int r) { return r < TL ? r / L : 8; }
__device__ __forceinline__ const float* h_row(const P& p, int l, int r) {
    if (r < TL) return (l == 0 ? p.in[I_X] : p.out) + (size_t)r * D;
    return (l == 0 ? p.in[I_CTX] : (const float*)(p.ws + WS_HC1)) + (size_t)(r - TL) * D;
}
__device__ __forceinline__ bf16_t* hmid_row(const P& p, int r) { return (bf16_t*)(p.ws + WS_HMID) + (size_t)r * D; }
__device__ __forceinline__ const float* mod_vec(const P& p, int l, int bb, int chunk) {
    return (const float*)(p.ws + WS_MOD) + ((size_t)(l * 9 + bb) * 6 + chunk) * D;
}

__device__ __forceinline__ void st_mod(const P& p, float* lds) {
    float* red = lds + 9 * D;
    for (int i = TIDX; i < 9 * D; i += NT) {
        const int bb = i / D, k = i % D;
        const float c = bb < 8 ? p.in[I_C][bb * D + k] : p.in[I_CCTX][k];
        lds[i] = silu_f(c);
    }
    __syncthreads();
    float* mod = (float*)(p.ws + WS_MOD);
    const int col = TIDX & 31, ks = TIDX >> 5;
    for (int item = BIDX; item < 2 * 6 * D / 32; item += gridDim.x) {
        const int l = item / (6 * D / 32), j = (item % (6 * D / 32)) * 32 + col;
        const float* w = p.in[I_WMOD] + (size_t)l * D * 6 * D + j;
        float acc[9];
#pragma unroll
        for (int bb = 0; bb < 9; ++bb) acc[bb] = 0.f;
        for (int k0 = ks * 128; k0 < ks * 128 + 128; k0 += 16) {
            float wv[16];
#pragma unroll
            for (int q = 0; q < 16; ++q) wv[q] = w[(size_t)(k0 + q) * 6 * D];
#pragma unroll
            for (int q = 0; q < 16; ++q)
#pragma unroll
                for (int bb = 0; bb < 9; ++bb) acc[bb] += lds[bb * D + k0 + q] * wv[q];
        }
#pragma unroll
        for (int bb = 0; bb < 9; ++bb) red[(bb * 8 + ks) * 32 + col] = acc[bb];
        __syncthreads();
        for (int o = TIDX; o < 9 * 32; o += NT) {
            const int bb = o >> 5, c2 = o & 31;
            float sum = p.in[I_BMOD][l * 6 * D + (item % (6 * D / 32)) * 32 + c2];
#pragma unroll
            for (int q = 0; q < 8; ++q) sum += red[(bb * 8 + q) * 32 + c2];
            mod[(size_t)(l * 9 + bb) * 6 * D + (item % (6 * D / 32)) * 32 + c2] = sum;
        }
        __syncthreads();
    }
}

__device__ __forceinline__ void st_norm(const P& p, int l, int which) {
    const int lane = TIDX & 63, wv = TIDX >> 6;
    const int nrows = (which == 1 && l == 1) ? TL : TA;
    float* xn = (float*)(p.ws + WS_BUFA);
    const float* g = p.in[which == 0 ? I_N1G : I_N2G] + l * D;
    for (int r0 = (BIDX * 4 + wv) * 2; r0 < nrows; r0 += gridDim.x * 8) {
        f32x4 v[2][4];
#pragma unroll
        for (int u = 0; u < 2; ++u) {
            if (l == 1 && r0 + u < TL) {
                const bf16_t* s16 = (const bf16_t*)p.out + (size_t)(r0 + u) * D;
#pragma unroll
                for (int j = 0; j < 4; ++j) v[u][j] = bf4_to_f(*(const uint2*)(s16 + j * 256 + lane * 4));
            } else {
                const float* src = h_row(p, l, r0 + u);
#pragma unroll
                for (int j = 0; j < 4; ++j) v[u][j] = *(const f32x4*)(src + j * 256 + lane * 4);
            }
        }
        const int bb = row_bb(r0);
        const float* sh = mod_vec(p, l, bb, which == 0 ? 0 : 3);
        const float* sc = mod_vec(p, l, bb, which == 0 ? 1 : 4);
#pragma unroll
        for (int u = 0; u < 2; ++u) {
            const int r = r0 + u;
            float s = 0.f;
#pragma unroll
            for (int j = 0; j < 4; ++j) s += v[u][j][0] * v[u][j][0] + v[u][j][1] * v[u][j][1] + v[u][j][2] * v[u][j][2] + v[u][j][3] * v[u][j][3];
            s = wave_sum(s);
            const float rinv = rsqrtf(s * (1.f / D) + 1e-6f);
#pragma unroll
            for (int j = 0; j < 4; ++j) {
                const int k = j * 256 + lane * 4;
                const f32x4 gg = *(const f32x4*)(g + k), s1 = *(const f32x4*)(sc + k), s0 = *(const f32x4*)(sh + k);
                f32x4 o;
#pragma unroll
                for (int q = 0; q < 4; ++q) o[q] = v[u][j][q] * rinv * gg[q] * (1.f + s1[q]) + s0[q];
                if (which == 1) *(f32x4*)(xn + (size_t)r * D + k) = o;
                else { uint2 pk; pk.x = cvt_pk_bf16(o[0], o[1]); pk.y = cvt_pk_bf16(o[2], o[3]); *(uint2*)((bf16_t*)(p.ws + WS_BUFA) + (size_t)r * D + k) = pk; }
            }
        }
    }
}

__device__ __forceinline__ void bf8_to_f(const u32x4& v, float (&f)[8]) {
#pragma unroll
    for (int q = 0; q < 4; ++q) { f[2 * q] = __uint_as_float(v[q] << 16); f[2 * q + 1] = __uint_as_float(v[q] & 0xffff0000u); }
}
__device__ __forceinline__ void st_conv(const P& p, int l, int first_blk) {
    const bf16_t* pb = (const bf16_t*)(p.ws + WS_PC);
    bf16_t* mix = (bf16_t*)(p.ws + WS_BUFA);
    const float* cw = p.in[I_CONVW] + l * 3 * DCONV;
    const int nrows = l == 0 ? TA : TL;
    const int nblk = (int)gridDim.x - first_blk;
    if (BIDX < first_blk || nblk <= 0) return;
    for (int idx = (BIDX - first_blk) * NT + TIDX; idx < nrows * 32; idx += nblk * NT) {
        const int r = idx >> 5, ch = (idx & 31) * 8;
        int t, len;
        if (r < TL) { t = r & (L - 1); len = L; } else { t = (r - TL) & (LC - 1); len = LC; }
        const bf16_t* pr = pb + (size_t)r * 768 + ch;
        float x[8], c[8], bgate[8], y[8];
        bf8_to_f(*(const u32x4*)(pr), x); bf8_to_f(*(const u32x4*)(pr + 512), c); bf8_to_f(*(const u32x4*)(pr + 256), bgate);
        const f32x4 w1a = *(const f32x4*)(cw + DCONV + ch), w1b = *(const f32x4*)(cw + DCONV + ch + 4);
#pragma unroll
        for (int q = 0; q < 8; ++q) y[q] = (q < 4 ? w1a[q] : w1b[q - 4]) * (c[q] * x[q]);
        if (t > 0) {
            bf8_to_f(*(const u32x4*)(pr - 768), x); bf8_to_f(*(const u32x4*)(pr - 768 + 512), c);
            const f32x4 wa = *(const f32x4*)(cw + ch), wb = *(const f32x4*)(cw + ch + 4);
#pragma unroll
            for (int q = 0; q < 8; ++q) y[q] += (q < 4 ? wa[q] : wb[q - 4]) * (c[q] * x[q]);
        }
        if (t < len - 1) {
            bf8_to_f(*(const u32x4*)(pr + 768), x); bf8_to_f(*(const u32x4*)(pr + 768 + 512), c);
            const f32x4 wa = *(const f32x4*)(cw + 2 * DCONV + ch), wb = *(const f32x4*)(cw + 2 * DCONV + ch + 4);
#pragma unroll
            for (int q = 0; q < 8; ++q) y[q] += (q < 4 ? wa[q] : wb[q - 4]) * (c[q] * x[q]);
        }
        u32x4 o;
#pragma unroll
        for (int q = 0; q < 4; ++q) o[q] = cvt_pk_bf16(bgate[2 * q] * y[2 * q], bgate[2 * q + 1] * y[2 * q + 1]);
        *(u32x4*)(mix + (size_t)r * D + ch) = o;
    }
}

struct EpiOut { const float* modl; const float* hlat; const bf16_t* hlat16; const float* hctx; bf16_t* hmid;
    __device__ __forceinline__ f32x4 resid(int r, int c) const {
        if (r >= TL) return *(const f32x4*)(hctx + (size_t)(r - TL) * D + c);
        if (hlat16) return bf4_to_f(*(const uint2*)(hlat16 + (size_t)r * D + c));
        return *(const f32x4*)(hlat + (size_t)r * D + c); }
    __device__ __forceinline__ void operator()(int r, int c, float v0, float v1, float v2, float v3) const {
    const int bb = row_bb(r);
    const f32x4 g1 = *(const f32x4*)(modl + ((size_t)bb * 6 + 2) * D + c);
    const f32x4 hv = resid(r, c);
    f32x4 o; o[0] = hv[0] + g1[0] * v0; o[1] = hv[1] + g1[1] * v1; o[2] = hv[2] + g1[2] * v2; o[3] = hv[3] + g1[3] * v3;
    uint2 pk; pk.x = cvt_pk_bf16(o[0], o[1]); pk.y = cvt_pk_bf16(o[2], o[3]); *(uint2*)(hmid + (size_t)r * D + c) = pk; }
    __device__ __forceinline__ f32x4 prefetch(int r, int c) const { return resid(r, c); }
    __device__ __forceinline__ void with_pre(int r, int c, float v0, float v1, float v2, float v3, const f32x4& hv) const {
    const f32x4 g1 = *(const f32x4*)(modl + ((size_t)row_bb(r) * 6 + 2) * D + c);
    f32x4 o; o[0] = hv[0] + g1[0] * v0; o[1] = hv[1] + g1[1] * v1; o[2] = hv[2] + g1[2] * v2; o[3] = hv[3] + g1[3] * v3;
    uint2 pk; pk.x = cvt_pk_bf16(o[0], o[1]); pk.y = cvt_pk_bf16(o[2], o[3]); *(uint2*)(hmid + (size_t)r * D + c) = pk; } };
__device__ __forceinline__ EpiOut make_epi_out(const P& p, int l) {
    return EpiOut{(const float*)(p.ws + WS_MOD) + (size_t)l * 9 * 6 * D, p.in[I_X], l == 0 ? (const bf16_t*)nullptr : (const bf16_t*)p.out, l == 0 ? p.in[I_CTX] : (const float*)(p.ws + WS_HC1), (bf16_t*)(p.ws + WS_HMID)};
}

typedef __attribute__((ext_vector_type(8))) short bf16x8;
typedef __attribute__((ext_vector_type(16))) float f32x16;
constexpr int G_STAGEB = 16384;
constexpr int G_NSTG = 4;
constexpr int LDS_BYTES = G_NSTG * G_STAGEB;

template <class ARow, class ARowN>
__device__ __forceinline__ void gemm_tile(f32x16 (&acc)[2][2], ARow arow, const bf16_t* Bt, int ldb, int K, unsigned char* lds, bool& pre, bool has_next, ARowN narow, const bf16_t* nBt) {
    const int t = TIDX, lane = t & 63, w = __builtin_amdgcn_readfirstlane(t >> 6), wr = w >> 1, wc = w & 1, lr = lane & 31, lh = lane >> 5;
    const int srow = t >> 2, lc = (t & 3) ^ ((srow >> 2) & 3);
    const bf16_t* ap[2]; const bf16_t* bp[2];
#pragma unroll
    for (int i = 0; i < 2; ++i) { ap[i] = arow(srow + 64 * i) + lc * 8; bp[i] = Bt + (size_t)(srow + 64 * i) * ldb + lc * 8; }
    const bf16_t* nap[2]; const bf16_t* nbp[2];
#pragma unroll
    for (int i = 0; i < 2; ++i) { nap[i] = has_next ? narow(srow + 64 * i) + lc * 8 : ap[i]; nbp[i] = has_next ? nBt + (size_t)(srow + 64 * i) * ldb + lc * 8 : bp[i]; }
    float zf = 0.f; asm volatile("" : "+v"(zf));
#pragma unroll
    for (int mi = 0; mi < 2; ++mi)
#pragma unroll
        for (int ni = 0; ni < 2; ++ni)
#pragma unroll
            for (int r = 0; r < 16; ++r) acc[mi][ni][r] = zf;
    const int nk = K >> 5;
    LAS unsigned char* l3 = (LAS unsigned char*)lds;
    const int f = (lr >> 2) & 3;
    const int aoff = (wr * 64 + lr) * 64 + ((lh ^ f) << 4), boff = 8192 + (wc * 64 + lr) * 64 + ((lh ^ f) << 4);
#define G_ISSUE(ks) do { LAS unsigned char* d_ = l3 + ((ks) & 3) * G_STAGEB + w * 1024; \
        __builtin_amdgcn_global_load_lds((const unsigned*)(ap[0] + (ks) * 32), (LAS unsigned*)(d_), 16, 0, 0); \
        __builtin_amdgcn_global_load_lds((const unsigned*)(ap[1] + (ks) * 32), (LAS unsigned*)(d_ + 4096), 16, 0, 0); \
        __builtin_amdgcn_global_load_lds((const unsigned*)(bp[0] + (ks) * 32), (LAS unsigned*)(d_ + 8192), 16, 0, 0); \
        __builtin_amdgcn_global_load_lds((const unsigned*)(bp[1] + (ks) * 32), (LAS unsigned*)(d_ + 12288), 16, 0, 0); } while (0)
#define G_RD(A0, A1, B0, B1, slot, s2) do { const LAS unsigned char* c_ = l3 + (slot) * G_STAGEB; \
        A0 = *(const LAS bf16x8*)(c_ + (aoff ^ ((s2) << 5))); A1 = *(const LAS bf16x8*)(c_ + ((aoff + 2048) ^ ((s2) << 5))); \
        B0 = *(const LAS bf16x8*)(c_ + (boff ^ ((s2) << 5))); B1 = *(const LAS bf16x8*)(c_ + ((boff + 2048) ^ ((s2) << 5))); } while (0)
#define G_MM(A0, A1, B0, B1) do { __builtin_amdgcn_s_setprio(1); \
        acc[0][0] = __builtin_amdgcn_mfma_f32_32x32x16_bf16(B0, A0, acc[0][0], 0, 0, 0); acc[0][1] = __builtin_amdgcn_mfma_f32_32x32x16_bf16(B1, A0, acc[0][1], 0, 0, 0); \
        acc[1][0] = __builtin_amdgcn_mfma_f32_32x32x16_bf16(B0, A1, acc[1][0], 0, 0, 0); acc[1][1] = __builtin_amdgcn_mfma_f32_32x32x16_bf16(B1, A1, acc[1][1], 0, 0, 0); __builtin_amdgcn_s_setprio(0); } while (0)
#define G_ISSUE_NEXT(ks) do { LAS unsigned char* d_ = l3 + ((ks) & 3) * G_STAGEB + w * 1024; \
        __builtin_amdgcn_global_load_lds((const unsigned*)(nap[0] + (ks) * 32), (LAS unsigned*)(d_), 16, 0, 0); \
        __builtin_amdgcn_global_load_lds((const unsigned*)(nap[1] + (ks) * 32), (LAS unsigned*)(d_ + 4096), 16, 0, 0); \
        __builtin_amdgcn_global_load_lds((const unsigned*)(nbp[0] + (ks) * 32), (LAS unsigned*)(d_ + 8192), 16, 0, 0); \
        __builtin_amdgcn_global_load_lds((const unsigned*)(nbp[1] + (ks) * 32), (LAS unsigned*)(d_ + 12288), 16, 0, 0); } while (0)
    __syncthreads();
    const int np = nk >> 1;
    if (!pre) { G_ISSUE(0); G_ISSUE(1); }
    if (1 < np) { G_ISSUE(2); G_ISSUE(3); asm volatile("s_waitcnt vmcnt(8)" ::: "memory"); } else asm volatile("s_waitcnt vmcnt(0)" ::: "memory");
    __builtin_amdgcn_s_barrier();
    bf16x8 fa0, fa1, fb0, fb1, ga0, ga1, gb0, gb1;
    G_RD(fa0, fa1, fb0, fb1, 0, 0);
    for (int m = 0; m < np; ++m) {
        const int sa = (2 * m) & 3, sb = (2 * m + 1) & 3;
        G_RD(ga0, ga1, gb0, gb1, sa, 1);
        __builtin_amdgcn_sched_barrier(0);
        asm volatile("s_waitcnt lgkmcnt(4)" ::: "memory");
        __builtin_amdgcn_sched_barrier(0);
        G_MM(fa0, fa1, fb0, fb1);
        __builtin_amdgcn_sched_barrier(0);
        G_RD(fa0, fa1, fb0, fb1, sb, 0);
        __builtin_amdgcn_sched_barrier(0);
        asm volatile("s_waitcnt lgkmcnt(4)" ::: "memory");
        __builtin_amdgcn_sched_barrier(0);
        G_MM(ga0, ga1, gb0, gb1);
        __builtin_amdgcn_sched_barrier(0);
        G_RD(ga0, ga1, gb0, gb1, sb, 1);
        __builtin_amdgcn_sched_barrier(0);
        asm volatile("s_waitcnt lgkmcnt(4)" ::: "memory");
        __builtin_amdgcn_sched_barrier(0);
        G_MM(fa0, fa1, fb0, fb1);
        __builtin_amdgcn_sched_barrier(0);
        if (m + 1 < np) {
            asm volatile("s_waitcnt vmcnt(0) lgkmcnt(0)" ::: "memory");
            __builtin_amdgcn_s_barrier();
            if (m + 2 < np) { G_ISSUE(2 * m + 4); G_ISSUE(2 * m + 5); }
            else if (has_next) { G_ISSUE_NEXT(0); G_ISSUE_NEXT(1); }
            G_RD(fa0, fa1, fb0, fb1, (2 * m + 2) & 3, 0);
        } else {
            asm volatile("s_waitcnt lgkmcnt(0)" ::: "memory");
        }
        __builtin_amdgcn_sched_barrier(0);
        G_MM(ga0, ga1, gb0, gb1);
        __builtin_amdgcn_sched_barrier(0);
    }
    pre = has_next;
#undef G_RD
#undef G_MM
#undef G_ISSUE
#undef G_ISSUE_NEXT
}
template <class ARow>
__device__ __forceinline__ void gemm_tile(f32x16 (&acc)[2][2], ARow arow, const bf16_t* Bt, int ldb, int K, unsigned char* lds) {
    bool pre = false; gemm_tile(acc, arow, Bt, ldb, K, lds, pre, false, arow, Bt);
}
template <class F>
__device__ __forceinline__ void acc_foreach4(const f32x16 (&acc)[2][2], F f) {
    const int lane = TIDX & 63, w = (TIDX >> 6) & 3, wr = w >> 1, wc = w & 1, lr = lane & 31, lh = lane >> 5;
#pragma unroll
    for (int mi = 0; mi < 2; ++mi)
#pragma unroll
        for (int ni = 0; ni < 2; ++ni)
#pragma unroll
            for (int g = 0; g < 4; ++g)
                f(wr * 64 + mi * 32 + lr, wc * 64 + ni * 32 + 8 * g + 4 * lh, acc[mi][ni][4 * g], acc[mi][ni][4 * g + 1], acc[mi][ni][4 * g + 2], acc[mi][ni][4 * g + 3]);
}
constexpr int C_LD = 132, C_OFF = 32768;
template <class F>
__device__ __forceinline__ void acc_foreach4_lds(const f32x16 (&acc)[2][2], unsigned char* lds, F f) {
    float* C = (float*)(lds + C_OFF);
    const int t = TIDX, lane = t & 63, w = (t >> 6) & 3, wr = w >> 1, wc = w & 1, lr = lane & 31, lh = lane >> 5;
#pragma unroll
    for (int h = 0; h < 2; ++h) {
        __syncthreads();
        if (wr == h) {
#pragma unroll
            for (int mi = 0; mi < 2; ++mi)
#pragma unroll
                for (int ni = 0; ni < 2; ++ni)
#pragma unroll
                    for (int g = 0; g < 4; ++g) {
                        f32x4 v; v[0] = acc[mi][ni][4 * g]; v[1] = acc[mi][ni][4 * g + 1]; v[2] = acc[mi][ni][4 * g + 2]; v[3] = acc[mi][ni][4 * g + 3];
                        *(f32x4*)(C + (mi * 32 + lr) * C_LD + wc * 64 + ni * 32 + 8 * g + 4 * lh) = v;
                    }
        }
        __syncthreads();
#pragma unroll
        for (int i = 0; i < 8; ++i) {
            const int idx = t + 256 * i, r = idx >> 5, c = (idx & 31) * 4;
            const f32x4 v = *(const f32x4*)(C + r * C_LD + c);
            f(h * 64 + r, c, v[0], v[1], v[2], v[3]);
        }
    }
}
constexpr float SLAB_SCALE = 32.f;
__device__ __forceinline__ unsigned pack4_fp8(float a, float b, float c, float d) {
    a = fminf(fmaxf(a * SLAB_SCALE, -448.f), 448.f); b = fminf(fmaxf(b * SLAB_SCALE, -448.f), 448.f);
    c = fminf(fmaxf(c * SLAB_SCALE, -448.f), 448.f); d = fminf(fmaxf(d * SLAB_SCALE, -448.f), 448.f);
    int w = __builtin_amdgcn_cvt_pk_fp8_f32(a, b, 0, false);
    w = __builtin_amdgcn_cvt_pk_fp8_f32(c, d, w, true);
    return (unsigned)w;
}
__device__ __forceinline__ uint2 pack4(float a, float b, float c, float d) { uint2 o; o.x = cvt_pk_bf16(a, b); o.y = cvt_pk_bf16(c, d); return o; }
struct ARowPlain { const bf16_t* A; int lda; __device__ __forceinline__ const bf16_t* operator()(int m) const { return A + (size_t)m * lda; } };

template <class Epi>
__device__ __forceinline__ void gemm_stage(const bf16_t* A, int lda, const bf16_t* Bt, int ldb, int M, int N, int K, Epi epi, unsigned char* lds) {
    const int tn = N / 128, tm = M / 128;
    int t_end, t_step;
    bool pre = false;
    for (int tile = xcd_first(tm * tn, t_end, t_step); tile < t_end; tile += t_step) {
        const int m0 = (tile / tn) * 128, n0 = (tile % tn) * 128;
        const int nx = tile + t_step; const bool hn = nx < t_end;
        const int nm0 = hn ? (nx / tn) * 128 : m0, nn0 = hn ? (nx % tn) * 128 : n0;
        f32x16 acc[2][2];
        gemm_tile(acc, ARowPlain{A + (size_t)m0 * lda, lda}, Bt + (size_t)n0 * ldb, ldb, K, lds, pre, hn, ARowPlain{A + (size_t)nm0 * lda, lda}, Bt + (size_t)nn0 * ldb);
        acc_foreach4_lds(acc, lds, [&](int r, int c, float v0, float v1, float v2, float v3) { epi(m0 + r, n0 + c, v0, v1, v2, v3); });
    }
}
template <class Epi>
__device__ __forceinline__ void gemm_stage_pre(const bf16_t* A, int lda, const bf16_t* Bt, int ldb, int M, int N, int K, Epi epi, unsigned char* lds) {
    const int tn = N / 128, tm = M / 128;
    int t_end, t_step;
    bool pre = false;
    for (int tile = xcd_first(tm * tn, t_end, t_step); tile < t_end; tile += t_step) {
        const int m0 = (tile / tn) * 128, n0 = (tile % tn) * 128;
        const int nx = tile + t_step; const bool hn = nx < t_end;
        const int nm0 = hn ? (nx / tn) * 128 : m0, nn0 = hn ? (nx % tn) * 128 : n0;
        f32x4 pf[16];
        { const int t = TIDX;
#pragma unroll
          for (int i = 0; i < 16; ++i) { const int idx = t + 256 * (i & 7); pf[i] = epi.prefetch(m0 + (i >> 3) * 64 + (idx >> 5), n0 + (idx & 31) * 4); } }
        f32x16 acc[2][2];
        gemm_tile(acc, ARowPlain{A + (size_t)m0 * lda, lda}, Bt + (size_t)n0 * ldb, ldb, K, lds, pre, hn, ARowPlain{A + (size_t)nm0 * lda, lda}, Bt + (size_t)nn0 * ldb);
        float* C = (float*)(lds + C_OFF);
        const int t = TIDX, lane = t & 63, w = (t >> 6) & 3, wr = w >> 1, wc = w & 1, lr = lane & 31, lh = lane >> 5;
#pragma unroll
        for (int h = 0; h < 2; ++h) {
            __syncthreads();
            if (wr == h) {
#pragma unroll
                for (int mi = 0; mi < 2; ++mi)
#pragma unroll
                    for (int ni = 0; ni < 2; ++ni)
#pragma unroll
                        for (int g = 0; g < 4; ++g) {
                            f32x4 v; v[0] = acc[mi][ni][4 * g]; v[1] = acc[mi][ni][4 * g + 1]; v[2] = acc[mi][ni][4 * g + 2]; v[3] = acc[mi][ni][4 * g + 3];
                            *(f32x4*)(C + (mi * 32 + lr) * C_LD + wc * 64 + ni * 32 + 8 * g + 4 * lh) = v;
                        }
            }
            __syncthreads();
#pragma unroll
            for (int i = 0; i < 8; ++i) {
                const int idx = t + 256 * i, r = idx >> 5, c = (idx & 31) * 4;
                const f32x4 v = *(const f32x4*)(C + r * C_LD + c);
                epi.with_pre(m0 + h * 64 + r, n0 + c, v[0], v[1], v[2], v[3], pf[h * 8 + i]);
            }
        }
    }
}
struct TrDesc { const float* src; size_t sk; bf16_t* dst; size_t dld; };
__device__ __forceinline__ void tr_item2(const TrDesc& d0, const TrDesc& d1, bool has1, bf16_t* tl) {
    const int t = TIDX, kr = t >> 3, nq = (t & 7) * 4;
    f32x4 v0[4], v1[4];
#pragma unroll
    for (int ps = 0; ps < 4; ++ps) v0[ps] = *(const f32x4*)(d0.src + (size_t)(kr + 32 * ps) * d0.sk + nq);
    if (has1) {
#pragma unroll
        for (int ps = 0; ps < 4; ++ps) v1[ps] = *(const f32x4*)(d1.src + (size_t)(kr + 32 * ps) * d1.sk + nq);
    }
    __syncthreads();
#pragma unroll
    for (int ps = 0; ps < 4; ++ps)
#pragma unroll
        for (int j = 0; j < 4; ++j) tl[(nq + j) * 136 + kr + 32 * ps] = f2bf(v0[ps][j]);
    if (has1) {
#pragma unroll
        for (int ps = 0; ps < 4; ++ps)
#pragma unroll
            for (int j = 0; j < 4; ++j) tl[32 * 136 + (nq + j) * 136 + kr + 32 * ps] = f2bf(v1[ps][j]);
    }
    __syncthreads();
    const int n = t >> 3, part = t & 7;
    { const u32x4 a = *(const u32x4*)(tl + n * 136 + part * 16), b = *(const u32x4*)(tl + n * 136 + part * 16 + 8);
      bf16_t* o = d0.dst + (size_t)n * d0.dld + part * 16; *(u32x4*)o = a; *(u32x4*)(o + 8) = b; }
    if (has1) { const u32x4 a = *(const u32x4*)(tl + 32 * 136 + n * 136 + part * 16), b = *(const u32x4*)(tl + 32 * 136 + n * 136 + part * 16 + 8);
      bf16_t* o = d1.dst + (size_t)n * d1.dld + part * 16; *(u32x4*)o = a; *(u32x4*)(o + 8) = b; }
}
constexpr int PW_IN = 1, PW_OUT = 2, PW_GLU = 4, PW_GU = 8, PW_DN = 16, PW_ALL = 31;
__device__ __forceinline__ TrDesc prep_desc(const P& p, int l, int part, int r) {
    if (part == PW_IN) { const int nt = r >> 3, kt = r & 7; return TrDesc{p.in[I_WIN] + (size_t)l * D * DIN + (size_t)kt * 128 * DIN + nt * 32, DIN, (bf16_t*)(p.ws + WS_WTIN) + (size_t)nt * 32 * D + kt * 128, D}; }
    if (part == PW_OUT) { const int nt = r >> 3, kt = r & 7; return TrDesc{p.in[I_WOUT] + (size_t)l * D * D + (size_t)kt * 128 * D + nt * 32, D, (bf16_t*)(p.ws + WS_WTOUT) + (size_t)nt * 32 * D + kt * 128, D}; }
    if (part == PW_GLU) { const int nt = r >> 1, kt = r & 1; return TrDesc{p.in[I_WGLU] + (size_t)l * DSSM * DSSM + (size_t)kt * 128 * DSSM + nt * 32, DSSM, (bf16_t*)(p.ws + WS_WTGLU) + (size_t)nt * 32 * DSSM + kt * 128, DSSM}; }
    if (part == PW_GU) {
        const int kt = r & 7, q = (r >> 3) & 3, j = (r >> 5) & 1, e = r >> 6;
        const int wc = q >> 1, ni = q & 1, unit0 = j * 64 + wc * 32;
        const float* sp; size_t sk;
        if (e < NE) { sp = p.in[ni ? I_WEU : I_WEG] + ((size_t)(l * D + kt * 128) * NE + e) * DE + unit0; sk = (size_t)NE * DE; }
        else { sp = p.in[ni ? I_WSU : I_WSG] + (size_t)(l * D + kt * 128) * DE + unit0; sk = DE; }
        return TrDesc{sp, sk, (bf16_t*)(p.ws + WS_WGU) + ((size_t)(e * 2 + j) * 128 + q * 32) * D + kt * 128, D};
    }
    {
        const int nt = r & 31, e = r >> 5;
        const float* sp = (e < NE ? p.in[I_WED] + (size_t)(l * NE + e) * DE * D : p.in[I_WSD] + (size_t)l * DE * D) + nt * 32;
        return TrDesc{sp, D, (bf16_t*)(p.ws + WS_WD) + ((size_t)e * D + nt * 32) * DE, DE};
    }
}
__device__ __forceinline__ void st_prep_weights(const P& p, int l, unsigned char* lds, int parts) {
    bf16_t* tl = (bf16_t*)lds;
    constexpr int N_IN_ = (DIN / 32) * 8, N_OUT = (D / 32) * 8, N_GLU = (DSSM / 32) * 2, N_GU = 33 * 2 * 4 * 8, N_DN = 33 * (D / 32);
    const int cnts[5] = {N_IN_, N_OUT, N_GLU, N_GU, N_DN};
#pragma unroll
    for (int pi = 0; pi < 5; ++pi) {
        const int part = 1 << pi;
        if (!(parts & part)) continue;
        const int G = gridDim.x;
        for (int r = BIDX; r < cnts[pi]; r += 2 * G) {
            const bool has1 = r + G < cnts[pi];
            const TrDesc d0 = prep_desc(p, l, part, r), d1 = prep_desc(p, l, part, has1 ? r + G : r);
            tr_item2(d0, d1, has1, tl);
        }
    }
    __syncthreads();
}
struct EpiStoreBf { bf16_t* C; int ldc; __device__ __forceinline__ void operator()(int r, int c, float v0, float v1, float v2, float v3) const { *(uint2*)(C + (size_t)r * ldc + c) = pack4(v0, v1, v2, v3); } };


__device__ __forceinline__ void st_rbias(const P& p, int l, float* lds) {
    const int lane = TIDX & 63, w = TIDX >> 6;
    const float* rw = p.in[I_RW] + (size_t)l * D * NE;
    for (int o = BIDX * 4 + w; o < 9 * 32; o += gridDim.x * 4) {
        const int bb = o >> 5, e = o & 31;
        const float* sh2 = mod_vec(p, l, bb, 3);
        float a = 0.f;
#pragma unroll
        for (int j = 0; j < 16; ++j) { const int k = j * 64 + lane; a += sh2[k] * rw[(size_t)k * NE + e]; }
        a = wave_sum(a);
        if (lane == 0) ((float*)(p.ws + WS_RBIAS))[(l * 9 + bb) * 32 + e] = a;
    }
    const float* g2 = p.in[I_N2G] + l * D;
    for (int idx = BIDX * NT + TIDX; idx < 9 * D; idx += gridDim.x * NT) {
        const int bb = idx >> 10, k = idx & (D - 1);
        ((float*)(p.ws + WS_GS2))[(size_t)(l * 9 + bb) * D + k] = g2[k] * (1.f + mod_vec(p, l, bb, 4)[k]);
    }
}
template <bool DRY = false>
__device__ __forceinline__ void st_router2(const P& p, int l, unsigned char* ldsb) {
    float* part = (float*)ldsb;
    float* ssq = part + 4 * 32 * 33;
    float* sc = ssq + 128;
    float* rinvs = sc + 32 * 33;
    int* hist = (int*)(rinvs + 32);
    int* gbase = hist + 32;
    const int t = TIDX, lane = t & 63, w = t >> 6, i = lane & 31, hf = lane >> 5;
    const int nrows = l == 0 ? TA : TL;
    const float* rw = p.in[I_RW] + (size_t)l * D * NE;
    int* cnt = CNT_PTR(p, l);
    int* lcode = (int*)(p.ws + WS_LCODE);
    float* lw = (float*)(p.ws + WS_LW);
    bf16_t* xn2 = (bf16_t*)(p.ws + WS_BUFA);
    for (int item = BIDX; item < nrows / 32; item += gridDim.x) {
        const int r0 = item * 32, bb = row_bb(r0);
        const float* gs2 = (const float*)(p.ws + WS_GS2) + (size_t)(l * 9 + bb) * D;
        const float* sh2 = mod_vec(p, l, bb, 3);
        const int kb = w * 256 + hf * 128;
        const bf16_t* src = hmid_row(p, r0 + i) + kb;
        const float* gsp = gs2 + kb;
        const float* rwp = rw + (size_t)kb * NE + i;
        f32x16 acc;
        float zf = 0.f; asm volatile("" : "+v"(zf));
#pragma unroll
        for (int r = 0; r < 16; ++r) acc[r] = zf;
        float ss = 0.f;
        uint2 xa[4], xb[4]; f32x4 ga[4], gb[4]; float wa[16], wb[16];
        const bool dual = item + (int)gridDim.x < nrows / 32;
        const int r0b = dual ? r0 + (int)gridDim.x * 32 : r0, bbb = row_bb(r0b);
        const float* gs2b = (const float*)(p.ws + WS_GS2) + (size_t)(l * 9 + bbb) * D;
        const float* sh2b = mod_vec(p, l, bbb, 3);
        const bf16_t* srcb = hmid_row(p, r0b + i) + kb;
        const float* gspb = gs2b + kb;
        f32x16 acc2;
#pragma unroll
        for (int r = 0; r < 16; ++r) acc2[r] = zf;
        float ss2 = 0.f;
        uint2 xa2[4], xb2[4]; f32x4 ga2[4], gb2[4];
#define R_LOAD2(X, G, cb) do { _Pragma("unroll") for (int q = 0; q < 4; ++q) { const int k = ((cb) * 4 + q) * 4; X[q] = *(const uint2*)(srcb + k); G[q] = *(const f32x4*)(gspb + k); } } while (0)
#define R_COMP2(X, G, W) do { _Pragma("unroll") for (int q = 0; q < 4; ++q) { \
            const float xf[4] = {__uint_as_float(X[q].x << 16), __uint_as_float(X[q].x & 0xffff0000u), __uint_as_float(X[q].y << 16), __uint_as_float(X[q].y & 0xffff0000u)}; \
            ss2 += xf[0] * xf[0] + xf[1] * xf[1] + xf[2] * xf[2] + xf[3] * xf[3]; \
            _Pragma("unroll") for (int j = 0; j < 4; ++j) acc2 = __builtin_amdgcn_mfma_f32_32x32x2f32(xf[j] * G[q][j], W[q * 4 + j], acc2, 0, 0, 0); } } while (0)
#define R_LOAD(X, G, W, cb) do { _Pragma("unroll") for (int q = 0; q < 4; ++q) { const int k = ((cb) * 4 + q) * 4; X[q] = *(const uint2*)(src + k); G[q] = *(const f32x4*)(gsp + k); \
            _Pragma("unroll") for (int j = 0; j < 4; ++j) W[q * 4 + j] = rwp[(size_t)(k + j) * NE]; } } while (0)
#define R_COMP(X, G, W) do { _Pragma("unroll") for (int q = 0; q < 4; ++q) { \
            const float xf[4] = {__uint_as_float(X[q].x << 16), __uint_as_float(X[q].x & 0xffff0000u), __uint_as_float(X[q].y << 16), __uint_as_float(X[q].y & 0xffff0000u)}; \
            ss += xf[0] * xf[0] + xf[1] * xf[1] + xf[2] * xf[2] + xf[3] * xf[3]; \
            _Pragma("unroll") for (int j = 0; j < 4; ++j) acc = __builtin_amdgcn_mfma_f32_32x32x2f32(xf[j] * G[q][j], W[q * 4 + j], acc, 0, 0, 0); } } while (0)
        R_LOAD(xa, ga, wa, 0); if (dual) R_LOAD2(xa2, ga2, 0);
#pragma unroll 1
        for (int cb = 0; cb < 8; cb += 2) {
            R_LOAD(xb, gb, wb, cb + 1); if (dual) R_LOAD2(xb2, gb2, cb + 1);
            R_COMP(xa, ga, wa); if (dual) R_COMP2(xa2, ga2, wa);
            if (cb + 2 < 8) { R_LOAD(xa, ga, wa, cb + 2); if (dual) R_LOAD2(xa2, ga2, cb + 2); }
            R_COMP(xb, gb, wb); if (dual) R_COMP2(xb2, gb2, wb);
        }
#undef R_LOAD
#undef R_COMP
#undef R_LOAD2
#undef R_COMP2
        auto post = [&](const int r0, const int bb, const float* gs2, const float* sh2, const f32x16& acc, float ss) {
        ss += __shfl_xor(ss, 32);
        __syncthreads();
        if (hf == 0) ssq[w * 32 + i] = ss;
        if (t < 32) hist[t] = 0;
#pragma unroll
        for (int r = 0; r < 16; ++r) part[(w * 32 + (r & 3) + 8 * (r >> 2) + 4 * hf) * 33 + i] = acc[r];
        __syncthreads();
        for (int idx = t; idx < 1024; idx += NT) {
            const int row = idx >> 5, e = idx & 31;
            const float logit = part[(0 * 32 + row) * 33 + e] + part[(1 * 32 + row) * 33 + e] + part[(2 * 32 + row) * 33 + e] + part[(3 * 32 + row) * 33 + e];
            const float rinv = rsqrtf((ssq[row] + ssq[32 + row] + ssq[64 + row] + ssq[96 + row]) * (1.f / D) + 1e-6f);
            sc[row * 33 + e] = sigmoid_f(rinv * logit + ((const float*)(p.ws + WS_RBIAS))[(l * 9 + bb) * 32 + e]);
            if (e == 0) rinvs[row] = rinv;
        }
        __syncthreads();
        if (t < 32) {
            const int r = r0 + t;
            float sel[32];
#pragma unroll
            for (int e = 0; e < 32; ++e) sel[e] = sc[t * 33 + e] + p.in[I_RB][l * NE + e];
            int bi[4]; float sv[4]; float sum = 0.f;
#pragma unroll
            for (int k = 0; k < 4; ++k) {
                float best = -1e30f; int b = 0;
#pragma unroll
                for (int e = 0; e < 32; ++e) if (sel[e] > best) { best = sel[e]; b = e; }
#pragma unroll
                for (int e = 0; e < 32; ++e) if (e == b) sel[e] = -1e30f;
                bi[k] = b; sv[k] = sc[t * 33 + b]; sum += sv[k];
            }
            int rank[4];
#pragma unroll
            for (int k = 0; k < 4; ++k) rank[k] = atomicAdd(&hist[bi[k]], 1);
            __builtin_amdgcn_s_waitcnt(0xc07f);
            __builtin_amdgcn_wave_barrier();
            { const int hc = hist[t]; gbase[t] = (hc > 0 && !DRY) ? atomicAdd(&cnt[t * 64], hc) : 0; }
            __builtin_amdgcn_s_waitcnt(0xc07f);
            __builtin_amdgcn_wave_barrier();
#pragma unroll
            for (int k = 0; k < 4; ++k) {
                if (DRY) { if (sv[k] / sum == 12345.f) lw[0] = 0.f; } else {
                const int pos = gbase[bi[k]] + rank[k];
                lcode[(size_t)bi[k] * TA + pos] = r * 4 + k;
                lw[(size_t)bi[k] * TA + pos] = sv[k] / sum * 2.5f; }
            }
        }
        {
            float gs[16], sh[16];
#pragma unroll
            for (int q = 0; q < 16; ++q) { const int k = (q >> 3) * 512 + 8 * lane + (q & 7); gs[q] = gs2[k]; sh[q] = sh2[k]; }
            for (int rr8 = 0; rr8 < 8; rr8 += 4) {
                u32x4 xv[4][2];
#pragma unroll
                for (int u = 0; u < 4; ++u) {
                    const bf16_t* s2 = hmid_row(p, r0 + w * 8 + rr8 + u);
#pragma unroll
                    for (int h2 = 0; h2 < 2; ++h2) xv[u][h2] = *(const u32x4*)(s2 + h2 * 512 + 8 * lane);
                }
#pragma unroll
                for (int u = 0; u < 4; ++u) {
                    const int rho = w * 8 + rr8 + u;
                    const float rr = rinvs[rho];
                    bf16_t* dst = xn2 + (size_t)(r0 + rho) * D;
#pragma unroll
                    for (int h2 = 0; h2 < 2; ++h2) {
                        float xq[8]; bf8_to_f(xv[u][h2], xq);
                        const float x0[4] = {xq[0], xq[1], xq[2], xq[3]}, x1[4] = {xq[4], xq[5], xq[6], xq[7]};
                        u32x4 o;
                        o[0] = cvt_pk_bf16(x0[0] * rr * gs[h2 * 8 + 0] + sh[h2 * 8 + 0], x0[1] * rr * gs[h2 * 8 + 1] + sh[h2 * 8 + 1]);
                        o[1] = cvt_pk_bf16(x0[2] * rr * gs[h2 * 8 + 2] + sh[h2 * 8 + 2], x0[3] * rr * gs[h2 * 8 + 3] + sh[h2 * 8 + 3]);
                        o[2] = cvt_pk_bf16(x1[0] * rr * gs[h2 * 8 + 4] + sh[h2 * 8 + 4], x1[1] * rr * gs[h2 * 8 + 5] + sh[h2 * 8 + 5]);
                        o[3] = cvt_pk_bf16(x1[2] * rr * gs[h2 * 8 + 6] + sh[h2 * 8 + 6], x1[3] * rr * gs[h2 * 8 + 7] + sh[h2 * 8 + 7]);
                        *(u32x4*)(dst + h2 * 512 + 8 * lane) = o;
                    }
                }
            }
        }
        };
        post(r0, bb, gs2, sh2, acc, ss);
        if (dual) { post(r0b, bbb, gs2b, sh2b, acc2, ss2); item += gridDim.x; }
    }
    __syncthreads();
}

constexpr int LDS_CSTAGE = 128 * C_LD * 4;
constexpr int M2_A = 0, M2_B = 32768, M2_C = 57344, M2_CLD = 144;
constexpr int MOE_LDS_LIST = M2_C + 128 * M2_CLD;
constexpr int LDS_MOE = MOE_LDS_LIST + 128 * 4 + 128 * 4 + 64 * 4;
constexpr int LDS_MODB = (9 * D + 9 * 8 * 32) * 4;
constexpr int LDS_TOTAL = LDS_MOE > LDS_MODB ? LDS_MOE : LDS_MODB;
struct ARowCode { const bf16_t* base; const int* codes; int mode; __device__ __forceinline__ const bf16_t* operator()(int m) const {
    const int c = codes[m];
    if (mode == 0) return base + (size_t)(c < 0 ? 0 : (c >> 2)) * D;
    return base + (size_t)(c < 0 ? 0 : (c >> 2) * 5 + (c & 3)) * DE; } };
__device__ __forceinline__ void moe_tstart(const P& p, int l, int* ts) {
    if (TIDX == 0) { const int* cnt = CNT_PTR(p, l); int a = 0; for (int e = 0; e < NE; ++e) { ts[e] = a; a += (cnt[e * 64] + 127) >> 7; } ts[NE] = a; }
    __syncthreads();
}
__device__ __forceinline__ void st_moe1(const P& p, int l, unsigned char* lds) {
    int* codes = (int*)(lds + MOE_LDS_LIST); float* wts = (float*)(codes + 128); int* ts = (int*)(wts + 128);
    const int nrows = l == 0 ? TA : TL;
    const int* cnt = CNT_PTR(p, l);
    const int* lcode = (const int*)(p.ws + WS_LCODE);
    const float* lw = (const float*)(p.ws + WS_LW);
    const bf16_t* xn2 = (const bf16_t*)(p.ws + WS_BUFA);
    bf16_t* hid = (bf16_t*)(p.ws + WS_HID);
    const bf16_t* wgu = (const bf16_t*)(p.ws + WS_WGU);
    moe_tstart(p, l, ts);
    const int nrt = ts[NE], nsh = nrows / 128, total = (nrt + nsh) * 2;
    const int lane = TIDX & 63, w = TIDX >> 6, wr = w >> 1, wc = w & 1, lr = lane & 31, lh = lane >> 5;
    int t_end, t_step;
    for (int tile = xcd_first(total, t_end, t_step); tile < t_end; tile += t_step) {
        const int rt = tile >> 1, j = tile & 1;
        int e, m0, valid;
        if (rt < nrt) { e = 0; while (ts[e + 1] <= rt) ++e; m0 = (rt - ts[e]) * 128; valid = cnt[e * 64] - m0; if (valid > 128) valid = 128; }
        else { e = NE; m0 = (rt - nrt) * 128; valid = 128; }
        __syncthreads();
        if (TIDX < 128) {
            const int m = TIDX;
            if (e < NE) { const bool ok = m < valid; codes[m] = ok ? lcode[(size_t)e * TA + m0 + m] : -1; wts[m] = ok ? lw[(size_t)e * TA + m0 + m] : 0.f; }
            else { codes[m] = (m0 + m) * 4; wts[m] = 1.f; }
        }
        __syncthreads();
        f32x16 acc[2][2];
        gemm_tile(acc, ARowCode{xn2, codes, 0}, wgu + (size_t)((e * 2 + j) * 128) * D, D, D, lds);
#pragma unroll
        for (int mi = 0; mi < 2; ++mi) {
            const int m = wr * 64 + mi * 32 + lr;
            const int c = codes[m];
            if (c >= 0) {
                const float wt = wts[m];
                const size_t hrow = e < NE ? (size_t)(c >> 2) * 5 + (c & 3) : (size_t)(c >> 2) * 5 + 4;
#pragma unroll
                for (int g = 0; g < 4; ++g) {
                    float h[4];
#pragma unroll
                    for (int q = 0; q < 4; ++q) h[q] = silu_f(acc[mi][0][4 * g + q]) * acc[mi][1][4 * g + q] * wt;
                    *(uint2*)(hid + hrow * DE + j * 64 + wc * 32 + 8 * g + 4 * lh) = pack4(h[0], h[1], h[2], h[3]);
                }
            }
        }
    }
}
__device__ __forceinline__ void st_moe2(const P& p, int l, unsigned char* lds) {
    int* codes = (int*)(lds + MOE_LDS_LIST); float* wts = (float*)(codes + 128); int* ts = (int*)(wts + 128);
    const int* cnt = CNT_PTR(p, l);
    const int* lcode = (const int*)(p.ws + WS_LCODE);
    const bf16_t* hid = (const bf16_t*)(p.ws + WS_HID);
    unsigned char* slab = (unsigned char*)(p.ws + WS_SLAB);
    const bf16_t* wd = (const bf16_t*)(p.ws + WS_WD);
    moe_tstart(p, l, ts);
    const int nrt = ts[NE], total = nrt * 8;
    int t_end, t_step;
    for (int tile = xcd_first(total, t_end, t_step); tile < t_end; tile += t_step) {
        const int rt = tile >> 3, n0 = (tile & 7) * 128;
        int e = 0; while (ts[e + 1] <= rt) ++e;
        const int m0 = (rt - ts[e]) * 128; int valid = cnt[e * 64] - m0; if (valid > 128) valid = 128;
        __syncthreads();
        if (TIDX < 128) { const int m = TIDX; codes[m] = m < valid ? lcode[(size_t)e * TA + m0 + m] : -1; }
        __syncthreads();
        f32x16 acc[2][2];
        gemm_tile(acc, ARowCode{hid, codes, 1}, wd + ((size_t)e * D + n0) * DE, DE, DE, lds);
        acc_foreach4_lds(acc, lds, [&](int r, int c, float v0, float v1, float v2, float v3) { const int code = codes[r]; if (code >= 0) *(unsigned*)(slab + (size_t)code * D + n0 + c) = pack4_fp8(v0, v1, v2, v3); });
    }
}
constexpr int M2_NPER = 4;
__device__ __forceinline__ void st_moe2s(const P& p, int l, unsigned char* lds) {
    int* codes = (int*)(lds + MOE_LDS_LIST); float* wts = (float*)(codes + 128); int* ts = (int*)(wts + 128);
    const int* cnt = CNT_PTR(p, l);
    const int* lcode = (const int*)(p.ws + WS_LCODE);
    const bf16_t* hid = (const bf16_t*)(p.ws + WS_HID);
    unsigned char* slab = (unsigned char*)(p.ws + WS_SLAB);
    const bf16_t* wd = (const bf16_t*)(p.ws + WS_WD);
    moe_tstart(p, l, ts);
    const int nrt = ts[NE], total4 = nrt * 2, GG = (int)gridDim.x;
    const int full = (total4 / GG) * GG, rem4 = total4 - full;
    const int tper = rem4 * 4 <= GG ? 1 : (rem4 * 2 <= GG ? 2 : 4), tmul = 4 / tper;
    const int t = TIDX, lane = t & 63, w = __builtin_amdgcn_readfirstlane(t >> 6), wr = w >> 1, wc = w & 1, lr = lane & 31, lh = lane >> 5;
    const int srow = t >> 2, lc = (t & 3) ^ ((srow >> 2) & 3);
    const int f = (lr >> 2) & 3;
    const int aoff = (wr * 64 + lr) * 64 + ((lh ^ f) << 4), boff = (wc * 64 + lr) * 64 + ((lh ^ f) << 4);
    LAS unsigned char* l3 = (LAS unsigned char*)lds;
#pragma unroll 1
    for (int phase = 0; phase < 2; ++phase) {
    const int n_items = phase == 0 ? full : rem4 * tmul, nper = phase == 0 ? 4 : tper, S = 4 * nper;
    int t_end, t_step;
    for (int it = xcd_first(n_items, t_end, t_step); it < t_end; it += t_step) {
        const int item4 = phase == 0 ? it : full + it / tmul, sub = phase == 0 ? 0 : it % tmul;
        const int rt = item4 >> 1, n0 = (item4 & 1) * 512 + sub * (128 * nper);
        int e = 0; while (ts[e + 1] <= rt) ++e;
        const int m0 = (rt - ts[e]) * 128; int valid = cnt[e * 64] - m0; if (valid > 128) valid = 128;
        __syncthreads();
        if (t < 128) codes[t] = t < valid ? lcode[(size_t)e * TA + m0 + t] : -1;
        __syncthreads();
        const bf16_t* ap[2]; const bf16_t* bp[2];
#pragma unroll
        for (int i = 0; i < 2; ++i) {
            const int c = codes[srow + 64 * i];
            ap[i] = hid + (size_t)(c < 0 ? 0 : (c >> 2) * 5 + (c & 3)) * DE + lc * 8;
            bp[i] = wd + ((size_t)e * D + n0 + srow + 64 * i) * DE + lc * 8;
        }
#pragma unroll
        for (int ks = 0; ks < 4; ++ks) {
            __builtin_amdgcn_global_load_lds((const unsigned*)(ap[0] + ks * 32), (LAS unsigned*)(l3 + M2_A + ks * 8192 + w * 1024), 16, 0, 0);
            __builtin_amdgcn_global_load_lds((const unsigned*)(ap[1] + ks * 32), (LAS unsigned*)(l3 + M2_A + ks * 8192 + w * 1024 + 4096), 16, 0, 0);
        }
#define M2_ISSUE(s_) do { const int nt_ = (s_) >> 2, ks_ = (s_) & 3; LAS unsigned char* d_ = l3 + M2_B + ((s_) % 3) * 8192 + w * 1024; \
        __builtin_amdgcn_global_load_lds((const unsigned*)(bp[0] + (size_t)nt_ * 128 * DE + ks_ * 32), (LAS unsigned*)(d_), 16, 0, 0); \
        __builtin_amdgcn_global_load_lds((const unsigned*)(bp[1] + (size_t)nt_ * 128 * DE + ks_ * 32), (LAS unsigned*)(d_ + 4096), 16, 0, 0); } while (0)
        M2_ISSUE(0); M2_ISSUE(1);
        f32x16 acc[2][2];
        float zf = 0.f; asm volatile("" : "+v"(zf));
#pragma unroll
        for (int mi = 0; mi < 2; ++mi)
#pragma unroll
            for (int ni = 0; ni < 2; ++ni)
#pragma unroll
                for (int r = 0; r < 16; ++r) acc[mi][ni][r] = zf;
#pragma unroll 1
        for (int s = 0; s < S; ++s) {
            if (s + 1 < S) asm volatile("s_waitcnt vmcnt(2) lgkmcnt(0)" ::: "memory"); else asm volatile("s_waitcnt vmcnt(0) lgkmcnt(0)" ::: "memory");
            __builtin_amdgcn_s_barrier();
            if (s + 2 < S) M2_ISSUE(s + 2);
            const int ks = s & 3;
            const LAS unsigned char* ca = l3 + M2_A + ks * 8192;
            const LAS unsigned char* cb = l3 + M2_B + (s % 3) * 8192;
#pragma unroll
            for (int s2 = 0; s2 < 2; ++s2) {
                const bf16x8 a0 = *(const LAS bf16x8*)(ca + (aoff ^ (s2 << 5))), a1 = *(const LAS bf16x8*)(ca + ((aoff + 2048) ^ (s2 << 5)));
                const bf16x8 b0 = *(const LAS bf16x8*)(cb + (boff ^ (s2 << 5))), b1 = *(const LAS bf16x8*)(cb + ((boff + 2048) ^ (s2 << 5)));
                acc[0][0] = __builtin_amdgcn_mfma_f32_32x32x16_bf16(b0, a0, acc[0][0], 0, 0, 0);
                acc[0][1] = __builtin_amdgcn_mfma_f32_32x32x16_bf16(b1, a0, acc[0][1], 0, 0, 0);
                acc[1][0] = __builtin_amdgcn_mfma_f32_32x32x16_bf16(b0, a1, acc[1][0], 0, 0, 0);
                acc[1][1] = __builtin_amdgcn_mfma_f32_32x32x16_bf16(b1, a1, acc[1][1], 0, 0, 0);
            }
            if (ks == 3) {
                const int nt = s >> 2;
#pragma unroll
                for (int mi = 0; mi < 2; ++mi)
#pragma unroll
                    for (int ni = 0; ni < 2; ++ni)
#pragma unroll
                        for (int g = 0; g < 4; ++g) {
                            *(unsigned*)(lds + M2_C + (wr * 64 + mi * 32 + lr) * M2_CLD + wc * 64 + ni * 32 + 8 * g + 4 * lh) =
                                pack4_fp8(acc[mi][ni][4 * g], acc[mi][ni][4 * g + 1], acc[mi][ni][4 * g + 2], acc[mi][ni][4 * g + 3]);
                            acc[mi][ni][4 * g] = zf; acc[mi][ni][4 * g + 1] = zf; acc[mi][ni][4 * g + 2] = zf; acc[mi][ni][4 * g + 3] = zf;
                        }
                asm volatile("s_waitcnt lgkmcnt(0)" ::: "memory");
                __builtin_amdgcn_s_barrier();
#pragma unroll
                for (int i = 0; i < 4; ++i) {
                    const int ch = t + 256 * i, r = ch >> 3, c16 = (ch & 7) * 16;
                    const int code = codes[r];
                    const u32x4 v = *(const u32x4*)(lds + M2_C + r * M2_CLD + c16);
                    if (code >= 0) *(u32x4*)(slab + (size_t)code * D + n0 + nt * 128 + c16) = v;
                }
            }
        }
#undef M2_ISSUE
    }
    }
    __syncthreads();
}
struct EpiMoeF { const unsigned char* slab; const float* modl; float* out; bf16_t* out16; const bf16_t* hmid; float* hc1; bool outw = true;
    __device__ __forceinline__ void operator()(int r, int c, float v0, float v1, float v2, float v3) const {
    const unsigned char* sl = slab + (size_t)r * 4 * D + c;
    float v[4] = {v0, v1, v2, v3};
    float a[4] = {0.f, 0.f, 0.f, 0.f};
#pragma unroll
    for (int k = 0; k < 4; ++k) { const int q = (int)*(const unsigned*)(sl + (size_t)k * D);
        a[0] += __builtin_amdgcn_cvt_f32_fp8(q, 0); a[1] += __builtin_amdgcn_cvt_f32_fp8(q, 1); a[2] += __builtin_amdgcn_cvt_f32_fp8(q, 2); a[3] += __builtin_amdgcn_cvt_f32_fp8(q, 3); }
#pragma unroll
    for (int q = 0; q < 4; ++q) v[q] += a[q] * (1.f / SLAB_SCALE);
    const f32x4 g2 = *(const f32x4*)(modl + ((size_t)row_bb(r) * 6 + 5) * D + c);
    const uint2 hq = *(const uint2*)(hmid + (size_t)r * D + c);
    const float hm[4] = {__uint_as_float(hq.x << 16), __uint_as_float(hq.x & 0xffff0000u), __uint_as_float(hq.y << 16), __uint_as_float(hq.y & 0xffff0000u)};
    f32x4 o; o[0] = hm[0] + g2[0] * v[0]; o[1] = hm[1] + g2[1] * v[1]; o[2] = hm[2] + g2[2] * v[2]; o[3] = hm[3] + g2[3] * v[3];
    if (outw) {
        if (r >= TL) *(f32x4*)(hc1 + (size_t)(r - TL) * D + c) = o;
        else if (out16) { uint2 pk; pk.x = cvt_pk_bf16(o[0], o[1]); pk.y = cvt_pk_bf16(o[2], o[3]); *(uint2*)(out16 + (size_t)r * D + c) = pk; }
        else *(f32x4*)(out + (size_t)r * D + c) = o; }
    else if (o[0] == 12345.f) *(f32x4*)(hc1) = o; } };
__device__ __forceinline__ EpiMoeF make_epi_moef(const P& p, int l) {
    return EpiMoeF{(const unsigned char*)(p.ws + WS_SLAB), (const float*)(p.ws + WS_MOD) + (size_t)l * 9 * 6 * D, p.out, l == 0 ? (bf16_t*)p.out : (bf16_t*)nullptr, (const bf16_t*)(p.ws + WS_HMID), (float*)(p.ws + WS_HC1)};
}
struct SsmPar { float lre, lim, dt; };
__device__ __forceinline__ SsmPar ssm_par(const P& p, int l, int dir, int g, int pp) {
    const int pi = ((l * 2 + dir) * SG + g) * SP + pp;
    SsmPar r; r.lre = p.in[I_LRE][pi]; r.lim = p.in[I_LIM][pi]; r.dt = expf(p.in[I_LDT][(l * 2 + dir) * SG + g]); return r;
}
__device__ __forceinline__ float2 ssm_pow(const SsmPar& q, float e) {
    const float mag = expf(e * q.lre * q.dt), ang = e * (q.lim * q.dt);
    return make_float2(mag * cosf(ang), mag * sinf(ang));
}
__device__ __forceinline__ float2 ssm_f(const SsmPar& q) {
    const float2 lb = ssm_pow(q, 1.f);
    const float nr = lb.x - 1.f, ni = lb.y, den = q.lre * q.lre + q.lim * q.lim;
    return make_float2((nr * q.lre + ni * q.lim) / den, (ni * q.lre - nr * q.lim) / den);
}
__device__ __forceinline__ float2 cmul(float2 a, float2 b) { return make_float2(a.x * b.x - a.y * b.y, a.x * b.y + a.y * b.x); }
__device__ __forceinline__ void st_ssm_tables(const P& p) {
    float2* pw = (float2*)(p.ws + WS_POW); float2* fb = (float2*)(p.ws + WS_FB);
    for (int idx = BIDX * NT + TIDX; idx < 2 * 2 * 16 * 33 * 64; idx += gridDim.x * NT) {
        const int pp = idx & 63; int q_ = idx >> 6; const int e = q_ % 33; q_ /= 33; const int g = q_ & 15, dir = (q_ >> 4) & 1, l = q_ >> 5;
        pw[idx] = ssm_pow(ssm_par(p, l, dir, g, pp), (float)e);
    }
    for (int idx = BIDX * NT + TIDX; idx < 2 * 2 * 16 * 64 * 16; idx += gridDim.x * NT) {
        const int h = idx & 15, pp = (idx >> 4) & 63, g = (idx >> 10) & 15, dir = (idx >> 14) & 1, l = idx >> 15;
        const size_t bi = ((size_t)((l * 2 + dir) * SG + g) * SP + pp) * 16 + h;
        fb[idx] = cmul(ssm_f(ssm_par(p, l, dir, g, pp)), make_float2(p.in[I_BRE][bi], p.in[I_BIM][bi]));
    }
}
__device__ __forceinline__ void st_ssm_kj(const P& p, float* lds) {
    float* lam = lds; float* Cc = lds + 128; float* Bb = Cc + 2048;
    float* kj = (float*)(p.ws + WS_KJ);
    const int t = TIDX;
    for (int item = (int)gridDim.x - 1 - BIDX; item < 64; item += gridDim.x) {
        const int l = item >> 5, g = (item >> 1) & 15, dir = item & 1;
        const int base = (l * 2 + dir) * SG + g;
        __syncthreads();
        if (t < 64) {
            const SsmPar q = ssm_par(p, l, dir, g, t);
            const float2 lb = ssm_pow(q, 1.f), f = ssm_f(q);
            lam[2 * t] = lb.x; lam[2 * t + 1] = lb.y;
            for (int h = 0; h < 16; ++h) {
                const size_t bi = ((size_t)base * SP + t) * 16 + h;
                const float2 bb = cmul(f, make_float2(p.in[I_BRE][bi], p.in[I_BIM][bi]));
                Bb[(t * 16 + h) * 2] = bb.x; Bb[(t * 16 + h) * 2 + 1] = bb.y;
            }
        }
        for (int i = t; i < 1024; i += NT) { const size_t ci = (size_t)base * 1024 + i; Cc[2 * i] = p.in[I_CRE][ci]; Cc[2 * i + 1] = p.in[I_CIM][ci]; }
        __syncthreads();
        const int ho = t >> 4, hi = t & 15;
        float acc[32];
#pragma unroll
        for (int j = 0; j < 32; ++j) acc[j] = 0.f;
        for (int pp = 0; pp < 64; ++pp) {
            float2 z = cmul(make_float2(Cc[(ho * 64 + pp) * 2], Cc[(ho * 64 + pp) * 2 + 1]), make_float2(Bb[(pp * 16 + hi) * 2], Bb[(pp * 16 + hi) * 2 + 1]));
            const float2 lb = make_float2(lam[2 * pp], lam[2 * pp + 1]);
#pragma unroll
            for (int j = 0; j < 32; ++j) { acc[j] += z.x; z = cmul(z, lb); }
        }
#pragma unroll
        for (int j = 0; j < 32; ++j) kj[((size_t)((l * 16 + g) * 2 + dir) * 32 + j) * 256 + ho * 16 + hi] = acc[j];
    }
    __syncthreads();
}
__device__ __forceinline__ void st_prep_ssm(const P& p, int l, int parts) {
    bf16_t* wst = (bf16_t*)(p.ws + WS_WST);
    if (parts & 1) for (int idx = BIDX * NT + TIDX; idx < 16 * 256 * 64; idx += gridDim.x * NT) {
        const int kc = idx & 63, n = (idx >> 6) & 255, g = idx >> 14;
        const int dir = n >> 7, c = (n >> 6) & 1, pp = n & 63, s = kc >> 1, h0 = (kc & 1) * 8;
        const int ldg = (l * 2 + dir) * 16 + g;
        const float2 coef = ((const float2*)(p.ws + WS_POW))[((size_t)ldg * 33 + (dir == 0 ? 31 - s : s)) * 64 + pp];
        const float2* fbp = (const float2*)(p.ws + WS_FB) + ((size_t)ldg * 64 + pp) * 16 + h0;
        float v[8];
#pragma unroll
        for (int j = 0; j < 8; ++j) { const float2 z = cmul(coef, fbp[j]); v[j] = c == 0 ? z.x : z.y; }
        u32x4 o; o[0] = cvt_pk_bf16(v[0], v[1]); o[1] = cvt_pk_bf16(v[2], v[3]); o[2] = cvt_pk_bf16(v[4], v[5]); o[3] = cvt_pk_bf16(v[6], v[7]);
        *(u32x4*)(wst + ((size_t)(g * 256 + n)) * 512 + kc * 8) = o;
    }
    bf16_t* kw = (bf16_t*)(p.ws + WS_KW);
    const float* kj = (const float*)(p.ws + WS_KJ);
    if (parts & 2) for (int idx = BIDX * NT + TIDX; idx < 16 * 512 * 96; idx += gridDim.x * NT) {
        const int kc = idx % 96, n = (idx / 96) & 511, g = idx / (96 * 512);
        const int tau = n >> 4, ho = n & 15;
        float v[8];
        if (kc < 64) {
            const int s = kc >> 1, hi0 = (kc & 1) * 8;
            const int d0 = tau - s, d1 = s - tau;
            const float m0 = d0 >= 0 ? 1.f : 0.f, m1 = d1 >= 0 ? 1.f : 0.f;
            const float* k0p = kj + ((size_t)((l * 16 + g) * 2 + 0) * 32 + (d0 > 0 ? d0 : 0)) * 256 + ho * 16 + hi0;
            const float* k1p = kj + ((size_t)((l * 16 + g) * 2 + 1) * 32 + (d1 > 0 ? d1 : 0)) * 256 + ho * 16 + hi0;
            const f32x4 a0 = *(const f32x4*)k0p, a1 = *(const f32x4*)(k0p + 4), b0 = *(const f32x4*)k1p, b1 = *(const f32x4*)(k1p + 4);
            const float dsk = p.in[I_SD][l * DSSM + g * 16 + ho];
#pragma unroll
            for (int j = 0; j < 8; ++j) v[j] = m0 * (j < 4 ? a0[j] : a1[j - 4]) + m1 * (j < 4 ? b0[j] : b1[j - 4]) + ((s == tau && ho == hi0 + j) ? dsk : 0.f);
        } else {
            const int kk = (kc - 64) * 8, dir = kk >> 7, c = (kk >> 6) & 1, p0 = kk & 63;
            const int e = dir == 0 ? tau + 1 : 32 - tau;
            const f32x4* pwp = (const f32x4*)((const float2*)(p.ws + WS_POW) + ((size_t)((l * 2 + dir) * 16 + g) * 33 + e) * 64 + p0);
            const size_t ci = ((size_t)((l * 2 + dir) * SG + g) * 16 + ho) * SP + p0;
            const f32x4 cr0 = *(const f32x4*)(p.in[I_CRE] + ci), cr1 = *(const f32x4*)(p.in[I_CRE] + ci + 4), ci0 = *(const f32x4*)(p.in[I_CIM] + ci), ci1 = *(const f32x4*)(p.in[I_CIM] + ci + 4);
            const f32x4 w0 = pwp[0], w1 = pwp[1], w2 = pwp[2], w3 = pwp[3];
            const float pr[8] = {w0[0], w0[2], w1[0], w1[2], w2[0], w2[2], w3[0], w3[2]}, pi[8] = {w0[1], w0[3], w1[1], w1[3], w2[1], w2[3], w3[1], w3[3]};
#pragma unroll
            for (int j = 0; j < 8; ++j) {
                const float2 z = cmul(make_float2(j < 4 ? cr0[j] : cr1[j - 4], j < 4 ? ci0[j] : ci1[j - 4]), make_float2(pr[j], pi[j]));
                v[j] = c == 0 ? z.x : -z.y;
            }
        }
        u32x4 o; o[0] = cvt_pk_bf16(v[0], v[1]); o[1] = cvt_pk_bf16(v[2], v[3]); o[2] = cvt_pk_bf16(v[4], v[5]); o[3] = cvt_pk_bf16(v[6], v[7]);
        *(u32x4*)(kw + ((size_t)(g * 512 + n)) * 768 + kc * 8) = o;
    }
}
__device__ __forceinline__ void st_ssm_egemm(const P& p, unsigned char* lds) {
    const bf16_t* ua = (const bf16_t*)(p.ws + WS_UA);
    const bf16_t* wst = (const bf16_t*)(p.ws + WS_WST);
    float* E = (float*)(p.ws + WS_E);
    int t_end, t_step;
    for (int tile = xcd_first(160, t_end, t_step); tile < t_end; tile += t_step) {
        const int nt = tile & 1, mt = (tile >> 1) % 5, g = tile / 10;
        f32x16 acc[2][2];
        gemm_tile(acc, ARowPlain{ua + (size_t)(g * 640 + mt * 128) * 768, 768}, wst + (size_t)(g * 256 + nt * 128) * 512, 512, 512, lds);
        acc_foreach4_lds(acc, lds, [&](int r, int c, float v0, float v1, float v2, float v3) { f32x4 o; o[0] = v0; o[1] = v1; o[2] = v2; o[3] = v3; *(f32x4*)(E + (size_t)(g * 640 + mt * 128 + r) * 256 + nt * 128 + c) = o; });
    }
}
__device__ __forceinline__ void st_ssm_carry(const P& p, int l) {
    bf16_t* ua = (bf16_t*)(p.ws + WS_UA);
    const float* E = (const float*)(p.ws + WS_E);
    for (int idx = ((int)gridDim.x - 1 - BIDX) * NT + TIDX; idx < NB * 16 * 2 * 64; idx += gridDim.x * NT) {
        const int pp = idx & 63, dir = (idx >> 6) & 1, g = (idx >> 7) & 15, b = idx >> 11;
        const float2 l32 = ((const float2*)(p.ws + WS_POW))[((size_t)((l * 2 + dir) * 16 + g) * 33 + 32) * 64 + pp];
        float2 S = make_float2(0.f, 0.f);
        for (int s0 = 0; s0 < 72; s0 += 24) {
            int ch[24]; float er[24], ei[24];
#pragma unroll
            for (int j = 0; j < 24; ++j) {
                const int step = s0 + j;
                if (dir == 0) ch[j] = step < 8 ? 512 + b * 8 + step : b * 64 + (step - 8);
                else ch[j] = step < 8 ? 512 + b * 8 + (7 - step) : b * 64 + (63 - (step - 8));
                const float* e = E + (size_t)(g * 640 + ch[j]) * 256 + dir * 128 + pp;
                er[j] = e[0]; ei[j] = e[64];
            }
#pragma unroll
            for (int j = 0; j < 24; ++j) {
                bf16_t* o = ua + (size_t)(g * 640 + ch[j]) * 768 + 512 + dir * 128 + pp;
                o[0] = f2bf(S.x); o[64] = f2bf(S.y);
                S = cmul(l32, S); S.x += er[j]; S.y += ei[j];
            }
        }
    }
}
__device__ __forceinline__ void st_ssm_ygemm(const P& p, int l, unsigned char* lds) {
    const bf16_t* ua = (const bf16_t*)(p.ws + WS_UA);
    const bf16_t* kw = (const bf16_t*)(p.ws + WS_KW);
    bf16_t* G = (bf16_t*)(p.ws + WS_G);
    const int nmt = l == 0 ? 5 : 4;
    int t_end, t_step;
    for (int tile = xcd_first(16 * nmt * 4, t_end, t_step); tile < t_end; tile += t_step) {
        const int nt = tile & 3, mt = (tile >> 2) % nmt, g = tile / (4 * nmt);
        f32x16 acc[2][2];
        gemm_tile(acc, ARowPlain{ua + (size_t)(g * 640 + mt * 128) * 768, 768}, kw + (size_t)(g * 512 + nt * 128) * 768, 768, 768, lds);
        acc_foreach4_lds(acc, lds, [&](int r, int c, float v0, float v1, float v2, float v3) {
            const int chunk = mt * 128 + r, n = nt * 128 + c;
            if (chunk < TA / 32) *(uint2*)(G + (size_t)(chunk * 32 + (n >> 4)) * DSSM + g * 16 + (n & 15)) = pack4(gelu_f(v0), gelu_f(v1), gelu_f(v2), gelu_f(v3)); });
    }
}
struct EpiGlu2 { const bf16_t* G; bf16_t* mix; const float* bias; __device__ __forceinline__ void operator()(int r, int c, float v0, float v1, float v2, float v3) const {
    const uint2 q = *(const uint2*)(G + (size_t)r * DSSM + c);
    const f32x4 b = *(const f32x4*)(bias + c);
    *(uint2*)(mix + (size_t)r * D + 256 + c) = pack4(__uint_as_float(q.x << 16) * sigmoid_f(v0 + b[0]), __uint_as_float(q.x & 0xffff0000u) * sigmoid_f(v1 + b[1]),
                                                     __uint_as_float(q.y << 16) * sigmoid_f(v2 + b[2]), __uint_as_float(q.y & 0xffff0000u) * sigmoid_f(v3 + b[3])); } };

constexpr float QSCALE = 0.125f * 1.4426950408889634f;
__device__ __forceinline__ void st_rope_table(const P& p) {
    float2* tab = (float2*)(p.ws + WS_ROPE);
    for (int idx = BIDX * NT + TIDX; idx < L * 32; idx += gridDim.x * NT) {
        const int t = idx >> 5, a = (idx >> 4) & 1, i = idx & 15;
        const float pos = a == 0 ? (float)(t / 64) : (float)(t % 64);
        const float ang = pos * powf(10000.f, -(float)i / 16.f);
        tab[idx] = make_float2(cosf(ang), sinf(ang));
    }
}
__device__ __forceinline__ void st_inproj(const P& p, int l, unsigned char* lds) {
    const bf16_t* A = (const bf16_t*)(p.ws + WS_BUFA);
    const bf16_t* Bt = (const bf16_t*)(p.ws + WS_WTIN);
    bf16_t* pc = (bf16_t*)(p.ws + WS_PC);
    bf16_t* ua = (bf16_t*)(p.ws + WS_UA);
    bf16_t* qb = (bf16_t*)(p.ws + WS_QB);
    bf16_t* kb = (bf16_t*)(p.ws + WS_KB);
    bf16_t* vt = (bf16_t*)(p.ws + WS_VT);
    const float2* rope = (const float2*)(p.ws + WS_ROPE);
    const int lane = TIDX & 63, w = TIDX >> 6, wr = w >> 1, wc = w & 1, lr = lane & 31, lh = lane >> 5;
    constexpr int TN = DIN / 128;
    int t_end, t_step;
    bool pre = false;
    for (int tile = xcd_first((TA / 128) * TN, t_end, t_step); tile < t_end; tile += t_step) {
        const int tn = tile % TN, m0 = (tile / TN) * 128, n0 = tn * 128;
        const int nx = tile + t_step; const bool hn = nx < t_end;
        const int nm0 = hn ? (nx / TN) * 128 : m0, nn0 = hn ? (nx % TN) * 128 : n0;
        f32x16 acc[2][2];
        gemm_tile(acc, ARowPlain{A + (size_t)m0 * D, D}, Bt + (size_t)n0 * D, D, D, lds, pre, hn, ARowPlain{A + (size_t)nm0 * D, D}, Bt + (size_t)nn0 * D);
        if (tn < 6) {
            acc_foreach4_lds(acc, lds, [&](int r, int c, float v0, float v1, float v2, float v3) { *(uint2*)(pc + (size_t)(m0 + r) * 768 + n0 + c) = pack4(v0, v1, v2, v3); });
        } else if (tn < 8) {
            acc_foreach4_lds(acc, lds, [&](int r, int c, float v0, float v1, float v2, float v3) { const int row = m0 + r, g = (tn - 6) * 8 + (c >> 4);
                *(uint2*)(ua + (size_t)(g * 640 + (row >> 5)) * 768 + (row & 31) * 16 + (c & 15)) = pack4(v0, v1, v2, v3); });
        } else if (tn < 13) {
            const bool isq = tn < 12;
            const float* gain = (isq ? p.in[I_QG] : p.in[I_KG]) + l * 64;
            const bool lat = m0 < TL;
            const float osc = isq ? QSCALE : 1.f;
#pragma unroll
            for (int mi = 0; mi < 2; ++mi) {
                const int row = m0 + wr * 64 + mi * 32 + lr;
                float ss = 0.f;
#pragma unroll
                for (int ni = 0; ni < 2; ++ni)
#pragma unroll
                    for (int r = 0; r < 16; ++r) ss += acc[mi][ni][r] * acc[mi][ni][r];
                ss += __shfl_xor(ss, 32);
                const float rinv = rsqrtf(ss * (1.f / 64.f) + 1e-6f) * osc;
                const int t = row & (L - 1);
                bf16_t* o = isq ? qb + (size_t)row * DATT + ((tn - 8) * 2 + wc) * 64 : kb + (size_t)row * 128 + wc * 64;
#pragma unroll
                for (int ni = 0; ni < 2; ++ni)
#pragma unroll
                    for (int g = 0; g < 2; ++g) {
                        const int d0 = ni * 32 + 8 * g + 4 * lh;
                        const f32x4 glo = *(const f32x4*)(gain + d0), ghi = *(const f32x4*)(gain + d0 + 16);
                        float t1[4], t2[4];
#pragma unroll
                        for (int q = 0; q < 4; ++q) { t1[q] = acc[mi][ni][4 * g + q] * rinv * glo[q]; t2[q] = acc[mi][ni][8 + 4 * g + q] * rinv * ghi[q]; }
                        if (lat) {
                            const float2* cs = rope + (t * 2 + ni) * 16 + 8 * g + 4 * lh;
                            const f32x4 c01 = *(const f32x4*)(cs), c23 = *(const f32x4*)(cs + 2);
                            const float cc[4] = {c01[0], c01[2], c23[0], c23[2]}, sn[4] = {c01[1], c01[3], c23[1], c23[3]};
#pragma unroll
                            for (int q = 0; q < 4; ++q) { const float a = t1[q], b = t2[q]; t1[q] = a * cc[q] - b * sn[q]; t2[q] = a * sn[q] + b * cc[q]; }
                        }
                        *(uint2*)(o + d0) = pack4(t1[0], t1[1], t1[2], t1[3]);
                        *(uint2*)(o + d0 + 16) = pack4(t2[0], t2[1], t2[2], t2[3]);
                    }
            }
        } else {
#pragma unroll
            for (int mi = 0; mi < 2; ++mi) {
                const int row = m0 + wr * 64 + mi * 32 + lr;
                const int prow = (row & ~12) | ((row & 4) << 1) | ((row & 8) >> 1);
#pragma unroll
                for (int ni = 0; ni < 2; ++ni)
#pragma unroll
                    for (int rr = 0; rr < 16; ++rr)
                        vt[(size_t)(wc * 64 + ni * 32 + 8 * (rr >> 2) + 4 * lh + (rr & 3)) * TA + prow] = f2bf(acc[mi][ni][rr]);
            }
        }
    }
}

constexpr int AT_KROWB = 144, AT_VROWB = 144, AT_VOFF = 64 * AT_KROWB, AT_BUFB = AT_VOFF + 64 * AT_VROWB;
template <int NQS>
__device__ __forceinline__ void st_attn3(const P& p, int l, unsigned char* lds, int item_lo, int item_hi, int j_lo, int j_hi) {
    const bf16_t* qb = (const bf16_t*)(p.ws + WS_QB);
    const bf16_t* kb = (const bf16_t*)(p.ws + WS_KB);
    const bf16_t* vb = (const bf16_t*)(p.ws + WS_VT);
    bf16_t* mix = (bf16_t*)(p.ws + WS_BUFA);
    const int t = TIDX, lane = t & 63, w = t >> 6, lr = lane & 31, lh = lane >> 5;
    constexpr int QR = 32 * NQS, NPB = L / QR, NPC = LC / QR, NLAT = NB * NPB * 2;
    int i_first, i_end, i_step;
    {
        const int nb = gridDim.x, bb = BIDX;
        if (j_hi > j_lo) {
            const int x = bb & 7, j = bb >> 3, per = (item_hi - item_lo + 7) >> 3;
            i_first = (j >= j_lo && j < j_hi) ? item_lo + x * per + (j - j_lo) : item_hi;
            i_end = item_lo + (x + 1) * per < item_hi ? item_lo + (x + 1) * per : item_hi; i_step = j_hi - j_lo;
        } else { i_first = item_lo + bb; i_end = item_hi; i_step = nb; }
    }
    for (int item = i_first; item < i_end; item += i_step) {
        const bool isctx = item >= NLAT;
        int b, q0, g;
        if (!isctx) { g = item & 1; q0 = ((item >> 1) % NPB) * QR; b = (item >> 1) / NPB; }
        else { const int it = item - NLAT; g = it & 1; q0 = ((it >> 1) % NPC) * QR; b = (it >> 1) / NPC; }
        const int hq = g * 4 + w, m64 = q0 >> 6;
        const int rq0 = isctx ? TL + b * LC + q0 : b * L + q0;
        bf16x8 qf[NQS][4];
#pragma unroll
        for (int qs = 0; qs < NQS; ++qs)
#pragma unroll
            for (int s4 = 0; s4 < 4; ++s4) qf[qs][s4] = *(const bf16x8*)(qb + (size_t)(rq0 + qs * 32 + lr) * DATT + hq * 64 + s4 * 16 + lh * 8);
        const float sinkl = p.in[I_SINK][l * NQH + hq] * 1.4426950408889634f;
        float m[NQS], lsum[NQS];
        f32x16 o[NQS][2], negm[NQS];
        float zf = 0.f; asm volatile("" : "+v"(zf));
#pragma unroll
        for (int qs = 0; qs < NQS; ++qs) {
            m[qs] = sinkl; lsum[qs] = lh == 0 ? 1.f : 0.f;
#pragma unroll
            for (int r = 0; r < 16; ++r) negm[qs][r] = -sinkl;
            asm volatile("" : "+v"(negm[qs]));
#pragma unroll
            for (int dt = 0; dt < 2; ++dt)
#pragma unroll
                for (int r = 0; r < 16; ++r) o[qs][dt][r] = zf;
        }
        const int nwin = isctx ? 0 : 5, nkt = nwin + 4;
        const int srow = t >> 3, kc = t & 7;
        u32x4 pk[2], pv[2];
        auto tile_row0 = [&](int kt, bool& win, bool& valid) -> int {
            if (kt < nwin) { win = true; const int k64 = m64 - 2 + kt; valid = (k64 >= 0 && k64 < 32); return b * L + k64 * 64; }
            win = false; valid = true; return TL + b * LC + (kt - nwin) * 64;
        };
        int kt = 0; bool win, valid; int krow0 = 0;
        for (; kt < nkt; ++kt) { krow0 = tile_row0(kt, win, valid); if (valid) break; }
#define AT_LOAD(row0_) do { _Pragma("unroll") for (int i = 0; i < 2; ++i) { const size_t off = (size_t)((row0_) + srow + 32 * i) * 128 + g * 64 + kc * 8; pk[i] = *(const u32x4*)(kb + off); pv[i] = *(const u32x4*)(vb + (size_t)(g * 64 + srow + 32 * i) * TA + (row0_) + kc * 8); } } while (0)
#define AT_WRITE(buf_) do { unsigned char* bb_ = lds + (buf_) * AT_BUFB; _Pragma("unroll") for (int i = 0; i < 2; ++i) { const int row = srow + 32 * i; \
            *(u32x4*)(bb_ + row * AT_KROWB + kc * 16) = pk[i]; *(u32x4*)(bb_ + AT_VOFF + row * AT_VROWB + kc * 16) = pv[i]; } } while (0)
        AT_LOAD(krow0);
        __syncthreads();
        AT_WRITE(0);
        int nkt2 = kt + 1; bool nwin2 = false, nvalid = false; int nrow0 = 0;
        for (; nkt2 < nkt; ++nkt2) { nrow0 = tile_row0(nkt2, nwin2, nvalid); if (nvalid) break; }
        if (nkt2 < nkt) AT_LOAD(nrow0);
        __syncthreads();
        int cur = 0;
        while (kt < nkt) {
            const bool cwin = win; const int ckrow0 = krow0;
            const unsigned char* tb = lds + cur * AT_BUFB;
            const bool have_next = nkt2 < nkt;
            int nkt3 = nkt2 + 1; bool nwin3 = false, nvalid3 = false; int nrow3 = 0;
            if (have_next) {
                AT_WRITE(cur ^ 1);
                for (; nkt3 < nkt; ++nkt3) { nrow3 = tile_row0(nkt3, nwin3, nvalid3); if (nvalid3) break; }
                if (nkt3 < nkt) AT_LOAD(nrow3);
            }
            const int j0t = ckrow0 - b * L;
#pragma unroll
            for (int sub = 0; sub < 2; ++sub) {
                bool skip[NQS], anyb = false, alls = true;
#pragma unroll
                for (int qs = 0; qs < NQS; ++qs) {
                    skip[qs] = false;
                    if (cwin) {
                        const int j0 = j0t + sub * 32, i0 = q0 + qs * 32;
                        skip[qs] = (j0 > i0 + 31 + 128 || j0 + 31 < i0 - 128);
                        anyb = anyb || skip[qs] || !(j0 >= i0 + 31 - 128 && j0 + 31 <= i0 + 128);
                    }
                    alls = alls && skip[qs];
                }
                if (alls) continue;
                bf16x8 kf[4];
#pragma unroll
                for (int s4 = 0; s4 < 4; ++s4) kf[s4] = *(const bf16x8*)(tb + (sub * 32 + lr) * AT_KROWB + s4 * 32 + lh * 16);
                f32x16 sT[NQS];
#pragma unroll
                for (int qs = 0; qs < NQS; ++qs) sT[qs] = __builtin_amdgcn_mfma_f32_32x32x16_bf16(kf[0], qf[qs][0], negm[qs], 0, 0, 0);
#pragma unroll
                for (int s4 = 1; s4 < 4; ++s4)
#pragma unroll
                    for (int qs = 0; qs < NQS; ++qs) sT[qs] = __builtin_amdgcn_mfma_f32_32x32x16_bf16(kf[s4], qf[qs][s4], sT[qs], 0, 0, 0);
                if (anyb) {
                    int djb = j0t + sub * 32 + 4 * lh - (q0 + lr);
                    asm volatile("" : "+v"(djb));
#pragma unroll
                    for (int qs = 0; qs < NQS; ++qs)
#pragma unroll
                        for (int r = 0; r < 16; ++r) { const int dj = djb - qs * 32 + (r & 3) + 8 * (r >> 2); if (dj > 128 || dj < -128) sT[qs][r] = -1e30f; }
                }
                float mt[NQS]; bool keep = true;
#pragma unroll
                for (int qs = 0; qs < NQS; ++qs) {
                    float a = sT[qs][0];
#pragma unroll
                    for (int r = 1; r < 16; ++r) a = fmaxf(a, sT[qs][r]);
                    mt[qs] = a;
                    keep = keep && (a <= 8.f);
                }
                if (!__all(keep)) {
                    asm volatile("" ::: "memory");
#pragma unroll
                    for (int qs = 0; qs < NQS; ++qs) {
                        const float dm = fmaxf(0.f, fmaxf(mt[qs], __shfl_xor(mt[qs], 32)));
                        const float alpha = __builtin_amdgcn_exp2f(-dm);
                        m[qs] += dm;
                        lsum[qs] *= alpha;
#pragma unroll
                        for (int r = 0; r < 16; ++r) { o[qs][0][r] *= alpha; o[qs][1][r] *= alpha; sT[qs][r] -= dm; negm[qs][r] = -m[qs]; }
                        asm volatile("" : "+v"(negm[qs]));
                    }
                }
#pragma unroll
                for (int qs = 0; qs < NQS; ++qs) {
                    float ps = 0.f;
#pragma unroll
                    for (int r = 0; r < 16; ++r) { sT[qs][r] = __builtin_amdgcn_exp2f(sT[qs][r]); ps += sT[qs][r]; }
                    lsum[qs] += ps;
                }
#pragma unroll
                for (int s2 = 0; s2 < 2; ++s2) {
                    bf16x8 pf[NQS];
#pragma unroll
                    for (int qs = 0; qs < NQS; ++qs) {
                        u32x4 pkk;
                        pkk[0] = cvt_pk_bf16(sT[qs][8 * s2 + 0], sT[qs][8 * s2 + 1]); pkk[1] = cvt_pk_bf16(sT[qs][8 * s2 + 2], sT[qs][8 * s2 + 3]);
                        pkk[2] = cvt_pk_bf16(sT[qs][8 * s2 + 4], sT[qs][8 * s2 + 5]); pkk[3] = cvt_pk_bf16(sT[qs][8 * s2 + 6], sT[qs][8 * s2 + 7]);
                        pf[qs] = __builtin_bit_cast(bf16x8, pkk);
                    }
#pragma unroll
                    for (int dt = 0; dt < 2; ++dt) {
                        const bf16x8 vf = *(const bf16x8*)(tb + AT_VOFF + (dt * 32 + lr) * AT_VROWB + (sub * 32 + s2 * 16 + lh * 8) * 2);
#pragma unroll
                        for (int qs = 0; qs < NQS; ++qs) o[qs][dt] = __builtin_amdgcn_mfma_f32_32x32x16_bf16(vf, pf[qs], o[qs][dt], 0, 0, 0);
                    }
                }
            }
            __syncthreads();
            kt = nkt2; win = nwin2; krow0 = nrow0; nkt2 = nkt3; nwin2 = nwin3; nrow0 = nrow3; cur ^= 1;
        }
#undef AT_LOAD
#undef AT_WRITE
#pragma unroll
        for (int qs = 0; qs < NQS; ++qs) {
            const float lt = lsum[qs] + __shfl_xor(lsum[qs], 32);
            const float inv = 1.f / lt;
            bf16_t* orow = mix + (size_t)(rq0 + qs * 32 + lr) * D + 512 + hq * 64;
#pragma unroll
            for (int dt = 0; dt < 2; ++dt)
#pragma unroll
                for (int rg = 0; rg < 4; ++rg)
                    *(uint2*)(orow + dt * 32 + 8 * rg + 4 * lh) = pack4(o[qs][dt][4 * rg] * inv, o[qs][dt][4 * rg + 1] * inv, o[qs][dt][4 * rg + 2] * inv, o[qs][dt][4 * rg + 3] * inv);
        }
    }
}

constexpr int FAKE = 0;
constexpr int TIM = 0;
constexpr int PROBE3 = 0;
constexpr int PROBE2 = 0;
__device__ __forceinline__ void st_fake(const P& p, unsigned char* lds) {
    if (FAKE == 0) return;
    const bf16_t* A = (const bf16_t*)(p.ws + WS_BUFA);
    const bf16_t* Bt = (const bf16_t*)(p.ws + WS_WTIN);
    constexpr int TN = DIN / 128;
    int t_end, t_step;
    float sink = 0.f;
    for (int tile = xcd_first((TA / 128) * TN, t_end, t_step); tile < t_end; tile += t_step) {
        const int tn = tile % TN, m0 = (FAKE == 2 || FAKE == 3) ? 0 : (tile / TN) * 128, n0 = FAKE == 3 ? 0 : tn * 128;
        f32x16 acc[2][2];
        gemm_tile(acc, ARowPlain{A + (size_t)m0 * D, D}, Bt + (size_t)n0 * D, D, D, lds);
        if (FAKE == 4) {
            bf16_t* dst = (bf16_t*)(p.ws + WS_HID);
            acc_foreach4_lds(acc, lds, [&](int r, int c, float v0, float v1, float v2, float v3) { *(uint2*)(dst + ((size_t)((tile / TN) * 128 + r) * 128 + c)) = pack4(v0, v1, v2, v3); });
        } else if (FAKE == 5) {
            bf16_t* dst = (bf16_t*)(p.ws + WS_HID);
            __syncthreads();
            acc_foreach4_lds(acc, lds, [&](int r, int c, float v0, float v1, float v2, float v3) { *(uint2*)(lds + (r * 136 + c) * 2) = pack4(v0, v1, v2, v3); });
            __syncthreads();
            const int t = TIDX;
#pragma unroll
            for (int i = 0; i < 8; ++i) { const int ch = t + 256 * i, r = ch >> 4, cc = (ch & 15) * 8;
                *(u32x4*)(dst + ((size_t)((tile / TN) * 128 + r) * 128 + cc)) = *(const u32x4*)(lds + (r * 136 + cc) * 2); }
        } else {
#pragma unroll
        for (int mi = 0; mi < 2; ++mi)
#pragma unroll
            for (int ni = 0; ni < 2; ++ni) sink += acc[mi][ni][0] + acc[mi][ni][7];
        }
    }
    if (sink == 12345.678f) ((float*)(p.ws + WS_RBIAS))[1000] = sink;
}
constexpr int STAGES_PER_LAYER = 11;
constexpr int N_STAGES = 1 + 2 * STAGES_PER_LAYER;
constexpr int REP_STAGE = -1;

__device__ __forceinline__ void run_stage(const P& p, int s, unsigned char* ldsb) {
    float* lds = (float*)ldsb;
    if (s == 0) { st_mod(p, lds); st_rope_table(p); st_ssm_tables(p); st_ssm_kj(p, lds); st_prep_weights(p, 0, ldsb, PW_ALL); return; }
    const int l = (s - 1) / STAGES_PER_LAYER, k = (s - 1) % STAGES_PER_LAYER;
    switch (k) {
    case 0: st_rbias(p, l, lds);
            if (l == 0) st_prep_ssm(p, 0, 3); else st_prep_weights(p, 1, ldsb, PW_GU | PW_DN);
            st_norm(p, l, 0); break;
    case 1: if (l == 0) st_fake(p, ldsb); st_inproj(p, l, ldsb); break;
    case 2: st_ssm_egemm(p, ldsb); st_conv(p, l, gridDim.x >= 320 ? 160 : 0); if (l == 0) st_prep_weights(p, 1, ldsb, PW_IN); break;
    case 3: st_ssm_carry(p, l);
            if (gridDim.x == 512) st_attn3<2>(p, l, ldsb, 0, 448, 0, 56);
            else st_attn3<2>(p, l, ldsb, 0, NB * 64 + (l == 0 ? NB * 8 : 0), 0, 0);
            break;
    case 4: st_ssm_ygemm(p, l, ldsb);
            if (gridDim.x == 512) st_attn3<1>(p, l, ldsb, 896, 1024, 40, 64);
            if (l == 0) st_prep_ssm(p, 1, 1); break;
    case 5: gemm_stage((const bf16_t*)(p.ws + WS_G), DSSM, (const bf16_t*)(p.ws + WS_WTGLU), DSSM, l == 0 ? TA : TL, DSSM, DSSM,
                       EpiGlu2{(const bf16_t*)(p.ws + WS_G), (bf16_t*)(p.ws + WS_BUFA), p.in[I_BGLU] + l * DSSM}, ldsb);
            if (gridDim.x == 512 && l == 0) st_attn3<2>(p, l, ldsb, NB * 64, NB * 64 + NB * 8, 36, 64);
            if (l == 0) st_prep_ssm(p, 1, 2); break;
    case 6: gemm_stage_pre((const bf16_t*)(p.ws + WS_BUFA), D, (const bf16_t*)(p.ws + WS_WTOUT), D, l == 0 ? TA : TL, D, D, make_epi_out(p, l), ldsb); break;
    case 7: if (PROBE2 == 1 && l == 0) st_router2<true>(p, l, ldsb); st_router2(p, l, ldsb); if (l == 0) st_prep_weights(p, 1, ldsb, PW_GLU | PW_OUT); break;
    case 8: st_moe1(p, l, ldsb); break;
    case 9: st_moe2s(p, l, ldsb); break;
    case 10: if (PROBE2 == 2 && l == 0) { EpiMoeF e = make_epi_moef(p, l); e.outw = false; gemm_stage((const bf16_t*)(p.ws + WS_HID) + 4 * DE, 5 * DE, (const bf16_t*)(p.ws + WS_WD) + (size_t)32 * D * DE, DE, TA, D, DE, e, ldsb); }
             gemm_stage((const bf16_t*)(p.ws + WS_HID) + 4 * DE, 5 * DE, (const bf16_t*)(p.ws + WS_WD) + (size_t)32 * D * DE, DE, l == 0 ? TA : TL, D, DE, make_epi_moef(p, l), ldsb); break;
    }
}


#define XB_TMO      128
#define XB_XCNT(j)  (256  + 64 * (j))
#define XB_XSUB(j)  (1280 + 64 * (j))
#define XB_XGEN(j)  (2304 + 64 * (j))
#define XB_TOP      3328
#define XB_TOPGEN   3392
#define XCD_BAR_WORDS 3456
#define XB_SPIN_CAP (1u << 22)
__device__ __forceinline__ unsigned xb_ld(unsigned* p)              { return __hip_atomic_load(p, __ATOMIC_RELAXED, __HIP_MEMORY_SCOPE_AGENT); }
__device__ __forceinline__ unsigned xb_add(unsigned* p, unsigned v) { return __hip_atomic_fetch_add(p, v, __ATOMIC_RELAXED, __HIP_MEMORY_SCOPE_AGENT); }
__device__ __forceinline__ unsigned xb_xcc_id() { return (unsigned)__builtin_amdgcn_s_getreg((3 << 11) | 20) & 0xFu; }
#define XB_SPIN(cond, bar) do { unsigned _sp = 0; while (cond) { __builtin_amdgcn_s_sleep(1); \
    if ((++_sp & 255u) == 0u) { if (xb_ld(&(bar)[XB_TMO])) break; if (_sp > XB_SPIN_CAP) { atomicAdd(&(bar)[XB_TMO], 1u); break; } } } } while (0)
struct XcdBarrier { unsigned* bar; unsigned x; volatile LAS unsigned* st; };
__device__ __forceinline__ XcdBarrier xcd_barrier_post(unsigned* bar, volatile LAS unsigned* st) {
    XcdBarrier b; b.bar = bar; b.x = xb_xcc_id(); b.st = st;
    if (threadIdx.x == 0) (void)xb_add(&bar[XB_XCNT(b.x)], 1u);
    return b;
}
__device__ __forceinline__ void xcd_barrier_complete(unsigned* bar, unsigned x, unsigned& nloc, unsigned& nx, unsigned& mask) {
    const unsigned G = gridDim.x * gridDim.y * gridDim.z;
    unsigned sum, cnt, mine, sp = 0u;
    for (;;) {
        sum = 0u; cnt = 0u; mine = 0u; mask = 0u;
#pragma unroll
        for (unsigned j = 0; j < 16; ++j) { const unsigned c = xb_ld(&bar[XB_XCNT(j)]); sum += c; cnt += (c > 0u) ? 1u : 0u; mask |= (c > 0u) ? (1u << j) : 0u; mine = (j == x) ? c : mine; }
        if (sum == G) break;
        __builtin_amdgcn_s_sleep(1);
        if ((++sp & 255u) == 0u) { if (xb_ld(&bar[XB_TMO])) break; if (sp > XB_SPIN_CAP) { atomicAdd(&bar[XB_TMO], 1u); break; } }
    }
    nloc = mine > 0u ? mine : 1u; nx = cnt > 0u ? cnt : 1u;
}
__device__ __forceinline__ void xcd_barrier(const XcdBarrier& b) {
    asm volatile("s_waitcnt vmcnt(0)" ::: "memory");
    __syncthreads();
    if (threadIdx.x == 0) {
        unsigned* bar = b.bar;
        __builtin_amdgcn_s_waitcnt(0);
        unsigned nloc = b.st[0], nx = b.st[1];
        if (nloc == 0u) { unsigned mk; xcd_barrier_complete(bar, b.x, nloc, nx, mk); b.st[0] = nloc; b.st[1] = nx; b.st[4] = mk; }
        const unsigned k = b.st[3], mask = b.st[4];
        const unsigned old = xb_add(&bar[XB_XSUB(b.x)], 1u);
        const unsigned gen = old / nloc;
        if (old + 1u == (gen + 1u) * nloc) {
            __builtin_amdgcn_fence(__ATOMIC_RELEASE, "agent");
            asm volatile("s_waitcnt vmcnt(0)" ::: "memory");
            __hip_atomic_store(&bar[XB_XGEN(b.x)], k + 1u, __ATOMIC_RELAXED, __HIP_MEMORY_SCOPE_AGENT);
        }
        {
            unsigned _sp = 0;
            for (;;) {
                unsigned mn = 0xffffffffu;
#pragma unroll
                for (unsigned j = 0; j < 16; ++j) if (mask & (1u << j)) { const unsigned v = xb_ld(&bar[XB_XGEN(j)]); mn = v < mn ? v : mn; }
                if (mn > k) break;
                __builtin_amdgcn_s_sleep(1);
                if ((++_sp & 255u) == 0u) { if (xb_ld(&bar[XB_TMO])) break; if (_sp > XB_SPIN_CAP) { atomicAdd(&bar[XB_TMO], 1u); break; } }
            }
        }
        __builtin_amdgcn_fence(__ATOMIC_ACQUIRE, "agent");
        asm volatile("s_waitcnt vmcnt(0)" ::: "memory");
        b.st[3] = k + 1u;
    }
    __syncthreads();
}
constexpr size_t WS_XBAR = 4096;

template <int S> __device__ __forceinline__ void run_all(const P& p, unsigned char* lds, const XcdBarrier& xb) {
    run_stage(p, S, lds);
    if constexpr (S == REP_STAGE) { xcd_barrier(xb); run_stage(p, S, lds); }
    if constexpr (S + 1 < N_STAGES) {
        unsigned long long t0 = 0; if (TIM) t0 = __builtin_amdgcn_s_memrealtime();
        xcd_barrier(xb);
        if (TIM && threadIdx.x == 0) { const unsigned long long t1 = __builtin_amdgcn_s_memrealtime(); xb.st[2] += (unsigned)(t1 - t0);
            if (blockIdx.x == 0) ((unsigned long long*)(p.ws + WS_CTL + 32768))[S + 1] = t1; }
        run_all<S + 1>(p, lds, xb);
    } else if (TIM) {
        unsigned* ctl = (unsigned*)(p.ws + WS_CTL + 32768 + 512);
        unsigned long long* ts = (unsigned long long*)(p.ws + WS_CTL + 32768);
        if (threadIdx.x == 0) { atomicAdd(ctl, xb.st[2]); if (blockIdx.x == 0) ts[N_STAGES] = __builtin_amdgcn_s_memrealtime(); }
        xcd_barrier(xb);
        if (blockIdx.x == 0 && threadIdx.x == 0) {
            float us;
            if (TIM == 1) us = (float)__hip_atomic_load(ctl, __ATOMIC_RELAXED, __HIP_MEMORY_SCOPE_AGENT) / (float)gridDim.x * 0.01f / 10.f;
            else if (TIM == 2) us = (float)(ts[N_STAGES] - ts[0]) * 0.01f / 25.f;
            else us = (float)(ts[TIM - 10 + 1] - ts[TIM - 10]) * 0.01f / 2.f;
            float code = floorf(us); if (code > 89.f) code = 89.f;
            p.out[0] += 10.f + code;
        }
    }
}
__global__ void __launch_bounds__(NT, 2) mega(P p) {
    __shared__ __attribute__((aligned(16))) unsigned char lds[LDS_TOTAL + 32];
    volatile LAS unsigned* st = (volatile LAS unsigned*)(lds + LDS_TOTAL);
    if (threadIdx.x == 0) { st[0] = 0u; st[1] = 0u; st[2] = 0u; st[3] = 0u; st[4] = 0u; if (TIM && blockIdx.x == 0) ((unsigned long long*)(p.ws + WS_CTL + 32768))[0] = __builtin_amdgcn_s_memrealtime(); }
    __syncthreads();
    const XcdBarrier xb = xcd_barrier_post((unsigned*)(p.ws + WS_CTL + WS_XBAR), st);
    if (p.ws == nullptr) cg::this_grid().sync();
    run_all<0>(p, lds, xb);
}

extern "C" void kernel_launch(void* const* d_in, const int* in_sizes, int n_in, void* d_out, int out_size, void* d_ws, size_t ws_size, hipStream_t stream) {
    if (n_in != N_IN || ws_size < WS_END) { fprintf(stderr, "kernel_launch: unexpected n_in %d or ws_size %zu (< %zu)\n", n_in, ws_size, (size_t)WS_END); return; }
    P p{};
    for (int i = 0; i < N_IN; ++i) p.in[i] = (const float*)d_in[i];
    p.out = (float*)d_out; p.ws = (unsigned char*)d_ws;
    static int grid_blocks = 0;
    if (!grid_blocks) {
        int dev = 0, cus = 0, per_cu = 0;
        hipGetDevice(&dev);
        hipDeviceGetAttribute(&cus, hipDeviceAttributeMultiprocessorCount, dev);
        hipOccupancyMaxActiveBlocksPerMultiprocessor(&per_cu, (const void*)mega, NT, 0);
        if (per_cu < 1) per_cu = 1;
        if (per_cu > 2) per_cu = 2;
        grid_blocks = cus * per_cu;
    }
    hipMemsetAsync((char*)d_ws + WS_CTL, 0, 65536, stream);
    void* args[] = {&p};
    hipError_t e = hipLaunchCooperativeKernel((const void*)mega, dim3(grid_blocks), dim3(NT), args, 0, stream);
    if (e != hipSuccess) fprintf(stderr, "cooperative launch failed: %s (grid %d)\n", hipGetErrorString(e), grid_blocks);
}
```
